# Optimizing an MI355X kernel written in HIP

```python
import jax
import jax.numpy as jnp
from jax import lax
import numpy as np

D_MODEL = 1024
BATCH = 8
SEQ = 2048
DEPTH = 2

GRID_W = 64
CTX_LEN = 256

RET_HEADS = 4
RET_HD = 128
RET_W = RET_HEADS * RET_HD
RET_CHUNK = 128
RET_GN_EPS = 1e-5

NA_HEADS = 8
NA_HD = 64
NA_W = NA_HEADS * NA_HD
NA_KR_MAX = 8
NA_KC = 16

MIX_W = RET_W + NA_W
IN_W = 4 * RET_W + 3 * NA_W

RWKV_HD = 64
RWKV_HEADS = D_MODEL // RWKV_HD
DECAY_LORA = 64
AAA_LORA = 64
GATE_LORA = 160
RWKV_GN_EPS = 64e-5

FFN_HIDDEN = 2816
N_EXPERTS = 8
TOP_K = 2
EXPERT_HIDDEN = 3584

N_EVEN = (DEPTH + 1) // 2
N_ODD = DEPTH // 2

ROPE_BASE = 10000.0
NORM_EPS = 1e-6
F32 = jnp.float32

kernel_name = 'hybrid_retention_natten_rwkv7_moe_dit'


def rms_norm(x, w):
    x32 = x.astype(F32)
    y = x32 * lax.rsqrt(jnp.mean(x32 * x32, axis=-1, keepdims=True) + NORM_EPS)
    return (y * w.astype(F32)).astype(x.dtype)


def modulate(x, w, shift, scale):
    return rms_norm(x, w) * (1.0 + scale) + shift


def head_group_norm(y, eps):
    mu = jnp.mean(y, axis=-1, keepdims=True)
    yc = y - mu
    return yc * lax.rsqrt(jnp.mean(yc * yc, axis=-1, keepdims=True) + eps)


def to_heads(t, n_heads):
    b, l, _ = t.shape
    return t.reshape(b, l, n_heads, -1).transpose(0, 2, 1, 3)


def from_heads(t):
    b, h, l, d = t.shape
    return t.transpose(0, 2, 1, 3).reshape(b, l, h * d)


def rope_1d(x, pos):
    half = x.shape[-1] // 2
    freqs = ROPE_BASE ** (-jnp.arange(half, dtype=F32) / half)
    ang = pos.astype(F32)[:, None] * freqs[None, :]
    cos, sin = jnp.cos(ang), jnp.sin(ang)
    x1, x2 = x[..., :half], x[..., half:]
    return jnp.concatenate([x1 * cos - x2 * sin, x1 * sin + x2 * cos], axis=-1)


def rope_2d(x, rpos, cpos):
    h = x.shape[-1] // 2
    xf = x.astype(F32)
    return jnp.concatenate([rope_1d(xf[..., :h], rpos), rope_1d(xf[..., h:], cpos)], axis=-1).astype(x.dtype)


def retention_chunked(q, k, v, log_g, s0, return_out):
    b, h, l, dk = q.shape
    dv = v.shape[-1]
    n = l // RET_CHUNK
    qc = q.reshape(b, h, n, RET_CHUNK, dk)
    kc = k.reshape(b, h, n, RET_CHUNK, dk)
    vc = v.reshape(b, h, n, RET_CHUNK, dv)
    idx = jnp.arange(RET_CHUNK, dtype=F32)
    k_dec = jnp.exp(log_g[:, None] * (RET_CHUNK - 1.0 - idx)[None, :])
    kv = jnp.einsum('bhncd,hc,bhnce->nbhde', kc, k_dec, vc)
    chunk_dec = jnp.exp(log_g * RET_CHUNK)[None, :, None, None]

    def step(s, kv_n):
        return s * chunk_dec + kv_n, s

    s_fin, s_prev = lax.scan(step, s0, kv)
    if not return_out:
        return None, s_fin
    diff = idx[:, None] - idx[None, :]
    dmat = jnp.where(diff >= 0, jnp.exp(log_g[:, None, None] * jnp.maximum(diff, 0.0)[None]), 0.0)
    scores = jnp.einsum('bhncd,bhnsd->bhncs', qc, kc) * dmat[None, :, None]
    intra = jnp.einsum('bhncs,bhnse->bhnce', scores, vc)
    q_dec = jnp.exp(log_g[:, None] * (idx + 1.0)[None, :])
    cross = jnp.einsum('bhncd,nbhde->bhnce', qc, s_prev) * q_dec[None, :, None, :, None]
    return (intra + cross).reshape(b, h, l, dv), s_fin


def retention_mix(q_c, k_c, v_c, q_l, k_l, v_l, log_g_f, log_g_b, ctx_out):
    b, h, _, dk = q_c.shape
    s0 = jnp.zeros((b, h, dk, v_c.shape[-1]), F32)

    def flip(t):
        return jnp.flip(t, axis=2)

    oc_f, s_f = retention_chunked(q_c, k_c, v_c, log_g_f, s0, ctx_out)
    ol_f, _ = retention_chunked(q_l, k_l, v_l, log_g_f, s_f, True)
    oc_b, s_b = retention_chunked(flip(q_c), flip(k_c), flip(v_c), log_g_b, s0, ctx_out)
    ol_b, _ = retention_chunked(flip(q_l), flip(k_l), flip(v_l), log_g_b, s_b, True)
    y_l = ol_f + flip(ol_b)
    y_c = oc_f + flip(oc_b) if ctx_out else None
    return y_c, y_l


def retention_readout(y, g, gn_w):
    yn = from_heads(head_group_norm(y, RET_GN_EPS)) * gn_w.astype(F32)
    return (yn * jax.nn.silu(g.astype(F32))).astype(g.dtype)


def neighborhood_attention(q, k, v, k_c, v_c, rpb, rows):
    b, h, l, d = q.shape
    kr = min(NA_KR_MAX, rows)
    nwin = kr * NA_KC
    scale = d ** -0.5
    qg = q.reshape(b, h, rows, GRID_W, d)
    kg = k.reshape(b, h, rows, GRID_W, d)
    vg = v.reshape(b, h, rows, GRID_W, d)
    cols = np.arange(GRID_W)
    col_start = np.clip(cols - NA_KC // 2, 0, GRID_W - NA_KC)
    col_idx = col_start[:, None] + np.arange(NA_KC)[None, :]
    col_off = col_idx - cols[:, None] + (NA_KC - 1)
    rpb_c = rpb[:, :, col_off]

    def row_fn(r):
        r0 = jnp.clip(r - kr // 2, 0, rows - kr)
        q_row = lax.dynamic_index_in_dim(qg, r, axis=2, keepdims=False)
        k_win = lax.dynamic_slice_in_dim(kg, r0, kr, axis=2)[:, :, :, col_idx]
        v_win = lax.dynamic_slice_in_dim(vg, r0, kr, axis=2)[:, :, :, col_idx]
        row_off = r0 + jnp.arange(kr) - r + (NA_KR_MAX - 1)
        bias = jnp.transpose(rpb_c[:, row_off], (0, 2, 1, 3))
        s_win = jnp.einsum('bhqd,bhrqcd->bhqrc', q_row, k_win) * scale + bias[None]
        s_ctx = jnp.einsum('bhqd,bhkd->bhqk', q_row, k_c) * scale
        s = jnp.concatenate([s_win.reshape(b, h, GRID_W, nwin), s_ctx], axis=-1).astype(F32)
        p = jax.nn.softmax(s, axis=-1).astype(v.dtype)
        p_win = p[..., :nwin].reshape(b, h, GRID_W, kr, NA_KC)
        return (jnp.einsum('bhqrc,bhrqcd->bhqd', p_win, v_win)
                + jnp.einsum('bhqk,bhkd->bhqd', p[..., nwin:], v_c))

    out = lax.map(row_fn, jnp.arange(rows))
    return jnp.transpose(out, (1, 2, 0, 3, 4)).reshape(b, h, l, d)


def context_attention(q, k, v):
    s = jnp.einsum('bhqd,bhkd->bhqk', q, k) * (q.shape[-1] ** -0.5)
    p = jax.nn.softmax(s.astype(F32), axis=-1).astype(v.dtype)
    return jnp.einsum('bhqk,bhkd->bhqd', p, v)


def even_mixer(h_c, h_l, w_in, dec_f, dec_b, gn_w, qn_w, kn_w, rpb, w_out, rows, ctx_out):
    l = h_l.shape[1]
    t = jnp.arange(l)
    rpos, cpos = t // GRID_W, t % GRID_W
    cuts = [int(u) for u in np.cumsum([RET_W] * 4 + [NA_W] * 3)[:-1]]
    rq_l, rk_l, rv_l, rg_l, nq_l, nk_l, nv_l = jnp.split(h_l @ w_in, cuts, axis=-1)
    rq_c, rk_c, rv_c, rg_c, nq_c, nk_c, nv_c = jnp.split(h_c @ w_in, cuts, axis=-1)
    kscale = RET_HD ** -0.5
    q_l = rope_2d(to_heads(rq_l, RET_HEADS), rpos, cpos).astype(F32)
    k_l = rope_2d(to_heads(rk_l, RET_HEADS), rpos, cpos).astype(F32) * kscale
    v_l = to_heads(rv_l, RET_HEADS).astype(F32)
    q_c = to_heads(rq_c, RET_HEADS).astype(F32)
    k_c = to_heads(rk_c, RET_HEADS).astype(F32) * kscale
    v_c = to_heads(rv_c, RET_HEADS).astype(F32)
    log_g_f = -jnp.exp(dec_f.astype(F32))
    log_g_b = -jnp.exp(dec_b.astype(F32))
    y_c, y_l = retention_mix(q_c, k_c, v_c, q_l, k_l, v_l, log_g_f, log_g_b, ctx_out)
    ret_l = retention_readout(y_l, rg_l, gn_w)
    aq_l = rms_norm(to_heads(nq_l, NA_HEADS), qn_w)
    ak_l = rms_norm(to_heads(nk_l, NA_HEADS), kn_w)
    av_l = to_heads(nv_l, NA_HEADS)
    aq_c = rms_norm(to_heads(nq_c, NA_HEADS), qn_w)
    ak_c = rms_norm(to_heads(nk_c, NA_HEADS), kn_w)
    av_c = to_heads(nv_c, NA_HEADS)
    na_l = from_heads(neighborhood_attention(aq_l, ak_l, av_l, ak_c, av_c, rpb, rows))
    out_l = jnp.concatenate([ret_l, na_l], axis=-1) @ w_out
    out_c = None
    if ctx_out:
        na_c = from_heads(context_attention(aq_c, ak_c, av_c))
        out_c = jnp.concatenate([retention_readout(y_c, rg_c, gn_w), na_c], axis=-1) @ w_out
    return out_c, out_l


def centred_shift(x):
    xp = jnp.pad(x, ((0, 0), (1, 1), (0, 0)))
    return 0.5 * (xp[:, :-2] + xp[:, 2:])


def rwkv_features(h, mu, w_rkv, w0, w1, w2, a0, a1, a2, k_k, k_a, full):
    def hs(t):
        return t.astype(F32).reshape(t.shape[:-1] + (RWKV_HEADS, RWKV_HD))

    xx = centred_shift(h) - h
    xm = h[None] + xx[None] * mu[:, None, None, :]
    lo = 0 if full else 1
    proj = jnp.einsum('sbld,sde->sble', xm[lo:3], w_rkv[lo:3])
    r = hs(proj[0]) if full else None
    k, v = proj[-2], proj[-1]
    w_lora = jnp.einsum('zblr,zrd->zbld', jnp.tanh(jnp.einsum('bld,zdr->zblr', xm[3], w1)), w2)
    log_w = -jax.nn.softplus(-(w0[:, None, None, :] + w_lora).astype(F32)) - 0.5
    decay = jnp.exp(-jnp.exp(log_w))
    a = jax.nn.sigmoid((a0[:, None, None, :] + jnp.einsum('zblr,zrd->zbld', jnp.einsum('bld,zdr->zblr', xm[4], a1), a2)).astype(F32))
    kk = hs(k * k_k)
    kk = kk / jnp.maximum(jnp.sqrt(jnp.sum(kk * kk, axis=-1, keepdims=True)), 1e-12)
    k_dir = hs(k.astype(F32)[None] * (1.0 + (a - 1.0) * k_a.astype(F32)))
    return r, k_dir, hs(v), kk, hs(a), hs(decay), xm[5]


def rwkv7_scan(seqs, s0):
    with_y = len(seqs) == 6

    def step(S, inp):
        w_t, k_t, v_t, a_t, b_t = inp[:5]
        S = (S * w_t[:, :, None, :]
             + jnp.einsum('bhij,bhj->bhi', S, a_t)[..., None] * b_t[:, :, None, :]
             + v_t[..., None] * k_t[:, :, None, :])
        y_t = jnp.einsum('bhij,bhj->bhi', S, inp[5]) if with_y else None
        return S, y_t

    xs = tuple(jnp.moveaxis(t, 1, 0) for t in seqs)
    s_fin, ys = lax.scan(step, s0, xs)
    return (jnp.moveaxis(ys, 0, 1) if with_y else None), s_fin


def rwkv_direction(feat, z, s0, reverse, with_y):
    r, k_dir, v, kk, a, decay, _ = feat
    seqs = [decay[z], k_dir[z], v, -kk, kk * a[z]]
    if with_y:
        seqs.append(r)
    if reverse:
        seqs = [jnp.flip(t, axis=1) for t in seqs]
    y, s = rwkv7_scan(seqs, s0)
    if reverse and with_y:
        y = jnp.flip(y, axis=1)
    return y, s


def rwkv_readout(y, feat, g1, g2, r_k, ln_w, ln_b, w_o):
    r, k_dir, v, _, _, _, xg = feat
    b, l, hh, n = y.shape
    yn = head_group_norm(y, RWKV_GN_EPS).reshape(b, l, hh * n) * ln_w.astype(F32) + ln_b.astype(F32)
    coeff = jnp.sum(r[None] * k_dir * r_k.astype(F32).reshape(hh, n), axis=-1, keepdims=True).sum(axis=0)
    bonus = (coeff * v).reshape(b, l, hh * n)
    g = jax.nn.sigmoid(xg @ g1) @ g2
    return ((yn + bonus).astype(xg.dtype) * g) @ w_o


def odd_mixer(h_c, h_l, mu, w_rkv, w0, w1, w2, a0, a1, a2, g1, g2, k_k, k_a, r_k, ln_w, ln_b, w_o, ctx_out):
    feat_c = rwkv_features(h_c, mu, w_rkv, w0, w1, w2, a0, a1, a2, k_k, k_a, ctx_out)
    feat_l = rwkv_features(h_l, mu, w_rkv, w0, w1, w2, a0, a1, a2, k_k, k_a, True)
    s0 = jnp.zeros((h_c.shape[0], RWKV_HEADS, RWKV_HD, RWKV_HD), F32)
    yc_f, sc_f = rwkv_direction(feat_c, 0, s0, False, ctx_out)
    yc_b, sc_b = rwkv_direction(feat_c, 1, s0, True, ctx_out)
    yl_f, _ = rwkv_direction(feat_l, 0, sc_f, False, True)
    yl_b, _ = rwkv_direction(feat_l, 1, sc_b, True, True)
    out_l = rwkv_readout(yl_f + yl_b, feat_l, g1, g2, r_k, ln_w, ln_b, w_o)
    out_c = rwkv_readout(yc_f + yc_b, feat_c, g1, g2, r_k, ln_w, ln_b, w_o) if ctx_out else None
    return out_c, out_l


def swiglu(x, w13, w2):
    gate, up = jnp.split(x @ w13, 2, axis=-1)
    return (jax.nn.silu(gate) * up) @ w2


def moe_swiglu(h, router, w13, w2):
    b, l, d = h.shape
    t = h.reshape(-1, d)
    logits = (t @ router).astype(F32)
    top_v, top_i = lax.top_k(logits, TOP_K)
    top_w = jax.nn.softmax(top_v, axis=-1)
    gates = jnp.sum(jax.nn.one_hot(top_i, N_EXPERTS, dtype=F32) * top_w[..., None], axis=1)
    out = jnp.zeros(t.shape, F32)
    for e in range(N_EXPERTS):
        out = out + gates[:, e:e + 1] * swiglu(t, w13[e], w2[e]).astype(F32)
    return out.astype(h.dtype).reshape(b, l, d)


def setup_inputs(seed: int = 0) -> dict:
    key = jax.random.key(seed)
    ks = iter(jax.random.split(key, 48))

    def nrm(shape, scale):
        return jax.random.normal(next(ks), shape, F32) * scale

    def unif(shape, lo, hi):
        return jax.random.uniform(next(ks), shape, F32, lo, hi)

    d = D_MODEL
    ret_dec = jnp.log(-jnp.log1p(-(2.0 ** (-5.0 - jnp.arange(RET_HEADS, dtype=F32)))))
    return {
        'x': nrm((BATCH, SEQ, d), 1.0),
        'c': nrm((BATCH, d), 1.0),
        'ctx': nrm((BATCH, CTX_LEN, d), 1.0),
        'c_ctx': nrm((d,), 1.0),
        'ada_w': nrm((DEPTH, d, 6 * d), 0.5 * d ** -0.5),
        'ada_b': nrm((DEPTH, 6 * d), 0.02),
        'norm_mix_w': 1.0 + nrm((DEPTH, d), 0.02),
        'norm_ffn_w': 1.0 + nrm((DEPTH, d), 0.02),
        'ev_w_in': nrm((N_EVEN, d, IN_W), d ** -0.5),
        'ev_ret_decay_f': ret_dec + nrm((N_EVEN, RET_HEADS), 0.05),
        'ev_ret_decay_b': ret_dec + nrm((N_EVEN, RET_HEADS), 0.05),
        'ev_ret_gn_w': 1.0 + nrm((N_EVEN, RET_W), 0.02),
        'ev_na_qn_w': 1.0 + nrm((N_EVEN, NA_HD), 0.02),
        'ev_na_kn_w': 1.0 + nrm((N_EVEN, NA_HD), 0.02),
        'ev_na_rpb': nrm((N_EVEN, NA_HEADS, 2 * NA_KR_MAX - 1, 2 * NA_KC - 1), 0.1),
        'ev_w_out': nrm((N_EVEN, MIX_W, d), MIX_W ** -0.5),
        'ev_ffn_w13': nrm((N_EVEN, d, 2 * FFN_HIDDEN), d ** -0.5),
        'ev_ffn_w2': nrm((N_EVEN, FFN_HIDDEN, d), FFN_HIDDEN ** -0.5),
        'od_mu': unif((N_ODD, 6, d), 0.0, 1.0),
        'od_w_rkv': nrm((N_ODD, 3, d, d), d ** -0.5),
        'od_w0': unif((N_ODD, 2, d), -6.5, -1.5),
        'od_w1': nrm((N_ODD, 2, d, DECAY_LORA), d ** -0.5),
        'od_w2': nrm((N_ODD, 2, DECAY_LORA, d), 0.1 * DECAY_LORA ** -0.5),
        'od_a0': nrm((N_ODD, 2, d), 0.1),
        'od_a1': nrm((N_ODD, 2, d, AAA_LORA), d ** -0.5),
        'od_a2': nrm((N_ODD, 2, AAA_LORA, d), 0.1 * AAA_LORA ** -0.5),
        'od_g1': nrm((N_ODD, d, GATE_LORA), d ** -0.5),
        'od_g2': nrm((N_ODD, GATE_LORA, d), GATE_LORA ** -0.5),
        'od_k_k': 0.85 + nrm((N_ODD, d), 0.05),
        'od_k_a': 1.0 + nrm((N_ODD, d), 0.05),
        'od_r_k': nrm((N_ODD, d), 0.1),
        'od_ln_w': 1.0 + nrm((N_ODD, d), 0.02),
        'od_ln_b': nrm((N_ODD, d), 0.02),
        'od_w_o': nrm((N_ODD, d, d), d ** -0.5),
        'od_router': nrm((N_ODD, d, N_EXPERTS), d ** -0.5),
        'od_moe_w13': nrm((N_ODD, N_EXPERTS, d, 2 * EXPERT_HIDDEN), d ** -0.5),
        'od_moe_w2': nrm((N_ODD, N_EXPERTS, EXPERT_HIDDEN, d), EXPERT_HIDDEN ** -0.5),
    }


def reference(x, c, ctx, c_ctx, ada_w, ada_b, norm_mix_w, norm_ffn_w, ev_w_in, ev_ret_decay_f, ev_ret_decay_b,
              ev_ret_gn_w, ev_na_qn_w, ev_na_kn_w, ev_na_rpb, ev_w_out, ev_ffn_w13, ev_ffn_w2, od_mu, od_w_rkv,
              od_w0, od_w1, od_w2, od_a0, od_a1, od_a2, od_g1, od_g2, od_k_k, od_k_a, od_r_k, od_ln_w, od_ln_b,
              od_w_o, od_router, od_moe_w13, od_moe_w2):
    rows = x.shape[1] // GRID_W
    s_lat = jax.nn.silu(c)
    s_ctx = jax.nn.silu(c_ctx)
    x_l, x_c = x, ctx
    for i in range(DEPTH):
        j = i // 2
        ctx_out = i < DEPTH - 1
        m_l = jnp.split((s_lat @ ada_w[i] + ada_b[i])[:, None, :], 6, axis=-1)
        m_c = jnp.split(s_ctx @ ada_w[i] + ada_b[i], 6, axis=-1)
        h_l = modulate(x_l, norm_mix_w[i], m_l[0], m_l[1])
        h_c = modulate(x_c, norm_mix_w[i], m_c[0], m_c[1])
        if i % 2 == 0:
            o_c, o_l = even_mixer(h_c, h_l, ev_w_in[j], ev_ret_decay_f[j], ev_ret_decay_b[j], ev_ret_gn_w[j],
                                  ev_na_qn_w[j], ev_na_kn_w[j], ev_na_rpb[j], ev_w_out[j], rows, ctx_out)

            def ffn(hh, j=j):
                return swiglu(hh, ev_ffn_w13[j], ev_ffn_w2[j])
        else:
            o_c, o_l = odd_mixer(h_c, h_l, od_mu[j], od_w_rkv[j], od_w0[j], od_w1[j], od_w2[j], od_a0[j], od_a1[j],
                                 od_a2[j], od_g1[j], od_g2[j], od_k_k[j], od_k_a[j], od_r_k[j], od_ln_w[j],
                                 od_ln_b[j], od_w_o[j], ctx_out)

            def ffn(hh, j=j):
                return moe_swiglu(hh, od_router[j], od_moe_w13[j], od_moe_w2[j])
        x_l = x_l + m_l[2] * o_l
        x_l = x_l + m_l[5] * ffn(modulate(x_l, norm_ffn_w[i], m_l[3], m_l[4]))
        if ctx_out:
            x_c = x_c + m_c[2] * o_c
            x_c = x_c + m_c[5] * ffn(modulate(x_c, norm_ffn_w[i], m_c[3], m_c[4]))
    return x_l
```

```cpp
#include <hip/hip_runtime.h>
#include <cstdio>
#include <cstdint>

#define DI __device__ __forceinline__
#define LAS __attribute__((address_space(3)))

namespace pg8 {
#define PG8_LAS __attribute__((address_space(3)))
typedef unsigned short bf16_t;
typedef short bf16x8 __attribute__((ext_vector_type(8)));
typedef float f32x4 __attribute__((ext_vector_type(4)));
typedef unsigned u32x4 __attribute__((ext_vector_type(4)));
constexpr int BM = 256, BK = 64, HALF = 128, HTB = HALF * BK * 2  , STAGE_BYTES = 8 * HTB, NXCD = 8, WGM = 8;

__host__ __device__ __forceinline__ int lds_byte(int r, int c) { const int st = (r >> 4) * 2 + (c >> 5), rr = r & 15, cc = c & 31, ob = rr * 64 + cc * 2; return st * 1024 + (ob ^ (((ob >> 9) & 1) << 5)); }
__host__ __device__ __forceinline__ void stage_rc(int b, int& R, int& C) { const int st = b / 1024, sb = b % 1024, swz = sb ^ (((sb >> 9) & 1) << 5); R = (st >> 1) * 16 + swz / 64; C = (st & 1) * 32 + (swz % 64) / 2; }
__host__ __device__ __forceinline__ int perm32(int rho) { const int n = rho >> 4, i = rho & 15; return 8 * (i >> 2) + 4 * n + (i & 3); }

struct Unit { int pm, pn, pb; };
struct Gemm { const bf16_t* A; const bf16_t* Bt; int M, N, K; };

struct StaticOrder {
    int nM, nN, nwg, G, c;
    __host__ __device__ void init(int M, int N, int G_, int c_) { nM = M / BM; nN = N / BM; nwg = nM * nN; G = G_; c = c_; }
    __host__ __device__ bool next(int i, Unit& u) const {
        const long L = (long)i * G + c; if (L >= nwg) return false;
        int wgid = (int)L; { const int q = nwg / NXCD, r = nwg % NXCD, xcd = wgid % NXCD, off = wgid / NXCD; wgid = (xcd < r ? xcd * (q + 1) : r * (q + 1) + (xcd - r) * q) + off; }
        const int nig = WGM * nN, gid = wgid / nig, fm = gid * WGM, gsz = (nM - fm) < WGM ? (nM - fm) : WGM;
        u.pm = fm + ((wgid % nig) % gsz); u.pn = (wgid % nig) / gsz; u.pb = u.pn; return true;
    }
    __device__ __forceinline__ void a_ready(const Unit&) const {}
    __device__ __forceinline__ void done(const Unit&) const {}
};
struct MoeOrder {
    int nM, nN, nwg, G, c; int tend[8];
    __device__ bool next(int i, Unit& u) const {
        const long L = (long)i * G + c; if (L >= nwg) return false;
        int wgid = (int)L; { const int q = nwg / NXCD, r = nwg % NXCD, xcd = wgid % NXCD, off = wgid / NXCD; wgid = (xcd < r ? xcd * (q + 1) : r * (q + 1) + (xcd - r) * q) + off; }
        const int nig = WGM * nN, gid = wgid / nig, fm = gid * WGM, gsz = (nM - fm) < WGM ? (nM - fm) : WGM;
        u.pm = fm + ((wgid % nig) % gsz); u.pn = (wgid % nig) / gsz;
        int e = 0;
#pragma unroll
        for (int j = 0; j < 7; ++j) e += (u.pm >= tend[j]) ? 1 : 0;
        u.pb = e * nN + u.pn; return true;
    }
    __device__ __forceinline__ void a_ready(const Unit&) const {}
    __device__ __forceinline__ void done(const Unit&) const {}
};

__device__ __forceinline__ unsigned cvt_pk_bf16(float lo, float hi) { unsigned r; asm volatile("v_cvt_pk_bf16_f32 %0, %1, %2" : "=v"(r) : "v"(lo), "v"(hi)); return r; }

template <class Epi, class Sched>
__device__ __forceinline__ void gemm_phase(PG8_LAS unsigned char* lds, const Gemm g, const Sched& S, const Epi& E) {
    const int tid = threadIdx.x, wid = __builtin_amdgcn_readfirstlane(tid >> 6), lane = tid & 63, wr = wid >> 2, wc = wid & 3, fr = lane & 15, fq = lane >> 4;
    const int K = g.K, nt = K / BK;
    unsigned voffA[2], voffB[2];
#pragma unroll
    for (int i = 0; i < 2; ++i) { int R, C; stage_rc(tid * 16 + i * 8192, R, C); const int Rb = Epi::PERM ? ((R & ~31) + perm32(R & 31)) : R;
        voffA[i] = (unsigned)(R * K + C) * 2u; voffB[i] = (unsigned)(Rb * K + C) * 2u; }
    const size_t kstep = (size_t)(BK * 2);
    const size_t hstep = (size_t)HALF * K * 2;
    const size_t tstep = 2 * hstep;
    const unsigned ldsw = (unsigned)wid * 1024u;
    const int aoff = lds_byte(wr * 64 + fr, fq * 8), boff = lds_byte(wc * 32 + fr, fq * 8);
#define PG8_SA(b, h) (((b) * 2 + (h)) * HTB)
#define PG8_SB(b, h) ((4 + (b) * 2 + (h)) * HTB)
#define PG8_STAGE(bufoff, gbase, voff) do { _Pragma("unroll") for (int _i = 0; _i < 2; ++_i) \
        __builtin_amdgcn_global_load_lds((const unsigned*)((const char*)(gbase) + (voff)[_i]), (PG8_LAS unsigned*)(lds + (bufoff) + ldsw + _i * 8192), 16, 0, 0); } while (0)
#define PG8_LDA(dst, b, h) do { _Pragma("unroll") for (int m = 0; m < 4; ++m) _Pragma("unroll") for (int k = 0; k < 2; ++k) dst[m][k] = *(const PG8_LAS bf16x8*)(lds + PG8_SA(b, h) + aoff + m * 2048 + k * 1024); } while (0)
#define PG8_LDB(dst, b, h) do { _Pragma("unroll") for (int n = 0; n < 2; ++n) _Pragma("unroll") for (int k = 0; k < 2; ++k) dst[n][k] = *(const PG8_LAS bf16x8*)(lds + PG8_SB(b, h) + boff + n * 2048 + k * 1024); } while (0)
#define PG8_MMA(ai, bj, At, Bt) do { __builtin_amdgcn_s_setprio(1); _Pragma("unroll") for (int m = 0; m < 4; ++m) _Pragma("unroll") for (int n = 0; n < 2; ++n) _Pragma("unroll") for (int k = 0; k < 2; ++k) \
        acc[ai][bj][m][n] = __builtin_amdgcn_mfma_f32_16x16x32_bf16(Bt[n][k], At[m][k], acc[ai][bj][m][n], 0, 0, 0); __builtin_amdgcn_s_setprio(0); } while (0)
#define PG8_WAIT_V(n) asm volatile("s_waitcnt vmcnt(" #n ")" ::: "memory")
#define PG8_WAIT_L(n) asm volatile("s_waitcnt lgkmcnt(" #n ")" ::: "memory")
#define PG8_BAR __builtin_amdgcn_s_barrier()
#define PG8_SCHED __builtin_amdgcn_sched_barrier(0)
    Unit cur, nxt; int ui = 0;
    if (!S.next(0, cur)) return;
    f32x4 acc[2][2][4][2];
#pragma unroll
    for (int a = 0; a < 2; ++a)
#pragma unroll
        for (int b = 0; b < 2; ++b)
#pragma unroll
            for (int m = 0; m < 4; ++m)
#pragma unroll
                for (int n = 0; n < 2; ++n) acc[a][b][m][n] = (f32x4){0.f, 0.f, 0.f, 0.f};
    bf16x8 At[4][2], B0[2][2], B1[2][2];
    const char* cA = (const char*)g.A + (size_t)cur.pm * tstep; const char* cB = (const char*)g.Bt + (size_t)cur.pb * tstep;
    S.a_ready(cur);
    PG8_STAGE(PG8_SB(0, 0), cB, voffB); PG8_STAGE(PG8_SA(0, 0), cA, voffA); PG8_STAGE(PG8_SB(0, 1), cB + hstep, voffB); PG8_STAGE(PG8_SA(0, 1), cA + hstep, voffA);
    if (wr == 1) PG8_BAR;
    PG8_WAIT_V(4); PG8_BAR;
    PG8_STAGE(PG8_SB(1, 0), cB + kstep, voffB); PG8_STAGE(PG8_SA(1, 0), cA + kstep, voffA); PG8_STAGE(PG8_SB(1, 1), cB + hstep + kstep, voffB);
    PG8_WAIT_V(6); PG8_BAR;
    for (;;) {
        const bool has_next = S.next(ui + 1, nxt);
        const char* nA = has_next ? (const char*)g.A + (size_t)nxt.pm * tstep : cA; const char* nB = has_next ? (const char*)g.Bt + (size_t)nxt.pb * tstep : cB;
        for (int t = 0; t < nt; t += 2) {
            const bool last = (t == nt - 2);
            const char* a1 = cA + (size_t)(t + 1) * kstep;
            const char* a2 = last ? nA : cA + (size_t)(t + 2) * kstep; const char* b2 = last ? nB : cB + (size_t)(t + 2) * kstep;
            const char* a3 = a2 + kstep; const char* b3 = b2 + kstep;
            if (last && has_next) S.a_ready(nxt);
            PG8_LDB(B0, 0, 0); PG8_SCHED; PG8_LDA(At, 0, 0); PG8_STAGE(PG8_SA(1, 1), a1 + hstep, voffA);
            PG8_WAIT_L(8); PG8_BAR; PG8_WAIT_L(0); PG8_MMA(0, 0, At, B0); PG8_BAR; PG8_SCHED;
            PG8_LDB(B1, 0, 1); PG8_STAGE(PG8_SB(0, 0), b2, voffB);
            PG8_BAR; PG8_WAIT_L(0); PG8_MMA(0, 1, At, B1); PG8_BAR;
            PG8_LDA(At, 0, 1); PG8_STAGE(PG8_SA(0, 0), a2, voffA);
            PG8_BAR; PG8_WAIT_L(0); PG8_MMA(1, 0, At, B0); PG8_BAR; PG8_SCHED;
            PG8_STAGE(PG8_SB(0, 1), b2 + hstep, voffB);
            PG8_WAIT_V(6); PG8_BAR; PG8_MMA(1, 1, At, B1); PG8_BAR;
            PG8_LDB(B0, 1, 0); PG8_SCHED; PG8_LDA(At, 1, 0); PG8_STAGE(PG8_SA(0, 1), a2 + hstep, voffA);
            PG8_WAIT_L(8); PG8_BAR; PG8_WAIT_L(0); PG8_MMA(0, 0, At, B0); PG8_BAR; PG8_SCHED;
            PG8_LDB(B1, 1, 1); PG8_STAGE(PG8_SB(1, 0), b3, voffB);
            PG8_BAR; PG8_WAIT_L(0); PG8_MMA(0, 1, At, B1); PG8_BAR;
            PG8_LDA(At, 1, 1); PG8_STAGE(PG8_SA(1, 0), a3, voffA);
            PG8_BAR; PG8_WAIT_L(0); PG8_MMA(1, 0, At, B0); PG8_BAR; PG8_SCHED;
            PG8_STAGE(PG8_SB(1, 1), b3 + hstep, voffB);
            PG8_WAIT_V(6); PG8_BAR; PG8_MMA(1, 1, At, B1); PG8_BAR;
        }
        E(acc, cur, wr, wc, fr, fq); S.done(cur);
        if (!has_next) break;
#pragma unroll
        for (int a = 0; a < 2; ++a)
#pragma unroll
            for (int b = 0; b < 2; ++b)
#pragma unroll
                for (int m = 0; m < 4; ++m)
#pragma unroll
                    for (int n = 0; n < 2; ++n) acc[a][b][m][n] = (f32x4){0.f, 0.f, 0.f, 0.f};
        cur = nxt; cA = nA; cB = nB; ++ui;
    }
    PG8_WAIT_V(0);
    if (wr == 0) PG8_BAR;
    PG8_BAR;
#undef PG8_SA
#undef PG8_SB
#undef PG8_STAGE
#undef PG8_LDA
#undef PG8_LDB
#undef PG8_MMA
#undef PG8_WAIT_V
#undef PG8_WAIT_L
#undef PG8_BAR
#undef PG8_SCHED
}
}

constexpr int D = 1024, NB = 8, SEQ = 2048, CTXL = 256;
constexpr int ML = NB * SEQ;
constexpr int MC = NB * CTXL;
constexpr int MA = ML + MC;
constexpr int INW = 3584, FFN_H = 2816, EXP_H = 3584, NEXP = 8;
constexpr int NCH = 18;
constexpr int XG_ROWS = 34816;
constexpr int NWAVES = 8, NTHR = 512;

constexpr size_t MiB = 1u << 20;
constexpr size_t WS_CTL = 0, CTL_ZERO_BYTES = 1 * MiB;
constexpr size_t WS_MOD = 1 * MiB;
constexpr size_t WS_ROPE = 2 * MiB;
constexpr size_t WS_MISC = 3 * MiB;
constexpr size_t WS_W_IN = 4 * MiB, WS_W_OUT = 11 * MiB, WS_W_13 = 13 * MiB, WS_W_2 = 24 * MiB, WS_W_RKV = 30 * MiB, WS_W_L1 = 36 * MiB,
                 WS_W_L2 = 38 * MiB, WS_W_G2 = 40 * MiB, WS_W_O = 41 * MiB, WS_W_M13 = 43 * MiB, WS_W_M2 = 155 * MiB;
constexpr size_t WS_XC = 211 * MiB, WS_H = 219 * MiB, WS_MIX = 255 * MiB, WS_R = 291 * MiB;
constexpr size_t WS_QKV = WS_R, WS_KV = WS_R + 126 * MiB, WS_SPREV = WS_R + 198 * MiB, WS_FFH = WS_R;
constexpr size_t WS_XM = WS_R, WS_DEC = WS_R, WS_AG = WS_R + 144 * MiB, WS_RB = WS_R + 216 * MiB, WS_KB = WS_R + 248 * MiB, WS_VB = WS_R + 284 * MiB,
                 WS_L1 = WS_R + 320 * MiB, WS_LG = WS_R + 329 * MiB, WS_G = WS_R + 337 * MiB, WS_YF = WS_R + 369 * MiB, WS_YB = WS_R + 433 * MiB;
constexpr size_t WS_XG = WS_R, WS_HG = WS_R + 68 * MiB, WS_YS = WS_R + 306 * MiB, WS_ROWS = WS_R + 370 * MiB;
constexpr size_t WS_END = WS_R + 497 * MiB;
static_assert(WS_END <= 896 * MiB, "workspace map");
constexpr int CW_BAR = 4096;
constexpr size_t MISC_TOPE = 0, MISC_TOPW = 65536, MISC_CNTS = 196608, MISC_EXP = 204800;

constexpr int LDS_MAIN = 147456;
constexpr int LDS_MISC_OFF = LDS_MAIN;
constexpr int LDS_BYTES = LDS_MAIN + 256;

typedef unsigned short bf16;
typedef short bf16x8 __attribute__((ext_vector_type(8)));
typedef short s16x4 __attribute__((ext_vector_type(4)));
typedef float f32x4 __attribute__((ext_vector_type(4)));
typedef float f32x2 __attribute__((ext_vector_type(2)));
typedef unsigned u32x4 __attribute__((ext_vector_type(4)));
typedef unsigned u32x2 __attribute__((ext_vector_type(2)));
#define LDS_WAIT() asm volatile("s_waitcnt lgkmcnt(0)" ::: "memory")
#define VM_WAIT() asm volatile("s_waitcnt vmcnt(0)" ::: "memory")
#define WG_SYNC() __syncthreads()
DI unsigned f2bf(float f) { unsigned u = __builtin_bit_cast(unsigned, f); return (u + 0x7fffu + ((u >> 16) & 1u)) >> 16; }
DI unsigned pk2(float lo, float hi) { return f2bf(lo) | (f2bf(hi) << 16); }
DI float bflo(unsigned w) { return __builtin_bit_cast(float, w << 16); }
DI float bfhi(unsigned w) { return __builtin_bit_cast(float, w & 0xffff0000u); }
DI float bf1(bf16 b) { return __builtin_bit_cast(float, (unsigned)b << 16); }
DI float wave_sum(float v) {
#pragma unroll
    for (int o = 1; o < 64; o <<= 1) v += __shfl_xor(v, o);
    return v;
}
DI float wave_max(float v) {
#pragma unroll
    for (int o = 1; o < 64; o <<= 1) v = fmaxf(v, __shfl_xor(v, o));
    return v;
}
DI float dpp_x1(float v) { return __builtin_bit_cast(float, __builtin_amdgcn_update_dpp(0, __builtin_bit_cast(int, v), 0xB1, 0xf, 0xf, true)); }
DI float dpp_x2(float v) { return __builtin_bit_cast(float, __builtin_amdgcn_update_dpp(0, __builtin_bit_cast(int, v), 0x4E, 0xf, 0xf, true)); }
DI float dpp_hm(float v) { return __builtin_bit_cast(float, __builtin_amdgcn_update_dpp(0, __builtin_bit_cast(int, v), 0x141, 0xf, 0xf, true)); }
DI float red4(float v) { v += dpp_x1(v); v += dpp_x2(v); return v; }
DI float red8(float v) { v += dpp_x1(v); v += dpp_x2(v); v += dpp_hm(v); return v; }
DI float sigmoidf_(float x) { return 1.f / (1.f + __expf(-x)); }
DI float siluf_(float x) { return x / (1.f + __expf(-x)); }

DI bf16x8 frag_kc(const LAS bf16* base, int ld, int row0, int k0, int lane) {
    return *(const LAS bf16x8*)(base + (row0 + (lane & 15)) * ld + k0 + 8 * (lane >> 4));
}
DI bf16x8 frag_kr(const LAS bf16* base, int ld, int x0, int k0, int lane) {
    const int g = lane >> 4, q = (lane & 15) >> 2, p = lane & 3;
    const LAS bf16* a = base + (k0 + 8 * g + q) * ld + x0 + 4 * p;
    const s16x4 lo = __builtin_amdgcn_ds_read_tr16_b64_v4i16((LAS s16x4*)a);
    const s16x4 hi = __builtin_amdgcn_ds_read_tr16_b64_v4i16((LAS s16x4*)(a + 4 * ld));
    return __builtin_shufflevector(lo, hi, 0, 1, 2, 3, 4, 5, 6, 7);
}
DI f32x4 mma(f32x4 acc, bf16x8 bfrag, bf16x8 afrag) { return __builtin_amdgcn_mfma_f32_16x16x32_bf16(bfrag, afrag, acc, 0, 0, 0); }

#define XB_TMO      128
#define XB_XCNT(j)  (256  + 64 * (j))
#define XB_XSUB(j)  (1280 + 64 * (j))
#define XB_XGEN(j)  (2304 + 64 * (j))
#define XB_TOP      3328
#define XB_TOPGEN   3392
#define XCD_BAR_WORDS 3456
#define XB_SPIN_CAP (1u << 18)
DI unsigned xb_ld(unsigned* p)              { return __hip_atomic_load(p, __ATOMIC_RELAXED, __HIP_MEMORY_SCOPE_AGENT); }
DI unsigned xb_add(unsigned* p, unsigned v) { return __hip_atomic_fetch_add(p, v, __ATOMIC_RELAXED, __HIP_MEMORY_SCOPE_AGENT); }
DI unsigned xb_xcc_id() { return (unsigned)__builtin_amdgcn_s_getreg((3 << 11) | 20) & 0xFu; }
#define XB_SPIN(cond, bar) do { unsigned _sp = 0; while (cond) { __builtin_amdgcn_s_sleep(1); \
    if ((++_sp & 255u) == 0u) { if (xb_ld(&(bar)[XB_TMO])) break; if (_sp > XB_SPIN_CAP) { atomicAdd(&(bar)[XB_TMO], 1u); break; } } } } while (0)
struct XcdBarrier { unsigned* bar; unsigned x; volatile LAS unsigned* st; };
DI XcdBarrier xcd_barrier_post(unsigned* bar, volatile LAS unsigned* st) {
    XcdBarrier b; b.bar = bar; b.x = xb_xcc_id(); b.st = st;
    if (threadIdx.x == 0) (void)xb_add(&bar[XB_XCNT(b.x)], 1u);
    return b;
}
DI void xcd_barrier_complete(unsigned* bar, unsigned x, unsigned& nloc, unsigned& nx) {
    const unsigned G = gridDim.x * gridDim.y * gridDim.z;
    unsigned sum, cnt, mine, sp = 0u;
    for (;;) {
        sum = 0u; cnt = 0u; mine = 0u;
#pragma unroll
        for (unsigned j = 0; j < 16; ++j) { const unsigned c = xb_ld(&bar[XB_XCNT(j)]); sum += c; cnt += (c > 0u) ? 1u : 0u; mine = (j == x) ? c : mine; }
        if (sum == G) break;
        __builtin_amdgcn_s_sleep(1);
        if ((++sp & 255u) == 0u) { if (xb_ld(&bar[XB_TMO])) break; if (sp > XB_SPIN_CAP) { atomicAdd(&bar[XB_TMO], 1u); break; } }
    }
    nloc = mine > 0u ? mine : 1u; nx = cnt > 0u ? cnt : 1u;
}
DI void xcd_barrier(const XcdBarrier& b) {
    asm volatile("s_waitcnt vmcnt(0)" ::: "memory");
    __syncthreads();
    if (threadIdx.x == 0) {
        unsigned* bar = b.bar;
        __builtin_amdgcn_s_waitcnt(0);
        unsigned nloc = b.st[0], nx = b.st[1];
        if (nloc == 0u) { xcd_barrier_complete(bar, b.x, nloc, nx); b.st[0] = nloc; b.st[1] = nx; }
        const unsigned old = xb_add(&bar[XB_XSUB(b.x)], 1u);
        const unsigned gen = old / nloc;
        if (old + 1u == (gen + 1u) * nloc) {
            __builtin_amdgcn_fence(__ATOMIC_RELEASE, "agent");
            asm volatile("s_waitcnt vmcnt(0)" ::: "memory");
            const unsigned og = xb_add(&bar[XB_TOP], 1u);
            const unsigned tg = og / nx;
            if (og + 1u == (tg + 1u) * nx) xb_add(&bar[XB_TOPGEN], 1u);
            else XB_SPIN(xb_ld(&bar[XB_TOPGEN]) == tg, bar);
            __builtin_amdgcn_fence(__ATOMIC_ACQUIRE, "agent");
            xb_add(&bar[XB_XGEN(b.x)], 1u);
            asm volatile("s_waitcnt vmcnt(0)" ::: "memory");
        } else {
            XB_SPIN(xb_ld(&bar[XB_XGEN(b.x)]) == gen, bar);
            __builtin_amdgcn_fence(__ATOMIC_ACQUIRE, "agent");
            asm volatile("s_waitcnt vmcnt(0)" ::: "memory");
        }
    }
    __syncthreads();
}

struct Fr {
    LAS unsigned char* lds;
    unsigned char* ws;
    const float* const* in;
    float* out;
    int tid, lane, wave, bx, G, gw, NGW;
};

using pg8::Unit;
template <int ACT  > struct EpiStore {
    static constexpr bool PERM = true;
    bf16* O; int ldc; int nvalid;
    DI void operator()(const f32x4 (&acc)[2][2][4][2], const Unit& u, int wr, int wc, int fr, int fq) const {
        const int row0 = u.pm * 256 + wr * 64 + fr, col0 = u.pn * 256 + wc * 32 + 8 * fq;
#pragma unroll
        for (int ai = 0; ai < 2; ++ai)
#pragma unroll
            for (int m = 0; m < 4; ++m) { bf16* rowp = O + (size_t)(row0 + ai * 128 + m * 16) * ldc + col0;
#pragma unroll
                for (int bj = 0; bj < 2; ++bj) { if (u.pn * 256 + bj * 128 >= nvalid) continue;
                    f32x4 v0 = acc[ai][bj][m][0], v1 = acc[ai][bj][m][1];
                    if (ACT == 1) {
#pragma unroll
                        for (int j = 0; j < 4; ++j) { v0[j] = tanhf(v0[j]); v1[j] = tanhf(v1[j]); } }
                    if (ACT == 2) {
#pragma unroll
                        for (int j = 0; j < 4; ++j) { v0[j] = sigmoidf_(v0[j]); v1[j] = sigmoidf_(v1[j]); } }
                    u32x4 w; w.x = pg8::cvt_pk_bf16(v0[0], v0[1]); w.y = pg8::cvt_pk_bf16(v0[2], v0[3]); w.z = pg8::cvt_pk_bf16(v1[0], v1[1]); w.w = pg8::cvt_pk_bf16(v1[2], v1[3]);
                    *(u32x4*)(rowp + bj * 128) = w; } }
    }
};
struct EpiResid {
    static constexpr bool PERM = false;
    const float* baseL; float* outL; const float* baseC; float* outC; const float* modg;
    DI void operator()(const f32x4 (&acc)[2][2][4][2], const Unit& u, int wr, int wc, int fr, int fq) const {
        const bool lat = u.pm < 64; const int r = lat ? (u.pm >> 3) : 8;
        const float* base = lat ? baseL : baseC; float* out = lat ? outL : outC;
        const int row0 = (lat ? u.pm : u.pm - 64) * 256 + wr * 64 + fr, col0 = u.pn * 256 + wc * 32 + 4 * fq;
        const float* mg = modg + (size_t)r * 6144 + col0;
        f32x4 mv[2][2];
#pragma unroll
        for (int bj = 0; bj < 2; ++bj)
#pragma unroll
            for (int n = 0; n < 2; ++n) mv[bj][n] = *(const f32x4*)(mg + bj * 128 + n * 16);
#pragma unroll
        for (int ai = 0; ai < 2; ++ai)
#pragma unroll
            for (int m = 0; m < 4; ++m) { const size_t off = (size_t)(row0 + ai * 128 + m * 16) * D + col0;
#pragma unroll
                for (int bj = 0; bj < 2; ++bj)
#pragma unroll
                    for (int n = 0; n < 2; ++n) { const f32x4 bs = *(const f32x4*)(base + off + bj * 128 + n * 16);
                        *(f32x4*)(out + off + bj * 128 + n * 16) = bs + mv[bj][n] * acc[ai][bj][m][n]; } }
    }
};
struct EpiSwiglu {
    static constexpr bool PERM = true;
    bf16* Hd; int ldh;
    DI void operator()(const f32x4 (&acc)[2][2][4][2], const Unit& u, int wr, int wc, int fr, int fq) const {
        const int row0 = u.pm * 256 + wr * 64 + fr, col0 = u.pn * 128 + wc * 32 + 8 * fq;
#pragma unroll
        for (int ai = 0; ai < 2; ++ai)
#pragma unroll
            for (int m = 0; m < 4; ++m) { bf16* rowp = Hd + (size_t)(row0 + ai * 128 + m * 16) * ldh + col0;
                f32x4 v0, v1;
#pragma unroll
                for (int j = 0; j < 4; ++j) { v0[j] = siluf_(acc[ai][0][m][0][j]) * acc[ai][1][m][0][j]; v1[j] = siluf_(acc[ai][0][m][1][j]) * acc[ai][1][m][1][j]; }
                u32x4 w; w.x = pg8::cvt_pk_bf16(v0[0], v0[1]); w.y = pg8::cvt_pk_bf16(v0[2], v0[3]); w.z = pg8::cvt_pk_bf16(v1[0], v1[1]); w.w = pg8::cvt_pk_bf16(v1[2], v1[3]);
                *(u32x4*)rowp = w; }
    }
};
struct EpiLora2 {
    static constexpr bool PERM = true;
    float* DEC; bf16* AG; const float* w0; const float* a0;
    DI void operator()(const f32x4 (&acc)[2][2][4][2], const Unit& u, int wr, int wc, int fr, int fq) const {
        const int q = u.pn >> 2, z = q & 1; const int row0 = u.pm * 256 + wr * 64 + fr, col0 = (u.pn & 3) * 256 + wc * 32 + 8 * fq;
        const float* bias = (q < 2 ? w0 : a0) + z * 1024 + col0;
        f32x4 bv[2][2];
#pragma unroll
        for (int bj = 0; bj < 2; ++bj)
#pragma unroll
            for (int n = 0; n < 2; ++n) bv[bj][n] = *(const f32x4*)(bias + bj * 128 + 4 * n);
#pragma unroll
        for (int ai = 0; ai < 2; ++ai)
#pragma unroll
            for (int m = 0; m < 4; ++m) { const size_t off = ((size_t)z * MA + (row0 + ai * 128 + m * 16)) * D + col0;
#pragma unroll
                for (int bj = 0; bj < 2; ++bj) { f32x4 v0 = acc[ai][bj][m][0] + bv[bj][0], v1 = acc[ai][bj][m][1] + bv[bj][1];
                    if (q < 2) {
#pragma unroll
                        for (int j = 0; j < 4; ++j) {
                            v0[j] = __expf(-0.6065306597126334f * sigmoidf_(v0[j])); v1[j] = __expf(-0.6065306597126334f * sigmoidf_(v1[j])); }
                        *(f32x4*)(DEC + off + bj * 128) = v0; *(f32x4*)(DEC + off + bj * 128 + 4) = v1;
                        __builtin_amdgcn_sched_barrier(0);
                    } else {
#pragma unroll
                        for (int j = 0; j < 4; ++j) { v0[j] = sigmoidf_(v0[j]); v1[j] = sigmoidf_(v1[j]); }
                        u32x4 w; w.x = pg8::cvt_pk_bf16(v0[0], v0[1]); w.y = pg8::cvt_pk_bf16(v0[2], v0[3]); w.z = pg8::cvt_pk_bf16(v1[0], v1[1]); w.w = pg8::cvt_pk_bf16(v1[2], v1[3]);
                        *(u32x4*)(AG + off + bj * 128) = w; __builtin_amdgcn_sched_barrier(0); } } }
    }
};
struct EpiMoeOut {
    static constexpr bool PERM = true;
    bf16* YS; const int* RowTok; const float* RowW;
    DI void operator()(const f32x4 (&acc)[2][2][4][2], const Unit& u, int wr, int wc, int fr, int fq) const {
        const int row0 = u.pm * 256 + wr * 64 + fr, col0 = u.pn * 256 + wc * 32 + 8 * fq;
#pragma unroll
        for (int ai = 0; ai < 2; ++ai)
#pragma unroll
            for (int m = 0; m < 4; ++m) { const int row = row0 + ai * 128 + m * 16; const int t2 = RowTok[row]; if (t2 < 0) continue; const float w = RowW[row];
                bf16* rowp = YS + (size_t)t2 * D + col0;
#pragma unroll
                for (int bj = 0; bj < 2; ++bj) { const f32x4 v0 = acc[ai][bj][m][0] * w, v1 = acc[ai][bj][m][1] * w;
                    u32x4 o; o.x = pg8::cvt_pk_bf16(v0[0], v0[1]); o.y = pg8::cvt_pk_bf16(v0[2], v0[3]); o.z = pg8::cvt_pk_bf16(v1[0], v1[1]); o.w = pg8::cvt_pk_bf16(v1[2], v1[3]);
                    *(u32x4*)(rowp + bj * 128) = o; } }
    }
};

DI void tr_item(const float* src, int ldsrc, int Kreal, int k0, int n0, bf16* dst, int lddst, int drow0, int dcol0, LAS float* scr, int lane) {
#pragma unroll 8
    for (int i = 0; i < 32; ++i) { const int kk = 2 * i + (lane >> 5), k = k0 + kk; float v = 0.f; if (k < Kreal) v = src[(size_t)k * ldsrc + n0 + (lane & 31)]; scr[kk * 33 + (lane & 31)] = v; }
    LDS_WAIT();
    const int c = lane & 7;
#pragma unroll
    for (int j = 0; j < 4; ++j) { const int n = (lane >> 3) + 8 * j; const LAS float* s = scr + (8 * c) * 33 + n;
        u32x4 o; o.x = pk2(s[0 * 33], s[1 * 33]); o.y = pk2(s[2 * 33], s[3 * 33]); o.z = pk2(s[4 * 33], s[5 * 33]); o.w = pk2(s[6 * 33], s[7 * 33]);
        *(u32x4*)(dst + (size_t)(drow0 + n) * lddst + dcol0 + k0 + 8 * c) = o; }
    LDS_WAIT();
}
DI void tr_plain(const float* src, int K, int N, bf16* dst, int r, LAS float* scr, int lane) {
    const int nblk = N / 32, kb = r / nblk, nb = r % nblk; tr_item(src, N, K, 64 * kb, 32 * nb, dst, K, 32 * nb, 0, scr, lane);
}
DI void tr_gateup(const float* src, int K, int Hh, bf16* dst, int r, LAS float* scr, int lane) {
    const int nblk = 2 * Hh / 32, kb = r / nblk, nb = r % nblk, n0 = 32 * nb, half = n0 / Hh, j0 = n0 % Hh;
    tr_item(src, 2 * Hh, K, 64 * kb, n0, dst, K, (j0 / 128) * 256 + half * 128 + (j0 % 128), 0, scr, lane);
}
DI void p0_prologue(Fr& F) {
    LAS float* scr = (LAS float*)(F.lds + F.wave * 16384);
    const float* const* in = F.in;
    bf16* W_IN = (bf16*)(F.ws + WS_W_IN); bf16* W_OUT = (bf16*)(F.ws + WS_W_OUT); bf16* W_13 = (bf16*)(F.ws + WS_W_13); bf16* W_2 = (bf16*)(F.ws + WS_W_2);
    bf16* W_RKV = (bf16*)(F.ws + WS_W_RKV); bf16* W_L1 = (bf16*)(F.ws + WS_W_L1); bf16* W_L2 = (bf16*)(F.ws + WS_W_L2); bf16* W_G2 = (bf16*)(F.ws + WS_W_G2);
    bf16* W_O = (bf16*)(F.ws + WS_W_O); bf16* W_M13 = (bf16*)(F.ws + WS_W_M13); bf16* W_M2 = (bf16*)(F.ws + WS_W_M2);
    constexpr int I_IN = 16 * 112, I_OUT = 16 * 32, I_13 = 16 * 176, I_2 = 44 * 32, I_RKV = 3 * 512, I_W1 = 2 * 32, I_A1 = 2 * 32, I_G1 = 16 * 5, I_L2 = 4 * 32, I_G2 = 4 * 32,
                  I_O = 512, I_M13 = 8 * 16 * 224, I_M2 = 8 * 56 * 32;
    constexpr int NITEMS = I_IN + I_OUT + I_13 + I_2 + I_RKV + I_W1 + I_A1 + I_G1 + I_L2 + I_G2 + I_O + I_M13 + I_M2;
    for (int it = F.gw; it < NITEMS; it += F.NGW) {
        int r = it;
        if (r < I_M13) { const int e = r / (16 * 224); tr_gateup(in[35] + (size_t)e * 1024 * 7168, 1024, EXP_H, W_M13 + (size_t)e * 7168 * 1024, r % (16 * 224), scr, F.lane); continue; } r -= I_M13;
        if (r < I_M2) { const int e = r / (56 * 32); tr_plain(in[36] + (size_t)e * EXP_H * 1024, EXP_H, 1024, W_M2 + (size_t)e * 1024 * EXP_H, r % (56 * 32), scr, F.lane); continue; } r -= I_M2;
        if (r < I_IN) { tr_plain(in[8], 1024, INW, W_IN, r, scr, F.lane); continue; } r -= I_IN;
        if (r < I_OUT) { tr_plain(in[15], 1024, 1024, W_OUT, r, scr, F.lane); continue; } r -= I_OUT;
        if (r < I_13) { tr_gateup(in[16], 1024, FFN_H, W_13, r, scr, F.lane); continue; } r -= I_13;
        if (r < I_2) { tr_plain(in[17], FFN_H, 1024, W_2, r, scr, F.lane); continue; } r -= I_2;
        if (r < I_RKV) { const int s = r / 512; tr_plain(in[19] + (size_t)s * 1024 * 1024, 1024, 1024, W_RKV + (size_t)s * 1024 * 1024, r % 512, scr, F.lane); continue; } r -= I_RKV;
        if (r < I_W1) { const int z = r / 32, rr = r % 32; tr_item(in[21] + (size_t)z * 1024 * 64, 64, 1024, 64 * (rr / 2), 32 * (rr % 2), W_L1, 1024, z * 64 + 32 * (rr % 2), 0, scr, F.lane); continue; } r -= I_W1;
        if (r < I_A1) { const int z = r / 32, rr = r % 32; tr_item(in[24] + (size_t)z * 1024 * 64, 64, 1024, 64 * (rr / 2), 32 * (rr % 2), W_L1 + 256 * 1024, 1024, z * 64 + 32 * (rr % 2), 0, scr, F.lane); continue; } r -= I_A1;
        if (r < I_G1) { tr_item(in[26], 160, 1024, 64 * (r / 5), 32 * (r % 5), W_L1 + 2 * 256 * 1024, 1024, 32 * (r % 5), 0, scr, F.lane); continue; } r -= I_G1;
        if (r < I_L2) { const int q = r / 32, nb = r % 32; const float* src = (q < 2 ? in[22] : in[25]) + (size_t)(q & 1) * 64 * 1024;
            for (int i = F.lane; i < 32 * 24; i += 64) { const int row = i / 24, ch = i % 24; const int col = 8 * ch + (8 * ch >= q * 64 ? 64 : 0);
                *(u32x4*)(W_L2 + (size_t)(q * 1024 + 32 * nb + row) * 256 + col) = (u32x4){0u, 0u, 0u, 0u}; }
            tr_item(src, 1024, 64, 0, 32 * nb, W_L2, 256, q * 1024 + 32 * nb, q * 64, scr, F.lane); continue; } r -= I_L2;
        if (r < I_G2) { tr_item(in[27], 1024, 160, 64 * (r / 32), 32 * (r % 32), W_G2, 256, 32 * (r % 32), 0, scr, F.lane); continue; } r -= I_G2;
        tr_plain(in[33], 1024, 1024, W_O, r, scr, F.lane);
    }
    { const int gt = F.bx * NTHR + F.tid, NT = F.G * NTHR;
      for (int i = gt; i < (128 + 128 + 96) * 128; i += NT) { int row = i / 128; const int ch = i % 128; int mat = 0;
          if (row >= 256) { mat = 2; row = row - 256 + 160; } else if (row >= 128) { mat = 1; } else { row += 128; }
          *(u32x4*)(W_L1 + ((size_t)mat * 256 + row) * 1024 + 8 * ch) = (u32x4){0u, 0u, 0u, 0u}; }
      f32x2* rope = (f32x2*)(F.ws + WS_ROPE);
      for (int i = gt; i < 2048; i += NT) { const int pos = i >> 5, j = i & 31; const float fr = powf(10000.f, -(float)j / 32.f), ang = (float)pos * fr; rope[i] = (f32x2){cosf(ang), sinf(ang)}; }
    }
    WG_SYNC();
    for (int u = F.bx; u < 192; u += F.G) {
        const int li = u / 96, n0 = (u % 96) * 64;
        LAS float* sm = (LAS float*)F.lds;
        for (int idx = F.tid; idx < 9 * 1024; idx += NTHR) { const int r = idx >> 10, k = idx & 1023; const float cv = (r < 8) ? in[1][r * 1024 + k] : in[3][k]; sm[idx] = cv / (1.f + expf(-cv)); }
        WG_SYNC();
        const int kq = F.tid >> 6, nn = F.tid & 63;
        float acc[9];
#pragma unroll
        for (int r = 0; r < 9; ++r) acc[r] = 0.f;
        const float* w = in[4] + (size_t)li * 1024 * 6144 + n0 + nn;
#pragma unroll 4
        for (int k = kq * 128; k < kq * 128 + 128; ++k) { const float wv = w[(size_t)k * 6144];
#pragma unroll
            for (int r = 0; r < 9; ++r) acc[r] += sm[r * 1024 + k] * wv; }
        LAS float* red = sm + 9 * 1024;
#pragma unroll
        for (int r = 0; r < 9; ++r) red[(kq * 9 + r) * 64 + nn] = acc[r];
        WG_SYNC();
        float* MOD = (float*)(F.ws + WS_MOD);
        for (int idx = F.tid; idx < 9 * 64; idx += NTHR) { const int r = idx / 64, n2 = idx % 64; float s = 0.f;
#pragma unroll
            for (int q = 0; q < 8; ++q) s += red[(q * 9 + r) * 64 + n2];
            MOD[((size_t)li * 9 + r) * 6144 + n0 + n2] = s + in[5][li * 6144 + n0 + n2]; }
        WG_SYNC();
    }
}

DI void mod_rows(Fr& F, const float* xl, const float* xc, int nrows, const float* normw, const float* modl, int off_shift, int off_scale, bf16* H) {
    for (int row = F.gw; row < nrows; row += F.NGW) {
        const float* src = row < ML ? xl + (size_t)row * D : xc + (size_t)(row - ML) * D;
        const float* mrow = modl + (size_t)(row < ML ? row / SEQ : 8) * 6144;
        f32x4 v[4]; float ss = 0.f;
#pragma unroll
        for (int j = 0; j < 4; ++j) { v[j] = ((const f32x4*)src)[F.lane + 64 * j]; ss += (v[j].x * v[j].x + v[j].y * v[j].y) + (v[j].z * v[j].z + v[j].w * v[j].w); }
        const float rstd = rsqrtf(wave_sum(ss) * (1.f / D) + 1e-6f);
        u32x2* o = (u32x2*)(H + (size_t)row * D);
#pragma unroll
        for (int j = 0; j < 4; ++j) { const int c4 = F.lane + 64 * j;
            const f32x4 w = ((const f32x4*)normw)[c4], sc = ((const f32x4*)(mrow + off_scale))[c4], sh = ((const f32x4*)(mrow + off_shift))[c4];
            const f32x4 y = v[j] * rstd * w * (sc + 1.f) + sh;
            u32x2 p; p.x = pk2(y.x, y.y); p.y = pk2(y.z, y.w); o[c4] = p; }
    }
}

DI void load_rope_pair(const bf16* rowp, int hh, int jj, bool lat, int rpos, int cpos, const f32x2* rope, float scl, float (&x1)[8], float (&x2)[8]) {
    const u32x4 a = *(const u32x4*)(rowp + hh * 64 + jj), b = *(const u32x4*)(rowp + hh * 64 + jj + 32);
    const unsigned aw[4] = {a.x, a.y, a.z, a.w}, bw[4] = {b.x, b.y, b.z, b.w};
#pragma unroll
    for (int i = 0; i < 4; ++i) { x1[2 * i] = bflo(aw[i]); x1[2 * i + 1] = bfhi(aw[i]); x2[2 * i] = bflo(bw[i]); x2[2 * i + 1] = bfhi(bw[i]); }
    if (lat) { const int pos = hh ? cpos : rpos;
#pragma unroll
        for (int i = 0; i < 8; ++i) { const f32x2 cs = rope[pos * 32 + jj + i]; const float y1 = x1[i] * cs.x - x2[i] * cs.y, y2 = x1[i] * cs.y + x2[i] * cs.x; x1[i] = y1; x2[i] = y2; } }
#pragma unroll
    for (int i = 0; i < 8; ++i) { x1[i] *= scl; x2[i] *= scl; }
}
DI u32x4 pack8(const float (&x)[8], float s) { u32x4 o; o.x = pk2(x[0] * s, x[1] * s); o.y = pk2(x[2] * s, x[3] * s); o.z = pk2(x[4] * s, x[5] * s); o.w = pk2(x[6] * s, x[7] * s); return o; }
constexpr int RLD = 136;
constexpr int RTILE = 128 * RLD * 2;
DI int ret_row0(int b, int id) { return id < 2 ? ML + b * CTXL + id * 128 : b * SEQ + (id - 2) * 128; }

DI void ret_kv_phase(Fr& F) {
    const bf16* QKV = (const bf16*)(F.ws + WS_QKV); float* KV = (float*)(F.ws + WS_KV); const f32x2* rope = (const f32x2*)(F.ws + WS_ROPE);
    LAS bf16* Vs = (LAS bf16*)F.lds; LAS bf16* Kf = (LAS bf16*)(F.lds + RTILE); LAS bf16* Kb = (LAS bf16*)(F.lds + 2 * RTILE);
    const int wr2 = F.wave >> 1, wc2 = F.wave & 1, fr = F.lane & 15, fq = F.lane >> 4;
    for (int u = F.bx; u < NB * 4 * NCH; u += F.G) {
        const int b = u / (4 * NCH), h = (u / NCH) % 4, id = u % NCH; const int grow0 = ret_row0(b, id); const bool lat = id >= 2;
        const float lgf = -expf(F.in[9][h]), lgb = -expf(F.in[10][h]);
        for (int it = F.tid; it < 128 * 16; it += NTHR) { const int c = it >> 4, ch = it & 15;
            *(LAS u32x4*)(Vs + c * RLD + 8 * ch) = *(const u32x4*)(QKV + (size_t)(grow0 + c) * INW + 1024 + h * 128 + 8 * ch); }
        for (int it = F.tid; it < 128 * 8; it += NTHR) { const int c = it >> 3, pi = it & 7, hh = pi >> 2, jj = (pi & 3) * 8; const int t = (id - 2) * 128 + c;
            float x1[8], x2[8]; load_rope_pair(QKV + (size_t)(grow0 + c) * INW + 512 + h * 128, hh, jj, lat, t >> 6, t & 63, rope, 0.08838834764831845f, x1, x2);
            const float wf = expf(lgf * (float)(127 - c)), wb = expf(lgb * (float)c);
            *(LAS u32x4*)(Kf + c * RLD + hh * 64 + jj) = pack8(x1, wf); *(LAS u32x4*)(Kf + c * RLD + hh * 64 + jj + 32) = pack8(x2, wf);
            *(LAS u32x4*)(Kb + c * RLD + hh * 64 + jj) = pack8(x1, wb); *(LAS u32x4*)(Kb + c * RLD + hh * 64 + jj + 32) = pack8(x2, wb); }
        WG_SYNC();
#pragma unroll
        for (int dir = 0; dir < 2; ++dir) {
            const LAS bf16* Kd = dir ? Kb : Kf;
            f32x4 acc[2][4];
#pragma unroll
            for (int i = 0; i < 2; ++i)
#pragma unroll
                for (int j = 0; j < 4; ++j) acc[i][j] = (f32x4){0.f, 0.f, 0.f, 0.f};
#pragma unroll 1
            for (int k0 = 0; k0 < 128; k0 += 32) { bf16x8 af[2], bfg[4];
#pragma unroll
                for (int i = 0; i < 2; ++i) af[i] = frag_kr(Vs, RLD, 32 * wr2 + 16 * i, k0, F.lane);
#pragma unroll
                for (int j = 0; j < 4; ++j) bfg[j] = frag_kr(Kd, RLD, 64 * wc2 + 16 * j, k0, F.lane);
#pragma unroll
                for (int i = 0; i < 2; ++i)
#pragma unroll
                    for (int j = 0; j < 4; ++j) acc[i][j] = mma(acc[i][j], bfg[j], af[i]); }
            float* o = KV + ((size_t)((b * 4 + h) * 2 + dir) * NCH + id) * 16384;
#pragma unroll
            for (int i = 0; i < 2; ++i)
#pragma unroll
                for (int j = 0; j < 4; ++j) *(f32x4*)(o + (32 * wr2 + 16 * i + fr) * 128 + 64 * wc2 + 16 * j + 4 * fq) = acc[i][j];
        }
        WG_SYNC();
    }
}
DI void ret_prefix_phase(Fr& F) {
    const float* KV = (const float*)(F.ws + WS_KV); bf16* SP = (bf16*)(F.ws + WS_SPREV);
    const int gt = F.bx * NTHR + F.tid, NT = F.G * NTHR;
    for (int i = gt; i < 64 * 4096; i += NT) { const int bhd = i >> 12, e4 = i & 4095, dir = bhd & 1, h = (bhd >> 1) & 3;
        const float lg = -expf(dir ? F.in[10][h] : F.in[9][h]), cd = expf(lg * 128.f);
        f32x4 s = (f32x4){0.f, 0.f, 0.f, 0.f};
        for (int st = 0; st < NCH; ++st) { const int id = dir ? (st == 0 ? 1 : (st == 1 ? 0 : 19 - st)) : st;
            const size_t off = ((size_t)bhd * NCH + id) * 16384 + 4 * e4;
            u32x2 p; p.x = pk2(s.x, s.y); p.y = pk2(s.z, s.w); *(u32x2*)(SP + off) = p;
            s = s * cd + *(const f32x4*)(KV + off); }
    }
}
DI void ret_out_phase(Fr& F) {
    const bf16* QKV = (const bf16*)(F.ws + WS_QKV); const bf16* SP = (const bf16*)(F.ws + WS_SPREV); bf16* MIX = (bf16*)(F.ws + WS_MIX); const f32x2* rope = (const f32x2*)(F.ws + WS_ROPE);
    LAS bf16* Qs = (LAS bf16*)F.lds; LAS bf16* KP = (LAS bf16*)(F.lds + RTILE); LAS bf16* Vs = (LAS bf16*)(F.lds + 2 * RTILE); LAS bf16* Sf = (LAS bf16*)(F.lds + 3 * RTILE);
    LAS float* red = (LAS float*)(F.lds + 4 * RTILE);
    const int wr2 = F.wave >> 1, wc2 = F.wave & 1, fr = F.lane & 15, fq = F.lane >> 4;
    for (int u = F.bx; u < NB * 4 * NCH; u += F.G) {
        const int b = u / (4 * NCH), h = (u / NCH) % 4, id = u % NCH; const int grow0 = ret_row0(b, id); const bool lat = id >= 2;
        const float lgf = -expf(F.in[9][h]), lgb = -expf(F.in[10][h]);
        const bf16* spf = SP + ((size_t)((b * 4 + h) * 2 + 0) * NCH + id) * 16384; const bf16* spb = SP + ((size_t)((b * 4 + h) * 2 + 1) * NCH + id) * 16384;
        for (int it = F.tid; it < 128 * 16; it += NTHR) { const int c = it >> 4, ch = it & 15;
            *(LAS u32x4*)(Vs + c * RLD + 8 * ch) = *(const u32x4*)(QKV + (size_t)(grow0 + c) * INW + 1024 + h * 128 + 8 * ch);
            *(LAS u32x4*)(Sf + c * RLD + 8 * ch) = *(const u32x4*)(spf + c * 128 + 8 * ch); }
        for (int it = F.tid; it < 128 * 8; it += NTHR) { const int c = it >> 3, pi = it & 7, hh = pi >> 2, jj = (pi & 3) * 8; const int t = (id - 2) * 128 + c;
            float x1[8], x2[8];
            load_rope_pair(QKV + (size_t)(grow0 + c) * INW + h * 128, hh, jj, lat, t >> 6, t & 63, rope, 1.f, x1, x2);
            *(LAS u32x4*)(Qs + c * RLD + hh * 64 + jj) = pack8(x1, 1.f); *(LAS u32x4*)(Qs + c * RLD + hh * 64 + jj + 32) = pack8(x2, 1.f);
            load_rope_pair(QKV + (size_t)(grow0 + c) * INW + 512 + h * 128, hh, jj, lat, t >> 6, t & 63, rope, 0.08838834764831845f, x1, x2);
            *(LAS u32x4*)(KP + c * RLD + hh * 64 + jj) = pack8(x1, 1.f); *(LAS u32x4*)(KP + c * RLD + hh * 64 + jj + 32) = pack8(x2, 1.f); }
        WG_SYNC();
        f32x4 sacc[2][4], facc[2][4];
#pragma unroll
        for (int i = 0; i < 2; ++i)
#pragma unroll
            for (int j = 0; j < 4; ++j) { sacc[i][j] = (f32x4){0.f, 0.f, 0.f, 0.f}; facc[i][j] = (f32x4){0.f, 0.f, 0.f, 0.f}; }
#pragma unroll 1
        for (int k0 = 0; k0 < 128; k0 += 32) { bf16x8 af[2], bk[4], bs[4];
#pragma unroll
            for (int i = 0; i < 2; ++i) af[i] = frag_kc(Qs, RLD, 32 * wr2 + 16 * i, k0, F.lane);
#pragma unroll
            for (int j = 0; j < 4; ++j) { bk[j] = frag_kc(KP, RLD, 64 * wc2 + 16 * j, k0, F.lane); bs[j] = frag_kc(Sf, RLD, 64 * wc2 + 16 * j, k0, F.lane); }
#pragma unroll
            for (int i = 0; i < 2; ++i)
#pragma unroll
                for (int j = 0; j < 4; ++j) { sacc[i][j] = mma(sacc[i][j], bk[j], af[i]); facc[i][j] = mma(facc[i][j], bs[j], af[i]); } }
        WG_SYNC();
        { const float lf2 = lgf * 1.4426950408889634f, lb2 = lgb * 1.4426950408889634f;
#pragma unroll
          for (int i = 0; i < 2; ++i)
#pragma unroll
            for (int j = 0; j < 4; ++j) { const int c = 32 * wr2 + 16 * i + fr, s0 = 64 * wc2 + 16 * j + 4 * fq; float pv[4];
#pragma unroll
                for (int r = 0; r < 4; ++r) { const int df = c - (s0 + r); const float wgt = df > 0 ? exp2f(lf2 * (float)df) : (df < 0 ? exp2f(lb2 * (float)(-df)) : 2.f); pv[r] = sacc[i][j][r] * wgt; }
                u32x2 p; p.x = pk2(pv[0], pv[1]); p.y = pk2(pv[2], pv[3]); *(LAS u32x2*)(KP + c * RLD + s0) = p; }
          for (int it = F.tid; it < 128 * 16; it += NTHR) { const int c = it >> 4, ch = it & 15; *(LAS u32x4*)(Sf + c * RLD + 8 * ch) = *(const u32x4*)(spb + c * 128 + 8 * ch); }
        }
        WG_SYNC();
        f32x4 oacc[2][4], bacc[2][4];
#pragma unroll
        for (int i = 0; i < 2; ++i) { const float qdf = expf(lgf * (float)(32 * wr2 + 16 * i + fr + 1));
#pragma unroll
            for (int j = 0; j < 4; ++j) { oacc[i][j] = facc[i][j] * qdf; bacc[i][j] = (f32x4){0.f, 0.f, 0.f, 0.f}; } }
#pragma unroll 1
        for (int k0 = 0; k0 < 128; k0 += 32) { bf16x8 ap[2], aq[2], bv[4], bs[4];
#pragma unroll
            for (int i = 0; i < 2; ++i) { ap[i] = frag_kc(KP, RLD, 32 * wr2 + 16 * i, k0, F.lane); aq[i] = frag_kc(Qs, RLD, 32 * wr2 + 16 * i, k0, F.lane); }
#pragma unroll
            for (int j = 0; j < 4; ++j) { bv[j] = frag_kr(Vs, RLD, 64 * wc2 + 16 * j, k0, F.lane); bs[j] = frag_kc(Sf, RLD, 64 * wc2 + 16 * j, k0, F.lane); }
#pragma unroll
            for (int i = 0; i < 2; ++i)
#pragma unroll
                for (int j = 0; j < 4; ++j) { oacc[i][j] = mma(oacc[i][j], bv[j], ap[i]); bacc[i][j] = mma(bacc[i][j], bs[j], aq[i]); } }
        float rs[2], rq[2];
#pragma unroll
        for (int i = 0; i < 2; ++i) { const int c = 32 * wr2 + 16 * i + fr; const float qdb = expf(lgb * (float)(128 - c)); float s = 0.f, q = 0.f;
#pragma unroll
            for (int j = 0; j < 4; ++j) { oacc[i][j] = oacc[i][j] + bacc[i][j] * qdb;
#pragma unroll
                for (int r = 0; r < 4; ++r) { s += oacc[i][j][r]; q += oacc[i][j][r] * oacc[i][j][r]; } }
            s += __shfl_xor(s, 16); s += __shfl_xor(s, 32); q += __shfl_xor(q, 16); q += __shfl_xor(q, 32);
            if (fq == 0) { red[(c * 2 + wc2) * 2 + 0] = s; red[(c * 2 + wc2) * 2 + 1] = q; }
            rs[i] = s; rq[i] = q; }
        WG_SYNC();
#pragma unroll
        for (int i = 0; i < 2; ++i) { const int c = 32 * wr2 + 16 * i + fr;
            const float s = red[(c * 2 + 0) * 2 + 0] + red[(c * 2 + 1) * 2 + 0], q = red[(c * 2 + 0) * 2 + 1] + red[(c * 2 + 1) * 2 + 1];
            const float mean = s * (1.f / 128.f), var = fmaxf(q * (1.f / 128.f) - mean * mean, 0.f), rstd = rsqrtf(var + 1e-5f);
            const size_t grow = (size_t)(grow0 + c);
#pragma unroll
            for (int j = 0; j < 4; ++j) { const int e0 = 64 * wc2 + 16 * j + 4 * fq;
                const f32x4 gw = *(const f32x4*)(F.in[11] + h * 128 + e0); const u32x2 gg = *(const u32x2*)(QKV + grow * INW + 1536 + h * 128 + e0);
                const float g0 = bflo(gg.x), g1 = bfhi(gg.x), g2 = bflo(gg.y), g3 = bfhi(gg.y);
                const f32x4 y = (oacc[i][j] - mean) * rstd * gw;
                u32x2 p; p.x = pk2(y.x * siluf_(g0), y.y * siluf_(g1)); p.y = pk2(y.z * siluf_(g2), y.w * siluf_(g3));
                *(u32x2*)(MIX + grow * D + h * 128 + e0) = p; } }
        (void)rs; (void)rq;
        WG_SYNC();
    }
}

constexpr int NLD = 72;
DI void na_phase(Fr& F) {
    const bf16* QKV = (const bf16*)(F.ws + WS_QKV); bf16* MIX = (bf16*)(F.ws + WS_MIX);
    LAS bf16* Qs = (LAS bf16*)F.lds;
    LAS bf16* Ks = (LAS bf16*)(F.lds + 9216);
    LAS bf16* Vs = (LAS bf16*)(F.lds + 9216 + 36864);
    LAS bf16* Pw = (LAS bf16*)(F.lds + 9216 + 2 * 36864) + F.wave * (16 * RLD);
    LAS float* comb = (LAS float*)(F.lds + 9216 + 2 * 36864);
    LAS float* rpbs = (LAS float*)(F.lds + 9216 + 2 * 36864 + 34816);
    const int mq = F.wave >> 1, kh = F.wave & 1, fr = F.lane & 15, fq = F.lane >> 4;
    float bound;
    { float mqw = fabsf(F.in[12][F.lane]), mkw = fabsf(F.in[13][F.lane]), mb = 0.f;
      for (int i = F.lane; i < 8 * 15 * 31; i += 64) mb = fmaxf(mb, fabsf(F.in[14][i]));
      bound = 8.f * wave_max(mqw) * wave_max(mkw) + wave_max(mb); }
    for (int u = F.bx; u < 2048 + 256; u += F.G) {
        int b, head, r = 0, r0 = 0, qrow0, blk0;
        if (u < 2048) { b = u >> 8; head = (u >> 5) & 7; r = u & 31; r0 = min(max(r - 4, 0), 24); qrow0 = b * SEQ + r * 64; blk0 = 0; }
        else { const int cu = u - 2048; b = cu >> 5; head = (cu >> 2) & 7; qrow0 = ML + b * CTXL + (cu & 3) * 64; blk0 = 2; }
        { const int row = F.tid >> 3, c8 = F.tid & 7;
          const u32x4 a = *(const u32x4*)(QKV + (size_t)(qrow0 + row) * INW + 2048 + head * 64 + 8 * c8); const unsigned aw[4] = {a.x, a.y, a.z, a.w}; float x[8]; float ss = 0.f;
#pragma unroll
          for (int i = 0; i < 4; ++i) { x[2 * i] = bflo(aw[i]); x[2 * i + 1] = bfhi(aw[i]); ss += x[2 * i] * x[2 * i] + x[2 * i + 1] * x[2 * i + 1]; }
          const float rinv = rsqrtf(red8(ss) * (1.f / 64.f) + 1e-6f) * 0.125f;
#pragma unroll
          for (int i = 0; i < 8; ++i) x[i] *= F.in[12][8 * c8 + i];
          *(LAS u32x4*)(Qs + row * NLD + 8 * c8) = pack8(x, rinv); }
        for (int i = F.tid; i < 15 * 31; i += NTHR) rpbs[i] = F.in[14][head * 465 + i];
        f32x4 oacc[4]; float lsum = 0.f;
#pragma unroll
        for (int j = 0; j < 4; ++j) oacc[j] = (f32x4){0.f, 0.f, 0.f, 0.f};
        for (int blk = blk0; blk < 3; ++blk) {
            for (int it = F.tid; it < 256 * 8; it += NTHR) { const int krow = it >> 3, c8 = it & 7;
                const int grow = blk < 2 ? b * SEQ + (r0 + 4 * blk + (krow >> 6)) * 64 + (krow & 63) : ML + b * CTXL + krow;
                const u32x4 a = *(const u32x4*)(QKV + (size_t)grow * INW + 2560 + head * 64 + 8 * c8); const unsigned aw[4] = {a.x, a.y, a.z, a.w}; float x[8]; float ss = 0.f;
#pragma unroll
                for (int i = 0; i < 4; ++i) { x[2 * i] = bflo(aw[i]); x[2 * i + 1] = bfhi(aw[i]); ss += x[2 * i] * x[2 * i] + x[2 * i + 1] * x[2 * i + 1]; }
                const float rinv = rsqrtf(red8(ss) * (1.f / 64.f) + 1e-6f);
#pragma unroll
                for (int i = 0; i < 8; ++i) x[i] *= F.in[13][8 * c8 + i];
                *(LAS u32x4*)(Ks + krow * NLD + 8 * c8) = pack8(x, rinv);
                *(LAS u32x4*)(Vs + krow * NLD + 8 * c8) = *(const u32x4*)(QKV + (size_t)grow * INW + 3072 + head * 64 + 8 * c8); }
            WG_SYNC();
            f32x4 sacc[8];
#pragma unroll
            for (int j = 0; j < 8; ++j) sacc[j] = (f32x4){0.f, 0.f, 0.f, 0.f};
#pragma unroll
            for (int k0 = 0; k0 < 64; k0 += 32) { const bf16x8 aq = frag_kc(Qs, NLD, 16 * mq, k0, F.lane);
#pragma unroll
                for (int j = 0; j < 8; ++j) sacc[j] = mma(sacc[j], frag_kc(Ks, NLD, 128 * kh + 16 * j, k0, F.lane), aq); }
            const int c = 16 * mq + fr, c0 = min(max(c - 8, 0), 48);
#pragma unroll
            for (int j = 0; j < 8; ++j) { float pv[4];
#pragma unroll
                for (int i = 0; i < 4; ++i) { const int key = 128 * kh + 16 * j + 4 * fq + i; float p;
                    if (blk < 2) { const int kr = 4 * blk + (key >> 6), kc = key & 63; const bool ok = (kc >= c0) && (kc < c0 + 16);
                        const float bias = ok ? rpbs[(r0 + kr - r + 7) * 31 + (kc - c + 15)] : 0.f; p = ok ? __expf(sacc[j][i] + bias - bound) : 0.f; }
                    else p = __expf(sacc[j][i] - bound);
                    pv[i] = p; lsum += p; }
                u32x2 pk; pk.x = pk2(pv[0], pv[1]); pk.y = pk2(pv[2], pv[3]); *(LAS u32x2*)(Pw + fr * RLD + 16 * j + 4 * fq) = pk; }
            LDS_WAIT();
#pragma unroll
            for (int ks = 0; ks < 4; ++ks) { const bf16x8 ap = frag_kc(Pw, RLD, 0, 32 * ks, F.lane);
#pragma unroll
                for (int j = 0; j < 4; ++j) oacc[j] = mma(oacc[j], frag_kr(Vs, NLD, 16 * j, 128 * kh + 32 * ks, F.lane), ap); }
            WG_SYNC();
        }
        lsum += __shfl_xor(lsum, 16); lsum += __shfl_xor(lsum, 32);
        if (kh == 1) {
#pragma unroll
            for (int j = 0; j < 4; ++j) *(LAS f32x4*)(comb + mq * 1040 + fr * 64 + 16 * j + 4 * fq) = oacc[j];
            if (fq == 0) comb[mq * 1040 + 1024 + fr] = lsum; }
        WG_SYNC();
        if (kh == 0) { const float inv = 1.f / (lsum + comb[mq * 1040 + 1024 + fr]);
#pragma unroll
            for (int j = 0; j < 4; ++j) { const f32x4 o = (oacc[j] + *(LAS f32x4*)(comb + mq * 1040 + fr * 64 + 16 * j + 4 * fq)) * inv;
                u32x2 p; p.x = pk2(o.x, o.y); p.y = pk2(o.z, o.w);
                *(u32x2*)(MIX + (size_t)(qrow0 + 16 * mq + fr) * D + 512 + head * 64 + 16 * j + 4 * fq) = p; } }
        WG_SYNC();
    }
}

DI void xm_phase(Fr& F, const float* xl, const float* xc, const float* normw, const float* modl) {
    bf16* XM = (bf16*)(F.ws + WS_XM); const float* mu = F.in[18];
    for (int row = F.gw; row < MA; row += F.NGW) {
        const bool lat = row < ML; const int rr = lat ? row : row - ML; const int L = lat ? SEQ : CTXL; const int t = rr % L;
        const float* src = (lat ? xl : xc) + (size_t)rr * D;
        const float* mrow = modl + (size_t)(lat ? row / SEQ : 8) * 6144;
        const bool hp = t > 0, hn = t < L - 1;
        f32x4 vc[4], vp[4], vn[4]; float sc_ = 0.f, sp_ = 0.f, sn_ = 0.f;
#pragma unroll
        for (int j = 0; j < 4; ++j) { vc[j] = ((const f32x4*)src)[F.lane + 64 * j];
            vp[j] = hp ? ((const f32x4*)(src - D))[F.lane + 64 * j] : (f32x4){0.f, 0.f, 0.f, 0.f}; vn[j] = hn ? ((const f32x4*)(src + D))[F.lane + 64 * j] : (f32x4){0.f, 0.f, 0.f, 0.f};
            sc_ += (vc[j].x * vc[j].x + vc[j].y * vc[j].y) + (vc[j].z * vc[j].z + vc[j].w * vc[j].w);
            sp_ += (vp[j].x * vp[j].x + vp[j].y * vp[j].y) + (vp[j].z * vp[j].z + vp[j].w * vp[j].w);
            sn_ += (vn[j].x * vn[j].x + vn[j].y * vn[j].y) + (vn[j].z * vn[j].z + vn[j].w * vn[j].w); }
        const float rc = rsqrtf(wave_sum(sc_) * (1.f / D) + 1e-6f), rp = rsqrtf(wave_sum(sp_) * (1.f / D) + 1e-6f), rn = rsqrtf(wave_sum(sn_) * (1.f / D) + 1e-6f);
#pragma unroll
        for (int j = 0; j < 4; ++j) { const int c4 = F.lane + 64 * j;
            const f32x4 w = ((const f32x4*)normw)[c4], sc = ((const f32x4*)(mrow + 1024))[c4], sh = ((const f32x4*)mrow)[c4];
            const f32x4 g = w * (sc + 1.f);
            const f32x4 hc = vc[j] * rc * g + sh;
            const f32x4 hpv = hp ? vp[j] * rp * g + sh : (f32x4){0.f, 0.f, 0.f, 0.f};
            const f32x4 hnv = hn ? vn[j] * rn * g + sh : (f32x4){0.f, 0.f, 0.f, 0.f};
            const f32x4 xx = (hpv + hnv) * 0.5f - hc;
#pragma unroll
            for (int s = 0; s < 6; ++s) { const f32x4 m = ((const f32x4*)(mu + s * 1024))[c4]; const f32x4 y = hc + xx * m;
                u32x2 p; p.x = pk2(y.x, y.y); p.y = pk2(y.z, y.w); ((u32x2*)(XM + ((size_t)s * MA + row) * D))[c4] = p; } }
    }
}

constexpr int SC_T = 32;
constexpr int SC_STRIDE = 6 * 64;
DI void rwkv_scan_phase(Fr& F) {
    const bf16* KB = (const bf16*)(F.ws + WS_KB); const bf16* VB = (const bf16*)(F.ws + WS_VB); const bf16* RB = (const bf16*)(F.ws + WS_RB);
    const float* DEC = (const float*)(F.ws + WS_DEC); const bf16* AG = (const bf16*)(F.ws + WS_AG);
    LAS float* buf[2] = {(LAS float*)F.lds, (LAS float*)F.lds + SC_T * SC_STRIDE};
    const int i = F.tid >> 3, cg = F.tid & 7;
    for (int u = F.bx; u < 256; u += F.G) {
        const int z = u & 1, h = (u >> 1) & 15, b = u >> 5;
        float* Y = (float*)(F.ws + (z ? WS_YB : WS_YF));
        const int ch = h * 64 + F.lane;
        const float kkw = F.in[28][ch], kaw = F.in[29][ch];
        const float* decz = DEC + (size_t)z * MA * D; const bf16* agz = AG + (size_t)z * MA * D;
        float s[8];
#pragma unroll
        for (int j = 0; j < 8; ++j) s[j] = 0.f;
        bf16 kreg[4], vreg[4], rreg[4], areg[4]; float dreg[4];
#define SC_ROW(n, q, rowv, latv) const int g_ = (n) * SC_T + F.wave * 4 + (q); const bool latv = g_ >= CTXL; \
        const int rowv = latv ? b * SEQ + (z ? (SEQ + CTXL - 1 - g_) : (g_ - CTXL)) : ML + b * CTXL + (z ? (CTXL - 1 - g_) : g_);
#define SC_LOAD(n) do { _Pragma("unroll") for (int q = 0; q < 4; ++q) { SC_ROW(n, q, row_, lat_) \
            kreg[q] = KB[(size_t)row_ * D + ch]; vreg[q] = VB[(size_t)row_ * D + ch]; areg[q] = agz[(size_t)row_ * D + ch]; dreg[q] = decz[(size_t)row_ * D + ch]; \
            rreg[q] = lat_ ? RB[(size_t)row_ * D + ch] : (bf16)0; } } while (0)
#define SC_STAGE(dst) do { _Pragma("unroll") for (int q = 0; q < 4; ++q) { const float kr_ = bf1(kreg[q]), ag_ = bf1(areg[q]); float kk_ = kr_ * kkw; \
            const float nr_ = sqrtf(wave_sum(kk_ * kk_)); kk_ = kk_ / fmaxf(nr_, 1e-12f); LAS float* d_ = (dst) + (F.wave * 4 + q) * SC_STRIDE + F.lane; \
            d_[0] = -kk_; d_[64] = dreg[q]; d_[128] = kk_ * ag_; d_[192] = kr_ * (1.f + (ag_ - 1.f) * kaw); d_[256] = bf1(rreg[q]); d_[320] = bf1(vreg[q]); } } while (0)
        SC_LOAD(0); SC_STAGE(buf[0]);
        WG_SYNC();
        constexpr int NCHUNK = (SEQ + CTXL) / SC_T;
        for (int n = 0; n < NCHUNK; ++n) {
            if (n + 1 < NCHUNK) SC_LOAD(n + 1);
            const LAS float* cb = buf[n & 1];
            const bool lat = n * SC_T >= CTXL;
#pragma unroll 2
            for (int st = 0; st < SC_T; ++st) {
                const LAS float* p = cb + st * SC_STRIDE + 8 * cg;
                const f32x4 a0 = *(const LAS f32x4*)p, a1 = *(const LAS f32x4*)(p + 4), w0 = *(const LAS f32x4*)(p + 64), w1 = *(const LAS f32x4*)(p + 68);
                const f32x4 b0 = *(const LAS f32x4*)(p + 128), b1 = *(const LAS f32x4*)(p + 132), k0 = *(const LAS f32x4*)(p + 192), k1 = *(const LAS f32x4*)(p + 196);
                const f32x4 r0 = *(const LAS f32x4*)(p + 256), r1 = *(const LAS f32x4*)(p + 260);
                const float vi = cb[st * SC_STRIDE + 320 + i];
                float sa = (s[0] * a0.x + s[1] * a0.y) + (s[2] * a0.z + s[3] * a0.w) + (s[4] * a1.x + s[5] * a1.y) + (s[6] * a1.z + s[7] * a1.w);
                sa = red8(sa);
                s[0] = s[0] * w0.x + sa * b0.x + vi * k0.x; s[1] = s[1] * w0.y + sa * b0.y + vi * k0.y; s[2] = s[2] * w0.z + sa * b0.z + vi * k0.z; s[3] = s[3] * w0.w + sa * b0.w + vi * k0.w;
                s[4] = s[4] * w1.x + sa * b1.x + vi * k1.x; s[5] = s[5] * w1.y + sa * b1.y + vi * k1.y; s[6] = s[6] * w1.z + sa * b1.z + vi * k1.z; s[7] = s[7] * w1.w + sa * b1.w + vi * k1.w;
                if (lat) {
                    float y = (s[0] * r0.x + s[1] * r0.y) + (s[2] * r0.z + s[3] * r0.w) + (s[4] * r1.x + s[5] * r1.y) + (s[6] * r1.z + s[7] * r1.w);
                    y = red8(y);
                    const int g = n * SC_T + st; const int tl = z ? (SEQ + CTXL - 1 - g) : (g - CTXL);
                    if (cg == 0) Y[(size_t)(b * SEQ + tl) * D + h * 64 + i] = y;
                }
            }
            if (n + 1 < NCHUNK) SC_STAGE(buf[(n + 1) & 1]);
            WG_SYNC();
        }
#undef SC_ROW
#undef SC_LOAD
#undef SC_STAGE
    }
}

DI void rwkv_readout_phase(Fr& F) {
    const bf16* KB = (const bf16*)(F.ws + WS_KB); const bf16* VB = (const bf16*)(F.ws + WS_VB); const bf16* RB = (const bf16*)(F.ws + WS_RB);
    const bf16* AG = (const bf16*)(F.ws + WS_AG); const bf16* G = (const bf16*)(F.ws + WS_G);
    const float* YF = (const float*)(F.ws + WS_YF); const float* YB = (const float*)(F.ws + WS_YB); bf16* Z = (bf16*)(F.ws + WS_H);
    const int c0 = 16 * F.lane;
    for (int row = F.gw; row < ML; row += F.NGW) {
        const size_t off = (size_t)row * D + c0;
        float y[16], kv[16], vv[16], rv[16], gv[16], a0v[16], a1v[16];
#pragma unroll
        for (int q = 0; q < 4; ++q) { const f32x4 a = *(const f32x4*)(YF + off + 4 * q), bq = *(const f32x4*)(YB + off + 4 * q);
            y[4 * q] = a.x + bq.x; y[4 * q + 1] = a.y + bq.y; y[4 * q + 2] = a.z + bq.z; y[4 * q + 3] = a.w + bq.w; }
#define RD16(dst, ptr) do { const u32x4 t0_ = *(const u32x4*)(ptr), t1_ = *(const u32x4*)((ptr) + 8); const unsigned tw_[8] = {t0_.x, t0_.y, t0_.z, t0_.w, t1_.x, t1_.y, t1_.z, t1_.w}; \
        _Pragma("unroll") for (int q_ = 0; q_ < 8; ++q_) { dst[2 * q_] = bflo(tw_[q_]); dst[2 * q_ + 1] = bfhi(tw_[q_]); } } while (0)
        RD16(kv, KB + off); RD16(vv, VB + off); RD16(rv, RB + off); RD16(gv, G + off); RD16(a0v, AG + off); RD16(a1v, AG + (size_t)MA * D + off);
#undef RD16
        float s = 0.f, cf = 0.f;
#pragma unroll
        for (int q = 0; q < 16; ++q) { s += y[q]; const float ka = F.in[29][c0 + q];
            const float kd = kv[q] * ((1.f + (a0v[q] - 1.f) * ka) + (1.f + (a1v[q] - 1.f) * ka)); cf += rv[q] * kd * F.in[30][c0 + q]; }
        s = red4(s); cf = red4(cf);
        const float mean = s * (1.f / 64.f); float q2 = 0.f;
#pragma unroll
        for (int q = 0; q < 16; ++q) { const float d = y[q] - mean; q2 += d * d; }
        q2 = red4(q2);
        const float rstd = rsqrtf(q2 * (1.f / 64.f) + 64e-5f);
        float o[16];
#pragma unroll
        for (int q = 0; q < 16; ++q) o[q] = ((y[q] - mean) * rstd * F.in[31][c0 + q] + F.in[32][c0 + q] + cf * vv[q]) * gv[q];
        u32x4 p0, p1; p0.x = pk2(o[0], o[1]); p0.y = pk2(o[2], o[3]); p0.z = pk2(o[4], o[5]); p0.w = pk2(o[6], o[7]); p1.x = pk2(o[8], o[9]); p1.y = pk2(o[10], o[11]); p1.z = pk2(o[12], o[13]); p1.w = pk2(o[14], o[15]);
        *(u32x4*)(Z + off) = p0; *(u32x4*)(Z + off + 8) = p1;
    }
}

DI void moe_route_phase(Fr& F, const float* xl, const float* normw, const float* modl) {
    bf16* H2 = (bf16*)(F.ws + WS_MIX); int* TopE = (int*)(F.ws + WS_MISC + MISC_TOPE); f32x2* TopW = (f32x2*)(F.ws + WS_MISC + MISC_TOPW); int* Cnts = (int*)(F.ws + WS_MISC + MISC_CNTS);
    LAS float* rt = (LAS float*)F.lds;
    LAS int* lc = (LAS int*)(F.lds + 32768);
    for (int idx = F.tid; idx < 1024 * 8 / 4; idx += NTHR) ((LAS f32x4*)rt)[idx] = ((const f32x4*)F.in[34])[idx];
    for (int wg = F.bx; wg < 256; wg += F.G) {
        WG_SYNC();
        for (int it = 0; it < 8; ++it) { const int row = wg * 64 + F.wave * 8 + it;
            const float* src = xl + (size_t)row * D; const float* mrow = modl + (size_t)(row / SEQ) * 6144;
            f32x4 v[4]; float ss = 0.f;
#pragma unroll
            for (int j = 0; j < 4; ++j) { v[j] = ((const f32x4*)src)[F.lane + 64 * j]; ss += (v[j].x * v[j].x + v[j].y * v[j].y) + (v[j].z * v[j].z + v[j].w * v[j].w); }
            const float rstd = rsqrtf(wave_sum(ss) * (1.f / D) + 1e-6f);
            float lg[8];
#pragma unroll
            for (int e = 0; e < 8; ++e) lg[e] = 0.f;
#pragma unroll
            for (int j = 0; j < 4; ++j) { const int c4 = F.lane + 64 * j;
                const f32x4 w = ((const f32x4*)normw)[c4], sc = ((const f32x4*)(mrow + 4096))[c4], sh = ((const f32x4*)(mrow + 3072))[c4];
                const f32x4 y = v[j] * rstd * w * (sc + 1.f) + sh;
                u32x2 p; p.x = pk2(y.x, y.y); p.y = pk2(y.z, y.w); ((u32x2*)(H2 + (size_t)row * D))[c4] = p;
                const float yy[4] = {y.x, y.y, y.z, y.w};
#pragma unroll
                for (int q = 0; q < 4; ++q) { const f32x4 r0 = *(const LAS f32x4*)(rt + (4 * c4 + q) * 8), r1 = *(const LAS f32x4*)(rt + (4 * c4 + q) * 8 + 4);
                    lg[0] += yy[q] * r0.x; lg[1] += yy[q] * r0.y; lg[2] += yy[q] * r0.z; lg[3] += yy[q] * r0.w; lg[4] += yy[q] * r1.x; lg[5] += yy[q] * r1.y; lg[6] += yy[q] * r1.z; lg[7] += yy[q] * r1.w; } }
#pragma unroll
            for (int e = 0; e < 8; ++e) lg[e] = wave_sum(lg[e]);
            int e0 = 0; float v0 = lg[0];
#pragma unroll
            for (int e = 1; e < 8; ++e) if (lg[e] > v0) { v0 = lg[e]; e0 = e; }
            int e1 = -1; float v1 = -3.0e38f;
#pragma unroll
            for (int e = 0; e < 8; ++e) if (e != e0 && lg[e] > v1) { v1 = lg[e]; e1 = e; }
            const float w0 = 1.f / (1.f + expf(v1 - v0)), w1 = 1.f - w0;
            if (F.lane == 0) { TopE[row] = e0 | (e1 << 8); TopW[row] = (f32x2){w0, w1}; lc[F.wave * 8 + it] = e0 | (e1 << 8); }
        }
        WG_SYNC();
        if (F.tid < 8) { int c = 0; for (int t = 0; t < 64; ++t) { const int code = lc[t]; c += ((code & 255) == F.tid ? 1 : 0) + ((code >> 8) == F.tid ? 1 : 0); } Cnts[wg * 8 + F.tid] = c; }
        WG_SYNC();
    }
}
DI void moe_gather_phase(Fr& F) {
    const bf16* H2 = (const bf16*)(F.ws + WS_MIX); const int* TopE = (const int*)(F.ws + WS_MISC + MISC_TOPE); const f32x2* TopW = (const f32x2*)(F.ws + WS_MISC + MISC_TOPW);
    const int* Cnts = (const int*)(F.ws + WS_MISC + MISC_CNTS); int* Exp = (int*)(F.ws + WS_MISC + MISC_EXP);
    bf16* XG = (bf16*)(F.ws + WS_XG); int* RowTok = (int*)(F.ws + WS_ROWS); float* RowW = (float*)(F.ws + WS_ROWS + 262144);
    LAS int* lc = (LAS int*)F.lds;
    LAS int* tot = lc + 2048;
    LAS int* rows = tot + 32;
    LAS int* te = rows + 128;
    for (int idx = F.tid; idx < 2048; idx += NTHR) lc[idx] = Cnts[idx];
    WG_SYNC();
    for (int wg = F.bx; wg < 256; wg += F.G) {
        if (F.tid < 64) te[F.tid] = TopE[wg * 64 + F.tid];
        if (F.tid < 8) { int t = 0, mb = 0; for (int w = 0; w < 256; ++w) { const int c = lc[w * 8 + F.tid]; t += c; mb += (w < wg) ? c : 0; } tot[F.tid] = t; tot[16 + F.tid] = mb; }
        WG_SYNC();
        if (F.tid == 0) { int sgs = 0; for (int e = 0; e < 8; ++e) { tot[8 + e] = sgs; sgs += (tot[e] + 255) & ~255; }
            if (wg == 0) { int acc = 0; for (int e = 0; e < 8; ++e) { Exp[e] = tot[e]; Exp[8 + e] = tot[8 + e]; acc += (tot[e] + 255) >> 8; Exp[16 + e] = acc; } } }
        WG_SYNC();
        if (F.tid < 64) { const int code = te[F.tid]; const int e0 = code & 255, e1 = code >> 8; int r0 = 0, r1 = 0;
            for (int t = 0; t < F.tid; ++t) { const int c2 = te[t]; const int a = c2 & 255, bq = c2 >> 8; r0 += (a == e0 ? 1 : 0) + (bq == e0 ? 1 : 0); r1 += (a == e1 ? 1 : 0) + (bq == e1 ? 1 : 0); }
            rows[2 * F.tid] = tot[8 + e0] + tot[16 + e0] + r0; rows[2 * F.tid + 1] = tot[8 + e1] + tot[16 + e1] + r1; }
        WG_SYNC();
        for (int it = F.wave; it < 128; it += NWAVES) { const int t = it >> 1, k = it & 1, tok = wg * 64 + t, row = rows[it];
            const u32x4* s = (const u32x4*)(H2 + (size_t)tok * D); u32x4* d = (u32x4*)(XG + (size_t)row * D);
            d[F.lane] = s[F.lane]; d[F.lane + 64] = s[F.lane + 64];
            if (F.lane == 0) { RowTok[row] = tok * 2 + k; const f32x2 w = TopW[tok]; RowW[row] = k ? w.y : w.x; } }
        if (wg == 0) {
            for (int e = 0; e < 8; ++e) { const int a = tot[8 + e] + tot[e], bnd = tot[8 + e] + ((tot[e] + 255) & ~255); for (int rr = a + F.tid; rr < bnd; rr += NTHR) RowTok[rr] = -1; } }
        WG_SYNC();
    }
}
DI void moe_combine_phase(Fr& F, float* xl, const float* modl) {
    const bf16* YS = (const bf16*)(F.ws + WS_YS);
    for (int row = F.gw; row < ML; row += F.NGW) {
        const float* mrow = modl + (size_t)(row / SEQ) * 6144 + 5120; float* xr = xl + (size_t)row * D;
        const u32x2* s0 = (const u32x2*)(YS + (size_t)(2 * row) * D); const u32x2* s1 = (const u32x2*)(YS + (size_t)(2 * row + 1) * D);
#pragma unroll
        for (int j = 0; j < 4; ++j) { const int c4 = F.lane + 64 * j; const f32x4 x = ((const f32x4*)xr)[c4], m = ((const f32x4*)mrow)[c4]; const u32x2 a = s0[c4], bq = s1[c4];
            f32x4 o; o.x = x.x + m.x * (bflo(a.x) + bflo(bq.x)); o.y = x.y + m.y * (bfhi(a.x) + bfhi(bq.x)); o.z = x.z + m.z * (bflo(a.y) + bflo(bq.y)); o.w = x.w + m.w * (bfhi(a.y) + bfhi(bq.y));
            ((f32x4*)xr)[c4] = o; }
    }
}

constexpr int N_PHASES = 20;
struct Args { const float* in[37]; float* out; unsigned char* ws; int ph_lo, ph_hi; };
template <class Epi> DI void run_gemm(Fr& F, const bf16* A, const bf16* Bt, int M, int N, int K, const Epi& E, int& rot) {
    int Kv = K; asm volatile("" : "+s"(Kv));
    pg8::Gemm g{A, Bt, M, N, Kv}; pg8::StaticOrder S; S.init(M, N, F.G, (F.bx + F.G - (rot % F.G)) % F.G); rot += (M / 256) * (N / 256);
    pg8::gemm_phase<Epi, pg8::StaticOrder>(F.lds, g, S, E);
}
__global__ void __launch_bounds__(NTHR, 2) fwd_kernel(Args args) {
    extern __shared__ __attribute__((aligned(16))) unsigned char lds_raw[];
    Fr F;
    F.lds = (LAS unsigned char*)lds_raw; F.ws = args.ws; F.in = args.in; F.out = args.out;
    F.tid = threadIdx.x; F.lane = F.tid & 63; F.wave = __builtin_amdgcn_readfirstlane(F.tid >> 6); F.bx = blockIdx.x; F.G = gridDim.x;
    F.gw = F.bx * NWAVES + F.wave; F.NGW = F.G * NWAVES;
    volatile LAS unsigned* MISC = (volatile LAS unsigned*)(F.lds + LDS_MISC_OFF);
    if (F.tid < 64) MISC[F.tid] = 0u;
    __syncthreads();
    const int lo = args.ph_lo, hi = args.ph_hi;
    const bool multi = (hi - lo) > 1;
    XcdBarrier bar; bar.bar = (unsigned*)(F.ws + WS_CTL) + CW_BAR; bar.x = 0; bar.st = nullptr;
    if (multi) bar = xcd_barrier_post((unsigned*)(F.ws + WS_CTL) + CW_BAR, MISC + 8);
#ifndef PH_MASK
#define PH_MASK 0xFFFFFFFFu
#endif
#define IN(k) ((((PH_MASK) >> (k)) & 1u) && lo <= (k) && (k) < hi)
#define SEAM(k) do { if (IN(k) && IN((k) + 1)) xcd_barrier(bar); } while (0)
    const float* const* in = args.in;
    float* MOD = (float*)(F.ws + WS_MOD);
    float* XL = F.out; float* XC = (float*)(F.ws + WS_XC);
    bf16* H = (bf16*)(F.ws + WS_H); bf16* MIX = (bf16*)(F.ws + WS_MIX);

    if (IN(0)) { p0_prologue(F); } SEAM(0);
    if (IN(1)) { mod_rows(F, in[0], in[2], MA, in[6], MOD, 0, 1024, H); } SEAM(1);
    if (IN(2)) { int rot = 0; EpiStore<0> E{(bf16*)(F.ws + WS_QKV), INW, INW}; run_gemm(F, H, (const bf16*)(F.ws + WS_W_IN), MA, INW, 1024, E, rot); } SEAM(2);
    if (IN(3)) { ret_kv_phase(F); } SEAM(3);
    if (IN(4)) { ret_prefix_phase(F); } SEAM(4);
    #ifndef PH5_SEL
#define PH5_SEL 3
#endif
    if (IN(5)) { if (PH5_SEL & 1) ret_out_phase(F); if (PH5_SEL & 2) na_phase(F); } SEAM(5);
    if (IN(6)) { int rot = 0; EpiResid E{in[0], XL, in[2], XC, MOD + 2048}; run_gemm(F, MIX, (const bf16*)(F.ws + WS_W_OUT), MA, 1024, 1024, E, rot); } SEAM(6);
    if (IN(7)) { mod_rows(F, XL, XC, MA, in[7], MOD, 3072, 4096, H); } SEAM(7);
    if (IN(8)) { int rot = 0; EpiSwiglu E{(bf16*)(F.ws + WS_FFH), FFN_H}; run_gemm(F, H, (const bf16*)(F.ws + WS_W_13), MA, 2 * FFN_H, 1024, E, rot); } SEAM(8);
    if (IN(9)) { int rot = 0; EpiResid E{XL, XL, XC, XC, MOD + 5120}; run_gemm(F, (const bf16*)(F.ws + WS_FFH), (const bf16*)(F.ws + WS_W_2), MA, 1024, FFN_H, E, rot); } SEAM(9);
    const float* MOD1 = MOD + 9 * 6144;
    if (IN(10)) { xm_phase(F, XL, XC, in[6] + 1024, MOD1); } SEAM(10);
    if (IN(11)) { int rot = 0; const bf16* XM = (const bf16*)(F.ws + WS_XM); const bf16* WR = (const bf16*)(F.ws + WS_W_RKV); const bf16* WL1 = (const bf16*)(F.ws + WS_W_L1);
        { EpiStore<0> E{(bf16*)(F.ws + WS_RB), D, D}; run_gemm(F, XM, WR, ML, 1024, 1024, E, rot); }
        { EpiStore<0> E{(bf16*)(F.ws + WS_KB), D, D}; run_gemm(F, XM + (size_t)1 * MA * D, WR + 1024 * 1024, MA, 1024, 1024, E, rot); }
        { EpiStore<0> E{(bf16*)(F.ws + WS_VB), D, D}; run_gemm(F, XM + (size_t)2 * MA * D, WR + 2 * 1024 * 1024, MA, 1024, 1024, E, rot); }
        { EpiStore<1> E{(bf16*)(F.ws + WS_L1), 256, 128}; run_gemm(F, XM + (size_t)3 * MA * D, WL1, MA, 256, 1024, E, rot); }
        { EpiStore<0> E{(bf16*)(F.ws + WS_L1) + 128, 256, 128}; run_gemm(F, XM + (size_t)4 * MA * D, WL1 + 256 * 1024, MA, 256, 1024, E, rot); }
        { EpiStore<2> E{(bf16*)(F.ws + WS_LG), 256, 256}; run_gemm(F, XM + (size_t)5 * MA * D, WL1 + 2 * 256 * 1024, ML, 256, 1024, E, rot); } } SEAM(11);
    if (IN(12)) { int rot = 0;
        { EpiLora2 E{(float*)(F.ws + WS_DEC), (bf16*)(F.ws + WS_AG), in[20], in[23]}; run_gemm(F, (const bf16*)(F.ws + WS_L1), (const bf16*)(F.ws + WS_W_L2), MA, 4096, 256, E, rot); }
        { EpiStore<0> E{(bf16*)(F.ws + WS_G), D, D}; run_gemm(F, (const bf16*)(F.ws + WS_LG), (const bf16*)(F.ws + WS_W_G2), ML, 1024, 256, E, rot); } } SEAM(12);
    if (IN(13)) { rwkv_scan_phase(F); } SEAM(13);
    if (IN(14)) { rwkv_readout_phase(F); } SEAM(14);
    if (IN(15)) { int rot = 0; EpiResid E{XL, XL, XC, XC, MOD1 + 2048}; run_gemm(F, H, (const bf16*)(F.ws + WS_W_O), ML, 1024, 1024, E, rot); } SEAM(15);
    if (IN(16)) { moe_route_phase(F, XL, in[7] + 1024, MOD1); } SEAM(16);
    if (IN(17)) { moe_gather_phase(F); } SEAM(17);
    if (IN(18) || IN(19)) {
        const int* Exp = (const int*)(F.ws + WS_MISC + MISC_EXP);
        pg8::MoeOrder S; S.G = F.G; S.c = F.bx;
#pragma unroll
        for (int e = 0; e < 8; ++e) S.tend[e] = Exp[16 + e];
        S.nM = S.tend[7];
        if (IN(18)) { S.nN = 2 * EXP_H / 256; S.nwg = S.nM * S.nN; pg8::Gemm g{(const bf16*)(F.ws + WS_XG), (const bf16*)(F.ws + WS_W_M13), XG_ROWS, 2 * EXP_H, 1024};
            EpiSwiglu E{(bf16*)(F.ws + WS_HG), EXP_H}; pg8::gemm_phase<EpiSwiglu, pg8::MoeOrder>(F.lds, g, S, E); }
        SEAM(18);
        if (IN(19)) { S.nN = 4; S.nwg = S.nM * S.nN; pg8::Gemm g{(const bf16*)(F.ws + WS_HG), (const bf16*)(F.ws + WS_W_M2), XG_ROWS, 1024, EXP_H};
            EpiMoeOut E{(bf16*)(F.ws + WS_YS), (const int*)(F.ws + WS_ROWS), (const float*)(F.ws + WS_ROWS + 262144)}; pg8::gemm_phase<EpiMoeOut, pg8::MoeOrder>(F.lds, g, S, E); }
    }
    if (IN(19) && IN(20)) xcd_barrier(bar);
    if (IN(20)) { moe_combine_phase(F, XL, MOD1); }
#undef IN
#undef SEAM
}

#ifndef MK_SPLIT
#define MK_SPLIT 1
#endif
extern "C" void kernel_launch(void* const* d_in, const int* in_sizes, int n_in, void* d_out, int out_size, void* d_ws, size_t ws_size, hipStream_t stream) {
    static int grid = 0;
    if (grid == 0) {
        if (n_in != 37 || out_size != ML * D || ws_size < WS_END) { fprintf(stderr, "kernel_launch: unexpected problem (n_in %d out %d ws %zu)\n", n_in, out_size, ws_size); grid = -1; return; }
        int dev = 0, cus = 0, per_cu = 0;
        if (hipGetDevice(&dev) != hipSuccess || hipDeviceGetAttribute(&cus, hipDeviceAttributeMultiprocessorCount, dev) != hipSuccess) { grid = -1; return; }
        if (hipFuncSetAttribute((const void*)fwd_kernel, hipFuncAttributeMaxDynamicSharedMemorySize, LDS_BYTES) != hipSuccess) { fprintf(stderr, "kernel_launch: hipFuncSetAttribute failed\n"); grid = -1; return; }
        if (hipOccupancyMaxActiveBlocksPerMultiprocessor(&per_cu, (const void*)fwd_kernel, NTHR, LDS_BYTES) != hipSuccess || per_cu < 1) { fprintf(stderr, "kernel_launch: occupancy query says %d\n", per_cu); }
        (void)hipGetLastError();
        grid = cus;
    }
    if (grid < 0) return;
    (void)hipMemsetAsync((char*)d_ws + WS_CTL, 0, CTL_ZERO_BYTES, stream);
    Args a{};
    for (int i = 0; i < 37; ++i) a.in[i] = (const float*)d_in[i];
    a.out = (float*)d_out; a.ws = (unsigned char*)d_ws;
#if MK_SPLIT
    for (int p = 0; p <= N_PHASES; ++p) { a.ph_lo = p; a.ph_hi = p + 1; hipLaunchKernelGGL(fwd_kernel, dim3(grid), dim3(NTHR), LDS_BYTES, stream, a); }
#else
    a.ph_lo = 0; a.ph_hi = N_PHASES + 1; hipLaunchKernelGGL(fwd_kernel, dim3(grid), dim3(NTHR), LDS_BYTES, stream, a);
#endif
}
```

```cpp
#include <hip/hip_runtime.h>
#include <cstdio>
#include <cstdint>

#define DI __device__ __forceinline__
#define LAS __attribute__((address_space(3)))

namespace pg8 {
#define PG8_LAS __attribute__((address_space(3)))
typedef unsigned short bf16_t;
typedef short bf16x8 __attribute__((ext_vector_type(8)));
typedef float f32x4 __attribute__((ext_vector_type(4)));
typedef unsigned u32x4 __attribute__((ext_vector_type(4)));
constexpr int BM = 256, BK = 64, HALF = 128, HTB = HALF * BK * 2  , STAGE_BYTES = 8 * HTB, NXCD = 8, WGM = 8;

__host__ __device__ __forceinline__ int lds_byte(int r, int c) { const int st = (r >> 4) * 2 + (c >> 5), rr = r & 15, cc = c & 31, ob = rr * 64 + cc * 2; return st * 1024 + (ob ^ (((ob >> 9) & 1) << 5)); }
__host__ __device__ __forceinline__ void stage_rc(int b, int& R, int& C) { const int st = b / 1024, sb = b % 1024, swz = sb ^ (((sb >> 9) & 1) << 5); R = (st >> 1) * 16 + swz / 64; C = (st & 1) * 32 + (swz % 64) / 2; }
__host__ __device__ __forceinline__ int perm32(int rho) { const int n = rho >> 4, i = rho & 15; return 8 * (i >> 2) + 4 * n + (i & 3); }

struct Unit { int pm, pn, pb; };
struct Gemm { const bf16_t* A; const bf16_t* Bt; int M, N, K; };

struct StaticOrder {
    int nM, nN, nwg, G, c;
    __host__ __device__ void init(int M, int N, int G_, int c_) { nM = M / BM; nN = N / BM; nwg = nM * nN; G = G_; c = c_; }
    __host__ __device__ bool next(int i, Unit& u) const {
        const long L = (long)i * G + c; if (L >= nwg) return false;
        int wgid = (int)L; { const int q = nwg / NXCD, r = nwg % NXCD, xcd = wgid % NXCD, off = wgid / NXCD; wgid = (xcd < r ? xcd * (q + 1) : r * (q + 1) + (xcd - r) * q) + off; }
        const int nig = WGM * nN, gid = wgid / nig, fm = gid * WGM, gsz = (nM - fm) < WGM ? (nM - fm) : WGM;
        u.pm = fm + ((wgid % nig) % gsz); u.pn = (wgid % nig) / gsz; u.pb = u.pn; return true;
    }
    __device__ __forceinline__ void a_ready(const Unit&) const {}
    __device__ __forceinline__ void done(const Unit&) const {}
};
struct MoeOrder {
    int nM, nN, nwg, G, c; int tend[8];
    __device__ bool next(int i, Unit& u) const {
        const long L = (long)i * G + c; if (L >= nwg) return false;
        int wgid = (int)L; { const int q = nwg / NXCD, r = nwg % NXCD, xcd = wgid % NXCD, off = wgid / NXCD; wgid = (xcd < r ? xcd * (q + 1) : r * (q + 1) + (xcd - r) * q) + off; }
        const int nig = WGM * nN, gid = wgid / nig, fm = gid * WGM, gsz = (nM - fm) < WGM ? (nM - fm) : WGM;
        u.pm = fm + ((wgid % nig) % gsz); u.pn = (wgid % nig) / gsz;
        int e = 0;
#pragma unroll
        for (int j = 0; j < 7; ++j) e += (u.pm >= tend[j]) ? 1 : 0;
        u.pb = e * nN + u.pn; return true;
    }
    __device__ __forceinline__ void a_ready(const Unit&) const {}
    __device__ __forceinline__ void done(const Unit&) const {}
};

__device__ __forceinline__ unsigned cvt_pk_bf16(float lo, float hi) { unsigned r; asm volatile("v_cvt_pk_bf16_f32 %0, %1, %2" : "=v"(r) : "v"(lo), "v"(hi)); return r; }

template <class Epi, class Sched>
__device__ __forceinline__ void gemm_phase(PG8_LAS unsigned char* lds, const Gemm g, const Sched& S, const Epi& E) {
    const int tid = threadIdx.x, wid = __builtin_amdgcn_readfirstlane(tid >> 6), lane = tid & 63, wr = wid >> 2, wc = wid & 3, fr = lane & 15, fq = lane >> 4;
    const int K = g.K, nt = K / BK;
    unsigned voffA[2], voffB[2];
#pragma unroll
    for (int i = 0; i < 2; ++i) { int R, C; stage_rc(tid * 16 + i * 8192, R, C); const int Rb = Epi::PERM ? ((R & ~31) + perm32(R & 31)) : R;
        voffA[i] = (unsigned)(R * K + C) * 2u; voffB[i] = (unsigned)(Rb * K + C) * 2u; }
    const size_t kstep = (size_t)(BK * 2);
    const size_t hstep = (size_t)HALF * K * 2;
    const size_t tstep = 2 * hstep;
    const unsigned ldsw = (unsigned)wid * 1024u;
    const int aoff = lds_byte(wr * 64 + fr, fq * 8), boff = lds_byte(wc * 32 + fr, fq * 8);
#define PG8_SA(b, h) (((b) * 2 + (h)) * HTB)
#define PG8_SB(b, h) ((4 + (b) * 2 + (h)) * HTB)
#define PG8_STAGE(bufoff, gbase, voff) do { _Pragma("unroll") for (int _i = 0; _i < 2; ++_i) \
        __builtin_amdgcn_global_load_lds((const unsigned*)((const char*)(gbase) + (voff)[_i]), (PG8_LAS unsigned*)(lds + (bufoff) + ldsw + _i * 8192), 16, 0, 0); } while (0)
#define PG8_LDA(dst, b, h) do { _Pragma("unroll") for (int m = 0; m < 4; ++m) _Pragma("unroll") for (int k = 0; k < 2; ++k) dst[m][k] = *(const PG8_LAS bf16x8*)(lds + PG8_SA(b, h) + aoff + m * 2048 + k * 1024); } while (0)
#define PG8_LDB(dst, b, h) do { _Pragma("unroll") for (int n = 0; n < 2; ++n) _Pragma("unroll") for (int k = 0; k < 2; ++k) dst[n][k] = *(const PG8_LAS bf16x8*)(lds + PG8_SB(b, h) + boff + n * 2048 + k * 1024); } while (0)
#define PG8_MMA(ai, bj, At, Bt) do { __builtin_amdgcn_s_setprio(1); _Pragma("unroll") for (int m = 0; m < 4; ++m) _Pragma("unroll") for (int n = 0; n < 2; ++n) _Pragma("unroll") for (int k = 0; k < 2; ++k) \
        acc[ai][bj][m][n] = __builtin_amdgcn_mfma_f32_16x16x32_bf16(Bt[n][k], At[m][k], acc[ai][bj][m][n], 0, 0, 0); __builtin_amdgcn_s_setprio(0); } while (0)
#define PG8_WAIT_V(n) asm volatile("s_waitcnt vmcnt(" #n ")" ::: "memory")
#define PG8_WAIT_L(n) asm volatile("s_waitcnt lgkmcnt(" #n ")" ::: "memory")
#define PG8_BAR __builtin_amdgcn_s_barrier()
#define PG8_SCHED __builtin_amdgcn_sched_barrier(0)
    Unit cur, nxt; int ui = 0;
    if (!S.next(0, cur)) return;
    f32x4 acc[2][2][4][2];
#pragma unroll
    for (int a = 0; a < 2; ++a)
#pragma unroll
        for (int b = 0; b < 2; ++b)
#pragma unroll
            for (int m = 0; m < 4; ++m)
#pragma unroll
                for (int n = 0; n < 2; ++n) acc[a][b][m][n] = (f32x4){0.f, 0.f, 0.f, 0.f};
    bf16x8 At[4][2], B0[2][2], B1[2][2];
    const char* cA = (const char*)g.A + (size_t)cur.pm * tstep; const char* cB = (const char*)g.Bt + (size_t)cur.pb * tstep;
    S.a_ready(cur);
    PG8_STAGE(PG8_SB(0, 0), cB, voffB); PG8_STAGE(PG8_SA(0, 0), cA, voffA); PG8_STAGE(PG8_SB(0, 1), cB + hstep, voffB); PG8_STAGE(PG8_SA(0, 1), cA + hstep, voffA);
    if (wr == 1) PG8_BAR;
    PG8_WAIT_V(4); PG8_BAR;
    PG8_STAGE(PG8_SB(1, 0), cB + kstep, voffB); PG8_STAGE(PG8_SA(1, 0), cA + kstep, voffA); PG8_STAGE(PG8_SB(1, 1), cB + hstep + kstep, voffB);
    PG8_WAIT_V(6); PG8_BAR;
    for (;;) {
        const bool has_next = S.next(ui + 1, nxt);
        const char* nA = has_next ? (const char*)g.A + (size_t)nxt.pm * tstep : cA; const char* nB = has_next ? (const char*)g.Bt + (size_t)nxt.pb * tstep : cB;
        for (int t = 0; t < nt; t += 2) {
            const bool last = (t == nt - 2);
            const char* a1 = cA + (size_t)(t + 1) * kstep;
            const char* a2 = last ? nA : cA + (size_t)(t + 2) * kstep; const char* b2 = last ? nB : cB + (size_t)(t + 2) * kstep;
            const char* a3 = a2 + kstep; const char* b3 = b2 + kstep;
            if (last && has_next) S.a_ready(nxt);
            PG8_LDB(B0, 0, 0); PG8_SCHED; PG8_LDA(At, 0, 0); PG8_STAGE(PG8_SA(1, 1), a1 + hstep, voffA);
            PG8_WAIT_L(8); PG8_BAR; PG8_WAIT_L(0); PG8_MMA(0, 0, At, B0); PG8_BAR; PG8_SCHED;
            PG8_LDB(B1, 0, 1); PG8_STAGE(PG8_SB(0, 0), b2, voffB);
            PG8_BAR; PG8_WAIT_L(0); PG8_MMA(0, 1, At, B1); PG8_BAR;
            PG8_LDA(At, 0, 1); PG8_STAGE(PG8_SA(0, 0), a2, voffA);
            PG8_BAR; PG8_WAIT_L(0); PG8_MMA(1, 0, At, B0); PG8_BAR; PG8_SCHED;
            PG8_STAGE(PG8_SB(0, 1), b2 + hstep, voffB);
            PG8_WAIT_V(6); PG8_BAR; PG8_MMA(1, 1, At, B1); PG8_BAR;
            PG8_LDB(B0, 1, 0); PG8_SCHED; PG8_LDA(At, 1, 0); PG8_STAGE(PG8_SA(0, 1), a2 + hstep, voffA);
            PG8_WAIT_L(8); PG8_BAR; PG8_WAIT_L(0); PG8_MMA(0, 0, At, B0); PG8_BAR; PG8_SCHED;
            PG8_LDB(B1, 1, 1); PG8_STAGE(PG8_SB(1, 0), b3, voffB);
            PG8_BAR; PG8_WAIT_L(0); PG8_MMA(0, 1, At, B1); PG8_BAR;
            PG8_LDA(At, 1, 1); PG8_STAGE(PG8_SA(1, 0), a3, voffA);
            PG8_BAR; PG8_WAIT_L(0); PG8_MMA(1, 0, At, B0); PG8_BAR; PG8_SCHED;
            PG8_STAGE(PG8_SB(1, 1), b3 + hstep, voffB);
            PG8_WAIT_V(6); PG8_BAR; PG8_MMA(1, 1, At, B1); PG8_BAR;
        }
        E(acc, cur, wr, wc, fr, fq); S.done(cur);
        if (!has_next) break;
#pragma unroll
        for (int a = 0; a < 2; ++a)
#pragma unroll
            for (int b = 0; b < 2; ++b)
#pragma unroll
                for (int m = 0; m < 4; ++m)
#pragma unroll
                    for (int n = 0; n < 2; ++n) acc[a][b][m][n] = (f32x4){0.f, 0.f, 0.f, 0.f};
        cur = nxt; cA = nA; cB = nB; ++ui;
    }
    PG8_WAIT_V(0);
    if (wr == 0) PG8_BAR;
    PG8_BAR;
#undef PG8_SA
#undef PG8_SB
#undef PG8_STAGE
#undef PG8_LDA
#undef PG8_LDB
#undef PG8_MMA
#undef PG8_WAIT_V
#undef PG8_WAIT_L
#undef PG8_BAR
#undef PG8_SCHED
}
}

constexpr int D = 1024, NB = 8, SEQ = 2048, CTXL = 256;
constexpr int ML = NB * SEQ;
constexpr int MC = NB * CTXL;
constexpr int MA = ML + MC;
constexpr int INW = 3584, FFN_H = 2816, EXP_H = 3584, NEXP = 8;
constexpr int NCH = 18;
constexpr int XG_ROWS = 34816;
constexpr int NWAVES = 8, NTHR = 512;

constexpr size_t MiB = 1u << 20;
constexpr size_t WS_CTL = 0, CTL_ZERO_BYTES = 1 * MiB;
constexpr size_t WS_MOD = 1 * MiB;
constexpr size_t WS_ROPE = 2 * MiB;
constexpr size_t WS_MISC = 3 * MiB;
constexpr size_t WS_W_IN = 4 * MiB, WS_W_OUT = 11 * MiB, WS_W_13 = 13 * MiB, WS_W_2 = 24 * MiB, WS_W_RKV = 30 * MiB, WS_W_L1 = 36 * MiB,
                 WS_W_L2 = 38 * MiB, WS_W_G2 = 40 * MiB, WS_W_O = 41 * MiB, WS_W_M13 = 43 * MiB, WS_W_M2 = 155 * MiB;
constexpr size_t WS_XC = 211 * MiB, WS_H = 219 * MiB, WS_MIX = 255 * MiB, WS_R = 291 * MiB;
constexpr size_t WS_QKV = WS_R, WS_KV = WS_R + 126 * MiB, WS_SPREV = WS_R + 198 * MiB, WS_FFH = WS_R;
constexpr size_t WS_XM = WS_R, WS_DEC = WS_R, WS_AG = WS_R + 144 * MiB, WS_RB = WS_R + 216 * MiB, WS_KB = WS_R + 248 * MiB, WS_VB = WS_R + 284 * MiB,
                 WS_L1 = WS_R + 320 * MiB, WS_LG = WS_R + 329 * MiB, WS_G = WS_R + 337 * MiB, WS_YF = WS_R + 369 * MiB, WS_YB = WS_R + 433 * MiB;
constexpr size_t WS_XG = WS_R, WS_HG = WS_R + 68 * MiB, WS_YS = WS_R + 306 * MiB, WS_ROWS = WS_R + 370 * MiB;
constexpr size_t WS_END = WS_R + 497 * MiB;
static_assert(WS_END <= 896 * MiB, "workspace map");
constexpr int CW_BAR = 4096;
constexpr size_t MISC_TOPE = 0, MISC_TOPW = 65536, MISC_CNTS = 196608, MISC_EXP = 204800;

constexpr int LDS_MAIN = 147456;
constexpr int LDS_MISC_OFF = LDS_MAIN;
constexpr int LDS_BYTES = LDS_MAIN + 256;

typedef unsigned short bf16;
typedef short bf16x8 __attribute__((ext_vector_type(8)));
typedef short s16x4 __attribute__((ext_vector_type(4)));
typedef float f32x4 __attribute__((ext_vector_type(4)));
typedef float f32x2 __attribute__((ext_vector_type(2)));
typedef unsigned u32x4 __attribute__((ext_vector_type(4)));
typedef unsigned u32x2 __attribute__((ext_vector_type(2)));
#define LDS_WAIT() asm volatile("s_waitcnt lgkmcnt(0)" ::: "memory")
#define VM_WAIT() asm volatile("s_waitcnt vmcnt(0)" ::: "memory")
#define WG_SYNC() __syncthreads()
DI unsigned f2bf(float f) { unsigned u = __builtin_bit_cast(unsigned, f); return (u + 0x7fffu + ((u >> 16) & 1u)) >> 16; }
DI unsigned pk2(float lo, float hi) { return f2bf(lo) | (f2bf(hi) << 16); }
DI float bflo(unsigned w) { return __builtin_bit_cast(float, w << 16); }
DI float bfhi(unsigned w) { return __builtin_bit_cast(float, w & 0xffff0000u); }
DI float bf1(bf16 b) { return __builtin_bit_cast(float, (unsigned)b << 16); }
DI float wave_sum(float v) {
#pragma unroll
    for (int o = 1; o < 64; o <<= 1) v += __shfl_xor(v, o);
    return v;
}
DI float wave_max(float v) {
#pragma unroll
    for (int o = 1; o < 64; o <<= 1) v = fmaxf(v, __shfl_xor(v, o));
    return v;
}
DI float dpp_x1(float v) { return __builtin_bit_cast(float, __builtin_amdgcn_update_dpp(0, __builtin_bit_cast(int, v), 0xB1, 0xf, 0xf, true)); }
DI float dpp_x2(float v) { return __builtin_bit_cast(float, __builtin_amdgcn_update_dpp(0, __builtin_bit_cast(int, v), 0x4E, 0xf, 0xf, true)); }
DI float dpp_hm(float v) { return __builtin_bit_cast(float, __builtin_amdgcn_update_dpp(0, __builtin_bit_cast(int, v), 0x141, 0xf, 0xf, true)); }
DI float red4(float v) { v += dpp_x1(v); v += dpp_x2(v); return v; }
DI float red8(float v) { v += dpp_x1(v); v += dpp_x2(v); v += dpp_hm(v); return v; }
DI float sigmoidf_(float x) { return 1.f / (1.f + __expf(-x)); }
DI float siluf_(float x) { return x / (1.f + __expf(-x)); }

DI bf16x8 frag_kc(const LAS bf16* base, int ld, int row0, int k0, int lane) {
    return *(const LAS bf16x8*)(base + (row0 + (lane & 15)) * ld + k0 + 8 * (lane >> 4));
}
DI bf16x8 frag_kr(const LAS bf16* base, int ld, int x0, int k0, int lane) {
    const int g = lane >> 4, q = (lane & 15) >> 2, p = lane & 3;
    const LAS bf16* a = base + (k0 + 8 * g + q) * ld + x0 + 4 * p;
    const s16x4 lo = __builtin_amdgcn_ds_read_tr16_b64_v4i16((LAS s16x4*)a);
    const s16x4 hi = __builtin_amdgcn_ds_read_tr16_b64_v4i16((LAS s16x4*)(a + 4 * ld));
    return __builtin_shufflevector(lo, hi, 0, 1, 2, 3, 4, 5, 6, 7);
}
DI f32x4 mma(f32x4 acc, bf16x8 bfrag, bf16x8 afrag) { return __builtin_amdgcn_mfma_f32_16x16x32_bf16(bfrag, afrag, acc, 0, 0, 0); }

#define XB_TMO      128
#define XB_XCNT(j)  (256  + 64 * (j))
#define XB_XSUB(j)  (1280 + 64 * (j))
#define XB_XGEN(j)  (2304 + 64 * (j))
#define XB_TOP      3328
#define XB_TOPGEN   3392
#define XCD_BAR_WORDS 3456
#define XB_SPIN_CAP (1u << 18)
DI unsigned xb_ld(unsigned* p)              { return __hip_atomic_load(p, __ATOMIC_RELAXED, __HIP_MEMORY_SCOPE_AGENT); }
DI unsigned xb_add(unsigned* p, unsigned v) { return __hip_atomic_fetch_add(p, v, __ATOMIC_RELAXED, __HIP_MEMORY_SCOPE_AGENT); }
DI unsigned xb_xcc_id() { return (unsigned)__builtin_amdgcn_s_getreg((3 << 11) | 20) & 0xFu; }
#define XB_SPIN(cond, bar) do { unsigned _sp = 0; while (cond) { __builtin_amdgcn_s_sleep(1); \
    if ((++_sp & 255u) == 0u) { if (xb_ld(&(bar)[XB_TMO])) break; if (_sp > XB_SPIN_CAP) { atomicAdd(&(bar)[XB_TMO], 1u); break; } } } } while (0)
struct XcdBarrier { unsigned* bar; unsigned x; volatile LAS unsigned* st; };
DI XcdBarrier xcd_barrier_post(unsigned* bar, volatile LAS unsigned* st) {
    XcdBarrier b; b.bar = bar; b.x = xb_xcc_id(); b.st = st;
    if (threadIdx.x == 0) (void)xb_add(&bar[XB_XCNT(b.x)], 1u);
    return b;
}
DI void xcd_barrier_complete(unsigned* bar, unsigned x, unsigned& nloc, unsigned& nx) {
    const unsigned G = gridDim.x * gridDim.y * gridDim.z;
    unsigned sum, cnt, mine, sp = 0u;
    for (;;) {
        sum = 0u; cnt = 0u; mine = 0u;
#pragma unroll
        for (unsigned j = 0; j < 16; ++j) { const unsigned c = xb_ld(&bar[XB_XCNT(j)]); sum += c; cnt += (c > 0u) ? 1u : 0u; mine = (j == x) ? c : mine; }
        if (sum == G) break;
        __builtin_amdgcn_s_sleep(1);
        if ((++sp & 255u) == 0u) { if (xb_ld(&bar[XB_TMO])) break; if (sp > XB_SPIN_CAP) { atomicAdd(&bar[XB_TMO], 1u); break; } }
    }
    nloc = mine > 0u ? mine : 1u; nx = cnt > 0u ? cnt : 1u;
}
DI void xcd_barrier(const XcdBarrier& b) {
    asm volatile("s_waitcnt vmcnt(0)" ::: "memory");
    __syncthreads();
    if (threadIdx.x == 0) {
        unsigned* bar = b.bar;
        __builtin_amdgcn_s_waitcnt(0);
        unsigned nloc = b.st[0], nx = b.st[1];
        if (nloc == 0u) { xcd_barrier_complete(bar, b.x, nloc, nx); b.st[0] = nloc; b.st[1] = nx; }
        const unsigned old = xb_add(&bar[XB_XSUB(b.x)], 1u);
        const unsigned gen = old / nloc;
        if (old + 1u == (gen + 1u) * nloc) {
            __builtin_amdgcn_fence(__ATOMIC_RELEASE, "agent");
            asm volatile("s_waitcnt vmcnt(0)" ::: "memory");
            const unsigned og = xb_add(&bar[XB_TOP], 1u);
            const unsigned tg = og / nx;
            if (og + 1u == (tg + 1u) * nx) xb_add(&bar[XB_TOPGEN], 1u);
            else XB_SPIN(xb_ld(&bar[XB_TOPGEN]) == tg, bar);
            __builtin_amdgcn_fence(__ATOMIC_ACQUIRE, "agent");
            xb_add(&bar[XB_XGEN(b.x)], 1u);
            asm volatile("s_waitcnt vmcnt(0)" ::: "memory");
        } else {
            XB_SPIN(xb_ld(&bar[XB_XGEN(b.x)]) == gen, bar);
            __builtin_amdgcn_fence(__ATOMIC_ACQUIRE, "agent");
            asm volatile("s_waitcnt vmcnt(0)" ::: "memory");
        }
    }
    __syncthreads();
}

struct Fr {
    LAS unsigned char* lds;
    unsigned char* ws;
    const float* const* in;
    float* out;
    int tid, lane, wave, bx, G, gw, NGW;
};

using pg8::Unit;
template <int ACT  > struct EpiStore {
    static constexpr bool PERM = true;
    bf16* O; int ldc; int nvalid;
    DI void operator()(const f32x4 (&acc)[2][2][4][2], const Unit& u, int wr, int wc, int fr, int fq) const {
        const int row0 = u.pm * 256 + wr * 64 + fr, col0 = u.pn * 256 + wc * 32 + 8 * fq;
#pragma unroll
        for (int ai = 0; ai < 2; ++ai)
#pragma unroll
            for (int m = 0; m < 4; ++m) { bf16* rowp = O + (size_t)(row0 + ai * 128 + m * 16) * ldc + col0;
#pragma unroll
                for (int bj = 0; bj < 2; ++bj) { if (u.pn * 256 + bj * 128 >= nvalid) continue;
                    f32x4 v0 = acc[ai][bj][m][0], v1 = acc[ai][bj][m][1];
                    if (ACT == 1) {
#pragma unroll
                        for (int j = 0; j < 4; ++j) { v0[j] = tanhf(v0[j]); v1[j] = tanhf(v1[j]); } }
                    if (ACT == 2) {
#pragma unroll
                        for (int j = 0; j < 4; ++j) { v0[j] = sigmoidf_(v0[j]); v1[j] = sigmoidf_(v1[j]); } }
                    u32x4 w; w.x = pg8::cvt_pk_bf16(v0[0], v0[1]); w.y = pg8::cvt_pk_bf16(v0[2], v0[3]); w.z = pg8::cvt_pk_bf16(v1[0], v1[1]); w.w = pg8::cvt_pk_bf16(v1[2], v1[3]);
                    *(u32x4*)(rowp + bj * 128) = w; } }
    }
};
struct EpiResid {
    static constexpr bool PERM = false;
    const float* baseL; float* outL; const float* baseC; float* outC; const float* modg;
    DI void operator()(const f32x4 (&acc)[2][2][4][2], const Unit& u, int wr, int wc, int fr, int fq) const {
        const bool lat = u.pm < 64; const int r = lat ? (u.pm >> 3) : 8;
        const float* base = lat ? baseL : baseC; float* out = lat ? outL : outC;
        const int row0 = (lat ? u.pm : u.pm - 64) * 256 + wr * 64 + fr, col0 = u.pn * 256 + wc * 32 + 4 * fq;
        const float* mg = modg + (size_t)r * 6144 + col0;
        f32x4 mv[2][2];
#pragma unroll
        for (int bj = 0; bj < 2; ++bj)
#pragma unroll
            for (int n = 0; n < 2; ++n) mv[bj][n] = *(const f32x4*)(mg + bj * 128 + n * 16);
#pragma unroll
        for (int ai = 0; ai < 2; ++ai)
#pragma unroll
            for (int m = 0; m < 4; ++m) { const size_t off = (size_t)(row0 + ai * 128 + m * 16) * D + col0;
#pragma unroll
                for (int bj = 0; bj < 2; ++bj)
#pragma unroll
                    for (int n = 0; n < 2; ++n) { const f32x4 bs = *(const f32x4*)(base + off + bj * 128 + n * 16);
                        *(f32x4*)(out + off + bj * 128 + n * 16) = bs + mv[bj][n] * acc[ai][bj][m][n]; } }
    }
};
struct EpiSwiglu {
    static constexpr bool PERM = true;
    bf16* Hd; int ldh;
    DI void operator()(const f32x4 (&acc)[2][2][4][2], const Unit& u, int wr, int wc, int fr, int fq) const {
        const int row0 = u.pm * 256 + wr * 64 + fr, col0 = u.pn * 128 + wc * 32 + 8 * fq;
#pragma unroll
        for (int ai = 0; ai < 2; ++ai)
#pragma unroll
            for (int m = 0; m < 4; ++m) { bf16* rowp = Hd + (size_t)(row0 + ai * 128 + m * 16) * ldh + col0;
                f32x4 v0, v1;
#pragma unroll
                for (int j = 0; j < 4; ++j) { v0[j] = siluf_(acc[ai][0][m][0][j]) * acc[ai][1][m][0][j]; v1[j] = siluf_(acc[ai][0][m][1][j]) * acc[ai][1][m][1][j]; }
                u32x4 w; w.x = pg8::cvt_pk_bf16(v0[0], v0[1]); w.y = pg8::cvt_pk_bf16(v0[2], v0[3]); w.z = pg8::cvt_pk_bf16(v1[0], v1[1]); w.w = pg8::cvt_pk_bf16(v1[2], v1[3]);
                *(u32x4*)rowp = w; }
    }
};
struct EpiLora2 {
    static constexpr bool PERM = true;
    float* DEC; bf16* AG; const float* w0; const float* a0;
    DI void operator()(const f32x4 (&acc)[2][2][4][2], const Unit& u, int wr, int wc, int fr, int fq) const {
        const int q = u.pn >> 2, z = q & 1; const int row0 = u.pm * 256 + wr * 64 + fr, col0 = (u.pn & 3) * 256 + wc * 32 + 8 * fq;
        const float* bias = (q < 2 ? w0 : a0) + z * 1024 + col0;
        f32x4 bv[2][2];
#pragma unroll
        for (int bj = 0; bj < 2; ++bj)
#pragma unroll
            for (int n = 0; n < 2; ++n) bv[bj][n] = *(const f32x4*)(bias + bj * 128 + 4 * n);
#pragma unroll
        for (int ai = 0; ai < 2; ++ai)
#pragma unroll
            for (int m = 0; m < 4; ++m) { const size_t off = ((size_t)z * MA + (row0 + ai * 128 + m * 16)) * D + col0;
#pragma unroll
                for (int bj = 0; bj < 2; ++bj) { f32x4 v0 = acc[ai][bj][m][0] + bv[bj][0], v1 = acc[ai][bj][m][1] + bv[bj][1];
                    if (q < 2) {
#pragma unroll
                        for (int j = 0; j < 4; ++j) {
                            v0[j] = __expf(-0.6065306597126334f * sigmoidf_(v0[j])); v1[j] = __expf(-0.6065306597126334f * sigmoidf_(v1[j])); }
                        *(f32x4*)(DEC + off + bj * 128) = v0; *(f32x4*)(DEC + off + bj * 128 + 4) = v1;
                        __builtin_amdgcn_sched_barrier(0);
                    } else {
#pragma unroll
                        for (int j = 0; j < 4; ++j) { v0[j] = sigmoidf_(v0[j]); v1[j] = sigmoidf_(v1[j]); }
                        u32x4 w; w.x = pg8::cvt_pk_bf16(v0[0], v0[1]); w.y = pg8::cvt_pk_bf16(v0[2], v0[3]); w.z = pg8::cvt_pk_bf16(v1[0], v1[1]); w.w = pg8::cvt_pk_bf16(v1[2], v1[3]);
                        *(u32x4*)(AG + off + bj * 128) = w; __builtin_amdgcn_sched_barrier(0); } } }
    }
};
struct EpiMoeOut {
    static constexpr bool PERM = true;
    bf16* YS; const int* RowTok; const float* RowW;
    DI void operator()(const f32x4 (&acc)[2][2][4][2], const Unit& u, int wr, int wc, int fr, int fq) const {
        const int row0 = u.pm * 256 + wr * 64 + fr, col0 = u.pn * 256 + wc * 32 + 8 * fq;
#pragma unroll
        for (int ai = 0; ai < 2; ++ai)
#pragma unroll
            for (int m = 0; m < 4; ++m) { const int row = row0 + ai * 128 + m * 16; const int t2 = RowTok[row]; if (t2 < 0) continue; const float w = RowW[row];
                bf16* rowp = YS + (size_t)t2 * D + col0;
#pragma unroll
                for (int bj = 0; bj < 2; ++bj) { const f32x4 v0 = acc[ai][bj][m][0] * w, v1 = acc[ai][bj][m][1] * w;
                    u32x4 o; o.x = pg8::cvt_pk_bf16(v0[0], v0[1]); o.y = pg8::cvt_pk_bf16(v0[2], v0[3]); o.z = pg8::cvt_pk_bf16(v1[0], v1[1]); o.w = pg8::cvt_pk_bf16(v1[2], v1[3]);
                    *(u32x4*)(rowp + bj * 128) = o; } }
    }
};

DI void tr_item(const float* src, int ldsrc, int Kreal, int k0, int n0, bf16* dst, int lddst, int drow0, int dcol0, LAS float* scr, int lane) {
#pragma unroll 8
    for (int i = 0; i < 32; ++i) { const int kk = 2 * i + (lane >> 5), k = k0 + kk; float v = 0.f; if (k < Kreal) v = src[(size_t)k * ldsrc + n0 + (lane & 31)]; scr[kk * 33 + (lane & 31)] = v; }
    LDS_WAIT();
    const int c = lane & 7;
#pragma unroll
    for (int j = 0; j < 4; ++j) { const int n = (lane >> 3) + 8 * j; const LAS float* s = scr + (8 * c) * 33 + n;
        u32x4 o; o.x = pk2(s[0 * 33], s[1 * 33]); o.y = pk2(s[2 * 33], s[3 * 33]); o.z = pk2(s[4 * 33], s[5 * 33]); o.w = pk2(s[6 * 33], s[7 * 33]);
        *(u32x4*)(dst + (size_t)(drow0 + n) * lddst + dcol0 + k0 + 8 * c) = o; }
    LDS_WAIT();
}
DI void tr_plain(const float* src, int K, int N, bf16* dst, int r, LAS float* scr, int lane) {
    const int nblk = N / 32, kb = r / nblk, nb = r % nblk; tr_item(src, N, K, 64 * kb, 32 * nb, dst, K, 32 * nb, 0, scr, lane);
}
DI void tr_gateup(const float* src, int K, int Hh, bf16* dst, int r, LAS float* scr, int lane) {
    const int nblk = 2 * Hh / 32, kb = r / nblk, nb = r % nblk, n0 = 32 * nb, half = n0 / Hh, j0 = n0 % Hh;
    tr_item(src, 2 * Hh, K, 64 * kb, n0, dst, K, (j0 / 128) * 256 + half * 128 + (j0 % 128), 0, scr, lane);
}
DI void p0_prologue(Fr& F) {
    LAS float* scr = (LAS float*)(F.lds + F.wave * 16384);
    const float* const* in = F.in;
    bf16* W_IN = (bf16*)(F.ws + WS_W_IN); bf16* W_OUT = (bf16*)(F.ws + WS_W_OUT); bf16* W_13 = (bf16*)(F.ws + WS_W_13); bf16* W_2 = (bf16*)(F.ws + WS_W_2);
    bf16* W_RKV = (bf16*)(F.ws + WS_W_RKV); bf16* W_L1 = (bf16*)(F.ws + WS_W_L1); bf16* W_L2 = (bf16*)(F.ws + WS_W_L2); bf16* W_G2 = (bf16*)(F.ws + WS_W_G2);
    bf16* W_O = (bf16*)(F.ws + WS_W_O); bf16* W_M13 = (bf16*)(F.ws + WS_W_M13); bf16* W_M2 = (bf16*)(F.ws + WS_W_M2);
    constexpr int I_IN = 16 * 112, I_OUT = 16 * 32, I_13 = 16 * 176, I_2 = 44 * 32, I_RKV = 3 * 512, I_W1 = 2 * 32, I_A1 = 2 * 32, I_G1 = 16 * 5, I_L2 = 4 * 32, I_G2 = 4 * 32,
                  I_O = 512, I_M13 = 8 * 16 * 224, I_M2 = 8 * 56 * 32;
    constexpr int NITEMS = I_IN + I_OUT + I_13 + I_2 + I_RKV + I_W1 + I_A1 + I_G1 + I_L2 + I_G2 + I_O + I_M13 + I_M2;
    for (int it = F.gw; it < NITEMS; it += F.NGW) {
        int r = it;
        if (r < I_M13) { const int e = r / (16 * 224); tr_gateup(in[35] + (size_t)e * 1024 * 7168, 1024, EXP_H, W_M13 + (size_t)e * 7168 * 1024, r % (16 * 224), scr, F.lane); continue; } r -= I_M13;
        if (r < I_M2) { const int e = r / (56 * 32); tr_plain(in[36] + (size_t)e * EXP_H * 1024, EXP_H, 1024, W_M2 + (size_t)e * 1024 * EXP_H, r % (56 * 32), scr, F.lane); continue; } r -= I_M2;
        if (r < I_IN) { tr_plain(in[8], 1024, INW, W_IN, r, scr, F.lane); continue; } r -= I_IN;
        if (r < I_OUT) { tr_plain(in[15], 1024, 1024, W_OUT, r, scr, F.lane); continue; } r -= I_OUT;
        if (r < I_13) { tr_gateup(in[16], 1024, FFN_H, W_13, r, scr, F.lane); continue; } r -= I_13;
        if (r < I_2) { tr_plain(in[17], FFN_H, 1024, W_2, r, scr, F.lane); continue; } r -= I_2;
        if (r < I_RKV) { const int s = r / 512; tr_plain(in[19] + (size_t)s * 1024 * 1024, 1024, 1024, W_RKV + (size_t)s * 1024 * 1024, r % 512, scr, F.lane); continue; } r -= I_RKV;
        if (r < I_W1) { const int z = r / 32, rr = r % 32; tr_item(in[21] + (size_t)z * 1024 * 64, 64, 1024, 64 * (rr / 2), 32 * (rr % 2), W_L1, 1024, z * 64 + 32 * (rr % 2), 0, scr, F.lane); continue; } r -= I_W1;
        if (r < I_A1) { const int z = r / 32, rr = r % 32; tr_item(in[24] + (size_t)z * 1024 * 64, 64, 1024, 64 * (rr / 2), 32 * (rr % 2), W_L1 + 256 * 1024, 1024, z * 64 + 32 * (rr % 2), 0, scr, F.lane); continue; } r -= I_A1;
        if (r < I_G1) { tr_item(in[26], 160, 1024, 64 * (r / 5), 32 * (r % 5), W_L1 + 2 * 256 * 1024, 1024, 32 * (r % 5), 0, scr, F.lane); continue; } r -= I_G1;
        if (r < I_L2) { const int q = r / 32, nb = r % 32; const float* src = (q < 2 ? in[22] : in[25]) + (size_t)(q & 1) * 64 * 1024;
            for (int i = F.lane; i < 32 * 24; i += 64) { const int row = i / 24, ch = i % 24; const int col = 8 * ch + (8 * ch >= q * 64 ? 64 : 0);
                *(u32x4*)(W_L2 + (size_t)(q * 1024 + 32 * nb + row) * 256 + col) = (u32x4){0u, 0u, 0u, 0u}; }
            tr_item(src, 1024, 64, 0, 32 * nb, W_L2, 256, q * 1024 + 32 * nb, q * 64, scr, F.lane); continue; } r -= I_L2;
        if (r < I_G2) { tr_item(in[27], 1024, 160, 64 * (r / 32), 32 * (r % 32), W_G2, 256, 32 * (r % 32), 0, scr, F.lane); continue; } r -= I_G2;
        tr_plain(in[33], 1024, 1024, W_O, r, scr, F.lane);
    }
    { const int gt = F.bx * NTHR + F.tid, NT = F.G * NTHR;
      for (int i = gt; i < (128 + 128 + 96) * 128; i += NT) { int row = i / 128; const int ch = i % 128; int mat = 0;
          if (row >= 256) { mat = 2; row = row - 256 + 160; } else if (row >= 128) { mat = 1; } else { row += 128; }
          *(u32x4*)(W_L1 + ((size_t)mat * 256 + row) * 1024 + 8 * ch) = (u32x4){0u, 0u, 0u, 0u}; }
      f32x2* rope = (f32x2*)(F.ws + WS_ROPE);
      for (int i = gt; i < 2048; i += NT) { const int pos = i >> 5, j = i & 31; const float fr = powf(10000.f, -(float)j / 32.f), ang = (float)pos * fr; rope[i] = (f32x2){cosf(ang), sinf(ang)}; }
    }
    WG_SYNC();
    for (int u = F.bx; u < 192; u += F.G) {
        const int li = u / 96, n0 = (u % 96) * 64;
        LAS float* sm = (LAS float*)F.lds;
        for (int idx = F.tid; idx < 9 * 1024; idx += NTHR) { const int r = idx >> 10, k = idx & 1023; const float cv = (r < 8) ? in[1][r * 1024 + k] : in[3][k]; sm[idx] = cv / (1.f + expf(-cv)); }
        WG_SYNC();
        const int kq = F.tid >> 6, nn = F.tid & 63;
        float acc[9];
#pragma unroll
        for (int r = 0; r < 9; ++r) acc[r] = 0.f;
        const float* w = in[4] + (size_t)li * 1024 * 6144 + n0 + nn;
#pragma unroll 4
        for (int k = kq * 128; k < kq * 128 + 128; ++k) { const float wv = w[(size_t)k * 6144];
#pragma unroll
            for (int r = 0; r < 9; ++r) acc[r] += sm[r * 1024 + k] * wv; }
        LAS float* red = sm + 9 * 1024;
#pragma unroll
        for (int r = 0; r < 9; ++r) red[(kq * 9 + r) * 64 + nn] = acc[r];
        WG_SYNC();
        float* MOD = (float*)(F.ws + WS_MOD);
        for (int idx = F.tid; idx < 9 * 64; idx += NTHR) { const int r = idx / 64, n2 = idx % 64; float s = 0.f;
#pragma unroll
            for (int q = 0; q < 8; ++q) s += red[(q * 9 + r) * 64 + n2];
            MOD[((size_t)li * 9 + r) * 6144 + n0 + n2] = s + in[5][li * 6144 + n0 + n2]; }
        WG_SYNC();
    }
}

DI void mod_rows(Fr& F, const float* xl, const float* xc, int nrows, const float* normw, const float* modl, int off_shift, int off_scale, bf16* H) {
    for (int row = F.gw; row < nrows; row += F.NGW) {
        const float* src = row < ML ? xl + (size_t)row * D : xc + (size_t)(row - ML) * D;
        const float* mrow = modl + (size_t)(row < ML ? row / SEQ : 8) * 6144;
        f32x4 v[4]; float ss = 0.f;
#pragma unroll
        for (int j = 0; j < 4; ++j) { v[j] = ((const f32x4*)src)[F.lane + 64 * j]; ss += (v[j].x * v[j].x + v[j].y * v[j].y) + (v[j].z * v[j].z + v[j].w * v[j].w); }
        const float rstd = rsqrtf(wave_sum(ss) * (1.f / D) + 1e-6f);
        u32x2* o = (u32x2*)(H + (size_t)row * D);
#pragma unroll
        for (int j = 0; j < 4; ++j) { const int c4 = F.lane + 64 * j;
            const f32x4 w = ((const f32x4*)normw)[c4], sc = ((const f32x4*)(mrow + off_scale))[c4], sh = ((const f32x4*)(mrow + off_shift))[c4];
            const f32x4 y = v[j] * rstd * w * (sc + 1.f) + sh;
            u32x2 p; p.x = pk2(y.x, y.y); p.y = pk2(y.z, y.w); o[c4] = p; }
    }
}

DI void load_rope_pair(const bf16* rowp, int hh, int jj, bool lat, int rpos, int cpos, const f32x2* rope, float scl, float (&x1)[8], float (&x2)[8]) {
    const u32x4 a = *(const u32x4*)(rowp + hh * 64 + jj), b = *(const u32x4*)(rowp + hh * 64 + jj + 32);
    const unsigned aw[4] = {a.x, a.y, a.z, a.w}, bw[4] = {b.x, b.y, b.z, b.w};
#pragma unroll
    for (int i = 0; i < 4; ++i) { x1[2 * i] = bflo(aw[i]); x1[2 * i + 1] = bfhi(aw[i]); x2[2 * i] = bflo(bw[i]); x2[2 * i + 1] = bfhi(bw[i]); }
    if (lat) { const int pos = hh ? cpos : rpos;
#pragma unroll
        for (int i = 0; i < 8; ++i) { const f32x2 cs = rope[pos * 32 + jj + i]; const float y1 = x1[i] * cs.x - x2[i] * cs.y, y2 = x1[i] * cs.y + x2[i] * cs.x; x1[i] = y1; x2[i] = y2; } }
#pragma unroll
    for (int i = 0; i < 8; ++i) { x1[i] *= scl; x2[i] *= scl; }
}
DI u32x4 pack8(const float (&x)[8], float s) { u32x4 o; o.x = pk2(x[0] * s, x[1] * s); o.y = pk2(x[2] * s, x[3] * s); o.z = pk2(x[4] * s, x[5] * s); o.w = pk2(x[6] * s, x[7] * s); return o; }
constexpr int RLD = 136;
constexpr int RTILE = 128 * RLD * 2;
DI int ret_row0(int b, int id) { return id < 2 ? ML + b * CTXL + id * 128 : b * SEQ + (id - 2) * 128; }

DI void ret_kv_phase(Fr& F) {
    const bf16* QKV = (const bf16*)(F.ws + WS_QKV); float* KV = (float*)(F.ws + WS_KV); const f32x2* rope = (const f32x2*)(F.ws + WS_ROPE);
    LAS bf16* Vs = (LAS bf16*)F.lds; LAS bf16* Kf = (LAS bf16*)(F.lds + RTILE); LAS bf16* Kb = (LAS bf16*)(F.lds + 2 * RTILE);
    const int wr2 = F.wave >> 1, wc2 = F.wave & 1, fr = F.lane & 15, fq = F.lane >> 4;
    for (int u = F.bx; u < NB * 4 * NCH; u += F.G) {
        const int b = u / (4 * NCH), h = (u / NCH) % 4, id = u % NCH; const int grow0 = ret_row0(b, id); const bool lat = id >= 2;
        const float lgf = -expf(F.in[9][h]), lgb = -expf(F.in[10][h]);
        for (int it = F.tid; it < 128 * 16; it += NTHR) { const int c = it >> 4, ch = it & 15;
            *(LAS u32x4*)(Vs + c * RLD + 8 * ch) = *(const u32x4*)(QKV + (size_t)(grow0 + c) * INW + 1024 + h * 128 + 8 * ch); }
        for (int it = F.tid; it < 128 * 8; it += NTHR) { const int c = it >> 3, pi = it & 7, hh = pi >> 2, jj = (pi & 3) * 8; const int t = (id - 2) * 128 + c;
            float x1[8], x2[8]; load_rope_pair(QKV + (size_t)(grow0 + c) * INW + 512 + h * 128, hh, jj, lat, t >> 6, t & 63, rope, 0.08838834764831845f, x1, x2);
            const float wf = expf(lgf * (float)(127 - c)), wb = expf(lgb * (float)c);
            *(LAS u32x4*)(Kf + c * RLD + hh * 64 + jj) = pack8(x1, wf); *(LAS u32x4*)(Kf + c * RLD + hh * 64 + jj + 32) = pack8(x2, wf);
            *(LAS u32x4*)(Kb + c * RLD + hh * 64 + jj) = pack8(x1, wb); *(LAS u32x4*)(Kb + c * RLD + hh * 64 + jj + 32) = pack8(x2, wb); }
        WG_SYNC();
#pragma unroll
        for (int dir = 0; dir < 2; ++dir) {
            const LAS bf16* Kd = dir ? Kb : Kf;
            f32x4 acc[2][4];
#pragma unroll
            for (int i = 0; i < 2; ++i)
#pragma unroll
                for (int j = 0; j < 4; ++j) acc[i][j] = (f32x4){0.f, 0.f, 0.f, 0.f};
#pragma unroll 1
            for (int k0 = 0; k0 < 128; k0 += 32) { bf16x8 af[2], bfg[4];
#pragma unroll
                for (int i = 0; i < 2; ++i) af[i] = frag_kr(Vs, RLD, 32 * wr2 + 16 * i, k0, F.lane);
#pragma unroll
                for (int j = 0; j < 4; ++j) bfg[j] = frag_kr(Kd, RLD, 64 * wc2 + 16 * j, k0, F.lane);
#pragma unroll
                for (int i = 0; i < 2; ++i)
#pragma unroll
                    for (int j = 0; j < 4; ++j) acc[i][j] = mma(acc[i][j], bfg[j], af[i]); }
            float* o = KV + ((size_t)((b * 4 + h) * 2 + dir) * NCH + id) * 16384;
#pragma unroll
            for (int i = 0; i < 2; ++i)
#pragma unroll
                for (int j = 0; j < 4; ++j) *(f32x4*)(o + (32 * wr2 + 16 * i + fr) * 128 + 64 * wc2 + 16 * j + 4 * fq) = acc[i][j];
        }
        WG_SYNC();
    }
}
DI void ret_prefix_phase(Fr& F) {
    const float* KV = (const float*)(F.ws + WS_KV); bf16* SP = (bf16*)(F.ws + WS_SPREV);
    const int gt = F.bx * NTHR + F.tid, NT = F.G * NTHR;
    for (int i = gt; i < 64 * 4096; i += NT) { const int bhd = i >> 12, e4 = i & 4095, dir = bhd & 1, h = (bhd >> 1) & 3;
        const float lg = -expf(dir ? F.in[10][h] : F.in[9][h]), cd = expf(lg * 128.f);
        f32x4 s = (f32x4){0.f, 0.f, 0.f, 0.f};
        for (int st = 0; st < NCH; ++st) { const int id = dir ? (st == 0 ? 1 : (st == 1 ? 0 : 19 - st)) : st;
            const size_t off = ((size_t)bhd * NCH + id) * 16384 + 4 * e4;
            u32x2 p; p.x = pk2(s.x, s.y); p.y = pk2(s.z, s.w); *(u32x2*)(SP + off) = p;
            s = s * cd + *(const f32x4*)(KV + off); }
    }
}
DI void ret_out_phase(Fr& F) {
    const bf16* QKV = (const bf16*)(F.ws + WS_QKV); const bf16* SP = (const bf16*)(F.ws + WS_SPREV); bf16* MIX = (bf16*)(F.ws + WS_MIX); const f32x2* rope = (const f32x2*)(F.ws + WS_ROPE);
    LAS bf16* Qs = (LAS bf16*)F.lds; LAS bf16* KP = (LAS bf16*)(F.lds + RTILE); LAS bf16* Vs = (LAS bf16*)(F.lds + 2 * RTILE); LAS bf16* Sf = (LAS bf16*)(F.lds + 3 * RTILE);
    LAS float* red = (LAS float*)(F.lds + 4 * RTILE);
    const int wr2 = F.wave >> 1, wc2 = F.wave & 1, fr = F.lane & 15, fq = F.lane >> 4;
    for (int u = F.bx; u < NB * 4 * NCH; u += F.G) {
        const int b = u / (4 * NCH), h = (u / NCH) % 4, id = u % NCH; const int grow0 = ret_row0(b, id); const bool lat = id >= 2;
        const float lgf = -expf(F.in[9][h]), lgb = -expf(F.in[10][h]);
        const bf16* spf = SP + ((size_t)((b * 4 + h) * 2 + 0) * NCH + id) * 16384; const bf16* spb = SP + ((size_t)((b * 4 + h) * 2 + 1) * NCH + id) * 16384;
        for (int it = F.tid; it < 128 * 16; it += NTHR) { const int c = it >> 4, ch = it & 15;
            *(LAS u32x4*)(Vs + c * RLD + 8 * ch) = *(const u32x4*)(QKV + (size_t)(grow0 + c) * INW + 1024 + h * 128 + 8 * ch);
            *(LAS u32x4*)(Sf + c * RLD + 8 * ch) = *(const u32x4*)(spf + c * 128 + 8 * ch); }
        for (int it = F.tid; it < 128 * 8; it += NTHR) { const int c = it >> 3, pi = it & 7, hh = pi >> 2, jj = (pi & 3) * 8; const int t = (id - 2) * 128 + c;
            float x1[8], x2[8];
            load_rope_pair(QKV + (size_t)(grow0 + c) * INW + h * 128, hh, jj, lat, t >> 6, t & 63, rope, 1.f, x1, x2);
            *(LAS u32x4*)(Qs + c * RLD + hh * 64 + jj) = pack8(x1, 1.f); *(LAS u32x4*)(Qs + c * RLD + hh * 64 + jj + 32) = pack8(x2, 1.f);
            load_rope_pair(QKV + (size_t)(grow0 + c) * INW + 512 + h * 128, hh, jj, lat, t >> 6, t & 63, rope, 0.08838834764831845f, x1, x2);
            *(LAS u32x4*)(KP + c * RLD + hh * 64 + jj) = pack8(x1, 1.f); *(LAS u32x4*)(KP + c * RLD + hh * 64 + jj + 32) = pack8(x2, 1.f); }
        WG_SYNC();
        f32x4 sacc[2][4], facc[2][4];
#pragma unroll
        for (int i = 0; i < 2; ++i)
#pragma unroll
            for (int j = 0; j < 4; ++j) { sacc[i][j] = (f32x4){0.f, 0.f, 0.f, 0.f}; facc[i][j] = (f32x4){0.f, 0.f, 0.f, 0.f}; }
#pragma unroll 1
        for (int k0 = 0; k0 < 128; k0 += 32) { bf16x8 af[2], bk[4], bs[4];
#pragma unroll
            for (int i = 0; i < 2; ++i) af[i] = frag_kc(Qs, RLD, 32 * wr2 + 16 * i, k0, F.lane);
#pragma unroll
            for (int j = 0; j < 4; ++j) { bk[j] = frag_kc(KP, RLD, 64 * wc2 + 16 * j, k0, F.lane); bs[j] = frag_kc(Sf, RLD, 64 * wc2 + 16 * j, k0, F.lane); }
#pragma unroll
            for (int i = 0; i < 2; ++i)
#pragma unroll
                for (int j = 0; j < 4; ++j) { sacc[i][j] = mma(sacc[i][j], bk[j], af[i]); facc[i][j] = mma(facc[i][j], bs[j], af[i]); } }
        WG_SYNC();
        { const float lf2 = lgf * 1.4426950408889634f, lb2 = lgb * 1.4426950408889634f;
#pragma unroll
          for (int i = 0; i < 2; ++i)
#pragma unroll
            for (int j = 0; j < 4; ++j) { const int c = 32 * wr2 + 16 * i + fr, s0 = 64 * wc2 + 16 * j + 4 * fq; float pv[4];
#pragma unroll
                for (int r = 0; r < 4; ++r) { const int df = c - (s0 + r); const float wgt = df > 0 ? exp2f(lf2 * (float)df) : (df < 0 ? exp2f(lb2 * (float)(-df)) : 2.f); pv[r] = sacc[i][j][r] * wgt; }
                u32x2 p; p.x = pk2(pv[0], pv[1]); p.y = pk2(pv[2], pv[3]); *(LAS u32x2*)(KP + c * RLD + s0) = p; }
          for (int it = F.tid; it < 128 * 16; it += NTHR) { const int c = it >> 4, ch = it & 15; *(LAS u32x4*)(Sf + c * RLD + 8 * ch) = *(const u32x4*)(spb + c * 128 + 8 * ch); }
        }
        WG_SYNC();
        f32x4 oacc[2][4], bacc[2][4];
#pragma unroll
        for (int i = 0; i < 2; ++i) { const float qdf = expf(lgf * (float)(32 * wr2 + 16 * i + fr + 1));
#pragma unroll
            for (int j = 0; j < 4; ++j) { oacc[i][j] = facc[i][j] * qdf; bacc[i][j] = (f32x4){0.f, 0.f, 0.f, 0.f}; } }
#pragma unroll 1
        for (int k0 = 0; k0 < 128; k0 += 32) { bf16x8 ap[2], aq[2], bv[4], bs[4];
#pragma unroll
            for (int i = 0; i < 2; ++i) { ap[i] = frag_kc(KP, RLD, 32 * wr2 + 16 * i, k0, F.lane); aq[i] = frag_kc(Qs, RLD, 32 * wr2 + 16 * i, k0, F.lane); }
#pragma unroll
            for (int j = 0; j < 4; ++j) { bv[j] = frag_kr(Vs, RLD, 64 * wc2 + 16 * j, k0, F.lane); bs[j] = frag_kc(Sf, RLD, 64 * wc2 + 16 * j, k0, F.lane); }
#pragma unroll
            for (int i = 0; i < 2; ++i)
#pragma unroll
                for (int j = 0; j < 4; ++j) { oacc[i][j] = mma(oacc[i][j], bv[j], ap[i]); bacc[i][j] = mma(bacc[i][j], bs[j], aq[i]); } }
        float rs[2], rq[2];
#pragma unroll
        for (int i = 0; i < 2; ++i) { const int c = 32 * wr2 + 16 * i + fr; const float qdb = expf(lgb * (float)(128 - c)); float s = 0.f, q = 0.f;
#pragma unroll
            for (int j = 0; j < 4; ++j) { oacc[i][j] = oacc[i][j] + bacc[i][j] * qdb;
#pragma unroll
                for (int r = 0; r < 4; ++r) { s += oacc[i][j][r]; q += oacc[i][j][r] * oacc[i][j][r]; } }
            s += __shfl_xor(s, 16); s += __shfl_xor(s, 32); q += __shfl_xor(q, 16); q += __shfl_xor(q, 32);
            if (fq == 0) { red[(c * 2 + wc2) * 2 + 0] = s; red[(c * 2 + wc2) * 2 + 1] = q; }
            rs[i] = s; rq[i] = q; }
        WG_SYNC();
#pragma unroll
        for (int i = 0; i < 2; ++i) { const int c = 32 * wr2 + 16 * i + fr;
            const float s = red[(c * 2 + 0) * 2 + 0] + red[(c * 2 + 1) * 2 + 0], q = red[(c * 2 + 0) * 2 + 1] + red[(c * 2 + 1) * 2 + 1];
            const float mean = s * (1.f / 128.f), var = fmaxf(q * (1.f / 128.f) - mean * mean, 0.f), rstd = rsqrtf(var + 1e-5f);
            const size_t grow = (size_t)(grow0 + c);
#pragma unroll
            for (int j = 0; j < 4; ++j) { const int e0 = 64 * wc2 + 16 * j + 4 * fq;
                const f32x4 gw = *(const f32x4*)(F.in[11] + h * 128 + e0); const u32x2 gg = *(const u32x2*)(QKV + grow * INW + 1536 + h * 128 + e0);
                const float g0 = bflo(gg.x), g1 = bfhi(gg.x), g2 = bflo(gg.y), g3 = bfhi(gg.y);
                const f32x4 y = (oacc[i][j] - mean) * rstd * gw;
                u32x2 p; p.x = pk2(y.x * siluf_(g0), y.y * siluf_(g1)); p.y = pk2(y.z * siluf_(g2), y.w * siluf_(g3));
                *(u32x2*)(MIX + grow * D + h * 128 + e0) = p; } }
        (void)rs; (void)rq;
        WG_SYNC();
    }
}

constexpr int NLD = 72;
DI void na_phase(Fr& F) {
    const bf16* QKV = (const bf16*)(F.ws + WS_QKV); bf16* MIX = (bf16*)(F.ws + WS_MIX);
    LAS bf16* Qs = (LAS bf16*)F.lds;
    LAS bf16* Ks = (LAS bf16*)(F.lds + 9216);
    LAS bf16* Vs = (LAS bf16*)(F.lds + 9216 + 36864);
    LAS bf16* Pw = (LAS bf16*)(F.lds + 9216 + 2 * 36864) + F.wave * (16 * RLD);
    LAS float* comb = (LAS float*)(F.lds + 9216 + 2 * 36864);
    LAS float* rpbs = (LAS float*)(F.lds + 9216 + 2 * 36864 + 34816);
    const int mq = F.wave >> 1, kh = F.wave & 1, fr = F.lane & 15, fq = F.lane >> 4;
    float bound;
    { float mqw = fabsf(F.in[12][F.lane]), mkw = fabsf(F.in[13][F.lane]), mb = 0.f;
      for (int i = F.lane; i < 8 * 15 * 31; i += 64) mb = fmaxf(mb, fabsf(F.in[14][i]));
      bound = 8.f * wave_max(mqw) * wave_max(mkw) + wave_max(mb); }
    for (int u = F.bx; u < 2048 + 256; u += F.G) {
        int b, head, r = 0, r0 = 0, qrow0, blk0;
        if (u < 2048) { b = u >> 8; head = (u >> 5) & 7; r = u & 31; r0 = min(max(r - 4, 0), 24); qrow0 = b * SEQ + r * 64; blk0 = 0; }
        else { const int cu = u - 2048; b = cu >> 5; head = (cu >> 2) & 7; qrow0 = ML + b * CTXL + (cu & 3) * 64; blk0 = 2; }
        { const int row = F.tid >> 3, c8 = F.tid & 7;
          const u32x4 a = *(const u32x4*)(QKV + (size_t)(qrow0 + row) * INW + 2048 + head * 64 + 8 * c8); const unsigned aw[4] = {a.x, a.y, a.z, a.w}; float x[8]; float ss = 0.f;
#pragma unroll
          for (int i = 0; i < 4; ++i) { x[2 * i] = bflo(aw[i]); x[2 * i + 1] = bfhi(aw[i]); ss += x[2 * i] * x[2 * i] + x[2 * i + 1] * x[2 * i + 1]; }
          const float rinv = rsqrtf(red8(ss) * (1.f / 64.f) + 1e-6f) * 0.125f;
#pragma unroll
          for (int i = 0; i < 8; ++i) x[i] *= F.in[12][8 * c8 + i];
          *(LAS u32x4*)(Qs + row * NLD + 8 * c8) = pack8(x, rinv); }
        for (int i = F.tid; i < 15 * 31; i += NTHR) rpbs[i] = F.in[14][head * 465 + i];
        f32x4 oacc[4]; float lsum = 0.f;
#pragma unroll
        for (int j = 0; j < 4; ++j) oacc[j] = (f32x4){0.f, 0.f, 0.f, 0.f};
        for (int blk = blk0; blk < 3; ++blk) {
            for (int it = F.tid; it < 256 * 8; it += NTHR) { const int krow = it >> 3, c8 = it & 7;
                const int grow = blk < 2 ? b * SEQ + (r0 + 4 * blk + (krow >> 6)) * 64 + (krow & 63) : ML + b * CTXL + krow;
                const u32x4 a = *(const u32x4*)(QKV + (size_t)grow * INW + 2560 + head * 64 + 8 * c8); const unsigned aw[4] = {a.x, a.y, a.z, a.w}; float x[8]; float ss = 0.f;
#pragma unroll
                for (int i = 0; i < 4; ++i) { x[2 * i] = bflo(aw[i]); x[2 * i + 1] = bfhi(aw[i]); ss += x[2 * i] * x[2 * i] + x[2 * i + 1] * x[2 * i + 1]; }
                const float rinv = rsqrtf(red8(ss) * (1.f / 64.f) + 1e-6f);
#pragma unroll
                for (int i = 0; i < 8; ++i) x[i] *= F.in[13][8 * c8 + i];
                *(LAS u32x4*)(Ks + krow * NLD + 8 * c8) = pack8(x, rinv);
                *(LAS u32x4*)(Vs + krow * NLD + 8 * c8) = *(const u32x4*)(QKV + (size_t)grow * INW + 3072 + head * 64 + 8 * c8); }
            WG_SYNC();
            f32x4 sacc[8];
#pragma unroll
            for (int j = 0; j < 8; ++j) sacc[j] = (f32x4){0.f, 0.f, 0.f, 0.f};
#pragma unroll
            for (int k0 = 0; k0 < 64; k0 += 32) { const bf16x8 aq = frag_kc(Qs, NLD, 16 * mq, k0, F.lane);
#pragma unroll
                for (int j = 0; j < 8; ++j) sacc[j] = mma(sacc[j], frag_kc(Ks, NLD, 128 * kh + 16 * j, k0, F.lane), aq); }
            const int c = 16 * mq + fr, c0 = min(max(c - 8, 0), 48);
#pragma unroll
            for (int j = 0; j < 8; ++j) { float pv[4];
#pragma unroll
                for (int i = 0; i < 4; ++i) { const int key = 128 * kh + 16 * j + 4 * fq + i; float p;
                    if (blk < 2) { const int kr = 4 * blk + (key >> 6), kc = key & 63; const bool ok = (kc >= c0) && (kc < c0 + 16);
                        const float bias = ok ? rpbs[(r0 + kr - r + 7) * 31 + (kc - c + 15)] : 0.f; p = ok ? __expf(sacc[j][i] + bias - bound) : 0.f; }
                    else p = __expf(sacc[j][i] - bound);
                    pv[i] = p; lsum += p; }
                u32x2 pk; pk.x = pk2(pv[0], pv[1]); pk.y = pk2(pv[2], pv[3]); *(LAS u32x2*)(Pw + fr * RLD + 16 * j + 4 * fq) = pk; }
            LDS_WAIT();
#pragma unroll
            for (int ks = 0; ks < 4; ++ks) { const bf16x8 ap = frag_kc(Pw, RLD, 0, 32 * ks, F.lane);
#pragma unroll
                for (int j = 0; j < 4; ++j) oacc[j] = mma(oacc[j], frag_kr(Vs, NLD, 16 * j, 128 * kh + 32 * ks, F.lane), ap); }
            WG_SYNC();
        }
        lsum += __shfl_xor(lsum, 16); lsum += __shfl_xor(lsum, 32);
        if (kh == 1) {
#pragma unroll
            for (int j = 0; j < 4; ++j) *(LAS f32x4*)(comb + mq * 1040 + fr * 64 + 16 * j + 4 * fq) = oacc[j];
            if (fq == 0) comb[mq * 1040 + 1024 + fr] = lsum; }
        WG_SYNC();
        if (kh == 0) { const float inv = 1.f / (lsum + comb[mq * 1040 + 1024 + fr]);
#pragma unroll
            for (int j = 0; j < 4; ++j) { const f32x4 o = (oacc[j] + *(LAS f32x4*)(comb + mq * 1040 + fr * 64 + 16 * j + 4 * fq)) * inv;
                u32x2 p; p.x = pk2(o.x, o.y); p.y = pk2(o.z, o.w);
                *(u32x2*)(MIX + (size_t)(qrow0 + 16 * mq + fr) * D + 512 + head * 64 + 16 * j + 4 * fq) = p; } }
        WG_SYNC();
    }
}

DI void xm_phase(Fr& F, const float* xl, const float* xc, const float* normw, const float* modl) {
    bf16* XM = (bf16*)(F.ws + WS_XM); const float* mu = F.in[18];
    for (int row = F.gw; row < MA; row += F.NGW) {
        const bool lat = row < ML; const int rr = lat ? row : row - ML; const int L = lat ? SEQ : CTXL; const int t = rr % L;
        const float* src = (lat ? xl : xc) + (size_t)rr * D;
        const float* mrow = modl + (size_t)(lat ? row / SEQ : 8) * 6144;
        const bool hp = t > 0, hn = t < L - 1;
        f32x4 vc[4], vp[4], vn[4]; float sc_ = 0.f, sp_ = 0.f, sn_ = 0.f;
#pragma unroll
        for (int j = 0; j < 4; ++j) { vc[j] = ((const f32x4*)src)[F.lane + 64 * j];
            vp[j] = hp ? ((const f32x4*)(src - D))[F.lane + 64 * j] : (f32x4){0.f, 0.f, 0.f, 0.f}; vn[j] = hn ? ((const f32x4*)(src + D))[F.lane + 64 * j] : (f32x4){0.f, 0.f, 0.f, 0.f};
            sc_ += (vc[j].x * vc[j].x + vc[j].y * vc[j].y) + (vc[j].z * vc[j].z + vc[j].w * vc[j].w);
            sp_ += (vp[j].x * vp[j].x + vp[j].y * vp[j].y) + (vp[j].z * vp[j].z + vp[j].w * vp[j].w);
            sn_ += (vn[j].x * vn[j].x + vn[j].y * vn[j].y) + (vn[j].z * vn[j].z + vn[j].w * vn[j].w); }
        const float rc = rsqrtf(wave_sum(sc_) * (1.f / D) + 1e-6f), rp = rsqrtf(wave_sum(sp_) * (1.f / D) + 1e-6f), rn = rsqrtf(wave_sum(sn_) * (1.f / D) + 1e-6f);
#pragma unroll
        for (int j = 0; j < 4; ++j) { const int c4 = F.lane + 64 * j;
            const f32x4 w = ((const f32x4*)normw)[c4], sc = ((const f32x4*)(mrow + 1024))[c4], sh = ((const f32x4*)mrow)[c4];
            const f32x4 g = w * (sc + 1.f);
            const f32x4 hc = vc[j] * rc * g + sh;
            const f32x4 hpv = hp ? vp[j] * rp * g + sh : (f32x4){0.f, 0.f, 0.f, 0.f};
            const f32x4 hnv = hn ? vn[j] * rn * g + sh : (f32x4){0.f, 0.f, 0.f, 0.f};
            const f32x4 xx = (hpv + hnv) * 0.5f - hc;
#pragma unroll
            for (int s = 0; s < 6; ++s) { const f32x4 m = ((const f32x4*)(mu + s * 1024))[c4]; const f32x4 y = hc + xx * m;
                u32x2 p; p.x = pk2(y.x, y.y); p.y = pk2(y.z, y.w); ((u32x2*)(XM + ((size_t)s * MA + row) * D))[c4] = p; } }
    }
}

constexpr int SC_T = 32;
constexpr int SC_STRIDE = 6 * 64;
DI void rwkv_scan_phase(Fr& F) {
    const bf16* KB = (const bf16*)(F.ws + WS_KB); const bf16* VB = (const bf16*)(F.ws + WS_VB); const bf16* RB = (const bf16*)(F.ws + WS_RB);
    const float* DEC = (const float*)(F.ws + WS_DEC); const bf16* AG = (const bf16*)(F.ws + WS_AG);
    LAS float* buf[2] = {(LAS float*)F.lds, (LAS float*)F.lds + SC_T * SC_STRIDE};
    const int i = F.tid >> 3, cg = F.tid & 7;
    for (int u = F.bx; u < 256; u += F.G) {
        const int z = u & 1, h = (u >> 1) & 15, b = u >> 5;
        float* Y = (float*)(F.ws + (z ? WS_YB : WS_YF));
        const int ch = h * 64 + F.lane;
        const float kkw = F.in[28][ch], kaw = F.in[29][ch];
        const float* decz = DEC + (size_t)z * MA * D; const bf16* agz = AG + (size_t)z * MA * D;
        float s[8];
#pragma unroll
        for (int j = 0; j < 8; ++j) s[j] = 0.f;
        bf16 kreg[4], vreg[4], rreg[4], areg[4]; float dreg[4];
#define SC_ROW(n, q, rowv, latv) const int g_ = (n) * SC_T + F.wave * 4 + (q); const bool latv = g_ >= CTXL; \
        const int rowv = latv ? b * SEQ + (z ? (SEQ + CTXL - 1 - g_) : (g_ - CTXL)) : ML + b * CTXL + (z ? (CTXL - 1 - g_) : g_);
#define SC_LOAD(n) do { _Pragma("unroll") for (int q = 0; q < 4; ++q) { SC_ROW(n, q, row_, lat_) \
            kreg[q] = KB[(size_t)row_ * D + ch]; vreg[q] = VB[(size_t)row_ * D + ch]; areg[q] = agz[(size_t)row_ * D + ch]; dreg[q] = decz[(size_t)row_ * D + ch]; \
            rreg[q] = lat_ ? RB[(size_t)row_ * D + ch] : (bf16)0; } } while (0)
#define SC_STAGE(dst) do { _Pragma("unroll") for (int q = 0; q < 4; ++q) { const float kr_ = bf1(kreg[q]), ag_ = bf1(areg[q]); float kk_ = kr_ * kkw; \
            const float nr_ = sqrtf(wave_sum(kk_ * kk_)); kk_ = kk_ / fmaxf(nr_, 1e-12f); LAS float* d_ = (dst) + (F.wave * 4 + q) * SC_STRIDE + F.lane; \
            d_[0] = -kk_; d_[64] = dreg[q]; d_[128] = kk_ * ag_; d_[192] = kr_ * (1.f + (ag_ - 1.f) * kaw); d_[256] = bf1(rreg[q]); d_[320] = bf1(vreg[q]); } } while (0)
        SC_LOAD(0); SC_STAGE(buf[0]);
        WG_SYNC();
        constexpr int NCHUNK = (SEQ + CTXL) / SC_T;
        for (int n = 0; n < NCHUNK; ++n) {
            if (n + 1 < NCHUNK) SC_LOAD(n + 1);
            const LAS float* cb = buf[n & 1];
            const bool lat = n * SC_T >= CTXL;
#pragma unroll 2
            for (int st = 0; st < SC_T; ++st) {
                const LAS float* p = cb + st * SC_STRIDE + 8 * cg;
                const f32x4 a0 = *(const LAS f32x4*)p, a1 = *(const LAS f32x4*)(p + 4), w0 = *(const LAS f32x4*)(p + 64), w1 = *(const LAS f32x4*)(p + 68);
                const f32x4 b0 = *(const LAS f32x4*)(p + 128), b1 = *(const LAS f32x4*)(p + 132), k0 = *(const LAS f32x4*)(p + 192), k1 = *(const LAS f32x4*)(p + 196);
                const f32x4 r0 = *(const LAS f32x4*)(p + 256), r1 = *(const LAS f32x4*)(p + 260);
                const float vi = cb[st * SC_STRIDE + 320 + i];
                float sa = (s[0] * a0.x + s[1] * a0.y) + (s[2] * a0.z + s[3] * a0.w) + (s[4] * a1.x + s[5] * a1.y) + (s[6] * a1.z + s[7] * a1.w);
                sa = red8(sa);
                s[0] = s[0] * w0.x + sa * b0.x + vi * k0.x; s[1] = s[1] * w0.y + sa * b0.y + vi * k0.y; s[2] = s[2] * w0.z + sa * b0.z + vi * k0.z; s[3] = s[3] * w0.w + sa * b0.w + vi * k0.w;
                s[4] = s[4] * w1.x + sa * b1.x + vi * k1.x; s[5] = s[5] * w1.y + sa * b1.y + vi * k1.y; s[6] = s[6] * w1.z + sa * b1.z + vi * k1.z; s[7] = s[7] * w1.w + sa * b1.w + vi * k1.w;
                if (lat) {
                    float y = (s[0] * r0.x + s[1] * r0.y) + (s[2] * r0.z + s[3] * r0.w) + (s[4] * r1.x + s[5] * r1.y) + (s[6] * r1.z + s[7] * r1.w);
                    y = red8(y);
                    const int g = n * SC_T + st; const int tl = z ? (SEQ + CTXL - 1 - g) : (g - CTXL);
                    if (cg == 0) Y[(size_t)(b * SEQ + tl) * D + h * 64 + i] = y;
                }
            }
            if (n + 1 < NCHUNK) SC_STAGE(buf[(n + 1) & 1]);
            WG_SYNC();
        }
#undef SC_ROW
#undef SC_LOAD
#undef SC_STAGE
    }
}

DI void rwkv_readout_phase(Fr& F) {
    const bf16* KB = (const bf16*)(F.ws + WS_KB); const bf16* VB = (const bf16*)(F.ws + WS_VB); const bf16* RB = (const bf16*)(F.ws + WS_RB);
    const bf16* AG = (const bf16*)(F.ws + WS_AG); const bf16* G = (const bf16*)(F.ws + WS_G);
    const float* YF = (const float*)(F.ws + WS_YF); const float* YB = (const float*)(F.ws + WS_YB); bf16* Z = (bf16*)(F.ws + WS_H);
    const int c0 = 16 * F.lane;
    for (int row = F.gw; row < ML; row += F.NGW) {
        const size_t off = (size_t)row * D + c0;
        float y[16], kv[16], vv[16], rv[16], gv[16], a0v[16], a1v[16];
#pragma unroll
        for (int q = 0; q < 4; ++q) { const f32x4 a = *(const f32x4*)(YF + off + 4 * q), bq = *(const f32x4*)(YB + off + 4 * q);
            y[4 * q] = a.x + bq.x; y[4 * q + 1] = a.y + bq.y; y[4 * q + 2] = a.z + bq.z; y[4 * q + 3] = a.w + bq.w; }
#define RD16(dst, ptr) do { const u32x4 t0_ = *(const u32x4*)(ptr), t1_ = *(const u32x4*)((ptr) + 8); const unsigned tw_[8] = {t0_.x, t0_.y, t0_.z, t0_.w, t1_.x, t1_.y, t1_.z, t1_.w}; \
        _Pragma("unroll") for (int q_ = 0; q_ < 8; ++q_) { dst[2 * q_] = bflo(tw_[q_]); dst[2 * q_ + 1] = bfhi(tw_[q_]); } } while (0)
        RD16(kv, KB + off); RD16(vv, VB + off); RD16(rv, RB + off); RD16(gv, G + off); RD16(a0v, AG + off); RD16(a1v, AG + (size_t)MA * D + off);
#undef RD16
        float s = 0.f, cf = 0.f;
#pragma unroll
        for (int q = 0; q < 16; ++q) { s += y[q]; const float ka = F.in[29][c0 + q];
            const float kd = kv[q] * ((1.f + (a0v[q] - 1.f) * ka) + (1.f + (a1v[q] - 1.f) * ka)); cf += rv[q] * kd * F.in[30][c0 + q]; }
        s = red4(s); cf = red4(cf);
        const float mean = s * (1.f / 64.f); float q2 = 0.f;
#pragma unroll
        for (int q = 0; q < 16; ++q) { const float d = y[q] - mean; q2 += d * d; }
        q2 = red4(q2);
        const float rstd = rsqrtf(q2 * (1.f / 64.f) + 64e-5f);
        float o[16];
#pragma unroll
        for (int q = 0; q < 16; ++q) o[q] = ((y[q] - mean) * rstd * F.in[31][c0 + q] + F.in[32][c0 + q] + cf * vv[q]) * gv[q];
        u32x4 p0, p1; p0.x = pk2(o[0], o[1]); p0.y = pk2(o[2], o[3]); p0.z = pk2(o[4], o[5]); p0.w = pk2(o[6], o[7]); p1.x = pk2(o[8], o[9]); p1.y = pk2(o[10], o[11]); p1.z = pk2(o[12], o[13]); p1.w = pk2(o[14], o[15]);
        *(u32x4*)(Z + off) = p0; *(u32x4*)(Z + off + 8) = p1;
    }
}

DI void moe_route_phase(Fr& F, const float* xl, const float* normw, const float* modl) {
    bf16* H2 = (bf16*)(F.ws + WS_MIX); int* TopE = (int*)(F.ws + WS_MISC + MISC_TOPE); f32x2* TopW = (f32x2*)(F.ws + WS_MISC + MISC_TOPW); int* Cnts = (int*)(F.ws + WS_MISC + MISC_CNTS);
    LAS float* rt = (LAS float*)F.lds;
    LAS int* lc = (LAS int*)(F.lds + 32768);
    for (int idx = F.tid; idx < 1024 * 8 / 4; idx += NTHR) ((LAS f32x4*)rt)[idx] = ((const f32x4*)F.in[34])[idx];
    for (int wg = F.bx; wg < 256; wg += F.G) {
        WG_SYNC();
        for (int it = 0; it < 8; ++it) { const int row = wg * 64 + F.wave * 8 + it;
            const float* src = xl + (size_t)row * D; const float* mrow = modl + (size_t)(row / SEQ) * 6144;
            f32x4 v[4]; float ss = 0.f;
#pragma unroll
            for (int j = 0; j < 4; ++j) { v[j] = ((const f32x4*)src)[F.lane + 64 * j]; ss += (v[j].x * v[j].x + v[j].y * v[j].y) + (v[j].z * v[j].z + v[j].w * v[j].w); }
            const float rstd = rsqrtf(wave_sum(ss) * (1.f / D) + 1e-6f);
            float lg[8];
#pragma unroll
            for (int e = 0; e < 8; ++e) lg[e] = 0.f;
#pragma unroll
            for (int j = 0; j < 4; ++j) { const int c4 = F.lane + 64 * j;
                const f32x4 w = ((const f32x4*)normw)[c4], sc = ((const f32x4*)(mrow + 4096))[c4], sh = ((const f32x4*)(mrow + 3072))[c4];
                const f32x4 y = v[j] * rstd * w * (sc + 1.f) + sh;
                u32x2 p; p.x = pk2(y.x, y.y); p.y = pk2(y.z, y.w); ((u32x2*)(H2 + (size_t)row * D))[c4] = p;
                const float yy[4] = {y.x, y.y, y.z, y.w};
#pragma unroll
                for (int q = 0; q < 4; ++q) { const f32x4 r0 = *(const LAS f32x4*)(rt + (4 * c4 + q) * 8), r1 = *(const LAS f32x4*)(rt + (4 * c4 + q) * 8 + 4);
                    lg[0] += yy[q] * r0.x; lg[1] += yy[q] * r0.y; lg[2] += yy[q] * r0.z; lg[3] += yy[q] * r0.w; lg[4] += yy[q] * r1.x; lg[5] += yy[q] * r1.y; lg[6] += yy[q] * r1.z; lg[7] += yy[q] * r1.w; } }
#pragma unroll
            for (int e = 0; e < 8; ++e) lg[e] = wave_sum(lg[e]);
            int e0 = 0; float v0 = lg[0];
#pragma unroll
            for (int e = 1; e < 8; ++e) if (lg[e] > v0) { v0 = lg[e]; e0 = e; }
            int e1 = -1; float v1 = -3.0e38f;
#pragma unroll
            for (int e = 0; e < 8; ++e) if (e != e0 && lg[e] > v1) { v1 = lg[e]; e1 = e; }
            const float w0 = 1.f / (1.f + expf(v1 - v0)), w1 = 1.f - w0;
            if (F.lane == 0) { TopE[row] = e0 | (e1 << 8); TopW[row] = (f32x2){w0, w1}; lc[F.wave * 8 + it] = e0 | (e1 << 8); }
        }
        WG_SYNC();
        if (F.tid < 8) { int c = 0; for (int t = 0; t < 64; ++t) { const int code = lc[t]; c += ((code & 255) == F.tid ? 1 : 0) + ((code >> 8) == F.tid ? 1 : 0); } Cnts[wg * 8 + F.tid] = c; }
        WG_SYNC();
    }
}
DI void moe_gather_phase(Fr& F) {
    const bf16* H2 = (const bf16*)(F.ws + WS_MIX); const int* TopE = (const int*)(F.ws + WS_MISC + MISC_TOPE); const f32x2* TopW = (const f32x2*)(F.ws + WS_MISC + MISC_TOPW);
    const int* Cnts = (const int*)(F.ws + WS_MISC + MISC_CNTS); int* Exp = (int*)(F.ws + WS_MISC + MISC_EXP);
    bf16* XG = (bf16*)(F.ws + WS_XG); int* RowTok = (int*)(F.ws + WS_ROWS); float* RowW = (float*)(F.ws + WS_ROWS + 262144);
    LAS int* lc = (LAS int*)F.lds;
    LAS int* tot = lc + 2048;
    LAS int* rows = tot + 32;
    LAS int* te = rows + 128;
    for (int idx = F.tid; idx < 2048; idx += NTHR) lc[idx] = Cnts[idx];
    WG_SYNC();
    for (int wg = F.bx; wg < 256; wg += F.G) {
        if (F.tid < 64) te[F.tid] = TopE[wg * 64 + F.tid];
        if (F.tid < 8) { int t = 0, mb = 0; for (int w = 0; w < 256; ++w) { const int c = lc[w * 8 + F.tid]; t += c; mb += (w < wg) ? c : 0; } tot[F.tid] = t; tot[16 + F.tid] = mb; }
        WG_SYNC();
        if (F.tid == 0) { int sgs = 0; for (int e = 0; e < 8; ++e) { tot[8 + e] = sgs; sgs += (tot[e] + 255) & ~255; }
            if (wg == 0) { int acc = 0; for (int e = 0; e < 8; ++e) { Exp[e] = tot[e]; Exp[8 + e] = tot[8 + e]; acc += (tot[e] + 255) >> 8; Exp[16 + e] = acc; } } }
        WG_SYNC();
        if (F.tid < 64) { const int code = te[F.tid]; const int e0 = code & 255, e1 = code >> 8; int r0 = 0, r1 = 0;
            for (int t = 0; t < F.tid; ++t) { const int c2 = te[t]; const int a = c2 & 255, bq = c2 >> 8; r0 += (a == e0 ? 1 : 0) + (bq == e0 ? 1 : 0); r1 += (a == e1 ? 1 : 0) + (bq == e1 ? 1 : 0); }
            rows[2 * F.tid] = tot[8 + e0] + tot[16 + e0] + r0; rows[2 * F.tid + 1] = tot[8 + e1] + tot[16 + e1] + r1; }
        WG_SYNC();
        for (int it = F.wave; it < 128; it += NWAVES) { const int t = it >> 1, k = it & 1, tok = wg * 64 + t, row = rows[it];
            const u32x4* s = (const u32x4*)(H2 + (size_t)tok * D); u32x4* d = (u32x4*)(XG + (size_t)row * D);
            d[F.lane] = s[F.lane]; d[F.lane + 64] = s[F.lane + 64];
            if (F.lane == 0) { RowTok[row] = tok * 2 + k; const f32x2 w = TopW[tok]; RowW[row] = k ? w.y : w.x; } }
        if (wg == 0) {
            for (int e = 0; e < 8; ++e) { const int a = tot[8 + e] + tot[e], bnd = tot[8 + e] + ((tot[e] + 255) & ~255); for (int rr = a + F.tid; rr < bnd; rr += NTHR) RowTok[rr] = -1; } }
        WG_SYNC();
    }
}
DI void moe_combine_phase(Fr& F, float* xl, const float* modl) {
    const bf16* YS = (const bf16*)(F.ws + WS_YS);
    for (int row = F.gw; row < ML; row += F.NGW) {
        const float* mrow = modl + (size_t)(row / SEQ) * 6144 + 5120; float* xr = xl + (size_t)row * D;
        const u32x2* s0 = (const u32x2*)(YS + (size_t)(2 * row) * D); const u32x2* s1 = (const u32x2*)(YS + (size_t)(2 * row + 1) * D);
#pragma unroll
        for (int j = 0; j < 4; ++j) { const int c4 = F.lane + 64 * j; const f32x4 x = ((const f32x4*)xr)[c4], m = ((const f32x4*)mrow)[c4]; const u32x2 a = s0[c4], bq = s1[c4];
            f32x4 o; o.x = x.x + m.x * (bflo(a.x) + bflo(bq.x)); o.y = x.y + m.y * (bfhi(a.x) + bfhi(bq.x)); o.z = x.z + m.z * (bflo(a.y) + bflo(bq.y)); o.w = x.w + m.w * (bfhi(a.y) + bfhi(bq.y));
            ((f32x4*)xr)[c4] = o; }
    }
}

constexpr int N_PHASES = 20;
struct Args { const float* in[37]; float* out; unsigned char* ws; int ph_lo, ph_hi; };
template <class Epi> DI void run_gemm(Fr& F, const bf16* A, const bf16* Bt, int M, int N, int K, const Epi& E, int& rot) {
    int Kv = K; asm volatile("" : "+s"(Kv));
    pg8::Gemm g{A, Bt, M, N, Kv}; pg8::StaticOrder S; S.init(M, N, F.G, (F.bx + F.G - (rot % F.G)) % F.G); rot += (M / 256) * (N / 256);
    pg8::gemm_phase<Epi, pg8::StaticOrder>(F.lds, g, S, E);
}
__global__ void __launch_bounds__(NTHR, 2) fwd_kernel(Args args) {
    extern __shared__ __attribute__((aligned(16))) unsigned char lds_raw[];
    Fr F;
    F.lds = (LAS unsigned char*)lds_raw; F.ws = args.ws; F.in = args.in; F.out = args.out;
    F.tid = threadIdx.x; F.lane = F.tid & 63; F.wave = __builtin_amdgcn_readfirstlane(F.tid >> 6); F.bx = blockIdx.x; F.G = gridDim.x;
    F.gw = F.bx * NWAVES + F.wave; F.NGW = F.G * NWAVES;
    volatile LAS unsigned* MISC = (volatile LAS unsigned*)(F.lds + LDS_MISC_OFF);
    if (F.tid < 64) MISC[F.tid] = 0u;
    __syncthreads();
    const int lo = args.ph_lo, hi = args.ph_hi;
    const bool multi = (hi - lo) > 1;
    XcdBarrier bar; bar.bar = (unsigned*)(F.ws + WS_CTL) + CW_BAR; bar.x = 0; bar.st = nullptr;
    if (multi) bar = xcd_barrier_post((unsigned*)(F.ws + WS_CTL) + CW_BAR, MISC + 8);
#ifndef PH_MASK
#define PH_MASK 0xFFFFFFFFu
#endif
#define IN(k) ((((PH_MASK) >> (k)) & 1u) && lo <= (k) && (k) < hi)
#define SEAM(k) do { if (IN(k) && IN((k) + 1)) xcd_barrier(bar); } while (0)
    const float* const* in = args.in;
    float* MOD = (float*)(F.ws + WS_MOD);
    float* XL = F.out; float* XC = (float*)(F.ws + WS_XC);
    bf16* H = (bf16*)(F.ws + WS_H); bf16* MIX = (bf16*)(F.ws + WS_MIX);

    if (IN(0)) { p0_prologue(F); } SEAM(0);
    if (IN(1)) { mod_rows(F, in[0], in[2], MA, in[6], MOD, 0, 1024, H); } SEAM(1);
    if (IN(2)) { int rot = 0; EpiStore<0> E{(bf16*)(F.ws + WS_QKV), INW, INW}; run_gemm(F, H, (const bf16*)(F.ws + WS_W_IN), MA, INW, 1024, E, rot); } SEAM(2);
    if (IN(3)) { ret_kv_phase(F); } SEAM(3);
    if (IN(4)) { ret_prefix_phase(F); } SEAM(4);
    #ifndef PH5_SEL
#define PH5_SEL 3
#endif
    if (IN(5)) { if (PH5_SEL & 1) ret_out_phase(F); if (PH5_SEL & 2) na_phase(F); } SEAM(5);
    if (IN(6)) { int rot = 0; EpiResid E{in[0], XL, in[2], XC, MOD + 2048}; run_gemm(F, MIX, (const bf16*)(F.ws + WS_W_OUT), MA, 1024, 1024, E, rot); } SEAM(6);
    if (IN(7)) { mod_rows(F, XL, XC, MA, in[7], MOD, 3072, 4096, H); } SEAM(7);
    if (IN(8)) { int rot = 0; EpiSwiglu E{(bf16*)(F.ws + WS_FFH), FFN_H}; run_gemm(F, H, (const bf16*)(F.ws + WS_W_13), MA, 2 * FFN_H, 1024, E, rot); } SEAM(8);
    if (IN(9)) { int rot = 0; EpiResid E{XL, XL, XC, XC, MOD + 5120}; run_gemm(F, (const bf16*)(F.ws + WS_FFH), (const bf16*)(F.ws + WS_W_2), MA, 1024, FFN_H, E, rot); } SEAM(9);
    const float* MOD1 = MOD + 9 * 6144;
    if (IN(10)) { xm_phase(F, XL, XC, in[6] + 1024, MOD1); } SEAM(10);
    if (IN(11)) { int rot = 0; const bf16* XM = (const bf16*)(F.ws + WS_XM); const bf16* WR = (const bf16*)(F.ws + WS_W_RKV); const bf16* WL1 = (const bf16*)(F.ws + WS_W_L1);
        { EpiStore<0> E{(bf16*)(F.ws + WS_RB), D, D}; run_gemm(F, XM, WR, ML, 1024, 1024, E, rot); }
        { EpiStore<0> E{(bf16*)(F.ws + WS_KB), D, D}; run_gemm(F, XM + (size_t)1 * MA * D, WR + 1024 * 1024, MA, 1024, 1024, E, rot); }
        { EpiStore<0> E{(bf16*)(F.ws + WS_VB), D, D}; run_gemm(F, XM + (size_t)2 * MA * D, WR + 2 * 1024 * 1024, MA, 1024, 1024, E, rot); }
        { EpiStore<1> E{(bf16*)(F.ws + WS_L1), 256, 128}; run_gemm(F, XM + (size_t)3 * MA * D, WL1, MA, 256, 1024, E, rot); }
        { EpiStore<0> E{(bf16*)(F.ws + WS_L1) + 128, 256, 128}; run_gemm(F, XM + (size_t)4 * MA * D, WL1 + 256 * 1024, MA, 256, 1024, E, rot); }
        { EpiStore<2> E{(bf16*)(F.ws + WS_LG), 256, 256}; run_gemm(F, XM + (size_t)5 * MA * D, WL1 + 2 * 256 * 1024, ML, 256, 1024, E, rot); } } SEAM(11);
    if (IN(12)) { int rot = 0;
        { EpiLora2 E{(float*)(F.ws + WS_DEC), (bf16*)(F.ws + WS_AG), in[20], in[23]}; run_gemm(F, (const bf16*)(F.ws + WS_L1), (const bf16*)(F.ws + WS_W_L2), MA, 4096, 256, E, rot); }
        { EpiStore<0> E{(bf16*)(F.ws + WS_G), D, D}; run_gemm(F, (const bf16*)(F.ws + WS_LG), (const bf16*)(F.ws + WS_W_G2), ML, 1024, 256, E, rot); } } SEAM(12);
    if (IN(13)) { rwkv_scan_phase(F); } SEAM(13);
    if (IN(14)) { rwkv_readout_phase(F); } SEAM(14);
    if (IN(15)) { int rot = 0; EpiResid E{XL, XL, XC, XC, MOD1 + 2048}; run_gemm(F, H, (const bf16*)(F.ws + WS_W_O), ML, 1024, 1024, E, rot); } SEAM(15);
    if (IN(16)) { moe_route_phase(F, XL, in[7] + 1024, MOD1); } SEAM(16);
    if (IN(17)) { moe_gather_phase(F); } SEAM(17);
    if (IN(18) || IN(19)) {
        const int* Exp = (const int*)(F.ws + WS_MISC + MISC_EXP);
        pg8::MoeOrder S; S.G = F.G; S.c = F.bx;
#pragma unroll
        for (int e = 0; e < 8; ++e) S.tend[e] = Exp[16 + e];
        S.nM = S.tend[7];
        if (IN(18)) { S.nN = 2 * EXP_H / 256; S.nwg = S.nM * S.nN; pg8::Gemm g{(const bf16*)(F.ws + WS_XG), (const bf16*)(F.ws + WS_W_M13), XG_ROWS, 2 * EXP_H, 1024};
            EpiSwiglu E{(bf16*)(F.ws + WS_HG), EXP_H}; pg8::gemm_phase<EpiSwiglu, pg8::MoeOrder>(F.lds, g, S, E); }
        SEAM(18);
        if (IN(19)) { S.nN = 4; S.nwg = S.nM * S.nN; pg8::Gemm g{(const bf16*)(F.ws + WS_HG), (const bf16*)(F.ws + WS_W_M2), XG_ROWS, 1024, EXP_H};
            EpiMoeOut E{(bf16*)(F.ws + WS_YS), (const int*)(F.ws + WS_ROWS), (const float*)(F.ws + WS_ROWS + 262144)}; pg8::gemm_phase<EpiMoeOut, pg8::MoeOrder>(F.lds, g, S, E); }
    }
    if (IN(19) && IN(20)) xcd_barrier(bar);
    if (IN(20)) { moe_combine_phase(F, XL, MOD1); }
#undef IN
#undef SEAM
}

#ifndef MK_SPLIT
#define MK_SPLIT 0
#endif
extern "C" void kernel_launch(void* const* d_in, const int* in_sizes, int n_in, void* d_out, int out_size, void* d_ws, size_t ws_size, hipStream_t stream) {
    static int grid = 0;
    if (grid == 0) {
        if (n_in != 37 || out_size != ML * D || ws_size < WS_END) { fprintf(stderr, "kernel_launch: unexpected problem (n_in %d out %d ws %zu)\n", n_in, out_size, ws_size); grid = -1; return; }
        int dev = 0, cus = 0, per_cu = 0;
        if (hipGetDevice(&dev) != hipSuccess || hipDeviceGetAttribute(&cus, hipDeviceAttributeMultiprocessorCount, dev) != hipSuccess) { grid = -1; return; }
        if (hipFuncSetAttribute((const void*)fwd_kernel, hipFuncAttributeMaxDynamicSharedMemorySize, LDS_BYTES) != hipSuccess) { fprintf(stderr, "kernel_launch: hipFuncSetAttribute failed\n"); grid = -1; return; }
        if (hipOccupancyMaxActiveBlocksPerMultiprocessor(&per_cu, (const void*)fwd_kernel, NTHR, LDS_BYTES) != hipSuccess || per_cu < 1) { fprintf(stderr, "kernel_launch: occupancy query says %d\n", per_cu); }
        (void)hipGetLastError();
        grid = cus;
    }
    if (grid < 0) return;
    (void)hipMemsetAsync((char*)d_ws + WS_CTL, 0, CTL_ZERO_BYTES, stream);
    Args a{};
    for (int i = 0; i < 37; ++i) a.in[i] = (const float*)d_in[i];
    a.out = (float*)d_out; a.ws = (unsigned char*)d_ws;
#if MK_SPLIT
    for (int p = 0; p <= N_PHASES; ++p) { a.ph_lo = p; a.ph_hi = p + 1; hipLaunchKernelGGL(fwd_kernel, dim3(grid), dim3(NTHR), LDS_BYTES, stream, a); }
#else
    a.ph_lo = 0; a.ph_hi = N_PHASES + 1; hipLaunchKernelGGL(fwd_kernel, dim3(grid), dim3(NTHR), LDS_BYTES, stream, a);
#endif
}
```

```cpp
#include <hip/hip_runtime.h>
#include <cstdio>
#include <cstdint>

#define DI __device__ __forceinline__
#define LAS __attribute__((address_space(3)))

namespace pg8 {
#define PG8_LAS __attribute__((address_space(3)))
typedef unsigned short bf16_t;
typedef short bf16x8 __attribute__((ext_vector_type(8)));
typedef float f32x4 __attribute__((ext_vector_type(4)));
typedef unsigned u32x4 __attribute__((ext_vector_type(4)));
constexpr int BM = 256, BK = 64, HALF = 128, HTB = HALF * BK * 2  , STAGE_BYTES = 8 * HTB, NXCD = 8, WGM = 8;

__host__ __device__ __forceinline__ int lds_byte(int r, int c) { const int st = (r >> 4) * 2 + (c >> 5), rr = r & 15, cc = c & 31, ob = rr * 64 + cc * 2; return st * 1024 + (ob ^ (((ob >> 9) & 1) << 5)); }
__host__ __device__ __forceinline__ void stage_rc(int b, int& R, int& C) { const int st = b / 1024, sb = b % 1024, swz = sb ^ (((sb >> 9) & 1) << 5); R = (st >> 1) * 16 + swz / 64; C = (st & 1) * 32 + (swz % 64) / 2; }
__host__ __device__ __forceinline__ int perm32(int rho) { const int n = rho >> 4, i = rho & 15; return 8 * (i >> 2) + 4 * n + (i & 3); }

struct Unit { int pm, pn, pb; };
struct Gemm { const bf16_t* A; const bf16_t* Bt; int M, N, K; };

struct StaticOrder {
    int nM, nN, nwg, G, c;
    __host__ __device__ void init(int M, int N, int G_, int c_) { nM = M / BM; nN = N / BM; nwg = nM * nN; G = G_; c = c_; }
    __host__ __device__ bool next(int i, Unit& u) const {
        const long L = (long)i * G + c; if (L >= nwg) return false;
        int wgid = (int)L; { const int q = nwg / NXCD, r = nwg % NXCD, xcd = wgid % NXCD, off = wgid / NXCD; wgid = (xcd < r ? xcd * (q + 1) : r * (q + 1) + (xcd - r) * q) + off; }
        const int nig = WGM * nN, gid = wgid / nig, fm = gid * WGM, gsz = (nM - fm) < WGM ? (nM - fm) : WGM;
        u.pm = fm + ((wgid % nig) % gsz); u.pn = (wgid % nig) / gsz; u.pb = u.pn; return true;
    }
    __device__ __forceinline__ void a_ready(const Unit&) const {}
    __device__ __forceinline__ void done(const Unit&) const {}
};
struct MoeOrder {
    int nM, nN, nwg, G, c; int tend[8];
    __device__ bool next(int i, Unit& u) const {
        const long L = (long)i * G + c; if (L >= nwg) return false;
        int wgid = (int)L; { const int q = nwg / NXCD, r = nwg % NXCD, xcd = wgid % NXCD, off = wgid / NXCD; wgid = (xcd < r ? xcd * (q + 1) : r * (q + 1) + (xcd - r) * q) + off; }
        const int nig = WGM * nN, gid = wgid / nig, fm = gid * WGM, gsz = (nM - fm) < WGM ? (nM - fm) : WGM;
        u.pm = fm + ((wgid % nig) % gsz); u.pn = (wgid % nig) / gsz;
        int e = 0;
#pragma unroll
        for (int j = 0; j < 7; ++j) e += (u.pm >= tend[j]) ? 1 : 0;
        u.pb = e * nN + u.pn; return true;
    }
    __device__ __forceinline__ void a_ready(const Unit&) const {}
    __device__ __forceinline__ void done(const Unit&) const {}
};

__device__ __forceinline__ unsigned cvt_pk_bf16(float lo, float hi) { unsigned r; asm volatile("v_cvt_pk_bf16_f32 %0, %1, %2" : "=v"(r) : "v"(lo), "v"(hi)); return r; }

template <class Epi, class Sched>
__device__ __forceinline__ void gemm_phase(PG8_LAS unsigned char* lds, const Gemm g, const Sched& S, const Epi& E) {
    const int tid = threadIdx.x, wid = __builtin_amdgcn_readfirstlane(tid >> 6), lane = tid & 63, wr = wid >> 2, wc = wid & 3, fr = lane & 15, fq = lane >> 4;
    const int K = g.K, nt = K / BK;
    unsigned voffA[2], voffB[2];
#pragma unroll
    for (int i = 0; i < 2; ++i) { int R, C; stage_rc(tid * 16 + i * 8192, R, C); const int Rb = Epi::PERM ? ((R & ~31) + perm32(R & 31)) : R;
        voffA[i] = (unsigned)(R * K + C) * 2u; voffB[i] = (unsigned)(Rb * K + C) * 2u; }
    const size_t kstep = (size_t)(BK * 2);
    const size_t hstep = (size_t)HALF * K * 2;
    const size_t tstep = 2 * hstep;
    const unsigned ldsw = (unsigned)wid * 1024u;
    const int aoff = lds_byte(wr * 64 + fr, fq * 8), boff = lds_byte(wc * 32 + fr, fq * 8);
#define PG8_SA(b, h) (((b) * 2 + (h)) * HTB)
#define PG8_SB(b, h) ((4 + (b) * 2 + (h)) * HTB)
#define PG8_STAGE(bufoff, gbase, voff) do { _Pragma("unroll") for (int _i = 0; _i < 2; ++_i) \
        __builtin_amdgcn_global_load_lds((const unsigned*)((const char*)(gbase) + (voff)[_i]), (PG8_LAS unsigned*)(lds + (bufoff) + ldsw + _i * 8192), 16, 0, 0); } while (0)
#define PG8_LDA(dst, b, h) do { _Pragma("unroll") for (int m = 0; m < 4; ++m) _Pragma("unroll") for (int k = 0; k < 2; ++k) dst[m][k] = *(const PG8_LAS bf16x8*)(lds + PG8_SA(b, h) + aoff + m * 2048 + k * 1024); } while (0)
#define PG8_LDB(dst, b, h) do { _Pragma("unroll") for (int n = 0; n < 2; ++n) _Pragma("unroll") for (int k = 0; k < 2; ++k) dst[n][k] = *(const PG8_LAS bf16x8*)(lds + PG8_SB(b, h) + boff + n * 2048 + k * 1024); } while (0)
#define PG8_MMA(ai, bj, At, Bt) do { __builtin_amdgcn_s_setprio(1); _Pragma("unroll") for (int m = 0; m < 4; ++m) _Pragma("unroll") for (int n = 0; n < 2; ++n) _Pragma("unroll") for (int k = 0; k < 2; ++k) \
        acc[ai][bj][m][n] = __builtin_amdgcn_mfma_f32_16x16x32_bf16(Bt[n][k], At[m][k], acc[ai][bj][m][n], 0, 0, 0); __builtin_amdgcn_s_setprio(0); } while (0)
#define PG8_WAIT_V(n) asm volatile("s_waitcnt vmcnt(" #n ")" ::: "memory")
#define PG8_WAIT_L(n) asm volatile("s_waitcnt lgkmcnt(" #n ")" ::: "memory")
#define PG8_BAR __builtin_amdgcn_s_barrier()
#define PG8_SCHED __builtin_amdgcn_sched_barrier(0)
    Unit cur, nxt; int ui = 0;
    if (!S.next(0, cur)) return;
    f32x4 acc[2][2][4][2];
#pragma unroll
    for (int a = 0; a < 2; ++a)
#pragma unroll
        for (int b = 0; b < 2; ++b)
#pragma unroll
            for (int m = 0; m < 4; ++m)
#pragma unroll
                for (int n = 0; n < 2; ++n) acc[a][b][m][n] = (f32x4){0.f, 0.f, 0.f, 0.f};
    bf16x8 At[4][2], B0[2][2], B1[2][2];
    const char* cA = (const char*)g.A + (size_t)cur.pm * tstep; const char* cB = (const char*)g.Bt + (size_t)cur.pb * tstep;
    S.a_ready(cur);
    PG8_STAGE(PG8_SB(0, 0), cB, voffB); PG8_STAGE(PG8_SA(0, 0), cA, voffA); PG8_STAGE(PG8_SB(0, 1), cB + hstep, voffB); PG8_STAGE(PG8_SA(0, 1), cA + hstep, voffA);
    if (wr == 1) PG8_BAR;
    PG8_WAIT_V(4); PG8_BAR;
    PG8_STAGE(PG8_SB(1, 0), cB + kstep, voffB); PG8_STAGE(PG8_SA(1, 0), cA + kstep, voffA); PG8_STAGE(PG8_SB(1, 1), cB + hstep + kstep, voffB);
    PG8_WAIT_V(6); PG8_BAR;
    for (;;) {
        const bool has_next = S.next(ui + 1, nxt);
        const char* nA = has_next ? (const char*)g.A + (size_t)nxt.pm * tstep : cA; const char* nB = has_next ? (const char*)g.Bt + (size_t)nxt.pb * tstep : cB;
        for (int t = 0; t < nt; t += 2) {
            const bool last = (t == nt - 2);
            const char* a1 = cA + (size_t)(t + 1) * kstep;
            const char* a2 = last ? nA : cA + (size_t)(t + 2) * kstep; const char* b2 = last ? nB : cB + (size_t)(t + 2) * kstep;
            const char* a3 = a2 + kstep; const char* b3 = b2 + kstep;
            if (last && has_next) S.a_ready(nxt);
            PG8_LDB(B0, 0, 0); PG8_SCHED; PG8_LDA(At, 0, 0); PG8_STAGE(PG8_SA(1, 1), a1 + hstep, voffA);
            PG8_WAIT_L(8); PG8_BAR; PG8_WAIT_L(0); PG8_MMA(0, 0, At, B0); PG8_BAR; PG8_SCHED;
            PG8_LDB(B1, 0, 1); PG8_STAGE(PG8_SB(0, 0), b2, voffB);
            PG8_BAR; PG8_WAIT_L(0); PG8_MMA(0, 1, At, B1); PG8_BAR;
            PG8_LDA(At, 0, 1); PG8_STAGE(PG8_SA(0, 0), a2, voffA);
            PG8_BAR; PG8_WAIT_L(0); PG8_MMA(1, 0, At, B0); PG8_BAR; PG8_SCHED;
            PG8_STAGE(PG8_SB(0, 1), b2 + hstep, voffB);
            PG8_WAIT_V(6); PG8_BAR; PG8_MMA(1, 1, At, B1); PG8_BAR;
            PG8_LDB(B0, 1, 0); PG8_SCHED; PG8_LDA(At, 1, 0); PG8_STAGE(PG8_SA(0, 1), a2 + hstep, voffA);
            PG8_WAIT_L(8); PG8_BAR; PG8_WAIT_L(0); PG8_MMA(0, 0, At, B0); PG8_BAR; PG8_SCHED;
            PG8_LDB(B1, 1, 1); PG8_STAGE(PG8_SB(1, 0), b3, voffB);
            PG8_BAR; PG8_WAIT_L(0); PG8_MMA(0, 1, At, B1); PG8_BAR;
            PG8_LDA(At, 1, 1); PG8_STAGE(PG8_SA(1, 0), a3, voffA);
            PG8_BAR; PG8_WAIT_L(0); PG8_MMA(1, 0, At, B0); PG8_BAR; PG8_SCHED;
            PG8_STAGE(PG8_SB(1, 1), b3 + hstep, voffB);
            PG8_WAIT_V(6); PG8_BAR; PG8_MMA(1, 1, At, B1); PG8_BAR;
        }
        E(acc, cur, wr, wc, fr, fq); S.done(cur);
        if (!has_next) break;
#pragma unroll
        for (int a = 0; a < 2; ++a)
#pragma unroll
            for (int b = 0; b < 2; ++b)
#pragma unroll
                for (int m = 0; m < 4; ++m)
#pragma unroll
                    for (int n = 0; n < 2; ++n) acc[a][b][m][n] = (f32x4){0.f, 0.f, 0.f, 0.f};
        cur = nxt; cA = nA; cB = nB; ++ui;
    }
    PG8_WAIT_V(0);
    if (wr == 0) PG8_BAR;
    PG8_BAR;
#undef PG8_SA
#undef PG8_SB
#undef PG8_STAGE
#undef PG8_LDA
#undef PG8_LDB
#undef PG8_MMA
#undef PG8_WAIT_V
#undef PG8_WAIT_L
#undef PG8_BAR
#undef PG8_SCHED
}
}

constexpr int D = 1024, NB = 8, SEQ = 2048, CTXL = 256;
constexpr int ML = NB * SEQ;
constexpr int MC = NB * CTXL;
constexpr int MA = ML + MC;
constexpr int INW = 3584, FFN_H = 2816, EXP_H = 3584, NEXP = 8;
constexpr int NCH = 18;
constexpr int XG_ROWS = 34816;
constexpr int NWAVES = 8, NTHR = 512;

constexpr size_t MiB = 1u << 20;
constexpr size_t WS_CTL = 0, CTL_ZERO_BYTES = 1 * MiB;
constexpr size_t WS_MOD = 1 * MiB;
constexpr size_t WS_ROPE = 2 * MiB;
constexpr size_t WS_MISC = 3 * MiB;
constexpr size_t WS_W_IN = 4 * MiB, WS_W_OUT = 11 * MiB, WS_W_13 = 13 * MiB, WS_W_2 = 24 * MiB, WS_W_RKV = 30 * MiB, WS_W_L1 = 36 * MiB,
                 WS_W_L2 = 38 * MiB, WS_W_G2 = 40 * MiB, WS_W_O = 41 * MiB, WS_W_M13 = 43 * MiB, WS_W_M2 = 155 * MiB;
constexpr size_t WS_XC = 211 * MiB, WS_H = 219 * MiB, WS_MIX = 255 * MiB, WS_R = 291 * MiB;
constexpr size_t WS_QKV = WS_R, WS_KV = WS_R + 126 * MiB, WS_SPREV = WS_R + 198 * MiB, WS_FFH = WS_R;
constexpr size_t WS_XM = WS_R, WS_DEC = WS_R, WS_AG = WS_R + 144 * MiB, WS_RB = WS_R + 216 * MiB, WS_KB = WS_R + 248 * MiB, WS_VB = WS_R + 284 * MiB,
                 WS_L1 = WS_R + 320 * MiB, WS_LG = WS_R + 329 * MiB, WS_G = WS_R + 337 * MiB, WS_YF = WS_R + 369 * MiB, WS_YB = WS_R + 433 * MiB;
constexpr size_t WS_XG = WS_R, WS_HG = WS_R + 68 * MiB, WS_YS = WS_R + 306 * MiB, WS_ROWS = WS_R + 370 * MiB;
constexpr size_t WS_END = WS_R + 497 * MiB;
static_assert(WS_END <= 896 * MiB, "workspace map");
constexpr int CW_BAR = 4096;
constexpr size_t MISC_TOPE = 0, MISC_TOPW = 65536, MISC_CNTS = 196608, MISC_EXP = 204800;

constexpr int LDS_MAIN = 147456;
constexpr int LDS_MISC_OFF = LDS_MAIN;
constexpr int LDS_BYTES = LDS_MAIN + 256;

typedef unsigned short bf16;
typedef short bf16x8 __attribute__((ext_vector_type(8)));
typedef short s16x4 __attribute__((ext_vector_type(4)));
typedef float f32x4 __attribute__((ext_vector_type(4)));
typedef float f32x2 __attribute__((ext_vector_type(2)));
typedef unsigned u32x4 __attribute__((ext_vector_type(4)));
typedef unsigned u32x2 __attribute__((ext_vector_type(2)));
#define LDS_WAIT() asm volatile("s_waitcnt lgkmcnt(0)" ::: "memory")
#define VM_WAIT() asm volatile("s_waitcnt vmcnt(0)" ::: "memory")
#define WG_SYNC() __syncthreads()
DI unsigned f2bf(float f) { unsigned u = __builtin_bit_cast(unsigned, f); return (u + 0x7fffu + ((u >> 16) & 1u)) >> 16; }
DI unsigned pk2(float lo, float hi) { return f2bf(lo) | (f2bf(hi) << 16); }
DI float bflo(unsigned w) { return __builtin_bit_cast(float, w << 16); }
DI float bfhi(unsigned w) { return __builtin_bit_cast(float, w & 0xffff0000u); }
DI float bf1(bf16 b) { return __builtin_bit_cast(float, (unsigned)b << 16); }
DI float wave_sum(float v) {
#pragma unroll
    for (int o = 1; o < 64; o <<= 1) v += __shfl_xor(v, o);
    return v;
}
DI float wave_max(float v) {
#pragma unroll
    for (int o = 1; o < 64; o <<= 1) v = fmaxf(v, __shfl_xor(v, o));
    return v;
}
DI float dpp_x1(float v) { return __builtin_bit_cast(float, __builtin_amdgcn_update_dpp(0, __builtin_bit_cast(int, v), 0xB1, 0xf, 0xf, true)); }
DI float dpp_x2(float v) { return __builtin_bit_cast(float, __builtin_amdgcn_update_dpp(0, __builtin_bit_cast(int, v), 0x4E, 0xf, 0xf, true)); }
DI float dpp_hm(float v) { return __builtin_bit_cast(float, __builtin_amdgcn_update_dpp(0, __builtin_bit_cast(int, v), 0x141, 0xf, 0xf, true)); }
DI float red4(float v) { v += dpp_x1(v); v += dpp_x2(v); return v; }
DI float red8(float v) { v += dpp_x1(v); v += dpp_x2(v); v += dpp_hm(v); return v; }
DI float sigmoidf_(float x) { return 1.f / (1.f + __expf(-x)); }
DI float siluf_(float x) { return x / (1.f + __expf(-x)); }

DI bf16x8 frag_kc(const LAS bf16* base, int ld, int row0, int k0, int lane) {
    return *(const LAS bf16x8*)(base + (row0 + (lane & 15)) * ld + k0 + 8 * (lane >> 4));
}
DI bf16x8 frag_kr(const LAS bf16* base, int ld, int x0, int k0, int lane) {
    const int g = lane >> 4, q = (lane & 15) >> 2, p = lane & 3;
    const LAS bf16* a = base + (k0 + 8 * g + q) * ld + x0 + 4 * p;
    const s16x4 lo = __builtin_amdgcn_ds_read_tr16_b64_v4i16((LAS s16x4*)a);
    const s16x4 hi = __builtin_amdgcn_ds_read_tr16_b64_v4i16((LAS s16x4*)(a + 4 * ld));
    return __builtin_shufflevector(lo, hi, 0, 1, 2, 3, 4, 5, 6, 7);
}
DI f32x4 mma(f32x4 acc, bf16x8 bfrag, bf16x8 afrag) { return __builtin_amdgcn_mfma_f32_16x16x32_bf16(bfrag, afrag, acc, 0, 0, 0); }

#define XB_TMO      128
#define XB_XCNT(j)  (256  + 64 * (j))
#define XB_XSUB(j)  (1280 + 64 * (j))
#define XB_XGEN(j)  (2304 + 64 * (j))
#define XB_TOP      3328
#define XB_TOPGEN   3392
#define XCD_BAR_WORDS 3456
#define XB_SPIN_CAP (1u << 18)
DI unsigned xb_ld(unsigned* p)              { return __hip_atomic_load(p, __ATOMIC_RELAXED, __HIP_MEMORY_SCOPE_AGENT); }
DI unsigned xb_add(unsigned* p, unsigned v) { return __hip_atomic_fetch_add(p, v, __ATOMIC_RELAXED, __HIP_MEMORY_SCOPE_AGENT); }
DI unsigned xb_xcc_id() { return (unsigned)__builtin_amdgcn_s_getreg((3 << 11) | 20) & 0xFu; }
#define XB_SPIN(cond, bar) do { unsigned _sp = 0; while (cond) { __builtin_amdgcn_s_sleep(1); \
    if ((++_sp & 255u) == 0u) { if (xb_ld(&(bar)[XB_TMO])) break; if (_sp > XB_SPIN_CAP) { atomicAdd(&(bar)[XB_TMO], 1u); break; } } } } while (0)
struct XcdBarrier { unsigned* bar; unsigned x; volatile LAS unsigned* st; };
DI XcdBarrier xcd_barrier_post(unsigned* bar, volatile LAS unsigned* st) {
    XcdBarrier b; b.bar = bar; b.x = xb_xcc_id(); b.st = st;
    if (threadIdx.x == 0) (void)xb_add(&bar[XB_XCNT(b.x)], 1u);
    return b;
}
DI void xcd_barrier_complete(unsigned* bar, unsigned x, unsigned& nloc, unsigned& nx) {
    const unsigned G = gridDim.x * gridDim.y * gridDim.z;
    unsigned sum, cnt, mine, sp = 0u;
    for (;;) {
        sum = 0u; cnt = 0u; mine = 0u;
#pragma unroll
        for (unsigned j = 0; j < 16; ++j) { const unsigned c = xb_ld(&bar[XB_XCNT(j)]); sum += c; cnt += (c > 0u) ? 1u : 0u; mine = (j == x) ? c : mine; }
        if (sum == G) break;
        __builtin_amdgcn_s_sleep(1);
        if ((++sp & 255u) == 0u) { if (xb_ld(&bar[XB_TMO])) break; if (sp > XB_SPIN_CAP) { atomicAdd(&bar[XB_TMO], 1u); break; } }
    }
    nloc = mine > 0u ? mine : 1u; nx = cnt > 0u ? cnt : 1u;
}
DI void xcd_barrier(const XcdBarrier& b) {
    asm volatile("s_waitcnt vmcnt(0)" ::: "memory");
    __syncthreads();
    if (threadIdx.x == 0) {
        unsigned* bar = b.bar;
        __builtin_amdgcn_s_waitcnt(0);
        unsigned nloc = b.st[0], nx = b.st[1];
        if (nloc == 0u) { xcd_barrier_complete(bar, b.x, nloc, nx); b.st[0] = nloc; b.st[1] = nx; }
        const unsigned old = xb_add(&bar[XB_XSUB(b.x)], 1u);
        const unsigned gen = old / nloc;
        if (old + 1u == (gen + 1u) * nloc) {
            __builtin_amdgcn_fence(__ATOMIC_RELEASE, "agent");
            asm volatile("s_waitcnt vmcnt(0)" ::: "memory");
            const unsigned og = xb_add(&bar[XB_TOP], 1u);
            const unsigned tg = og / nx;
            if (og + 1u == (tg + 1u) * nx) xb_add(&bar[XB_TOPGEN], 1u);
            else XB_SPIN(xb_ld(&bar[XB_TOPGEN]) == tg, bar);
            __builtin_amdgcn_fence(__ATOMIC_ACQUIRE, "agent");
            xb_add(&bar[XB_XGEN(b.x)], 1u);
            asm volatile("s_waitcnt vmcnt(0)" ::: "memory");
        } else {
            XB_SPIN(xb_ld(&bar[XB_XGEN(b.x)]) == gen, bar);
            __builtin_amdgcn_fence(__ATOMIC_ACQUIRE, "agent");
            asm volatile("s_waitcnt vmcnt(0)" ::: "memory");
        }
    }
    __syncthreads();
}

struct Fr {
    LAS unsigned char* lds;
    unsigned char* ws;
    const float* const* in;
    float* out;
    int tid, lane, wave, bx, G, gw, NGW;
};

using pg8::Unit;
template <int ACT  > struct EpiStore {
    static constexpr bool PERM = true;
    bf16* O; int ldc; int nvalid;
    DI void operator()(const f32x4 (&acc)[2][2][4][2], const Unit& u, int wr, int wc, int fr, int fq) const {
        const int row0 = u.pm * 256 + wr * 64 + fr, col0 = u.pn * 256 + wc * 32 + 8 * fq;
#pragma unroll
        for (int ai = 0; ai < 2; ++ai)
#pragma unroll
            for (int m = 0; m < 4; ++m) { bf16* rowp = O + (size_t)(row0 + ai * 128 + m * 16) * ldc + col0;
#pragma unroll
                for (int bj = 0; bj < 2; ++bj) { if (u.pn * 256 + bj * 128 >= nvalid) continue;
                    f32x4 v0 = acc[ai][bj][m][0], v1 = acc[ai][bj][m][1];
                    if (ACT == 1) {
#pragma unroll
                        for (int j = 0; j < 4; ++j) { v0[j] = tanhf(v0[j]); v1[j] = tanhf(v1[j]); } }
                    if (ACT == 2) {
#pragma unroll
                        for (int j = 0; j < 4; ++j) { v0[j] = sigmoidf_(v0[j]); v1[j] = sigmoidf_(v1[j]); } }
                    u32x4 w; w.x = pg8::cvt_pk_bf16(v0[0], v0[1]); w.y = pg8::cvt_pk_bf16(v0[2], v0[3]); w.z = pg8::cvt_pk_bf16(v1[0], v1[1]); w.w = pg8::cvt_pk_bf16(v1[2], v1[3]);
                    *(u32x4*)(rowp + bj * 128) = w; } }
    }
};
struct EpiResid {
    static constexpr bool PERM = false;
    const float* baseL; float* outL; const float* baseC; float* outC; const float* modg;
    DI void operator()(const f32x4 (&acc)[2][2][4][2], const Unit& u, int wr, int wc, int fr, int fq) const {
        const bool lat = u.pm < 64; const int r = lat ? (u.pm >> 3) : 8;
        const float* base = lat ? baseL : baseC; float* out = lat ? outL : outC;
        const int row0 = (lat ? u.pm : u.pm - 64) * 256 + wr * 64 + fr, col0 = u.pn * 256 + wc * 32 + 4 * fq;
        const float* mg = modg + (size_t)r * 6144 + col0;
        f32x4 mv[2][2];
#pragma unroll
        for (int bj = 0; bj < 2; ++bj)
#pragma unroll
            for (int n = 0; n < 2; ++n) mv[bj][n] = *(const f32x4*)(mg + bj * 128 + n * 16);
#pragma unroll
        for (int ai = 0; ai < 2; ++ai)
#pragma unroll
            for (int m = 0; m < 4; ++m) { const size_t off = (size_t)(row0 + ai * 128 + m * 16) * D + col0;
#pragma unroll
                for (int bj = 0; bj < 2; ++bj)
#pragma unroll
                    for (int n = 0; n < 2; ++n) { const f32x4 bs = *(const f32x4*)(base + off + bj * 128 + n * 16);
                        *(f32x4*)(out + off + bj * 128 + n * 16) = bs + mv[bj][n] * acc[ai][bj][m][n]; } }
    }
};
struct EpiSwiglu {
    static constexpr bool PERM = true;
    bf16* Hd; int ldh;
    DI void operator()(const f32x4 (&acc)[2][2][4][2], const Unit& u, int wr, int wc, int fr, int fq) const {
        const int row0 = u.pm * 256 + wr * 64 + fr, col0 = u.pn * 128 + wc * 32 + 8 * fq;
#pragma unroll
        for (int ai = 0; ai < 2; ++ai)
#pragma unroll
            for (int m = 0; m < 4; ++m) { bf16* rowp = Hd + (size_t)(row0 + ai * 128 + m * 16) * ldh + col0;
                f32x4 v0, v1;
#pragma unroll
                for (int j = 0; j < 4; ++j) { v0[j] = siluf_(acc[ai][0][m][0][j]) * acc[ai][1][m][0][j]; v1[j] = siluf_(acc[ai][0][m][1][j]) * acc[ai][1][m][1][j]; }
                u32x4 w; w.x = pg8::cvt_pk_bf16(v0[0], v0[1]); w.y = pg8::cvt_pk_bf16(v0[2], v0[3]); w.z = pg8::cvt_pk_bf16(v1[0], v1[1]); w.w = pg8::cvt_pk_bf16(v1[2], v1[3]);
                *(u32x4*)rowp = w; }
    }
};
struct EpiLora2 {
    static constexpr bool PERM = true;
    float* DEC; bf16* AG; const float* w0; const float* a0;
    DI void operator()(const f32x4 (&acc)[2][2][4][2], const Unit& u, int wr, int wc, int fr, int fq) const {
        const int q = u.pn >> 2, z = q & 1; const int row0 = u.pm * 256 + wr * 64 + fr, col0 = (u.pn & 3) * 256 + wc * 32 + 8 * fq;
        const float* bias = (q < 2 ? w0 : a0) + z * 1024 + col0;
        f32x4 bv[2][2];
#pragma unroll
        for (int bj = 0; bj < 2; ++bj)
#pragma unroll
            for (int n = 0; n < 2; ++n) bv[bj][n] = *(const f32x4*)(bias + bj * 128 + 4 * n);
#pragma unroll
        for (int ai = 0; ai < 2; ++ai)
#pragma unroll
            for (int m = 0; m < 4; ++m) { const size_t off = ((size_t)z * MA + (row0 + ai * 128 + m * 16)) * D + col0;
#pragma unroll
                for (int bj = 0; bj < 2; ++bj) { f32x4 v0 = acc[ai][bj][m][0] + bv[bj][0], v1 = acc[ai][bj][m][1] + bv[bj][1];
                    if (q < 2) {
#pragma unroll
                        for (int j = 0; j < 4; ++j) {
                            v0[j] = -0.6065306597126334f * sigmoidf_(v0[j]); v1[j] = -0.6065306597126334f * sigmoidf_(v1[j]); }
                        *(f32x4*)(DEC + off + bj * 128) = v0; *(f32x4*)(DEC + off + bj * 128 + 4) = v1;
                        __builtin_amdgcn_sched_barrier(0);
                    } else {
#pragma unroll
                        for (int j = 0; j < 4; ++j) { v0[j] = sigmoidf_(v0[j]); v1[j] = sigmoidf_(v1[j]); }
                        u32x4 w; w.x = pg8::cvt_pk_bf16(v0[0], v0[1]); w.y = pg8::cvt_pk_bf16(v0[2], v0[3]); w.z = pg8::cvt_pk_bf16(v1[0], v1[1]); w.w = pg8::cvt_pk_bf16(v1[2], v1[3]);
                        *(u32x4*)(AG + off + bj * 128) = w; __builtin_amdgcn_sched_barrier(0); } } }
    }
};
struct EpiMoeOut {
    static constexpr bool PERM = true;
    bf16* YS; const int* RowTok; const float* RowW;
    DI void operator()(const f32x4 (&acc)[2][2][4][2], const Unit& u, int wr, int wc, int fr, int fq) const {
        const int row0 = u.pm * 256 + wr * 64 + fr, col0 = u.pn * 256 + wc * 32 + 8 * fq;
#pragma unroll
        for (int ai = 0; ai < 2; ++ai)
#pragma unroll
            for (int m = 0; m < 4; ++m) { const int row = row0 + ai * 128 + m * 16; const int t2 = RowTok[row]; if (t2 < 0) continue; const float w = RowW[row];
                bf16* rowp = YS + (size_t)t2 * D + col0;
#pragma unroll
                for (int bj = 0; bj < 2; ++bj) { const f32x4 v0 = acc[ai][bj][m][0] * w, v1 = acc[ai][bj][m][1] * w;
                    u32x4 o; o.x = pg8::cvt_pk_bf16(v0[0], v0[1]); o.y = pg8::cvt_pk_bf16(v0[2], v0[3]); o.z = pg8::cvt_pk_bf16(v1[0], v1[1]); o.w = pg8::cvt_pk_bf16(v1[2], v1[3]);
                    *(u32x4*)(rowp + bj * 128) = o; } }
    }
};

DI void tr_item(const float* src, int ldsrc, int Kreal, int k0, int n0, bf16* dst, int lddst, int drow0, int dcol0, LAS float* scr, int lane) {
#pragma unroll 8
    for (int i = 0; i < 32; ++i) { const int kk = 2 * i + (lane >> 5), k = k0 + kk; float v = 0.f; if (k < Kreal) v = src[(size_t)k * ldsrc + n0 + (lane & 31)]; scr[kk * 33 + (lane & 31)] = v; }
    LDS_WAIT();
    const int c = lane & 7;
#pragma unroll
    for (int j = 0; j < 4; ++j) { const int n = (lane >> 3) + 8 * j; const LAS float* s = scr + (8 * c) * 33 + n;
        u32x4 o; o.x = pk2(s[0 * 33], s[1 * 33]); o.y = pk2(s[2 * 33], s[3 * 33]); o.z = pk2(s[4 * 33], s[5 * 33]); o.w = pk2(s[6 * 33], s[7 * 33]);
        *(u32x4*)(dst + (size_t)(drow0 + n) * lddst + dcol0 + k0 + 8 * c) = o; }
    LDS_WAIT();
}
DI void tr_plain(const float* src, int K, int N, bf16* dst, int r, LAS float* scr, int lane) {
    const int nblk = N / 32, kb = r / nblk, nb = r % nblk; tr_item(src, N, K, 64 * kb, 32 * nb, dst, K, 32 * nb, 0, scr, lane);
}
DI void tr_gateup(const float* src, int K, int Hh, bf16* dst, int r, LAS float* scr, int lane) {
    const int nblk = 2 * Hh / 32, kb = r / nblk, nb = r % nblk, n0 = 32 * nb, half = n0 / Hh, j0 = n0 % Hh;
    tr_item(src, 2 * Hh, K, 64 * kb, n0, dst, K, (j0 / 128) * 256 + half * 128 + (j0 % 128), 0, scr, lane);
}
DI void tr16_item(const float* src, int ldsrc, int k0, int n0, bf16* dst, int lddst, int Hh, int lane) {
    f32x4 v[16];
#pragma unroll
    for (int kk = 0; kk < 16; ++kk) v[kk] = *(const f32x4*)(src + (size_t)(k0 + kk) * ldsrc + n0 + 4 * lane);
    const int n = n0 + 4 * lane; int drow = n;
    if (Hh) { const int half = n / Hh, j = n % Hh; drow = (j / 128) * 256 + half * 128 + (j % 128); }
#pragma unroll
    for (int q = 0; q < 4; ++q) { u32x4 o0, o1;
        o0.x = pk2(v[0][q], v[1][q]); o0.y = pk2(v[2][q], v[3][q]); o0.z = pk2(v[4][q], v[5][q]); o0.w = pk2(v[6][q], v[7][q]);
        o1.x = pk2(v[8][q], v[9][q]); o1.y = pk2(v[10][q], v[11][q]); o1.z = pk2(v[12][q], v[13][q]); o1.w = pk2(v[14][q], v[15][q]);
        bf16* d = dst + (size_t)(drow + q) * lddst + k0; *(u32x4*)d = o0; *(u32x4*)(d + 8) = o1; }
}
DI void tr16_mat(const float* src, int K, int N, bf16* dst, int Hh, int r, int lane) { const int nb = N / 256; tr16_item(src, N, 16 * (r / nb), 256 * (r % nb), dst, K, Hh, lane); }
DI void p0_prologue(Fr& F) {
    LAS float* scr = (LAS float*)(F.lds + F.wave * 16384);
    const float* const* in = F.in;
    bf16* W_IN = (bf16*)(F.ws + WS_W_IN); bf16* W_OUT = (bf16*)(F.ws + WS_W_OUT); bf16* W_13 = (bf16*)(F.ws + WS_W_13); bf16* W_2 = (bf16*)(F.ws + WS_W_2);
    bf16* W_RKV = (bf16*)(F.ws + WS_W_RKV); bf16* W_L1 = (bf16*)(F.ws + WS_W_L1); bf16* W_L2 = (bf16*)(F.ws + WS_W_L2); bf16* W_G2 = (bf16*)(F.ws + WS_W_G2);
    bf16* W_O = (bf16*)(F.ws + WS_W_O); bf16* W_M13 = (bf16*)(F.ws + WS_W_M13); bf16* W_M2 = (bf16*)(F.ws + WS_W_M2);
    {
        constexpr int B_M13 = 64 * 28, B_M2 = 224 * 4, B_IN = 64 * 14, B_OUT = 64 * 4, B_13 = 64 * 22, B_2 = 176 * 4, B_RKV = 256, B_O = 256;
        constexpr int NB_ITEMS = 8 * B_M13 + 8 * B_M2 + B_IN + B_OUT + B_13 + B_2 + 3 * B_RKV + B_O;
        for (int it = F.gw; it < NB_ITEMS; it += F.NGW) {
            int r = it;
            if (r < 8 * B_M13) { const int e = r / B_M13; tr16_mat(in[35] + (size_t)e * 1024 * 7168, 1024, 7168, W_M13 + (size_t)e * 7168 * 1024, EXP_H, r % B_M13, F.lane); continue; } r -= 8 * B_M13;
            if (r < 8 * B_M2) { const int e = r / B_M2; tr16_mat(in[36] + (size_t)e * EXP_H * 1024, EXP_H, 1024, W_M2 + (size_t)e * 1024 * EXP_H, 0, r % B_M2, F.lane); continue; } r -= 8 * B_M2;
            if (r < B_IN) { tr16_mat(in[8], 1024, INW, W_IN, 0, r, F.lane); continue; } r -= B_IN;
            if (r < B_OUT) { tr16_mat(in[15], 1024, 1024, W_OUT, 0, r, F.lane); continue; } r -= B_OUT;
            if (r < B_13) { tr16_mat(in[16], 1024, 2 * FFN_H, W_13, FFN_H, r, F.lane); continue; } r -= B_13;
            if (r < B_2) { tr16_mat(in[17], FFN_H, 1024, W_2, 0, r, F.lane); continue; } r -= B_2;
            if (r < 3 * B_RKV) { const int sx = r / B_RKV; tr16_mat(in[19] + (size_t)sx * 1024 * 1024, 1024, 1024, W_RKV + (size_t)sx * 1024 * 1024, 0, r % B_RKV, F.lane); continue; } r -= 3 * B_RKV;
            tr16_mat(in[33], 1024, 1024, W_O, 0, r, F.lane);
        }
    }
    constexpr int I_W1 = 2 * 32, I_A1 = 2 * 32, I_G1 = 16 * 5, I_L2 = 4 * 32, I_G2 = 4 * 32;
    constexpr int NITEMS = I_W1 + I_A1 + I_G1 + I_L2 + I_G2;
    for (int it = F.gw; it < NITEMS; it += F.NGW) {
        int r = it;
        if (r < I_W1) { const int z = r / 32, rr = r % 32; tr_item(in[21] + (size_t)z * 1024 * 64, 64, 1024, 64 * (rr / 2), 32 * (rr % 2), W_L1, 1024, z * 64 + 32 * (rr % 2), 0, scr, F.lane); continue; } r -= I_W1;
        if (r < I_A1) { const int z = r / 32, rr = r % 32; tr_item(in[24] + (size_t)z * 1024 * 64, 64, 1024, 64 * (rr / 2), 32 * (rr % 2), W_L1 + 256 * 1024, 1024, z * 64 + 32 * (rr % 2), 0, scr, F.lane); continue; } r -= I_A1;
        if (r < I_G1) { tr_item(in[26], 160, 1024, 64 * (r / 5), 32 * (r % 5), W_L1 + 2 * 256 * 1024, 1024, 32 * (r % 5), 0, scr, F.lane); continue; } r -= I_G1;
        if (r < I_L2) { const int q = r / 32, nb = r % 32; const float* src = (q < 2 ? in[22] : in[25]) + (size_t)(q & 1) * 64 * 1024;
            for (int i = F.lane; i < 32 * 24; i += 64) { const int row = i / 24, ch = i % 24; const int col = 8 * ch + (8 * ch >= q * 64 ? 64 : 0);
                *(u32x4*)(W_L2 + (size_t)(q * 1024 + 32 * nb + row) * 256 + col) = (u32x4){0u, 0u, 0u, 0u}; }
            tr_item(src, 1024, 64, 0, 32 * nb, W_L2, 256, q * 1024 + 32 * nb, q * 64, scr, F.lane); continue; } r -= I_L2;
        tr_item(in[27], 1024, 160, 64 * (r / 32), 32 * (r % 32), W_G2, 256, 32 * (r % 32), 0, scr, F.lane);
    }
    { const int gt = F.bx * NTHR + F.tid, NT = F.G * NTHR;
      for (int i = gt; i < (128 + 128 + 96) * 128; i += NT) { int row = i / 128; const int ch = i % 128; int mat = 0;
          if (row >= 256) { mat = 2; row = row - 256 + 160; } else if (row >= 128) { mat = 1; } else { row += 128; }
          *(u32x4*)(W_L1 + ((size_t)mat * 256 + row) * 1024 + 8 * ch) = (u32x4){0u, 0u, 0u, 0u}; }
      f32x2* rope = (f32x2*)(F.ws + WS_ROPE);
      for (int i = gt; i < 2048; i += NT) { const int pos = i >> 5, j = i & 31; const float fr = powf(10000.f, -(float)j / 32.f), ang = (float)pos * fr; rope[i] = (f32x2){cosf(ang), sinf(ang)}; }
    }
    WG_SYNC();
    for (int u = F.bx; u < 192; u += F.G) {
        const int li = u / 96, n0 = (u % 96) * 64;
        LAS float* sm = (LAS float*)F.lds;
        for (int idx = F.tid; idx < 9 * 1024; idx += NTHR) { const int r = idx >> 10, k = idx & 1023; const float cv = (r < 8) ? in[1][r * 1024 + k] : in[3][k]; sm[idx] = cv / (1.f + expf(-cv)); }
        WG_SYNC();
        const int kq = F.tid >> 6, nn = F.tid & 63;
        float acc[9];
#pragma unroll
        for (int r = 0; r < 9; ++r) acc[r] = 0.f;
        const float* w = in[4] + (size_t)li * 1024 * 6144 + n0 + nn;
#pragma unroll 4
        for (int k = kq * 128; k < kq * 128 + 128; ++k) { const float wv = w[(size_t)k * 6144];
#pragma unroll
            for (int r = 0; r < 9; ++r) acc[r] += sm[r * 1024 + k] * wv; }
        LAS float* red = sm + 9 * 1024;
#pragma unroll
        for (int r = 0; r < 9; ++r) red[(kq * 9 + r) * 64 + nn] = acc[r];
        WG_SYNC();
        float* MOD = (float*)(F.ws + WS_MOD);
        for (int idx = F.tid; idx < 9 * 64; idx += NTHR) { const int r = idx / 64, n2 = idx % 64; float s = 0.f;
#pragma unroll
            for (int q = 0; q < 8; ++q) s += red[(q * 9 + r) * 64 + n2];
            MOD[((size_t)li * 9 + r) * 6144 + n0 + n2] = s + in[5][li * 6144 + n0 + n2]; }
        WG_SYNC();
    }
}

DI void mod_rows(Fr& F, const float* xl, const float* xc, int nrows, const float* normw, const float* modl, int off_shift, int off_scale, bf16* H) {
    for (int row = F.gw; row < nrows; row += F.NGW) {
        const float* src = row < ML ? xl + (size_t)row * D : xc + (size_t)(row - ML) * D;
        const float* mrow = modl + (size_t)(row < ML ? row / SEQ : 8) * 6144;
        f32x4 v[4]; float ss = 0.f;
#pragma unroll
        for (int j = 0; j < 4; ++j) { v[j] = ((const f32x4*)src)[F.lane + 64 * j]; ss += (v[j].x * v[j].x + v[j].y * v[j].y) + (v[j].z * v[j].z + v[j].w * v[j].w); }
        const float rstd = rsqrtf(wave_sum(ss) * (1.f / D) + 1e-6f);
        u32x2* o = (u32x2*)(H + (size_t)row * D);
#pragma unroll
        for (int j = 0; j < 4; ++j) { const int c4 = F.lane + 64 * j;
            const f32x4 w = ((const f32x4*)normw)[c4], sc = ((const f32x4*)(mrow + off_scale))[c4], sh = ((const f32x4*)(mrow + off_shift))[c4];
            const f32x4 y = v[j] * rstd * w * (sc + 1.f) + sh;
            u32x2 p; p.x = pk2(y.x, y.y); p.y = pk2(y.z, y.w); o[c4] = p; }
    }
}

DI void load_rope_pair(const bf16* rowp, int hh, int jj, bool lat, int rpos, int cpos, const f32x2* rope, float scl, float (&x1)[8], float (&x2)[8]) {
    const u32x4 a = *(const u32x4*)(rowp + hh * 64 + jj), b = *(const u32x4*)(rowp + hh * 64 + jj + 32);
    const unsigned aw[4] = {a.x, a.y, a.z, a.w}, bw[4] = {b.x, b.y, b.z, b.w};
#pragma unroll
    for (int i = 0; i < 4; ++i) { x1[2 * i] = bflo(aw[i]); x1[2 * i + 1] = bfhi(aw[i]); x2[2 * i] = bflo(bw[i]); x2[2 * i + 1] = bfhi(bw[i]); }
    if (lat) { const int pos = hh ? cpos : rpos;
#pragma unroll
        for (int i = 0; i < 8; ++i) { const f32x2 cs = rope[pos * 32 + jj + i]; const float y1 = x1[i] * cs.x - x2[i] * cs.y, y2 = x1[i] * cs.y + x2[i] * cs.x; x1[i] = y1; x2[i] = y2; } }
#pragma unroll
    for (int i = 0; i < 8; ++i) { x1[i] *= scl; x2[i] *= scl; }
}
DI u32x4 pack8(const float (&x)[8], float s) { u32x4 o; o.x = pk2(x[0] * s, x[1] * s); o.y = pk2(x[2] * s, x[3] * s); o.z = pk2(x[4] * s, x[5] * s); o.w = pk2(x[6] * s, x[7] * s); return o; }
constexpr int RLD = 136;
constexpr int RTILE = 128 * RLD * 2;
DI int ret_row0(int b, int id) { return id < 2 ? ML + b * CTXL + id * 128 : b * SEQ + (id - 2) * 128; }

DI void ret_kv_phase(Fr& F) {
    const bf16* QKV = (const bf16*)(F.ws + WS_QKV); float* KV = (float*)(F.ws + WS_KV); const f32x2* rope = (const f32x2*)(F.ws + WS_ROPE);
    LAS bf16* Vs = (LAS bf16*)F.lds; LAS bf16* Kf = (LAS bf16*)(F.lds + RTILE); LAS bf16* Kb = (LAS bf16*)(F.lds + 2 * RTILE);
    const int wr2 = F.wave >> 1, wc2 = F.wave & 1, fr = F.lane & 15, fq = F.lane >> 4;
    for (int u = F.bx; u < NB * 4 * NCH; u += F.G) {
        const int b = u / (4 * NCH), h = (u / NCH) % 4, id = u % NCH; const int grow0 = ret_row0(b, id); const bool lat = id >= 2;
        const float lgf = -expf(F.in[9][h]), lgb = -expf(F.in[10][h]);
        for (int it = F.tid; it < 128 * 16; it += NTHR) { const int c = it >> 4, ch = it & 15;
            *(LAS u32x4*)(Vs + c * RLD + 8 * ch) = *(const u32x4*)(QKV + (size_t)(grow0 + c) * INW + 1024 + h * 128 + 8 * ch); }
        for (int it = F.tid; it < 128 * 8; it += NTHR) { const int c = it >> 3, pi = it & 7, hh = pi >> 2, jj = (pi & 3) * 8; const int t = (id - 2) * 128 + c;
            float x1[8], x2[8]; load_rope_pair(QKV + (size_t)(grow0 + c) * INW + 512 + h * 128, hh, jj, lat, t >> 6, t & 63, rope, 0.08838834764831845f, x1, x2);
            const float wf = expf(lgf * (float)(127 - c)), wb = expf(lgb * (float)c);
            *(LAS u32x4*)(Kf + c * RLD + hh * 64 + jj) = pack8(x1, wf); *(LAS u32x4*)(Kf + c * RLD + hh * 64 + jj + 32) = pack8(x2, wf);
            *(LAS u32x4*)(Kb + c * RLD + hh * 64 + jj) = pack8(x1, wb); *(LAS u32x4*)(Kb + c * RLD + hh * 64 + jj + 32) = pack8(x2, wb); }
        WG_SYNC();
#pragma unroll
        for (int dir = 0; dir < 2; ++dir) {
            const LAS bf16* Kd = dir ? Kb : Kf;
            f32x4 acc[2][4];
#pragma unroll
            for (int i = 0; i < 2; ++i)
#pragma unroll
                for (int j = 0; j < 4; ++j) acc[i][j] = (f32x4){0.f, 0.f, 0.f, 0.f};
#pragma unroll 1
            for (int k0 = 0; k0 < 128; k0 += 32) { bf16x8 af[2], bfg[4];
#pragma unroll
                for (int i = 0; i < 2; ++i) af[i] = frag_kr(Vs, RLD, 32 * wr2 + 16 * i, k0, F.lane);
#pragma unroll
                for (int j = 0; j < 4; ++j) bfg[j] = frag_kr(Kd, RLD, 64 * wc2 + 16 * j, k0, F.lane);
#pragma unroll
                for (int i = 0; i < 2; ++i)
#pragma unroll
                    for (int j = 0; j < 4; ++j) acc[i][j] = mma(acc[i][j], bfg[j], af[i]); }
            float* o = KV + ((size_t)((b * 4 + h) * 2 + dir) * NCH + id) * 16384;
#pragma unroll
            for (int i = 0; i < 2; ++i)
#pragma unroll
                for (int j = 0; j < 4; ++j) *(f32x4*)(o + (32 * wr2 + 16 * i + fr) * 128 + 64 * wc2 + 16 * j + 4 * fq) = acc[i][j];
        }
        WG_SYNC();
    }
}
DI void ret_prefix_phase(Fr& F) {
    const float* KV = (const float*)(F.ws + WS_KV); bf16* SP = (bf16*)(F.ws + WS_SPREV);
    const int gt = F.bx * NTHR + F.tid, NT = F.G * NTHR;
    for (int i = gt; i < 64 * 4096; i += NT) { const int bhd = i >> 12, e4 = i & 4095, dir = bhd & 1, h = (bhd >> 1) & 3;
        const float lg = -expf(dir ? F.in[10][h] : F.in[9][h]), cd = expf(lg * 128.f);
        f32x4 s = (f32x4){0.f, 0.f, 0.f, 0.f};
        for (int st = 0; st < NCH; ++st) { const int id = dir ? (st == 0 ? 1 : (st == 1 ? 0 : 19 - st)) : st;
            const size_t off = ((size_t)bhd * NCH + id) * 16384 + 4 * e4;
            u32x2 p; p.x = pk2(s.x, s.y); p.y = pk2(s.z, s.w); *(u32x2*)(SP + off) = p;
            s = s * cd + *(const f32x4*)(KV + off); }
    }
}
DI void ret_out_phase(Fr& F) {
    const bf16* QKV = (const bf16*)(F.ws + WS_QKV); const bf16* SP = (const bf16*)(F.ws + WS_SPREV); bf16* MIX = (bf16*)(F.ws + WS_MIX); const f32x2* rope = (const f32x2*)(F.ws + WS_ROPE);
    LAS bf16* Qs = (LAS bf16*)F.lds; LAS bf16* KP = (LAS bf16*)(F.lds + RTILE); LAS bf16* Vs = (LAS bf16*)(F.lds + 2 * RTILE); LAS bf16* Sf = (LAS bf16*)(F.lds + 3 * RTILE);
    LAS float* red = (LAS float*)(F.lds + 4 * RTILE);
    const int wr2 = F.wave >> 1, wc2 = F.wave & 1, fr = F.lane & 15, fq = F.lane >> 4;
    for (int u = F.bx; u < NB * 4 * NCH; u += F.G) {
        const int b = u / (4 * NCH), h = (u / NCH) % 4, id = u % NCH; const int grow0 = ret_row0(b, id); const bool lat = id >= 2;
        const float lgf = -expf(F.in[9][h]), lgb = -expf(F.in[10][h]);
        const bf16* spf = SP + ((size_t)((b * 4 + h) * 2 + 0) * NCH + id) * 16384; const bf16* spb = SP + ((size_t)((b * 4 + h) * 2 + 1) * NCH + id) * 16384;
        for (int it = F.tid; it < 128 * 16; it += NTHR) { const int c = it >> 4, ch = it & 15;
            *(LAS u32x4*)(Vs + c * RLD + 8 * ch) = *(const u32x4*)(QKV + (size_t)(grow0 + c) * INW + 1024 + h * 128 + 8 * ch);
            *(LAS u32x4*)(Sf + c * RLD + 8 * ch) = *(const u32x4*)(spf + c * 128 + 8 * ch); }
        for (int it = F.tid; it < 128 * 8; it += NTHR) { const int c = it >> 3, pi = it & 7, hh = pi >> 2, jj = (pi & 3) * 8; const int t = (id - 2) * 128 + c;
            float x1[8], x2[8];
            load_rope_pair(QKV + (size_t)(grow0 + c) * INW + h * 128, hh, jj, lat, t >> 6, t & 63, rope, 1.f, x1, x2);
            *(LAS u32x4*)(Qs + c * RLD + hh * 64 + jj) = pack8(x1, 1.f); *(LAS u32x4*)(Qs + c * RLD + hh * 64 + jj + 32) = pack8(x2, 1.f);
            load_rope_pair(QKV + (size_t)(grow0 + c) * INW + 512 + h * 128, hh, jj, lat, t >> 6, t & 63, rope, 0.08838834764831845f, x1, x2);
            *(LAS u32x4*)(KP + c * RLD + hh * 64 + jj) = pack8(x1, 1.f); *(LAS u32x4*)(KP + c * RLD + hh * 64 + jj + 32) = pack8(x2, 1.f); }
        WG_SYNC();
        f32x4 sacc[2][4], facc[2][4];
#pragma unroll
        for (int i = 0; i < 2; ++i)
#pragma unroll
            for (int j = 0; j < 4; ++j) { sacc[i][j] = (f32x4){0.f, 0.f, 0.f, 0.f}; facc[i][j] = (f32x4){0.f, 0.f, 0.f, 0.f}; }
#pragma unroll 1
        for (int k0 = 0; k0 < 128; k0 += 32) { bf16x8 af[2], bk[4], bs[4];
#pragma unroll
            for (int i = 0; i < 2; ++i) af[i] = frag_kc(Qs, RLD, 32 * wr2 + 16 * i, k0, F.lane);
#pragma unroll
            for (int j = 0; j < 4; ++j) { bk[j] = frag_kc(KP, RLD, 64 * wc2 + 16 * j, k0, F.lane); bs[j] = frag_kc(Sf, RLD, 64 * wc2 + 16 * j, k0, F.lane); }
#pragma unroll
            for (int i = 0; i < 2; ++i)
#pragma unroll
                for (int j = 0; j < 4; ++j) { sacc[i][j] = mma(sacc[i][j], bk[j], af[i]); facc[i][j] = mma(facc[i][j], bs[j], af[i]); } }
        WG_SYNC();
        { const float lf2 = lgf * 1.4426950408889634f, lb2 = lgb * 1.4426950408889634f;
#pragma unroll
          for (int i = 0; i < 2; ++i)
#pragma unroll
            for (int j = 0; j < 4; ++j) { const int c = 32 * wr2 + 16 * i + fr, s0 = 64 * wc2 + 16 * j + 4 * fq; float pv[4];
#pragma unroll
                for (int r = 0; r < 4; ++r) { const int df = c - (s0 + r); const float wgt = df > 0 ? exp2f(lf2 * (float)df) : (df < 0 ? exp2f(lb2 * (float)(-df)) : 2.f); pv[r] = sacc[i][j][r] * wgt; }
                u32x2 p; p.x = pk2(pv[0], pv[1]); p.y = pk2(pv[2], pv[3]); *(LAS u32x2*)(KP + c * RLD + s0) = p; }
          for (int it = F.tid; it < 128 * 16; it += NTHR) { const int c = it >> 4, ch = it & 15; *(LAS u32x4*)(Sf + c * RLD + 8 * ch) = *(const u32x4*)(spb + c * 128 + 8 * ch); }
        }
        WG_SYNC();
        f32x4 oacc[2][4], bacc[2][4];
#pragma unroll
        for (int i = 0; i < 2; ++i) { const float qdf = expf(lgf * (float)(32 * wr2 + 16 * i + fr + 1));
#pragma unroll
            for (int j = 0; j < 4; ++j) { oacc[i][j] = facc[i][j] * qdf; bacc[i][j] = (f32x4){0.f, 0.f, 0.f, 0.f}; } }
#pragma unroll 1
        for (int k0 = 0; k0 < 128; k0 += 32) { bf16x8 ap[2], aq[2], bv[4], bs[4];
#pragma unroll
            for (int i = 0; i < 2; ++i) { ap[i] = frag_kc(KP, RLD, 32 * wr2 + 16 * i, k0, F.lane); aq[i] = frag_kc(Qs, RLD, 32 * wr2 + 16 * i, k0, F.lane); }
#pragma unroll
            for (int j = 0; j < 4; ++j) { bv[j] = frag_kr(Vs, RLD, 64 * wc2 + 16 * j, k0, F.lane); bs[j] = frag_kc(Sf, RLD, 64 * wc2 + 16 * j, k0, F.lane); }
#pragma unroll
            for (int i = 0; i < 2; ++i)
#pragma unroll
                for (int j = 0; j < 4; ++j) { oacc[i][j] = mma(oacc[i][j], bv[j], ap[i]); bacc[i][j] = mma(bacc[i][j], bs[j], aq[i]); } }
        float rs[2], rq[2];
#pragma unroll
        for (int i = 0; i < 2; ++i) { const int c = 32 * wr2 + 16 * i + fr; const float qdb = expf(lgb * (float)(128 - c)); float s = 0.f, q = 0.f;
#pragma unroll
            for (int j = 0; j < 4; ++j) { oacc[i][j] = oacc[i][j] + bacc[i][j] * qdb;
#pragma unroll
                for (int r = 0; r < 4; ++r) { s += oacc[i][j][r]; q += oacc[i][j][r] * oacc[i][j][r]; } }
            s += __shfl_xor(s, 16); s += __shfl_xor(s, 32); q += __shfl_xor(q, 16); q += __shfl_xor(q, 32);
            if (fq == 0) { red[(c * 2 + wc2) * 2 + 0] = s; red[(c * 2 + wc2) * 2 + 1] = q; }
            rs[i] = s; rq[i] = q; }
        WG_SYNC();
#pragma unroll
        for (int i = 0; i < 2; ++i) { const int c = 32 * wr2 + 16 * i + fr;
            const float s = red[(c * 2 + 0) * 2 + 0] + red[(c * 2 + 1) * 2 + 0], q = red[(c * 2 + 0) * 2 + 1] + red[(c * 2 + 1) * 2 + 1];
            const float mean = s * (1.f / 128.f), var = fmaxf(q * (1.f / 128.f) - mean * mean, 0.f), rstd = rsqrtf(var + 1e-5f);
            const size_t grow = (size_t)(grow0 + c);
#pragma unroll
            for (int j = 0; j < 4; ++j) { const int e0 = 64 * wc2 + 16 * j + 4 * fq;
                const f32x4 gw = *(const f32x4*)(F.in[11] + h * 128 + e0); const u32x2 gg = *(const u32x2*)(QKV + grow * INW + 1536 + h * 128 + e0);
                const float g0 = bflo(gg.x), g1 = bfhi(gg.x), g2 = bflo(gg.y), g3 = bfhi(gg.y);
                const f32x4 y = (oacc[i][j] - mean) * rstd * gw;
                u32x2 p; p.x = pk2(y.x * siluf_(g0), y.y * siluf_(g1)); p.y = pk2(y.z * siluf_(g2), y.w * siluf_(g3));
                *(u32x2*)(MIX + grow * D + h * 128 + e0) = p; } }
        (void)rs; (void)rq;
        WG_SYNC();
    }
}

constexpr int NLD = 72;
DI void na_phase(Fr& F) {
    const bf16* QKV = (const bf16*)(F.ws + WS_QKV); bf16* MIX = (bf16*)(F.ws + WS_MIX);
    LAS bf16* Qs = (LAS bf16*)F.lds;
    LAS bf16* Ks = (LAS bf16*)(F.lds + 9216);
    LAS bf16* Vs = (LAS bf16*)(F.lds + 9216 + 36864);
    LAS bf16* Pw = (LAS bf16*)(F.lds + 9216 + 2 * 36864) + F.wave * (16 * RLD);
    LAS float* comb = (LAS float*)(F.lds + 9216 + 2 * 36864);
    LAS float* rpbs = (LAS float*)(F.lds + 9216 + 2 * 36864 + 34816);
    const int mq = F.wave >> 1, kh = F.wave & 1, fr = F.lane & 15, fq = F.lane >> 4;
    float bound;
    { float mqw = fabsf(F.in[12][F.lane]), mkw = fabsf(F.in[13][F.lane]), mb = 0.f;
      for (int i = F.lane; i < 8 * 15 * 31; i += 64) mb = fmaxf(mb, fabsf(F.in[14][i]));
      bound = 8.f * wave_max(mqw) * wave_max(mkw) + wave_max(mb); }
    for (int u = F.bx; u < 2048 + 256; u += F.G) {
        int b, head, r = 0, r0 = 0, qrow0, blk0;
        if (u < 2048) { b = u >> 8; head = (u >> 5) & 7; r = u & 31; r0 = min(max(r - 4, 0), 24); qrow0 = b * SEQ + r * 64; blk0 = 0; }
        else { const int cu = u - 2048; b = cu >> 5; head = (cu >> 2) & 7; qrow0 = ML + b * CTXL + (cu & 3) * 64; blk0 = 2; }
        { const int row = F.tid >> 3, c8 = F.tid & 7;
          const u32x4 a = *(const u32x4*)(QKV + (size_t)(qrow0 + row) * INW + 2048 + head * 64 + 8 * c8); const unsigned aw[4] = {a.x, a.y, a.z, a.w}; float x[8]; float ss = 0.f;
#pragma unroll
          for (int i = 0; i < 4; ++i) { x[2 * i] = bflo(aw[i]); x[2 * i + 1] = bfhi(aw[i]); ss += x[2 * i] * x[2 * i] + x[2 * i + 1] * x[2 * i + 1]; }
          const float rinv = rsqrtf(red8(ss) * (1.f / 64.f) + 1e-6f) * 0.125f;
#pragma unroll
          for (int i = 0; i < 8; ++i) x[i] *= F.in[12][8 * c8 + i];
          *(LAS u32x4*)(Qs + row * NLD + 8 * c8) = pack8(x, rinv); }
        for (int i = F.tid; i < 15 * 31; i += NTHR) rpbs[i] = F.in[14][head * 465 + i];
        f32x4 oacc[4]; float lsum = 0.f;
#pragma unroll
        for (int j = 0; j < 4; ++j) oacc[j] = (f32x4){0.f, 0.f, 0.f, 0.f};
        for (int blk = blk0; blk < 3; ++blk) {
            for (int it = F.tid; it < 256 * 8; it += NTHR) { const int krow = it >> 3, c8 = it & 7;
                const int grow = blk < 2 ? b * SEQ + (r0 + 4 * blk + (krow >> 6)) * 64 + (krow & 63) : ML + b * CTXL + krow;
                const u32x4 a = *(const u32x4*)(QKV + (size_t)grow * INW + 2560 + head * 64 + 8 * c8); const unsigned aw[4] = {a.x, a.y, a.z, a.w}; float x[8]; float ss = 0.f;
#pragma unroll
                for (int i = 0; i < 4; ++i) { x[2 * i] = bflo(aw[i]); x[2 * i + 1] = bfhi(aw[i]); ss += x[2 * i] * x[2 * i] + x[2 * i + 1] * x[2 * i + 1]; }
                const float rinv = rsqrtf(red8(ss) * (1.f / 64.f) + 1e-6f);
#pragma unroll
                for (int i = 0; i < 8; ++i) x[i] *= F.in[13][8 * c8 + i];
                *(LAS u32x4*)(Ks + krow * NLD + 8 * c8) = pack8(x, rinv);
                *(LAS u32x4*)(Vs + krow * NLD + 8 * c8) = *(const u32x4*)(QKV + (size_t)grow * INW + 3072 + head * 64 + 8 * c8); }
            WG_SYNC();
            f32x4 sacc[8];
#pragma unroll
            for (int j = 0; j < 8; ++j) sacc[j] = (f32x4){0.f, 0.f, 0.f, 0.f};
#pragma unroll
            for (int k0 = 0; k0 < 64; k0 += 32) { const bf16x8 aq = frag_kc(Qs, NLD, 16 * mq, k0, F.lane);
#pragma unroll
                for (int j = 0; j < 8; ++j) sacc[j] = mma(sacc[j], frag_kc(Ks, NLD, 128 * kh + 16 * j, k0, F.lane), aq); }
            const int c = 16 * mq + fr, c0 = min(max(c - 8, 0), 48);
#pragma unroll
            for (int j = 0; j < 8; ++j) { float pv[4];
#pragma unroll
                for (int i = 0; i < 4; ++i) { const int key = 128 * kh + 16 * j + 4 * fq + i; float p;
                    if (blk < 2) { const int kr = 4 * blk + (key >> 6), kc = key & 63; const bool ok = (kc >= c0) && (kc < c0 + 16);
                        const float bias = ok ? rpbs[(r0 + kr - r + 7) * 31 + (kc - c + 15)] : 0.f; p = ok ? __expf(sacc[j][i] + bias - bound) : 0.f; }
                    else p = __expf(sacc[j][i] - bound);
                    pv[i] = p; lsum += p; }
                u32x2 pk; pk.x = pk2(pv[0], pv[1]); pk.y = pk2(pv[2], pv[3]); *(LAS u32x2*)(Pw + fr * RLD + 16 * j + 4 * fq) = pk; }
            LDS_WAIT();
#pragma unroll
            for (int ks = 0; ks < 4; ++ks) { const bf16x8 ap = frag_kc(Pw, RLD, 0, 32 * ks, F.lane);
#pragma unroll
                for (int j = 0; j < 4; ++j) oacc[j] = mma(oacc[j], frag_kr(Vs, NLD, 16 * j, 128 * kh + 32 * ks, F.lane), ap); }
            WG_SYNC();
        }
        lsum += __shfl_xor(lsum, 16); lsum += __shfl_xor(lsum, 32);
        if (kh == 1) {
#pragma unroll
            for (int j = 0; j < 4; ++j) *(LAS f32x4*)(comb + mq * 1040 + fr * 64 + 16 * j + 4 * fq) = oacc[j];
            if (fq == 0) comb[mq * 1040 + 1024 + fr] = lsum; }
        WG_SYNC();
        if (kh == 0) { const float inv = 1.f / (lsum + comb[mq * 1040 + 1024 + fr]);
#pragma unroll
            for (int j = 0; j < 4; ++j) { const f32x4 o = (oacc[j] + *(LAS f32x4*)(comb + mq * 1040 + fr * 64 + 16 * j + 4 * fq)) * inv;
                u32x2 p; p.x = pk2(o.x, o.y); p.y = pk2(o.z, o.w);
                *(u32x2*)(MIX + (size_t)(qrow0 + 16 * mq + fr) * D + 512 + head * 64 + 16 * j + 4 * fq) = p; } }
        WG_SYNC();
    }
}

DI void xm_phase(Fr& F, const float* xl, const float* xc, const float* normw, const float* modl) {
    bf16* XM = (bf16*)(F.ws + WS_XM); const float* mu = F.in[18];
    for (int row = F.gw; row < MA; row += F.NGW) {
        const bool lat = row < ML; const int rr = lat ? row : row - ML; const int L = lat ? SEQ : CTXL; const int t = rr % L;
        const float* src = (lat ? xl : xc) + (size_t)rr * D;
        const float* mrow = modl + (size_t)(lat ? row / SEQ : 8) * 6144;
        const bool hp = t > 0, hn = t < L - 1;
        f32x4 vc[4], vp[4], vn[4]; float sc_ = 0.f, sp_ = 0.f, sn_ = 0.f;
#pragma unroll
        for (int j = 0; j < 4; ++j) { vc[j] = ((const f32x4*)src)[F.lane + 64 * j];
            vp[j] = hp ? ((const f32x4*)(src - D))[F.lane + 64 * j] : (f32x4){0.f, 0.f, 0.f, 0.f}; vn[j] = hn ? ((const f32x4*)(src + D))[F.lane + 64 * j] : (f32x4){0.f, 0.f, 0.f, 0.f};
            sc_ += (vc[j].x * vc[j].x + vc[j].y * vc[j].y) + (vc[j].z * vc[j].z + vc[j].w * vc[j].w);
            sp_ += (vp[j].x * vp[j].x + vp[j].y * vp[j].y) + (vp[j].z * vp[j].z + vp[j].w * vp[j].w);
            sn_ += (vn[j].x * vn[j].x + vn[j].y * vn[j].y) + (vn[j].z * vn[j].z + vn[j].w * vn[j].w); }
        const float rc = rsqrtf(wave_sum(sc_) * (1.f / D) + 1e-6f), rp = rsqrtf(wave_sum(sp_) * (1.f / D) + 1e-6f), rn = rsqrtf(wave_sum(sn_) * (1.f / D) + 1e-6f);
#pragma unroll
        for (int j = 0; j < 4; ++j) { const int c4 = F.lane + 64 * j;
            const f32x4 w = ((const f32x4*)normw)[c4], sc = ((const f32x4*)(mrow + 1024))[c4], sh = ((const f32x4*)mrow)[c4];
            const f32x4 g = w * (sc + 1.f);
            const f32x4 hc = vc[j] * rc * g + sh;
            const f32x4 hpv = hp ? vp[j] * rp * g + sh : (f32x4){0.f, 0.f, 0.f, 0.f};
            const f32x4 hnv = hn ? vn[j] * rn * g + sh : (f32x4){0.f, 0.f, 0.f, 0.f};
            const f32x4 xx = (hpv + hnv) * 0.5f - hc;
#pragma unroll
            for (int s = 0; s < 6; ++s) { const f32x4 m = ((const f32x4*)(mu + s * 1024))[c4]; const f32x4 y = hc + xx * m;
                u32x2 p; p.x = pk2(y.x, y.y); p.y = pk2(y.z, y.w); ((u32x2*)(XM + ((size_t)s * MA + row) * D))[c4] = p; } }
    }
}

constexpr int SC_T = 32;
constexpr int SC_STRIDE = 6 * 64;
DI void rwkv_scan_phase(Fr& F) {
    const bf16* KB = (const bf16*)(F.ws + WS_KB); const bf16* VB = (const bf16*)(F.ws + WS_VB); const bf16* RB = (const bf16*)(F.ws + WS_RB);
    const float* DEC = (const float*)(F.ws + WS_DEC); const bf16* AG = (const bf16*)(F.ws + WS_AG);
    LAS float* buf[2] = {(LAS float*)F.lds, (LAS float*)F.lds + SC_T * SC_STRIDE};
    const int i = F.tid >> 3, cg = F.tid & 7;
    for (int u = F.bx; u < 256; u += F.G) {
        const int z = u & 1, h = (u >> 1) & 15, b = u >> 5;
        float* Y = (float*)(F.ws + (z ? WS_YB : WS_YF));
        const int ch = h * 64 + F.lane;
        const float kkw = F.in[28][ch], kaw = F.in[29][ch];
        const float* decz = DEC + (size_t)z * MA * D; const bf16* agz = AG + (size_t)z * MA * D;
        float s[8];
#pragma unroll
        for (int j = 0; j < 8; ++j) s[j] = 0.f;
        bf16 kreg[4], vreg[4], rreg[4], areg[4]; float dreg[4];
#define SC_ROW(n, q, rowv, latv) const int g_ = (n) * SC_T + F.wave * 4 + (q); const bool latv = g_ >= CTXL; \
        const int rowv = latv ? b * SEQ + (z ? (SEQ + CTXL - 1 - g_) : (g_ - CTXL)) : ML + b * CTXL + (z ? (CTXL - 1 - g_) : g_);
#define SC_LOAD(n) do { _Pragma("unroll") for (int q = 0; q < 4; ++q) { SC_ROW(n, q, row_, lat_) \
            kreg[q] = KB[(size_t)row_ * D + ch]; vreg[q] = VB[(size_t)row_ * D + ch]; areg[q] = agz[(size_t)row_ * D + ch]; dreg[q] = decz[(size_t)row_ * D + ch]; \
            rreg[q] = lat_ ? RB[(size_t)row_ * D + ch] : (bf16)0; } } while (0)
#define SC_STAGE(dst) do { _Pragma("unroll") for (int q = 0; q < 4; ++q) { const float kr_ = bf1(kreg[q]), ag_ = bf1(areg[q]); float kk_ = kr_ * kkw; \
            const float nr_ = sqrtf(wave_sum(kk_ * kk_)); kk_ = kk_ / fmaxf(nr_, 1e-12f); LAS float* d_ = (dst) + (F.wave * 4 + q) * SC_STRIDE + F.lane; \
            d_[0] = -kk_; d_[64] = dreg[q]; d_[128] = kk_ * ag_; d_[192] = kr_ * (1.f + (ag_ - 1.f) * kaw); d_[256] = bf1(rreg[q]); d_[320] = bf1(vreg[q]); } } while (0)
        SC_LOAD(0); SC_STAGE(buf[0]);
        WG_SYNC();
        constexpr int NCHUNK = (SEQ + CTXL) / SC_T;
        for (int n = 0; n < NCHUNK; ++n) {
            if (n + 1 < NCHUNK) SC_LOAD(n + 1);
            const LAS float* cb = buf[n & 1];
            const bool lat = n * SC_T >= CTXL;
#pragma unroll 2
            for (int st = 0; st < SC_T; ++st) {
                const LAS float* p = cb + st * SC_STRIDE + 8 * cg;
                const f32x4 a0 = *(const LAS f32x4*)p, a1 = *(const LAS f32x4*)(p + 4), w0 = *(const LAS f32x4*)(p + 64), w1 = *(const LAS f32x4*)(p + 68);
                const f32x4 b0 = *(const LAS f32x4*)(p + 128), b1 = *(const LAS f32x4*)(p + 132), k0 = *(const LAS f32x4*)(p + 192), k1 = *(const LAS f32x4*)(p + 196);
                const f32x4 r0 = *(const LAS f32x4*)(p + 256), r1 = *(const LAS f32x4*)(p + 260);
                const float vi = cb[st * SC_STRIDE + 320 + i];
                float sa = (s[0] * a0.x + s[1] * a0.y) + (s[2] * a0.z + s[3] * a0.w) + (s[4] * a1.x + s[5] * a1.y) + (s[6] * a1.z + s[7] * a1.w);
                sa = red8(sa);
                s[0] = s[0] * w0.x + sa * b0.x + vi * k0.x; s[1] = s[1] * w0.y + sa * b0.y + vi * k0.y; s[2] = s[2] * w0.z + sa * b0.z + vi * k0.z; s[3] = s[3] * w0.w + sa * b0.w + vi * k0.w;
                s[4] = s[4] * w1.x + sa * b1.x + vi * k1.x; s[5] = s[5] * w1.y + sa * b1.y + vi * k1.y; s[6] = s[6] * w1.z + sa * b1.z + vi * k1.z; s[7] = s[7] * w1.w + sa * b1.w + vi * k1.w;
                if (lat) {
                    float y = (s[0] * r0.x + s[1] * r0.y) + (s[2] * r0.z + s[3] * r0.w) + (s[4] * r1.x + s[5] * r1.y) + (s[6] * r1.z + s[7] * r1.w);
                    y = red8(y);
                    const int g = n * SC_T + st; const int tl = z ? (SEQ + CTXL - 1 - g) : (g - CTXL);
                    if (cg == 0) Y[(size_t)(b * SEQ + tl) * D + h * 64 + i] = y;
                }
            }
            if (n + 1 < NCHUNK) SC_STAGE(buf[(n + 1) & 1]);
            WG_SYNC();
        }
#undef SC_ROW
#undef SC_LOAD
#undef SC_STAGE
    }
}


DI f32x4 mma16(f32x4 acc, s16x4 bfrag, s16x4 afrag) { return __builtin_amdgcn_mfma_f32_16x16x16bf16_1k(bfrag, afrag, acc, 0, 0, 0); }
DI s16x4 frag16_kc(const LAS bf16* base, int ld, int row0, int k0, int lane) { return *(const LAS s16x4*)(base + (row0 + (lane & 15)) * ld + k0 + 4 * (lane >> 4)); }
DI s16x4 frag16_kr(const LAS bf16* base, int ld, int x0, int k0, int lane) { const int g = lane >> 4, q = (lane & 15) >> 2, p = lane & 3;
    return __builtin_amdgcn_ds_read_tr16_b64_v4i16((LAS s16x4*)(base + (k0 + 4 * g + q) * ld + x0 + 4 * p)); }
DI s16x4 cvt4(f32x4 v) { u32x2 p; p.x = pk2(v.x, v.y); p.y = pk2(v.z, v.w); return __builtin_bit_cast(s16x4, p); }
constexpr int WLD = 72;
DI void rwkv_scan2_phase(Fr& F) {
    const bf16* KB = (const bf16*)(F.ws + WS_KB); const bf16* VB = (const bf16*)(F.ws + WS_VB); const bf16* RB = (const bf16*)(F.ws + WS_RB);
    const float* LW = (const float*)(F.ws + WS_DEC); const bf16* AG = (const bf16*)(F.ws + WS_AG);
    LAS bf16* AT = (LAS bf16*)F.lds; LAS bf16* BT = AT + 64 * WLD; LAS bf16* KT = BT + 64 * WLD; LAS bf16* RT = KT + 64 * WLD; LAS bf16* BH = RT + 64 * WLD; LAS bf16* KH = BH + 64 * WLD;
    LAS bf16* VN = KH + 64 * WLD; LAS bf16* W1s = VN + 64 * WLD; LAS bf16* XV = W1s + 64 * WLD;
    LAS float* AAB = (LAS float*)(XV + 64 * WLD);
    LAS bf16* AAK = (LAS bf16*)(AAB + 1024); LAS bf16* PRB = AAK + 1024; LAS bf16* PRK = PRB + 1024; LAS bf16* TT = PRK + 1024;
    LAS f32x4* UVT = (LAS f32x4*)(TT + 1024);
    LAS float* GC = (LAS float*)(UVT + 1024);
    const int cq = F.wave >> 1, half = F.wave & 1, fr = F.lane & 15, fq = F.lane >> 4;
    for (int u = F.bx; u < 256; u += F.G) {
        const int z = u & 1, h = (u >> 1) & 15, b = u >> 5;
        float* Y = (float*)(F.ws + (z ? WS_YB : WS_YF));
        const int ch = h * 64 + F.lane;
        const float kkw = F.in[28][ch], kaw = F.in[29][ch];
        const float* lwz = LW + (size_t)z * MA * D; const bf16* agz = AG + (size_t)z * MA * D;
        f32x4 S[4];
#pragma unroll
        for (int j = 0; j < 4; ++j) S[j] = (f32x4){0.f, 0.f, 0.f, 0.f};
        bf16 kreg[8], vreg[8], rreg[8], areg[8]; float lwo[8], lwx[8];
#define RW_ROW(g_, rowv, latv) const bool latv = (g_) >= CTXL; const int rowv = latv ? b * SEQ + (z ? (SEQ + CTXL - 1 - (g_)) : ((g_) - CTXL)) : ML + b * CTXL + (z ? (CTXL - 1 - (g_)) : (g_));
#define RW_LOAD(sc) do { _Pragma("unroll") for (int sx = 0; sx < 8; ++sx) { const int g3_ = (sc) * 64 + 16 * cq + 8 * half + sx; RW_ROW(g3_, row_, lat_) \
            kreg[sx] = KB[(size_t)row_ * D + ch]; vreg[sx] = VB[(size_t)row_ * D + ch]; areg[sx] = agz[(size_t)row_ * D + ch]; rreg[sx] = lat_ ? RB[(size_t)row_ * D + ch] : (bf16)0; \
            lwo[sx] = lwz[(size_t)row_ * D + ch]; const int g4_ = (sc) * 64 + 16 * cq + 8 * (1 - half) + sx; RW_ROW(g4_, row2_, lat2_) (void)lat2_; lwx[sx] = lwz[(size_t)row2_ * D + ch]; } } while (0)
        RW_LOAD(0);
        for (int sc = 0; sc < (SEQ + CTXL) / 64; ++sc) {
            const bool lat = sc * 64 >= CTXL;
            { float sx_other = 0.f;
#pragma unroll
              for (int t = 0; t < 8; ++t) sx_other += lwx[t];
              float c = half ? sx_other : 0.f; float eprev = __expf(c);
              float csv[8];
#pragma unroll
              for (int t = 0; t < 8; ++t) { c += lwo[t]; csv[t] = c; }
              const float eC = __expf(half ? c : c + sx_other);
#pragma unroll
              for (int sx = 0; sx < 8; ++sx) { const float e1 = __expf(csv[sx]), inv = __builtin_amdgcn_rcpf(e1);
                  const float kr_ = bf1(kreg[sx]), ag_ = bf1(areg[sx]); float kk_ = kr_ * kkw; kk_ = kk_ * __builtin_amdgcn_rsqf(fmaxf(wave_sum(kk_ * kk_), 1e-24f));
                  const float b_ = kk_ * ag_, kd_ = kr_ * (1.f + (ag_ - 1.f) * kaw); const int o = (16 * cq + 8 * half + sx) * WLD + F.lane;
                  AT[o] = (bf16)f2bf(-kk_ * eprev); BT[o] = (bf16)f2bf(b_ * inv); KT[o] = (bf16)f2bf(kd_ * inv); RT[o] = (bf16)f2bf(bf1(rreg[sx]) * e1);
                  BH[o] = (bf16)f2bf(b_ * eC * inv); KH[o] = (bf16)f2bf(kd_ * eC * inv); VN[o] = vreg[sx]; eprev = e1; }
              if (half == 0) GC[cq * 64 + F.lane] = eC; }
            WG_SYNC();
            if (sc + 1 < (SEQ + CTXL) / 64) RW_LOAD(sc + 1);
            { const LAS bf16* Aop = half ? RT : AT; f32x4 pb = (f32x4){0.f, 0.f, 0.f, 0.f}, pk = (f32x4){0.f, 0.f, 0.f, 0.f};
#pragma unroll
              for (int k0 = 0; k0 < 64; k0 += 32) { const bf16x8 af = frag_kc(Aop, WLD, 16 * cq, k0, F.lane);
                  pb = mma(pb, frag_kc(BT, WLD, 16 * cq, k0, F.lane), af); pk = mma(pk, frag_kc(KT, WLD, 16 * cq, k0, F.lane), af); }
#pragma unroll
              for (int r = 0; r < 4; ++r) { const int tp = 4 * fq + r; const bool keep = half ? (tp <= fr) : (tp < fr); if (!keep) { pb[r] = 0.f; pk[r] = 0.f; } }
              const int o = cq * 256 + fr * 16 + 4 * fq;
              if (half == 0) { *(LAS f32x4*)(AAB + o) = pb; *(LAS s16x4*)(AAK + o) = cvt4(pk); }
              else { *(LAS s16x4*)(PRB + o) = cvt4(pb); *(LAS s16x4*)(PRK + o) = cvt4(pk); } }
            WG_SYNC();
            if (F.wave == 0) { const int q = F.lane >> 4, cc = F.lane & 15; float t[16];
#pragma unroll
                for (int tau = 0; tau < 16; ++tau) { float a[16];
#pragma unroll
                    for (int j4 = 0; j4 < 4; ++j4) { const f32x4 av = *(const LAS f32x4*)(AAB + q * 256 + tau * 16 + 4 * j4); a[4 * j4] = av.x; a[4 * j4 + 1] = av.y; a[4 * j4 + 2] = av.z; a[4 * j4 + 3] = av.w; }
                    float acc = (tau == cc) ? 1.f : 0.f;
#pragma unroll
                    for (int j = 0; j < tau; ++j) acc += a[j] * t[j];
                    t[tau] = acc; TT[q * 256 + tau * 16 + cc] = (bf16)f2bf(acc); } }
            else if (F.wave >= 4) { const int q = F.wave - 4; const s16x4 af = frag16_kc(AAK + q * 256, 16, 0, 0, F.lane);
#pragma unroll
                for (int it = 0; it < 4; ++it) { f32x4 acc = mma16((f32x4){0.f, 0.f, 0.f, 0.f}, frag16_kr(VN, WLD, 16 * it, 16 * q, F.lane), af);
                    *(LAS s16x4*)(XV + (16 * q + fr) * WLD + 16 * it + 4 * fq) = cvt4(acc); } }
            WG_SYNC();
            { const s16x4 tf = frag16_kc(TT + cq * 256, 16, 0, 0, F.lane);
              if (half == 0) {
#pragma unroll
                  for (int jt = 0; jt < 4; ++jt) { const f32x4 acc = mma16((f32x4){0.f, 0.f, 0.f, 0.f}, frag16_kr(AT, WLD, 16 * jt, 16 * cq, F.lane), tf);
                      *(LAS s16x4*)(W1s + (16 * cq + fr) * WLD + 16 * jt + 4 * fq) = cvt4(acc); } }
              else {
#pragma unroll
                  for (int it = 0; it < 4; ++it) UVT[(cq * 4 + it) * 64 + F.lane] = mma16((f32x4){0.f, 0.f, 0.f, 0.f}, tf, frag16_kr(XV, WLD, 16 * it, 16 * cq, F.lane)); } }
            WG_SYNC();
            if (F.wave < 4) { const int it = F.wave;
#pragma unroll 1
                for (int c = 0; c < 4; ++c) {
                    s16x4 sfr[4];
#pragma unroll
                    for (int jt = 0; jt < 4; ++jt) sfr[jt] = cvt4(S[jt]);
                    f32x4 Ut = UVT[(c * 4 + it) * 64 + F.lane], Yt = (f32x4){0.f, 0.f, 0.f, 0.f};
#pragma unroll
                    for (int jt = 0; jt < 4; ++jt) { Ut = mma16(Ut, frag16_kc(W1s, WLD, 16 * c, 16 * jt, F.lane), sfr[jt]); if (lat) Yt = mma16(Yt, frag16_kc(RT, WLD, 16 * c, 16 * jt, F.lane), sfr[jt]); }
                    const s16x4 ufr = cvt4(Ut), vfr = frag16_kr(VN, WLD, 16 * it, 16 * c, F.lane);
                    if (lat) { Yt = mma16(Yt, frag16_kc(PRB + c * 256, 16, 0, 0, F.lane), ufr); Yt = mma16(Yt, frag16_kc(PRK + c * 256, 16, 0, 0, F.lane), vfr);
#pragma unroll
                        for (int r = 0; r < 4; ++r) { const int g = sc * 64 + 16 * c + 4 * fq + r; const int tl = z ? (SEQ + CTXL - 1 - g) : (g - CTXL);
                            Y[(size_t)(b * SEQ + tl) * D + h * 64 + 16 * it + fr] = Yt[r]; } }
#pragma unroll
                    for (int jt = 0; jt < 4; ++jt) { const f32x4 g4 = *(const LAS f32x4*)(GC + c * 64 + 16 * jt + 4 * fq);
                        f32x4 sn = S[jt] * g4; sn = mma16(sn, frag16_kr(BH, WLD, 16 * jt, 16 * c, F.lane), ufr); sn = mma16(sn, frag16_kr(KH, WLD, 16 * jt, 16 * c, F.lane), vfr); S[jt] = sn; }
                } }
            WG_SYNC();
        }
#undef RW_ROW
#undef RW_LOAD
    }
}

DI void rwkv_readout_phase(Fr& F) {
    const bf16* KB = (const bf16*)(F.ws + WS_KB); const bf16* VB = (const bf16*)(F.ws + WS_VB); const bf16* RB = (const bf16*)(F.ws + WS_RB);
    const bf16* AG = (const bf16*)(F.ws + WS_AG); const bf16* G = (const bf16*)(F.ws + WS_G);
    const float* YF = (const float*)(F.ws + WS_YF); const float* YB = (const float*)(F.ws + WS_YB); bf16* Z = (bf16*)(F.ws + WS_H);
    const int c0 = 16 * F.lane;
    for (int row = F.gw; row < ML; row += F.NGW) {
        const size_t off = (size_t)row * D + c0;
        float y[16], kv[16], vv[16], rv[16], gv[16], a0v[16], a1v[16];
#pragma unroll
        for (int q = 0; q < 4; ++q) { const f32x4 a = *(const f32x4*)(YF + off + 4 * q), bq = *(const f32x4*)(YB + off + 4 * q);
            y[4 * q] = a.x + bq.x; y[4 * q + 1] = a.y + bq.y; y[4 * q + 2] = a.z + bq.z; y[4 * q + 3] = a.w + bq.w; }
#define RD16(dst, ptr) do { const u32x4 t0_ = *(const u32x4*)(ptr), t1_ = *(const u32x4*)((ptr) + 8); const unsigned tw_[8] = {t0_.x, t0_.y, t0_.z, t0_.w, t1_.x, t1_.y, t1_.z, t1_.w}; \
        _Pragma("unroll") for (int q_ = 0; q_ < 8; ++q_) { dst[2 * q_] = bflo(tw_[q_]); dst[2 * q_ + 1] = bfhi(tw_[q_]); } } while (0)
        RD16(kv, KB + off); RD16(vv, VB + off); RD16(rv, RB + off); RD16(gv, G + off); RD16(a0v, AG + off); RD16(a1v, AG + (size_t)MA * D + off);
#undef RD16
        float s = 0.f, cf = 0.f;
#pragma unroll
        for (int q = 0; q < 16; ++q) { s += y[q]; const float ka = F.in[29][c0 + q];
            const float kd = kv[q] * ((1.f + (a0v[q] - 1.f) * ka) + (1.f + (a1v[q] - 1.f) * ka)); cf += rv[q] * kd * F.in[30][c0 + q]; }
        s = red4(s); cf = red4(cf);
        const float mean = s * (1.f / 64.f); float q2 = 0.f;
#pragma unroll
        for (int q = 0; q < 16; ++q) { const float d = y[q] - mean; q2 += d * d; }
        q2 = red4(q2);
        const float rstd = rsqrtf(q2 * (1.f / 64.f) + 64e-5f);
        float o[16];
#pragma unroll
        for (int q = 0; q < 16; ++q) o[q] = ((y[q] - mean) * rstd * F.in[31][c0 + q] + F.in[32][c0 + q] + cf * vv[q]) * gv[q];
        u32x4 p0, p1; p0.x = pk2(o[0], o[1]); p0.y = pk2(o[2], o[3]); p0.z = pk2(o[4], o[5]); p0.w = pk2(o[6], o[7]); p1.x = pk2(o[8], o[9]); p1.y = pk2(o[10], o[11]); p1.z = pk2(o[12], o[13]); p1.w = pk2(o[14], o[15]);
        *(u32x4*)(Z + off) = p0; *(u32x4*)(Z + off + 8) = p1;
    }
}

DI void moe_route_phase(Fr& F, const float* xl, const float* normw, const float* modl) {
    bf16* H2 = (bf16*)(F.ws + WS_MIX); int* TopE = (int*)(F.ws + WS_MISC + MISC_TOPE); f32x2* TopW = (f32x2*)(F.ws + WS_MISC + MISC_TOPW); int* Cnts = (int*)(F.ws + WS_MISC + MISC_CNTS);
    LAS float* rt = (LAS float*)F.lds;
    LAS int* lc = (LAS int*)(F.lds + 32768);
    for (int idx = F.tid; idx < 1024 * 8 / 4; idx += NTHR) ((LAS f32x4*)rt)[idx] = ((const f32x4*)F.in[34])[idx];
    for (int wg = F.bx; wg < 256; wg += F.G) {
        WG_SYNC();
        for (int it = 0; it < 8; ++it) { const int row = wg * 64 + F.wave * 8 + it;
            const float* src = xl + (size_t)row * D; const float* mrow = modl + (size_t)(row / SEQ) * 6144;
            f32x4 v[4]; float ss = 0.f;
#pragma unroll
            for (int j = 0; j < 4; ++j) { v[j] = ((const f32x4*)src)[F.lane + 64 * j]; ss += (v[j].x * v[j].x + v[j].y * v[j].y) + (v[j].z * v[j].z + v[j].w * v[j].w); }
            const float rstd = rsqrtf(wave_sum(ss) * (1.f / D) + 1e-6f);
            float lg[8];
#pragma unroll
            for (int e = 0; e < 8; ++e) lg[e] = 0.f;
#pragma unroll
            for (int j = 0; j < 4; ++j) { const int c4 = F.lane + 64 * j;
                const f32x4 w = ((const f32x4*)normw)[c4], sc = ((const f32x4*)(mrow + 4096))[c4], sh = ((const f32x4*)(mrow + 3072))[c4];
                const f32x4 y = v[j] * rstd * w * (sc + 1.f) + sh;
                u32x2 p; p.x = pk2(y.x, y.y); p.y = pk2(y.z, y.w); ((u32x2*)(H2 + (size_t)row * D))[c4] = p;
                const float yy[4] = {y.x, y.y, y.z, y.w};
#pragma unroll
                for (int q = 0; q < 4; ++q) { const f32x4 r0 = *(const LAS f32x4*)(rt + (4 * c4 + q) * 8), r1 = *(const LAS f32x4*)(rt + (4 * c4 + q) * 8 + 4);
                    lg[0] += yy[q] * r0.x; lg[1] += yy[q] * r0.y; lg[2] += yy[q] * r0.z; lg[3] += yy[q] * r0.w; lg[4] += yy[q] * r1.x; lg[5] += yy[q] * r1.y; lg[6] += yy[q] * r1.z; lg[7] += yy[q] * r1.w; } }
#pragma unroll
            for (int e = 0; e < 8; ++e) lg[e] = wave_sum(lg[e]);
            int e0 = 0; float v0 = lg[0];
#pragma unroll
            for (int e = 1; e < 8; ++e) if (lg[e] > v0) { v0 = lg[e]; e0 = e; }
            int e1 = -1; float v1 = -3.0e38f;
#pragma unroll
            for (int e = 0; e < 8; ++e) if (e != e0 && lg[e] > v1) { v1 = lg[e]; e1 = e; }
            const float w0 = 1.f / (1.f + expf(v1 - v0)), w1 = 1.f - w0;
            if (F.lane == 0) { TopE[row] = e0 | (e1 << 8); TopW[row] = (f32x2){w0, w1}; lc[F.wave * 8 + it] = e0 | (e1 << 8); }
        }
        WG_SYNC();
        if (F.tid < 8) { int c = 0; for (int t = 0; t < 64; ++t) { const int code = lc[t]; c += ((code & 255) == F.tid ? 1 : 0) + ((code >> 8) == F.tid ? 1 : 0); } Cnts[wg * 8 + F.tid] = c; }
        WG_SYNC();
    }
}
DI void moe_gather_phase(Fr& F) {
    const bf16* H2 = (const bf16*)(F.ws + WS_MIX); const int* TopE = (const int*)(F.ws + WS_MISC + MISC_TOPE); const f32x2* TopW = (const f32x2*)(F.ws + WS_MISC + MISC_TOPW);
    const int* Cnts = (const int*)(F.ws + WS_MISC + MISC_CNTS); int* Exp = (int*)(F.ws + WS_MISC + MISC_EXP);
    bf16* XG = (bf16*)(F.ws + WS_XG); int* RowTok = (int*)(F.ws + WS_ROWS); float* RowW = (float*)(F.ws + WS_ROWS + 262144);
    LAS int* lc = (LAS int*)F.lds;
    LAS int* tot = lc + 2048;
    LAS int* rows = tot + 32;
    LAS int* te = rows + 128;
    for (int idx = F.tid; idx < 2048; idx += NTHR) lc[idx] = Cnts[idx];
    WG_SYNC();
    for (int wg = F.bx; wg < 256; wg += F.G) {
        if (F.tid < 64) te[F.tid] = TopE[wg * 64 + F.tid];
        if (F.tid < 8) { int t = 0, mb = 0; for (int w = 0; w < 256; ++w) { const int c = lc[w * 8 + F.tid]; t += c; mb += (w < wg) ? c : 0; } tot[F.tid] = t; tot[16 + F.tid] = mb; }
        WG_SYNC();
        if (F.tid == 0) { int sgs = 0; for (int e = 0; e < 8; ++e) { tot[8 + e] = sgs; sgs += (tot[e] + 255) & ~255; }
            if (wg == 0) { int acc = 0; for (int e = 0; e < 8; ++e) { Exp[e] = tot[e]; Exp[8 + e] = tot[8 + e]; acc += (tot[e] + 255) >> 8; Exp[16 + e] = acc; } } }
        WG_SYNC();
        if (F.tid < 64) { const int code = te[F.tid]; const int e0 = code & 255, e1 = code >> 8; int r0 = 0, r1 = 0;
            for (int t = 0; t < F.tid; ++t) { const int c2 = te[t]; const int a = c2 & 255, bq = c2 >> 8; r0 += (a == e0 ? 1 : 0) + (bq == e0 ? 1 : 0); r1 += (a == e1 ? 1 : 0) + (bq == e1 ? 1 : 0); }
            rows[2 * F.tid] = tot[8 + e0] + tot[16 + e0] + r0; rows[2 * F.tid + 1] = tot[8 + e1] + tot[16 + e1] + r1; }
        WG_SYNC();
        for (int it = F.wave; it < 128; it += NWAVES) { const int t = it >> 1, k = it & 1, tok = wg * 64 + t, row = rows[it];
            const u32x4* s = (const u32x4*)(H2 + (size_t)tok * D); u32x4* d = (u32x4*)(XG + (size_t)row * D);
            d[F.lane] = s[F.lane]; d[F.lane + 64] = s[F.lane + 64];
            if (F.lane == 0) { RowTok[row] = tok * 2 + k; const f32x2 w = TopW[tok]; RowW[row] = k ? w.y : w.x; } }
        if (wg == 0) {
            for (int e = 0; e < 8; ++e) { const int a = tot[8 + e] + tot[e], bnd = tot[8 + e] + ((tot[e] + 255) & ~255); for (int rr = a + F.tid; rr < bnd; rr += NTHR) RowTok[rr] = -1; } }
        WG_SYNC();
    }
}
DI void moe_combine_phase(Fr& F, float* xl, const float* modl) {
    const bf16* YS = (const bf16*)(F.ws + WS_YS);
    for (int row = F.gw; row < ML; row += F.NGW) {
        const float* mrow = modl + (size_t)(row / SEQ) * 6144 + 5120; float* xr = xl + (size_t)row * D;
        const u32x2* s0 = (const u32x2*)(YS + (size_t)(2 * row) * D); const u32x2* s1 = (const u32x2*)(YS + (size_t)(2 * row + 1) * D);
#pragma unroll
        for (int j = 0; j < 4; ++j) { const int c4 = F.lane + 64 * j; const f32x4 x = ((const f32x4*)xr)[c4], m = ((const f32x4*)mrow)[c4]; const u32x2 a = s0[c4], bq = s1[c4];
            f32x4 o; o.x = x.x + m.x * (bflo(a.x) + bflo(bq.x)); o.y = x.y + m.y * (bfhi(a.x) + bfhi(bq.x)); o.z = x.z + m.z * (bflo(a.y) + bflo(bq.y)); o.w = x.w + m.w * (bfhi(a.y) + bfhi(bq.y));
            ((f32x4*)xr)[c4] = o; }
    }
}

constexpr int N_PHASES = 20;
struct Args { const float* in[37]; float* out; unsigned char* ws; int ph_lo, ph_hi; };
template <class Epi> DI void run_gemm(Fr& F, const bf16* A, const bf16* Bt, int M, int N, int K, const Epi& E, int& rot) {
    int Kv = K; asm volatile("" : "+s"(Kv));
    pg8::Gemm g{A, Bt, M, N, Kv}; pg8::StaticOrder S; S.init(M, N, F.G, (F.bx + F.G - (rot % F.G)) % F.G); rot += (M / 256) * (N / 256);
    pg8::gemm_phase<Epi, pg8::StaticOrder>(F.lds, g, S, E);
}
__global__ void __launch_bounds__(NTHR, 2) fwd_kernel(Args args) {
    extern __shared__ __attribute__((aligned(16))) unsigned char lds_raw[];
    Fr F;
    F.lds = (LAS unsigned char*)lds_raw; F.ws = args.ws; F.in = args.in; F.out = args.out;
    F.tid = threadIdx.x; F.lane = F.tid & 63; F.wave = __builtin_amdgcn_readfirstlane(F.tid >> 6); F.bx = blockIdx.x; F.G = gridDim.x;
    F.gw = F.bx * NWAVES + F.wave; F.NGW = F.G * NWAVES;
    volatile LAS unsigned* MISC = (volatile LAS unsigned*)(F.lds + LDS_MISC_OFF);
    if (F.tid < 64) MISC[F.tid] = 0u;
    __syncthreads();
    const int lo = args.ph_lo, hi = args.ph_hi;
    const bool multi = (hi - lo) > 1;
    XcdBarrier bar; bar.bar = (unsigned*)(F.ws + WS_CTL) + CW_BAR; bar.x = 0; bar.st = nullptr;
    if (multi) bar = xcd_barrier_post((unsigned*)(F.ws + WS_CTL) + CW_BAR, MISC + 8);
#ifndef PH_MASK
#define PH_MASK 0xFFFFFFFFu
#endif
#define IN(k) ((((PH_MASK) >> (k)) & 1u) && lo <= (k) && (k) < hi)
#ifndef PROBE_DUP
#define PROBE_DUP 0u
#endif
#define REP(k) for (int rep_ = 0; rep_ < ((((PROBE_DUP) >> (k)) & 1u) ? 2 : 1); ++rep_)
#define SEAM(k) do { if (IN(k) && IN((k) + 1)) xcd_barrier(bar); } while (0)
    const float* const* in = args.in;
    float* MOD = (float*)(F.ws + WS_MOD);
    float* XL = F.out; float* XC = (float*)(F.ws + WS_XC);
    bf16* H = (bf16*)(F.ws + WS_H); bf16* MIX = (bf16*)(F.ws + WS_MIX);

    if (IN(0)) REP(0) { p0_prologue(F); } SEAM(0);
    if (IN(1)) REP(1) { mod_rows(F, in[0], in[2], MA, in[6], MOD, 0, 1024, H); } SEAM(1);
    if (IN(2)) REP(2) { int rot = 0; EpiStore<0> E{(bf16*)(F.ws + WS_QKV), INW, INW}; run_gemm(F, H, (const bf16*)(F.ws + WS_W_IN), MA, INW, 1024, E, rot); } SEAM(2);
    if (IN(3)) REP(3) { ret_kv_phase(F); } SEAM(3);
    if (IN(4)) REP(4) { ret_prefix_phase(F); } SEAM(4);
    #ifndef PH5_SEL
#define PH5_SEL 3
#endif
    if (IN(5)) REP(5) { if (PH5_SEL & 1) ret_out_phase(F); if (PH5_SEL & 2) na_phase(F); } SEAM(5);
    if (IN(6)) REP(6) { int rot = 0; EpiResid E{in[0], XL, in[2], XC, MOD + 2048}; run_gemm(F, MIX, (const bf16*)(F.ws + WS_W_OUT), MA, 1024, 1024, E, rot); } SEAM(6);
    if (IN(7)) REP(7) { mod_rows(F, XL, XC, MA, in[7], MOD, 3072, 4096, H); } SEAM(7);
    if (IN(8)) REP(8) { int rot = 0; EpiSwiglu E{(bf16*)(F.ws + WS_FFH), FFN_H}; run_gemm(F, H, (const bf16*)(F.ws + WS_W_13), MA, 2 * FFN_H, 1024, E, rot); } SEAM(8);
    if (IN(9)) { int rot = 0; EpiResid E{XL, XL, XC, XC, MOD + 5120}; run_gemm(F, (const bf16*)(F.ws + WS_FFH), (const bf16*)(F.ws + WS_W_2), MA, 1024, FFN_H, E, rot); } SEAM(9);
    const float* MOD1 = MOD + 9 * 6144;
    if (IN(10)) REP(10) { xm_phase(F, XL, XC, in[6] + 1024, MOD1); } SEAM(10);
    if (IN(11)) REP(11) { int rot = 0; const bf16* XM = (const bf16*)(F.ws + WS_XM); const bf16* WR = (const bf16*)(F.ws + WS_W_RKV); const bf16* WL1 = (const bf16*)(F.ws + WS_W_L1);
        { EpiStore<0> E{(bf16*)(F.ws + WS_RB), D, D}; run_gemm(F, XM, WR, ML, 1024, 1024, E, rot); }
        { EpiStore<0> E{(bf16*)(F.ws + WS_KB), D, D}; run_gemm(F, XM + (size_t)1 * MA * D, WR + 1024 * 1024, MA, 1024, 1024, E, rot); }
        { EpiStore<0> E{(bf16*)(F.ws + WS_VB), D, D}; run_gemm(F, XM + (size_t)2 * MA * D, WR + 2 * 1024 * 1024, MA, 1024, 1024, E, rot); }
        { EpiStore<1> E{(bf16*)(F.ws + WS_L1), 256, 128}; run_gemm(F, XM + (size_t)3 * MA * D, WL1, MA, 256, 1024, E, rot); }
        { EpiStore<0> E{(bf16*)(F.ws + WS_L1) + 128, 256, 128}; run_gemm(F, XM + (size_t)4 * MA * D, WL1 + 256 * 1024, MA, 256, 1024, E, rot); }
        { EpiStore<2> E{(bf16*)(F.ws + WS_LG), 256, 256}; run_gemm(F, XM + (size_t)5 * MA * D, WL1 + 2 * 256 * 1024, ML, 256, 1024, E, rot); } } SEAM(11);
    if (IN(12)) REP(12) { int rot = 0;
        { EpiLora2 E{(float*)(F.ws + WS_DEC), (bf16*)(F.ws + WS_AG), in[20], in[23]}; run_gemm(F, (const bf16*)(F.ws + WS_L1), (const bf16*)(F.ws + WS_W_L2), MA, 4096, 256, E, rot); }
        { EpiStore<0> E{(bf16*)(F.ws + WS_G), D, D}; run_gemm(F, (const bf16*)(F.ws + WS_LG), (const bf16*)(F.ws + WS_W_G2), ML, 1024, 256, E, rot); } } SEAM(12);
    #ifndef SCAN_VER
#define SCAN_VER 2
#endif
    if (IN(13)) REP(13) { if (SCAN_VER == 2) rwkv_scan2_phase(F); else rwkv_scan_phase(F); } SEAM(13);
    if (IN(14)) REP(14) { rwkv_readout_phase(F); } SEAM(14);
    if (IN(15)) { int rot = 0; EpiResid E{XL, XL, XC, XC, MOD1 + 2048}; run_gemm(F, H, (const bf16*)(F.ws + WS_W_O), ML, 1024, 1024, E, rot); } SEAM(15);
    if (IN(16)) REP(16) { moe_route_phase(F, XL, in[7] + 1024, MOD1); } SEAM(16);
    if (IN(17)) REP(17) { moe_gather_phase(F); } SEAM(17);
    if (IN(18) || IN(19)) {
        const int* Exp = (const int*)(F.ws + WS_MISC + MISC_EXP);
        pg8::MoeOrder S; S.G = F.G; S.c = F.bx;
#pragma unroll
        for (int e = 0; e < 8; ++e) S.tend[e] = Exp[16 + e];
        S.nM = S.tend[7];
        if (IN(18)) { S.nN = 2 * EXP_H / 256; S.nwg = S.nM * S.nN; pg8::Gemm g{(const bf16*)(F.ws + WS_XG), (const bf16*)(F.ws + WS_W_M13), XG_ROWS, 2 * EXP_H, 1024};
            EpiSwiglu E{(bf16*)(F.ws + WS_HG), EXP_H}; pg8::gemm_phase<EpiSwiglu, pg8::MoeOrder>(F.lds, g, S, E); }
        SEAM(18);
        if (IN(19)) { S.nN = 4; S.nwg = S.nM * S.nN; pg8::Gemm g{(const bf16*)(F.ws + WS_HG), (const bf16*)(F.ws + WS_W_M2), XG_ROWS, 1024, EXP_H};
            EpiMoeOut E{(bf16*)(F.ws + WS_YS), (const int*)(F.ws + WS_ROWS), (const float*)(F.ws + WS_ROWS + 262144)}; pg8::gemm_phase<EpiMoeOut, pg8::MoeOrder>(F.lds, g, S, E); }
    }
    if (IN(19) && IN(20)) xcd_barrier(bar);
    if (IN(20)) { moe_combine_phase(F, XL, MOD1); }
#undef IN
#undef SEAM
}

#ifndef MK_SPLIT
#define MK_SPLIT 0
#endif
extern "C" void kernel_launch(void* const* d_in, const int* in_sizes, int n_in, void* d_out, int out_size, void* d_ws, size_t ws_size, hipStream_t stream) {
    static int grid = 0;
    if (grid == 0) {
        if (n_in != 37 || out_size != ML * D || ws_size < WS_END) { fprintf(stderr, "kernel_launch: unexpected problem (n_in %d out %d ws %zu)\n", n_in, out_size, ws_size); grid = -1; return; }
        int dev = 0, cus = 0, per_cu = 0;
        if (hipGetDevice(&dev) != hipSuccess || hipDeviceGetAttribute(&cus, hipDeviceAttributeMultiprocessorCount, dev) != hipSuccess) { grid = -1; return; }
        if (hipFuncSetAttribute((const void*)fwd_kernel, hipFuncAttributeMaxDynamicSharedMemorySize, LDS_BYTES) != hipSuccess) { fprintf(stderr, "kernel_launch: hipFuncSetAttribute failed\n"); grid = -1; return; }
        if (hipOccupancyMaxActiveBlocksPerMultiprocessor(&per_cu, (const void*)fwd_kernel, NTHR, LDS_BYTES) != hipSuccess || per_cu < 1) { fprintf(stderr, "kernel_launch: occupancy query says %d\n", per_cu); }
        (void)hipGetLastError();
        grid = cus;
    }
    if (grid < 0) return;
    (void)hipMemsetAsync((char*)d_ws + WS_CTL, 0, CTL_ZERO_BYTES, stream);
    Args a{};
    for (int i = 0; i < 37; ++i) a.in[i] = (const float*)d_in[i];
    a.out = (float*)d_out; a.ws = (unsigned char*)d_ws;
#if MK_SPLIT
    for (int p = 0; p <= N_PHASES; ++p) { a.ph_lo = p; a.ph_hi = p + 1; hipLaunchKernelGGL(fwd_kernel, dim3(grid), dim3(NTHR), LDS_BYTES, stream, a); }
#else
    a.ph_lo = 0; a.ph_hi = N_PHASES + 1; hipLaunchKernelGGL(fwd_kernel, dim3(grid), dim3(NTHR), LDS_BYTES, stream, a);
#endif
}
```

```cpp
#include <hip/hip_runtime.h>
#include <cstdio>
#include <cstdint>

#ifndef PROBE_DUP
#define PROBE_DUP 0u
#endif
#define DI __device__ __forceinline__
#define LAS __attribute__((address_space(3)))

namespace pg8 {
#define PG8_LAS __attribute__((address_space(3)))
typedef unsigned short bf16_t;
typedef short bf16x8 __attribute__((ext_vector_type(8)));
typedef float f32x4 __attribute__((ext_vector_type(4)));
typedef unsigned u32x4 __attribute__((ext_vector_type(4)));
constexpr int BM = 256, BK = 64, HALF = 128, HTB = HALF * BK * 2  , STAGE_BYTES = 8 * HTB, NXCD = 8, WGM = 8;

__host__ __device__ __forceinline__ int lds_byte(int r, int c) { const int st = (r >> 4) * 2 + (c >> 5), rr = r & 15, cc = c & 31, ob = rr * 64 + cc * 2; return st * 1024 + (ob ^ (((ob >> 9) & 1) << 5)); }
__host__ __device__ __forceinline__ void stage_rc(int b, int& R, int& C) { const int st = b / 1024, sb = b % 1024, swz = sb ^ (((sb >> 9) & 1) << 5); R = (st >> 1) * 16 + swz / 64; C = (st & 1) * 32 + (swz % 64) / 2; }
__host__ __device__ __forceinline__ int perm32(int rho) { const int n = rho >> 4, i = rho & 15; return 8 * (i >> 2) + 4 * n + (i & 3); }

struct Unit { int pm, pn, pb; };
struct Gemm { const bf16_t* A; const bf16_t* Bt; int M, N, K; };

struct StaticOrder {
    int nM, nN, nwg, G, c;
    __host__ __device__ void init(int M, int N, int G_, int c_) { nM = M / BM; nN = N / BM; nwg = nM * nN; G = G_; c = c_; }
    __host__ __device__ bool next(int i, Unit& u) const {
        const long L = (long)i * G + c; if (L >= nwg) return false;
        int wgid = (int)L; { const int q = nwg / NXCD, r = nwg % NXCD, xcd = wgid % NXCD, off = wgid / NXCD; wgid = (xcd < r ? xcd * (q + 1) : r * (q + 1) + (xcd - r) * q) + off; }
        const int nig = WGM * nN, gid = wgid / nig, fm = gid * WGM, gsz = (nM - fm) < WGM ? (nM - fm) : WGM;
        u.pm = fm + ((wgid % nig) % gsz); u.pn = (wgid % nig) / gsz; u.pb = u.pn; return true;
    }
    __device__ __forceinline__ void a_ready(const Unit&) const {}
    __device__ __forceinline__ void done(const Unit&) const {}
};
struct MoeOrder {
    int nM, nN, nwg, G, c; int tend[8];
    __device__ bool next(int i, Unit& u) const {
        const long L = (long)i * G + c; if (L >= nwg) return false;
        int wgid = (int)L; { const int q = nwg / NXCD, r = nwg % NXCD, xcd = wgid % NXCD, off = wgid / NXCD; wgid = (xcd < r ? xcd * (q + 1) : r * (q + 1) + (xcd - r) * q) + off; }
        const int nig = WGM * nN, gid = wgid / nig, fm = gid * WGM, gsz = (nM - fm) < WGM ? (nM - fm) : WGM;
        u.pm = fm + ((wgid % nig) % gsz); u.pn = (wgid % nig) / gsz;
        int e = 0;
#pragma unroll
        for (int j = 0; j < 7; ++j) e += (u.pm >= tend[j]) ? 1 : 0;
        u.pb = e * nN + u.pn; return true;
    }
    __device__ __forceinline__ void a_ready(const Unit&) const {}
    __device__ __forceinline__ void done(const Unit&) const {}
};

typedef float f32x2_t __attribute__((ext_vector_type(2))); typedef __bf16 bf16x2_t __attribute__((ext_vector_type(2)));
__device__ __forceinline__ unsigned cvt_pk_bf16(float lo, float hi) { const f32x2_t v = {lo, hi}; const bf16x2_t b = __builtin_convertvector(v, bf16x2_t); return __builtin_bit_cast(unsigned, b); }

template <class Epi, class Sched>
__device__ __forceinline__ void gemm_phase(PG8_LAS unsigned char* lds, const Gemm g, const Sched& S, const Epi& E) {
    const int tid = threadIdx.x, wid = __builtin_amdgcn_readfirstlane(tid >> 6), lane = tid & 63, wr = wid >> 2, wc = wid & 3, fr = lane & 15, fq = lane >> 4;
    const int K = g.K, nt = K / BK;
    unsigned voffA[2], voffB[2];
#pragma unroll
    for (int i = 0; i < 2; ++i) { int R, C; stage_rc(tid * 16 + i * 8192, R, C); const int Rb = Epi::PERM ? ((R & ~31) + perm32(R & 31)) : R;
        voffA[i] = (unsigned)(R * K + C) * 2u; voffB[i] = (unsigned)(Rb * K + C) * 2u; }
    const size_t kstep = (size_t)(BK * 2);
    const size_t hstep = (size_t)HALF * K * 2;
    const size_t tstep = 2 * hstep;
    const unsigned ldsw = (unsigned)wid * 1024u;
    const int aoff = lds_byte(wr * 64 + fr, fq * 8), boff = lds_byte(wc * 32 + fr, fq * 8);
#define PG8_SA(b, h) (((b) * 2 + (h)) * HTB)
#define PG8_SB(b, h) ((4 + (b) * 2 + (h)) * HTB)
#define PG8_STAGE(bufoff, gbase, voff) do { _Pragma("unroll") for (int _i = 0; _i < 2; ++_i) \
        __builtin_amdgcn_global_load_lds((const unsigned*)((const char*)(gbase) + (voff)[_i]), (PG8_LAS unsigned*)(lds + (bufoff) + ldsw + _i * 8192), 16, 0, 0); } while (0)
#define PG8_LDA(dst, b, h) do { _Pragma("unroll") for (int m = 0; m < 4; ++m) _Pragma("unroll") for (int k = 0; k < 2; ++k) dst[m][k] = *(const PG8_LAS bf16x8*)(lds + PG8_SA(b, h) + aoff + m * 2048 + k * 1024); } while (0)
#define PG8_LDB(dst, b, h) do { _Pragma("unroll") for (int n = 0; n < 2; ++n) _Pragma("unroll") for (int k = 0; k < 2; ++k) dst[n][k] = *(const PG8_LAS bf16x8*)(lds + PG8_SB(b, h) + boff + n * 2048 + k * 1024); } while (0)
#define PG8_MMA(ai, bj, At, Bt) do { __builtin_amdgcn_s_setprio(1); _Pragma("unroll") for (int m = 0; m < 4; ++m) _Pragma("unroll") for (int n = 0; n < 2; ++n) _Pragma("unroll") for (int k = 0; k < 2; ++k) \
        acc[ai][bj][m][n] = __builtin_amdgcn_mfma_f32_16x16x32_bf16(Bt[n][k], At[m][k], acc[ai][bj][m][n], 0, 0, 0); __builtin_amdgcn_s_setprio(0); } while (0)
#define PG8_WAIT_V(n) asm volatile("s_waitcnt vmcnt(" #n ")" ::: "memory")
#define PG8_WAIT_L(n) asm volatile("s_waitcnt lgkmcnt(" #n ")" ::: "memory")
#define PG8_BAR __builtin_amdgcn_s_barrier()
#define PG8_SCHED __builtin_amdgcn_sched_barrier(0)
    Unit cur, nxt; int ui = 0;
    if (!S.next(0, cur)) return;
    f32x4 acc[2][2][4][2];
#pragma unroll
    for (int a = 0; a < 2; ++a)
#pragma unroll
        for (int b = 0; b < 2; ++b)
#pragma unroll
            for (int m = 0; m < 4; ++m)
#pragma unroll
                for (int n = 0; n < 2; ++n) acc[a][b][m][n] = (f32x4){0.f, 0.f, 0.f, 0.f};
    bf16x8 At[4][2], B0[2][2], B1[2][2];
    const char* cA = (const char*)g.A + (size_t)cur.pm * tstep; const char* cB = (const char*)g.Bt + (size_t)cur.pb * tstep;
    S.a_ready(cur);
    PG8_STAGE(PG8_SB(0, 0), cB, voffB); PG8_STAGE(PG8_SA(0, 0), cA, voffA); PG8_STAGE(PG8_SB(0, 1), cB + hstep, voffB); PG8_STAGE(PG8_SA(0, 1), cA + hstep, voffA);
    if (wr == 1) PG8_BAR;
    PG8_WAIT_V(4); PG8_BAR;
    PG8_STAGE(PG8_SB(1, 0), cB + kstep, voffB); PG8_STAGE(PG8_SA(1, 0), cA + kstep, voffA); PG8_STAGE(PG8_SB(1, 1), cB + hstep + kstep, voffB);
    PG8_WAIT_V(6); PG8_BAR;
    for (;;) {
        const bool has_next = S.next(ui + 1, nxt);
        const char* nA = has_next ? (const char*)g.A + (size_t)nxt.pm * tstep : cA; const char* nB = has_next ? (const char*)g.Bt + (size_t)nxt.pb * tstep : cB;
        for (int t = 0; t < nt; t += 2) {
            const bool last = (t == nt - 2);
            const char* a1 = cA + (size_t)(t + 1) * kstep;
            const char* a2 = last ? nA : cA + (size_t)(t + 2) * kstep; const char* b2 = last ? nB : cB + (size_t)(t + 2) * kstep;
            const char* a3 = a2 + kstep; const char* b3 = b2 + kstep;
            if (last && has_next) S.a_ready(nxt);
            PG8_LDB(B0, 0, 0); PG8_SCHED; PG8_LDA(At, 0, 0); PG8_STAGE(PG8_SA(1, 1), a1 + hstep, voffA);
            PG8_WAIT_L(8); PG8_BAR; PG8_WAIT_L(0); PG8_MMA(0, 0, At, B0); PG8_BAR; PG8_SCHED;
            PG8_LDB(B1, 0, 1); PG8_STAGE(PG8_SB(0, 0), b2, voffB);
            PG8_BAR; PG8_WAIT_L(0); PG8_MMA(0, 1, At, B1); PG8_BAR;
            PG8_LDA(At, 0, 1); PG8_STAGE(PG8_SA(0, 0), a2, voffA);
            PG8_BAR; PG8_WAIT_L(0); PG8_MMA(1, 0, At, B0); PG8_BAR; PG8_SCHED;
            PG8_STAGE(PG8_SB(0, 1), b2 + hstep, voffB);
            PG8_WAIT_V(6); PG8_BAR; PG8_MMA(1, 1, At, B1); PG8_BAR;
            PG8_LDB(B0, 1, 0); PG8_SCHED; PG8_LDA(At, 1, 0); PG8_STAGE(PG8_SA(0, 1), a2 + hstep, voffA);
            PG8_WAIT_L(8); PG8_BAR; PG8_WAIT_L(0); PG8_MMA(0, 0, At, B0); PG8_BAR; PG8_SCHED;
            PG8_LDB(B1, 1, 1); PG8_STAGE(PG8_SB(1, 0), b3, voffB);
            PG8_BAR; PG8_WAIT_L(0); PG8_MMA(0, 1, At, B1); PG8_BAR;
            PG8_LDA(At, 1, 1); PG8_STAGE(PG8_SA(1, 0), a3, voffA);
            PG8_BAR; PG8_WAIT_L(0); PG8_MMA(1, 0, At, B0); PG8_BAR; PG8_SCHED;
            PG8_STAGE(PG8_SB(1, 1), b3 + hstep, voffB);
            PG8_WAIT_V(6); PG8_BAR; PG8_MMA(1, 1, At, B1); PG8_BAR;
        }
        E(acc, cur, wr, wc, fr, fq); S.done(cur);
        if (!has_next) break;
#pragma unroll
        for (int a = 0; a < 2; ++a)
#pragma unroll
            for (int b = 0; b < 2; ++b)
#pragma unroll
                for (int m = 0; m < 4; ++m)
#pragma unroll
                    for (int n = 0; n < 2; ++n) acc[a][b][m][n] = (f32x4){0.f, 0.f, 0.f, 0.f};
        cur = nxt; cA = nA; cB = nB; ++ui;
    }
    PG8_WAIT_V(0);
    if (wr == 0) PG8_BAR;
    PG8_BAR;
#undef PG8_SA
#undef PG8_SB
#undef PG8_STAGE
#undef PG8_LDA
#undef PG8_LDB
#undef PG8_MMA
#undef PG8_WAIT_V
#undef PG8_WAIT_L
#undef PG8_BAR
#undef PG8_SCHED
}
}

constexpr int D = 1024, NB = 8, SEQ = 2048, CTXL = 256;
constexpr int ML = NB * SEQ;
constexpr int MC = NB * CTXL;
constexpr int MA = ML + MC;
constexpr int INW = 3584, FFN_H = 2816, EXP_H = 3584, NEXP = 8;
constexpr int NCH = 18;
constexpr int XG_ROWS = 34816;
constexpr int NWAVES = 8, NTHR = 512;

constexpr size_t MiB = 1u << 20;
constexpr size_t WS_CTL = 0, CTL_ZERO_BYTES = 1 * MiB;
constexpr size_t WS_MOD = 1 * MiB;
constexpr size_t WS_ROPE = 2 * MiB;
constexpr size_t WS_MISC = 3 * MiB;
constexpr size_t WS_W_IN = 4 * MiB, WS_W_OUT = 11 * MiB, WS_W_13 = 13 * MiB, WS_W_2 = 24 * MiB, WS_W_RKV = 30 * MiB, WS_W_L1 = 36 * MiB,
                 WS_W_L2 = 38 * MiB, WS_W_G2 = 40 * MiB, WS_W_O = 41 * MiB, WS_W_M13 = 43 * MiB, WS_W_M2 = 155 * MiB;
constexpr size_t WS_XC = 211 * MiB, WS_H = 219 * MiB, WS_MIX = 255 * MiB, WS_R = 291 * MiB;
constexpr size_t WS_QKV = WS_R, WS_KV = WS_R + 126 * MiB, WS_SPREV = WS_R + 198 * MiB, WS_FFH = WS_R;
constexpr size_t WS_XM = WS_R, WS_DEC = WS_R, WS_AG = WS_R + 144 * MiB, WS_RB = WS_R + 216 * MiB, WS_KB = WS_R + 248 * MiB, WS_VB = WS_R + 284 * MiB,
                 WS_L1 = WS_R + 320 * MiB, WS_LG = WS_R + 329 * MiB, WS_G = WS_R + 337 * MiB, WS_YF = WS_R + 369 * MiB, WS_YB = WS_R + 433 * MiB;
constexpr size_t WS_XG = WS_R, WS_HG = WS_R + 68 * MiB, WS_YS = WS_R + 306 * MiB, WS_ROWS = WS_R + 370 * MiB;
constexpr size_t WS_END = WS_R + 497 * MiB;
static_assert(WS_END <= 896 * MiB, "workspace map");
constexpr int CW_BAR = 4096;
constexpr size_t MISC_TOPE = 0, MISC_TOPW = 65536, MISC_CNTS = 196608, MISC_EXP = 204800;

constexpr int LDS_MAIN = 147456;
constexpr int LDS_MISC_OFF = LDS_MAIN;
constexpr int LDS_BYTES = LDS_MAIN + 256;

typedef unsigned short bf16;
typedef short bf16x8 __attribute__((ext_vector_type(8)));
typedef short s16x4 __attribute__((ext_vector_type(4)));
typedef float f32x4 __attribute__((ext_vector_type(4)));
typedef float f32x2 __attribute__((ext_vector_type(2)));
typedef unsigned u32x4 __attribute__((ext_vector_type(4)));
typedef unsigned u32x2 __attribute__((ext_vector_type(2)));
#define LDS_WAIT() asm volatile("s_waitcnt lgkmcnt(0)" ::: "memory")
#define VM_WAIT() asm volatile("s_waitcnt vmcnt(0)" ::: "memory")
#define WG_SYNC() __syncthreads()
#define LDS_BARRIER() do { asm volatile("s_waitcnt lgkmcnt(0)" ::: "memory"); __builtin_amdgcn_s_barrier(); asm volatile("" ::: "memory"); } while (0)
DI unsigned f2bf(float f) { unsigned u = __builtin_bit_cast(unsigned, f); return (u + 0x7fffu + ((u >> 16) & 1u)) >> 16; }
typedef __bf16 bf16x2_t __attribute__((ext_vector_type(2)));
DI unsigned pk2(float lo, float hi) { const f32x2 v = {lo, hi}; const bf16x2_t b = __builtin_convertvector(v, bf16x2_t); return __builtin_bit_cast(unsigned, b); }
DI float bflo(unsigned w) { return __builtin_bit_cast(float, w << 16); }
DI float bfhi(unsigned w) { return __builtin_bit_cast(float, w & 0xffff0000u); }
DI float bf1(bf16 b) { return __builtin_bit_cast(float, (unsigned)b << 16); }
DI float wave_sum(float v) {
#pragma unroll
    for (int o = 1; o < 64; o <<= 1) v += __shfl_xor(v, o);
    return v;
}
DI float dpp_rm(float v) { return __builtin_bit_cast(float, __builtin_amdgcn_update_dpp(0, __builtin_bit_cast(int, v), 0x140, 0xf, 0xf, true)); }
DI float wave_sum_fast(float v) {
    v += __builtin_bit_cast(float, __builtin_amdgcn_update_dpp(0, __builtin_bit_cast(int, v), 0xB1, 0xf, 0xf, true));
    v += __builtin_bit_cast(float, __builtin_amdgcn_update_dpp(0, __builtin_bit_cast(int, v), 0x4E, 0xf, 0xf, true));
    v += __builtin_bit_cast(float, __builtin_amdgcn_update_dpp(0, __builtin_bit_cast(int, v), 0x141, 0xf, 0xf, true));
    v += dpp_rm(v);
    const int iv = __builtin_bit_cast(int, v);
    const float a = __builtin_bit_cast(float, __builtin_amdgcn_readlane(iv, 0)), b = __builtin_bit_cast(float, __builtin_amdgcn_readlane(iv, 16));
    const float c = __builtin_bit_cast(float, __builtin_amdgcn_readlane(iv, 32)), d = __builtin_bit_cast(float, __builtin_amdgcn_readlane(iv, 48));
    return (a + b) + (c + d);
}
DI float wave_max(float v) {
#pragma unroll
    for (int o = 1; o < 64; o <<= 1) v = fmaxf(v, __shfl_xor(v, o));
    return v;
}
DI float dpp_x1(float v) { return __builtin_bit_cast(float, __builtin_amdgcn_update_dpp(0, __builtin_bit_cast(int, v), 0xB1, 0xf, 0xf, true)); }
DI float dpp_x2(float v) { return __builtin_bit_cast(float, __builtin_amdgcn_update_dpp(0, __builtin_bit_cast(int, v), 0x4E, 0xf, 0xf, true)); }
DI float dpp_hm(float v) { return __builtin_bit_cast(float, __builtin_amdgcn_update_dpp(0, __builtin_bit_cast(int, v), 0x141, 0xf, 0xf, true)); }
DI float red4(float v) { v += dpp_x1(v); v += dpp_x2(v); return v; }
DI float red8(float v) { v += dpp_x1(v); v += dpp_x2(v); v += dpp_hm(v); return v; }
DI float sigmoidf_(float x) { return 1.f / (1.f + __expf(-x)); }
DI float siluf_(float x) { return x / (1.f + __expf(-x)); }

DI bf16x8 frag_kc(const LAS bf16* base, int ld, int row0, int k0, int lane) {
    return *(const LAS bf16x8*)(base + (row0 + (lane & 15)) * ld + k0 + 8 * (lane >> 4));
}
DI bf16x8 frag_kr(const LAS bf16* base, int ld, int x0, int k0, int lane) {
    const int g = lane >> 4, q = (lane & 15) >> 2, p = lane & 3;
    const LAS bf16* a = base + (k0 + 8 * g + q) * ld + x0 + 4 * p;
    const s16x4 lo = __builtin_amdgcn_ds_read_tr16_b64_v4i16((LAS s16x4*)a);
    const s16x4 hi = __builtin_amdgcn_ds_read_tr16_b64_v4i16((LAS s16x4*)(a + 4 * ld));
    return __builtin_shufflevector(lo, hi, 0, 1, 2, 3, 4, 5, 6, 7);
}
DI f32x4 mma(f32x4 acc, bf16x8 bfrag, bf16x8 afrag) { return __builtin_amdgcn_mfma_f32_16x16x32_bf16(bfrag, afrag, acc, 0, 0, 0); }

#define XB_TMO      128
#define XB_XCNT(j)  (256  + 64 * (j))
#define XB_XSUB(j)  (1280 + 64 * (j))
#define XB_XGEN(j)  (2304 + 64 * (j))
#define XB_TOP      3328
#define XB_TOPGEN   3392
#define XCD_BAR_WORDS 3456
#define XB_SPIN_CAP (1u << 18)
DI unsigned xb_ld(unsigned* p)              { return __hip_atomic_load(p, __ATOMIC_RELAXED, __HIP_MEMORY_SCOPE_AGENT); }
DI unsigned xb_add(unsigned* p, unsigned v) { return __hip_atomic_fetch_add(p, v, __ATOMIC_RELAXED, __HIP_MEMORY_SCOPE_AGENT); }
DI unsigned xb_xcc_id() { return (unsigned)__builtin_amdgcn_s_getreg((3 << 11) | 20) & 0xFu; }
#define XB_SPIN(cond, bar) do { unsigned _sp = 0; while (cond) { __builtin_amdgcn_s_sleep(1); \
    if ((++_sp & 255u) == 0u) { if (xb_ld(&(bar)[XB_TMO])) break; if (_sp > XB_SPIN_CAP) { atomicAdd(&(bar)[XB_TMO], 1u); break; } } } } while (0)
struct XcdBarrier { unsigned* bar; unsigned x; volatile LAS unsigned* st; };
DI XcdBarrier xcd_barrier_post(unsigned* bar, volatile LAS unsigned* st) {
    XcdBarrier b; b.bar = bar; b.x = xb_xcc_id(); b.st = st;
    if (threadIdx.x == 0) (void)xb_add(&bar[XB_XCNT(b.x)], 1u);
    return b;
}
DI void xcd_barrier_complete(unsigned* bar, unsigned x, unsigned& nloc, unsigned& nx) {
    const unsigned G = gridDim.x * gridDim.y * gridDim.z;
    unsigned sum, cnt, mine, sp = 0u;
    for (;;) {
        sum = 0u; cnt = 0u; mine = 0u;
#pragma unroll
        for (unsigned j = 0; j < 16; ++j) { const unsigned c = xb_ld(&bar[XB_XCNT(j)]); sum += c; cnt += (c > 0u) ? 1u : 0u; mine = (j == x) ? c : mine; }
        if (sum == G) break;
        __builtin_amdgcn_s_sleep(1);
        if ((++sp & 255u) == 0u) { if (xb_ld(&bar[XB_TMO])) break; if (sp > XB_SPIN_CAP) { atomicAdd(&bar[XB_TMO], 1u); break; } }
    }
    nloc = mine > 0u ? mine : 1u; nx = cnt > 0u ? cnt : 1u;
}
DI void xcd_barrier(const XcdBarrier& b) {
    asm volatile("s_waitcnt vmcnt(0)" ::: "memory");
    __syncthreads();
    if (threadIdx.x == 0) {
        unsigned* bar = b.bar;
        __builtin_amdgcn_s_waitcnt(0);
        unsigned nloc = b.st[0], nx = b.st[1];
        if (nloc == 0u) { xcd_barrier_complete(bar, b.x, nloc, nx); b.st[0] = nloc; b.st[1] = nx; }
        const unsigned old = xb_add(&bar[XB_XSUB(b.x)], 1u);
        const unsigned gen = old / nloc;
        if (old + 1u == (gen + 1u) * nloc) {
            __builtin_amdgcn_fence(__ATOMIC_RELEASE, "agent");
            asm volatile("s_waitcnt vmcnt(0)" ::: "memory");
            const unsigned og = xb_add(&bar[XB_TOP], 1u);
            const unsigned tg = og / nx;
            if (og + 1u == (tg + 1u) * nx) xb_add(&bar[XB_TOPGEN], 1u);
            else XB_SPIN(xb_ld(&bar[XB_TOPGEN]) == tg, bar);
            __builtin_amdgcn_fence(__ATOMIC_ACQUIRE, "agent");
            xb_add(&bar[XB_XGEN(b.x)], 1u);
            asm volatile("s_waitcnt vmcnt(0)" ::: "memory");
        } else {
            XB_SPIN(xb_ld(&bar[XB_XGEN(b.x)]) == gen, bar);
            __builtin_amdgcn_fence(__ATOMIC_ACQUIRE, "agent");
            asm volatile("s_waitcnt vmcnt(0)" ::: "memory");
        }
    }
    __syncthreads();
}

struct Fr {
    LAS unsigned char* lds;
    unsigned char* ws;
    const float* const* in;
    float* out;
    int tid, lane, wave, bx, G, gw, NGW;
};

using pg8::Unit;
template <int ACT  > struct EpiStore {
    static constexpr bool PERM = true;
    bf16* O; int ldc; int nvalid;
    DI void operator()(const f32x4 (&acc)[2][2][4][2], const Unit& u, int wr, int wc, int fr, int fq) const {
        const int row0 = u.pm * 256 + wr * 64 + fr, col0 = u.pn * 256 + wc * 32 + 8 * fq;
#pragma unroll
        for (int ai = 0; ai < 2; ++ai)
#pragma unroll
            for (int m = 0; m < 4; ++m) { bf16* rowp = O + (size_t)(row0 + ai * 128 + m * 16) * ldc + col0;
#pragma unroll
                for (int bj = 0; bj < 2; ++bj) { if (u.pn * 256 + bj * 128 >= nvalid) continue;
                    f32x4 v0 = acc[ai][bj][m][0], v1 = acc[ai][bj][m][1];
                    if (ACT == 1) {
#pragma unroll
                        for (int j = 0; j < 4; ++j) { v0[j] = tanhf(v0[j]); v1[j] = tanhf(v1[j]); } }
                    if (ACT == 2) {
#pragma unroll
                        for (int j = 0; j < 4; ++j) { v0[j] = sigmoidf_(v0[j]); v1[j] = sigmoidf_(v1[j]); } }
                    u32x4 w; w.x = pg8::cvt_pk_bf16(v0[0], v0[1]); w.y = pg8::cvt_pk_bf16(v0[2], v0[3]); w.z = pg8::cvt_pk_bf16(v1[0], v1[1]); w.w = pg8::cvt_pk_bf16(v1[2], v1[3]);
                    *(u32x4*)(rowp + bj * 128) = w; } }
    }
};
struct EpiStoreHead {
    static constexpr bool PERM = true;
    bf16* O; int TL; int lat_off;
    DI void operator()(const f32x4 (&acc)[2][2][4][2], const Unit& u, int wr, int wc, int fr, int fq) const {
        const bool lat = u.pm < 64; const int b = lat ? (u.pm >> 3) : (u.pm - 64); const int sbase = lat ? lat_off + (u.pm & 7) * 256 : 0;
        const int rt0 = sbase + wr * 64 + fr, j = (wc & 1) * 32 + 8 * fq;
#pragma unroll
        for (int ai = 0; ai < 2; ++ai)
#pragma unroll
            for (int m = 0; m < 4; ++m)
#pragma unroll
                for (int bj = 0; bj < 2; ++bj) { const int h = 4 * u.pn + 2 * bj + (wc >> 1);
                    const f32x4 v0 = acc[ai][bj][m][0], v1 = acc[ai][bj][m][1];
                    u32x4 w; w.x = pg8::cvt_pk_bf16(v0[0], v0[1]); w.y = pg8::cvt_pk_bf16(v0[2], v0[3]); w.z = pg8::cvt_pk_bf16(v1[0], v1[1]); w.w = pg8::cvt_pk_bf16(v1[2], v1[3]);
                    *(u32x4*)(O + ((size_t)(b * 16 + h) * TL + rt0 + ai * 128 + m * 16) * 64 + j) = w; }
    }
};
struct EpiResid {
    static constexpr bool PERM = false;
    const float* baseL; float* outL; const float* baseC; float* outC; const float* modg;
    DI void operator()(const f32x4 (&acc)[2][2][4][2], const Unit& u, int wr, int wc, int fr, int fq) const {
        const bool lat = u.pm < 64; const int r = lat ? (u.pm >> 3) : 8;
        const float* base = lat ? baseL : baseC; float* out = lat ? outL : outC;
        const int row0 = (lat ? u.pm : u.pm - 64) * 256 + wr * 64 + fr, col0 = u.pn * 256 + wc * 32 + 4 * fq;
        const float* mg = modg + (size_t)r * 6144 + col0;
        f32x4 mv[2][2];
#pragma unroll
        for (int bj = 0; bj < 2; ++bj)
#pragma unroll
            for (int n = 0; n < 2; ++n) mv[bj][n] = *(const f32x4*)(mg + bj * 128 + n * 16);
#pragma unroll
        for (int ai = 0; ai < 2; ++ai)
#pragma unroll
            for (int m = 0; m < 4; ++m) { const size_t off = (size_t)(row0 + ai * 128 + m * 16) * D + col0;
#pragma unroll
                for (int bj = 0; bj < 2; ++bj)
#pragma unroll
                    for (int n = 0; n < 2; ++n) { const f32x4 bs = *(const f32x4*)(base + off + bj * 128 + n * 16);
                        *(f32x4*)(out + off + bj * 128 + n * 16) = bs + mv[bj][n] * acc[ai][bj][m][n]; } }
    }
};
struct EpiSwiglu {
    static constexpr bool PERM = true;
    bf16* Hd; int ldh;
    DI void operator()(const f32x4 (&acc)[2][2][4][2], const Unit& u, int wr, int wc, int fr, int fq) const {
        const int row0 = u.pm * 256 + wr * 64 + fr, col0 = u.pn * 128 + wc * 32 + 8 * fq;
#pragma unroll
        for (int ai = 0; ai < 2; ++ai)
#pragma unroll
            for (int m = 0; m < 4; ++m) { bf16* rowp = Hd + (size_t)(row0 + ai * 128 + m * 16) * ldh + col0;
                f32x4 v0, v1;
#pragma unroll
                for (int j = 0; j < 4; ++j) { v0[j] = siluf_(acc[ai][0][m][0][j]) * acc[ai][1][m][0][j]; v1[j] = siluf_(acc[ai][0][m][1][j]) * acc[ai][1][m][1][j]; }
                u32x4 w; w.x = pg8::cvt_pk_bf16(v0[0], v0[1]); w.y = pg8::cvt_pk_bf16(v0[2], v0[3]); w.z = pg8::cvt_pk_bf16(v1[0], v1[1]); w.w = pg8::cvt_pk_bf16(v1[2], v1[3]);
                *(u32x4*)rowp = w; }
    }
};
struct EpiLora2 {
    static constexpr bool PERM = true;
    float* DEC; bf16* AG; const float* w0; const float* a0;
    DI void operator()(const f32x4 (&acc)[2][2][4][2], const Unit& u, int wr, int wc, int fr, int fq) const {
        const int q = u.pn >> 2, z = q & 1; const int col0 = (u.pn & 3) * 256 + wc * 32 + 8 * fq;
        const bool lat = u.pm < 64; const int b = lat ? (u.pm >> 3) : (u.pm - 64); const int rt0 = (lat ? CTXL + (u.pm & 7) * 256 : 0) + wr * 64 + fr, j = (wc & 1) * 32 + 8 * fq;
        const float* bias = (q < 2 ? w0 : a0) + z * 1024 + col0;
        f32x4 bv[2][2];
#pragma unroll
        for (int bj = 0; bj < 2; ++bj)
#pragma unroll
            for (int n = 0; n < 2; ++n) bv[bj][n] = *(const f32x4*)(bias + bj * 128 + 4 * n);
#pragma unroll
        for (int ai = 0; ai < 2; ++ai)
#pragma unroll
            for (int m = 0; m < 4; ++m) {
#pragma unroll
                for (int bj = 0; bj < 2; ++bj) { f32x4 v0 = acc[ai][bj][m][0] + bv[bj][0], v1 = acc[ai][bj][m][1] + bv[bj][1];
                    const int h = 4 * (u.pn & 3) + 2 * bj + (wc >> 1);
                    const size_t off = ((size_t)(z * 128 + b * 16 + h) * (SEQ + CTXL) + rt0 + ai * 128 + m * 16) * 64 + j;
                    if (q < 2) {
#pragma unroll
                        for (int jj = 0; jj < 4; ++jj) {
                            v0[jj] = -0.6065306597126334f * sigmoidf_(v0[jj]); v1[jj] = -0.6065306597126334f * sigmoidf_(v1[jj]); }
                        *(f32x4*)(DEC + off) = v0; *(f32x4*)(DEC + off + 4) = v1;
                        __builtin_amdgcn_sched_barrier(0);
                    } else {
#pragma unroll
                        for (int jj = 0; jj < 4; ++jj) { v0[jj] = sigmoidf_(v0[jj]); v1[jj] = sigmoidf_(v1[jj]); }
                        u32x4 w; w.x = pg8::cvt_pk_bf16(v0[0], v0[1]); w.y = pg8::cvt_pk_bf16(v0[2], v0[3]); w.z = pg8::cvt_pk_bf16(v1[0], v1[1]); w.w = pg8::cvt_pk_bf16(v1[2], v1[3]);
                        *(u32x4*)(AG + off) = w; __builtin_amdgcn_sched_barrier(0); } } }
    }
};
struct EpiMoeOut {
    static constexpr bool PERM = true;
    bf16* YS; const int* RowTok; const float* RowW;
    DI void operator()(const f32x4 (&acc)[2][2][4][2], const Unit& u, int wr, int wc, int fr, int fq) const {
        const int row0 = u.pm * 256 + wr * 64 + fr, col0 = u.pn * 256 + wc * 32 + 8 * fq;
#pragma unroll
        for (int ai = 0; ai < 2; ++ai)
#pragma unroll
            for (int m = 0; m < 4; ++m) { const int row = row0 + ai * 128 + m * 16; const int t2 = RowTok[row]; if (t2 < 0) continue; const float w = RowW[row];
                bf16* rowp = YS + (size_t)t2 * D + col0;
#pragma unroll
                for (int bj = 0; bj < 2; ++bj) { const f32x4 v0 = acc[ai][bj][m][0] * w, v1 = acc[ai][bj][m][1] * w;
                    u32x4 o; o.x = pg8::cvt_pk_bf16(v0[0], v0[1]); o.y = pg8::cvt_pk_bf16(v0[2], v0[3]); o.z = pg8::cvt_pk_bf16(v1[0], v1[1]); o.w = pg8::cvt_pk_bf16(v1[2], v1[3]);
                    *(u32x4*)(rowp + bj * 128) = o; } }
    }
};

DI void tr_item(const float* src, int ldsrc, int Kreal, int k0, int n0, bf16* dst, int lddst, int drow0, int dcol0, LAS float* scr, int lane) {
#pragma unroll 8
    for (int i = 0; i < 32; ++i) { const int kk = 2 * i + (lane >> 5), k = k0 + kk; float v = 0.f; if (k < Kreal) v = src[(size_t)k * ldsrc + n0 + (lane & 31)]; scr[kk * 33 + (lane & 31)] = v; }
    LDS_WAIT();
    const int c = lane & 7;
#pragma unroll
    for (int j = 0; j < 4; ++j) { const int n = (lane >> 3) + 8 * j; const LAS float* s = scr + (8 * c) * 33 + n;
        u32x4 o; o.x = pk2(s[0 * 33], s[1 * 33]); o.y = pk2(s[2 * 33], s[3 * 33]); o.z = pk2(s[4 * 33], s[5 * 33]); o.w = pk2(s[6 * 33], s[7 * 33]);
        *(u32x4*)(dst + (size_t)(drow0 + n) * lddst + dcol0 + k0 + 8 * c) = o; }
    LDS_WAIT();
}
DI void tr_plain(const float* src, int K, int N, bf16* dst, int r, LAS float* scr, int lane) {
    const int nblk = N / 32, kb = r / nblk, nb = r % nblk; tr_item(src, N, K, 64 * kb, 32 * nb, dst, K, 32 * nb, 0, scr, lane);
}
DI void tr_gateup(const float* src, int K, int Hh, bf16* dst, int r, LAS float* scr, int lane) {
    const int nblk = 2 * Hh / 32, kb = r / nblk, nb = r % nblk, n0 = 32 * nb, half = n0 / Hh, j0 = n0 % Hh;
    tr_item(src, 2 * Hh, K, 64 * kb, n0, dst, K, (j0 / 128) * 256 + half * 128 + (j0 % 128), 0, scr, lane);
}
DI void tr16_item(const float* src, int ldsrc, int k0, int n0, bf16* dst, int lddst, int Hh, int lane) {
    f32x4 v[16];
#pragma unroll
    for (int kk = 0; kk < 16; ++kk) v[kk] = *(const f32x4*)(src + (size_t)(k0 + kk) * ldsrc + n0 + 4 * lane);
    const int n = n0 + 4 * lane; int drow = n;
    if (Hh) { const int half = n / Hh, j = n % Hh; drow = (j / 128) * 256 + half * 128 + (j % 128); }
#pragma unroll
    for (int q = 0; q < 4; ++q) { u32x4 o0, o1;
        o0.x = pk2(v[0][q], v[1][q]); o0.y = pk2(v[2][q], v[3][q]); o0.z = pk2(v[4][q], v[5][q]); o0.w = pk2(v[6][q], v[7][q]);
        o1.x = pk2(v[8][q], v[9][q]); o1.y = pk2(v[10][q], v[11][q]); o1.z = pk2(v[12][q], v[13][q]); o1.w = pk2(v[14][q], v[15][q]);
        bf16* d = dst + (size_t)(drow + q) * lddst + k0; *(u32x4*)d = o0; *(u32x4*)(d + 8) = o1; }
}
DI void tr64_item(const float* src, int ldsrc, int k0, int n0, bf16* dst, int lddst, int Hh, int lane) {
    float v[64];
    const float* sp = src + (size_t)k0 * ldsrc + n0 + lane;
#pragma unroll
    for (int kk = 0; kk < 64; ++kk) v[kk] = sp[(size_t)kk * ldsrc];
    const int n = n0 + lane; int drow = n;
    if (Hh) { const int half = n / Hh, j = n % Hh; drow = (j / 128) * 256 + half * 128 + (j % 128); }
    bf16* d = dst + (size_t)drow * lddst + k0;
#pragma unroll
    for (int c = 0; c < 8; ++c) { u32x4 o; o.x = pk2(v[8 * c], v[8 * c + 1]); o.y = pk2(v[8 * c + 2], v[8 * c + 3]); o.z = pk2(v[8 * c + 4], v[8 * c + 5]); o.w = pk2(v[8 * c + 6], v[8 * c + 7]);
        *(u32x4*)(d + 8 * c) = o; }
}
DI void tr16_mat(const float* src, int K, int N, bf16* dst, int Hh, int r, int lane) { const int nb = N / 64; tr64_item(src, N, 64 * (r / nb), 64 * (r % nb), dst, K, Hh, lane); }
DI void p0_prologue(Fr& F) {
    LAS float* scr = (LAS float*)(F.lds + F.wave * 16384);
    const float* const* in = F.in;
    bf16* W_IN = (bf16*)(F.ws + WS_W_IN); bf16* W_OUT = (bf16*)(F.ws + WS_W_OUT); bf16* W_13 = (bf16*)(F.ws + WS_W_13); bf16* W_2 = (bf16*)(F.ws + WS_W_2);
    bf16* W_RKV = (bf16*)(F.ws + WS_W_RKV); bf16* W_L1 = (bf16*)(F.ws + WS_W_L1); bf16* W_L2 = (bf16*)(F.ws + WS_W_L2); bf16* W_G2 = (bf16*)(F.ws + WS_W_G2);
    bf16* W_O = (bf16*)(F.ws + WS_W_O); bf16* W_M13 = (bf16*)(F.ws + WS_W_M13); bf16* W_M2 = (bf16*)(F.ws + WS_W_M2);
    for (int prep_ = 0; prep_ < ((((PROBE_DUP) >> 21) & 1u) ? 2 : 1); ++prep_) {
        constexpr int B_M13 = 16 * 112, B_M2 = 56 * 16, B_IN = 16 * 56, B_OUT = 16 * 16, B_13 = 16 * 88, B_2 = 44 * 16, B_RKV = 256, B_O = 256;
        constexpr int NB_ITEMS = 8 * B_M13 + 8 * B_M2 + B_IN + B_OUT + B_13 + B_2 + 3 * B_RKV + B_O;
        for (int it = F.gw; it < NB_ITEMS; it += F.NGW) {
            int r = it;
            if (r < 8 * B_M13) { const int e = r / B_M13; tr16_mat(in[35] + (size_t)e * 1024 * 7168, 1024, 7168, W_M13 + (size_t)e * 7168 * 1024, EXP_H, r % B_M13, F.lane); continue; } r -= 8 * B_M13;
            if (r < 8 * B_M2) { const int e = r / B_M2; tr16_mat(in[36] + (size_t)e * EXP_H * 1024, EXP_H, 1024, W_M2 + (size_t)e * 1024 * EXP_H, 0, r % B_M2, F.lane); continue; } r -= 8 * B_M2;
            if (r < B_IN) { tr16_mat(in[8], 1024, INW, W_IN, 0, r, F.lane); continue; } r -= B_IN;
            if (r < B_OUT) { tr16_mat(in[15], 1024, 1024, W_OUT, 0, r, F.lane); continue; } r -= B_OUT;
            if (r < B_13) { tr16_mat(in[16], 1024, 2 * FFN_H, W_13, FFN_H, r, F.lane); continue; } r -= B_13;
            if (r < B_2) { tr16_mat(in[17], FFN_H, 1024, W_2, 0, r, F.lane); continue; } r -= B_2;
            if (r < 3 * B_RKV) { const int sx = r / B_RKV; tr16_mat(in[19] + (size_t)sx * 1024 * 1024, 1024, 1024, W_RKV + (size_t)sx * 1024 * 1024, 0, r % B_RKV, F.lane); continue; } r -= 3 * B_RKV;
            tr16_mat(in[33], 1024, 1024, W_O, 0, r, F.lane);
        }
    }
    constexpr int I_W1 = 2 * 32, I_A1 = 2 * 32, I_G1 = 16 * 5, I_L2 = 4 * 32, I_G2 = 4 * 32;
    constexpr int NITEMS = I_W1 + I_A1 + I_G1 + I_L2 + I_G2;
    for (int it = F.gw; it < NITEMS; it += F.NGW) {
        int r = it;
        if (r < I_W1) { const int z = r / 32, rr = r % 32; tr_item(in[21] + (size_t)z * 1024 * 64, 64, 1024, 64 * (rr / 2), 32 * (rr % 2), W_L1, 1024, z * 64 + 32 * (rr % 2), 0, scr, F.lane); continue; } r -= I_W1;
        if (r < I_A1) { const int z = r / 32, rr = r % 32; tr_item(in[24] + (size_t)z * 1024 * 64, 64, 1024, 64 * (rr / 2), 32 * (rr % 2), W_L1 + 256 * 1024, 1024, z * 64 + 32 * (rr % 2), 0, scr, F.lane); continue; } r -= I_A1;
        if (r < I_G1) { tr_item(in[26], 160, 1024, 64 * (r / 5), 32 * (r % 5), W_L1 + 2 * 256 * 1024, 1024, 32 * (r % 5), 0, scr, F.lane); continue; } r -= I_G1;
        if (r < I_L2) { const int q = r / 32, nb = r % 32; const float* src = (q < 2 ? in[22] : in[25]) + (size_t)(q & 1) * 64 * 1024;
            for (int i = F.lane; i < 32 * 24; i += 64) { const int row = i / 24, ch = i % 24; const int col = 8 * ch + (8 * ch >= q * 64 ? 64 : 0);
                *(u32x4*)(W_L2 + (size_t)(q * 1024 + 32 * nb + row) * 256 + col) = (u32x4){0u, 0u, 0u, 0u}; }
            tr_item(src, 1024, 64, 0, 32 * nb, W_L2, 256, q * 1024 + 32 * nb, q * 64, scr, F.lane); continue; } r -= I_L2;
        tr_item(in[27], 1024, 160, 64 * (r / 32), 32 * (r % 32), W_G2, 256, 32 * (r % 32), 0, scr, F.lane);
    }
    { const int gt = F.bx * NTHR + F.tid, NT = F.G * NTHR;
      for (int i = gt; i < (128 + 128 + 96) * 128; i += NT) { int row = i / 128; const int ch = i % 128; int mat = 0;
          if (row >= 256) { mat = 2; row = row - 256 + 160; } else if (row >= 128) { mat = 1; } else { row += 128; }
          *(u32x4*)(W_L1 + ((size_t)mat * 256 + row) * 1024 + 8 * ch) = (u32x4){0u, 0u, 0u, 0u}; }
      f32x2* rope = (f32x2*)(F.ws + WS_ROPE);
      for (int i = gt; i < 2048; i += NT) { const int pos = i >> 5, j = i & 31; const float fr = powf(10000.f, -(float)j / 32.f), ang = (float)pos * fr; rope[i] = (f32x2){cosf(ang), sinf(ang)}; }
    }
    WG_SYNC();
    for (int prep_ = 0; prep_ < ((((PROBE_DUP) >> 23) & 1u) ? 2 : 1); ++prep_)
    for (int u = F.bx; u < 192; u += F.G) {
        const int li = u / 96, n0 = (u % 96) * 64;
        LAS float* sm = (LAS float*)F.lds;
        for (int idx = F.tid; idx < 9 * 1024; idx += NTHR) { const int r = idx >> 10, k = idx & 1023; const float cv = (r < 8) ? in[1][r * 1024 + k] : in[3][k]; sm[idx] = cv / (1.f + expf(-cv)); }
        WG_SYNC();
        const int ks = F.tid >> 4, cg4 = F.tid & 15;
        f32x4 acc[9];
#pragma unroll
        for (int r = 0; r < 9; ++r) acc[r] = (f32x4){0.f, 0.f, 0.f, 0.f};
        const float* w = in[4] + (size_t)li * 1024 * 6144 + n0 + 4 * cg4;
#pragma unroll 8
        for (int k = ks * 32; k < ks * 32 + 32; ++k) { const f32x4 wv = *(const f32x4*)(w + (size_t)k * 6144);
#pragma unroll
            for (int r = 0; r < 9; ++r) acc[r] += wv * sm[r * 1024 + k]; }
        LAS float* red = sm + 9 * 1024;
#pragma unroll
        for (int r = 0; r < 9; ++r) *(LAS f32x4*)(red + (ks * 9 + r) * 64 + 4 * cg4) = acc[r];
        WG_SYNC();
        float* MOD = (float*)(F.ws + WS_MOD);
        for (int idx = F.tid; idx < 9 * 64; idx += NTHR) { const int r = idx / 64, n2 = idx % 64; float s = 0.f;
#pragma unroll
            for (int q = 0; q < 32; ++q) s += red[(q * 9 + r) * 64 + n2];
            MOD[((size_t)li * 9 + r) * 6144 + n0 + n2] = s + in[5][li * 6144 + n0 + n2]; }
        WG_SYNC();
    }
}

DI void mod_rows(Fr& F, const float* xl, const float* xc, int nrows, const float* normw, const float* modl, int off_shift, int off_scale, bf16* H) {
    for (int row = F.gw; row < nrows; row += F.NGW) {
        const float* src = row < ML ? xl + (size_t)row * D : xc + (size_t)(row - ML) * D;
        const float* mrow = modl + (size_t)(row < ML ? row / SEQ : 8) * 6144;
        f32x4 v[4]; float ss = 0.f;
#pragma unroll
        for (int j = 0; j < 4; ++j) { v[j] = ((const f32x4*)src)[F.lane + 64 * j]; ss += (v[j].x * v[j].x + v[j].y * v[j].y) + (v[j].z * v[j].z + v[j].w * v[j].w); }
        const float rstd = rsqrtf(wave_sum(ss) * (1.f / D) + 1e-6f);
        u32x2* o = (u32x2*)(H + (size_t)row * D);
#pragma unroll
        for (int j = 0; j < 4; ++j) { const int c4 = F.lane + 64 * j;
            const f32x4 w = ((const f32x4*)normw)[c4], sc = ((const f32x4*)(mrow + off_scale))[c4], sh = ((const f32x4*)(mrow + off_shift))[c4];
            const f32x4 y = v[j] * rstd * w * (sc + 1.f) + sh;
            u32x2 p; p.x = pk2(y.x, y.y); p.y = pk2(y.z, y.w); o[c4] = p; }
    }
}

DI void load_rope_pair(const bf16* rowp, int hh, int jj, bool lat, int rpos, int cpos, const f32x2* rope, float scl, float (&x1)[8], float (&x2)[8]) {
    const u32x4 a = *(const u32x4*)(rowp + hh * 64 + jj), b = *(const u32x4*)(rowp + hh * 64 + jj + 32);
    const unsigned aw[4] = {a.x, a.y, a.z, a.w}, bw[4] = {b.x, b.y, b.z, b.w};
#pragma unroll
    for (int i = 0; i < 4; ++i) { x1[2 * i] = bflo(aw[i]); x1[2 * i + 1] = bfhi(aw[i]); x2[2 * i] = bflo(bw[i]); x2[2 * i + 1] = bfhi(bw[i]); }
    if (lat) { const int pos = hh ? cpos : rpos;
#pragma unroll
        for (int i = 0; i < 8; ++i) { const f32x2 cs = rope[pos * 32 + jj + i]; const float y1 = x1[i] * cs.x - x2[i] * cs.y, y2 = x1[i] * cs.y + x2[i] * cs.x; x1[i] = y1; x2[i] = y2; } }
#pragma unroll
    for (int i = 0; i < 8; ++i) { x1[i] *= scl; x2[i] *= scl; }
}
DI u32x4 pack8(const float (&x)[8], float s) { u32x4 o; o.x = pk2(x[0] * s, x[1] * s); o.y = pk2(x[2] * s, x[3] * s); o.z = pk2(x[4] * s, x[5] * s); o.w = pk2(x[6] * s, x[7] * s); return o; }
constexpr int RLD = 136;
constexpr int RTILE = 128 * RLD * 2;
DI int ret_row0(int b, int id) { return id < 2 ? ML + b * CTXL + id * 128 : b * SEQ + (id - 2) * 128; }

DI void ret_kv_phase(Fr& F) {
    const bf16* QKV = (const bf16*)(F.ws + WS_QKV); float* KV = (float*)(F.ws + WS_KV); const f32x2* rope = (const f32x2*)(F.ws + WS_ROPE);
    LAS bf16* Vs = (LAS bf16*)F.lds; LAS bf16* Kf = (LAS bf16*)(F.lds + RTILE); LAS bf16* Kb = (LAS bf16*)(F.lds + 2 * RTILE);
    const int wr2 = F.wave >> 1, wc2 = F.wave & 1, fr = F.lane & 15, fq = F.lane >> 4;
    for (int u = F.bx; u < NB * 4 * NCH; u += F.G) {
        const int b = u / (4 * NCH), h = (u / NCH) % 4, id = u % NCH; const int grow0 = ret_row0(b, id); const bool lat = id >= 2;
        const float lgf = -expf(F.in[9][h]), lgb = -expf(F.in[10][h]);
        for (int it = F.tid; it < 128 * 16; it += NTHR) { const int c = it >> 4, ch = it & 15;
            *(LAS u32x4*)(Vs + c * RLD + 8 * ch) = *(const u32x4*)(QKV + (size_t)(grow0 + c) * INW + 1024 + h * 128 + 8 * ch); }
        for (int it = F.tid; it < 128 * 8; it += NTHR) { const int c = it >> 3, pi = it & 7, hh = pi >> 2, jj = (pi & 3) * 8; const int t = (id - 2) * 128 + c;
            float x1[8], x2[8]; load_rope_pair(QKV + (size_t)(grow0 + c) * INW + 512 + h * 128, hh, jj, lat, t >> 6, t & 63, rope, 0.08838834764831845f, x1, x2);
            const float wf = expf(lgf * (float)(127 - c)), wb = expf(lgb * (float)c);
            *(LAS u32x4*)(Kf + c * RLD + hh * 64 + jj) = pack8(x1, wf); *(LAS u32x4*)(Kf + c * RLD + hh * 64 + jj + 32) = pack8(x2, wf);
            *(LAS u32x4*)(Kb + c * RLD + hh * 64 + jj) = pack8(x1, wb); *(LAS u32x4*)(Kb + c * RLD + hh * 64 + jj + 32) = pack8(x2, wb); }
        WG_SYNC();
#pragma unroll
        for (int dir = 0; dir < 2; ++dir) {
            const LAS bf16* Kd = dir ? Kb : Kf;
            f32x4 acc[2][4];
#pragma unroll
            for (int i = 0; i < 2; ++i)
#pragma unroll
                for (int j = 0; j < 4; ++j) acc[i][j] = (f32x4){0.f, 0.f, 0.f, 0.f};
#pragma unroll 1
            for (int k0 = 0; k0 < 128; k0 += 32) { bf16x8 af[2], bfg[4];
#pragma unroll
                for (int i = 0; i < 2; ++i) af[i] = frag_kr(Vs, RLD, 32 * wr2 + 16 * i, k0, F.lane);
#pragma unroll
                for (int j = 0; j < 4; ++j) bfg[j] = frag_kr(Kd, RLD, 64 * wc2 + 16 * j, k0, F.lane);
#pragma unroll
                for (int i = 0; i < 2; ++i)
#pragma unroll
                    for (int j = 0; j < 4; ++j) acc[i][j] = mma(acc[i][j], bfg[j], af[i]); }
            float* o = KV + ((size_t)((b * 4 + h) * 2 + dir) * NCH + id) * 16384;
#pragma unroll
            for (int i = 0; i < 2; ++i)
#pragma unroll
                for (int j = 0; j < 4; ++j) *(f32x4*)(o + (32 * wr2 + 16 * i + fr) * 128 + 64 * wc2 + 16 * j + 4 * fq) = acc[i][j];
        }
        WG_SYNC();
    }
}
DI void ret_prefix_phase(Fr& F) {
    const float* KV = (const float*)(F.ws + WS_KV); bf16* SP = (bf16*)(F.ws + WS_SPREV);
    const int gt = F.bx * NTHR + F.tid, NT = F.G * NTHR;
    for (int i = gt; i < 64 * 4096; i += NT) { const int bhd = i >> 12, e4 = i & 4095, dir = bhd & 1, h = (bhd >> 1) & 3;
        const float lg = -expf(dir ? F.in[10][h] : F.in[9][h]), cd = expf(lg * 128.f);
        f32x4 s = (f32x4){0.f, 0.f, 0.f, 0.f};
        for (int st = 0; st < NCH; ++st) { const int id = dir ? (st == 0 ? 1 : (st == 1 ? 0 : 19 - st)) : st;
            const size_t off = ((size_t)bhd * NCH + id) * 16384 + 4 * e4;
            u32x2 p; p.x = pk2(s.x, s.y); p.y = pk2(s.z, s.w); *(u32x2*)(SP + off) = p;
            s = s * cd + *(const f32x4*)(KV + off); }
    }
}
DI void ret_out_phase(Fr& F) {
    const bf16* QKV = (const bf16*)(F.ws + WS_QKV); const bf16* SP = (const bf16*)(F.ws + WS_SPREV); bf16* MIX = (bf16*)(F.ws + WS_MIX); const f32x2* rope = (const f32x2*)(F.ws + WS_ROPE);
    LAS bf16* Qs = (LAS bf16*)F.lds; LAS bf16* KP = (LAS bf16*)(F.lds + RTILE); LAS bf16* Vs = (LAS bf16*)(F.lds + 2 * RTILE); LAS bf16* Sf = (LAS bf16*)(F.lds + 3 * RTILE);
    LAS float* red = (LAS float*)(F.lds + 4 * RTILE);
    const int wr2 = F.wave >> 1, wc2 = F.wave & 1, fr = F.lane & 15, fq = F.lane >> 4;
    for (int u = F.bx; u < NB * 4 * NCH; u += F.G) {
        const int b = u / (4 * NCH), h = (u / NCH) % 4, id = u % NCH; const int grow0 = ret_row0(b, id); const bool lat = id >= 2;
        const float lgf = -expf(F.in[9][h]), lgb = -expf(F.in[10][h]);
        const bf16* spf = SP + ((size_t)((b * 4 + h) * 2 + 0) * NCH + id) * 16384; const bf16* spb = SP + ((size_t)((b * 4 + h) * 2 + 1) * NCH + id) * 16384;
        for (int it = F.tid; it < 128 * 16; it += NTHR) { const int c = it >> 4, ch = it & 15;
            *(LAS u32x4*)(Vs + c * RLD + 8 * ch) = *(const u32x4*)(QKV + (size_t)(grow0 + c) * INW + 1024 + h * 128 + 8 * ch);
            *(LAS u32x4*)(Sf + c * RLD + 8 * ch) = *(const u32x4*)(spf + c * 128 + 8 * ch); }
        for (int it = F.tid; it < 128 * 8; it += NTHR) { const int c = it >> 3, pi = it & 7, hh = pi >> 2, jj = (pi & 3) * 8; const int t = (id - 2) * 128 + c;
            float x1[8], x2[8];
            load_rope_pair(QKV + (size_t)(grow0 + c) * INW + h * 128, hh, jj, lat, t >> 6, t & 63, rope, 1.f, x1, x2);
            *(LAS u32x4*)(Qs + c * RLD + hh * 64 + jj) = pack8(x1, 1.f); *(LAS u32x4*)(Qs + c * RLD + hh * 64 + jj + 32) = pack8(x2, 1.f);
            load_rope_pair(QKV + (size_t)(grow0 + c) * INW + 512 + h * 128, hh, jj, lat, t >> 6, t & 63, rope, 0.08838834764831845f, x1, x2);
            *(LAS u32x4*)(KP + c * RLD + hh * 64 + jj) = pack8(x1, 1.f); *(LAS u32x4*)(KP + c * RLD + hh * 64 + jj + 32) = pack8(x2, 1.f); }
        WG_SYNC();
        f32x4 sacc[2][4], facc[2][4];
#pragma unroll
        for (int i = 0; i < 2; ++i)
#pragma unroll
            for (int j = 0; j < 4; ++j) { sacc[i][j] = (f32x4){0.f, 0.f, 0.f, 0.f}; facc[i][j] = (f32x4){0.f, 0.f, 0.f, 0.f}; }
#pragma unroll 1
        for (int k0 = 0; k0 < 128; k0 += 32) { bf16x8 af[2], bk[4], bs[4];
#pragma unroll
            for (int i = 0; i < 2; ++i) af[i] = frag_kc(Qs, RLD, 32 * wr2 + 16 * i, k0, F.lane);
#pragma unroll
            for (int j = 0; j < 4; ++j) { bk[j] = frag_kc(KP, RLD, 64 * wc2 + 16 * j, k0, F.lane); bs[j] = frag_kc(Sf, RLD, 64 * wc2 + 16 * j, k0, F.lane); }
#pragma unroll
            for (int i = 0; i < 2; ++i)
#pragma unroll
                for (int j = 0; j < 4; ++j) { sacc[i][j] = mma(sacc[i][j], bk[j], af[i]); facc[i][j] = mma(facc[i][j], bs[j], af[i]); } }
        WG_SYNC();
        { const float lf2 = lgf * 1.4426950408889634f, lb2 = lgb * 1.4426950408889634f;
#pragma unroll
          for (int i = 0; i < 2; ++i)
#pragma unroll
            for (int j = 0; j < 4; ++j) { const int c = 32 * wr2 + 16 * i + fr, s0 = 64 * wc2 + 16 * j + 4 * fq; float pv[4];
#pragma unroll
                for (int r = 0; r < 4; ++r) { const int df = c - (s0 + r); const float wgt = df > 0 ? exp2f(lf2 * (float)df) : (df < 0 ? exp2f(lb2 * (float)(-df)) : 2.f); pv[r] = sacc[i][j][r] * wgt; }
                u32x2 p; p.x = pk2(pv[0], pv[1]); p.y = pk2(pv[2], pv[3]); *(LAS u32x2*)(KP + c * RLD + s0) = p; }
          for (int it = F.tid; it < 128 * 16; it += NTHR) { const int c = it >> 4, ch = it & 15; *(LAS u32x4*)(Sf + c * RLD + 8 * ch) = *(const u32x4*)(spb + c * 128 + 8 * ch); }
        }
        WG_SYNC();
        f32x4 oacc[2][4], bacc[2][4];
#pragma unroll
        for (int i = 0; i < 2; ++i) { const float qdf = expf(lgf * (float)(32 * wr2 + 16 * i + fr + 1));
#pragma unroll
            for (int j = 0; j < 4; ++j) { oacc[i][j] = facc[i][j] * qdf; bacc[i][j] = (f32x4){0.f, 0.f, 0.f, 0.f}; } }
#pragma unroll 1
        for (int k0 = 0; k0 < 128; k0 += 32) { bf16x8 ap[2], aq[2], bv[4], bs[4];
#pragma unroll
            for (int i = 0; i < 2; ++i) { ap[i] = frag_kc(KP, RLD, 32 * wr2 + 16 * i, k0, F.lane); aq[i] = frag_kc(Qs, RLD, 32 * wr2 + 16 * i, k0, F.lane); }
#pragma unroll
            for (int j = 0; j < 4; ++j) { bv[j] = frag_kr(Vs, RLD, 64 * wc2 + 16 * j, k0, F.lane); bs[j] = frag_kc(Sf, RLD, 64 * wc2 + 16 * j, k0, F.lane); }
#pragma unroll
            for (int i = 0; i < 2; ++i)
#pragma unroll
                for (int j = 0; j < 4; ++j) { oacc[i][j] = mma(oacc[i][j], bv[j], ap[i]); bacc[i][j] = mma(bacc[i][j], bs[j], aq[i]); } }
        float rs[2], rq[2];
#pragma unroll
        for (int i = 0; i < 2; ++i) { const int c = 32 * wr2 + 16 * i + fr; const float qdb = expf(lgb * (float)(128 - c)); float s = 0.f, q = 0.f;
#pragma unroll
            for (int j = 0; j < 4; ++j) { oacc[i][j] = oacc[i][j] + bacc[i][j] * qdb;
#pragma unroll
                for (int r = 0; r < 4; ++r) { s += oacc[i][j][r]; q += oacc[i][j][r] * oacc[i][j][r]; } }
            s += __shfl_xor(s, 16); s += __shfl_xor(s, 32); q += __shfl_xor(q, 16); q += __shfl_xor(q, 32);
            if (fq == 0) { red[(c * 2 + wc2) * 2 + 0] = s; red[(c * 2 + wc2) * 2 + 1] = q; }
            rs[i] = s; rq[i] = q; }
        WG_SYNC();
#pragma unroll
        for (int i = 0; i < 2; ++i) { const int c = 32 * wr2 + 16 * i + fr;
            const float s = red[(c * 2 + 0) * 2 + 0] + red[(c * 2 + 1) * 2 + 0], q = red[(c * 2 + 0) * 2 + 1] + red[(c * 2 + 1) * 2 + 1];
            const float mean = s * (1.f / 128.f), var = fmaxf(q * (1.f / 128.f) - mean * mean, 0.f), rstd = rsqrtf(var + 1e-5f);
            const size_t grow = (size_t)(grow0 + c);
#pragma unroll
            for (int j = 0; j < 4; ++j) { const int e0 = 64 * wc2 + 16 * j + 4 * fq;
                const f32x4 gw = *(const f32x4*)(F.in[11] + h * 128 + e0); const u32x2 gg = *(const u32x2*)(QKV + grow * INW + 1536 + h * 128 + e0);
                const float g0 = bflo(gg.x), g1 = bfhi(gg.x), g2 = bflo(gg.y), g3 = bfhi(gg.y);
                const f32x4 y = (oacc[i][j] - mean) * rstd * gw;
                u32x2 p; p.x = pk2(y.x * siluf_(g0), y.y * siluf_(g1)); p.y = pk2(y.z * siluf_(g2), y.w * siluf_(g3));
                *(u32x2*)(MIX + grow * D + h * 128 + e0) = p; } }
        (void)rs; (void)rq;
        WG_SYNC();
    }
}

constexpr int NLD = 72;
DI void na_phase(Fr& F) {
    const bf16* QKV = (const bf16*)(F.ws + WS_QKV); bf16* MIX = (bf16*)(F.ws + WS_MIX);
    LAS bf16* Qs = (LAS bf16*)F.lds;
    LAS bf16* Ks = (LAS bf16*)(F.lds + 9216);
    LAS bf16* Vs = (LAS bf16*)(F.lds + 9216 + 36864);
    LAS bf16* Pw = (LAS bf16*)(F.lds + 9216 + 2 * 36864) + F.wave * (16 * RLD);
    LAS float* comb = (LAS float*)(F.lds + 9216 + 2 * 36864);
    LAS float* rpbs = (LAS float*)(F.lds + 9216 + 2 * 36864 + 34816);
    const int mq = F.wave >> 1, kh = F.wave & 1, fr = F.lane & 15, fq = F.lane >> 4;
    float bound;
    { float mqw = fabsf(F.in[12][F.lane]), mkw = fabsf(F.in[13][F.lane]), mb = 0.f;
      for (int i = F.lane; i < 8 * 15 * 31; i += 64) mb = fmaxf(mb, fabsf(F.in[14][i]));
      bound = 8.f * wave_max(mqw) * wave_max(mkw) + wave_max(mb); }
    for (int u = F.bx; u < 2048 + 256; u += F.G) {
        int b, head, r = 0, r0 = 0, qrow0, blk0;
        if (u < 2048) { b = u >> 8; head = (u >> 5) & 7; r = u & 31; r0 = min(max(r - 4, 0), 24); qrow0 = b * SEQ + r * 64; blk0 = 0; }
        else { const int cu = u - 2048; b = cu >> 5; head = (cu >> 2) & 7; qrow0 = ML + b * CTXL + (cu & 3) * 64; blk0 = 2; }
        { const int row = F.tid >> 3, c8 = F.tid & 7;
          const u32x4 a = *(const u32x4*)(QKV + (size_t)(qrow0 + row) * INW + 2048 + head * 64 + 8 * c8); const unsigned aw[4] = {a.x, a.y, a.z, a.w}; float x[8]; float ss = 0.f;
#pragma unroll
          for (int i = 0; i < 4; ++i) { x[2 * i] = bflo(aw[i]); x[2 * i + 1] = bfhi(aw[i]); ss += x[2 * i] * x[2 * i] + x[2 * i + 1] * x[2 * i + 1]; }
          const float rinv = rsqrtf(red8(ss) * (1.f / 64.f) + 1e-6f) * 0.125f;
#pragma unroll
          for (int i = 0; i < 8; ++i) x[i] *= F.in[12][8 * c8 + i];
          *(LAS u32x4*)(Qs + row * NLD + 8 * c8) = pack8(x, rinv); }
        for (int i = F.tid; i < 15 * 31; i += NTHR) rpbs[i] = F.in[14][head * 465 + i];
        f32x4 oacc[4]; float lsum = 0.f;
#pragma unroll
        for (int j = 0; j < 4; ++j) oacc[j] = (f32x4){0.f, 0.f, 0.f, 0.f};
        for (int blk = blk0; blk < 3; ++blk) {
            for (int it = F.tid; it < 256 * 8; it += NTHR) { const int krow = it >> 3, c8 = it & 7;
                const int grow = blk < 2 ? b * SEQ + (r0 + 4 * blk + (krow >> 6)) * 64 + (krow & 63) : ML + b * CTXL + krow;
                const u32x4 a = *(const u32x4*)(QKV + (size_t)grow * INW + 2560 + head * 64 + 8 * c8); const unsigned aw[4] = {a.x, a.y, a.z, a.w}; float x[8]; float ss = 0.f;
#pragma unroll
                for (int i = 0; i < 4; ++i) { x[2 * i] = bflo(aw[i]); x[2 * i + 1] = bfhi(aw[i]); ss += x[2 * i] * x[2 * i] + x[2 * i + 1] * x[2 * i + 1]; }
                const float rinv = rsqrtf(red8(ss) * (1.f / 64.f) + 1e-6f);
#pragma unroll
                for (int i = 0; i < 8; ++i) x[i] *= F.in[13][8 * c8 + i];
                *(LAS u32x4*)(Ks + krow * NLD + 8 * c8) = pack8(x, rinv);
                *(LAS u32x4*)(Vs + krow * NLD + 8 * c8) = *(const u32x4*)(QKV + (size_t)grow * INW + 3072 + head * 64 + 8 * c8); }
            WG_SYNC();
            f32x4 sacc[8];
#pragma unroll
            for (int j = 0; j < 8; ++j) sacc[j] = (f32x4){0.f, 0.f, 0.f, 0.f};
#pragma unroll
            for (int k0 = 0; k0 < 64; k0 += 32) { const bf16x8 aq = frag_kc(Qs, NLD, 16 * mq, k0, F.lane);
#pragma unroll
                for (int j = 0; j < 8; ++j) sacc[j] = mma(sacc[j], frag_kc(Ks, NLD, 128 * kh + 16 * j, k0, F.lane), aq); }
            const int c = 16 * mq + fr, c0 = min(max(c - 8, 0), 48);
#pragma unroll
            for (int j = 0; j < 8; ++j) { float pv[4];
#pragma unroll
                for (int i = 0; i < 4; ++i) { const int key = 128 * kh + 16 * j + 4 * fq + i; float p;
                    if (blk < 2) { const int kr = 4 * blk + (key >> 6), kc = key & 63; const bool ok = (kc >= c0) && (kc < c0 + 16);
                        const float bias = ok ? rpbs[(r0 + kr - r + 7) * 31 + (kc - c + 15)] : 0.f; p = ok ? __expf(sacc[j][i] + bias - bound) : 0.f; }
                    else p = __expf(sacc[j][i] - bound);
                    pv[i] = p; lsum += p; }
                u32x2 pk; pk.x = pk2(pv[0], pv[1]); pk.y = pk2(pv[2], pv[3]); *(LAS u32x2*)(Pw + fr * RLD + 16 * j + 4 * fq) = pk; }
            LDS_WAIT();
#pragma unroll
            for (int ks = 0; ks < 4; ++ks) { const bf16x8 ap = frag_kc(Pw, RLD, 0, 32 * ks, F.lane);
#pragma unroll
                for (int j = 0; j < 4; ++j) oacc[j] = mma(oacc[j], frag_kr(Vs, NLD, 16 * j, 128 * kh + 32 * ks, F.lane), ap); }
            WG_SYNC();
        }
        lsum += __shfl_xor(lsum, 16); lsum += __shfl_xor(lsum, 32);
        if (kh == 1) {
#pragma unroll
            for (int j = 0; j < 4; ++j) *(LAS f32x4*)(comb + mq * 1040 + fr * 64 + 16 * j + 4 * fq) = oacc[j];
            if (fq == 0) comb[mq * 1040 + 1024 + fr] = lsum; }
        WG_SYNC();
        if (kh == 0) { const float inv = 1.f / (lsum + comb[mq * 1040 + 1024 + fr]);
#pragma unroll
            for (int j = 0; j < 4; ++j) { const f32x4 o = (oacc[j] + *(LAS f32x4*)(comb + mq * 1040 + fr * 64 + 16 * j + 4 * fq)) * inv;
                u32x2 p; p.x = pk2(o.x, o.y); p.y = pk2(o.z, o.w);
                *(u32x2*)(MIX + (size_t)(qrow0 + 16 * mq + fr) * D + 512 + head * 64 + 16 * j + 4 * fq) = p; } }
        WG_SYNC();
    }
}

DI void xm_phase(Fr& F, const float* xl, const float* xc, const float* normw, const float* modl) {
    bf16* XM = (bf16*)(F.ws + WS_XM); const float* mu = F.in[18];
    for (int row = F.gw; row < MA; row += F.NGW) {
        const bool lat = row < ML; const int rr = lat ? row : row - ML; const int L = lat ? SEQ : CTXL; const int t = rr % L;
        const float* src = (lat ? xl : xc) + (size_t)rr * D;
        const float* mrow = modl + (size_t)(lat ? row / SEQ : 8) * 6144;
        const bool hp = t > 0, hn = t < L - 1;
        f32x4 vc[4], vp[4], vn[4]; float sc_ = 0.f, sp_ = 0.f, sn_ = 0.f;
#pragma unroll
        for (int j = 0; j < 4; ++j) { vc[j] = ((const f32x4*)src)[F.lane + 64 * j];
            vp[j] = hp ? ((const f32x4*)(src - D))[F.lane + 64 * j] : (f32x4){0.f, 0.f, 0.f, 0.f}; vn[j] = hn ? ((const f32x4*)(src + D))[F.lane + 64 * j] : (f32x4){0.f, 0.f, 0.f, 0.f};
            sc_ += (vc[j].x * vc[j].x + vc[j].y * vc[j].y) + (vc[j].z * vc[j].z + vc[j].w * vc[j].w);
            sp_ += (vp[j].x * vp[j].x + vp[j].y * vp[j].y) + (vp[j].z * vp[j].z + vp[j].w * vp[j].w);
            sn_ += (vn[j].x * vn[j].x + vn[j].y * vn[j].y) + (vn[j].z * vn[j].z + vn[j].w * vn[j].w); }
        const float rc = rsqrtf(wave_sum(sc_) * (1.f / D) + 1e-6f), rp = rsqrtf(wave_sum(sp_) * (1.f / D) + 1e-6f), rn = rsqrtf(wave_sum(sn_) * (1.f / D) + 1e-6f);
#pragma unroll
        for (int j = 0; j < 4; ++j) { const int c4 = F.lane + 64 * j;
            const f32x4 w = ((const f32x4*)normw)[c4], sc = ((const f32x4*)(mrow + 1024))[c4], sh = ((const f32x4*)mrow)[c4];
            const f32x4 g = w * (sc + 1.f);
            const f32x4 hc = vc[j] * rc * g + sh;
            const f32x4 hpv = hp ? vp[j] * rp * g + sh : (f32x4){0.f, 0.f, 0.f, 0.f};
            const f32x4 hnv = hn ? vn[j] * rn * g + sh : (f32x4){0.f, 0.f, 0.f, 0.f};
            const f32x4 xx = (hpv + hnv) * 0.5f - hc;
#pragma unroll
            for (int s = 0; s < 6; ++s) { const f32x4 m = ((const f32x4*)(mu + s * 1024))[c4]; const f32x4 y = hc + xx * m;
                u32x2 p; p.x = pk2(y.x, y.y); p.y = pk2(y.z, y.w); ((u32x2*)(XM + ((size_t)s * MA + row) * D))[c4] = p; } }
    }
}

DI f32x4 mma16(f32x4 acc, s16x4 bfrag, s16x4 afrag) { return __builtin_amdgcn_mfma_f32_16x16x16bf16_1k(bfrag, afrag, acc, 0, 0, 0); }
DI s16x4 frag16_kc(const LAS bf16* base, int ld, int row0, int k0, int lane) { return *(const LAS s16x4*)(base + (row0 + (lane & 15)) * ld + k0 + 4 * (lane >> 4)); }
DI s16x4 frag16_kr(const LAS bf16* base, int ld, int x0, int k0, int lane) { const int g = lane >> 4, q = (lane & 15) >> 2, p = lane & 3;
    return __builtin_amdgcn_ds_read_tr16_b64_v4i16((LAS s16x4*)(base + (k0 + 4 * g + q) * ld + x0 + 4 * p)); }
DI s16x4 cvt4(f32x4 v) { u32x2 p; p.x = pk2(v.x, v.y); p.y = pk2(v.z, v.w); return __builtin_bit_cast(s16x4, p); }
constexpr int WLD = 72;
DI void rwkv_scan2_phase(Fr& F) {
    const bf16* KB = (const bf16*)(F.ws + WS_KB); const bf16* VB = (const bf16*)(F.ws + WS_VB); const bf16* RB = (const bf16*)(F.ws + WS_RB);
    const float* LW = (const float*)(F.ws + WS_DEC); const bf16* AG = (const bf16*)(F.ws + WS_AG);
    LAS bf16* AT = (LAS bf16*)F.lds; LAS bf16* BT = AT + 64 * WLD; LAS bf16* KT = BT + 64 * WLD; LAS bf16* RT = KT + 64 * WLD; LAS bf16* BH = RT + 64 * WLD; LAS bf16* KH = BH + 64 * WLD;
    LAS bf16* VN = KH + 64 * WLD; LAS bf16* W1s = VN + 64 * WLD; LAS bf16* XV = W1s + 64 * WLD;
    LAS float* AAB = (LAS float*)(XV + 64 * WLD);
    LAS bf16* AAK = (LAS bf16*)(AAB + 1024); LAS bf16* PRB = AAK + 1024; LAS bf16* PRK = PRB + 1024; LAS bf16* TT = PRK + 1024;
    LAS f32x4* UVT = (LAS f32x4*)(TT + 1024);
    LAS float* GC = (LAS float*)(UVT + 1024);
    LAS float* CSs = GC + 256;
    const int cq = F.wave >> 1, half = F.wave & 1, fr = F.lane & 15, fq = F.lane >> 4;
    for (int u = F.bx; u < 256; u += F.G) {
        const int z = u & 1, h = (u >> 1) & 15, b = u >> 5;
        float* Y = (float*)(F.ws + (z ? WS_YB : WS_YF));
        const int sx = F.lane >> 3, cg = F.lane & 7;
        float kkw[8], kaw[8];
#pragma unroll
        for (int i = 0; i < 8; ++i) { kkw[i] = F.in[28][h * 64 + 8 * cg + i]; kaw[i] = F.in[29][h * 64 + 8 * cg + i]; }
        const size_t bh = (size_t)(b * 16 + h);
        const bf16* kbh = KB + bh * (SEQ + CTXL) * 64 + 8 * cg; const bf16* vbh = VB + bh * (SEQ + CTXL) * 64 + 8 * cg; const bf16* rbh = RB + bh * SEQ * 64 + 8 * cg;
        const bf16* agh = AG + ((size_t)z * 128 + bh) * (SEQ + CTXL) * 64 + 8 * cg; const float* lwh = LW + ((size_t)z * 128 + bh) * (SEQ + CTXL) * 64 + 8 * cg;
        f32x4 S[4];
#pragma unroll
        for (int j = 0; j < 4; ++j) S[j] = (f32x4){0.f, 0.f, 0.f, 0.f};
        u32x4 kreg, vreg, rreg, areg; f32x4 lw0, lw1;
        const int stl = 16 * cq + 8 * half + sx;
#define RW_LOAD(sc) do { const int g_ = (sc) * 64 + stl; const bool lat_ = g_ >= CTXL; const int row_ = z ? (lat_ ? (2 * CTXL + SEQ - 1 - g_) : (CTXL - 1 - g_)) : g_; \
            kreg = *(const u32x4*)(kbh + (size_t)row_ * 64); vreg = *(const u32x4*)(vbh + (size_t)row_ * 64); areg = *(const u32x4*)(agh + (size_t)row_ * 64); \
            rreg = lat_ ? *(const u32x4*)(rbh + (size_t)(row_ - CTXL) * 64) : (u32x4){0u, 0u, 0u, 0u}; \
            lw0 = *(const f32x4*)(lwh + (size_t)row_ * 64); lw1 = *(const f32x4*)(lwh + (size_t)row_ * 64 + 4); } while (0)
        RW_LOAD(0);
        for (int sc = 0; sc < (SEQ + CTXL) / 64; ++sc) {
            const bool lat = sc * 64 >= CTXL;
            *(LAS f32x4*)(CSs + stl * 64 + 8 * cg) = lw0; *(LAS f32x4*)(CSs + stl * 64 + 8 * cg + 4) = lw1;
            LDS_BARRIER();
            if (F.tid < 256) { const int q = F.tid >> 6, c = F.tid & 63; float v[16];
#pragma unroll
                for (int t = 0; t < 16; ++t) v[t] = CSs[(16 * q + t) * 64 + c];
                float acc = 0.f;
#pragma unroll
                for (int t = 0; t < 16; ++t) { acc += v[t]; CSs[(16 * q + t) * 64 + c] = acc; } }
            LDS_BARRIER();
            { const int tau = 8 * half + sx;
              const f32x4 c0 = *(const LAS f32x4*)(CSs + stl * 64 + 8 * cg), c1 = *(const LAS f32x4*)(CSs + stl * 64 + 8 * cg + 4);
              f32x4 p0 = (f32x4){0.f, 0.f, 0.f, 0.f}, p1 = p0;
              if (tau > 0) { p0 = *(const LAS f32x4*)(CSs + (stl - 1) * 64 + 8 * cg); p1 = *(const LAS f32x4*)(CSs + (stl - 1) * 64 + 8 * cg + 4); }
              const f32x4 t0 = *(const LAS f32x4*)(CSs + (16 * cq + 15) * 64 + 8 * cg), t1 = *(const LAS f32x4*)(CSs + (16 * cq + 15) * 64 + 8 * cg + 4);
              const float cs[8] = {c0.x, c0.y, c0.z, c0.w, c1.x, c1.y, c1.z, c1.w}, cp[8] = {p0.x, p0.y, p0.z, p0.w, p1.x, p1.y, p1.z, p1.w}, ct[8] = {t0.x, t0.y, t0.z, t0.w, t1.x, t1.y, t1.z, t1.w};
              const unsigned kw[4] = {kreg.x, kreg.y, kreg.z, kreg.w}, aw[4] = {areg.x, areg.y, areg.z, areg.w}, rw[4] = {rreg.x, rreg.y, rreg.z, rreg.w};
              float kr[8], ag[8], rr[8], kk[8]; float ss = 0.f;
#pragma unroll
              for (int i = 0; i < 4; ++i) { kr[2 * i] = bflo(kw[i]); kr[2 * i + 1] = bfhi(kw[i]); ag[2 * i] = bflo(aw[i]); ag[2 * i + 1] = bfhi(aw[i]); rr[2 * i] = bflo(rw[i]); rr[2 * i + 1] = bfhi(rw[i]); }
#pragma unroll
              for (int i = 0; i < 8; ++i) { kk[i] = kr[i] * kkw[i]; ss += kk[i] * kk[i]; }
              const float rn = __builtin_amdgcn_rsqf(fmaxf(red8(ss), 1e-24f));
              float oa[8], ob[8], ok[8], orr[8], obh[8], okh[8], eCv[8];
#pragma unroll
              for (int i = 0; i < 8; ++i) { const float e1 = __expf(cs[i]), ep = __expf(cp[i]), eC = __expf(ct[i]), inv = __builtin_amdgcn_rcpf(e1);
                  const float kki = kk[i] * rn, b_ = kki * ag[i], kd_ = kr[i] * (1.f + (ag[i] - 1.f) * kaw[i]);
                  oa[i] = -kki * ep; ob[i] = b_ * inv; ok[i] = kd_ * inv; orr[i] = rr[i] * e1; obh[i] = b_ * eC * inv; okh[i] = kd_ * eC * inv; eCv[i] = eC; }
              const int o = stl * WLD + 8 * cg;
              *(LAS u32x4*)(AT + o) = pack8(oa, 1.f); *(LAS u32x4*)(BT + o) = pack8(ob, 1.f); *(LAS u32x4*)(KT + o) = pack8(ok, 1.f); *(LAS u32x4*)(RT + o) = pack8(orr, 1.f);
              *(LAS u32x4*)(BH + o) = pack8(obh, 1.f); *(LAS u32x4*)(KH + o) = pack8(okh, 1.f); *(LAS u32x4*)(VN + o) = vreg;
              if (tau == 0) { *(LAS f32x4*)(GC + cq * 64 + 8 * cg) = (f32x4){eCv[0], eCv[1], eCv[2], eCv[3]}; *(LAS f32x4*)(GC + cq * 64 + 8 * cg + 4) = (f32x4){eCv[4], eCv[5], eCv[6], eCv[7]}; } }
            LDS_BARRIER();
            if (sc + 1 < (SEQ + CTXL) / 64) RW_LOAD(sc + 1);
            for (int pa2_ = 0; pa2_ < ((((PROBE_DUP) >> 25) & 1u) ? 2 : 1); ++pa2_)
            if (half) { f32x4 pb = (f32x4){0.f, 0.f, 0.f, 0.f}, pk = (f32x4){0.f, 0.f, 0.f, 0.f};
#pragma unroll
                for (int k0 = 0; k0 < 64; k0 += 32) { const bf16x8 af = frag_kc(RT, WLD, 16 * cq, k0, F.lane);
                    pb = mma(pb, frag_kc(BT, WLD, 16 * cq, k0, F.lane), af); pk = mma(pk, frag_kc(KT, WLD, 16 * cq, k0, F.lane), af); }
#pragma unroll
                for (int r = 0; r < 4; ++r) if (4 * fq + r > fr) { pb[r] = 0.f; pk[r] = 0.f; }
                const int o = cq * 256 + fr * 16 + 4 * fq;
                *(LAS s16x4*)(PRB + o) = cvt4(pb); *(LAS s16x4*)(PRK + o) = cvt4(pk); }
            else { f32x4 xa = (f32x4){0.f, 0.f, 0.f, 0.f}, xt = (f32x4){0.f, 0.f, 0.f, 0.f}, ak = (f32x4){0.f, 0.f, 0.f, 0.f};
#pragma unroll
                for (int k0 = 0; k0 < 64; k0 += 32) { const bf16x8 af = frag_kc(AT, WLD, 16 * cq, k0, F.lane), bfm = frag_kc(BT, WLD, 16 * cq, k0, F.lane);
                    xa = mma(xa, bfm, af);
                    xt = mma(xt, af, bfm);
                    ak = mma(ak, frag_kc(KT, WLD, 16 * cq, k0, F.lane), af); }
#pragma unroll
                for (int r = 0; r < 4; ++r) { if (4 * fq + r >= fr) { xa[r] = 0.f; ak[r] = 0.f; } if (4 * fq + r <= fr) xt[r] = 0.f; }
                f32x4 P = xa;
#pragma unroll
                for (int r = 0; r < 4; ++r) if (4 * fq + r == fr) P[r] += 1.f;
#pragma unroll
                for (int lvl = 0; lvl < 3; ++lvl) { const s16x4 xf = cvt4(xa), xtf = cvt4(xt);
                    const f32x4 x2 = mma16((f32x4){0.f, 0.f, 0.f, 0.f}, xtf, xf);
                    const f32x4 x2t = mma16((f32x4){0.f, 0.f, 0.f, 0.f}, xf, xtf);
                    xa = x2; xt = x2t;
                    P = mma16(P, cvt4(xt), cvt4(P)); }
                const s16x4 tf = cvt4(P), akf = cvt4(ak);
#pragma unroll
                for (int jt = 0; jt < 4; ++jt) { const f32x4 acc = mma16((f32x4){0.f, 0.f, 0.f, 0.f}, frag16_kr(AT, WLD, 16 * jt, 16 * cq, F.lane), tf);
                    *(LAS s16x4*)(W1s + (16 * cq + fr) * WLD + 16 * jt + 4 * fq) = cvt4(acc); }
#pragma unroll
                for (int it = 0; it < 4; ++it) { const f32x4 xvt = mma16((f32x4){0.f, 0.f, 0.f, 0.f}, akf, frag16_kr(VN, WLD, 16 * it, 16 * cq, F.lane));
                    UVT[(cq * 4 + it) * 64 + F.lane] = mma16((f32x4){0.f, 0.f, 0.f, 0.f}, tf, cvt4(xvt)); } }
            LDS_BARRIER();
            if (F.wave < 4) { const int it = F.wave; f32x4 Ssv[4];
#pragma unroll
                for (int j = 0; j < 4; ++j) Ssv[j] = S[j];
                for (int pb_ = 0; pb_ < ((((PROBE_DUP) >> 26) & 1u) ? 2 : 1); ++pb_) {
                if (pb_ == 1) {
#pragma unroll
                    for (int j = 0; j < 4; ++j) S[j] = Ssv[j]; }
#pragma unroll 1
                for (int c = 0; c < 4; ++c) {
                    s16x4 sfr[4];
#pragma unroll
                    for (int jt = 0; jt < 4; ++jt) sfr[jt] = cvt4(S[jt]);
                    f32x4 Ut = UVT[(c * 4 + it) * 64 + F.lane], Yt = (f32x4){0.f, 0.f, 0.f, 0.f};
#pragma unroll
                    for (int jt = 0; jt < 4; ++jt) { Ut = mma16(Ut, frag16_kc(W1s, WLD, 16 * c, 16 * jt, F.lane), sfr[jt]); if (lat) Yt = mma16(Yt, frag16_kc(RT, WLD, 16 * c, 16 * jt, F.lane), sfr[jt]); }
                    const s16x4 ufr = cvt4(Ut), vfr = frag16_kr(VN, WLD, 16 * it, 16 * c, F.lane);
                    if (lat) { Yt = mma16(Yt, frag16_kc(PRB + c * 256, 16, 0, 0, F.lane), ufr); Yt = mma16(Yt, frag16_kc(PRK + c * 256, 16, 0, 0, F.lane), vfr);
#pragma unroll
                        for (int r = 0; r < 4; ++r) { const int g = sc * 64 + 16 * c + 4 * fq + r; const int tl = z ? (SEQ + CTXL - 1 - g) : (g - CTXL);
                            Y[(size_t)(b * SEQ + tl) * D + h * 64 + 16 * it + fr] = Yt[r]; } }
#pragma unroll
                    for (int jt = 0; jt < 4; ++jt) { const f32x4 g4 = *(const LAS f32x4*)(GC + c * 64 + 16 * jt + 4 * fq);
                        f32x4 sn = S[jt] * g4; sn = mma16(sn, frag16_kr(BH, WLD, 16 * jt, 16 * c, F.lane), ufr); sn = mma16(sn, frag16_kr(KH, WLD, 16 * jt, 16 * c, F.lane), vfr); S[jt] = sn; }
                } } }
            LDS_BARRIER();
        }
#undef RW_LOAD
    }
}

DI void rwkv_readout_phase(Fr& F) {
    const bf16* KB = (const bf16*)(F.ws + WS_KB); const bf16* VB = (const bf16*)(F.ws + WS_VB); const bf16* RB = (const bf16*)(F.ws + WS_RB);
    const bf16* AG = (const bf16*)(F.ws + WS_AG); const bf16* G = (const bf16*)(F.ws + WS_G);
    const float* YF = (const float*)(F.ws + WS_YF); const float* YB = (const float*)(F.ws + WS_YB); bf16* Z = (bf16*)(F.ws + WS_H);
    const int c0 = 16 * F.lane;
    for (int row = F.gw; row < ML; row += F.NGW) {
        const size_t off = (size_t)row * D + c0;
        const int b = row / SEQ, t = row % SEQ, hh = F.lane >> 2, j0 = (F.lane & 3) * 16;
        const size_t hoff = ((size_t)(b * 16 + hh) * (SEQ + CTXL) + CTXL + t) * 64 + j0, roff = ((size_t)(b * 16 + hh) * SEQ + t) * 64 + j0;
        float y[16], kv[16], vv[16], rv[16], gv[16], a0v[16], a1v[16];
#pragma unroll
        for (int q = 0; q < 4; ++q) { const f32x4 a = *(const f32x4*)(YF + off + 4 * q), bq = *(const f32x4*)(YB + off + 4 * q);
            y[4 * q] = a.x + bq.x; y[4 * q + 1] = a.y + bq.y; y[4 * q + 2] = a.z + bq.z; y[4 * q + 3] = a.w + bq.w; }
#define RD16(dst, ptr) do { const u32x4 t0_ = *(const u32x4*)(ptr), t1_ = *(const u32x4*)((ptr) + 8); const unsigned tw_[8] = {t0_.x, t0_.y, t0_.z, t0_.w, t1_.x, t1_.y, t1_.z, t1_.w}; \
        _Pragma("unroll") for (int q_ = 0; q_ < 8; ++q_) { dst[2 * q_] = bflo(tw_[q_]); dst[2 * q_ + 1] = bfhi(tw_[q_]); } } while (0)
        RD16(kv, KB + hoff); RD16(vv, VB + hoff); RD16(rv, RB + roff); RD16(gv, G + off); RD16(a0v, AG + hoff); RD16(a1v, AG + (size_t)128 * (SEQ + CTXL) * 64 + hoff);
#undef RD16
        float s = 0.f, cf = 0.f;
#pragma unroll
        for (int q = 0; q < 16; ++q) { s += y[q]; const float ka = F.in[29][c0 + q];
            const float kd = kv[q] * ((1.f + (a0v[q] - 1.f) * ka) + (1.f + (a1v[q] - 1.f) * ka)); cf += rv[q] * kd * F.in[30][c0 + q]; }
        s = red4(s); cf = red4(cf);
        const float mean = s * (1.f / 64.f); float q2 = 0.f;
#pragma unroll
        for (int q = 0; q < 16; ++q) { const float d = y[q] - mean; q2 += d * d; }
        q2 = red4(q2);
        const float rstd = rsqrtf(q2 * (1.f / 64.f) + 64e-5f);
        float o[16];
#pragma unroll
        for (int q = 0; q < 16; ++q) o[q] = ((y[q] - mean) * rstd * F.in[31][c0 + q] + F.in[32][c0 + q] + cf * vv[q]) * gv[q];
        u32x4 p0, p1; p0.x = pk2(o[0], o[1]); p0.y = pk2(o[2], o[3]); p0.z = pk2(o[4], o[5]); p0.w = pk2(o[6], o[7]); p1.x = pk2(o[8], o[9]); p1.y = pk2(o[10], o[11]); p1.z = pk2(o[12], o[13]); p1.w = pk2(o[14], o[15]);
        *(u32x4*)(Z + off) = p0; *(u32x4*)(Z + off + 8) = p1;
    }
}

DI void moe_route_phase(Fr& F, const float* xl, const float* normw, const float* modl) {
    bf16* H2 = (bf16*)(F.ws + WS_MIX); int* TopE = (int*)(F.ws + WS_MISC + MISC_TOPE); f32x2* TopW = (f32x2*)(F.ws + WS_MISC + MISC_TOPW); int* Cnts = (int*)(F.ws + WS_MISC + MISC_CNTS);
    LAS float* rt = (LAS float*)F.lds;
    LAS int* lc = (LAS int*)(F.lds + 32768);
    for (int idx = F.tid; idx < 1024 * 8 / 4; idx += NTHR) ((LAS f32x4*)rt)[idx] = ((const f32x4*)F.in[34])[idx];
    for (int wg = F.bx; wg < 256; wg += F.G) {
        WG_SYNC();
        for (int it = 0; it < 8; ++it) { const int row = wg * 64 + F.wave * 8 + it;
            const float* src = xl + (size_t)row * D; const float* mrow = modl + (size_t)(row / SEQ) * 6144;
            f32x4 v[4]; float ss = 0.f;
#pragma unroll
            for (int j = 0; j < 4; ++j) { v[j] = ((const f32x4*)src)[F.lane + 64 * j]; ss += (v[j].x * v[j].x + v[j].y * v[j].y) + (v[j].z * v[j].z + v[j].w * v[j].w); }
            const float rstd = rsqrtf(wave_sum(ss) * (1.f / D) + 1e-6f);
            float lg[8];
#pragma unroll
            for (int e = 0; e < 8; ++e) lg[e] = 0.f;
#pragma unroll
            for (int j = 0; j < 4; ++j) { const int c4 = F.lane + 64 * j;
                const f32x4 w = ((const f32x4*)normw)[c4], sc = ((const f32x4*)(mrow + 4096))[c4], sh = ((const f32x4*)(mrow + 3072))[c4];
                const f32x4 y = v[j] * rstd * w * (sc + 1.f) + sh;
                u32x2 p; p.x = pk2(y.x, y.y); p.y = pk2(y.z, y.w); ((u32x2*)(H2 + (size_t)row * D))[c4] = p;
                const float yy[4] = {y.x, y.y, y.z, y.w};
#pragma unroll
                for (int q = 0; q < 4; ++q) { const f32x4 r0 = *(const LAS f32x4*)(rt + (4 * c4 + q) * 8), r1 = *(const LAS f32x4*)(rt + (4 * c4 + q) * 8 + 4);
                    lg[0] += yy[q] * r0.x; lg[1] += yy[q] * r0.y; lg[2] += yy[q] * r0.z; lg[3] += yy[q] * r0.w; lg[4] += yy[q] * r1.x; lg[5] += yy[q] * r1.y; lg[6] += yy[q] * r1.z; lg[7] += yy[q] * r1.w; } }
#pragma unroll
            for (int e = 0; e < 8; ++e) lg[e] = wave_sum(lg[e]);
            int e0 = 0; float v0 = lg[0];
#pragma unroll
            for (int e = 1; e < 8; ++e) if (lg[e] > v0) { v0 = lg[e]; e0 = e; }
            int e1 = -1; float v1 = -3.0e38f;
#pragma unroll
            for (int e = 0; e < 8; ++e) if (e != e0 && lg[e] > v1) { v1 = lg[e]; e1 = e; }
            const float w0 = 1.f / (1.f + expf(v1 - v0)), w1 = 1.f - w0;
            if (F.lane == 0) { TopE[row] = e0 | (e1 << 8); TopW[row] = (f32x2){w0, w1}; lc[F.wave * 8 + it] = e0 | (e1 << 8); }
        }
        WG_SYNC();
        if (F.tid < 8) { int c = 0; for (int t = 0; t < 64; ++t) { const int code = lc[t]; c += ((code & 255) == F.tid ? 1 : 0) + ((code >> 8) == F.tid ? 1 : 0); } Cnts[wg * 8 + F.tid] = c; }
        WG_SYNC();
    }
}
DI void moe_gather_phase(Fr& F) {
    const bf16* H2 = (const bf16*)(F.ws + WS_MIX); const int* TopE = (const int*)(F.ws + WS_MISC + MISC_TOPE); const f32x2* TopW = (const f32x2*)(F.ws + WS_MISC + MISC_TOPW);
    const int* Cnts = (const int*)(F.ws + WS_MISC + MISC_CNTS); int* Exp = (int*)(F.ws + WS_MISC + MISC_EXP);
    bf16* XG = (bf16*)(F.ws + WS_XG); int* RowTok = (int*)(F.ws + WS_ROWS); float* RowW = (float*)(F.ws + WS_ROWS + 262144);
    LAS int* lc = (LAS int*)F.lds;
    LAS int* tot = lc + 2048;
    LAS int* rows = tot + 32;
    LAS int* te = rows + 128;
    for (int idx = F.tid; idx < 2048; idx += NTHR) lc[idx] = Cnts[idx];
    WG_SYNC();
    for (int wg = F.bx; wg < 256; wg += F.G) {
        if (F.tid < 64) te[F.tid] = TopE[wg * 64 + F.tid];
        if (F.tid < 8) { int t = 0, mb = 0; for (int w = 0; w < 256; ++w) { const int c = lc[w * 8 + F.tid]; t += c; mb += (w < wg) ? c : 0; } tot[F.tid] = t; tot[16 + F.tid] = mb; }
        WG_SYNC();
        if (F.tid == 0) { int sgs = 0; for (int e = 0; e < 8; ++e) { tot[8 + e] = sgs; sgs += (tot[e] + 255) & ~255; }
            if (wg == 0) { int acc = 0; for (int e = 0; e < 8; ++e) { Exp[e] = tot[e]; Exp[8 + e] = tot[8 + e]; acc += (tot[e] + 255) >> 8; Exp[16 + e] = acc; } } }
        WG_SYNC();
        if (F.tid < 64) { const int code = te[F.tid]; const int e0 = code & 255, e1 = code >> 8; int r0 = 0, r1 = 0;
            for (int t = 0; t < F.tid; ++t) { const int c2 = te[t]; const int a = c2 & 255, bq = c2 >> 8; r0 += (a == e0 ? 1 : 0) + (bq == e0 ? 1 : 0); r1 += (a == e1 ? 1 : 0) + (bq == e1 ? 1 : 0); }
            rows[2 * F.tid] = tot[8 + e0] + tot[16 + e0] + r0; rows[2 * F.tid + 1] = tot[8 + e1] + tot[16 + e1] + r1; }
        WG_SYNC();
        for (int it = F.wave; it < 128; it += NWAVES) { const int t = it >> 1, k = it & 1, tok = wg * 64 + t, row = rows[it];
            const u32x4* s = (const u32x4*)(H2 + (size_t)tok * D); u32x4* d = (u32x4*)(XG + (size_t)row * D);
            d[F.lane] = s[F.lane]; d[F.lane + 64] = s[F.lane + 64];
            if (F.lane == 0) { RowTok[row] = tok * 2 + k; const f32x2 w = TopW[tok]; RowW[row] = k ? w.y : w.x; } }
        if (wg == 0) {
            for (int e = 0; e < 8; ++e) { const int a = tot[8 + e] + tot[e], bnd = tot[8 + e] + ((tot[e] + 255) & ~255); for (int rr = a + F.tid; rr < bnd; rr += NTHR) RowTok[rr] = -1; } }
        WG_SYNC();
    }
}
DI void moe_combine_phase(Fr& F, float* xl, const float* modl) {
    const bf16* YS = (const bf16*)(F.ws + WS_YS);
    for (int row = F.gw; row < ML; row += F.NGW) {
        const float* mrow = modl + (size_t)(row / SEQ) * 6144 + 5120; float* xr = xl + (size_t)row * D;
        const u32x2* s0 = (const u32x2*)(YS + (size_t)(2 * row) * D); const u32x2* s1 = (const u32x2*)(YS + (size_t)(2 * row + 1) * D);
#pragma unroll
        for (int j = 0; j < 4; ++j) { const int c4 = F.lane + 64 * j; const f32x4 x = ((const f32x4*)xr)[c4], m = ((const f32x4*)mrow)[c4]; const u32x2 a = s0[c4], bq = s1[c4];
            f32x4 o; o.x = x.x + m.x * (bflo(a.x) + bflo(bq.x)); o.y = x.y + m.y * (bfhi(a.x) + bfhi(bq.x)); o.z = x.z + m.z * (bflo(a.y) + bflo(bq.y)); o.w = x.w + m.w * (bfhi(a.y) + bfhi(bq.y));
            ((f32x4*)xr)[c4] = o; }
    }
}

constexpr int N_PHASES = 20;
struct Args { const float* in[37]; float* out; unsigned char* ws; int ph_lo, ph_hi; };
template <class Epi> DI void run_gemm(Fr& F, const bf16* A, const bf16* Bt, int M, int N, int K, const Epi& E, int& rot) {
    int Kv = K; asm volatile("" : "+s"(Kv));
    pg8::Gemm g{A, Bt, M, N, Kv}; pg8::StaticOrder S; S.init(M, N, F.G, (F.bx + F.G - (rot % F.G)) % F.G); rot += (M / 256) * (N / 256);
    pg8::gemm_phase<Epi, pg8::StaticOrder>(F.lds, g, S, E);
}
__global__ void __launch_bounds__(NTHR, 2) fwd_kernel(Args args) {
    extern __shared__ __attribute__((aligned(16))) unsigned char lds_raw[];
    Fr F;
    F.lds = (LAS unsigned char*)lds_raw; F.ws = args.ws; F.in = args.in; F.out = args.out;
    F.tid = threadIdx.x; F.lane = F.tid & 63; F.wave = __builtin_amdgcn_readfirstlane(F.tid >> 6); F.bx = blockIdx.x; F.G = gridDim.x;
    F.gw = F.bx * NWAVES + F.wave; F.NGW = F.G * NWAVES;
    volatile LAS unsigned* MISC = (volatile LAS unsigned*)(F.lds + LDS_MISC_OFF);
    if (F.tid < 64) MISC[F.tid] = 0u;
    __syncthreads();
    const int lo = args.ph_lo, hi = args.ph_hi;
    const bool multi = (hi - lo) > 1;
    XcdBarrier bar; bar.bar = (unsigned*)(F.ws + WS_CTL) + CW_BAR; bar.x = 0; bar.st = nullptr;
    if (multi) bar = xcd_barrier_post((unsigned*)(F.ws + WS_CTL) + CW_BAR, MISC + 8);
#ifndef PH_MASK
#define PH_MASK 0xFFFFFFFFu
#endif
#define IN(k) ((((PH_MASK) >> (k)) & 1u) && lo <= (k) && (k) < hi)
#define REP(k) for (int rep_ = 0; rep_ < ((((PROBE_DUP) >> (k)) & 1u) ? 2 : 1); ++rep_)
#define SEAM(k) do { if (IN(k) && IN((k) + 1)) xcd_barrier(bar); } while (0)
    const float* const* in = args.in;
    float* MOD = (float*)(F.ws + WS_MOD);
    float* XL = F.out; float* XC = (float*)(F.ws + WS_XC);
    bf16* H = (bf16*)(F.ws + WS_H); bf16* MIX = (bf16*)(F.ws + WS_MIX);

    if (IN(0)) REP(0) { p0_prologue(F); } SEAM(0);
    if (IN(1)) REP(1) { mod_rows(F, in[0], in[2], MA, in[6], MOD, 0, 1024, H); } SEAM(1);
    if (IN(2)) REP(2) { int rot = 0; EpiStore<0> E{(bf16*)(F.ws + WS_QKV), INW, INW}; run_gemm(F, H, (const bf16*)(F.ws + WS_W_IN), MA, INW, 1024, E, rot); } SEAM(2);
    if (IN(3)) REP(3) { ret_kv_phase(F); } SEAM(3);
    if (IN(4)) REP(4) { ret_prefix_phase(F); } SEAM(4);
    #ifndef PH5_SEL
#define PH5_SEL 3
#endif
    if (IN(5)) REP(5) { if (PH5_SEL & 1) ret_out_phase(F); if (PH5_SEL & 2) na_phase(F); } SEAM(5);
    if (IN(6)) REP(6) { int rot = 0; EpiResid E{in[0], XL, in[2], XC, MOD + 2048}; run_gemm(F, MIX, (const bf16*)(F.ws + WS_W_OUT), MA, 1024, 1024, E, rot); } SEAM(6);
    if (IN(7)) REP(7) { mod_rows(F, XL, XC, MA, in[7], MOD, 3072, 4096, H); } SEAM(7);
    if (IN(8)) REP(8) { int rot = 0; EpiSwiglu E{(bf16*)(F.ws + WS_FFH), FFN_H}; run_gemm(F, H, (const bf16*)(F.ws + WS_W_13), MA, 2 * FFN_H, 1024, E, rot); } SEAM(8);
    if (IN(9)) { int rot = 0; EpiResid E{XL, XL, XC, XC, MOD + 5120}; run_gemm(F, (const bf16*)(F.ws + WS_FFH), (const bf16*)(F.ws + WS_W_2), MA, 1024, FFN_H, E, rot); } SEAM(9);
    const float* MOD1 = MOD + 9 * 6144;
    if (IN(10)) REP(10) { xm_phase(F, XL, XC, in[6] + 1024, MOD1); } SEAM(10);
    if (IN(11)) REP(11) { int rot = 0; const bf16* XM = (const bf16*)(F.ws + WS_XM); const bf16* WR = (const bf16*)(F.ws + WS_W_RKV); const bf16* WL1 = (const bf16*)(F.ws + WS_W_L1);
        { EpiStoreHead E{(bf16*)(F.ws + WS_RB), SEQ, 0}; run_gemm(F, XM, WR, ML, 1024, 1024, E, rot); }
        { EpiStoreHead E{(bf16*)(F.ws + WS_KB), SEQ + CTXL, CTXL}; run_gemm(F, XM + (size_t)1 * MA * D, WR + 1024 * 1024, MA, 1024, 1024, E, rot); }
        { EpiStoreHead E{(bf16*)(F.ws + WS_VB), SEQ + CTXL, CTXL}; run_gemm(F, XM + (size_t)2 * MA * D, WR + 2 * 1024 * 1024, MA, 1024, 1024, E, rot); }
        { EpiStore<1> E{(bf16*)(F.ws + WS_L1), 256, 128}; run_gemm(F, XM + (size_t)3 * MA * D, WL1, MA, 256, 1024, E, rot); }
        { EpiStore<0> E{(bf16*)(F.ws + WS_L1) + 128, 256, 128}; run_gemm(F, XM + (size_t)4 * MA * D, WL1 + 256 * 1024, MA, 256, 1024, E, rot); }
        { EpiStore<2> E{(bf16*)(F.ws + WS_LG), 256, 256}; run_gemm(F, XM + (size_t)5 * MA * D, WL1 + 2 * 256 * 1024, ML, 256, 1024, E, rot); } } SEAM(11);
    if (IN(12)) REP(12) { int rot = 0;
        { EpiLora2 E{(float*)(F.ws + WS_DEC), (bf16*)(F.ws + WS_AG), in[20], in[23]}; run_gemm(F, (const bf16*)(F.ws + WS_L1), (const bf16*)(F.ws + WS_W_L2), MA, 4096, 256, E, rot); }
        { EpiStore<0> E{(bf16*)(F.ws + WS_G), D, D}; run_gemm(F, (const bf16*)(F.ws + WS_LG), (const bf16*)(F.ws + WS_W_G2), ML, 1024, 256, E, rot); } } SEAM(12);
    #ifndef SCAN_VER
#define SCAN_VER 2
#endif
    if (IN(13)) REP(13) { rwkv_scan2_phase(F); } SEAM(13);
    if (IN(14)) REP(14) { rwkv_readout_phase(F); } SEAM(14);
    if (IN(15)) { int rot = 0; EpiResid E{XL, XL, XC, XC, MOD1 + 2048}; run_gemm(F, H, (const bf16*)(F.ws + WS_W_O), ML, 1024, 1024, E, rot); } SEAM(15);
    if (IN(16)) REP(16) { moe_route_phase(F, XL, in[7] + 1024, MOD1); } SEAM(16);
    if (IN(17)) REP(17) { moe_gather_phase(F); } SEAM(17);
    if (IN(18) || IN(19)) {
        const int* Exp = (const int*)(F.ws + WS_MISC + MISC_EXP);
        pg8::MoeOrder S; S.G = F.G; S.c = F.bx;
#pragma unroll
        for (int e = 0; e < 8; ++e) S.tend[e] = Exp[16 + e];
        S.nM = S.tend[7];
        if (IN(18)) REP(18) { S.nN = 2 * EXP_H / 256; S.nwg = S.nM * S.nN; pg8::Gemm g{(const bf16*)(F.ws + WS_XG), (const bf16*)(F.ws + WS_W_M13), XG_ROWS, 2 * EXP_H, 1024};
            EpiSwiglu E{(bf16*)(F.ws + WS_HG), EXP_H}; pg8::gemm_phase<EpiSwiglu, pg8::MoeOrder>(F.lds, g, S, E); }
        SEAM(18);
        if (IN(19)) REP(19) { S.nN = 4; S.nwg = S.nM * S.nN; pg8::Gemm g{(const bf16*)(F.ws + WS_HG), (const bf16*)(F.ws + WS_W_M2), XG_ROWS, 1024, EXP_H};
            EpiMoeOut E{(bf16*)(F.ws + WS_YS), (const int*)(F.ws + WS_ROWS), (const float*)(F.ws + WS_ROWS + 262144)}; pg8::gemm_phase<EpiMoeOut, pg8::MoeOrder>(F.lds, g, S, E); }
    }
    if (IN(19) && IN(20)) xcd_barrier(bar);
    if (IN(20)) { moe_combine_phase(F, XL, MOD1); }
#undef IN
#undef SEAM
}

#ifndef MK_SPLIT
#define MK_SPLIT 0
#endif
extern "C" void kernel_launch(void* const* d_in, const int* in_sizes, int n_in, void* d_out, int out_size, void* d_ws, size_t ws_size, hipStream_t stream) {
    static int grid = 0;
    if (grid == 0) {
        if (n_in != 37 || out_size != ML * D || ws_size < WS_END) { fprintf(stderr, "kernel_launch: unexpected problem (n_in %d out %d ws %zu)\n", n_in, out_size, ws_size); grid = -1; return; }
        int dev = 0, cus = 0, per_cu = 0;
        if (hipGetDevice(&dev) != hipSuccess || hipDeviceGetAttribute(&cus, hipDeviceAttributeMultiprocessorCount, dev) != hipSuccess) { grid = -1; return; }
        if (hipFuncSetAttribute((const void*)fwd_kernel, hipFuncAttributeMaxDynamicSharedMemorySize, LDS_BYTES) != hipSuccess) { fprintf(stderr, "kernel_launch: hipFuncSetAttribute failed\n"); grid = -1; return; }
        if (hipOccupancyMaxActiveBlocksPerMultiprocessor(&per_cu, (const void*)fwd_kernel, NTHR, LDS_BYTES) != hipSuccess || per_cu < 1) { fprintf(stderr, "kernel_launch: occupancy query says %d\n", per_cu); }
        (void)hipGetLastError();
        grid = cus;
    }
    if (grid < 0) return;
    (void)hipMemsetAsync((char*)d_ws + WS_CTL, 0, CTL_ZERO_BYTES, stream);
    Args a{};
    for (int i = 0; i < 37; ++i) a.in[i] = (const float*)d_in[i];
    a.out = (float*)d_out; a.ws = (unsigned char*)d_ws;
#if MK_SPLIT
    for (int p = 0; p <= N_PHASES; ++p) { a.ph_lo = p; a.ph_hi = p + 1; hipLaunchKernelGGL(fwd_kernel, dim3(grid), dim3(NTHR), LDS_BYTES, stream, a); }
#else
    a.ph_lo = 0; a.ph_hi = N_PHASES + 1; hipLaunchKernelGGL(fwd_kernel, dim3(grid), dim3(NTHR), LDS_BYTES, stream, a);
#endif
}
```

```cpp
#include <hip/hip_runtime.h>
#include <cstdio>
#include <cstdint>

#ifndef PROBE_DUP
#define PROBE_DUP 0u
#endif
#define DI __device__ __forceinline__
#define LAS __attribute__((address_space(3)))

namespace pg8 {
#define PG8_LAS __attribute__((address_space(3)))
typedef unsigned short bf16_t;
typedef short bf16x8 __attribute__((ext_vector_type(8)));
typedef float f32x4 __attribute__((ext_vector_type(4)));
typedef unsigned u32x4 __attribute__((ext_vector_type(4)));
constexpr int BM = 256, BK = 64, HALF = 128, HTB = HALF * BK * 2  , STAGE_BYTES = 8 * HTB, NXCD = 8, WGM = 8;

__host__ __device__ __forceinline__ int lds_byte(int r, int c) { const int st = (r >> 4) * 2 + (c >> 5), rr = r & 15, cc = c & 31, ob = rr * 64 + cc * 2; return st * 1024 + (ob ^ (((ob >> 9) & 1) << 5)); }
__host__ __device__ __forceinline__ void stage_rc(int b, int& R, int& C) { const int st = b / 1024, sb = b % 1024, swz = sb ^ (((sb >> 9) & 1) << 5); R = (st >> 1) * 16 + swz / 64; C = (st & 1) * 32 + (swz % 64) / 2; }
__host__ __device__ __forceinline__ int perm32(int rho) { const int n = rho >> 4, i = rho & 15; return 8 * (i >> 2) + 4 * n + (i & 3); }

struct Unit { int pm, pn, pb; };
struct Gemm { const bf16_t* A; const bf16_t* Bt; int M, N, K; };

struct StaticOrder {
    int nM, nN, nwg, G, c;
    __host__ __device__ void init(int M, int N, int G_, int c_) { nM = M / BM; nN = N / BM; nwg = nM * nN; G = G_; c = c_; }
    __host__ __device__ bool next(int i, Unit& u) const {
        const long L = (long)i * G + c; if (L >= nwg) return false;
        int wgid = (int)L; { const int q = nwg / NXCD, r = nwg % NXCD, xcd = wgid % NXCD, off = wgid / NXCD; wgid = (xcd < r ? xcd * (q + 1) : r * (q + 1) + (xcd - r) * q) + off; }
        const int nig = WGM * nN, gid = wgid / nig, fm = gid * WGM, gsz = (nM - fm) < WGM ? (nM - fm) : WGM;
        u.pm = fm + ((wgid % nig) % gsz); u.pn = (wgid % nig) / gsz; u.pb = u.pn; return true;
    }
    __device__ __forceinline__ void a_ready(const Unit&) const {}
    __device__ __forceinline__ void done(const Unit&) const {}
};
struct MoeOrder {
    int nM, nN, nwg, G, c; int tend[8];
    __device__ bool next(int i, Unit& u) const {
        const long L = (long)i * G + c; if (L >= nwg) return false;
        int wgid = (int)L; { const int q = nwg / NXCD, r = nwg % NXCD, xcd = wgid % NXCD, off = wgid / NXCD; wgid = (xcd < r ? xcd * (q + 1) : r * (q + 1) + (xcd - r) * q) + off; }
        const int nig = WGM * nN, gid = wgid / nig, fm = gid * WGM, gsz = (nM - fm) < WGM ? (nM - fm) : WGM;
        u.pm = fm + ((wgid % nig) % gsz); u.pn = (wgid % nig) / gsz;
        int e = 0;
#pragma unroll
        for (int j = 0; j < 7; ++j) e += (u.pm >= tend[j]) ? 1 : 0;
        u.pb = e * nN + u.pn; return true;
    }
    __device__ __forceinline__ void a_ready(const Unit&) const {}
    __device__ __forceinline__ void done(const Unit&) const {}
};

typedef float f32x2_t __attribute__((ext_vector_type(2))); typedef __bf16 bf16x2_t __attribute__((ext_vector_type(2)));
__device__ __forceinline__ unsigned cvt_pk_bf16(float lo, float hi) { const f32x2_t v = {lo, hi}; const bf16x2_t b = __builtin_convertvector(v, bf16x2_t); return __builtin_bit_cast(unsigned, b); }

template <class Epi, class Sched>
__device__ __forceinline__ void gemm_phase(PG8_LAS unsigned char* lds, const Gemm g, const Sched& S, const Epi& E) {
    const int tid = threadIdx.x, wid = __builtin_amdgcn_readfirstlane(tid >> 6), lane = tid & 63, wr = wid >> 2, wc = wid & 3, fr = lane & 15, fq = lane >> 4;
    const int K = g.K, nt = K / BK;
    unsigned voffA[2], voffB[2];
#pragma unroll
    for (int i = 0; i < 2; ++i) { int R, C; stage_rc(tid * 16 + i * 8192, R, C); const int Rb = Epi::PERM ? ((R & ~31) + perm32(R & 31)) : R;
        voffA[i] = (unsigned)(R * K + C) * 2u; voffB[i] = (unsigned)(Rb * K + C) * 2u; }
    const size_t kstep = (size_t)(BK * 2);
    const size_t hstep = (size_t)HALF * K * 2;
    const size_t tstep = 2 * hstep;
    const unsigned ldsw = (unsigned)wid * 1024u;
    const int aoff = lds_byte(wr * 64 + fr, fq * 8), boff = lds_byte(wc * 32 + fr, fq * 8);
#define PG8_SA(b, h) (((b) * 2 + (h)) * HTB)
#define PG8_SB(b, h) ((4 + (b) * 2 + (h)) * HTB)
#define PG8_STAGE(bufoff, gbase, voff) do { _Pragma("unroll") for (int _i = 0; _i < 2; ++_i) \
        __builtin_amdgcn_global_load_lds((const unsigned*)((const char*)(gbase) + (voff)[_i]), (PG8_LAS unsigned*)(lds + (bufoff) + ldsw + _i * 8192), 16, 0, 0); } while (0)
#define PG8_LDA(dst, b, h) do { _Pragma("unroll") for (int m = 0; m < 4; ++m) _Pragma("unroll") for (int k = 0; k < 2; ++k) dst[m][k] = *(const PG8_LAS bf16x8*)(lds + PG8_SA(b, h) + aoff + m * 2048 + k * 1024); } while (0)
#define PG8_LDB(dst, b, h) do { _Pragma("unroll") for (int n = 0; n < 2; ++n) _Pragma("unroll") for (int k = 0; k < 2; ++k) dst[n][k] = *(const PG8_LAS bf16x8*)(lds + PG8_SB(b, h) + boff + n * 2048 + k * 1024); } while (0)
#define PG8_MMA(ai, bj, At, Bt) do { __builtin_amdgcn_s_setprio(1); _Pragma("unroll") for (int m = 0; m < 4; ++m) _Pragma("unroll") for (int n = 0; n < 2; ++n) _Pragma("unroll") for (int k = 0; k < 2; ++k) \
        acc[ai][bj][m][n] = __builtin_amdgcn_mfma_f32_16x16x32_bf16(Bt[n][k], At[m][k], acc[ai][bj][m][n], 0, 0, 0); __builtin_amdgcn_s_setprio(0); } while (0)
#define PG8_WAIT_V(n) asm volatile("s_waitcnt vmcnt(" #n ")" ::: "memory")
#define PG8_WAIT_L(n) asm volatile("s_waitcnt lgkmcnt(" #n ")" ::: "memory")
#define PG8_BAR __builtin_amdgcn_s_barrier()
#define PG8_SCHED __builtin_amdgcn_sched_barrier(0)
    Unit cur, nxt; int ui = 0;
    if (!S.next(0, cur)) return;
    f32x4 acc[2][2][4][2];
#pragma unroll
    for (int a = 0; a < 2; ++a)
#pragma unroll
        for (int b = 0; b < 2; ++b)
#pragma unroll
            for (int m = 0; m < 4; ++m)
#pragma unroll
                for (int n = 0; n < 2; ++n) acc[a][b][m][n] = (f32x4){0.f, 0.f, 0.f, 0.f};
    bf16x8 At[4][2], B0[2][2], B1[2][2];
    const char* cA = (const char*)g.A + (size_t)cur.pm * tstep; const char* cB = (const char*)g.Bt + (size_t)cur.pb * tstep;
    S.a_ready(cur);
    PG8_STAGE(PG8_SB(0, 0), cB, voffB); PG8_STAGE(PG8_SA(0, 0), cA, voffA); PG8_STAGE(PG8_SB(0, 1), cB + hstep, voffB); PG8_STAGE(PG8_SA(0, 1), cA + hstep, voffA);
    if (wr == 1) PG8_BAR;
    PG8_WAIT_V(4); PG8_BAR;
    PG8_STAGE(PG8_SB(1, 0), cB + kstep, voffB); PG8_STAGE(PG8_SA(1, 0), cA + kstep, voffA); PG8_STAGE(PG8_SB(1, 1), cB + hstep + kstep, voffB);
    PG8_WAIT_V(6); PG8_BAR;
    for (;;) {
        const bool has_next = S.next(ui + 1, nxt);
        const char* nA = has_next ? (const char*)g.A + (size_t)nxt.pm * tstep : cA; const char* nB = has_next ? (const char*)g.Bt + (size_t)nxt.pb * tstep : cB;
        for (int t = 0; t < nt; t += 2) {
            const bool last = (t == nt - 2);
            const char* a1 = cA + (size_t)(t + 1) * kstep;
            const char* a2 = last ? nA : cA + (size_t)(t + 2) * kstep; const char* b2 = last ? nB : cB + (size_t)(t + 2) * kstep;
            const char* a3 = a2 + kstep; const char* b3 = b2 + kstep;
            if (last && has_next) S.a_ready(nxt);
            PG8_LDB(B0, 0, 0); PG8_SCHED; PG8_LDA(At, 0, 0); PG8_STAGE(PG8_SA(1, 1), a1 + hstep, voffA);
            PG8_WAIT_L(8); PG8_BAR; PG8_WAIT_L(0); PG8_MMA(0, 0, At, B0); PG8_BAR; PG8_SCHED;
            PG8_LDB(B1, 0, 1); PG8_STAGE(PG8_SB(0, 0), b2, voffB);
            PG8_BAR; PG8_WAIT_L(0); PG8_MMA(0, 1, At, B1); PG8_BAR;
            PG8_LDA(At, 0, 1); PG8_STAGE(PG8_SA(0, 0), a2, voffA);
            PG8_BAR; PG8_WAIT_L(0); PG8_MMA(1, 0, At, B0); PG8_BAR; PG8_SCHED;
            PG8_STAGE(PG8_SB(0, 1), b2 + hstep, voffB);
            PG8_WAIT_V(6); PG8_BAR; PG8_MMA(1, 1, At, B1); PG8_BAR;
            PG8_LDB(B0, 1, 0); PG8_SCHED; PG8_LDA(At, 1, 0); PG8_STAGE(PG8_SA(0, 1), a2 + hstep, voffA);
            PG8_WAIT_L(8); PG8_BAR; PG8_WAIT_L(0); PG8_MMA(0, 0, At, B0); PG8_BAR; PG8_SCHED;
            PG8_LDB(B1, 1, 1); PG8_STAGE(PG8_SB(1, 0), b3, voffB);
            PG8_BAR; PG8_WAIT_L(0); PG8_MMA(0, 1, At, B1); PG8_BAR;
            PG8_LDA(At, 1, 1); PG8_STAGE(PG8_SA(1, 0), a3, voffA);
            PG8_BAR; PG8_WAIT_L(0); PG8_MMA(1, 0, At, B0); PG8_BAR; PG8_SCHED;
            PG8_STAGE(PG8_SB(1, 1), b3 + hstep, voffB);
            PG8_WAIT_V(6); PG8_BAR; PG8_MMA(1, 1, At, B1); PG8_BAR;
        }
        E(acc, cur, wr, wc, fr, fq); S.done(cur);
        if (!has_next) break;
#pragma unroll
        for (int a = 0; a < 2; ++a)
#pragma unroll
            for (int b = 0; b < 2; ++b)
#pragma unroll
                for (int m = 0; m < 4; ++m)
#pragma unroll
                    for (int n = 0; n < 2; ++n) acc[a][b][m][n] = (f32x4){0.f, 0.f, 0.f, 0.f};
        cur = nxt; cA = nA; cB = nB; ++ui;
    }
    PG8_WAIT_V(0);
    if (wr == 0) PG8_BAR;
    PG8_BAR;
#undef PG8_SA
#undef PG8_SB
#undef PG8_STAGE
#undef PG8_LDA
#undef PG8_LDB
#undef PG8_MMA
#undef PG8_WAIT_V
#undef PG8_WAIT_L
#undef PG8_BAR
#undef PG8_SCHED
}
}

constexpr int D = 1024, NB = 8, SEQ = 2048, CTXL = 256;
constexpr int ML = NB * SEQ;
constexpr int MC = NB * CTXL;
constexpr int MA = ML + MC;
constexpr int INW = 3584, FFN_H = 2816, EXP_H = 3584, NEXP = 8;
constexpr int NCH = 18;
constexpr int XG_ROWS = 34816;
constexpr int NWAVES = 8, NTHR = 512;

constexpr size_t MiB = 1u << 20;
constexpr size_t WS_CTL = 0, CTL_ZERO_BYTES = 1 * MiB;
constexpr size_t WS_MOD = 1 * MiB;
constexpr size_t WS_ROPE = 2 * MiB;
constexpr size_t WS_MISC = 3 * MiB;
constexpr size_t WS_W_IN = 4 * MiB, WS_W_OUT = 11 * MiB, WS_W_13 = 13 * MiB, WS_W_2 = 24 * MiB, WS_W_RKV = 30 * MiB, WS_W_L1 = 36 * MiB,
                 WS_W_L2 = 38 * MiB, WS_W_G2 = 40 * MiB, WS_W_O = 41 * MiB, WS_W_M13 = 43 * MiB, WS_W_M2 = 155 * MiB;
constexpr size_t WS_XC = 211 * MiB, WS_H = 219 * MiB, WS_MIX = 255 * MiB, WS_R = 291 * MiB;
constexpr size_t WS_QKV = WS_R, WS_KV = WS_R + 126 * MiB, WS_SPREV = WS_R + 198 * MiB, WS_FFH = WS_R;
constexpr size_t WS_XM = WS_R, WS_DEC = WS_R, WS_AG = WS_R + 144 * MiB, WS_RB = WS_R + 216 * MiB, WS_KB = WS_R + 248 * MiB, WS_VB = WS_R + 284 * MiB,
                 WS_L1 = WS_R + 320 * MiB, WS_LG = WS_R + 329 * MiB, WS_G = WS_R + 337 * MiB, WS_YF = WS_R + 369 * MiB, WS_YB = WS_R + 433 * MiB;
constexpr size_t WS_XG = WS_R, WS_HG = WS_R + 68 * MiB, WS_YS = WS_R + 306 * MiB, WS_ROWS = WS_R + 370 * MiB;
constexpr size_t WS_END = WS_R + 497 * MiB;
static_assert(WS_END <= 896 * MiB, "workspace map");
constexpr int CW_BAR = 4096;
constexpr size_t MISC_TOPE = 0, MISC_TOPW = 65536, MISC_CNTS = 196608, MISC_EXP = 204800;

constexpr int LDS_MAIN = 147456;
constexpr int LDS_MISC_OFF = LDS_MAIN;
constexpr int LDS_BYTES = LDS_MAIN + 256;

typedef unsigned short bf16;
typedef short bf16x8 __attribute__((ext_vector_type(8)));
typedef short s16x4 __attribute__((ext_vector_type(4)));
typedef float f32x4 __attribute__((ext_vector_type(4)));
typedef float f32x2 __attribute__((ext_vector_type(2)));
typedef unsigned u32x4 __attribute__((ext_vector_type(4)));
typedef unsigned u32x2 __attribute__((ext_vector_type(2)));
#define LDS_WAIT() asm volatile("s_waitcnt lgkmcnt(0)" ::: "memory")
#define VM_WAIT() asm volatile("s_waitcnt vmcnt(0)" ::: "memory")
#define WG_SYNC() __syncthreads()
#define LDS_BARRIER() do { asm volatile("s_waitcnt lgkmcnt(0)" ::: "memory"); __builtin_amdgcn_s_barrier(); asm volatile("" ::: "memory"); } while (0)
DI unsigned f2bf(float f) { unsigned u = __builtin_bit_cast(unsigned, f); return (u + 0x7fffu + ((u >> 16) & 1u)) >> 16; }
typedef __bf16 bf16x2_t __attribute__((ext_vector_type(2)));
DI unsigned pk2(float lo, float hi) { const f32x2 v = {lo, hi}; const bf16x2_t b = __builtin_convertvector(v, bf16x2_t); return __builtin_bit_cast(unsigned, b); }
DI float bflo(unsigned w) { return __builtin_bit_cast(float, w << 16); }
DI float bfhi(unsigned w) { return __builtin_bit_cast(float, w & 0xffff0000u); }
DI float bf1(bf16 b) { return __builtin_bit_cast(float, (unsigned)b << 16); }
DI float wave_sum(float v) {
#pragma unroll
    for (int o = 1; o < 64; o <<= 1) v += __shfl_xor(v, o);
    return v;
}
DI float dpp_rm(float v) { return __builtin_bit_cast(float, __builtin_amdgcn_update_dpp(0, __builtin_bit_cast(int, v), 0x140, 0xf, 0xf, true)); }
DI float wave_sum_fast(float v) {
    v += __builtin_bit_cast(float, __builtin_amdgcn_update_dpp(0, __builtin_bit_cast(int, v), 0xB1, 0xf, 0xf, true));
    v += __builtin_bit_cast(float, __builtin_amdgcn_update_dpp(0, __builtin_bit_cast(int, v), 0x4E, 0xf, 0xf, true));
    v += __builtin_bit_cast(float, __builtin_amdgcn_update_dpp(0, __builtin_bit_cast(int, v), 0x141, 0xf, 0xf, true));
    v += dpp_rm(v);
    const int iv = __builtin_bit_cast(int, v);
    const float a = __builtin_bit_cast(float, __builtin_amdgcn_readlane(iv, 0)), b = __builtin_bit_cast(float, __builtin_amdgcn_readlane(iv, 16));
    const float c = __builtin_bit_cast(float, __builtin_amdgcn_readlane(iv, 32)), d = __builtin_bit_cast(float, __builtin_amdgcn_readlane(iv, 48));
    return (a + b) + (c + d);
}
DI float wave_max(float v) {
#pragma unroll
    for (int o = 1; o < 64; o <<= 1) v = fmaxf(v, __shfl_xor(v, o));
    return v;
}
DI float dpp_x1(float v) { return __builtin_bit_cast(float, __builtin_amdgcn_update_dpp(0, __builtin_bit_cast(int, v), 0xB1, 0xf, 0xf, true)); }
DI float dpp_x2(float v) { return __builtin_bit_cast(float, __builtin_amdgcn_update_dpp(0, __builtin_bit_cast(int, v), 0x4E, 0xf, 0xf, true)); }
DI float dpp_hm(float v) { return __builtin_bit_cast(float, __builtin_amdgcn_update_dpp(0, __builtin_bit_cast(int, v), 0x141, 0xf, 0xf, true)); }
DI float red4(float v) { v += dpp_x1(v); v += dpp_x2(v); return v; }
DI float red8(float v) { v += dpp_x1(v); v += dpp_x2(v); v += dpp_hm(v); return v; }
DI float sigmoidf_(float x) { return 1.f / (1.f + __expf(-x)); }
DI float siluf_(float x) { return x / (1.f + __expf(-x)); }

DI bf16x8 frag_kc(const LAS bf16* base, int ld, int row0, int k0, int lane) {
    return *(const LAS bf16x8*)(base + (row0 + (lane & 15)) * ld + k0 + 8 * (lane >> 4));
}
DI bf16x8 frag_kr(const LAS bf16* base, int ld, int x0, int k0, int lane) {
    const int g = lane >> 4, q = (lane & 15) >> 2, p = lane & 3;
    const LAS bf16* a = base + (k0 + 8 * g + q) * ld + x0 + 4 * p;
    const s16x4 lo = __builtin_amdgcn_ds_read_tr16_b64_v4i16((LAS s16x4*)a);
    const s16x4 hi = __builtin_amdgcn_ds_read_tr16_b64_v4i16((LAS s16x4*)(a + 4 * ld));
    return __builtin_shufflevector(lo, hi, 0, 1, 2, 3, 4, 5, 6, 7);
}
DI f32x4 mma(f32x4 acc, bf16x8 bfrag, bf16x8 afrag) { return __builtin_amdgcn_mfma_f32_16x16x32_bf16(bfrag, afrag, acc, 0, 0, 0); }

#define XB_TMO      128
#define XB_XCNT(j)  (256  + 64 * (j))
#define XB_XSUB(j)  (1280 + 64 * (j))
#define XB_XGEN(j)  (2304 + 64 * (j))
#define XB_TOP      3328
#define XB_TOPGEN   3392
#define XCD_BAR_WORDS 3456
#define XB_SPIN_CAP (1u << 18)
DI unsigned xb_ld(unsigned* p)              { return __hip_atomic_load(p, __ATOMIC_RELAXED, __HIP_MEMORY_SCOPE_AGENT); }
DI unsigned xb_add(unsigned* p, unsigned v) { return __hip_atomic_fetch_add(p, v, __ATOMIC_RELAXED, __HIP_MEMORY_SCOPE_AGENT); }
DI unsigned xb_xcc_id() { return (unsigned)__builtin_amdgcn_s_getreg((3 << 11) | 20) & 0xFu; }
#define XB_SPIN(cond, bar) do { unsigned _sp = 0; while (cond) { __builtin_amdgcn_s_sleep(1); \
    if ((++_sp & 255u) == 0u) { if (xb_ld(&(bar)[XB_TMO])) break; if (_sp > XB_SPIN_CAP) { atomicAdd(&(bar)[XB_TMO], 1u); break; } } } } while (0)
struct XcdBarrier { unsigned* bar; unsigned x; volatile LAS unsigned* st; };
DI XcdBarrier xcd_barrier_post(unsigned* bar, volatile LAS unsigned* st) {
    XcdBarrier b; b.bar = bar; b.x = xb_xcc_id(); b.st = st;
    if (threadIdx.x == 0) (void)xb_add(&bar[XB_XCNT(b.x)], 1u);
    return b;
}
DI void xcd_barrier_complete(unsigned* bar, unsigned x, unsigned& nloc, unsigned& nx) {
    const unsigned G = gridDim.x * gridDim.y * gridDim.z;
    unsigned sum, cnt, mine, sp = 0u;
    for (;;) {
        sum = 0u; cnt = 0u; mine = 0u;
#pragma unroll
        for (unsigned j = 0; j < 16; ++j) { const unsigned c = xb_ld(&bar[XB_XCNT(j)]); sum += c; cnt += (c > 0u) ? 1u : 0u; mine = (j == x) ? c : mine; }
        if (sum == G) break;
        __builtin_amdgcn_s_sleep(1);
        if ((++sp & 255u) == 0u) { if (xb_ld(&bar[XB_TMO])) break; if (sp > XB_SPIN_CAP) { atomicAdd(&bar[XB_TMO], 1u); break; } }
    }
    nloc = mine > 0u ? mine : 1u; nx = cnt > 0u ? cnt : 1u;
}
DI void xcd_barrier(const XcdBarrier& b) {
    asm volatile("s_waitcnt vmcnt(0)" ::: "memory");
    __syncthreads();
    if (threadIdx.x == 0) {
        unsigned* bar = b.bar;
        __builtin_amdgcn_s_waitcnt(0);
        unsigned nloc = b.st[0], nx = b.st[1];
        if (nloc == 0u) { xcd_barrier_complete(bar, b.x, nloc, nx); b.st[0] = nloc; b.st[1] = nx; }
        const unsigned old = xb_add(&bar[XB_XSUB(b.x)], 1u);
        const unsigned gen = old / nloc;
        if (old + 1u == (gen + 1u) * nloc) {
            __builtin_amdgcn_fence(__ATOMIC_RELEASE, "agent");
            asm volatile("s_waitcnt vmcnt(0)" ::: "memory");
            const unsigned og = xb_add(&bar[XB_TOP], 1u);
            const unsigned tg = og / nx;
            if (og + 1u == (tg + 1u) * nx) xb_add(&bar[XB_TOPGEN], 1u);
            else XB_SPIN(xb_ld(&bar[XB_TOPGEN]) == tg, bar);
            __builtin_amdgcn_fence(__ATOMIC_ACQUIRE, "agent");
            xb_add(&bar[XB_XGEN(b.x)], 1u);
            asm volatile("s_waitcnt vmcnt(0)" ::: "memory");
        } else {
            XB_SPIN(xb_ld(&bar[XB_XGEN(b.x)]) == gen, bar);
            __builtin_amdgcn_fence(__ATOMIC_ACQUIRE, "agent");
            asm volatile("s_waitcnt vmcnt(0)" ::: "memory");
        }
    }
    __syncthreads();
}

struct Fr {
    LAS unsigned char* lds;
    unsigned char* ws;
    const float* const* in;
    float* out;
    int tid, lane, wave, bx, G, gw, NGW;
};

using pg8::Unit;
template <int ACT  > struct EpiStore {
    static constexpr bool PERM = true;
    bf16* O; int ldc; int nvalid;
    DI void operator()(const f32x4 (&acc)[2][2][4][2], const Unit& u, int wr, int wc, int fr, int fq) const {
        const int row0 = u.pm * 256 + wr * 64 + fr, col0 = u.pn * 256 + wc * 32 + 8 * fq;
#pragma unroll
        for (int ai = 0; ai < 2; ++ai)
#pragma unroll
            for (int m = 0; m < 4; ++m) { bf16* rowp = O + (size_t)(row0 + ai * 128 + m * 16) * ldc + col0;
#pragma unroll
                for (int bj = 0; bj < 2; ++bj) { if (u.pn * 256 + bj * 128 >= nvalid) continue;
                    f32x4 v0 = acc[ai][bj][m][0], v1 = acc[ai][bj][m][1];
                    if (ACT == 1) {
#pragma unroll
                        for (int j = 0; j < 4; ++j) { v0[j] = tanhf(v0[j]); v1[j] = tanhf(v1[j]); } }
                    if (ACT == 2) {
#pragma unroll
                        for (int j = 0; j < 4; ++j) { v0[j] = sigmoidf_(v0[j]); v1[j] = sigmoidf_(v1[j]); } }
                    u32x4 w; w.x = pg8::cvt_pk_bf16(v0[0], v0[1]); w.y = pg8::cvt_pk_bf16(v0[2], v0[3]); w.z = pg8::cvt_pk_bf16(v1[0], v1[1]); w.w = pg8::cvt_pk_bf16(v1[2], v1[3]);
                    *(u32x4*)(rowp + bj * 128) = w; } }
    }
};
struct EpiStoreHead {
    static constexpr bool PERM = true;
    bf16* O; int TL; int lat_off;
    DI void operator()(const f32x4 (&acc)[2][2][4][2], const Unit& u, int wr, int wc, int fr, int fq) const {
        const bool lat = u.pm < 64; const int b = lat ? (u.pm >> 3) : (u.pm - 64); const int sbase = lat ? lat_off + (u.pm & 7) * 256 : 0;
        const int rt0 = sbase + wr * 64 + fr, j = (wc & 1) * 32 + 8 * fq;
#pragma unroll
        for (int ai = 0; ai < 2; ++ai)
#pragma unroll
            for (int m = 0; m < 4; ++m)
#pragma unroll
                for (int bj = 0; bj < 2; ++bj) { const int h = 4 * u.pn + 2 * bj + (wc >> 1);
                    const f32x4 v0 = acc[ai][bj][m][0], v1 = acc[ai][bj][m][1];
                    u32x4 w; w.x = pg8::cvt_pk_bf16(v0[0], v0[1]); w.y = pg8::cvt_pk_bf16(v0[2], v0[3]); w.z = pg8::cvt_pk_bf16(v1[0], v1[1]); w.w = pg8::cvt_pk_bf16(v1[2], v1[3]);
                    *(u32x4*)(O + ((size_t)(b * 16 + h) * TL + rt0 + ai * 128 + m * 16) * 64 + j) = w; }
    }
};
struct EpiResid {
    static constexpr bool PERM = false;
    const float* baseL; float* outL; const float* baseC; float* outC; const float* modg;
    DI void operator()(const f32x4 (&acc)[2][2][4][2], const Unit& u, int wr, int wc, int fr, int fq) const {
        const bool lat = u.pm < 64; const int r = lat ? (u.pm >> 3) : 8;
        const float* base = lat ? baseL : baseC; float* out = lat ? outL : outC;
        const int row0 = (lat ? u.pm : u.pm - 64) * 256 + wr * 64 + fr, col0 = u.pn * 256 + wc * 32 + 4 * fq;
        const float* mg = modg + (size_t)r * 6144 + col0;
        f32x4 mv[2][2];
#pragma unroll
        for (int bj = 0; bj < 2; ++bj)
#pragma unroll
            for (int n = 0; n < 2; ++n) mv[bj][n] = *(const f32x4*)(mg + bj * 128 + n * 16);
#pragma unroll
        for (int ai = 0; ai < 2; ++ai)
#pragma unroll
            for (int m = 0; m < 4; ++m) { const size_t off = (size_t)(row0 + ai * 128 + m * 16) * D + col0;
#pragma unroll
                for (int bj = 0; bj < 2; ++bj)
#pragma unroll
                    for (int n = 0; n < 2; ++n) { const f32x4 bs = *(const f32x4*)(base + off + bj * 128 + n * 16);
                        *(f32x4*)(out + off + bj * 128 + n * 16) = bs + mv[bj][n] * acc[ai][bj][m][n]; } }
    }
};
struct EpiSwiglu {
    static constexpr bool PERM = true;
    bf16* Hd; int ldh;
    DI void operator()(const f32x4 (&acc)[2][2][4][2], const Unit& u, int wr, int wc, int fr, int fq) const {
        const int row0 = u.pm * 256 + wr * 64 + fr, col0 = u.pn * 128 + wc * 32 + 8 * fq;
#pragma unroll
        for (int ai = 0; ai < 2; ++ai)
#pragma unroll
            for (int m = 0; m < 4; ++m) { bf16* rowp = Hd + (size_t)(row0 + ai * 128 + m * 16) * ldh + col0;
                f32x4 v0, v1;
#pragma unroll
                for (int j = 0; j < 4; ++j) { v0[j] = siluf_(acc[ai][0][m][0][j]) * acc[ai][1][m][0][j]; v1[j] = siluf_(acc[ai][0][m][1][j]) * acc[ai][1][m][1][j]; }
                u32x4 w; w.x = pg8::cvt_pk_bf16(v0[0], v0[1]); w.y = pg8::cvt_pk_bf16(v0[2], v0[3]); w.z = pg8::cvt_pk_bf16(v1[0], v1[1]); w.w = pg8::cvt_pk_bf16(v1[2], v1[3]);
                *(u32x4*)rowp = w; }
    }
};
struct EpiLora2 {
    static constexpr bool PERM = true;
    float* DEC; bf16* AG; const float* w0; const float* a0;
    DI void operator()(const f32x4 (&acc)[2][2][4][2], const Unit& u, int wr, int wc, int fr, int fq) const {
        const int q = u.pn >> 2, z = q & 1; const int col0 = (u.pn & 3) * 256 + wc * 32 + 8 * fq;
        const bool lat = u.pm < 64; const int b = lat ? (u.pm >> 3) : (u.pm - 64); const int rt0 = (lat ? CTXL + (u.pm & 7) * 256 : 0) + wr * 64 + fr, j = (wc & 1) * 32 + 8 * fq;
        const float* bias = (q < 2 ? w0 : a0) + z * 1024 + col0;
        f32x4 bv[2][2];
#pragma unroll
        for (int bj = 0; bj < 2; ++bj)
#pragma unroll
            for (int n = 0; n < 2; ++n) bv[bj][n] = *(const f32x4*)(bias + bj * 128 + 4 * n);
#pragma unroll
        for (int ai = 0; ai < 2; ++ai)
#pragma unroll
            for (int m = 0; m < 4; ++m) {
#pragma unroll
                for (int bj = 0; bj < 2; ++bj) { f32x4 v0 = acc[ai][bj][m][0] + bv[bj][0], v1 = acc[ai][bj][m][1] + bv[bj][1];
                    const int h = 4 * (u.pn & 3) + 2 * bj + (wc >> 1);
                    const size_t off = ((size_t)(z * 128 + b * 16 + h) * (SEQ + CTXL) + rt0 + ai * 128 + m * 16) * 64 + j;
                    if (q < 2) {
#pragma unroll
                        for (int jj = 0; jj < 4; ++jj) {
                            v0[jj] = -0.6065306597126334f * sigmoidf_(v0[jj]); v1[jj] = -0.6065306597126334f * sigmoidf_(v1[jj]); }
                        *(f32x4*)(DEC + off) = v0; *(f32x4*)(DEC + off + 4) = v1;
                        __builtin_amdgcn_sched_barrier(0);
                    } else {
#pragma unroll
                        for (int jj = 0; jj < 4; ++jj) { v0[jj] = sigmoidf_(v0[jj]); v1[jj] = sigmoidf_(v1[jj]); }
                        u32x4 w; w.x = pg8::cvt_pk_bf16(v0[0], v0[1]); w.y = pg8::cvt_pk_bf16(v0[2], v0[3]); w.z = pg8::cvt_pk_bf16(v1[0], v1[1]); w.w = pg8::cvt_pk_bf16(v1[2], v1[3]);
                        *(u32x4*)(AG + off) = w; __builtin_amdgcn_sched_barrier(0); } } }
    }
};
struct EpiMoeOut {
    static constexpr bool PERM = true;
    bf16* YS; const int* RowTok; const float* RowW;
    DI void operator()(const f32x4 (&acc)[2][2][4][2], const Unit& u, int wr, int wc, int fr, int fq) const {
        const int row0 = u.pm * 256 + wr * 64 + fr, col0 = u.pn * 256 + wc * 32 + 8 * fq;
#pragma unroll
        for (int ai = 0; ai < 2; ++ai)
#pragma unroll
            for (int m = 0; m < 4; ++m) { const int row = row0 + ai * 128 + m * 16; const int t2 = RowTok[row]; if (t2 < 0) continue; const float w = RowW[row];
                bf16* rowp = YS + (size_t)t2 * D + col0;
#pragma unroll
                for (int bj = 0; bj < 2; ++bj) { const f32x4 v0 = acc[ai][bj][m][0] * w, v1 = acc[ai][bj][m][1] * w;
                    u32x4 o; o.x = pg8::cvt_pk_bf16(v0[0], v0[1]); o.y = pg8::cvt_pk_bf16(v0[2], v0[3]); o.z = pg8::cvt_pk_bf16(v1[0], v1[1]); o.w = pg8::cvt_pk_bf16(v1[2], v1[3]);
                    *(u32x4*)(rowp + bj * 128) = o; } }
    }
};

DI void tr_item(const float* src, int ldsrc, int Kreal, int k0, int n0, bf16* dst, int lddst, int drow0, int dcol0, LAS float* scr, int lane) {
#pragma unroll 8
    for (int i = 0; i < 32; ++i) { const int kk = 2 * i + (lane >> 5), k = k0 + kk; float v = 0.f; if (k < Kreal) v = src[(size_t)k * ldsrc + n0 + (lane & 31)]; scr[kk * 33 + (lane & 31)] = v; }
    LDS_WAIT();
    const int c = lane & 7;
#pragma unroll
    for (int j = 0; j < 4; ++j) { const int n = (lane >> 3) + 8 * j; const LAS float* s = scr + (8 * c) * 33 + n;
        u32x4 o; o.x = pk2(s[0 * 33], s[1 * 33]); o.y = pk2(s[2 * 33], s[3 * 33]); o.z = pk2(s[4 * 33], s[5 * 33]); o.w = pk2(s[6 * 33], s[7 * 33]);
        *(u32x4*)(dst + (size_t)(drow0 + n) * lddst + dcol0 + k0 + 8 * c) = o; }
    LDS_WAIT();
}
DI void tr_plain(const float* src, int K, int N, bf16* dst, int r, LAS float* scr, int lane) {
    const int nblk = N / 32, kb = r / nblk, nb = r % nblk; tr_item(src, N, K, 64 * kb, 32 * nb, dst, K, 32 * nb, 0, scr, lane);
}
DI void tr_gateup(const float* src, int K, int Hh, bf16* dst, int r, LAS float* scr, int lane) {
    const int nblk = 2 * Hh / 32, kb = r / nblk, nb = r % nblk, n0 = 32 * nb, half = n0 / Hh, j0 = n0 % Hh;
    tr_item(src, 2 * Hh, K, 64 * kb, n0, dst, K, (j0 / 128) * 256 + half * 128 + (j0 % 128), 0, scr, lane);
}
DI void tr16_item(const float* src, int ldsrc, int k0, int n0, bf16* dst, int lddst, int Hh, int lane) {
    f32x4 v[16];
#pragma unroll
    for (int kk = 0; kk < 16; ++kk) v[kk] = *(const f32x4*)(src + (size_t)(k0 + kk) * ldsrc + n0 + 4 * lane);
    const int n = n0 + 4 * lane; int drow = n;
    if (Hh) { const int half = n / Hh, j = n % Hh; drow = (j / 128) * 256 + half * 128 + (j % 128); }
#pragma unroll
    for (int q = 0; q < 4; ++q) { u32x4 o0, o1;
        o0.x = pk2(v[0][q], v[1][q]); o0.y = pk2(v[2][q], v[3][q]); o0.z = pk2(v[4][q], v[5][q]); o0.w = pk2(v[6][q], v[7][q]);
        o1.x = pk2(v[8][q], v[9][q]); o1.y = pk2(v[10][q], v[11][q]); o1.z = pk2(v[12][q], v[13][q]); o1.w = pk2(v[14][q], v[15][q]);
        bf16* d = dst + (size_t)(drow + q) * lddst + k0; *(u32x4*)d = o0; *(u32x4*)(d + 8) = o1; }
}
DI void tr64_item(const float* src, int ldsrc, int k0, int n0, bf16* dst, int lddst, int Hh, int lane) {
    float v[64];
    const float* sp = src + (size_t)k0 * ldsrc + n0 + lane;
#pragma unroll
    for (int kk = 0; kk < 64; ++kk) v[kk] = sp[(size_t)kk * ldsrc];
    const int n = n0 + lane; int drow = n;
    if (Hh) { const int half = n / Hh, j = n % Hh; drow = (j / 128) * 256 + half * 128 + (j % 128); }
    bf16* d = dst + (size_t)drow * lddst + k0;
#pragma unroll
    for (int c = 0; c < 8; ++c) { u32x4 o; o.x = pk2(v[8 * c], v[8 * c + 1]); o.y = pk2(v[8 * c + 2], v[8 * c + 3]); o.z = pk2(v[8 * c + 4], v[8 * c + 5]); o.w = pk2(v[8 * c + 6], v[8 * c + 7]);
        *(u32x4*)(d + 8 * c) = o; }
}
DI void tr16_mat(const float* src, int K, int N, bf16* dst, int Hh, int r, int lane) { const int nb = N / 64; tr64_item(src, N, 64 * (r / nb), 64 * (r % nb), dst, K, Hh, lane); }
DI void p0_prologue(Fr& F) {
    LAS float* scr = (LAS float*)(F.lds + F.wave * 16384);
    const float* const* in = F.in;
    bf16* W_IN = (bf16*)(F.ws + WS_W_IN); bf16* W_OUT = (bf16*)(F.ws + WS_W_OUT); bf16* W_13 = (bf16*)(F.ws + WS_W_13); bf16* W_2 = (bf16*)(F.ws + WS_W_2);
    bf16* W_RKV = (bf16*)(F.ws + WS_W_RKV); bf16* W_L1 = (bf16*)(F.ws + WS_W_L1); bf16* W_L2 = (bf16*)(F.ws + WS_W_L2); bf16* W_G2 = (bf16*)(F.ws + WS_W_G2);
    bf16* W_O = (bf16*)(F.ws + WS_W_O); bf16* W_M13 = (bf16*)(F.ws + WS_W_M13); bf16* W_M2 = (bf16*)(F.ws + WS_W_M2);
    for (int prep_ = 0; prep_ < ((((PROBE_DUP) >> 21) & 1u) ? 2 : 1); ++prep_) {
        constexpr int B_M13 = 16 * 112, B_M2 = 56 * 16, B_IN = 16 * 56, B_OUT = 16 * 16, B_13 = 16 * 88, B_2 = 44 * 16, B_RKV = 256, B_O = 256;
        constexpr int NB_ITEMS = 8 * B_M13 + 8 * B_M2 + B_IN + B_OUT + B_13 + B_2 + 3 * B_RKV + B_O;
        for (int it = F.gw; it < NB_ITEMS; it += F.NGW) {
            int r = it;
            if (r < 8 * B_M13) { const int e = r / B_M13; tr16_mat(in[35] + (size_t)e * 1024 * 7168, 1024, 7168, W_M13 + (size_t)e * 7168 * 1024, EXP_H, r % B_M13, F.lane); continue; } r -= 8 * B_M13;
            if (r < 8 * B_M2) { const int e = r / B_M2; tr16_mat(in[36] + (size_t)e * EXP_H * 1024, EXP_H, 1024, W_M2 + (size_t)e * 1024 * EXP_H, 0, r % B_M2, F.lane); continue; } r -= 8 * B_M2;
            if (r < B_IN) { tr16_mat(in[8], 1024, INW, W_IN, 0, r, F.lane); continue; } r -= B_IN;
            if (r < B_OUT) { tr16_mat(in[15], 1024, 1024, W_OUT, 0, r, F.lane); continue; } r -= B_OUT;
            if (r < B_13) { tr16_mat(in[16], 1024, 2 * FFN_H, W_13, FFN_H, r, F.lane); continue; } r -= B_13;
            if (r < B_2) { tr16_mat(in[17], FFN_H, 1024, W_2, 0, r, F.lane); continue; } r -= B_2;
            if (r < 3 * B_RKV) { const int sx = r / B_RKV; tr16_mat(in[19] + (size_t)sx * 1024 * 1024, 1024, 1024, W_RKV + (size_t)sx * 1024 * 1024, 0, r % B_RKV, F.lane); continue; } r -= 3 * B_RKV;
            tr16_mat(in[33], 1024, 1024, W_O, 0, r, F.lane);
        }
    }
    constexpr int I_W1 = 2 * 32, I_A1 = 2 * 32, I_G1 = 16 * 5, I_L2 = 4 * 32, I_G2 = 4 * 32;
    constexpr int NITEMS = I_W1 + I_A1 + I_G1 + I_L2 + I_G2;
    for (int it = F.gw; it < NITEMS; it += F.NGW) {
        int r = it;
        if (r < I_W1) { const int z = r / 32, rr = r % 32; tr_item(in[21] + (size_t)z * 1024 * 64, 64, 1024, 64 * (rr / 2), 32 * (rr % 2), W_L1, 1024, z * 64 + 32 * (rr % 2), 0, scr, F.lane); continue; } r -= I_W1;
        if (r < I_A1) { const int z = r / 32, rr = r % 32; tr_item(in[24] + (size_t)z * 1024 * 64, 64, 1024, 64 * (rr / 2), 32 * (rr % 2), W_L1 + 256 * 1024, 1024, z * 64 + 32 * (rr % 2), 0, scr, F.lane); continue; } r -= I_A1;
        if (r < I_G1) { tr_item(in[26], 160, 1024, 64 * (r / 5), 32 * (r % 5), W_L1 + 2 * 256 * 1024, 1024, 32 * (r % 5), 0, scr, F.lane); continue; } r -= I_G1;
        if (r < I_L2) { const int q = r / 32, nb = r % 32; const float* src = (q < 2 ? in[22] : in[25]) + (size_t)(q & 1) * 64 * 1024;
            for (int i = F.lane; i < 32 * 24; i += 64) { const int row = i / 24, ch = i % 24; const int col = 8 * ch + (8 * ch >= q * 64 ? 64 : 0);
                *(u32x4*)(W_L2 + (size_t)(q * 1024 + 32 * nb + row) * 256 + col) = (u32x4){0u, 0u, 0u, 0u}; }
            tr_item(src, 1024, 64, 0, 32 * nb, W_L2, 256, q * 1024 + 32 * nb, q * 64, scr, F.lane); continue; } r -= I_L2;
        tr_item(in[27], 1024, 160, 64 * (r / 32), 32 * (r % 32), W_G2, 256, 32 * (r % 32), 0, scr, F.lane);
    }
    { const int gt = F.bx * NTHR + F.tid, NT = F.G * NTHR;
      for (int i = gt; i < (128 + 128 + 96) * 128; i += NT) { int row = i / 128; const int ch = i % 128; int mat = 0;
          if (row >= 256) { mat = 2; row = row - 256 + 160; } else if (row >= 128) { mat = 1; } else { row += 128; }
          *(u32x4*)(W_L1 + ((size_t)mat * 256 + row) * 1024 + 8 * ch) = (u32x4){0u, 0u, 0u, 0u}; }
      f32x2* rope = (f32x2*)(F.ws + WS_ROPE);
      for (int i = gt; i < 2048; i += NT) { const int pos = i >> 5, j = i & 31; const float fr = powf(10000.f, -(float)j / 32.f), ang = (float)pos * fr; rope[i] = (f32x2){cosf(ang), sinf(ang)}; }
    }
    WG_SYNC();
    for (int prep_ = 0; prep_ < ((((PROBE_DUP) >> 23) & 1u) ? 2 : 1); ++prep_)
    for (int u = F.bx; u < 192; u += F.G) {
        const int li = u / 96, n0 = (u % 96) * 64;
        LAS float* sm = (LAS float*)F.lds;
        for (int idx = F.tid; idx < 9 * 1024; idx += NTHR) { const int r = idx >> 10, k = idx & 1023; const float cv = (r < 8) ? in[1][r * 1024 + k] : in[3][k]; sm[idx] = cv / (1.f + expf(-cv)); }
        WG_SYNC();
        const int ks = F.tid >> 4, cg4 = F.tid & 15;
        f32x4 acc[9];
#pragma unroll
        for (int r = 0; r < 9; ++r) acc[r] = (f32x4){0.f, 0.f, 0.f, 0.f};
        const float* w = in[4] + (size_t)li * 1024 * 6144 + n0 + 4 * cg4;
#pragma unroll 8
        for (int k = ks * 32; k < ks * 32 + 32; ++k) { const f32x4 wv = *(const f32x4*)(w + (size_t)k * 6144);
#pragma unroll
            for (int r = 0; r < 9; ++r) acc[r] += wv * sm[r * 1024 + k]; }
        LAS float* red = sm + 9 * 1024;
#pragma unroll
        for (int r = 0; r < 9; ++r) *(LAS f32x4*)(red + (ks * 9 + r) * 64 + 4 * cg4) = acc[r];
        WG_SYNC();
        float* MOD = (float*)(F.ws + WS_MOD);
        for (int idx = F.tid; idx < 9 * 64; idx += NTHR) { const int r = idx / 64, n2 = idx % 64; float s = 0.f;
#pragma unroll
            for (int q = 0; q < 32; ++q) s += red[(q * 9 + r) * 64 + n2];
            MOD[((size_t)li * 9 + r) * 6144 + n0 + n2] = s + in[5][li * 6144 + n0 + n2]; }
        WG_SYNC();
    }
}

DI void mod_rows(Fr& F, const float* xl, const float* xc, int nrows, const float* normw, const float* modl, int off_shift, int off_scale, bf16* H) {
    for (int row = F.gw; row < nrows; row += F.NGW) {
        const float* src = row < ML ? xl + (size_t)row * D : xc + (size_t)(row - ML) * D;
        const float* mrow = modl + (size_t)(row < ML ? row / SEQ : 8) * 6144;
        f32x4 v[4]; float ss = 0.f;
#pragma unroll
        for (int j = 0; j < 4; ++j) { v[j] = ((const f32x4*)src)[F.lane + 64 * j]; ss += (v[j].x * v[j].x + v[j].y * v[j].y) + (v[j].z * v[j].z + v[j].w * v[j].w); }
        const float rstd = rsqrtf(wave_sum(ss) * (1.f / D) + 1e-6f);
        u32x2* o = (u32x2*)(H + (size_t)row * D);
#pragma unroll
        for (int j = 0; j < 4; ++j) { const int c4 = F.lane + 64 * j;
            const f32x4 w = ((const f32x4*)normw)[c4], sc = ((const f32x4*)(mrow + off_scale))[c4], sh = ((const f32x4*)(mrow + off_shift))[c4];
            const f32x4 y = v[j] * rstd * w * (sc + 1.f) + sh;
            u32x2 p; p.x = pk2(y.x, y.y); p.y = pk2(y.z, y.w); o[c4] = p; }
    }
}

DI void load_rope_pair(const bf16* rowp, int hh, int jj, bool lat, int rpos, int cpos, const f32x2* rope, float scl, float (&x1)[8], float (&x2)[8]) {
    const u32x4 a = *(const u32x4*)(rowp + hh * 64 + jj), b = *(const u32x4*)(rowp + hh * 64 + jj + 32);
    const unsigned aw[4] = {a.x, a.y, a.z, a.w}, bw[4] = {b.x, b.y, b.z, b.w};
#pragma unroll
    for (int i = 0; i < 4; ++i) { x1[2 * i] = bflo(aw[i]); x1[2 * i + 1] = bfhi(aw[i]); x2[2 * i] = bflo(bw[i]); x2[2 * i + 1] = bfhi(bw[i]); }
    if (lat) { const int pos = hh ? cpos : rpos;
#pragma unroll
        for (int i = 0; i < 8; ++i) { const f32x2 cs = rope[pos * 32 + jj + i]; const float y1 = x1[i] * cs.x - x2[i] * cs.y, y2 = x1[i] * cs.y + x2[i] * cs.x; x1[i] = y1; x2[i] = y2; } }
#pragma unroll
    for (int i = 0; i < 8; ++i) { x1[i] *= scl; x2[i] *= scl; }
}
DI u32x4 pack8(const float (&x)[8], float s) { u32x4 o; o.x = pk2(x[0] * s, x[1] * s); o.y = pk2(x[2] * s, x[3] * s); o.z = pk2(x[4] * s, x[5] * s); o.w = pk2(x[6] * s, x[7] * s); return o; }
constexpr int RLD = 136;
constexpr int RTILE = 128 * RLD * 2;
DI int ret_row0(int b, int id) { return id < 2 ? ML + b * CTXL + id * 128 : b * SEQ + (id - 2) * 128; }

DI void ret_kv_phase(Fr& F) {
    const bf16* QKV = (const bf16*)(F.ws + WS_QKV); float* KV = (float*)(F.ws + WS_KV); const f32x2* rope = (const f32x2*)(F.ws + WS_ROPE);
    LAS bf16* Vs = (LAS bf16*)F.lds; LAS bf16* Kf = (LAS bf16*)(F.lds + RTILE); LAS bf16* Kb = (LAS bf16*)(F.lds + 2 * RTILE);
    const int wr2 = F.wave >> 1, wc2 = F.wave & 1, fr = F.lane & 15, fq = F.lane >> 4;
    for (int u = F.bx; u < NB * 4 * NCH; u += F.G) {
        const int b = u / (4 * NCH), h = (u / NCH) % 4, id = u % NCH; const int grow0 = ret_row0(b, id); const bool lat = id >= 2;
        const float lgf = -expf(F.in[9][h]), lgb = -expf(F.in[10][h]);
        for (int it = F.tid; it < 128 * 16; it += NTHR) { const int c = it >> 4, ch = it & 15;
            *(LAS u32x4*)(Vs + c * RLD + 8 * ch) = *(const u32x4*)(QKV + (size_t)(grow0 + c) * INW + 1024 + h * 128 + 8 * ch); }
        for (int it = F.tid; it < 128 * 8; it += NTHR) { const int c = it >> 3, pi = it & 7, hh = pi >> 2, jj = (pi & 3) * 8; const int t = (id - 2) * 128 + c;
            float x1[8], x2[8]; load_rope_pair(QKV + (size_t)(grow0 + c) * INW + 512 + h * 128, hh, jj, lat, t >> 6, t & 63, rope, 0.08838834764831845f, x1, x2);
            const float wf = expf(lgf * (float)(127 - c)), wb = expf(lgb * (float)c);
            *(LAS u32x4*)(Kf + c * RLD + hh * 64 + jj) = pack8(x1, wf); *(LAS u32x4*)(Kf + c * RLD + hh * 64 + jj + 32) = pack8(x2, wf);
            *(LAS u32x4*)(Kb + c * RLD + hh * 64 + jj) = pack8(x1, wb); *(LAS u32x4*)(Kb + c * RLD + hh * 64 + jj + 32) = pack8(x2, wb); }
        WG_SYNC();
#pragma unroll
        for (int dir = 0; dir < 2; ++dir) {
            const LAS bf16* Kd = dir ? Kb : Kf;
            f32x4 acc[2][4];
#pragma unroll
            for (int i = 0; i < 2; ++i)
#pragma unroll
                for (int j = 0; j < 4; ++j) acc[i][j] = (f32x4){0.f, 0.f, 0.f, 0.f};
#pragma unroll 1
            for (int k0 = 0; k0 < 128; k0 += 32) { bf16x8 af[2], bfg[4];
#pragma unroll
                for (int i = 0; i < 2; ++i) af[i] = frag_kr(Vs, RLD, 32 * wr2 + 16 * i, k0, F.lane);
#pragma unroll
                for (int j = 0; j < 4; ++j) bfg[j] = frag_kr(Kd, RLD, 64 * wc2 + 16 * j, k0, F.lane);
#pragma unroll
                for (int i = 0; i < 2; ++i)
#pragma unroll
                    for (int j = 0; j < 4; ++j) acc[i][j] = mma(acc[i][j], bfg[j], af[i]); }
            float* o = KV + ((size_t)((b * 4 + h) * 2 + dir) * NCH + id) * 16384;
#pragma unroll
            for (int i = 0; i < 2; ++i)
#pragma unroll
                for (int j = 0; j < 4; ++j) *(f32x4*)(o + (32 * wr2 + 16 * i + fr) * 128 + 64 * wc2 + 16 * j + 4 * fq) = acc[i][j];
        }
        WG_SYNC();
    }
}
DI void ret_prefix_phase(Fr& F) {
    const float* KV = (const float*)(F.ws + WS_KV); bf16* SP = (bf16*)(F.ws + WS_SPREV);
    const int gt = F.bx * NTHR + F.tid, NT = F.G * NTHR;
    for (int i = gt; i < 64 * 4096; i += NT) { const int bhd = i >> 12, e4 = i & 4095, dir = bhd & 1, h = (bhd >> 1) & 3;
        const float lg = -expf(dir ? F.in[10][h] : F.in[9][h]), cd = expf(lg * 128.f);
        f32x4 s = (f32x4){0.f, 0.f, 0.f, 0.f};
        for (int st = 0; st < NCH; ++st) { const int id = dir ? (st == 0 ? 1 : (st == 1 ? 0 : 19 - st)) : st;
            const size_t off = ((size_t)bhd * NCH + id) * 16384 + 4 * e4;
            u32x2 p; p.x = pk2(s.x, s.y); p.y = pk2(s.z, s.w); *(u32x2*)(SP + off) = p;
            s = s * cd + *(const f32x4*)(KV + off); }
    }
}
DI void ret_out_phase(Fr& F) {
    const bf16* QKV = (const bf16*)(F.ws + WS_QKV); const bf16* SP = (const bf16*)(F.ws + WS_SPREV); bf16* MIX = (bf16*)(F.ws + WS_MIX); const f32x2* rope = (const f32x2*)(F.ws + WS_ROPE);
    LAS bf16* Qs = (LAS bf16*)F.lds; LAS bf16* KP = (LAS bf16*)(F.lds + RTILE); LAS bf16* Vs = (LAS bf16*)(F.lds + 2 * RTILE); LAS bf16* Sf = (LAS bf16*)(F.lds + 3 * RTILE);
    LAS float* red = (LAS float*)(F.lds + 4 * RTILE);
    const int wr2 = F.wave >> 1, wc2 = F.wave & 1, fr = F.lane & 15, fq = F.lane >> 4;
    for (int u = F.bx; u < NB * 4 * NCH; u += F.G) {
        const int b = u / (4 * NCH), h = (u / NCH) % 4, id = u % NCH; const int grow0 = ret_row0(b, id); const bool lat = id >= 2;
        const float lgf = -expf(F.in[9][h]), lgb = -expf(F.in[10][h]);
        const bf16* spf = SP + ((size_t)((b * 4 + h) * 2 + 0) * NCH + id) * 16384; const bf16* spb = SP + ((size_t)((b * 4 + h) * 2 + 1) * NCH + id) * 16384;
        for (int it = F.tid; it < 128 * 16; it += NTHR) { const int c = it >> 4, ch = it & 15;
            *(LAS u32x4*)(Vs + c * RLD + 8 * ch) = *(const u32x4*)(QKV + (size_t)(grow0 + c) * INW + 1024 + h * 128 + 8 * ch);
            *(LAS u32x4*)(Sf + c * RLD + 8 * ch) = *(const u32x4*)(spf + c * 128 + 8 * ch); }
        for (int it = F.tid; it < 128 * 8; it += NTHR) { const int c = it >> 3, pi = it & 7, hh = pi >> 2, jj = (pi & 3) * 8; const int t = (id - 2) * 128 + c;
            float x1[8], x2[8];
            load_rope_pair(QKV + (size_t)(grow0 + c) * INW + h * 128, hh, jj, lat, t >> 6, t & 63, rope, 1.f, x1, x2);
            *(LAS u32x4*)(Qs + c * RLD + hh * 64 + jj) = pack8(x1, 1.f); *(LAS u32x4*)(Qs + c * RLD + hh * 64 + jj + 32) = pack8(x2, 1.f);
            load_rope_pair(QKV + (size_t)(grow0 + c) * INW + 512 + h * 128, hh, jj, lat, t >> 6, t & 63, rope, 0.08838834764831845f, x1, x2);
            *(LAS u32x4*)(KP + c * RLD + hh * 64 + jj) = pack8(x1, 1.f); *(LAS u32x4*)(KP + c * RLD + hh * 64 + jj + 32) = pack8(x2, 1.f); }
        WG_SYNC();
        f32x4 sacc[2][4], facc[2][4];
#pragma unroll
        for (int i = 0; i < 2; ++i)
#pragma unroll
            for (int j = 0; j < 4; ++j) { sacc[i][j] = (f32x4){0.f, 0.f, 0.f, 0.f}; facc[i][j] = (f32x4){0.f, 0.f, 0.f, 0.f}; }
#pragma unroll 1
        for (int k0 = 0; k0 < 128; k0 += 32) { bf16x8 af[2], bk[4], bs[4];
#pragma unroll
            for (int i = 0; i < 2; ++i) af[i] = frag_kc(Qs, RLD, 32 * wr2 + 16 * i, k0, F.lane);
#pragma unroll
            for (int j = 0; j < 4; ++j) { bk[j] = frag_kc(KP, RLD, 64 * wc2 + 16 * j, k0, F.lane); bs[j] = frag_kc(Sf, RLD, 64 * wc2 + 16 * j, k0, F.lane); }
#pragma unroll
            for (int i = 0; i < 2; ++i)
#pragma unroll
                for (int j = 0; j < 4; ++j) { sacc[i][j] = mma(sacc[i][j], bk[j], af[i]); facc[i][j] = mma(facc[i][j], bs[j], af[i]); } }
        WG_SYNC();
        { const float lf2 = lgf * 1.4426950408889634f, lb2 = lgb * 1.4426950408889634f;
#pragma unroll
          for (int i = 0; i < 2; ++i)
#pragma unroll
            for (int j = 0; j < 4; ++j) { const int c = 32 * wr2 + 16 * i + fr, s0 = 64 * wc2 + 16 * j + 4 * fq; float pv[4];
#pragma unroll
                for (int r = 0; r < 4; ++r) { const int df = c - (s0 + r); const float wgt = df > 0 ? exp2f(lf2 * (float)df) : (df < 0 ? exp2f(lb2 * (float)(-df)) : 2.f); pv[r] = sacc[i][j][r] * wgt; }
                u32x2 p; p.x = pk2(pv[0], pv[1]); p.y = pk2(pv[2], pv[3]); *(LAS u32x2*)(KP + c * RLD + s0) = p; }
          for (int it = F.tid; it < 128 * 16; it += NTHR) { const int c = it >> 4, ch = it & 15; *(LAS u32x4*)(Sf + c * RLD + 8 * ch) = *(const u32x4*)(spb + c * 128 + 8 * ch); }
        }
        WG_SYNC();
        f32x4 oacc[2][4], bacc[2][4];
#pragma unroll
        for (int i = 0; i < 2; ++i) { const float qdf = expf(lgf * (float)(32 * wr2 + 16 * i + fr + 1));
#pragma unroll
            for (int j = 0; j < 4; ++j) { oacc[i][j] = facc[i][j] * qdf; bacc[i][j] = (f32x4){0.f, 0.f, 0.f, 0.f}; } }
#pragma unroll 1
        for (int k0 = 0; k0 < 128; k0 += 32) { bf16x8 ap[2], aq[2], bv[4], bs[4];
#pragma unroll
            for (int i = 0; i < 2; ++i) { ap[i] = frag_kc(KP, RLD, 32 * wr2 + 16 * i, k0, F.lane); aq[i] = frag_kc(Qs, RLD, 32 * wr2 + 16 * i, k0, F.lane); }
#pragma unroll
            for (int j = 0; j < 4; ++j) { bv[j] = frag_kr(Vs, RLD, 64 * wc2 + 16 * j, k0, F.lane); bs[j] = frag_kc(Sf, RLD, 64 * wc2 + 16 * j, k0, F.lane); }
#pragma unroll
            for (int i = 0; i < 2; ++i)
#pragma unroll
                for (int j = 0; j < 4; ++j) { oacc[i][j] = mma(oacc[i][j], bv[j], ap[i]); bacc[i][j] = mma(bacc[i][j], bs[j], aq[i]); } }
        float rs[2], rq[2];
#pragma unroll
        for (int i = 0; i < 2; ++i) { const int c = 32 * wr2 + 16 * i + fr; const float qdb = expf(lgb * (float)(128 - c)); float s = 0.f, q = 0.f;
#pragma unroll
            for (int j = 0; j < 4; ++j) { oacc[i][j] = oacc[i][j] + bacc[i][j] * qdb;
#pragma unroll
                for (int r = 0; r < 4; ++r) { s += oacc[i][j][r]; q += oacc[i][j][r] * oacc[i][j][r]; } }
            s += __shfl_xor(s, 16); s += __shfl_xor(s, 32); q += __shfl_xor(q, 16); q += __shfl_xor(q, 32);
            if (fq == 0) { red[(c * 2 + wc2) * 2 + 0] = s; red[(c * 2 + wc2) * 2 + 1] = q; }
            rs[i] = s; rq[i] = q; }
        WG_SYNC();
#pragma unroll
        for (int i = 0; i < 2; ++i) { const int c = 32 * wr2 + 16 * i + fr;
            const float s = red[(c * 2 + 0) * 2 + 0] + red[(c * 2 + 1) * 2 + 0], q = red[(c * 2 + 0) * 2 + 1] + red[(c * 2 + 1) * 2 + 1];
            const float mean = s * (1.f / 128.f), var = fmaxf(q * (1.f / 128.f) - mean * mean, 0.f), rstd = rsqrtf(var + 1e-5f);
            const size_t grow = (size_t)(grow0 + c);
#pragma unroll
            for (int j = 0; j < 4; ++j) { const int e0 = 64 * wc2 + 16 * j + 4 * fq;
                const f32x4 gw = *(const f32x4*)(F.in[11] + h * 128 + e0); const u32x2 gg = *(const u32x2*)(QKV + grow * INW + 1536 + h * 128 + e0);
                const float g0 = bflo(gg.x), g1 = bfhi(gg.x), g2 = bflo(gg.y), g3 = bfhi(gg.y);
                const f32x4 y = (oacc[i][j] - mean) * rstd * gw;
                u32x2 p; p.x = pk2(y.x * siluf_(g0), y.y * siluf_(g1)); p.y = pk2(y.z * siluf_(g2), y.w * siluf_(g3));
                *(u32x2*)(MIX + grow * D + h * 128 + e0) = p; } }
        (void)rs; (void)rq;
        WG_SYNC();
    }
}

DI void na_norm_rows(Fr& F) {
    bf16* QKV = (bf16*)(F.ws + WS_QKV);
    const bool isk = F.lane >= 32; const float* wsrc = (isk ? F.in[13] : F.in[12]) + (F.lane & 3) * 16; const float scl = isk ? 1.f : 0.125f;
    float wv[16];
#pragma unroll
    for (int i = 0; i < 16; ++i) wv[i] = wsrc[i] * scl;
    for (int row = F.gw; row < MA; row += F.NGW) {
        bf16* p = QKV + (size_t)row * INW + 2048 + 16 * F.lane;
        const u32x4 a = *(const u32x4*)p, b2 = *(const u32x4*)(p + 8); const unsigned w[8] = {a.x, a.y, a.z, a.w, b2.x, b2.y, b2.z, b2.w}; float x[16]; float ss = 0.f;
#pragma unroll
        for (int i = 0; i < 8; ++i) { x[2 * i] = bflo(w[i]); x[2 * i + 1] = bfhi(w[i]); ss += x[2 * i] * x[2 * i] + x[2 * i + 1] * x[2 * i + 1]; }
        const float rinv = rsqrtf(red4(ss) * (1.f / 64.f) + 1e-6f);
        u32x4 o0, o1;
        o0.x = pk2(x[0] * rinv * wv[0], x[1] * rinv * wv[1]); o0.y = pk2(x[2] * rinv * wv[2], x[3] * rinv * wv[3]); o0.z = pk2(x[4] * rinv * wv[4], x[5] * rinv * wv[5]); o0.w = pk2(x[6] * rinv * wv[6], x[7] * rinv * wv[7]);
        o1.x = pk2(x[8] * rinv * wv[8], x[9] * rinv * wv[9]); o1.y = pk2(x[10] * rinv * wv[10], x[11] * rinv * wv[11]); o1.z = pk2(x[12] * rinv * wv[12], x[13] * rinv * wv[13]); o1.w = pk2(x[14] * rinv * wv[14], x[15] * rinv * wv[15]);
        *(u32x4*)p = o0; *(u32x4*)(p + 8) = o1;
    }
}
constexpr int NLD = 72;
DI void na_phase(Fr& F) {
    const bf16* QKV = (const bf16*)(F.ws + WS_QKV); bf16* MIX = (bf16*)(F.ws + WS_MIX);
    LAS bf16* Ks = (LAS bf16*)F.lds;
    LAS bf16* Vs = (LAS bf16*)(F.lds + 36864);
    LAS bf16* Pw = (LAS bf16*)(F.lds + 2 * 36864) + F.wave * (32 * NLD);
    LAS float* rpbs = (LAS float*)(F.lds + 2 * 36864 + 8 * 4608);
    const int fr = F.lane & 15, fq = F.lane >> 4;
    float bound;
    { float mqw = fabsf(F.in[12][F.lane]), mkw = fabsf(F.in[13][F.lane]), mb = 0.f;
      for (int i = F.lane; i < 8 * 15 * 31; i += 64) mb = fmaxf(mb, fabsf(F.in[14][i]));
      bound = 8.f * wave_max(mqw) * wave_max(mkw) + wave_max(mb); }
    for (int u = F.bx; u < 512 + 64; u += F.G) {
        int b, head, r = -1, cb = 0, qtok0, kb_lo = 0, nwin = 0;
        if (u < 512) { b = u >> 6; head = (u >> 3) & 7; const int qb = u & 7; r = 4 * qb + (F.wave >> 1); cb = 32 * (F.wave & 1); qtok0 = b * SEQ + r * 64 + cb;
            const int r0lo = min(max(4 * qb - 4, 0), 24), r0hi = min(max(4 * qb - 1, 0), 24); kb_lo = r0lo >> 2; nwin = ((r0hi + 7) >> 2) - kb_lo + 1; }
        else { const int cu = u - 512; b = cu >> 3; head = cu & 7; qtok0 = ML + b * CTXL + 32 * F.wave; }
        const int r0 = min(max(r - 4, 0), 24);
        bf16x8 aq[2][2];
#pragma unroll
        for (int mt = 0; mt < 2; ++mt)
#pragma unroll
            for (int ks = 0; ks < 2; ++ks) aq[mt][ks] = *(const bf16x8*)(QKV + (size_t)(qtok0 + 16 * mt + fr) * INW + 2048 + head * 64 + 32 * ks + 8 * fq);
        if (u < 512) for (int i = F.tid; i < 15 * 32; i += NTHR) { const int ro = i >> 5, co = i & 31; rpbs[i] = co < 31 ? F.in[14][head * 465 + ro * 31 + co] - bound : -1.0e30f; }
        int boff[2][4][4]; int nlo[2], nhi[2];
#pragma unroll
        for (int mt = 0; mt < 2; ++mt) { const int cs = cb + 16 * mt, c = cs + fr, c0 = min(max(c - 8, 0), 48);
            nlo[mt] = max(cs - 8, 0) >> 4; nhi[mt] = (min(cs + 7, 48) + 15) >> 4;
#pragma unroll
            for (int nt = 0; nt < 4; ++nt)
#pragma unroll
                for (int i = 0; i < 4; ++i) { const int kc = 16 * nt + 4 * fq + i; boff[mt][nt][i] = ((kc >= c0) && (kc < c0 + 16)) ? (kc - c + 15) : 31; } }
        f32x4 oacc[2][4]; float lsum[2] = {0.f, 0.f};
#pragma unroll
        for (int mt = 0; mt < 2; ++mt)
#pragma unroll
            for (int j = 0; j < 4; ++j) oacc[mt][j] = (f32x4){0.f, 0.f, 0.f, 0.f};
        u32x4 kst[4], vst[4];
#define NA_LOAD(bi_) do { _Pragma("unroll") for (int it_ = 0; it_ < 4; ++it_) { const int krow_ = (F.tid >> 3) + 64 * it_, c8_ = F.tid & 7; \
            const int grow_ = (bi_) < nwin ? b * SEQ + (4 * (kb_lo + (bi_)) + (krow_ >> 6)) * 64 + (krow_ & 63) : ML + b * CTXL + krow_; \
            kst[it_] = *(const u32x4*)(QKV + (size_t)grow_ * INW + 2560 + head * 64 + 8 * c8_); vst[it_] = *(const u32x4*)(QKV + (size_t)grow_ * INW + 3072 + head * 64 + 8 * c8_); } } while (0)
        NA_LOAD(0);
        for (int bi = 0; bi <= nwin; ++bi) {
            const bool is_ctx = bi == nwin;
#pragma unroll
            for (int it = 0; it < 4; ++it) { const int krow = (F.tid >> 3) + 64 * it, c8 = F.tid & 7;
                *(LAS u32x4*)(Ks + krow * NLD + 8 * c8) = kst[it]; *(LAS u32x4*)(Vs + krow * NLD + 8 * c8) = vst[it]; }
            LDS_BARRIER();
            if (bi < nwin) NA_LOAD(bi + 1);
#pragma unroll 1
            for (int krl = 0; krl < 4; ++krl) {
                const int kr = 4 * (kb_lo + bi) + krl;
                if (!is_ctx && (kr < r0 || kr > r0 + 7)) continue;
                f32x4 sacc[2][4];
#pragma unroll
                for (int mt = 0; mt < 2; ++mt)
#pragma unroll
                    for (int nt = 0; nt < 4; ++nt) sacc[mt][nt] = (f32x4){0.f, 0.f, 0.f, 0.f};
                const int n0w = is_ctx ? 0 : nlo[0], n1w = is_ctx ? 3 : nhi[1];
#pragma unroll
                for (int nt = 0; nt < 4; ++nt) { if (nt < n0w || nt > n1w) continue;
                    const bool u0 = is_ctx || (nt >= nlo[0] && nt <= nhi[0]), u1 = is_ctx || (nt >= nlo[1] && nt <= nhi[1]);
#pragma unroll
                    for (int ks = 0; ks < 2; ++ks) { const bf16x8 bk = frag_kc(Ks, NLD, 64 * krl + 16 * nt, 32 * ks, F.lane);
                        if (u0) sacc[0][nt] = mma(sacc[0][nt], bk, aq[0][ks]); if (u1) sacc[1][nt] = mma(sacc[1][nt], bk, aq[1][ks]); } }
                const int rowb = is_ctx ? 0 : (kr - r + 7) * 32;
#pragma unroll
                for (int mt = 0; mt < 2; ++mt) {
#pragma unroll
                    for (int nt = 0; nt < 4; ++nt) { float pv[4] = {0.f, 0.f, 0.f, 0.f};
                        if (is_ctx) {
#pragma unroll
                            for (int i = 0; i < 4; ++i) { pv[i] = __expf(sacc[mt][nt][i] - bound); lsum[mt] += pv[i]; } }
                        else if (nt >= nlo[mt] && nt <= nhi[mt]) {
#pragma unroll
                            for (int i = 0; i < 4; ++i) { pv[i] = __expf(sacc[mt][nt][i] + rpbs[rowb + boff[mt][nt][i]]); lsum[mt] += pv[i]; } }
                        u32x2 pk; pk.x = pk2(pv[0], pv[1]); pk.y = pk2(pv[2], pv[3]); *(LAS u32x2*)(Pw + (16 * mt + fr) * NLD + 16 * nt + 4 * fq) = pk; } }
                LDS_WAIT();
#pragma unroll
                for (int ks2 = 0; ks2 < 2; ++ks2) {
                    const bool v0 = is_ctx || (2 * ks2 + 1 >= nlo[0] && 2 * ks2 <= nhi[0]), v1 = is_ctx || (2 * ks2 + 1 >= nlo[1] && 2 * ks2 <= nhi[1]);
                    if (!(v0 || v1)) continue;
                    const bf16x8 ap0 = frag_kc(Pw, NLD, 0, 32 * ks2, F.lane), ap1 = frag_kc(Pw, NLD, 16, 32 * ks2, F.lane);
#pragma unroll
                    for (int et = 0; et < 4; ++et) { const bf16x8 bv = frag_kr(Vs, NLD, 16 * et, 64 * krl + 32 * ks2, F.lane);
                        if (v0) oacc[0][et] = mma(oacc[0][et], bv, ap0); if (v1) oacc[1][et] = mma(oacc[1][et], bv, ap1); } }
            }
            LDS_BARRIER();
        }
#undef NA_LOAD
#pragma unroll
        for (int mt = 0; mt < 2; ++mt) { float l = lsum[mt]; l += __shfl_xor(l, 16); l += __shfl_xor(l, 32); const float inv = 1.f / l;
#pragma unroll
            for (int et = 0; et < 4; ++et) { const f32x4 o = oacc[mt][et] * inv; u32x2 p; p.x = pk2(o.x, o.y); p.y = pk2(o.z, o.w);
                *(u32x2*)(MIX + (size_t)(qtok0 + 16 * mt + fr) * D + 512 + head * 64 + 16 * et + 4 * fq) = p; } }
    }
}

DI void xm_phase(Fr& F, const float* xl, const float* xc, const float* normw, const float* modl) {
    bf16* XM = (bf16*)(F.ws + WS_XM); const float* mu = F.in[18];
    for (int row = F.gw; row < MA; row += F.NGW) {
        const bool lat = row < ML; const int rr = lat ? row : row - ML; const int L = lat ? SEQ : CTXL; const int t = rr % L;
        const float* src = (lat ? xl : xc) + (size_t)rr * D;
        const float* mrow = modl + (size_t)(lat ? row / SEQ : 8) * 6144;
        const bool hp = t > 0, hn = t < L - 1;
        f32x4 vc[4], vp[4], vn[4]; float sc_ = 0.f, sp_ = 0.f, sn_ = 0.f;
#pragma unroll
        for (int j = 0; j < 4; ++j) { vc[j] = ((const f32x4*)src)[F.lane + 64 * j];
            vp[j] = hp ? ((const f32x4*)(src - D))[F.lane + 64 * j] : (f32x4){0.f, 0.f, 0.f, 0.f}; vn[j] = hn ? ((const f32x4*)(src + D))[F.lane + 64 * j] : (f32x4){0.f, 0.f, 0.f, 0.f};
            sc_ += (vc[j].x * vc[j].x + vc[j].y * vc[j].y) + (vc[j].z * vc[j].z + vc[j].w * vc[j].w);
            sp_ += (vp[j].x * vp[j].x + vp[j].y * vp[j].y) + (vp[j].z * vp[j].z + vp[j].w * vp[j].w);
            sn_ += (vn[j].x * vn[j].x + vn[j].y * vn[j].y) + (vn[j].z * vn[j].z + vn[j].w * vn[j].w); }
        const float rc = rsqrtf(wave_sum(sc_) * (1.f / D) + 1e-6f), rp = rsqrtf(wave_sum(sp_) * (1.f / D) + 1e-6f), rn = rsqrtf(wave_sum(sn_) * (1.f / D) + 1e-6f);
#pragma unroll
        for (int j = 0; j < 4; ++j) { const int c4 = F.lane + 64 * j;
            const f32x4 w = ((const f32x4*)normw)[c4], sc = ((const f32x4*)(mrow + 1024))[c4], sh = ((const f32x4*)mrow)[c4];
            const f32x4 g = w * (sc + 1.f);
            const f32x4 hc = vc[j] * rc * g + sh;
            const f32x4 hpv = hp ? vp[j] * rp * g + sh : (f32x4){0.f, 0.f, 0.f, 0.f};
            const f32x4 hnv = hn ? vn[j] * rn * g + sh : (f32x4){0.f, 0.f, 0.f, 0.f};
            const f32x4 xx = (hpv + hnv) * 0.5f - hc;
#pragma unroll
            for (int s = 0; s < 6; ++s) { const f32x4 m = ((const f32x4*)(mu + s * 1024))[c4]; const f32x4 y = hc + xx * m;
                u32x2 p; p.x = pk2(y.x, y.y); p.y = pk2(y.z, y.w); ((u32x2*)(XM + ((size_t)s * MA + row) * D))[c4] = p; } }
    }
}

DI f32x4 mma16(f32x4 acc, s16x4 bfrag, s16x4 afrag) { return __builtin_amdgcn_mfma_f32_16x16x16bf16_1k(bfrag, afrag, acc, 0, 0, 0); }
DI s16x4 frag16_kc(const LAS bf16* base, int ld, int row0, int k0, int lane) { return *(const LAS s16x4*)(base + (row0 + (lane & 15)) * ld + k0 + 4 * (lane >> 4)); }
DI s16x4 frag16_kr(const LAS bf16* base, int ld, int x0, int k0, int lane) { const int g = lane >> 4, q = (lane & 15) >> 2, p = lane & 3;
    return __builtin_amdgcn_ds_read_tr16_b64_v4i16((LAS s16x4*)(base + (k0 + 4 * g + q) * ld + x0 + 4 * p)); }
DI s16x4 cvt4(f32x4 v) { u32x2 p; p.x = pk2(v.x, v.y); p.y = pk2(v.z, v.w); return __builtin_bit_cast(s16x4, p); }
constexpr int WLD = 72;
DI void rwkv_scan2_phase(Fr& F) {
    const bf16* KB = (const bf16*)(F.ws + WS_KB); const bf16* VB = (const bf16*)(F.ws + WS_VB); const bf16* RB = (const bf16*)(F.ws + WS_RB);
    const float* LW = (const float*)(F.ws + WS_DEC); const bf16* AG = (const bf16*)(F.ws + WS_AG);
    LAS bf16* AT = (LAS bf16*)F.lds; LAS bf16* BT = AT + 64 * WLD; LAS bf16* KT = BT + 64 * WLD; LAS bf16* RT = KT + 64 * WLD; LAS bf16* BH = RT + 64 * WLD; LAS bf16* KH = BH + 64 * WLD;
    LAS bf16* VN = KH + 64 * WLD; LAS bf16* W1s = VN + 64 * WLD;
    LAS bf16* PRB = W1s + 64 * WLD; LAS bf16* PRK = PRB + 1024;
    LAS f32x4* UVT = (LAS f32x4*)(PRK + 1024);
    LAS float* GC = (LAS float*)(UVT + 1024);
    LAS float* CSs = GC + 256;
    LAS float* YS = CSs + 4096;
    const int cq = F.wave >> 1, half = F.wave & 1, fr = F.lane & 15, fq = F.lane >> 4;
    for (int u = F.bx; u < 256; u += F.G) {
        const int z = u & 1, h = (u >> 1) & 15, b = u >> 5;
        bf16* Y = (bf16*)(F.ws + (z ? WS_YB : WS_YF));
        const int sx = F.lane >> 3, cg = F.lane & 7;
        float kkw[8], kaw[8];
#pragma unroll
        for (int i = 0; i < 8; ++i) { kkw[i] = F.in[28][h * 64 + 8 * cg + i]; kaw[i] = F.in[29][h * 64 + 8 * cg + i]; }
        const size_t bh = (size_t)(b * 16 + h);
        const bf16* kbh = KB + bh * (SEQ + CTXL) * 64 + 8 * cg; const bf16* vbh = VB + bh * (SEQ + CTXL) * 64 + 8 * cg; const bf16* rbh = RB + bh * SEQ * 64 + 8 * cg;
        const bf16* agh = AG + ((size_t)z * 128 + bh) * (SEQ + CTXL) * 64 + 8 * cg; const float* lwh = LW + ((size_t)z * 128 + bh) * (SEQ + CTXL) * 64 + 8 * cg;
        f32x4 S[4];
#pragma unroll
        for (int j = 0; j < 4; ++j) S[j] = (f32x4){0.f, 0.f, 0.f, 0.f};
        u32x4 kreg, vreg, rreg, areg; f32x4 lw0, lw1;
        const int stl = 16 * cq + 8 * half + sx;
#define RW_LOAD(sc) do { const int g_ = (sc) * 64 + stl; const bool lat_ = g_ >= CTXL; const int row_ = z ? (lat_ ? (2 * CTXL + SEQ - 1 - g_) : (CTXL - 1 - g_)) : g_; \
            kreg = *(const u32x4*)(kbh + (size_t)row_ * 64); vreg = *(const u32x4*)(vbh + (size_t)row_ * 64); areg = *(const u32x4*)(agh + (size_t)row_ * 64); \
            rreg = lat_ ? *(const u32x4*)(rbh + (size_t)(row_ - CTXL) * 64) : (u32x4){0u, 0u, 0u, 0u}; \
            lw0 = *(const f32x4*)(lwh + (size_t)row_ * 64); lw1 = *(const f32x4*)(lwh + (size_t)row_ * 64 + 4); } while (0)
        RW_LOAD(0);
        for (int sc = 0; sc < (SEQ + CTXL) / 64; ++sc) {
            const bool lat = sc * 64 >= CTXL;
            *(LAS f32x4*)(CSs + stl * 64 + 8 * cg) = lw0; *(LAS f32x4*)(CSs + stl * 64 + 8 * cg + 4) = lw1;
            LDS_BARRIER();
            if (F.tid < 256) { const int q = F.tid >> 6, c = F.tid & 63; float v[16];
#pragma unroll
                for (int t = 0; t < 16; ++t) v[t] = CSs[(16 * q + t) * 64 + c];
                float acc = 0.f;
#pragma unroll
                for (int t = 0; t < 16; ++t) { acc += v[t]; CSs[(16 * q + t) * 64 + c] = acc; } }
            LDS_BARRIER();
            { const int tau = 8 * half + sx;
              const f32x4 c0 = *(const LAS f32x4*)(CSs + stl * 64 + 8 * cg), c1 = *(const LAS f32x4*)(CSs + stl * 64 + 8 * cg + 4);
              f32x4 p0 = (f32x4){0.f, 0.f, 0.f, 0.f}, p1 = p0;
              if (tau > 0) { p0 = *(const LAS f32x4*)(CSs + (stl - 1) * 64 + 8 * cg); p1 = *(const LAS f32x4*)(CSs + (stl - 1) * 64 + 8 * cg + 4); }
              const f32x4 t0 = *(const LAS f32x4*)(CSs + (16 * cq + 15) * 64 + 8 * cg), t1 = *(const LAS f32x4*)(CSs + (16 * cq + 15) * 64 + 8 * cg + 4);
              const float cs[8] = {c0.x, c0.y, c0.z, c0.w, c1.x, c1.y, c1.z, c1.w}, cp[8] = {p0.x, p0.y, p0.z, p0.w, p1.x, p1.y, p1.z, p1.w}, ct[8] = {t0.x, t0.y, t0.z, t0.w, t1.x, t1.y, t1.z, t1.w};
              const unsigned kw[4] = {kreg.x, kreg.y, kreg.z, kreg.w}, aw[4] = {areg.x, areg.y, areg.z, areg.w}, rw[4] = {rreg.x, rreg.y, rreg.z, rreg.w};
              float kr[8], ag[8], rr[8], kk[8]; float ss = 0.f;
#pragma unroll
              for (int i = 0; i < 4; ++i) { kr[2 * i] = bflo(kw[i]); kr[2 * i + 1] = bfhi(kw[i]); ag[2 * i] = bflo(aw[i]); ag[2 * i + 1] = bfhi(aw[i]); rr[2 * i] = bflo(rw[i]); rr[2 * i + 1] = bfhi(rw[i]); }
#pragma unroll
              for (int i = 0; i < 8; ++i) { kk[i] = kr[i] * kkw[i]; ss += kk[i] * kk[i]; }
              const float rn = __builtin_amdgcn_rsqf(fmaxf(red8(ss), 1e-24f));
              float oa[8], ob[8], ok[8], orr[8], obh[8], okh[8], eCv[8];
#pragma unroll
              for (int i = 0; i < 8; ++i) { const float e1 = __expf(cs[i]), ep = __expf(cp[i]), eC = __expf(ct[i]), inv = __builtin_amdgcn_rcpf(e1);
                  const float kki = kk[i] * rn, b_ = kki * ag[i], kd_ = kr[i] * (1.f + (ag[i] - 1.f) * kaw[i]);
                  oa[i] = -kki * ep; ob[i] = b_ * inv; ok[i] = kd_ * inv; orr[i] = rr[i] * e1; obh[i] = b_ * eC * inv; okh[i] = kd_ * eC * inv; eCv[i] = eC; }
              const int o = stl * WLD + 8 * cg;
              *(LAS u32x4*)(AT + o) = pack8(oa, 1.f); *(LAS u32x4*)(BT + o) = pack8(ob, 1.f); *(LAS u32x4*)(KT + o) = pack8(ok, 1.f); *(LAS u32x4*)(RT + o) = pack8(orr, 1.f);
              *(LAS u32x4*)(BH + o) = pack8(obh, 1.f); *(LAS u32x4*)(KH + o) = pack8(okh, 1.f); *(LAS u32x4*)(VN + o) = vreg;
              if (tau == 0) { *(LAS f32x4*)(GC + cq * 64 + 8 * cg) = (f32x4){eCv[0], eCv[1], eCv[2], eCv[3]}; *(LAS f32x4*)(GC + cq * 64 + 8 * cg + 4) = (f32x4){eCv[4], eCv[5], eCv[6], eCv[7]}; } }
            LDS_BARRIER();
            if (sc + 1 < (SEQ + CTXL) / 64) RW_LOAD(sc + 1);
            for (int pa2_ = 0; pa2_ < ((((PROBE_DUP) >> 25) & 1u) ? 2 : 1); ++pa2_)
            if (half) { f32x4 pb = (f32x4){0.f, 0.f, 0.f, 0.f}, pk = (f32x4){0.f, 0.f, 0.f, 0.f};
#pragma unroll
                for (int k0 = 0; k0 < 64; k0 += 32) { const bf16x8 af = frag_kc(RT, WLD, 16 * cq, k0, F.lane);
                    pb = mma(pb, frag_kc(BT, WLD, 16 * cq, k0, F.lane), af); pk = mma(pk, frag_kc(KT, WLD, 16 * cq, k0, F.lane), af); }
#pragma unroll
                for (int r = 0; r < 4; ++r) if (4 * fq + r > fr) { pb[r] = 0.f; pk[r] = 0.f; }
                const int o = cq * 256 + fr * 16 + 4 * fq;
                *(LAS s16x4*)(PRB + o) = cvt4(pb); *(LAS s16x4*)(PRK + o) = cvt4(pk); }
            else { f32x4 xa = (f32x4){0.f, 0.f, 0.f, 0.f}, xt = (f32x4){0.f, 0.f, 0.f, 0.f}, ak = (f32x4){0.f, 0.f, 0.f, 0.f};
#pragma unroll
                for (int k0 = 0; k0 < 64; k0 += 32) { const bf16x8 af = frag_kc(AT, WLD, 16 * cq, k0, F.lane), bfm = frag_kc(BT, WLD, 16 * cq, k0, F.lane);
                    xa = mma(xa, bfm, af);
                    xt = mma(xt, af, bfm);
                    ak = mma(ak, frag_kc(KT, WLD, 16 * cq, k0, F.lane), af); }
#pragma unroll
                for (int r = 0; r < 4; ++r) { if (4 * fq + r >= fr) { xa[r] = 0.f; ak[r] = 0.f; } if (4 * fq + r <= fr) xt[r] = 0.f; }
                f32x4 P = xa;
#pragma unroll
                for (int r = 0; r < 4; ++r) if (4 * fq + r == fr) P[r] += 1.f;
#pragma unroll
                for (int lvl = 0; lvl < 3; ++lvl) { const s16x4 xf = cvt4(xa), xtf = cvt4(xt);
                    const f32x4 x2 = mma16((f32x4){0.f, 0.f, 0.f, 0.f}, xtf, xf);
                    const f32x4 x2t = mma16((f32x4){0.f, 0.f, 0.f, 0.f}, xf, xtf);
                    xa = x2; xt = x2t;
                    P = mma16(P, cvt4(xt), cvt4(P)); }
                const s16x4 tf = cvt4(P), akf = cvt4(ak);
#pragma unroll
                for (int jt = 0; jt < 4; ++jt) { const f32x4 acc = mma16((f32x4){0.f, 0.f, 0.f, 0.f}, frag16_kr(AT, WLD, 16 * jt, 16 * cq, F.lane), tf);
                    *(LAS s16x4*)(W1s + (16 * cq + fr) * WLD + 16 * jt + 4 * fq) = cvt4(acc); }
#pragma unroll
                for (int it = 0; it < 4; ++it) { const f32x4 xvt = mma16((f32x4){0.f, 0.f, 0.f, 0.f}, akf, frag16_kr(VN, WLD, 16 * it, 16 * cq, F.lane));
                    UVT[(cq * 4 + it) * 64 + F.lane] = mma16((f32x4){0.f, 0.f, 0.f, 0.f}, tf, cvt4(xvt)); } }
            LDS_BARRIER();
            if (F.wave < 4) { const int it = F.wave;
#pragma unroll
                for (int c = 0; c < 4; ++c) {
                    s16x4 w1f[4], rtf[4], bhf[4], khf[4]; f32x4 g4[4];
#pragma unroll
                    for (int jt = 0; jt < 4; ++jt) { w1f[jt] = frag16_kc(W1s, WLD, 16 * c, 16 * jt, F.lane); rtf[jt] = frag16_kc(RT, WLD, 16 * c, 16 * jt, F.lane);
                        bhf[jt] = frag16_kr(BH, WLD, 16 * jt, 16 * c, F.lane); khf[jt] = frag16_kr(KH, WLD, 16 * jt, 16 * c, F.lane); g4[jt] = *(const LAS f32x4*)(GC + c * 64 + 16 * jt + 4 * fq); }
                    const s16x4 vfr = frag16_kr(VN, WLD, 16 * it, 16 * c, F.lane), pbf = frag16_kc(PRB + c * 256, 16, 0, 0, F.lane), pkf = frag16_kc(PRK + c * 256, 16, 0, 0, F.lane);
                    const f32x4 uv0 = UVT[(c * 4 + it) * 64 + F.lane];
                    s16x4 sfr[4];
#pragma unroll
                    for (int jt = 0; jt < 4; ++jt) sfr[jt] = cvt4(S[jt]);
#define CAT8(a_, b_) __builtin_shufflevector((a_), (b_), 0, 1, 2, 3, 4, 5, 6, 7)
                    const bf16x8 s01 = CAT8(sfr[0], sfr[1]), s23 = CAT8(sfr[2], sfr[3]);
                    f32x4 Ua = mma(uv0, CAT8(w1f[0], w1f[1]), s01); Ua = mma(Ua, CAT8(w1f[2], w1f[3]), s23);
                    const s16x4 ufr = cvt4(Ua); const bf16x8 uv8 = CAT8(ufr, vfr);
#pragma unroll
                    for (int jt = 0; jt < 4; ++jt) S[jt] = mma(S[jt] * g4[jt], CAT8(bhf[jt], khf[jt]), uv8);
                    if (lat) { f32x4 Ya = mma((f32x4){0.f, 0.f, 0.f, 0.f}, CAT8(rtf[0], rtf[1]), s01); Ya = mma(Ya, CAT8(rtf[2], rtf[3]), s23);
                        const f32x4 Yb = mma((f32x4){0.f, 0.f, 0.f, 0.f}, CAT8(pbf, pkf), uv8);
                        const f32x4 Yt = Ya + Yb;
#pragma unroll
                        for (int r = 0; r < 4; ++r) YS[(16 * c + 4 * fq + r) * 68 + 16 * it + fr] = Yt[r]; }
                } }
            LDS_BARRIER();
            if (lat) {
                const int g = sc * 64 + (F.tid >> 3); const int tl = z ? (SEQ + CTXL - 1 - g) : (g - CTXL);
                const f32x4 y0 = *(const LAS f32x4*)(YS + (F.tid >> 3) * 68 + 8 * (F.tid & 7)), y1 = *(const LAS f32x4*)(YS + (F.tid >> 3) * 68 + 8 * (F.tid & 7) + 4);
                u32x4 o; o.x = pk2(y0.x, y0.y); o.y = pk2(y0.z, y0.w); o.z = pk2(y1.x, y1.y); o.w = pk2(y1.z, y1.w);
                *(u32x4*)(Y + (size_t)(b * SEQ + tl) * D + h * 64 + 8 * (F.tid & 7)) = o; }
            LDS_BARRIER();
        }
#undef RW_LOAD
    }
}

DI void rwkv_readout_phase(Fr& F) {
    const bf16* KB = (const bf16*)(F.ws + WS_KB); const bf16* VB = (const bf16*)(F.ws + WS_VB); const bf16* RB = (const bf16*)(F.ws + WS_RB);
    const bf16* AG = (const bf16*)(F.ws + WS_AG); const bf16* G = (const bf16*)(F.ws + WS_G);
    const bf16* YF = (const bf16*)(F.ws + WS_YF); const bf16* YB = (const bf16*)(F.ws + WS_YB); bf16* Z = (bf16*)(F.ws + WS_H);
    const int c0 = 16 * F.lane;
    for (int row = F.gw; row < ML; row += F.NGW) {
        const size_t off = (size_t)row * D + c0;
        const int b = row / SEQ, t = row % SEQ, hh = F.lane >> 2, j0 = (F.lane & 3) * 16;
        const size_t hoff = ((size_t)(b * 16 + hh) * (SEQ + CTXL) + CTXL + t) * 64 + j0, roff = ((size_t)(b * 16 + hh) * SEQ + t) * 64 + j0;
        float y[16], kv[16], vv[16], rv[16], gv[16], a0v[16], a1v[16];
#pragma unroll
        for (int q = 0; q < 16; ++q) y[q] = 0.f;
#define RD16(dst, ptr) do { const u32x4 t0_ = *(const u32x4*)(ptr), t1_ = *(const u32x4*)((ptr) + 8); const unsigned tw_[8] = {t0_.x, t0_.y, t0_.z, t0_.w, t1_.x, t1_.y, t1_.z, t1_.w}; \
        _Pragma("unroll") for (int q_ = 0; q_ < 8; ++q_) { dst[2 * q_] = bflo(tw_[q_]); dst[2 * q_ + 1] = bfhi(tw_[q_]); } } while (0)
        { float yf[16], yb[16]; RD16(yf, YF + off); RD16(yb, YB + off);
#pragma unroll
          for (int q = 0; q < 16; ++q) y[q] = yf[q] + yb[q]; }
        RD16(kv, KB + hoff); RD16(vv, VB + hoff); RD16(rv, RB + roff); RD16(gv, G + off); RD16(a0v, AG + hoff); RD16(a1v, AG + (size_t)128 * (SEQ + CTXL) * 64 + hoff);
#undef RD16
        float s = 0.f, cf = 0.f;
#pragma unroll
        for (int q = 0; q < 16; ++q) { s += y[q]; const float ka = F.in[29][c0 + q];
            const float kd = kv[q] * ((1.f + (a0v[q] - 1.f) * ka) + (1.f + (a1v[q] - 1.f) * ka)); cf += rv[q] * kd * F.in[30][c0 + q]; }
        s = red4(s); cf = red4(cf);
        const float mean = s * (1.f / 64.f); float q2 = 0.f;
#pragma unroll
        for (int q = 0; q < 16; ++q) { const float d = y[q] - mean; q2 += d * d; }
        q2 = red4(q2);
        const float rstd = rsqrtf(q2 * (1.f / 64.f) + 64e-5f);
        float o[16];
#pragma unroll
        for (int q = 0; q < 16; ++q) o[q] = ((y[q] - mean) * rstd * F.in[31][c0 + q] + F.in[32][c0 + q] + cf * vv[q]) * gv[q];
        u32x4 p0, p1; p0.x = pk2(o[0], o[1]); p0.y = pk2(o[2], o[3]); p0.z = pk2(o[4], o[5]); p0.w = pk2(o[6], o[7]); p1.x = pk2(o[8], o[9]); p1.y = pk2(o[10], o[11]); p1.z = pk2(o[12], o[13]); p1.w = pk2(o[14], o[15]);
        *(u32x4*)(Z + off) = p0; *(u32x4*)(Z + off + 8) = p1;
    }
}

DI void moe_route_phase(Fr& F, const float* xl, const float* normw, const float* modl) {
    bf16* H2 = (bf16*)(F.ws + WS_MIX); int* TopE = (int*)(F.ws + WS_MISC + MISC_TOPE); f32x2* TopW = (f32x2*)(F.ws + WS_MISC + MISC_TOPW); int* Cnts = (int*)(F.ws + WS_MISC + MISC_CNTS);
    LAS float* rt = (LAS float*)F.lds;
    LAS int* lc = (LAS int*)(F.lds + 32768);
    for (int idx = F.tid; idx < 1024 * 8 / 4; idx += NTHR) ((LAS f32x4*)rt)[idx] = ((const f32x4*)F.in[34])[idx];
    for (int wg = F.bx; wg < 256; wg += F.G) {
        WG_SYNC();
        for (int it = 0; it < 8; ++it) { const int row = wg * 64 + F.wave * 8 + it;
            const float* src = xl + (size_t)row * D; const float* mrow = modl + (size_t)(row / SEQ) * 6144;
            f32x4 v[4]; float ss = 0.f;
#pragma unroll
            for (int j = 0; j < 4; ++j) { v[j] = ((const f32x4*)src)[F.lane + 64 * j]; ss += (v[j].x * v[j].x + v[j].y * v[j].y) + (v[j].z * v[j].z + v[j].w * v[j].w); }
            const float rstd = rsqrtf(wave_sum(ss) * (1.f / D) + 1e-6f);
            float lg[8];
#pragma unroll
            for (int e = 0; e < 8; ++e) lg[e] = 0.f;
#pragma unroll
            for (int j = 0; j < 4; ++j) { const int c4 = F.lane + 64 * j;
                const f32x4 w = ((const f32x4*)normw)[c4], sc = ((const f32x4*)(mrow + 4096))[c4], sh = ((const f32x4*)(mrow + 3072))[c4];
                const f32x4 y = v[j] * rstd * w * (sc + 1.f) + sh;
                u32x2 p; p.x = pk2(y.x, y.y); p.y = pk2(y.z, y.w); ((u32x2*)(H2 + (size_t)row * D))[c4] = p;
                const float yy[4] = {y.x, y.y, y.z, y.w};
#pragma unroll
                for (int q = 0; q < 4; ++q) { const f32x4 r0 = *(const LAS f32x4*)(rt + (4 * c4 + q) * 8), r1 = *(const LAS f32x4*)(rt + (4 * c4 + q) * 8 + 4);
                    lg[0] += yy[q] * r0.x; lg[1] += yy[q] * r0.y; lg[2] += yy[q] * r0.z; lg[3] += yy[q] * r0.w; lg[4] += yy[q] * r1.x; lg[5] += yy[q] * r1.y; lg[6] += yy[q] * r1.z; lg[7] += yy[q] * r1.w; } }
#pragma unroll
            for (int e = 0; e < 8; ++e) lg[e] = wave_sum(lg[e]);
            int e0 = 0; float v0 = lg[0];
#pragma unroll
            for (int e = 1; e < 8; ++e) if (lg[e] > v0) { v0 = lg[e]; e0 = e; }
            int e1 = -1; float v1 = -3.0e38f;
#pragma unroll
            for (int e = 0; e < 8; ++e) if (e != e0 && lg[e] > v1) { v1 = lg[e]; e1 = e; }
            const float w0 = 1.f / (1.f + expf(v1 - v0)), w1 = 1.f - w0;
            if (F.lane == 0) { TopE[row] = e0 | (e1 << 8); TopW[row] = (f32x2){w0, w1}; lc[F.wave * 8 + it] = e0 | (e1 << 8); }
        }
        WG_SYNC();
        if (F.tid < 8) { int c = 0; for (int t = 0; t < 64; ++t) { const int code = lc[t]; c += ((code & 255) == F.tid ? 1 : 0) + ((code >> 8) == F.tid ? 1 : 0); } Cnts[wg * 8 + F.tid] = c; }
        WG_SYNC();
    }
}
DI void moe_gather_phase(Fr& F) {
    const bf16* H2 = (const bf16*)(F.ws + WS_MIX); const int* TopE = (const int*)(F.ws + WS_MISC + MISC_TOPE); const f32x2* TopW = (const f32x2*)(F.ws + WS_MISC + MISC_TOPW);
    const int* Cnts = (const int*)(F.ws + WS_MISC + MISC_CNTS); int* Exp = (int*)(F.ws + WS_MISC + MISC_EXP);
    bf16* XG = (bf16*)(F.ws + WS_XG); int* RowTok = (int*)(F.ws + WS_ROWS); float* RowW = (float*)(F.ws + WS_ROWS + 262144);
    LAS int* lc = (LAS int*)F.lds;
    LAS int* tot = lc + 2048;
    LAS int* rows = tot + 32;
    LAS int* te = rows + 128;
    for (int idx = F.tid; idx < 2048; idx += NTHR) lc[idx] = Cnts[idx];
    WG_SYNC();
    for (int wg = F.bx; wg < 256; wg += F.G) {
        if (F.tid < 64) te[F.tid] = TopE[wg * 64 + F.tid];
        if (F.tid < 8) { int t = 0, mb = 0; for (int w = 0; w < 256; ++w) { const int c = lc[w * 8 + F.tid]; t += c; mb += (w < wg) ? c : 0; } tot[F.tid] = t; tot[16 + F.tid] = mb; }
        WG_SYNC();
        if (F.tid == 0) { int sgs = 0; for (int e = 0; e < 8; ++e) { tot[8 + e] = sgs; sgs += (tot[e] + 255) & ~255; }
            if (wg == 0) { int acc = 0; for (int e = 0; e < 8; ++e) { Exp[e] = tot[e]; Exp[8 + e] = tot[8 + e]; acc += (tot[e] + 255) >> 8; Exp[16 + e] = acc; } } }
        WG_SYNC();
        if (F.tid < 64) { const int code = te[F.tid]; const int e0 = code & 255, e1 = code >> 8; int r0 = 0, r1 = 0;
            for (int t = 0; t < F.tid; ++t) { const int c2 = te[t]; const int a = c2 & 255, bq = c2 >> 8; r0 += (a == e0 ? 1 : 0) + (bq == e0 ? 1 : 0); r1 += (a == e1 ? 1 : 0) + (bq == e1 ? 1 : 0); }
            rows[2 * F.tid] = tot[8 + e0] + tot[16 + e0] + r0; rows[2 * F.tid + 1] = tot[8 + e1] + tot[16 + e1] + r1; }
        WG_SYNC();
        for (int it = F.wave; it < 128; it += NWAVES) { const int t = it >> 1, k = it & 1, tok = wg * 64 + t, row = rows[it];
            const u32x4* s = (const u32x4*)(H2 + (size_t)tok * D); u32x4* d = (u32x4*)(XG + (size_t)row * D);
            d[F.lane] = s[F.lane]; d[F.lane + 64] = s[F.lane + 64];
            if (F.lane == 0) { RowTok[row] = tok * 2 + k; const f32x2 w = TopW[tok]; RowW[row] = k ? w.y : w.x; } }
        if (wg == 0) {
            for (int e = 0; e < 8; ++e) { const int a = tot[8 + e] + tot[e], bnd = tot[8 + e] + ((tot[e] + 255) & ~255); for (int rr = a + F.tid; rr < bnd; rr += NTHR) RowTok[rr] = -1; } }
        WG_SYNC();
    }
}
DI void moe_combine_phase(Fr& F, float* xl, const float* modl) {
    const bf16* YS = (const bf16*)(F.ws + WS_YS);
    for (int row = F.gw; row < ML; row += F.NGW) {
        const float* mrow = modl + (size_t)(row / SEQ) * 6144 + 5120; float* xr = xl + (size_t)row * D;
        const u32x2* s0 = (const u32x2*)(YS + (size_t)(2 * row) * D); const u32x2* s1 = (const u32x2*)(YS + (size_t)(2 * row + 1) * D);
#pragma unroll
        for (int j = 0; j < 4; ++j) { const int c4 = F.lane + 64 * j; const f32x4 x = ((const f32x4*)xr)[c4], m = ((const f32x4*)mrow)[c4]; const u32x2 a = s0[c4], bq = s1[c4];
            f32x4 o; o.x = x.x + m.x * (bflo(a.x) + bflo(bq.x)); o.y = x.y + m.y * (bfhi(a.x) + bfhi(bq.x)); o.z = x.z + m.z * (bflo(a.y) + bflo(bq.y)); o.w = x.w + m.w * (bfhi(a.y) + bfhi(bq.y));
            ((f32x4*)xr)[c4] = o; }
    }
}

constexpr int N_PHASES = 20;
struct Args { const float* in[37]; float* out; unsigned char* ws; int ph_lo, ph_hi; };
template <class Epi> DI void run_gemm(Fr& F, const bf16* A, const bf16* Bt, int M, int N, int K, const Epi& E, int& rot) {
    int Kv = K; asm volatile("" : "+s"(Kv));
    pg8::Gemm g{A, Bt, M, N, Kv}; pg8::StaticOrder S; S.init(M, N, F.G, (F.bx + F.G - (rot % F.G)) % F.G); rot += (M / 256) * (N / 256);
    pg8::gemm_phase<Epi, pg8::StaticOrder>(F.lds, g, S, E);
}
__global__ void __launch_bounds__(NTHR, 2) fwd_kernel(Args args) {
    extern __shared__ __attribute__((aligned(16))) unsigned char lds_raw[];
    Fr F;
    F.lds = (LAS unsigned char*)lds_raw; F.ws = args.ws; F.in = args.in; F.out = args.out;
    F.tid = threadIdx.x; F.lane = F.tid & 63; F.wave = __builtin_amdgcn_readfirstlane(F.tid >> 6); F.bx = blockIdx.x; F.G = gridDim.x;
    F.gw = F.bx * NWAVES + F.wave; F.NGW = F.G * NWAVES;
    volatile LAS unsigned* MISC = (volatile LAS unsigned*)(F.lds + LDS_MISC_OFF);
    if (F.tid < 64) MISC[F.tid] = 0u;
    __syncthreads();
    const int lo = args.ph_lo, hi = args.ph_hi;
    const bool multi = (hi - lo) > 1;
    XcdBarrier bar; bar.bar = (unsigned*)(F.ws + WS_CTL) + CW_BAR; bar.x = 0; bar.st = nullptr;
    if (multi) bar = xcd_barrier_post((unsigned*)(F.ws + WS_CTL) + CW_BAR, MISC + 8);
#ifndef PH_MASK
#define PH_MASK 0xFFFFFFFFu
#endif
#define IN(k) ((((PH_MASK) >> (k)) & 1u) && lo <= (k) && (k) < hi)
#define REP(k) for (int rep_ = 0; rep_ < ((((PROBE_DUP) >> (k)) & 1u) ? 2 : 1); ++rep_)
#define SEAM(k) do { if (IN(k) && IN((k) + 1)) xcd_barrier(bar); } while (0)
    const float* const* in = args.in;
    float* MOD = (float*)(F.ws + WS_MOD);
    float* XL = F.out; float* XC = (float*)(F.ws + WS_XC);
    bf16* H = (bf16*)(F.ws + WS_H); bf16* MIX = (bf16*)(F.ws + WS_MIX);

    if (IN(0)) REP(0) { p0_prologue(F); } SEAM(0);
    if (IN(1)) REP(1) { mod_rows(F, in[0], in[2], MA, in[6], MOD, 0, 1024, H); } SEAM(1);
    if (IN(2)) REP(2) { int rot = 0; EpiStore<0> E{(bf16*)(F.ws + WS_QKV), INW, INW}; run_gemm(F, H, (const bf16*)(F.ws + WS_W_IN), MA, INW, 1024, E, rot); } SEAM(2);
    if (IN(3)) REP(3) { na_norm_rows(F); ret_kv_phase(F); } SEAM(3);
    if (IN(4)) REP(4) { ret_prefix_phase(F); } SEAM(4);
    #ifndef PH5_SEL
#define PH5_SEL 3
#endif
    if (IN(5)) REP(5) { for (int r5_ = 0; r5_ < ((((PROBE_DUP) >> 27) & 1u) ? 2 : 1); ++r5_) ret_out_phase(F); for (int r6_ = 0; r6_ < ((((PROBE_DUP) >> 28) & 1u) ? 2 : 1); ++r6_) na_phase(F); } SEAM(5);
    if (IN(6)) REP(6) { int rot = 0; EpiResid E{in[0], XL, in[2], XC, MOD + 2048}; run_gemm(F, MIX, (const bf16*)(F.ws + WS_W_OUT), MA, 1024, 1024, E, rot); } SEAM(6);
    if (IN(7)) REP(7) { mod_rows(F, XL, XC, MA, in[7], MOD, 3072, 4096, H); } SEAM(7);
    if (IN(8)) REP(8) { int rot = 0; EpiSwiglu E{(bf16*)(F.ws + WS_FFH), FFN_H}; run_gemm(F, H, (const bf16*)(F.ws + WS_W_13), MA, 2 * FFN_H, 1024, E, rot); } SEAM(8);
    if (IN(9)) { int rot = 0; EpiResid E{XL, XL, XC, XC, MOD + 5120}; run_gemm(F, (const bf16*)(F.ws + WS_FFH), (const bf16*)(F.ws + WS_W_2), MA, 1024, FFN_H, E, rot); } SEAM(9);
    const float* MOD1 = MOD + 9 * 6144;
    if (IN(10)) REP(10) { xm_phase(F, XL, XC, in[6] + 1024, MOD1); } SEAM(10);
    if (IN(11)) REP(11) { int rot = 0; const bf16* XM = (const bf16*)(F.ws + WS_XM); const bf16* WR = (const bf16*)(F.ws + WS_W_RKV); const bf16* WL1 = (const bf16*)(F.ws + WS_W_L1);
        { EpiStoreHead E{(bf16*)(F.ws + WS_RB), SEQ, 0}; run_gemm(F, XM, WR, ML, 1024, 1024, E, rot); }
        { EpiStoreHead E{(bf16*)(F.ws + WS_KB), SEQ + CTXL, CTXL}; run_gemm(F, XM + (size_t)1 * MA * D, WR + 1024 * 1024, MA, 1024, 1024, E, rot); }
        { EpiStoreHead E{(bf16*)(F.ws + WS_VB), SEQ + CTXL, CTXL}; run_gemm(F, XM + (size_t)2 * MA * D, WR + 2 * 1024 * 1024, MA, 1024, 1024, E, rot); }
        { EpiStore<1> E{(bf16*)(F.ws + WS_L1), 256, 128}; run_gemm(F, XM + (size_t)3 * MA * D, WL1, MA, 256, 1024, E, rot); }
        { EpiStore<0> E{(bf16*)(F.ws + WS_L1) + 128, 256, 128}; run_gemm(F, XM + (size_t)4 * MA * D, WL1 + 256 * 1024, MA, 256, 1024, E, rot); }
        { EpiStore<2> E{(bf16*)(F.ws + WS_LG), 256, 256}; run_gemm(F, XM + (size_t)5 * MA * D, WL1 + 2 * 256 * 1024, ML, 256, 1024, E, rot); } } SEAM(11);
    if (IN(12)) REP(12) { int rot = 0;
        { EpiLora2 E{(float*)(F.ws + WS_DEC), (bf16*)(F.ws + WS_AG), in[20], in[23]}; run_gemm(F, (const bf16*)(F.ws + WS_L1), (const bf16*)(F.ws + WS_W_L2), MA, 4096, 256, E, rot); }
        { EpiStore<0> E{(bf16*)(F.ws + WS_G), D, D}; run_gemm(F, (const bf16*)(F.ws + WS_LG), (const bf16*)(F.ws + WS_W_G2), ML, 1024, 256, E, rot); } } SEAM(12);
    #ifndef SCAN_VER
#define SCAN_VER 2
#endif
    if (IN(13)) REP(13) { rwkv_scan2_phase(F); } SEAM(13);
    if (IN(14)) REP(14) { rwkv_readout_phase(F); } SEAM(14);
    if (IN(15)) { int rot = 0; EpiResid E{XL, XL, XC, XC, MOD1 + 2048}; run_gemm(F, H, (const bf16*)(F.ws + WS_W_O), ML, 1024, 1024, E, rot); } SEAM(15);
    if (IN(16)) REP(16) { moe_route_phase(F, XL, in[7] + 1024, MOD1); } SEAM(16);
    if (IN(17)) REP(17) { moe_gather_phase(F); } SEAM(17);
    if (IN(18) || IN(19)) {
        const int* Exp = (const int*)(F.ws + WS_MISC + MISC_EXP);
        pg8::MoeOrder S; S.G = F.G; S.c = F.bx;
#pragma unroll
        for (int e = 0; e < 8; ++e) S.tend[e] = Exp[16 + e];
        S.nM = S.tend[7];
        if (IN(18)) REP(18) { S.nN = 2 * EXP_H / 256; S.nwg = S.nM * S.nN; pg8::Gemm g{(const bf16*)(F.ws + WS_XG), (const bf16*)(F.ws + WS_W_M13), XG_ROWS, 2 * EXP_H, 1024};
            EpiSwiglu E{(bf16*)(F.ws + WS_HG), EXP_H}; pg8::gemm_phase<EpiSwiglu, pg8::MoeOrder>(F.lds, g, S, E); }
        SEAM(18);
        if (IN(19)) REP(19) { S.nN = 4; S.nwg = S.nM * S.nN; pg8::Gemm g{(const bf16*)(F.ws + WS_HG), (const bf16*)(F.ws + WS_W_M2), XG_ROWS, 1024, EXP_H};
            EpiMoeOut E{(bf16*)(F.ws + WS_YS), (const int*)(F.ws + WS_ROWS), (const float*)(F.ws + WS_ROWS + 262144)}; pg8::gemm_phase<EpiMoeOut, pg8::MoeOrder>(F.lds, g, S, E); }
    }
    if (IN(19) && IN(20)) xcd_barrier(bar);
    if (IN(20)) { moe_combine_phase(F, XL, MOD1); }
#undef IN
#undef SEAM
}

#ifndef MK_SPLIT
#define MK_SPLIT 0
#endif
extern "C" void kernel_launch(void* const* d_in, const int* in_sizes, int n_in, void* d_out, int out_size, void* d_ws, size_t ws_size, hipStream_t stream) {
    static int grid = 0;
    if (grid == 0) {
        if (n_in != 37 || out_size != ML * D || ws_size < WS_END) { fprintf(stderr, "kernel_launch: unexpected problem (n_in %d out %d ws %zu)\n", n_in, out_size, ws_size); grid = -1; return; }
        int dev = 0, cus = 0, per_cu = 0;
        if (hipGetDevice(&dev) != hipSuccess || hipDeviceGetAttribute(&cus, hipDeviceAttributeMultiprocessorCount, dev) != hipSuccess) { grid = -1; return; }
        if (hipFuncSetAttribute((const void*)fwd_kernel, hipFuncAttributeMaxDynamicSharedMemorySize, LDS_BYTES) != hipSuccess) { fprintf(stderr, "kernel_launch: hipFuncSetAttribute failed\n"); grid = -1; return; }
        if (hipOccupancyMaxActiveBlocksPerMultiprocessor(&per_cu, (const void*)fwd_kernel, NTHR, LDS_BYTES) != hipSuccess || per_cu < 1) { fprintf(stderr, "kernel_launch: occupancy query says %d\n", per_cu); }
        (void)hipGetLastError();
        grid = cus;
    }
    if (grid < 0) return;
    (void)hipMemsetAsync((char*)d_ws + WS_CTL, 0, CTL_ZERO_BYTES, stream);
    Args a{};
    for (int i = 0; i < 37; ++i) a.in[i] = (const float*)d_in[i];
    a.out = (float*)d_out; a.ws = (unsigned char*)d_ws;
#if MK_SPLIT
    for (int p = 0; p <= N_PHASES; ++p) { a.ph_lo = p; a.ph_hi = p + 1; hipLaunchKernelGGL(fwd_kernel, dim3(grid), dim3(NTHR), LDS_BYTES, stream, a); }
#else
    a.ph_lo = 0; a.ph_hi = N_PHASES + 1; hipLaunchKernelGGL(fwd_kernel, dim3(grid), dim3(NTHR), LDS_BYTES, stream, a);
#endif
}
```

```cpp
#include <hip/hip_runtime.h>
#include <cstdio>
#include <cstdint>

#ifndef PROBE_DUP
#define PROBE_DUP 0u
#endif
#define DI __device__ __forceinline__
#define LAS __attribute__((address_space(3)))

namespace pg8 {
#define PG8_LAS __attribute__((address_space(3)))
typedef unsigned short bf16_t;
typedef short bf16x8 __attribute__((ext_vector_type(8)));
typedef float f32x4 __attribute__((ext_vector_type(4)));
typedef unsigned u32x4 __attribute__((ext_vector_type(4)));
constexpr int BM = 256, BK = 64, HALF = 128, HTB = HALF * BK * 2  , STAGE_BYTES = 8 * HTB, NXCD = 8, WGM = 8;

__host__ __device__ __forceinline__ int lds_byte(int r, int c) { const int st = (r >> 4) * 2 + (c >> 5), rr = r & 15, cc = c & 31, ob = rr * 64 + cc * 2; return st * 1024 + (ob ^ (((ob >> 9) & 1) << 5)); }
__host__ __device__ __forceinline__ void stage_rc(int b, int& R, int& C) { const int st = b / 1024, sb = b % 1024, swz = sb ^ (((sb >> 9) & 1) << 5); R = (st >> 1) * 16 + swz / 64; C = (st & 1) * 32 + (swz % 64) / 2; }
__host__ __device__ __forceinline__ int perm32(int rho) { const int n = rho >> 4, i = rho & 15; return 8 * (i >> 2) + 4 * n + (i & 3); }

struct Unit { int pm, pn, pb; };
struct Gemm { const bf16_t* A; const bf16_t* Bt; int M, N, K; };

struct StaticOrder {
    int nM, nN, nwg, G, c;
    __host__ __device__ void init(int M, int N, int G_, int c_) { nM = M / BM; nN = N / BM; nwg = nM * nN; G = G_; c = c_; }
    __host__ __device__ bool next(int i, Unit& u) const {
        const long L = (long)i * G + c; if (L >= nwg) return false;
        int wgid = (int)L; { const int q = nwg / NXCD, r = nwg % NXCD, xcd = wgid % NXCD, off = wgid / NXCD; wgid = (xcd < r ? xcd * (q + 1) : r * (q + 1) + (xcd - r) * q) + off; }
        const int nig = WGM * nN, gid = wgid / nig, fm = gid * WGM, gsz = (nM - fm) < WGM ? (nM - fm) : WGM;
        u.pm = fm + ((wgid % nig) % gsz); u.pn = (wgid % nig) / gsz; u.pb = u.pn; return true;
    }
    __device__ __forceinline__ void a_ready(const Unit&) const {}
    __device__ __forceinline__ void done(const Unit&) const {}
};
struct MoeOrder {
    int nM, nN, nwg, G, c; int tend[8];
    __device__ bool next(int i, Unit& u) const {
        const long L = (long)i * G + c; if (L >= nwg) return false;
        int wgid = (int)L; { const int q = nwg / NXCD, r = nwg % NXCD, xcd = wgid % NXCD, off = wgid / NXCD; wgid = (xcd < r ? xcd * (q + 1) : r * (q + 1) + (xcd - r) * q) + off; }
        const int nig = WGM * nN, gid = wgid / nig, fm = gid * WGM, gsz = (nM - fm) < WGM ? (nM - fm) : WGM;
        u.pm = fm + ((wgid % nig) % gsz); u.pn = (wgid % nig) / gsz;
        int e = 0;
#pragma unroll
        for (int j = 0; j < 7; ++j) e += (u.pm >= tend[j]) ? 1 : 0;
        u.pb = e * nN + u.pn; return true;
    }
    __device__ __forceinline__ void a_ready(const Unit&) const {}
    __device__ __forceinline__ void done(const Unit&) const {}
};

typedef float f32x2_t __attribute__((ext_vector_type(2))); typedef __bf16 bf16x2_t __attribute__((ext_vector_type(2)));
__device__ __forceinline__ unsigned cvt_pk_bf16(float lo, float hi) { const f32x2_t v = {lo, hi}; const bf16x2_t b = __builtin_convertvector(v, bf16x2_t); return __builtin_bit_cast(unsigned, b); }

template <class Epi, class Sched>
__device__ __forceinline__ void gemm_phase(PG8_LAS unsigned char* lds, const Gemm g, const Sched& S, const Epi& E) {
    const int tid = threadIdx.x, wid = __builtin_amdgcn_readfirstlane(tid >> 6), lane = tid & 63, wr = wid >> 2, wc = wid & 3, fr = lane & 15, fq = lane >> 4;
    const int K = g.K, nt = K / BK;
    unsigned voffA[2], voffB[2];
#pragma unroll
    for (int i = 0; i < 2; ++i) { int R, C; stage_rc(tid * 16 + i * 8192, R, C); const int Rb = Epi::PERM ? ((R & ~31) + perm32(R & 31)) : R;
        voffA[i] = (unsigned)(R * K + C) * 2u; voffB[i] = (unsigned)(Rb * K + C) * 2u; }
    const size_t kstep = (size_t)(BK * 2);
    const size_t hstep = (size_t)HALF * K * 2;
    const size_t tstep = 2 * hstep;
    const unsigned ldsw = (unsigned)wid * 1024u;
    const int aoff = lds_byte(wr * 64 + fr, fq * 8), boff = lds_byte(wc * 32 + fr, fq * 8);
#define PG8_SA(b, h) (((b) * 2 + (h)) * HTB)
#define PG8_SB(b, h) ((4 + (b) * 2 + (h)) * HTB)
#define PG8_STAGE(bufoff, gbase, voff) do { _Pragma("unroll") for (int _i = 0; _i < 2; ++_i) \
        __builtin_amdgcn_global_load_lds((const unsigned*)((const char*)(gbase) + (voff)[_i]), (PG8_LAS unsigned*)(lds + (bufoff) + ldsw + _i * 8192), 16, 0, 0); } while (0)
#define PG8_LDA(dst, b, h) do { _Pragma("unroll") for (int m = 0; m < 4; ++m) _Pragma("unroll") for (int k = 0; k < 2; ++k) dst[m][k] = *(const PG8_LAS bf16x8*)(lds + PG8_SA(b, h) + aoff + m * 2048 + k * 1024); } while (0)
#define PG8_LDB(dst, b, h) do { _Pragma("unroll") for (int n = 0; n < 2; ++n) _Pragma("unroll") for (int k = 0; k < 2; ++k) dst[n][k] = *(const PG8_LAS bf16x8*)(lds + PG8_SB(b, h) + boff + n * 2048 + k * 1024); } while (0)
#define PG8_MMA(ai, bj, At, Bt) do { __builtin_amdgcn_s_setprio(1); _Pragma("unroll") for (int m = 0; m < 4; ++m) _Pragma("unroll") for (int n = 0; n < 2; ++n) _Pragma("unroll") for (int k = 0; k < 2; ++k) \
        acc[ai][bj][m][n] = __builtin_amdgcn_mfma_f32_16x16x32_bf16(Bt[n][k], At[m][k], acc[ai][bj][m][n], 0, 0, 0); __builtin_amdgcn_s_setprio(0); } while (0)
#define PG8_WAIT_V(n) asm volatile("s_waitcnt vmcnt(" #n ")" ::: "memory")
#define PG8_WAIT_L(n) asm volatile("s_waitcnt lgkmcnt(" #n ")" ::: "memory")
#define PG8_BAR __builtin_amdgcn_s_barrier()
#define PG8_SCHED __builtin_amdgcn_sched_barrier(0)
    Unit cur, nxt; int ui = 0;
    if (!S.next(0, cur)) return;
    f32x4 acc[2][2][4][2];
#pragma unroll
    for (int a = 0; a < 2; ++a)
#pragma unroll
        for (int b = 0; b < 2; ++b)
#pragma unroll
            for (int m = 0; m < 4; ++m)
#pragma unroll
                for (int n = 0; n < 2; ++n) acc[a][b][m][n] = (f32x4){0.f, 0.f, 0.f, 0.f};
    bf16x8 At[4][2], B0[2][2], B1[2][2];
    const char* cA = (const char*)g.A + (size_t)cur.pm * tstep; const char* cB = (const char*)g.Bt + (size_t)cur.pb * tstep;
    S.a_ready(cur);
    PG8_STAGE(PG8_SB(0, 0), cB, voffB); PG8_STAGE(PG8_SA(0, 0), cA, voffA); PG8_STAGE(PG8_SB(0, 1), cB + hstep, voffB); PG8_STAGE(PG8_SA(0, 1), cA + hstep, voffA);
    if (wr == 1) PG8_BAR;
    PG8_WAIT_V(4); PG8_BAR;
    PG8_STAGE(PG8_SB(1, 0), cB + kstep, voffB); PG8_STAGE(PG8_SA(1, 0), cA + kstep, voffA); PG8_STAGE(PG8_SB(1, 1), cB + hstep + kstep, voffB);
    PG8_WAIT_V(6); PG8_BAR;
    for (;;) {
        const bool has_next = S.next(ui + 1, nxt);
        const char* nA = has_next ? (const char*)g.A + (size_t)nxt.pm * tstep : cA; const char* nB = has_next ? (const char*)g.Bt + (size_t)nxt.pb * tstep : cB;
        for (int t = 0; t < nt; t += 2) {
            const bool last = (t == nt - 2);
            const char* a1 = cA + (size_t)(t + 1) * kstep;
            const char* a2 = last ? nA : cA + (size_t)(t + 2) * kstep; const char* b2 = last ? nB : cB + (size_t)(t + 2) * kstep;
            const char* a3 = a2 + kstep; const char* b3 = b2 + kstep;
            if (last && has_next) S.a_ready(nxt);
            PG8_LDB(B0, 0, 0); PG8_SCHED; PG8_LDA(At, 0, 0); PG8_STAGE(PG8_SA(1, 1), a1 + hstep, voffA);
            PG8_WAIT_L(8); PG8_BAR; PG8_WAIT_L(0); PG8_MMA(0, 0, At, B0); PG8_BAR; PG8_SCHED;
            PG8_LDB(B1, 0, 1); PG8_STAGE(PG8_SB(0, 0), b2, voffB);
            PG8_BAR; PG8_WAIT_L(0); PG8_MMA(0, 1, At, B1); PG8_BAR;
            PG8_LDA(At, 0, 1); PG8_STAGE(PG8_SA(0, 0), a2, voffA);
            PG8_BAR; PG8_WAIT_L(0); PG8_MMA(1, 0, At, B0); PG8_BAR; PG8_SCHED;
            PG8_STAGE(PG8_SB(0, 1), b2 + hstep, voffB);
            PG8_WAIT_V(6); PG8_BAR; PG8_MMA(1, 1, At, B1); PG8_BAR;
            PG8_LDB(B0, 1, 0); PG8_SCHED; PG8_LDA(At, 1, 0); PG8_STAGE(PG8_SA(0, 1), a2 + hstep, voffA);
            PG8_WAIT_L(8); PG8_BAR; PG8_WAIT_L(0); PG8_MMA(0, 0, At, B0); PG8_BAR; PG8_SCHED;
            PG8_LDB(B1, 1, 1); PG8_STAGE(PG8_SB(1, 0), b3, voffB);
            PG8_BAR; PG8_WAIT_L(0); PG8_MMA(0, 1, At, B1); PG8_BAR;
            PG8_LDA(At, 1, 1); PG8_STAGE(PG8_SA(1, 0), a3, voffA);
            PG8_BAR; PG8_WAIT_L(0); PG8_MMA(1, 0, At, B0); PG8_BAR; PG8_SCHED;
            PG8_STAGE(PG8_SB(1, 1), b3 + hstep, voffB);
            PG8_WAIT_V(6); PG8_BAR; PG8_MMA(1, 1, At, B1); PG8_BAR;
        }
        E(acc, cur, wr, wc, fr, fq); S.done(cur);
        if (!has_next) break;
#pragma unroll
        for (int a = 0; a < 2; ++a)
#pragma unroll
            for (int b = 0; b < 2; ++b)
#pragma unroll
                for (int m = 0; m < 4; ++m)
#pragma unroll
                    for (int n = 0; n < 2; ++n) acc[a][b][m][n] = (f32x4){0.f, 0.f, 0.f, 0.f};
        cur = nxt; cA = nA; cB = nB; ++ui;
    }
    PG8_WAIT_V(0);
    if (wr == 0) PG8_BAR;
    PG8_BAR;
#undef PG8_SA
#undef PG8_SB
#undef PG8_STAGE
#undef PG8_LDA
#undef PG8_LDB
#undef PG8_MMA
#undef PG8_WAIT_V
#undef PG8_WAIT_L
#undef PG8_BAR
#undef PG8_SCHED
}
}

constexpr int D = 1024, NB = 8, SEQ = 2048, CTXL = 256;
constexpr int ML = NB * SEQ;
constexpr int MC = NB * CTXL;
constexpr int MA = ML + MC;
constexpr int INW = 3584, FFN_H = 2816, EXP_H = 3584, NEXP = 8;
constexpr int NCH = 18;
constexpr int XG_ROWS = 34816;
constexpr int NWAVES = 8, NTHR = 512;

constexpr size_t MiB = 1u << 20;
constexpr size_t WS_CTL = 0, CTL_ZERO_BYTES = 1 * MiB;
constexpr size_t WS_MOD = 1 * MiB;
constexpr size_t WS_ROPE = 2 * MiB;
constexpr size_t WS_MISC = 3 * MiB;
constexpr size_t WS_W_IN = 4 * MiB, WS_W_OUT = 11 * MiB, WS_W_13 = 13 * MiB, WS_W_2 = 24 * MiB, WS_W_RKV = 30 * MiB, WS_W_L1 = 36 * MiB,
                 WS_W_L2 = 38 * MiB, WS_W_G2 = 40 * MiB, WS_W_O = 41 * MiB, WS_W_M13 = 43 * MiB, WS_W_M2 = 155 * MiB;
constexpr size_t WS_XC = 211 * MiB, WS_H = 219 * MiB, WS_MIX = 255 * MiB, WS_R = 291 * MiB;
constexpr size_t WS_QKV = WS_R, WS_KV = WS_R + 126 * MiB, WS_SPREV = WS_R + 198 * MiB, WS_FFH = WS_R;
constexpr size_t WS_NQ = WS_R + 240 * MiB, WS_NK = WS_R + 260 * MiB, WS_NV = WS_R + 280 * MiB;
constexpr size_t WS_XM = WS_R, WS_DEC = WS_R, WS_AG = WS_R + 144 * MiB, WS_RB = WS_R + 216 * MiB, WS_KB = WS_R + 248 * MiB, WS_VB = WS_R + 284 * MiB,
                 WS_L1 = WS_R + 320 * MiB, WS_LG = WS_R + 329 * MiB, WS_G = WS_R + 337 * MiB, WS_YF = WS_R + 369 * MiB, WS_YB = WS_R + 433 * MiB;
constexpr size_t WS_XG = WS_R, WS_HG = WS_R + 68 * MiB, WS_YS = WS_R + 306 * MiB, WS_ROWS = WS_R + 370 * MiB;
constexpr size_t WS_END = WS_R + 497 * MiB;
static_assert(WS_END <= 896 * MiB, "workspace map");
constexpr int CW_BAR = 4096;
constexpr size_t MISC_TOPE = 0, MISC_TOPW = 65536, MISC_CNTS = 196608, MISC_EXP = 204800;

constexpr int LDS_MAIN = 147456;
constexpr int LDS_MISC_OFF = LDS_MAIN;
constexpr int LDS_BYTES = LDS_MAIN + 256;

typedef unsigned short bf16;
typedef short bf16x8 __attribute__((ext_vector_type(8)));
typedef short s16x4 __attribute__((ext_vector_type(4)));
typedef float f32x4 __attribute__((ext_vector_type(4)));
typedef float f32x2 __attribute__((ext_vector_type(2)));
typedef unsigned u32x4 __attribute__((ext_vector_type(4)));
typedef unsigned u32x2 __attribute__((ext_vector_type(2)));
#define LDS_WAIT() asm volatile("s_waitcnt lgkmcnt(0)" ::: "memory")
#define VM_WAIT() asm volatile("s_waitcnt vmcnt(0)" ::: "memory")
#define WG_SYNC() __syncthreads()
#define LDS_BARRIER() do { asm volatile("s_waitcnt lgkmcnt(0)" ::: "memory"); __builtin_amdgcn_s_barrier(); asm volatile("" ::: "memory"); } while (0)
DI unsigned f2bf(float f) { unsigned u = __builtin_bit_cast(unsigned, f); return (u + 0x7fffu + ((u >> 16) & 1u)) >> 16; }
typedef __bf16 bf16x2_t __attribute__((ext_vector_type(2)));
DI unsigned pk2(float lo, float hi) { const f32x2 v = {lo, hi}; const bf16x2_t b = __builtin_convertvector(v, bf16x2_t); return __builtin_bit_cast(unsigned, b); }
DI float bflo(unsigned w) { return __builtin_bit_cast(float, w << 16); }
DI float bfhi(unsigned w) { return __builtin_bit_cast(float, w & 0xffff0000u); }
DI float bf1(bf16 b) { return __builtin_bit_cast(float, (unsigned)b << 16); }
DI float wave_sum(float v) {
#pragma unroll
    for (int o = 1; o < 64; o <<= 1) v += __shfl_xor(v, o);
    return v;
}
DI float dpp_rm(float v) { return __builtin_bit_cast(float, __builtin_amdgcn_update_dpp(0, __builtin_bit_cast(int, v), 0x140, 0xf, 0xf, true)); }
DI float wave_sum_fast(float v) {
    v += __builtin_bit_cast(float, __builtin_amdgcn_update_dpp(0, __builtin_bit_cast(int, v), 0xB1, 0xf, 0xf, true));
    v += __builtin_bit_cast(float, __builtin_amdgcn_update_dpp(0, __builtin_bit_cast(int, v), 0x4E, 0xf, 0xf, true));
    v += __builtin_bit_cast(float, __builtin_amdgcn_update_dpp(0, __builtin_bit_cast(int, v), 0x141, 0xf, 0xf, true));
    v += dpp_rm(v);
    const int iv = __builtin_bit_cast(int, v);
    const float a = __builtin_bit_cast(float, __builtin_amdgcn_readlane(iv, 0)), b = __builtin_bit_cast(float, __builtin_amdgcn_readlane(iv, 16));
    const float c = __builtin_bit_cast(float, __builtin_amdgcn_readlane(iv, 32)), d = __builtin_bit_cast(float, __builtin_amdgcn_readlane(iv, 48));
    return (a + b) + (c + d);
}
DI float wave_max(float v) {
#pragma unroll
    for (int o = 1; o < 64; o <<= 1) v = fmaxf(v, __shfl_xor(v, o));
    return v;
}
DI float dpp_x1(float v) { return __builtin_bit_cast(float, __builtin_amdgcn_update_dpp(0, __builtin_bit_cast(int, v), 0xB1, 0xf, 0xf, true)); }
DI float dpp_x2(float v) { return __builtin_bit_cast(float, __builtin_amdgcn_update_dpp(0, __builtin_bit_cast(int, v), 0x4E, 0xf, 0xf, true)); }
DI float dpp_hm(float v) { return __builtin_bit_cast(float, __builtin_amdgcn_update_dpp(0, __builtin_bit_cast(int, v), 0x141, 0xf, 0xf, true)); }
DI float red4(float v) { v += dpp_x1(v); v += dpp_x2(v); return v; }
DI float red8(float v) { v += dpp_x1(v); v += dpp_x2(v); v += dpp_hm(v); return v; }
DI float sigmoidf_(float x) { return 1.f / (1.f + __expf(-x)); }
DI float siluf_(float x) { return x / (1.f + __expf(-x)); }

DI bf16x8 frag_kc(const LAS bf16* base, int ld, int row0, int k0, int lane) {
    return *(const LAS bf16x8*)(base + (row0 + (lane & 15)) * ld + k0 + 8 * (lane >> 4));
}
DI bf16x8 frag_kr(const LAS bf16* base, int ld, int x0, int k0, int lane) {
    const int g = lane >> 4, q = (lane & 15) >> 2, p = lane & 3;
    const LAS bf16* a = base + (k0 + 8 * g + q) * ld + x0 + 4 * p;
    const s16x4 lo = __builtin_amdgcn_ds_read_tr16_b64_v4i16((LAS s16x4*)a);
    const s16x4 hi = __builtin_amdgcn_ds_read_tr16_b64_v4i16((LAS s16x4*)(a + 4 * ld));
    return __builtin_shufflevector(lo, hi, 0, 1, 2, 3, 4, 5, 6, 7);
}
DI f32x4 mma(f32x4 acc, bf16x8 bfrag, bf16x8 afrag) { return __builtin_amdgcn_mfma_f32_16x16x32_bf16(bfrag, afrag, acc, 0, 0, 0); }

#define XB_TMO      128
#define XB_XCNT(j)  (256  + 64 * (j))
#define XB_XSUB(j)  (1280 + 64 * (j))
#define XB_XGEN(j)  (2304 + 64 * (j))
#define XB_TOP      3328
#define XB_TOPGEN   3392
#define XCD_BAR_WORDS 3456
#define XB_SPIN_CAP (1u << 18)
DI unsigned xb_ld(unsigned* p)              { return __hip_atomic_load(p, __ATOMIC_RELAXED, __HIP_MEMORY_SCOPE_AGENT); }
DI unsigned xb_add(unsigned* p, unsigned v) { return __hip_atomic_fetch_add(p, v, __ATOMIC_RELAXED, __HIP_MEMORY_SCOPE_AGENT); }
DI unsigned xb_xcc_id() { return (unsigned)__builtin_amdgcn_s_getreg((3 << 11) | 20) & 0xFu; }
#define XB_SPIN(cond, bar) do { unsigned _sp = 0; while (cond) { __builtin_amdgcn_s_sleep(1); \
    if ((++_sp & 255u) == 0u) { if (xb_ld(&(bar)[XB_TMO])) break; if (_sp > XB_SPIN_CAP) { atomicAdd(&(bar)[XB_TMO], 1u); break; } } } } while (0)
struct XcdBarrier { unsigned* bar; unsigned x; volatile LAS unsigned* st; };
DI XcdBarrier xcd_barrier_post(unsigned* bar, volatile LAS unsigned* st) {
    XcdBarrier b; b.bar = bar; b.x = xb_xcc_id(); b.st = st;
    if (threadIdx.x == 0) (void)xb_add(&bar[XB_XCNT(b.x)], 1u);
    return b;
}
DI void xcd_barrier_complete(unsigned* bar, unsigned x, unsigned& nloc, unsigned& nx) {
    const unsigned G = gridDim.x * gridDim.y * gridDim.z;
    unsigned sum, cnt, mine, sp = 0u;
    for (;;) {
        sum = 0u; cnt = 0u; mine = 0u;
#pragma unroll
        for (unsigned j = 0; j < 16; ++j) { const unsigned c = xb_ld(&bar[XB_XCNT(j)]); sum += c; cnt += (c > 0u) ? 1u : 0u; mine = (j == x) ? c : mine; }
        if (sum == G) break;
        __builtin_amdgcn_s_sleep(1);
        if ((++sp & 255u) == 0u) { if (xb_ld(&bar[XB_TMO])) break; if (sp > XB_SPIN_CAP) { atomicAdd(&bar[XB_TMO], 1u); break; } }
    }
    nloc = mine > 0u ? mine : 1u; nx = cnt > 0u ? cnt : 1u;
}
DI void xcd_barrier(const XcdBarrier& b) {
    asm volatile("s_waitcnt vmcnt(0)" ::: "memory");
    __syncthreads();
    if (threadIdx.x == 0) {
        unsigned* bar = b.bar;
        __builtin_amdgcn_s_waitcnt(0);
        unsigned nloc = b.st[0], nx = b.st[1];
        if (nloc == 0u) { xcd_barrier_complete(bar, b.x, nloc, nx); b.st[0] = nloc; b.st[1] = nx; }
        const unsigned old = xb_add(&bar[XB_XSUB(b.x)], 1u);
        const unsigned gen = old / nloc;
        if (old + 1u == (gen + 1u) * nloc) {
            __builtin_amdgcn_fence(__ATOMIC_RELEASE, "agent");
            asm volatile("s_waitcnt vmcnt(0)" ::: "memory");
            const unsigned og = xb_add(&bar[XB_TOP], 1u);
            const unsigned tg = og / nx;
            if (og + 1u == (tg + 1u) * nx) xb_add(&bar[XB_TOPGEN], 1u);
            else XB_SPIN(xb_ld(&bar[XB_TOPGEN]) == tg, bar);
            __builtin_amdgcn_fence(__ATOMIC_ACQUIRE, "agent");
            xb_add(&bar[XB_XGEN(b.x)], 1u);
            asm volatile("s_waitcnt vmcnt(0)" ::: "memory");
        } else {
            XB_SPIN(xb_ld(&bar[XB_XGEN(b.x)]) == gen, bar);
            __builtin_amdgcn_fence(__ATOMIC_ACQUIRE, "agent");
            asm volatile("s_waitcnt vmcnt(0)" ::: "memory");
        }
    }
    __syncthreads();
}

struct Fr {
    LAS unsigned char* lds;
    unsigned char* ws;
    const float* const* in;
    float* out;
    int tid, lane, wave, bx, G, gw, NGW;
};

using pg8::Unit;
template <int ACT  > struct EpiStore {
    static constexpr bool PERM = true;
    bf16* O; int ldc; int nvalid;
    DI void operator()(const f32x4 (&acc)[2][2][4][2], const Unit& u, int wr, int wc, int fr, int fq) const {
        const int row0 = u.pm * 256 + wr * 64 + fr, col0 = u.pn * 256 + wc * 32 + 8 * fq;
#pragma unroll
        for (int ai = 0; ai < 2; ++ai)
#pragma unroll
            for (int m = 0; m < 4; ++m) { bf16* rowp = O + (size_t)(row0 + ai * 128 + m * 16) * ldc + col0;
#pragma unroll
                for (int bj = 0; bj < 2; ++bj) { if (u.pn * 256 + bj * 128 >= nvalid) continue;
                    f32x4 v0 = acc[ai][bj][m][0], v1 = acc[ai][bj][m][1];
                    if (ACT == 1) {
#pragma unroll
                        for (int j = 0; j < 4; ++j) { v0[j] = tanhf(v0[j]); v1[j] = tanhf(v1[j]); } }
                    if (ACT == 2) {
#pragma unroll
                        for (int j = 0; j < 4; ++j) { v0[j] = sigmoidf_(v0[j]); v1[j] = sigmoidf_(v1[j]); } }
                    u32x4 w; w.x = pg8::cvt_pk_bf16(v0[0], v0[1]); w.y = pg8::cvt_pk_bf16(v0[2], v0[3]); w.z = pg8::cvt_pk_bf16(v1[0], v1[1]); w.w = pg8::cvt_pk_bf16(v1[2], v1[3]);
                    *(u32x4*)(rowp + bj * 128) = w; } }
    }
};
struct EpiStoreHead {
    static constexpr bool PERM = true;
    bf16* O; int TL; int lat_off;
    DI void operator()(const f32x4 (&acc)[2][2][4][2], const Unit& u, int wr, int wc, int fr, int fq) const {
        const bool lat = u.pm < 64; const int b = lat ? (u.pm >> 3) : (u.pm - 64); const int sbase = lat ? lat_off + (u.pm & 7) * 256 : 0;
        const int rt0 = sbase + wr * 64 + fr, j = (wc & 1) * 32 + 8 * fq;
#pragma unroll
        for (int ai = 0; ai < 2; ++ai)
#pragma unroll
            for (int m = 0; m < 4; ++m)
#pragma unroll
                for (int bj = 0; bj < 2; ++bj) { const int h = 4 * u.pn + 2 * bj + (wc >> 1);
                    const f32x4 v0 = acc[ai][bj][m][0], v1 = acc[ai][bj][m][1];
                    u32x4 w; w.x = pg8::cvt_pk_bf16(v0[0], v0[1]); w.y = pg8::cvt_pk_bf16(v0[2], v0[3]); w.z = pg8::cvt_pk_bf16(v1[0], v1[1]); w.w = pg8::cvt_pk_bf16(v1[2], v1[3]);
                    *(u32x4*)(O + ((size_t)(b * 16 + h) * TL + rt0 + ai * 128 + m * 16) * 64 + j) = w; }
    }
};
struct EpiResid {
    static constexpr bool PERM = false;
    const float* baseL; float* outL; const float* baseC; float* outC; const float* modg;
    DI void operator()(const f32x4 (&acc)[2][2][4][2], const Unit& u, int wr, int wc, int fr, int fq) const {
        const bool lat = u.pm < 64; const int r = lat ? (u.pm >> 3) : 8;
        const float* base = lat ? baseL : baseC; float* out = lat ? outL : outC;
        const int row0 = (lat ? u.pm : u.pm - 64) * 256 + wr * 64 + fr, col0 = u.pn * 256 + wc * 32 + 4 * fq;
        const float* mg = modg + (size_t)r * 6144 + col0;
        f32x4 mv[2][2];
#pragma unroll
        for (int bj = 0; bj < 2; ++bj)
#pragma unroll
            for (int n = 0; n < 2; ++n) mv[bj][n] = *(const f32x4*)(mg + bj * 128 + n * 16);
#pragma unroll
        for (int ai = 0; ai < 2; ++ai)
#pragma unroll
            for (int m = 0; m < 4; ++m) { const size_t off = (size_t)(row0 + ai * 128 + m * 16) * D + col0;
#pragma unroll
                for (int bj = 0; bj < 2; ++bj)
#pragma unroll
                    for (int n = 0; n < 2; ++n) { const f32x4 bs = *(const f32x4*)(base + off + bj * 128 + n * 16);
                        *(f32x4*)(out + off + bj * 128 + n * 16) = bs + mv[bj][n] * acc[ai][bj][m][n]; } }
    }
};
struct EpiSwiglu {
    static constexpr bool PERM = true;
    bf16* Hd; int ldh;
    DI void operator()(const f32x4 (&acc)[2][2][4][2], const Unit& u, int wr, int wc, int fr, int fq) const {
        const int row0 = u.pm * 256 + wr * 64 + fr, col0 = u.pn * 128 + wc * 32 + 8 * fq;
#pragma unroll
        for (int ai = 0; ai < 2; ++ai)
#pragma unroll
            for (int m = 0; m < 4; ++m) { bf16* rowp = Hd + (size_t)(row0 + ai * 128 + m * 16) * ldh + col0;
                f32x4 v0, v1;
#pragma unroll
                for (int j = 0; j < 4; ++j) { v0[j] = siluf_(acc[ai][0][m][0][j]) * acc[ai][1][m][0][j]; v1[j] = siluf_(acc[ai][0][m][1][j]) * acc[ai][1][m][1][j]; }
                u32x4 w; w.x = pg8::cvt_pk_bf16(v0[0], v0[1]); w.y = pg8::cvt_pk_bf16(v0[2], v0[3]); w.z = pg8::cvt_pk_bf16(v1[0], v1[1]); w.w = pg8::cvt_pk_bf16(v1[2], v1[3]);
                *(u32x4*)rowp = w; }
    }
};
struct EpiLora2 {
    static constexpr bool PERM = true;
    float* DEC; bf16* AG; const float* w0; const float* a0;
    DI void operator()(const f32x4 (&acc)[2][2][4][2], const Unit& u, int wr, int wc, int fr, int fq) const {
        const int q = u.pn >> 2, z = q & 1; const int col0 = (u.pn & 3) * 256 + wc * 32 + 8 * fq;
        const bool lat = u.pm < 64; const int b = lat ? (u.pm >> 3) : (u.pm - 64); const int rt0 = (lat ? CTXL + (u.pm & 7) * 256 : 0) + wr * 64 + fr, j = (wc & 1) * 32 + 8 * fq;
        const float* bias = (q < 2 ? w0 : a0) + z * 1024 + col0;
        f32x4 bv[2][2];
#pragma unroll
        for (int bj = 0; bj < 2; ++bj)
#pragma unroll
            for (int n = 0; n < 2; ++n) bv[bj][n] = *(const f32x4*)(bias + bj * 128 + 4 * n);
#pragma unroll
        for (int ai = 0; ai < 2; ++ai)
#pragma unroll
            for (int m = 0; m < 4; ++m) {
#pragma unroll
                for (int bj = 0; bj < 2; ++bj) { f32x4 v0 = acc[ai][bj][m][0] + bv[bj][0], v1 = acc[ai][bj][m][1] + bv[bj][1];
                    const int h = 4 * (u.pn & 3) + 2 * bj + (wc >> 1);
                    const size_t off = ((size_t)(z * 128 + b * 16 + h) * (SEQ + CTXL) + rt0 + ai * 128 + m * 16) * 64 + j;
                    if (q < 2) {
#pragma unroll
                        for (int jj = 0; jj < 4; ++jj) {
                            v0[jj] = -0.6065306597126334f * sigmoidf_(v0[jj]); v1[jj] = -0.6065306597126334f * sigmoidf_(v1[jj]); }
                        *(f32x4*)(DEC + off) = v0; *(f32x4*)(DEC + off + 4) = v1;
                        __builtin_amdgcn_sched_barrier(0);
                    } else {
#pragma unroll
                        for (int jj = 0; jj < 4; ++jj) { v0[jj] = sigmoidf_(v0[jj]); v1[jj] = sigmoidf_(v1[jj]); }
                        u32x4 w; w.x = pg8::cvt_pk_bf16(v0[0], v0[1]); w.y = pg8::cvt_pk_bf16(v0[2], v0[3]); w.z = pg8::cvt_pk_bf16(v1[0], v1[1]); w.w = pg8::cvt_pk_bf16(v1[2], v1[3]);
                        *(u32x4*)(AG + off) = w; __builtin_amdgcn_sched_barrier(0); } } }
    }
};
struct EpiMoeOut {
    static constexpr bool PERM = true;
    bf16* YS; const int* RowTok; const float* RowW;
    DI void operator()(const f32x4 (&acc)[2][2][4][2], const Unit& u, int wr, int wc, int fr, int fq) const {
        const int row0 = u.pm * 256 + wr * 64 + fr, col0 = u.pn * 256 + wc * 32 + 8 * fq;
#pragma unroll
        for (int ai = 0; ai < 2; ++ai)
#pragma unroll
            for (int m = 0; m < 4; ++m) { const int row = row0 + ai * 128 + m * 16; const int t2 = RowTok[row]; if (t2 < 0) continue; const float w = RowW[row];
                bf16* rowp = YS + (size_t)t2 * D + col0;
#pragma unroll
                for (int bj = 0; bj < 2; ++bj) { const f32x4 v0 = acc[ai][bj][m][0] * w, v1 = acc[ai][bj][m][1] * w;
                    u32x4 o; o.x = pg8::cvt_pk_bf16(v0[0], v0[1]); o.y = pg8::cvt_pk_bf16(v0[2], v0[3]); o.z = pg8::cvt_pk_bf16(v1[0], v1[1]); o.w = pg8::cvt_pk_bf16(v1[2], v1[3]);
                    *(u32x4*)(rowp + bj * 128) = o; } }
    }
};

DI void tr_item(const float* src, int ldsrc, int Kreal, int k0, int n0, bf16* dst, int lddst, int drow0, int dcol0, LAS float* scr, int lane) {
#pragma unroll 8
    for (int i = 0; i < 32; ++i) { const int kk = 2 * i + (lane >> 5), k = k0 + kk; float v = 0.f; if (k < Kreal) v = src[(size_t)k * ldsrc + n0 + (lane & 31)]; scr[kk * 33 + (lane & 31)] = v; }
    LDS_WAIT();
    const int c = lane & 7;
#pragma unroll
    for (int j = 0; j < 4; ++j) { const int n = (lane >> 3) + 8 * j; const LAS float* s = scr + (8 * c) * 33 + n;
        u32x4 o; o.x = pk2(s[0 * 33], s[1 * 33]); o.y = pk2(s[2 * 33], s[3 * 33]); o.z = pk2(s[4 * 33], s[5 * 33]); o.w = pk2(s[6 * 33], s[7 * 33]);
        *(u32x4*)(dst + (size_t)(drow0 + n) * lddst + dcol0 + k0 + 8 * c) = o; }
    LDS_WAIT();
}
DI void tr_plain(const float* src, int K, int N, bf16* dst, int r, LAS float* scr, int lane) {
    const int nblk = N / 32, kb = r / nblk, nb = r % nblk; tr_item(src, N, K, 64 * kb, 32 * nb, dst, K, 32 * nb, 0, scr, lane);
}
DI void tr_gateup(const float* src, int K, int Hh, bf16* dst, int r, LAS float* scr, int lane) {
    const int nblk = 2 * Hh / 32, kb = r / nblk, nb = r % nblk, n0 = 32 * nb, half = n0 / Hh, j0 = n0 % Hh;
    tr_item(src, 2 * Hh, K, 64 * kb, n0, dst, K, (j0 / 128) * 256 + half * 128 + (j0 % 128), 0, scr, lane);
}
DI void tr16_item(const float* src, int ldsrc, int k0, int n0, bf16* dst, int lddst, int Hh, int lane) {
    f32x4 v[16];
#pragma unroll
    for (int kk = 0; kk < 16; ++kk) v[kk] = *(const f32x4*)(src + (size_t)(k0 + kk) * ldsrc + n0 + 4 * lane);
    const int n = n0 + 4 * lane; int drow = n;
    if (Hh) { const int half = n / Hh, j = n % Hh; drow = (j / 128) * 256 + half * 128 + (j % 128); }
#pragma unroll
    for (int q = 0; q < 4; ++q) { u32x4 o0, o1;
        o0.x = pk2(v[0][q], v[1][q]); o0.y = pk2(v[2][q], v[3][q]); o0.z = pk2(v[4][q], v[5][q]); o0.w = pk2(v[6][q], v[7][q]);
        o1.x = pk2(v[8][q], v[9][q]); o1.y = pk2(v[10][q], v[11][q]); o1.z = pk2(v[12][q], v[13][q]); o1.w = pk2(v[14][q], v[15][q]);
        bf16* d = dst + (size_t)(drow + q) * lddst + k0; *(u32x4*)d = o0; *(u32x4*)(d + 8) = o1; }
}
DI void tr64_item(const float* src, int ldsrc, int k0, int n0, bf16* dst, int lddst, int Hh, int lane) {
    float v[64];
    const float* sp = src + (size_t)k0 * ldsrc + n0 + lane;
#pragma unroll
    for (int kk = 0; kk < 64; ++kk) v[kk] = sp[(size_t)kk * ldsrc];
    const int n = n0 + lane; int drow = n;
    if (Hh) { const int half = n / Hh, j = n % Hh; drow = (j / 128) * 256 + half * 128 + (j % 128); }
    bf16* d = dst + (size_t)drow * lddst + k0;
#pragma unroll
    for (int c = 0; c < 8; ++c) { u32x4 o; o.x = pk2(v[8 * c], v[8 * c + 1]); o.y = pk2(v[8 * c + 2], v[8 * c + 3]); o.z = pk2(v[8 * c + 4], v[8 * c + 5]); o.w = pk2(v[8 * c + 6], v[8 * c + 7]);
        *(u32x4*)(d + 8 * c) = o; }
}
DI void tr16_mat(const float* src, int K, int N, bf16* dst, int Hh, int r, int lane) { const int nb = N / 64; tr64_item(src, N, 64 * (r / nb), 64 * (r % nb), dst, K, Hh, lane); }
constexpr int MOE_B13 = 16 * 112, MOE_B2 = 56 * 16, MOE_ITEMS = 8 * MOE_B13 + 8 * MOE_B2;
DI void moe_fill(Fr& F, int slot, int nslots, int i0, int i1) {
    if (slot < 0 || slot >= nslots) return;
    bf16* W_M13 = (bf16*)(F.ws + WS_W_M13); bf16* W_M2 = (bf16*)(F.ws + WS_W_M2);
    for (int r = i0 + slot * NWAVES + F.wave; r < i1; r += nslots * NWAVES) {
        if (r < 8 * MOE_B13) { const int e = r / MOE_B13; tr16_mat(F.in[35] + (size_t)e * 1024 * 7168, 1024, 7168, W_M13 + (size_t)e * 7168 * 1024, EXP_H, r % MOE_B13, F.lane); }
        else { const int r2 = r - 8 * MOE_B13, e = r2 / MOE_B2; tr16_mat(F.in[36] + (size_t)e * EXP_H * 1024, EXP_H, 1024, W_M2 + (size_t)e * 1024 * EXP_H, 0, r2 % MOE_B2, F.lane); }
    }
}
DI void p0_prologue(Fr& F) {
    LAS float* scr = (LAS float*)(F.lds + F.wave * 16384);
    const float* const* in = F.in;
    bf16* W_IN = (bf16*)(F.ws + WS_W_IN); bf16* W_OUT = (bf16*)(F.ws + WS_W_OUT); bf16* W_13 = (bf16*)(F.ws + WS_W_13); bf16* W_2 = (bf16*)(F.ws + WS_W_2);
    bf16* W_RKV = (bf16*)(F.ws + WS_W_RKV); bf16* W_L1 = (bf16*)(F.ws + WS_W_L1); bf16* W_L2 = (bf16*)(F.ws + WS_W_L2); bf16* W_G2 = (bf16*)(F.ws + WS_W_G2);
    bf16* W_O = (bf16*)(F.ws + WS_W_O);
    for (int prep_ = 0; prep_ < ((((PROBE_DUP) >> 21) & 1u) ? 2 : 1); ++prep_) {
        constexpr int B_IN = 16 * 56, B_OUT = 16 * 16, B_13 = 16 * 88, B_2 = 44 * 16, B_RKV = 256, B_O = 256;
        constexpr int NB_ITEMS = B_IN + B_OUT + B_13 + B_2 + 3 * B_RKV + B_O;
        for (int it = F.gw; it < NB_ITEMS; it += F.NGW) {
            int r = it;
            if (r < B_IN) { tr16_mat(in[8], 1024, INW, W_IN, 0, r, F.lane); continue; } r -= B_IN;
            if (r < B_OUT) { tr16_mat(in[15], 1024, 1024, W_OUT, 0, r, F.lane); continue; } r -= B_OUT;
            if (r < B_13) { tr16_mat(in[16], 1024, 2 * FFN_H, W_13, FFN_H, r, F.lane); continue; } r -= B_13;
            if (r < B_2) { tr16_mat(in[17], FFN_H, 1024, W_2, 0, r, F.lane); continue; } r -= B_2;
            if (r < 3 * B_RKV) { const int sx = r / B_RKV; tr16_mat(in[19] + (size_t)sx * 1024 * 1024, 1024, 1024, W_RKV + (size_t)sx * 1024 * 1024, 0, r % B_RKV, F.lane); continue; } r -= 3 * B_RKV;
            tr16_mat(in[33], 1024, 1024, W_O, 0, r, F.lane);
        }
    }
    constexpr int I_W1 = 2 * 32, I_A1 = 2 * 32, I_G1 = 16 * 5, I_L2 = 4 * 32, I_G2 = 4 * 32;
    constexpr int NITEMS = I_W1 + I_A1 + I_G1 + I_L2 + I_G2;
    for (int it = F.gw; it < NITEMS; it += F.NGW) {
        int r = it;
        if (r < I_W1) { const int z = r / 32, rr = r % 32; tr_item(in[21] + (size_t)z * 1024 * 64, 64, 1024, 64 * (rr / 2), 32 * (rr % 2), W_L1, 1024, z * 64 + 32 * (rr % 2), 0, scr, F.lane); continue; } r -= I_W1;
        if (r < I_A1) { const int z = r / 32, rr = r % 32; tr_item(in[24] + (size_t)z * 1024 * 64, 64, 1024, 64 * (rr / 2), 32 * (rr % 2), W_L1 + 256 * 1024, 1024, z * 64 + 32 * (rr % 2), 0, scr, F.lane); continue; } r -= I_A1;
        if (r < I_G1) { tr_item(in[26], 160, 1024, 64 * (r / 5), 32 * (r % 5), W_L1 + 2 * 256 * 1024, 1024, 32 * (r % 5), 0, scr, F.lane); continue; } r -= I_G1;
        if (r < I_L2) { const int q = r / 32, nb = r % 32; const float* src = (q < 2 ? in[22] : in[25]) + (size_t)(q & 1) * 64 * 1024;
            for (int i = F.lane; i < 32 * 24; i += 64) { const int row = i / 24, ch = i % 24; const int col = 8 * ch + (8 * ch >= q * 64 ? 64 : 0);
                *(u32x4*)(W_L2 + (size_t)(q * 1024 + 32 * nb + row) * 256 + col) = (u32x4){0u, 0u, 0u, 0u}; }
            tr_item(src, 1024, 64, 0, 32 * nb, W_L2, 256, q * 1024 + 32 * nb, q * 64, scr, F.lane); continue; } r -= I_L2;
        tr_item(in[27], 1024, 160, 64 * (r / 32), 32 * (r % 32), W_G2, 256, 32 * (r % 32), 0, scr, F.lane);
    }
    { const int gt = F.bx * NTHR + F.tid, NT = F.G * NTHR;
      for (int i = gt; i < (128 + 128 + 96) * 128; i += NT) { int row = i / 128; const int ch = i % 128; int mat = 0;
          if (row >= 256) { mat = 2; row = row - 256 + 160; } else if (row >= 128) { mat = 1; } else { row += 128; }
          *(u32x4*)(W_L1 + ((size_t)mat * 256 + row) * 1024 + 8 * ch) = (u32x4){0u, 0u, 0u, 0u}; }
      f32x2* rope = (f32x2*)(F.ws + WS_ROPE);
      for (int i = gt; i < 2048; i += NT) { const int pos = i >> 5, j = i & 31; const float fr = powf(10000.f, -(float)j / 32.f), ang = (float)pos * fr; rope[i] = (f32x2){cosf(ang), sinf(ang)}; }
    }
    WG_SYNC();
    for (int prep_ = 0; prep_ < ((((PROBE_DUP) >> 23) & 1u) ? 2 : 1); ++prep_)
    for (int u = F.bx; u < 192; u += F.G) {
        const int li = u / 96, n0 = (u % 96) * 64;
        LAS float* sm = (LAS float*)F.lds;
        for (int idx = F.tid; idx < 9 * 1024; idx += NTHR) { const int r = idx >> 10, k = idx & 1023; const float cv = (r < 8) ? in[1][r * 1024 + k] : in[3][k]; sm[idx] = cv / (1.f + expf(-cv)); }
        WG_SYNC();
        const int ks = F.tid >> 4, cg4 = F.tid & 15;
        f32x4 acc[9];
#pragma unroll
        for (int r = 0; r < 9; ++r) acc[r] = (f32x4){0.f, 0.f, 0.f, 0.f};
        const float* w = in[4] + (size_t)li * 1024 * 6144 + n0 + 4 * cg4;
#pragma unroll 8
        for (int k = ks * 32; k < ks * 32 + 32; ++k) { const f32x4 wv = *(const f32x4*)(w + (size_t)k * 6144);
#pragma unroll
            for (int r = 0; r < 9; ++r) acc[r] += wv * sm[r * 1024 + k]; }
        LAS float* red = sm + 9 * 1024;
#pragma unroll
        for (int r = 0; r < 9; ++r) *(LAS f32x4*)(red + (ks * 9 + r) * 64 + 4 * cg4) = acc[r];
        WG_SYNC();
        float* MOD = (float*)(F.ws + WS_MOD);
        for (int idx = F.tid; idx < 9 * 64; idx += NTHR) { const int r = idx / 64, n2 = idx % 64; float s = 0.f;
#pragma unroll
            for (int q = 0; q < 32; ++q) s += red[(q * 9 + r) * 64 + n2];
            MOD[((size_t)li * 9 + r) * 6144 + n0 + n2] = s + in[5][li * 6144 + n0 + n2]; }
        WG_SYNC();
    }
}

DI void mod_rows(Fr& F, const float* xl, const float* xc, int nrows, const float* normw, const float* modl, int off_shift, int off_scale, bf16* H) {
    for (int row = F.gw; row < nrows; row += F.NGW) {
        const float* src = row < ML ? xl + (size_t)row * D : xc + (size_t)(row - ML) * D;
        const float* mrow = modl + (size_t)(row < ML ? row / SEQ : 8) * 6144;
        f32x4 v[4]; float ss = 0.f;
#pragma unroll
        for (int j = 0; j < 4; ++j) { v[j] = ((const f32x4*)src)[F.lane + 64 * j]; ss += (v[j].x * v[j].x + v[j].y * v[j].y) + (v[j].z * v[j].z + v[j].w * v[j].w); }
        const float rstd = rsqrtf(wave_sum(ss) * (1.f / D) + 1e-6f);
        u32x2* o = (u32x2*)(H + (size_t)row * D);
#pragma unroll
        for (int j = 0; j < 4; ++j) { const int c4 = F.lane + 64 * j;
            const f32x4 w = ((const f32x4*)normw)[c4], sc = ((const f32x4*)(mrow + off_scale))[c4], sh = ((const f32x4*)(mrow + off_shift))[c4];
            const f32x4 y = v[j] * rstd * w * (sc + 1.f) + sh;
            u32x2 p; p.x = pk2(y.x, y.y); p.y = pk2(y.z, y.w); o[c4] = p; }
    }
}

DI void load_rope_pair(const bf16* rowp, int hh, int jj, bool lat, int rpos, int cpos, const f32x2* rope, float scl, float (&x1)[8], float (&x2)[8]) {
    const u32x4 a = *(const u32x4*)(rowp + hh * 64 + jj), b = *(const u32x4*)(rowp + hh * 64 + jj + 32);
    const unsigned aw[4] = {a.x, a.y, a.z, a.w}, bw[4] = {b.x, b.y, b.z, b.w};
#pragma unroll
    for (int i = 0; i < 4; ++i) { x1[2 * i] = bflo(aw[i]); x1[2 * i + 1] = bfhi(aw[i]); x2[2 * i] = bflo(bw[i]); x2[2 * i + 1] = bfhi(bw[i]); }
    if (lat) { const int pos = hh ? cpos : rpos;
#pragma unroll
        for (int i = 0; i < 8; ++i) { const f32x2 cs = rope[pos * 32 + jj + i]; const float y1 = x1[i] * cs.x - x2[i] * cs.y, y2 = x1[i] * cs.y + x2[i] * cs.x; x1[i] = y1; x2[i] = y2; } }
#pragma unroll
    for (int i = 0; i < 8; ++i) { x1[i] *= scl; x2[i] *= scl; }
}
DI u32x4 pack8(const float (&x)[8], float s) { u32x4 o; o.x = pk2(x[0] * s, x[1] * s); o.y = pk2(x[2] * s, x[3] * s); o.z = pk2(x[4] * s, x[5] * s); o.w = pk2(x[6] * s, x[7] * s); return o; }
constexpr int RLD = 136;
constexpr int RTILE = 128 * RLD * 2;
DI int ret_row0(int b, int id) { return id < 2 ? ML + b * CTXL + id * 128 : b * SEQ + (id - 2) * 128; }

DI void ret_kv_phase(Fr& F) {
    const bf16* QKV = (const bf16*)(F.ws + WS_QKV); float* KV = (float*)(F.ws + WS_KV); const f32x2* rope = (const f32x2*)(F.ws + WS_ROPE);
    LAS bf16* Vs = (LAS bf16*)F.lds; LAS bf16* Kf = (LAS bf16*)(F.lds + RTILE); LAS bf16* Kb = (LAS bf16*)(F.lds + 2 * RTILE);
    const int wr2 = F.wave >> 1, wc2 = F.wave & 1, fr = F.lane & 15, fq = F.lane >> 4;
    for (int u = F.bx; u < NB * 4 * NCH; u += F.G) {
        const int b = u / (4 * NCH), h = (u / NCH) % 4, id = u % NCH; const int grow0 = ret_row0(b, id); const bool lat = id >= 2;
        const float lgf = -expf(F.in[9][h]), lgb = -expf(F.in[10][h]);
        for (int it = F.tid; it < 128 * 16; it += NTHR) { const int c = it >> 4, ch = it & 15;
            *(LAS u32x4*)(Vs + c * RLD + 8 * ch) = *(const u32x4*)(QKV + (size_t)(grow0 + c) * INW + 1024 + h * 128 + 8 * ch); }
        for (int it = F.tid; it < 128 * 8; it += NTHR) { const int c = it >> 3, pi = it & 7, hh = pi >> 2, jj = (pi & 3) * 8; const int t = (id - 2) * 128 + c;
            float x1[8], x2[8]; load_rope_pair(QKV + (size_t)(grow0 + c) * INW + 512 + h * 128, hh, jj, lat, t >> 6, t & 63, rope, 0.08838834764831845f, x1, x2);
            const float wf = __expf(lgf * (float)(127 - c)), wb = __expf(lgb * (float)c);
            *(LAS u32x4*)(Kf + c * RLD + hh * 64 + jj) = pack8(x1, wf); *(LAS u32x4*)(Kf + c * RLD + hh * 64 + jj + 32) = pack8(x2, wf);
            *(LAS u32x4*)(Kb + c * RLD + hh * 64 + jj) = pack8(x1, wb); *(LAS u32x4*)(Kb + c * RLD + hh * 64 + jj + 32) = pack8(x2, wb); }
        LDS_BARRIER();
#pragma unroll
        for (int dir = 0; dir < 2; ++dir) {
            const LAS bf16* Kd = dir ? Kb : Kf;
            f32x4 acc[2][4];
#pragma unroll
            for (int i = 0; i < 2; ++i)
#pragma unroll
                for (int j = 0; j < 4; ++j) acc[i][j] = (f32x4){0.f, 0.f, 0.f, 0.f};
#pragma unroll 1
            for (int k0 = 0; k0 < 128; k0 += 32) { bf16x8 af[2], bfg[4];
#pragma unroll
                for (int i = 0; i < 2; ++i) af[i] = frag_kr(Vs, RLD, 32 * wr2 + 16 * i, k0, F.lane);
#pragma unroll
                for (int j = 0; j < 4; ++j) bfg[j] = frag_kr(Kd, RLD, 64 * wc2 + 16 * j, k0, F.lane);
#pragma unroll
                for (int i = 0; i < 2; ++i)
#pragma unroll
                    for (int j = 0; j < 4; ++j) acc[i][j] = mma(acc[i][j], bfg[j], af[i]); }
            float* o = KV + ((size_t)((b * 4 + h) * 2 + dir) * NCH + id) * 16384;
#pragma unroll
            for (int i = 0; i < 2; ++i)
#pragma unroll
                for (int j = 0; j < 4; ++j) *(f32x4*)(o + (32 * wr2 + 16 * i + fr) * 128 + 64 * wc2 + 16 * j + 4 * fq) = acc[i][j];
        }
        LDS_BARRIER();
    }
}
DI void ret_prefix_phase(Fr& F) {
    const float* KV = (const float*)(F.ws + WS_KV); bf16* SP = (bf16*)(F.ws + WS_SPREV);
    const int gt = F.bx * NTHR + F.tid, NT = F.G * NTHR;
    for (int i = gt; i < 64 * 4096; i += NT) { const int bhd = i >> 12, e4 = i & 4095, dir = bhd & 1, h = (bhd >> 1) & 3;
        const float lg = -expf(dir ? F.in[10][h] : F.in[9][h]), cd = expf(lg * 128.f);
        f32x4 s = (f32x4){0.f, 0.f, 0.f, 0.f};
        for (int st = 0; st < NCH; ++st) { const int id = dir ? (st == 0 ? 1 : (st == 1 ? 0 : 19 - st)) : st;
            const size_t off = ((size_t)bhd * NCH + id) * 16384 + 4 * e4;
            u32x2 p; p.x = pk2(s.x, s.y); p.y = pk2(s.z, s.w); *(u32x2*)(SP + off) = p;
            s = s * cd + *(const f32x4*)(KV + off); }
    }
}
DI void ret_out_phase(Fr& F) {
    const bf16* QKV = (const bf16*)(F.ws + WS_QKV); const bf16* SP = (const bf16*)(F.ws + WS_SPREV); bf16* MIX = (bf16*)(F.ws + WS_MIX); const f32x2* rope = (const f32x2*)(F.ws + WS_ROPE);
    LAS bf16* Qs = (LAS bf16*)F.lds; LAS bf16* KP = (LAS bf16*)(F.lds + RTILE); LAS bf16* Vs = (LAS bf16*)(F.lds + 2 * RTILE); LAS bf16* Sf = (LAS bf16*)(F.lds + 3 * RTILE);
    LAS float* red = (LAS float*)(F.lds + 4 * RTILE);
    const int wr2 = F.wave >> 1, wc2 = F.wave & 1, fr = F.lane & 15, fq = F.lane >> 4;
    for (int u = F.bx; u < NB * 4 * NCH; u += F.G) {
        const int b = u / (4 * NCH), h = (u / NCH) % 4, id = u % NCH; const int grow0 = ret_row0(b, id); const bool lat = id >= 2;
        const float lgf = -expf(F.in[9][h]), lgb = -expf(F.in[10][h]);
        const bf16* spf = SP + ((size_t)((b * 4 + h) * 2 + 0) * NCH + id) * 16384; const bf16* spb = SP + ((size_t)((b * 4 + h) * 2 + 1) * NCH + id) * 16384;
        for (int it = F.tid; it < 128 * 16; it += NTHR) { const int c = it >> 4, ch = it & 15;
            *(LAS u32x4*)(Vs + c * RLD + 8 * ch) = *(const u32x4*)(QKV + (size_t)(grow0 + c) * INW + 1024 + h * 128 + 8 * ch);
            *(LAS u32x4*)(Sf + c * RLD + 8 * ch) = *(const u32x4*)(spf + c * 128 + 8 * ch); }
        for (int it = F.tid; it < 128 * 8; it += NTHR) { const int c = it >> 3, pi = it & 7, hh = pi >> 2, jj = (pi & 3) * 8; const int t = (id - 2) * 128 + c;
            float x1[8], x2[8];
            load_rope_pair(QKV + (size_t)(grow0 + c) * INW + h * 128, hh, jj, lat, t >> 6, t & 63, rope, 1.f, x1, x2);
            *(LAS u32x4*)(Qs + c * RLD + hh * 64 + jj) = pack8(x1, 1.f); *(LAS u32x4*)(Qs + c * RLD + hh * 64 + jj + 32) = pack8(x2, 1.f);
            load_rope_pair(QKV + (size_t)(grow0 + c) * INW + 512 + h * 128, hh, jj, lat, t >> 6, t & 63, rope, 0.08838834764831845f, x1, x2);
            *(LAS u32x4*)(KP + c * RLD + hh * 64 + jj) = pack8(x1, 1.f); *(LAS u32x4*)(KP + c * RLD + hh * 64 + jj + 32) = pack8(x2, 1.f); }
        LDS_BARRIER();
        f32x4 sacc[2][4], facc[2][4];
#pragma unroll
        for (int i = 0; i < 2; ++i)
#pragma unroll
            for (int j = 0; j < 4; ++j) { sacc[i][j] = (f32x4){0.f, 0.f, 0.f, 0.f}; facc[i][j] = (f32x4){0.f, 0.f, 0.f, 0.f}; }
#pragma unroll 1
        for (int k0 = 0; k0 < 128; k0 += 32) { bf16x8 af[2], bk[4], bs[4];
#pragma unroll
            for (int i = 0; i < 2; ++i) af[i] = frag_kc(Qs, RLD, 32 * wr2 + 16 * i, k0, F.lane);
#pragma unroll
            for (int j = 0; j < 4; ++j) { bk[j] = frag_kc(KP, RLD, 64 * wc2 + 16 * j, k0, F.lane); bs[j] = frag_kc(Sf, RLD, 64 * wc2 + 16 * j, k0, F.lane); }
#pragma unroll
            for (int i = 0; i < 2; ++i)
#pragma unroll
                for (int j = 0; j < 4; ++j) { sacc[i][j] = mma(sacc[i][j], bk[j], af[i]); facc[i][j] = mma(facc[i][j], bs[j], af[i]); } }
        LDS_BARRIER();
        { const float lf2 = lgf * 1.4426950408889634f, lb2 = lgb * 1.4426950408889634f;
#pragma unroll
          for (int i = 0; i < 2; ++i)
#pragma unroll
            for (int j = 0; j < 4; ++j) { const int c = 32 * wr2 + 16 * i + fr, s0 = 64 * wc2 + 16 * j + 4 * fq; float pv[4];
#pragma unroll
                for (int r = 0; r < 4; ++r) { const int df = c - (s0 + r); const float wgt = df > 0 ? exp2f(lf2 * (float)df) : (df < 0 ? exp2f(lb2 * (float)(-df)) : 2.f); pv[r] = sacc[i][j][r] * wgt; }
                u32x2 p; p.x = pk2(pv[0], pv[1]); p.y = pk2(pv[2], pv[3]); *(LAS u32x2*)(KP + c * RLD + s0) = p; }
          for (int it = F.tid; it < 128 * 16; it += NTHR) { const int c = it >> 4, ch = it & 15; *(LAS u32x4*)(Sf + c * RLD + 8 * ch) = *(const u32x4*)(spb + c * 128 + 8 * ch); }
        }
        LDS_BARRIER();
        f32x4 oacc[2][4], bacc[2][4];
#pragma unroll
        for (int i = 0; i < 2; ++i) { const float qdf = __expf(lgf * (float)(32 * wr2 + 16 * i + fr + 1));
#pragma unroll
            for (int j = 0; j < 4; ++j) { oacc[i][j] = facc[i][j] * qdf; bacc[i][j] = (f32x4){0.f, 0.f, 0.f, 0.f}; } }
#pragma unroll 1
        for (int k0 = 0; k0 < 128; k0 += 32) { bf16x8 ap[2], aq[2], bv[4], bs[4];
#pragma unroll
            for (int i = 0; i < 2; ++i) { ap[i] = frag_kc(KP, RLD, 32 * wr2 + 16 * i, k0, F.lane); aq[i] = frag_kc(Qs, RLD, 32 * wr2 + 16 * i, k0, F.lane); }
#pragma unroll
            for (int j = 0; j < 4; ++j) { bv[j] = frag_kr(Vs, RLD, 64 * wc2 + 16 * j, k0, F.lane); bs[j] = frag_kc(Sf, RLD, 64 * wc2 + 16 * j, k0, F.lane); }
#pragma unroll
            for (int i = 0; i < 2; ++i)
#pragma unroll
                for (int j = 0; j < 4; ++j) { oacc[i][j] = mma(oacc[i][j], bv[j], ap[i]); bacc[i][j] = mma(bacc[i][j], bs[j], aq[i]); } }
        float rs[2], rq[2];
#pragma unroll
        for (int i = 0; i < 2; ++i) { const int c = 32 * wr2 + 16 * i + fr; const float qdb = __expf(lgb * (float)(128 - c)); float s = 0.f, q = 0.f;
#pragma unroll
            for (int j = 0; j < 4; ++j) { oacc[i][j] = oacc[i][j] + bacc[i][j] * qdb;
#pragma unroll
                for (int r = 0; r < 4; ++r) { s += oacc[i][j][r]; q += oacc[i][j][r] * oacc[i][j][r]; } }
            s += __shfl_xor(s, 16); s += __shfl_xor(s, 32); q += __shfl_xor(q, 16); q += __shfl_xor(q, 32);
            if (fq == 0) { red[(c * 2 + wc2) * 2 + 0] = s; red[(c * 2 + wc2) * 2 + 1] = q; }
            rs[i] = s; rq[i] = q; }
        LDS_BARRIER();
#pragma unroll
        for (int i = 0; i < 2; ++i) { const int c = 32 * wr2 + 16 * i + fr;
            const float s = red[(c * 2 + 0) * 2 + 0] + red[(c * 2 + 1) * 2 + 0], q = red[(c * 2 + 0) * 2 + 1] + red[(c * 2 + 1) * 2 + 1];
            const float mean = s * (1.f / 128.f), var = fmaxf(q * (1.f / 128.f) - mean * mean, 0.f), rstd = rsqrtf(var + 1e-5f);
            const size_t grow = (size_t)(grow0 + c);
#pragma unroll
            for (int j = 0; j < 4; ++j) { const int e0 = 64 * wc2 + 16 * j + 4 * fq;
                const f32x4 gw = *(const f32x4*)(F.in[11] + h * 128 + e0); const u32x2 gg = *(const u32x2*)(QKV + grow * INW + 1536 + h * 128 + e0);
                const float g0 = bflo(gg.x), g1 = bfhi(gg.x), g2 = bflo(gg.y), g3 = bfhi(gg.y);
                const f32x4 y = (oacc[i][j] - mean) * rstd * gw;
                u32x2 p; p.x = pk2(y.x * siluf_(g0), y.y * siluf_(g1)); p.y = pk2(y.z * siluf_(g2), y.w * siluf_(g3));
                *(u32x2*)(MIX + grow * D + h * 128 + e0) = p; } }
        (void)rs; (void)rq;
        LDS_BARRIER();
    }
}

DI void na_norm_rows(Fr& F) {
    const bf16* QKV = (const bf16*)(F.ws + WS_QKV); bf16* NQ = (bf16*)(F.ws + WS_NQ); bf16* NK = (bf16*)(F.ws + WS_NK); bf16* NV = (bf16*)(F.ws + WS_NV);
    const bool isk = F.lane >= 32; const float* wsrc = (isk ? F.in[13] : F.in[12]) + (F.lane & 3) * 16; const float scl = isk ? 1.f : 0.125f;
    const int head = (F.lane & 31) >> 2, j0 = (F.lane & 3) * 16;
    float wv[16];
#pragma unroll
    for (int i = 0; i < 16; ++i) wv[i] = wsrc[i] * scl;
    for (int row = F.gw; row < MA; row += F.NGW) {
        const bool lat = row < ML; const int b = lat ? row / SEQ : (row - ML) / CTXL, sr = lat ? CTXL + row % SEQ : (row - ML) % CTXL;
        const size_t ho = ((size_t)(b * 8 + head) * (SEQ + CTXL) + sr) * 64 + j0;
        const bf16* p = QKV + (size_t)row * INW + 2048 + 16 * F.lane;
        const u32x4 a = *(const u32x4*)p, b2 = *(const u32x4*)(p + 8); const unsigned w[8] = {a.x, a.y, a.z, a.w, b2.x, b2.y, b2.z, b2.w}; float x[16]; float ss = 0.f;
#pragma unroll
        for (int i = 0; i < 8; ++i) { x[2 * i] = bflo(w[i]); x[2 * i + 1] = bfhi(w[i]); ss += x[2 * i] * x[2 * i] + x[2 * i + 1] * x[2 * i + 1]; }
        const float rinv = rsqrtf(red4(ss) * (1.f / 64.f) + 1e-6f);
        u32x4 o0, o1;
        o0.x = pk2(x[0] * rinv * wv[0], x[1] * rinv * wv[1]); o0.y = pk2(x[2] * rinv * wv[2], x[3] * rinv * wv[3]); o0.z = pk2(x[4] * rinv * wv[4], x[5] * rinv * wv[5]); o0.w = pk2(x[6] * rinv * wv[6], x[7] * rinv * wv[7]);
        o1.x = pk2(x[8] * rinv * wv[8], x[9] * rinv * wv[9]); o1.y = pk2(x[10] * rinv * wv[10], x[11] * rinv * wv[11]); o1.z = pk2(x[12] * rinv * wv[12], x[13] * rinv * wv[13]); o1.w = pk2(x[14] * rinv * wv[14], x[15] * rinv * wv[15]);
        bf16* d = (isk ? NK : NQ) + ho; *(u32x4*)d = o0; *(u32x4*)(d + 8) = o1;
        if (!isk) { const bf16* pv = QKV + (size_t)row * INW + 3072 + 16 * F.lane; const u32x4 v0 = *(const u32x4*)pv, v1 = *(const u32x4*)(pv + 8); *(u32x4*)(NV + ho) = v0; *(u32x4*)(NV + ho + 8) = v1; }
    }
}
constexpr int NLD = 72;
DI void na_phase(Fr& F) {
    const bf16* NQ = (const bf16*)(F.ws + WS_NQ); const bf16* NK = (const bf16*)(F.ws + WS_NK); const bf16* NV = (const bf16*)(F.ws + WS_NV); bf16* MIX = (bf16*)(F.ws + WS_MIX);
    LAS bf16* Ks = (LAS bf16*)F.lds;
    LAS bf16* Vs = (LAS bf16*)(F.lds + 36864);
    LAS bf16* Pw = (LAS bf16*)(F.lds + 2 * 36864) + F.wave * (32 * NLD);
    LAS float* rpbs = (LAS float*)(F.lds + 2 * 36864 + 8 * 4608);
    const int fr = F.lane & 15, fq = F.lane >> 4;
    float bound;
    { float mqw = fabsf(F.in[12][F.lane]), mkw = fabsf(F.in[13][F.lane]), mb = 0.f;
      for (int i = F.lane; i < 8 * 15 * 31; i += 64) mb = fmaxf(mb, fabsf(F.in[14][i]));
      bound = 8.f * wave_max(mqw) * wave_max(mkw) + wave_max(mb); }
    for (int u = F.bx; u < 512 + 64; u += F.G) {
        int b, head, r = -1, cb = 0, qtok0, kb_lo = 0, nwin = 0;
        if (u < 512) { const int bh = ((u >> 6) << 3) + (u & 7), qb = (u >> 3) & 7; b = bh >> 3; head = bh & 7;
            r = 4 * qb + (F.wave >> 1); cb = 32 * (F.wave & 1); qtok0 = b * SEQ + r * 64 + cb;
            const int r0lo = min(max(4 * qb - 4, 0), 24), r0hi = min(max(4 * qb - 1, 0), 24); kb_lo = r0lo >> 2; nwin = ((r0hi + 7) >> 2) - kb_lo + 1; }
        else { const int cu = u - 512; b = cu >> 3; head = cu & 7; qtok0 = ML + b * CTXL + 32 * F.wave; }
        const int r0 = min(max(r - 4, 0), 24);
        const size_t hb = (size_t)(b * 8 + head) * (SEQ + CTXL); const int qseq = u < 512 ? CTXL + r * 64 + cb : 32 * F.wave;
        bf16x8 aq[2][2];
#pragma unroll
        for (int mt = 0; mt < 2; ++mt)
#pragma unroll
            for (int ks = 0; ks < 2; ++ks) aq[mt][ks] = *(const bf16x8*)(NQ + (hb + qseq + 16 * mt + fr) * 64 + 32 * ks + 8 * fq);
        if (u < 512) for (int i = F.tid; i < 15 * 32; i += NTHR) { const int ro = i >> 5, co = i & 31; rpbs[i] = co < 31 ? F.in[14][head * 465 + ro * 31 + co] - bound : -1.0e30f; }
        int boff[2][4][4]; int nlo[2], nhi[2];
#pragma unroll
        for (int mt = 0; mt < 2; ++mt) { const int cs = cb + 16 * mt, c = cs + fr, c0 = min(max(c - 8, 0), 48);
            nlo[mt] = max(cs - 8, 0) >> 4; nhi[mt] = (min(cs + 7, 48) + 15) >> 4;
#pragma unroll
            for (int nt = 0; nt < 4; ++nt)
#pragma unroll
                for (int i = 0; i < 4; ++i) { const int kc = 16 * nt + 4 * fq + i; boff[mt][nt][i] = ((kc >= c0) && (kc < c0 + 16)) ? (kc - c + 15) : 31; } }
        f32x4 oacc[2][4]; float lsum[2] = {0.f, 0.f};
#pragma unroll
        for (int mt = 0; mt < 2; ++mt)
#pragma unroll
            for (int j = 0; j < 4; ++j) oacc[mt][j] = (f32x4){0.f, 0.f, 0.f, 0.f};
        u32x4 kst[4], vst[4];
#define NA_LOAD(bi_) do { const int kbase_ = (bi_) < nwin ? CTXL + 256 * (kb_lo + (bi_)) : 0; _Pragma("unroll") for (int it_ = 0; it_ < 4; ++it_) { const size_t o_ = (hb + kbase_ + (F.tid >> 3) + 64 * it_) * 64 + 8 * (F.tid & 7); \
            kst[it_] = *(const u32x4*)(NK + o_); vst[it_] = *(const u32x4*)(NV + o_); } } while (0)
        NA_LOAD(0);
        for (int bi = 0; bi <= nwin; ++bi) {
            const bool is_ctx = bi == nwin;
#pragma unroll
            for (int it = 0; it < 4; ++it) { const int krow = (F.tid >> 3) + 64 * it, c8 = F.tid & 7;
                *(LAS u32x4*)(Ks + krow * NLD + 8 * c8) = kst[it]; *(LAS u32x4*)(Vs + krow * NLD + 8 * c8) = vst[it]; }
            LDS_BARRIER();
            if (bi < nwin) NA_LOAD(bi + 1);
            if ((((PROBE_DUP) >> 30) & 1u) && bi < nwin) { asm volatile("" ::: "memory"); NA_LOAD(bi + 1); }
            f32x4 osv[2][4]; float lsv[2];
#pragma unroll
            for (int mt = 0; mt < 2; ++mt) { lsv[mt] = lsum[mt];
#pragma unroll
                for (int j = 0; j < 4; ++j) osv[mt][j] = oacc[mt][j]; }
            for (int pdc_ = 0; pdc_ < ((((PROBE_DUP) >> 31) & 1u) ? 2 : 1); ++pdc_) {
            if (pdc_ == 1) {
#pragma unroll
                for (int mt = 0; mt < 2; ++mt) { lsum[mt] = lsv[mt];
#pragma unroll
                    for (int j = 0; j < 4; ++j) oacc[mt][j] = osv[mt][j]; } }
#pragma unroll 1
            for (int krl = 0; krl < 4; ++krl) {
                const int kr = 4 * (kb_lo + bi) + krl;
                if (!is_ctx && (kr < r0 || kr > r0 + 7)) continue;
                f32x4 sacc[2][4];
#pragma unroll
                for (int mt = 0; mt < 2; ++mt)
#pragma unroll
                    for (int nt = 0; nt < 4; ++nt) sacc[mt][nt] = (f32x4){0.f, 0.f, 0.f, 0.f};
                const int n0w = is_ctx ? 0 : nlo[0], n1w = is_ctx ? 3 : nhi[1];
#pragma unroll
                for (int nt = 0; nt < 4; ++nt) { if (nt < n0w || nt > n1w) continue;
                    const bool u0 = is_ctx || (nt >= nlo[0] && nt <= nhi[0]), u1 = is_ctx || (nt >= nlo[1] && nt <= nhi[1]);
#pragma unroll
                    for (int ks = 0; ks < 2; ++ks) { const bf16x8 bk = frag_kc(Ks, NLD, 64 * krl + 16 * nt, 32 * ks, F.lane);
                        if (u0) sacc[0][nt] = mma(sacc[0][nt], bk, aq[0][ks]); if (u1) sacc[1][nt] = mma(sacc[1][nt], bk, aq[1][ks]); } }
                const int rowb = is_ctx ? 0 : (kr - r + 7) * 32;
#pragma unroll
                for (int mt = 0; mt < 2; ++mt) {
#pragma unroll
                    for (int nt = 0; nt < 4; ++nt) { float pv[4] = {0.f, 0.f, 0.f, 0.f};
                        if (is_ctx) {
#pragma unroll
                            for (int i = 0; i < 4; ++i) { pv[i] = __expf(sacc[mt][nt][i] - bound); lsum[mt] += pv[i]; } }
                        else if (nt >= nlo[mt] && nt <= nhi[mt]) {
#pragma unroll
                            for (int i = 0; i < 4; ++i) { pv[i] = __expf(sacc[mt][nt][i] + rpbs[rowb + boff[mt][nt][i]]); lsum[mt] += pv[i]; } }
                        u32x2 pk; pk.x = pk2(pv[0], pv[1]); pk.y = pk2(pv[2], pv[3]); *(LAS u32x2*)(Pw + (16 * mt + fr) * NLD + 16 * nt + 4 * fq) = pk; } }
                LDS_WAIT();
#pragma unroll
                for (int ks2 = 0; ks2 < 2; ++ks2) {
                    const bool v0 = is_ctx || (2 * ks2 + 1 >= nlo[0] && 2 * ks2 <= nhi[0]), v1 = is_ctx || (2 * ks2 + 1 >= nlo[1] && 2 * ks2 <= nhi[1]);
                    if (!(v0 || v1)) continue;
                    const bf16x8 ap0 = frag_kc(Pw, NLD, 0, 32 * ks2, F.lane), ap1 = frag_kc(Pw, NLD, 16, 32 * ks2, F.lane);
#pragma unroll
                    for (int et = 0; et < 4; ++et) { const bf16x8 bv = frag_kr(Vs, NLD, 16 * et, 64 * krl + 32 * ks2, F.lane);
                        if (v0) oacc[0][et] = mma(oacc[0][et], bv, ap0); if (v1) oacc[1][et] = mma(oacc[1][et], bv, ap1); } }
            }
            }
            LDS_BARRIER();
        }
#undef NA_LOAD
#pragma unroll
        for (int mt = 0; mt < 2; ++mt) { float l = lsum[mt]; l += __shfl_xor(l, 16); l += __shfl_xor(l, 32); const float inv = 1.f / l;
#pragma unroll
            for (int et = 0; et < 4; ++et) { const f32x4 o = oacc[mt][et] * inv; u32x2 p; p.x = pk2(o.x, o.y); p.y = pk2(o.z, o.w);
                *(u32x2*)(MIX + (size_t)(qtok0 + 16 * mt + fr) * D + 512 + head * 64 + 16 * et + 4 * fq) = p; } }
    }
}

DI void xm_phase(Fr& F, const float* xl, const float* xc, const float* normw, const float* modl) {
    bf16* XM = (bf16*)(F.ws + WS_XM); const float* mu = F.in[18];
    for (int row = F.gw; row < MA; row += F.NGW) {
        const bool lat = row < ML; const int rr = lat ? row : row - ML; const int L = lat ? SEQ : CTXL; const int t = rr % L;
        const float* src = (lat ? xl : xc) + (size_t)rr * D;
        const float* mrow = modl + (size_t)(lat ? row / SEQ : 8) * 6144;
        const bool hp = t > 0, hn = t < L - 1;
        f32x4 vc[4], vp[4], vn[4]; float sc_ = 0.f, sp_ = 0.f, sn_ = 0.f;
#pragma unroll
        for (int j = 0; j < 4; ++j) { vc[j] = ((const f32x4*)src)[F.lane + 64 * j];
            vp[j] = hp ? ((const f32x4*)(src - D))[F.lane + 64 * j] : (f32x4){0.f, 0.f, 0.f, 0.f}; vn[j] = hn ? ((const f32x4*)(src + D))[F.lane + 64 * j] : (f32x4){0.f, 0.f, 0.f, 0.f};
            sc_ += (vc[j].x * vc[j].x + vc[j].y * vc[j].y) + (vc[j].z * vc[j].z + vc[j].w * vc[j].w);
            sp_ += (vp[j].x * vp[j].x + vp[j].y * vp[j].y) + (vp[j].z * vp[j].z + vp[j].w * vp[j].w);
            sn_ += (vn[j].x * vn[j].x + vn[j].y * vn[j].y) + (vn[j].z * vn[j].z + vn[j].w * vn[j].w); }
        const float rc = rsqrtf(wave_sum(sc_) * (1.f / D) + 1e-6f), rp = rsqrtf(wave_sum(sp_) * (1.f / D) + 1e-6f), rn = rsqrtf(wave_sum(sn_) * (1.f / D) + 1e-6f);
#pragma unroll
        for (int j = 0; j < 4; ++j) { const int c4 = F.lane + 64 * j;
            const f32x4 w = ((const f32x4*)normw)[c4], sc = ((const f32x4*)(mrow + 1024))[c4], sh = ((const f32x4*)mrow)[c4];
            const f32x4 g = w * (sc + 1.f);
            const f32x4 hc = vc[j] * rc * g + sh;
            const f32x4 hpv = hp ? vp[j] * rp * g + sh : (f32x4){0.f, 0.f, 0.f, 0.f};
            const f32x4 hnv = hn ? vn[j] * rn * g + sh : (f32x4){0.f, 0.f, 0.f, 0.f};
            const f32x4 xx = (hpv + hnv) * 0.5f - hc;
#pragma unroll
            for (int s = 0; s < 6; ++s) { const f32x4 m = ((const f32x4*)(mu + s * 1024))[c4]; const f32x4 y = hc + xx * m;
                u32x2 p; p.x = pk2(y.x, y.y); p.y = pk2(y.z, y.w); ((u32x2*)(XM + ((size_t)s * MA + row) * D))[c4] = p; } }
    }
}

DI f32x4 mma16(f32x4 acc, s16x4 bfrag, s16x4 afrag) { return __builtin_amdgcn_mfma_f32_16x16x16bf16_1k(bfrag, afrag, acc, 0, 0, 0); }
DI s16x4 frag16_kc(const LAS bf16* base, int ld, int row0, int k0, int lane) { return *(const LAS s16x4*)(base + (row0 + (lane & 15)) * ld + k0 + 4 * (lane >> 4)); }
DI s16x4 frag16_kr(const LAS bf16* base, int ld, int x0, int k0, int lane) { const int g = lane >> 4, q = (lane & 15) >> 2, p = lane & 3;
    return __builtin_amdgcn_ds_read_tr16_b64_v4i16((LAS s16x4*)(base + (k0 + 4 * g + q) * ld + x0 + 4 * p)); }
DI s16x4 cvt4(f32x4 v) { u32x2 p; p.x = pk2(v.x, v.y); p.y = pk2(v.z, v.w); return __builtin_bit_cast(s16x4, p); }
constexpr int WLD = 72;
DI void rwkv_scan2_phase(Fr& F) {
    const bf16* KB = (const bf16*)(F.ws + WS_KB); const bf16* VB = (const bf16*)(F.ws + WS_VB); const bf16* RB = (const bf16*)(F.ws + WS_RB);
    const float* LW = (const float*)(F.ws + WS_DEC); const bf16* AG = (const bf16*)(F.ws + WS_AG);
    LAS bf16* AT = (LAS bf16*)F.lds; LAS bf16* BT = AT + 64 * WLD; LAS bf16* KT = BT + 64 * WLD; LAS bf16* RT = KT + 64 * WLD; LAS bf16* BH = RT + 64 * WLD; LAS bf16* KH = BH + 64 * WLD;
    LAS bf16* VN = KH + 64 * WLD; LAS bf16* W1s = VN + 64 * WLD;
    LAS bf16* PRB = W1s + 64 * WLD; LAS bf16* PRK = PRB + 1024;
    LAS f32x4* UVT = (LAS f32x4*)(PRK + 1024);
    LAS float* GC = (LAS float*)(UVT + 1024);
    LAS float* CSs = GC + 256;
    LAS float* YS = CSs + 4096;
    const int cq = F.wave >> 1, half = F.wave & 1, fr = F.lane & 15, fq = F.lane >> 4;
    for (int u = F.bx; u < 256; u += F.G) {
        const int z = u & 1, h = (u >> 1) & 15, b = u >> 5;
        bf16* Y = (bf16*)(F.ws + (z ? WS_YB : WS_YF));
        const int sx = F.lane >> 3, cg = F.lane & 7;
        float kkw[8], kaw[8];
#pragma unroll
        for (int i = 0; i < 8; ++i) { kkw[i] = F.in[28][h * 64 + 8 * cg + i]; kaw[i] = F.in[29][h * 64 + 8 * cg + i]; }
        const size_t bh = (size_t)(b * 16 + h);
        const bf16* kbh = KB + bh * (SEQ + CTXL) * 64 + 8 * cg; const bf16* vbh = VB + bh * (SEQ + CTXL) * 64 + 8 * cg; const bf16* rbh = RB + bh * SEQ * 64 + 8 * cg;
        const bf16* agh = AG + ((size_t)z * 128 + bh) * (SEQ + CTXL) * 64 + 8 * cg; const float* lwh = LW + ((size_t)z * 128 + bh) * (SEQ + CTXL) * 64 + 8 * cg;
        f32x4 S[4];
#pragma unroll
        for (int j = 0; j < 4; ++j) S[j] = (f32x4){0.f, 0.f, 0.f, 0.f};
        u32x4 kreg, vreg, rreg, areg; f32x4 lw0, lw1;
        const int stl = 16 * cq + 8 * half + sx;
#define RW_LOAD(sc) do { const int g_ = (sc) * 64 + stl; const bool lat_ = g_ >= CTXL; const int row_ = z ? (lat_ ? (2 * CTXL + SEQ - 1 - g_) : (CTXL - 1 - g_)) : g_; \
            kreg = *(const u32x4*)(kbh + (size_t)row_ * 64); vreg = *(const u32x4*)(vbh + (size_t)row_ * 64); areg = *(const u32x4*)(agh + (size_t)row_ * 64); \
            rreg = lat_ ? *(const u32x4*)(rbh + (size_t)(row_ - CTXL) * 64) : (u32x4){0u, 0u, 0u, 0u}; \
            lw0 = *(const f32x4*)(lwh + (size_t)row_ * 64); lw1 = *(const f32x4*)(lwh + (size_t)row_ * 64 + 4); } while (0)
        RW_LOAD(0);
        for (int sc = 0; sc < (SEQ + CTXL) / 64; ++sc) {
            const bool lat = sc * 64 >= CTXL;
            *(LAS f32x4*)(CSs + stl * 64 + 8 * cg) = lw0; *(LAS f32x4*)(CSs + stl * 64 + 8 * cg + 4) = lw1;
            LDS_BARRIER();
            if (F.tid < 256) { const int q = F.tid >> 6, c = F.tid & 63; float v[16];
#pragma unroll
                for (int t = 0; t < 16; ++t) v[t] = CSs[(16 * q + t) * 64 + c];
                float acc = 0.f;
#pragma unroll
                for (int t = 0; t < 16; ++t) { acc += v[t]; CSs[(16 * q + t) * 64 + c] = acc; } }
            LDS_BARRIER();
            { const int tau = 8 * half + sx;
              const f32x4 c0 = *(const LAS f32x4*)(CSs + stl * 64 + 8 * cg), c1 = *(const LAS f32x4*)(CSs + stl * 64 + 8 * cg + 4);
              f32x4 p0 = (f32x4){0.f, 0.f, 0.f, 0.f}, p1 = p0;
              if (tau > 0) { p0 = *(const LAS f32x4*)(CSs + (stl - 1) * 64 + 8 * cg); p1 = *(const LAS f32x4*)(CSs + (stl - 1) * 64 + 8 * cg + 4); }
              const f32x4 t0 = *(const LAS f32x4*)(CSs + (16 * cq + 15) * 64 + 8 * cg), t1 = *(const LAS f32x4*)(CSs + (16 * cq + 15) * 64 + 8 * cg + 4);
              const float cs[8] = {c0.x, c0.y, c0.z, c0.w, c1.x, c1.y, c1.z, c1.w}, cp[8] = {p0.x, p0.y, p0.z, p0.w, p1.x, p1.y, p1.z, p1.w}, ct[8] = {t0.x, t0.y, t0.z, t0.w, t1.x, t1.y, t1.z, t1.w};
              const unsigned kw[4] = {kreg.x, kreg.y, kreg.z, kreg.w}, aw[4] = {areg.x, areg.y, areg.z, areg.w}, rw[4] = {rreg.x, rreg.y, rreg.z, rreg.w};
              float kr[8], ag[8], rr[8], kk[8]; float ss = 0.f;
#pragma unroll
              for (int i = 0; i < 4; ++i) { kr[2 * i] = bflo(kw[i]); kr[2 * i + 1] = bfhi(kw[i]); ag[2 * i] = bflo(aw[i]); ag[2 * i + 1] = bfhi(aw[i]); rr[2 * i] = bflo(rw[i]); rr[2 * i + 1] = bfhi(rw[i]); }
#pragma unroll
              for (int i = 0; i < 8; ++i) { kk[i] = kr[i] * kkw[i]; ss += kk[i] * kk[i]; }
              const float rn = __builtin_amdgcn_rsqf(fmaxf(red8(ss), 1e-24f));
              float oa[8], ob[8], ok[8], orr[8], obh[8], okh[8], eCv[8];
#pragma unroll
              for (int i = 0; i < 8; ++i) { const float e1 = __expf(cs[i]), ep = __expf(cp[i]), eC = __expf(ct[i]), inv = __builtin_amdgcn_rcpf(e1);
                  const float kki = kk[i] * rn, b_ = kki * ag[i], kd_ = kr[i] * (1.f + (ag[i] - 1.f) * kaw[i]);
                  oa[i] = -kki * ep; ob[i] = b_ * inv; ok[i] = kd_ * inv; orr[i] = rr[i] * e1; obh[i] = b_ * eC * inv; okh[i] = kd_ * eC * inv; eCv[i] = eC; }
              const int o = stl * WLD + 8 * cg;
              *(LAS u32x4*)(AT + o) = pack8(oa, 1.f); *(LAS u32x4*)(BT + o) = pack8(ob, 1.f); *(LAS u32x4*)(KT + o) = pack8(ok, 1.f); *(LAS u32x4*)(RT + o) = pack8(orr, 1.f);
              *(LAS u32x4*)(BH + o) = pack8(obh, 1.f); *(LAS u32x4*)(KH + o) = pack8(okh, 1.f); *(LAS u32x4*)(VN + o) = vreg;
              if (tau == 0) { *(LAS f32x4*)(GC + cq * 64 + 8 * cg) = (f32x4){eCv[0], eCv[1], eCv[2], eCv[3]}; *(LAS f32x4*)(GC + cq * 64 + 8 * cg + 4) = (f32x4){eCv[4], eCv[5], eCv[6], eCv[7]}; } }
            LDS_BARRIER();
            if (sc + 1 < (SEQ + CTXL) / 64) RW_LOAD(sc + 1);
            for (int pa2_ = 0; pa2_ < ((((PROBE_DUP) >> 25) & 1u) ? 2 : 1); ++pa2_)
            if (half) { f32x4 pb = (f32x4){0.f, 0.f, 0.f, 0.f}, pk = (f32x4){0.f, 0.f, 0.f, 0.f};
#pragma unroll
                for (int k0 = 0; k0 < 64; k0 += 32) { const bf16x8 af = frag_kc(RT, WLD, 16 * cq, k0, F.lane);
                    pb = mma(pb, frag_kc(BT, WLD, 16 * cq, k0, F.lane), af); pk = mma(pk, frag_kc(KT, WLD, 16 * cq, k0, F.lane), af); }
#pragma unroll
                for (int r = 0; r < 4; ++r) if (4 * fq + r > fr) { pb[r] = 0.f; pk[r] = 0.f; }
                const int o = cq * 256 + fr * 16 + 4 * fq;
                *(LAS s16x4*)(PRB + o) = cvt4(pb); *(LAS s16x4*)(PRK + o) = cvt4(pk); }
            else { f32x4 xa = (f32x4){0.f, 0.f, 0.f, 0.f}, xt = (f32x4){0.f, 0.f, 0.f, 0.f}, ak = (f32x4){0.f, 0.f, 0.f, 0.f};
#pragma unroll
                for (int k0 = 0; k0 < 64; k0 += 32) { const bf16x8 af = frag_kc(AT, WLD, 16 * cq, k0, F.lane), bfm = frag_kc(BT, WLD, 16 * cq, k0, F.lane);
                    xa = mma(xa, bfm, af);
                    xt = mma(xt, af, bfm);
                    ak = mma(ak, frag_kc(KT, WLD, 16 * cq, k0, F.lane), af); }
#pragma unroll
                for (int r = 0; r < 4; ++r) { if (4 * fq + r >= fr) { xa[r] = 0.f; ak[r] = 0.f; } if (4 * fq + r <= fr) xt[r] = 0.f; }
                f32x4 P = xa;
#pragma unroll
                for (int r = 0; r < 4; ++r) if (4 * fq + r == fr) P[r] += 1.f;
#pragma unroll
                for (int lvl = 0; lvl < 3; ++lvl) { const s16x4 xf = cvt4(xa), xtf = cvt4(xt);
                    const f32x4 x2 = mma16((f32x4){0.f, 0.f, 0.f, 0.f}, xtf, xf);
                    const f32x4 x2t = mma16((f32x4){0.f, 0.f, 0.f, 0.f}, xf, xtf);
                    xa = x2; xt = x2t;
                    P = mma16(P, cvt4(xt), cvt4(P)); }
                const s16x4 tf = cvt4(P), akf = cvt4(ak);
#pragma unroll
                for (int jt = 0; jt < 4; ++jt) { const f32x4 acc = mma16((f32x4){0.f, 0.f, 0.f, 0.f}, frag16_kr(AT, WLD, 16 * jt, 16 * cq, F.lane), tf);
                    *(LAS s16x4*)(W1s + (16 * cq + fr) * WLD + 16 * jt + 4 * fq) = cvt4(acc); }
#pragma unroll
                for (int it = 0; it < 4; ++it) { const f32x4 xvt = mma16((f32x4){0.f, 0.f, 0.f, 0.f}, akf, frag16_kr(VN, WLD, 16 * it, 16 * cq, F.lane));
                    UVT[(cq * 4 + it) * 64 + F.lane] = mma16((f32x4){0.f, 0.f, 0.f, 0.f}, tf, cvt4(xvt)); } }
            LDS_BARRIER();
            if (F.wave < 4) { const int it = F.wave;
#pragma unroll
                for (int c = 0; c < 4; ++c) {
                    s16x4 w1f[4], rtf[4], bhf[4], khf[4]; f32x4 g4[4];
#pragma unroll
                    for (int jt = 0; jt < 4; ++jt) { w1f[jt] = frag16_kc(W1s, WLD, 16 * c, 16 * jt, F.lane); rtf[jt] = frag16_kc(RT, WLD, 16 * c, 16 * jt, F.lane);
                        bhf[jt] = frag16_kr(BH, WLD, 16 * jt, 16 * c, F.lane); khf[jt] = frag16_kr(KH, WLD, 16 * jt, 16 * c, F.lane); g4[jt] = *(const LAS f32x4*)(GC + c * 64 + 16 * jt + 4 * fq); }
                    const s16x4 vfr = frag16_kr(VN, WLD, 16 * it, 16 * c, F.lane), pbf = frag16_kc(PRB + c * 256, 16, 0, 0, F.lane), pkf = frag16_kc(PRK + c * 256, 16, 0, 0, F.lane);
                    const f32x4 uv0 = UVT[(c * 4 + it) * 64 + F.lane];
                    s16x4 sfr[4];
#pragma unroll
                    for (int jt = 0; jt < 4; ++jt) sfr[jt] = cvt4(S[jt]);
#define CAT8(a_, b_) __builtin_shufflevector((a_), (b_), 0, 1, 2, 3, 4, 5, 6, 7)
                    const bf16x8 s01 = CAT8(sfr[0], sfr[1]), s23 = CAT8(sfr[2], sfr[3]);
                    f32x4 Ua = mma(uv0, CAT8(w1f[0], w1f[1]), s01); Ua = mma(Ua, CAT8(w1f[2], w1f[3]), s23);
                    const s16x4 ufr = cvt4(Ua); const bf16x8 uv8 = CAT8(ufr, vfr);
#pragma unroll
                    for (int jt = 0; jt < 4; ++jt) S[jt] = mma(S[jt] * g4[jt], CAT8(bhf[jt], khf[jt]), uv8);
                    if (lat) { f32x4 Ya = mma((f32x4){0.f, 0.f, 0.f, 0.f}, CAT8(rtf[0], rtf[1]), s01); Ya = mma(Ya, CAT8(rtf[2], rtf[3]), s23);
                        const f32x4 Yb = mma((f32x4){0.f, 0.f, 0.f, 0.f}, CAT8(pbf, pkf), uv8);
                        const f32x4 Yt = Ya + Yb;
#pragma unroll
                        for (int r = 0; r < 4; ++r) YS[(16 * c + 4 * fq + r) * 68 + 16 * it + fr] = Yt[r]; }
                } }
            LDS_BARRIER();
            if (lat) {
                const int g = sc * 64 + (F.tid >> 3); const int tl = z ? (SEQ + CTXL - 1 - g) : (g - CTXL);
                const f32x4 y0 = *(const LAS f32x4*)(YS + (F.tid >> 3) * 68 + 8 * (F.tid & 7)), y1 = *(const LAS f32x4*)(YS + (F.tid >> 3) * 68 + 8 * (F.tid & 7) + 4);
                u32x4 o; o.x = pk2(y0.x, y0.y); o.y = pk2(y0.z, y0.w); o.z = pk2(y1.x, y1.y); o.w = pk2(y1.z, y1.w);
                *(u32x4*)(Y + (size_t)(b * SEQ + tl) * D + h * 64 + 8 * (F.tid & 7)) = o; }
            LDS_BARRIER();
        }
#undef RW_LOAD
    }
}

DI void rwkv_readout_phase(Fr& F) {
    const bf16* KB = (const bf16*)(F.ws + WS_KB); const bf16* VB = (const bf16*)(F.ws + WS_VB); const bf16* RB = (const bf16*)(F.ws + WS_RB);
    const bf16* AG = (const bf16*)(F.ws + WS_AG); const bf16* G = (const bf16*)(F.ws + WS_G);
    const bf16* YF = (const bf16*)(F.ws + WS_YF); const bf16* YB = (const bf16*)(F.ws + WS_YB); bf16* Z = (bf16*)(F.ws + WS_H);
    const int c0 = 16 * F.lane;
    for (int row = F.gw; row < ML; row += F.NGW) {
        const size_t off = (size_t)row * D + c0;
        const int b = row / SEQ, t = row % SEQ, hh = F.lane >> 2, j0 = (F.lane & 3) * 16;
        const size_t hoff = ((size_t)(b * 16 + hh) * (SEQ + CTXL) + CTXL + t) * 64 + j0, roff = ((size_t)(b * 16 + hh) * SEQ + t) * 64 + j0;
        float y[16], kv[16], vv[16], rv[16], gv[16], a0v[16], a1v[16];
#pragma unroll
        for (int q = 0; q < 16; ++q) y[q] = 0.f;
#define RD16(dst, ptr) do { const u32x4 t0_ = *(const u32x4*)(ptr), t1_ = *(const u32x4*)((ptr) + 8); const unsigned tw_[8] = {t0_.x, t0_.y, t0_.z, t0_.w, t1_.x, t1_.y, t1_.z, t1_.w}; \
        _Pragma("unroll") for (int q_ = 0; q_ < 8; ++q_) { dst[2 * q_] = bflo(tw_[q_]); dst[2 * q_ + 1] = bfhi(tw_[q_]); } } while (0)
        { float yf[16], yb[16]; RD16(yf, YF + off); RD16(yb, YB + off);
#pragma unroll
          for (int q = 0; q < 16; ++q) y[q] = yf[q] + yb[q]; }
        RD16(kv, KB + hoff); RD16(vv, VB + hoff); RD16(rv, RB + roff); RD16(gv, G + off); RD16(a0v, AG + hoff); RD16(a1v, AG + (size_t)128 * (SEQ + CTXL) * 64 + hoff);
#undef RD16
        float s = 0.f, cf = 0.f;
#pragma unroll
        for (int q = 0; q < 16; ++q) { s += y[q]; const float ka = F.in[29][c0 + q];
            const float kd = kv[q] * ((1.f + (a0v[q] - 1.f) * ka) + (1.f + (a1v[q] - 1.f) * ka)); cf += rv[q] * kd * F.in[30][c0 + q]; }
        s = red4(s); cf = red4(cf);
        const float mean = s * (1.f / 64.f); float q2 = 0.f;
#pragma unroll
        for (int q = 0; q < 16; ++q) { const float d = y[q] - mean; q2 += d * d; }
        q2 = red4(q2);
        const float rstd = rsqrtf(q2 * (1.f / 64.f) + 64e-5f);
        float o[16];
#pragma unroll
        for (int q = 0; q < 16; ++q) o[q] = ((y[q] - mean) * rstd * F.in[31][c0 + q] + F.in[32][c0 + q] + cf * vv[q]) * gv[q];
        u32x4 p0, p1; p0.x = pk2(o[0], o[1]); p0.y = pk2(o[2], o[3]); p0.z = pk2(o[4], o[5]); p0.w = pk2(o[6], o[7]); p1.x = pk2(o[8], o[9]); p1.y = pk2(o[10], o[11]); p1.z = pk2(o[12], o[13]); p1.w = pk2(o[14], o[15]);
        *(u32x4*)(Z + off) = p0; *(u32x4*)(Z + off + 8) = p1;
    }
}

DI void moe_route_phase(Fr& F, const float* xl, const float* normw, const float* modl) {
    bf16* H2 = (bf16*)(F.ws + WS_MIX); int* TopE = (int*)(F.ws + WS_MISC + MISC_TOPE); f32x2* TopW = (f32x2*)(F.ws + WS_MISC + MISC_TOPW); int* Cnts = (int*)(F.ws + WS_MISC + MISC_CNTS);
    LAS float* rt = (LAS float*)F.lds;
    LAS int* lc = (LAS int*)(F.lds + 32768);
    for (int idx = F.tid; idx < 1024 * 8 / 4; idx += NTHR) ((LAS f32x4*)rt)[idx] = ((const f32x4*)F.in[34])[idx];
    for (int wg = F.bx; wg < 256; wg += F.G) {
        WG_SYNC();
        for (int it = 0; it < 8; ++it) { const int row = wg * 64 + F.wave * 8 + it;
            const float* src = xl + (size_t)row * D; const float* mrow = modl + (size_t)(row / SEQ) * 6144;
            f32x4 v[4]; float ss = 0.f;
#pragma unroll
            for (int j = 0; j < 4; ++j) { v[j] = ((const f32x4*)src)[F.lane + 64 * j]; ss += (v[j].x * v[j].x + v[j].y * v[j].y) + (v[j].z * v[j].z + v[j].w * v[j].w); }
            const float rstd = rsqrtf(wave_sum(ss) * (1.f / D) + 1e-6f);
            float lg[8];
#pragma unroll
            for (int e = 0; e < 8; ++e) lg[e] = 0.f;
#pragma unroll
            for (int j = 0; j < 4; ++j) { const int c4 = F.lane + 64 * j;
                const f32x4 w = ((const f32x4*)normw)[c4], sc = ((const f32x4*)(mrow + 4096))[c4], sh = ((const f32x4*)(mrow + 3072))[c4];
                const f32x4 y = v[j] * rstd * w * (sc + 1.f) + sh;
                u32x2 p; p.x = pk2(y.x, y.y); p.y = pk2(y.z, y.w); ((u32x2*)(H2 + (size_t)row * D))[c4] = p;
                const float yy[4] = {y.x, y.y, y.z, y.w};
#pragma unroll
                for (int q = 0; q < 4; ++q) { const f32x4 r0 = *(const LAS f32x4*)(rt + (4 * c4 + q) * 8), r1 = *(const LAS f32x4*)(rt + (4 * c4 + q) * 8 + 4);
                    lg[0] += yy[q] * r0.x; lg[1] += yy[q] * r0.y; lg[2] += yy[q] * r0.z; lg[3] += yy[q] * r0.w; lg[4] += yy[q] * r1.x; lg[5] += yy[q] * r1.y; lg[6] += yy[q] * r1.z; lg[7] += yy[q] * r1.w; } }
#pragma unroll
            for (int e = 0; e < 8; ++e) lg[e] = wave_sum(lg[e]);
            int e0 = 0; float v0 = lg[0];
#pragma unroll
            for (int e = 1; e < 8; ++e) if (lg[e] > v0) { v0 = lg[e]; e0 = e; }
            int e1 = -1; float v1 = -3.0e38f;
#pragma unroll
            for (int e = 0; e < 8; ++e) if (e != e0 && lg[e] > v1) { v1 = lg[e]; e1 = e; }
            const float w0 = 1.f / (1.f + expf(v1 - v0)), w1 = 1.f - w0;
            if (F.lane == 0) { TopE[row] = e0 | (e1 << 8); TopW[row] = (f32x2){w0, w1}; lc[F.wave * 8 + it] = e0 | (e1 << 8); }
        }
        WG_SYNC();
        if (F.tid < 8) { int c = 0; for (int t = 0; t < 64; ++t) { const int code = lc[t]; c += ((code & 255) == F.tid ? 1 : 0) + ((code >> 8) == F.tid ? 1 : 0); } Cnts[wg * 8 + F.tid] = c; }
        WG_SYNC();
    }
}
DI void moe_gather_phase(Fr& F) {
    const bf16* H2 = (const bf16*)(F.ws + WS_MIX); const int* TopE = (const int*)(F.ws + WS_MISC + MISC_TOPE); const f32x2* TopW = (const f32x2*)(F.ws + WS_MISC + MISC_TOPW);
    const int* Cnts = (const int*)(F.ws + WS_MISC + MISC_CNTS); int* Exp = (int*)(F.ws + WS_MISC + MISC_EXP);
    bf16* XG = (bf16*)(F.ws + WS_XG); int* RowTok = (int*)(F.ws + WS_ROWS); float* RowW = (float*)(F.ws + WS_ROWS + 262144);
    LAS int* lc = (LAS int*)F.lds;
    LAS int* tot = lc + 2048;
    LAS int* rows = tot + 32;
    LAS int* te = rows + 128;
    for (int idx = F.tid; idx < 2048; idx += NTHR) lc[idx] = Cnts[idx];
    WG_SYNC();
    for (int wg = F.bx; wg < 256; wg += F.G) {
        if (F.tid < 64) te[F.tid] = TopE[wg * 64 + F.tid];
        if (F.tid < 8) { int t = 0, mb = 0; for (int w = 0; w < 256; ++w) { const int c = lc[w * 8 + F.tid]; t += c; mb += (w < wg) ? c : 0; } tot[F.tid] = t; tot[16 + F.tid] = mb; }
        WG_SYNC();
        if (F.tid == 0) { int sgs = 0; for (int e = 0; e < 8; ++e) { tot[8 + e] = sgs; sgs += (tot[e] + 255) & ~255; }
            if (wg == 0) { int acc = 0; for (int e = 0; e < 8; ++e) { Exp[e] = tot[e]; Exp[8 + e] = tot[8 + e]; acc += (tot[e] + 255) >> 8; Exp[16 + e] = acc; } } }
        WG_SYNC();
        if (F.tid < 64) { const int code = te[F.tid]; const int e0 = code & 255, e1 = code >> 8; int r0 = 0, r1 = 0;
            for (int t = 0; t < F.tid; ++t) { const int c2 = te[t]; const int a = c2 & 255, bq = c2 >> 8; r0 += (a == e0 ? 1 : 0) + (bq == e0 ? 1 : 0); r1 += (a == e1 ? 1 : 0) + (bq == e1 ? 1 : 0); }
            rows[2 * F.tid] = tot[8 + e0] + tot[16 + e0] + r0; rows[2 * F.tid + 1] = tot[8 + e1] + tot[16 + e1] + r1; }
        WG_SYNC();
        for (int it = F.wave; it < 128; it += NWAVES) { const int t = it >> 1, k = it & 1, tok = wg * 64 + t, row = rows[it];
            const u32x4* s = (const u32x4*)(H2 + (size_t)tok * D); u32x4* d = (u32x4*)(XG + (size_t)row * D);
            d[F.lane] = s[F.lane]; d[F.lane + 64] = s[F.lane + 64];
            if (F.lane == 0) { RowTok[row] = tok * 2 + k; const f32x2 w = TopW[tok]; RowW[row] = k ? w.y : w.x; } }
        if (wg == 0) {
            for (int e = 0; e < 8; ++e) { const int a = tot[8 + e] + tot[e], bnd = tot[8 + e] + ((tot[e] + 255) & ~255); for (int rr = a + F.tid; rr < bnd; rr += NTHR) RowTok[rr] = -1; } }
        WG_SYNC();
    }
}
DI void moe_combine_phase(Fr& F, float* xl, const float* modl) {
    const bf16* YS = (const bf16*)(F.ws + WS_YS);
    for (int row = F.gw; row < ML; row += F.NGW) {
        const float* mrow = modl + (size_t)(row / SEQ) * 6144 + 5120; float* xr = xl + (size_t)row * D;
        const u32x2* s0 = (const u32x2*)(YS + (size_t)(2 * row) * D); const u32x2* s1 = (const u32x2*)(YS + (size_t)(2 * row + 1) * D);
#pragma unroll
        for (int j = 0; j < 4; ++j) { const int c4 = F.lane + 64 * j; const f32x4 x = ((const f32x4*)xr)[c4], m = ((const f32x4*)mrow)[c4]; const u32x2 a = s0[c4], bq = s1[c4];
            f32x4 o; o.x = x.x + m.x * (bflo(a.x) + bflo(bq.x)); o.y = x.y + m.y * (bfhi(a.x) + bfhi(bq.x)); o.z = x.z + m.z * (bflo(a.y) + bflo(bq.y)); o.w = x.w + m.w * (bfhi(a.y) + bfhi(bq.y));
            ((f32x4*)xr)[c4] = o; }
    }
}

constexpr int N_PHASES = 20;
constexpr int FILL_A = 4000, FILL_B = 8200, FILL_C = 15700;
struct Args { const float* in[37]; float* out; unsigned char* ws; int ph_lo, ph_hi; };
template <class Epi> DI void run_gemm(Fr& F, const bf16* A, const bf16* Bt, int M, int N, int K, const Epi& E, int& rot) {
    int Kv = K; asm volatile("" : "+s"(Kv));
    pg8::Gemm g{A, Bt, M, N, Kv}; pg8::StaticOrder S; S.init(M, N, F.G, (F.bx + F.G - (rot % F.G)) % F.G); rot += (M / 256) * (N / 256);
    pg8::gemm_phase<Epi, pg8::StaticOrder>(F.lds, g, S, E);
}
__global__ void __launch_bounds__(NTHR, 2) fwd_kernel(Args args) {
    extern __shared__ __attribute__((aligned(16))) unsigned char lds_raw[];
    Fr F;
    F.lds = (LAS unsigned char*)lds_raw; F.ws = args.ws; F.in = args.in; F.out = args.out;
    F.tid = threadIdx.x; F.lane = F.tid & 63; F.wave = __builtin_amdgcn_readfirstlane(F.tid >> 6); F.bx = blockIdx.x; F.G = gridDim.x;
    F.gw = F.bx * NWAVES + F.wave; F.NGW = F.G * NWAVES;
    volatile LAS unsigned* MISC = (volatile LAS unsigned*)(F.lds + LDS_MISC_OFF);
    if (F.tid < 64) MISC[F.tid] = 0u;
    __syncthreads();
    const int lo = args.ph_lo, hi = args.ph_hi;
    const bool multi = (hi - lo) > 1;
    XcdBarrier bar; bar.bar = (unsigned*)(F.ws + WS_CTL) + CW_BAR; bar.x = 0; bar.st = nullptr;
    if (multi) bar = xcd_barrier_post((unsigned*)(F.ws + WS_CTL) + CW_BAR, MISC + 8);
#ifndef PH_MASK
#define PH_MASK 0xFFFFFFFFu
#endif
#define IN(k) ((((PH_MASK) >> (k)) & 1u) && lo <= (k) && (k) < hi)
#define REP(k) for (int rep_ = 0; rep_ < ((((PROBE_DUP) >> (k)) & 1u) ? 2 : 1); ++rep_)
#define SEAM(k) do { if (IN(k) && IN((k) + 1)) xcd_barrier(bar); } while (0)
    const float* const* in = args.in;
    float* MOD = (float*)(F.ws + WS_MOD);
    float* XL = F.out; float* XC = (float*)(F.ws + WS_XC);
    bf16* H = (bf16*)(F.ws + WS_H); bf16* MIX = (bf16*)(F.ws + WS_MIX);

    if (IN(0)) REP(0) { p0_prologue(F); } SEAM(0);
    if (IN(1)) REP(1) { mod_rows(F, in[0], in[2], MA, in[6], MOD, 0, 1024, H); } SEAM(1);
    if (IN(2)) REP(2) { int rot = 0; EpiStore<0> E{(bf16*)(F.ws + WS_QKV), INW, INW}; run_gemm(F, H, (const bf16*)(F.ws + WS_W_IN), MA, INW, 1024, E, rot); } SEAM(2);
    if (IN(3)) REP(3) { na_norm_rows(F); ret_kv_phase(F); } SEAM(3);
    if (IN(4)) REP(4) { ret_prefix_phase(F); } SEAM(4);
    #ifndef PH5_SEL
#define PH5_SEL 3
#endif
    if (IN(5)) REP(5) { for (int r5_ = 0; r5_ < ((((PROBE_DUP) >> 27) & 1u) ? 2 : 1); ++r5_) ret_out_phase(F); for (int r6_ = 0; r6_ < ((((PROBE_DUP) >> 28) & 1u) ? 2 : 1); ++r6_) na_phase(F); } SEAM(5);
    if (IN(6)) REP(6) { int rot = 0; EpiResid E{in[0], XL, in[2], XC, MOD + 2048}; run_gemm(F, MIX, (const bf16*)(F.ws + WS_W_OUT), MA, 1024, 1024, E, rot); moe_fill(F, F.bx - 32, F.G - 32, 0, FILL_A); } SEAM(6);
    if (IN(7)) REP(7) { mod_rows(F, XL, XC, MA, in[7], MOD, 3072, 4096, H); } SEAM(7);
    if (IN(8)) REP(8) { int rot = 0; EpiSwiglu E{(bf16*)(F.ws + WS_FFH), FFN_H}; run_gemm(F, H, (const bf16*)(F.ws + WS_W_13), MA, 2 * FFN_H, 1024, E, rot); moe_fill(F, F.bx - 48, F.G - 48, FILL_A, FILL_B); } SEAM(8);
    if (IN(9)) { int rot = 0; EpiResid E{XL, XL, XC, XC, MOD + 5120}; run_gemm(F, (const bf16*)(F.ws + WS_FFH), (const bf16*)(F.ws + WS_W_2), MA, 1024, FFN_H, E, rot); moe_fill(F, F.bx - 32, F.G - 32, FILL_B, FILL_C); } SEAM(9);
    const float* MOD1 = MOD + 9 * 6144;
    if (IN(10)) REP(10) { xm_phase(F, XL, XC, in[6] + 1024, MOD1); } SEAM(10);
    if (IN(11)) REP(11) { int rot = 0; const bf16* XM = (const bf16*)(F.ws + WS_XM); const bf16* WR = (const bf16*)(F.ws + WS_W_RKV); const bf16* WL1 = (const bf16*)(F.ws + WS_W_L1);
        { EpiStoreHead E{(bf16*)(F.ws + WS_RB), SEQ, 0}; run_gemm(F, XM, WR, ML, 1024, 1024, E, rot); }
        { EpiStoreHead E{(bf16*)(F.ws + WS_KB), SEQ + CTXL, CTXL}; run_gemm(F, XM + (size_t)1 * MA * D, WR + 1024 * 1024, MA, 1024, 1024, E, rot); }
        { EpiStoreHead E{(bf16*)(F.ws + WS_VB), SEQ + CTXL, CTXL}; run_gemm(F, XM + (size_t)2 * MA * D, WR + 2 * 1024 * 1024, MA, 1024, 1024, E, rot); }
        { EpiStore<1> E{(bf16*)(F.ws + WS_L1), 256, 128}; run_gemm(F, XM + (size_t)3 * MA * D, WL1, MA, 256, 1024, E, rot); }
        { EpiStore<0> E{(bf16*)(F.ws + WS_L1) + 128, 256, 128}; run_gemm(F, XM + (size_t)4 * MA * D, WL1 + 256 * 1024, MA, 256, 1024, E, rot); }
        { EpiStore<2> E{(bf16*)(F.ws + WS_LG), 256, 256}; run_gemm(F, XM + (size_t)5 * MA * D, WL1 + 2 * 256 * 1024, ML, 256, 1024, E, rot); }
        moe_fill(F, F.bx - 16, F.G - 16, FILL_C, MOE_ITEMS); } SEAM(11);
    if (IN(12)) REP(12) { int rot = 0;
        { EpiLora2 E{(float*)(F.ws + WS_DEC), (bf16*)(F.ws + WS_AG), in[20], in[23]}; run_gemm(F, (const bf16*)(F.ws + WS_L1), (const bf16*)(F.ws + WS_W_L2), MA, 4096, 256, E, rot); }
        { EpiStore<0> E{(bf16*)(F.ws + WS_G), D, D}; run_gemm(F, (const bf16*)(F.ws + WS_LG), (const bf16*)(F.ws + WS_W_G2), ML, 1024, 256, E, rot); } } SEAM(12);
    #ifndef SCAN_VER
#define SCAN_VER 2
#endif
    if (IN(13)) REP(13) { rwkv_scan2_phase(F); } SEAM(13);
    if (IN(14)) REP(14) { rwkv_readout_phase(F); } SEAM(14);
    if (IN(15)) { int rot = 0; EpiResid E{XL, XL, XC, XC, MOD1 + 2048}; run_gemm(F, H, (const bf16*)(F.ws + WS_W_O), ML, 1024, 1024, E, rot); } SEAM(15);
    if (IN(16)) REP(16) { moe_route_phase(F, XL, in[7] + 1024, MOD1); } SEAM(16);
    if (IN(17)) REP(17) { moe_gather_phase(F); } SEAM(17);
    if (IN(18) || IN(19)) {
        const int* Exp = (const int*)(F.ws + WS_MISC + MISC_EXP);
        pg8::MoeOrder S; S.G = F.G; S.c = F.bx;
#pragma unroll
        for (int e = 0; e < 8; ++e) S.tend[e] = Exp[16 + e];
        S.nM = S.tend[7];
        if (IN(18)) REP(18) { S.nN = 2 * EXP_H / 256; S.nwg = S.nM * S.nN; pg8::Gemm g{(const bf16*)(F.ws + WS_XG), (const bf16*)(F.ws + WS_W_M13), XG_ROWS, 2 * EXP_H, 1024};
            EpiSwiglu E{(bf16*)(F.ws + WS_HG), EXP_H}; pg8::gemm_phase<EpiSwiglu, pg8::MoeOrder>(F.lds, g, S, E); }
        SEAM(18);
        if (IN(19)) REP(19) { S.nN = 4; S.nwg = S.nM * S.nN; pg8::Gemm g{(const bf16*)(F.ws + WS_HG), (const bf16*)(F.ws + WS_W_M2), XG_ROWS, 1024, EXP_H};
            EpiMoeOut E{(bf16*)(F.ws + WS_YS), (const int*)(F.ws + WS_ROWS), (const float*)(F.ws + WS_ROWS + 262144)}; pg8::gemm_phase<EpiMoeOut, pg8::MoeOrder>(F.lds, g, S, E); }
    }
    if (IN(19) && IN(20)) xcd_barrier(bar);
    if (IN(19) && IN(20)) for (int xb_ = 0; xb_ < ((((PROBE_DUP) >> 29) & 1u) ? 20 : 0); ++xb_) xcd_barrier(bar);
    if (IN(20)) { moe_combine_phase(F, XL, MOD1); }
#undef IN
#undef SEAM
}

#ifndef MK_SPLIT
#define MK_SPLIT 0
#endif
extern "C" void kernel_launch(void* const* d_in, const int* in_sizes, int n_in, void* d_out, int out_size, void* d_ws, size_t ws_size, hipStream_t stream) {
    static int grid = 0;
    if (grid == 0) {
        if (n_in != 37 || out_size != ML * D || ws_size < WS_END) { fprintf(stderr, "kernel_launch: unexpected problem (n_in %d out %d ws %zu)\n", n_in, out_size, ws_size); grid = -1; return; }
        int dev = 0, cus = 0, per_cu = 0;
        if (hipGetDevice(&dev) != hipSuccess || hipDeviceGetAttribute(&cus, hipDeviceAttributeMultiprocessorCount, dev) != hipSuccess) { grid = -1; return; }
        if (hipFuncSetAttribute((const void*)fwd_kernel, hipFuncAttributeMaxDynamicSharedMemorySize, LDS_BYTES) != hipSuccess) { fprintf(stderr, "kernel_launch: hipFuncSetAttribute failed\n"); grid = -1; return; }
        if (hipOccupancyMaxActiveBlocksPerMultiprocessor(&per_cu, (const void*)fwd_kernel, NTHR, LDS_BYTES) != hipSuccess || per_cu < 1) { fprintf(stderr, "kernel_launch: occupancy query says %d\n", per_cu); }
        (void)hipGetLastError();
        grid = cus;
    }
    if (grid < 0) return;
    (void)hipMemsetAsync((char*)d_ws + WS_CTL, 0, CTL_ZERO_BYTES, stream);
    Args a{};
    for (int i = 0; i < 37; ++i) a.in[i] = (const float*)d_in[i];
    a.out = (float*)d_out; a.ws = (unsigned char*)d_ws;
#if MK_SPLIT
    for (int p = 0; p <= N_PHASES; ++p) { a.ph_lo = p; a.ph_hi = p + 1; hipLaunchKernelGGL(fwd_kernel, dim3(grid), dim3(NTHR), LDS_BYTES, stream, a); }
#elif defined(PROBE_RELAUNCH)
    a.ph_lo = 0; a.ph_hi = PROBE_RELAUNCH + 1; hipLaunchKernelGGL(fwd_kernel, dim3(grid), dim3(NTHR), LDS_BYTES, stream, a);
    (void)hipMemsetAsync((char*)d_ws + WS_CTL, 0, CTL_ZERO_BYTES, stream);
    a.ph_lo = PROBE_RELAUNCH; a.ph_hi = PROBE_RELAUNCH + 1; hipLaunchKernelGGL(fwd_kernel, dim3(grid), dim3(NTHR), LDS_BYTES, stream, a);
    a.ph_lo = PROBE_RELAUNCH + 1; a.ph_hi = N_PHASES + 1; hipLaunchKernelGGL(fwd_kernel, dim3(grid), dim3(NTHR), LDS_BYTES, stream, a);
#else
    a.ph_lo = 0; a.ph_hi = N_PHASES + 1; hipLaunchKernelGGL(fwd_kernel, dim3(grid), dim3(NTHR), LDS_BYTES, stream, a);
#endif
}
```

```cpp
#include <hip/hip_runtime.h>
#include <cstdio>
#include <cstdint>

#ifndef PROBE_DUP
#define PROBE_DUP 0u
#endif
#define DI __device__ __forceinline__
#define LAS __attribute__((address_space(3)))

namespace pg8 {
#define PG8_LAS __attribute__((address_space(3)))
typedef unsigned short bf16_t;
typedef short bf16x8 __attribute__((ext_vector_type(8)));
typedef float f32x4 __attribute__((ext_vector_type(4)));
typedef unsigned u32x4 __attribute__((ext_vector_type(4)));
constexpr int BM = 256, BK = 64, HALF = 128, HTB = HALF * BK * 2  , STAGE_BYTES = 8 * HTB, NXCD = 8, WGM = 8;

__host__ __device__ __forceinline__ int lds_byte(int r, int c) { const int st = (r >> 4) * 2 + (c >> 5), rr = r & 15, cc = c & 31, ob = rr * 64 + cc * 2; return st * 1024 + (ob ^ (((ob >> 9) & 1) << 5)); }
__host__ __device__ __forceinline__ void stage_rc(int b, int& R, int& C) { const int st = b / 1024, sb = b % 1024, swz = sb ^ (((sb >> 9) & 1) << 5); R = (st >> 1) * 16 + swz / 64; C = (st & 1) * 32 + (swz % 64) / 2; }
__host__ __device__ __forceinline__ int perm32(int rho) { const int n = rho >> 4, i = rho & 15; return 8 * (i >> 2) + 4 * n + (i & 3); }

struct Unit { int pm, pn, pb; };
struct Gemm { const bf16_t* A; const bf16_t* Bt; int M, N, K; };

struct StaticOrder {
    int nM, nN, nwg, G, c;
    __host__ __device__ void init(int M, int N, int G_, int c_) { nM = M / BM; nN = N / BM; nwg = nM * nN; G = G_; c = c_; }
    __host__ __device__ bool next(int i, Unit& u) const {
        const long L = (long)i * G + c; if (L >= nwg) return false;
        int wgid = (int)L; { const int q = nwg / NXCD, r = nwg % NXCD, xcd = wgid % NXCD, off = wgid / NXCD; wgid = (xcd < r ? xcd * (q + 1) : r * (q + 1) + (xcd - r) * q) + off; }
        const int nig = WGM * nN, gid = wgid / nig, fm = gid * WGM, gsz = (nM - fm) < WGM ? (nM - fm) : WGM;
        u.pm = fm + ((wgid % nig) % gsz); u.pn = (wgid % nig) / gsz; u.pb = u.pn; return true;
    }
    __device__ __forceinline__ void a_ready(const Unit&) const {}
    __device__ __forceinline__ void done(const Unit&) const {}
};
struct MoeOrder {
    int nM, nN, nwg, G, c; int tend[8];
    __device__ bool next(int i, Unit& u) const {
        const long L = (long)i * G + c; if (L >= nwg) return false;
        int wgid = (int)L; { const int q = nwg / NXCD, r = nwg % NXCD, xcd = wgid % NXCD, off = wgid / NXCD; wgid = (xcd < r ? xcd * (q + 1) : r * (q + 1) + (xcd - r) * q) + off; }
        const int nig = WGM * nN, gid = wgid / nig, fm = gid * WGM, gsz = (nM - fm) < WGM ? (nM - fm) : WGM;
        u.pm = fm + ((wgid % nig) % gsz); u.pn = (wgid % nig) / gsz;
        int e = 0;
#pragma unroll
        for (int j = 0; j < 7; ++j) e += (u.pm >= tend[j]) ? 1 : 0;
        u.pb = e * nN + u.pn; return true;
    }
    __device__ __forceinline__ void a_ready(const Unit&) const {}
    __device__ __forceinline__ void done(const Unit&) const {}
};

typedef float f32x2_t __attribute__((ext_vector_type(2))); typedef __bf16 bf16x2_t __attribute__((ext_vector_type(2)));
__device__ __forceinline__ unsigned cvt_pk_bf16(float lo, float hi) { const f32x2_t v = {lo, hi}; const bf16x2_t b = __builtin_convertvector(v, bf16x2_t); return __builtin_bit_cast(unsigned, b); }

template <class Epi, class Sched>
__device__ __forceinline__ void gemm_phase(PG8_LAS unsigned char* lds, const Gemm g, const Sched& S, const Epi& E) {
    const int tid = threadIdx.x, wid = __builtin_amdgcn_readfirstlane(tid >> 6), lane = tid & 63, wr = wid >> 2, wc = wid & 3, fr = lane & 15, fq = lane >> 4;
    const int K = g.K, nt = K / BK;
    unsigned voffA[2], voffB[2];
#pragma unroll
    for (int i = 0; i < 2; ++i) { int R, C; stage_rc(tid * 16 + i * 8192, R, C); const int Rb = Epi::PERM ? ((R & ~31) + perm32(R & 31)) : R;
        voffA[i] = (unsigned)(R * K + C) * 2u; voffB[i] = (unsigned)(Rb * K + C) * 2u; }
    const size_t kstep = (size_t)(BK * 2);
    const size_t hstep = (size_t)HALF * K * 2;
    const size_t tstep = 2 * hstep;
    const unsigned ldsw = (unsigned)wid * 1024u;
    const int aoff = lds_byte(wr * 64 + fr, fq * 8), boff = lds_byte(wc * 32 + fr, fq * 8);
#define PG8_SA(b, h) (((b) * 2 + (h)) * HTB)
#define PG8_SB(b, h) ((4 + (b) * 2 + (h)) * HTB)
#define PG8_STAGE(bufoff, gbase, voff) do { _Pragma("unroll") for (int _i = 0; _i < 2; ++_i) \
        __builtin_amdgcn_global_load_lds((const unsigned*)((const char*)(gbase) + (voff)[_i]), (PG8_LAS unsigned*)(lds + (bufoff) + ldsw + _i * 8192), 16, 0, 0); } while (0)
#define PG8_LDA(dst, b, h) do { _Pragma("unroll") for (int m = 0; m < 4; ++m) _Pragma("unroll") for (int k = 0; k < 2; ++k) dst[m][k] = *(const PG8_LAS bf16x8*)(lds + PG8_SA(b, h) + aoff + m * 2048 + k * 1024); } while (0)
#define PG8_LDB(dst, b, h) do { _Pragma("unroll") for (int n = 0; n < 2; ++n) _Pragma("unroll") for (int k = 0; k < 2; ++k) dst[n][k] = *(const PG8_LAS bf16x8*)(lds + PG8_SB(b, h) + boff + n * 2048 + k * 1024); } while (0)
#define PG8_MMA(ai, bj, At, Bt) do { __builtin_amdgcn_s_setprio(1); _Pragma("unroll") for (int m = 0; m < 4; ++m) _Pragma("unroll") for (int n = 0; n < 2; ++n) _Pragma("unroll") for (int k = 0; k < 2; ++k) \
        acc[ai][bj][m][n] = __builtin_amdgcn_mfma_f32_16x16x32_bf16(Bt[n][k], At[m][k], acc[ai][bj][m][n], 0, 0, 0); __builtin_amdgcn_s_setprio(0); } while (0)
#define PG8_WAIT_V(n) asm volatile("s_waitcnt vmcnt(" #n ")" ::: "memory")
#define PG8_WAIT_L(n) asm volatile("s_waitcnt lgkmcnt(" #n ")" ::: "memory")
#define PG8_BAR __builtin_amdgcn_s_barrier()
#define PG8_SCHED __builtin_amdgcn_sched_barrier(0)
    Unit cur, nxt; int ui = 0;
    if (!S.next(0, cur)) return;
    f32x4 acc[2][2][4][2];
#pragma unroll
    for (int a = 0; a < 2; ++a)
#pragma unroll
        for (int b = 0; b < 2; ++b)
#pragma unroll
            for (int m = 0; m < 4; ++m)
#pragma unroll
                for (int n = 0; n < 2; ++n) acc[a][b][m][n] = (f32x4){0.f, 0.f, 0.f, 0.f};
    bf16x8 At[4][2], B0[2][2], B1[2][2];
    const char* cA = (const char*)g.A + (size_t)cur.pm * tstep; const char* cB = (const char*)g.Bt + (size_t)cur.pb * tstep;
    S.a_ready(cur);
    PG8_STAGE(PG8_SB(0, 0), cB, voffB); PG8_STAGE(PG8_SB(0, 1), cB + hstep, voffB); PG8_STAGE(PG8_SA(0, 0), cA, voffA); PG8_STAGE(PG8_SA(0, 1), cA + hstep, voffA);
    if (wr == 1) PG8_BAR;
    PG8_WAIT_V(2); PG8_BAR;
    PG8_STAGE(PG8_SB(1, 0), cB + kstep, voffB); PG8_STAGE(PG8_SA(1, 0), cA + kstep, voffA); PG8_STAGE(PG8_SB(1, 1), cB + hstep + kstep, voffB);
    PG8_WAIT_V(6); PG8_BAR;
    for (;;) {
        const bool has_next = S.next(ui + 1, nxt);
        const char* nA = has_next ? (const char*)g.A + (size_t)nxt.pm * tstep : cA; const char* nB = has_next ? (const char*)g.Bt + (size_t)nxt.pb * tstep : cB;
        for (int t = 0; t < nt; t += 2) {
            const bool last = (t == nt - 2);
            const char* a1 = cA + (size_t)(t + 1) * kstep;
            const char* a2 = last ? nA : cA + (size_t)(t + 2) * kstep; const char* b2 = last ? nB : cB + (size_t)(t + 2) * kstep;
            const char* a3 = a2 + kstep; const char* b3 = b2 + kstep;
            if (last && has_next) S.a_ready(nxt);
            PG8_LDB(B0, 0, 0); PG8_LDB(B1, 0, 1); PG8_SCHED; PG8_LDA(At, 0, 0); PG8_STAGE(PG8_SA(1, 1), a1 + hstep, voffA);
            PG8_WAIT_V(8); PG8_WAIT_L(0); PG8_BAR; PG8_MMA(0, 0, At, B0); PG8_MMA(0, 1, At, B1); PG8_BAR; PG8_SCHED;
            PG8_LDA(At, 0, 1); PG8_STAGE(PG8_SB(0, 0), b2, voffB); PG8_STAGE(PG8_SB(0, 1), b2 + hstep, voffB); PG8_STAGE(PG8_SA(0, 0), a2, voffA);
            PG8_WAIT_V(8); PG8_WAIT_L(0); PG8_BAR; PG8_MMA(1, 0, At, B0); PG8_MMA(1, 1, At, B1); PG8_BAR; PG8_SCHED;
            PG8_LDB(B0, 1, 0); PG8_LDB(B1, 1, 1); PG8_SCHED; PG8_LDA(At, 1, 0); PG8_STAGE(PG8_SA(0, 1), a2 + hstep, voffA);
            PG8_WAIT_V(8); PG8_WAIT_L(0); PG8_BAR; PG8_MMA(0, 0, At, B0); PG8_MMA(0, 1, At, B1); PG8_BAR; PG8_SCHED;
            PG8_LDA(At, 1, 1); PG8_STAGE(PG8_SB(1, 0), b3, voffB); PG8_STAGE(PG8_SB(1, 1), b3 + hstep, voffB); PG8_STAGE(PG8_SA(1, 0), a3, voffA);
            PG8_WAIT_V(8); PG8_WAIT_L(0); PG8_BAR; PG8_MMA(1, 0, At, B0); PG8_MMA(1, 1, At, B1); PG8_BAR; PG8_SCHED;
        }
        if (wr == 0) PG8_BAR;
        E(acc, cur, wr, wc, fr, fq); S.done(cur);
        if (!has_next) break;
#pragma unroll
        for (int a = 0; a < 2; ++a)
#pragma unroll
            for (int b = 0; b < 2; ++b)
#pragma unroll
                for (int m = 0; m < 4; ++m)
#pragma unroll
                    for (int n = 0; n < 2; ++n) acc[a][b][m][n] = (f32x4){0.f, 0.f, 0.f, 0.f};
        cur = nxt; cA = nA; cB = nB; ++ui;
        if (wr == 1) PG8_BAR;
    }
    PG8_WAIT_V(0);
    PG8_BAR;
#undef PG8_SA
#undef PG8_SB
#undef PG8_STAGE
#undef PG8_LDA
#undef PG8_LDB
#undef PG8_MMA
#undef PG8_WAIT_V
#undef PG8_WAIT_L
#undef PG8_BAR
#undef PG8_SCHED
}
}

constexpr int D = 1024, NB = 8, SEQ = 2048, CTXL = 256;
constexpr int ML = NB * SEQ;
constexpr int MC = NB * CTXL;
constexpr int MA = ML + MC;
constexpr int INW = 3584, FFN_H = 2816, EXP_H = 3584, NEXP = 8;
constexpr int NCH = 18;
constexpr int XG_ROWS = 34816;
constexpr int NWAVES = 8, NTHR = 512;

constexpr size_t MiB = 1u << 20;
constexpr size_t WS_CTL = 0, CTL_ZERO_BYTES = 1 * MiB;
constexpr size_t WS_MOD = 1 * MiB;
constexpr size_t WS_ROPE = 2 * MiB;
constexpr size_t WS_MISC = 3 * MiB;
constexpr size_t WS_W_IN = 4 * MiB, WS_W_OUT = 11 * MiB, WS_W_13 = 13 * MiB, WS_W_2 = 24 * MiB, WS_W_RKV = 30 * MiB, WS_W_L1 = 36 * MiB,
                 WS_W_L2 = 38 * MiB, WS_W_G2 = 40 * MiB, WS_W_O = 41 * MiB, WS_W_M13 = 43 * MiB, WS_W_M2 = 155 * MiB;
constexpr size_t WS_XC = 211 * MiB, WS_H = 219 * MiB, WS_MIX = 255 * MiB, WS_R = 291 * MiB;
constexpr size_t WS_QKV = WS_R, WS_KV = WS_R + 126 * MiB, WS_SPREV = WS_R + 198 * MiB, WS_FFH = WS_R;
constexpr size_t WS_NQ = WS_R + 240 * MiB, WS_NK = WS_R + 260 * MiB, WS_NV = WS_R + 280 * MiB;
constexpr size_t WS_XM = WS_R, WS_DEC = WS_R, WS_AG = WS_R + 144 * MiB, WS_RB = WS_R + 216 * MiB, WS_KB = WS_R + 248 * MiB, WS_VB = WS_R + 284 * MiB,
                 WS_L1 = WS_R + 320 * MiB, WS_LG = WS_R + 329 * MiB, WS_G = WS_R + 337 * MiB, WS_YF = WS_R + 369 * MiB, WS_YB = WS_R + 433 * MiB;
constexpr size_t WS_COEF = WS_R + 401 * MiB;
constexpr size_t WS_XG = WS_R, WS_HG = WS_R + 68 * MiB, WS_YS = WS_R + 306 * MiB, WS_ROWS = WS_R + 370 * MiB;
constexpr size_t WS_END = WS_R + 497 * MiB;
static_assert(WS_END <= 896 * MiB, "workspace map");
constexpr int CW_BAR = 4096;
constexpr size_t MISC_TOPE = 0, MISC_TOPW = 65536, MISC_CNTS = 196608, MISC_EXP = 204800;

constexpr int LDS_MAIN = 147456;
constexpr int LDS_MISC_OFF = LDS_MAIN;
constexpr int LDS_BYTES = LDS_MAIN + 256;

typedef unsigned short bf16;
typedef short bf16x8 __attribute__((ext_vector_type(8)));
typedef short s16x4 __attribute__((ext_vector_type(4)));
typedef float f32x4 __attribute__((ext_vector_type(4)));
typedef float f32x2 __attribute__((ext_vector_type(2)));
typedef unsigned u32x4 __attribute__((ext_vector_type(4)));
typedef unsigned u32x2 __attribute__((ext_vector_type(2)));
#define LDS_WAIT() asm volatile("s_waitcnt lgkmcnt(0)" ::: "memory")
#define VM_WAIT() asm volatile("s_waitcnt vmcnt(0)" ::: "memory")
#define WG_SYNC() __syncthreads()
#define LDS_BARRIER() do { asm volatile("s_waitcnt lgkmcnt(0)" ::: "memory"); __builtin_amdgcn_s_barrier(); asm volatile("" ::: "memory"); } while (0)
DI unsigned f2bf(float f) { unsigned u = __builtin_bit_cast(unsigned, f); return (u + 0x7fffu + ((u >> 16) & 1u)) >> 16; }
typedef __bf16 bf16x2_t __attribute__((ext_vector_type(2)));
DI unsigned pk2(float lo, float hi) { const f32x2 v = {lo, hi}; const bf16x2_t b = __builtin_convertvector(v, bf16x2_t); return __builtin_bit_cast(unsigned, b); }
DI float bflo(unsigned w) { return __builtin_bit_cast(float, w << 16); }
DI float bfhi(unsigned w) { return __builtin_bit_cast(float, w & 0xffff0000u); }
DI float bf1(bf16 b) { return __builtin_bit_cast(float, (unsigned)b << 16); }
DI float wave_sum(float v) {
#pragma unroll
    for (int o = 1; o < 64; o <<= 1) v += __shfl_xor(v, o);
    return v;
}
DI float dpp_rm(float v) { return __builtin_bit_cast(float, __builtin_amdgcn_update_dpp(0, __builtin_bit_cast(int, v), 0x140, 0xf, 0xf, true)); }
DI float wave_sum_fast(float v) {
    v += __builtin_bit_cast(float, __builtin_amdgcn_update_dpp(0, __builtin_bit_cast(int, v), 0xB1, 0xf, 0xf, true));
    v += __builtin_bit_cast(float, __builtin_amdgcn_update_dpp(0, __builtin_bit_cast(int, v), 0x4E, 0xf, 0xf, true));
    v += __builtin_bit_cast(float, __builtin_amdgcn_update_dpp(0, __builtin_bit_cast(int, v), 0x141, 0xf, 0xf, true));
    v += dpp_rm(v);
    const int iv = __builtin_bit_cast(int, v);
    const float a = __builtin_bit_cast(float, __builtin_amdgcn_readlane(iv, 0)), b = __builtin_bit_cast(float, __builtin_amdgcn_readlane(iv, 16));
    const float c = __builtin_bit_cast(float, __builtin_amdgcn_readlane(iv, 32)), d = __builtin_bit_cast(float, __builtin_amdgcn_readlane(iv, 48));
    return (a + b) + (c + d);
}
DI float wave_max(float v) {
#pragma unroll
    for (int o = 1; o < 64; o <<= 1) v = fmaxf(v, __shfl_xor(v, o));
    return v;
}
DI float dpp_x1(float v) { return __builtin_bit_cast(float, __builtin_amdgcn_update_dpp(0, __builtin_bit_cast(int, v), 0xB1, 0xf, 0xf, true)); }
DI float dpp_x2(float v) { return __builtin_bit_cast(float, __builtin_amdgcn_update_dpp(0, __builtin_bit_cast(int, v), 0x4E, 0xf, 0xf, true)); }
DI float dpp_hm(float v) { return __builtin_bit_cast(float, __builtin_amdgcn_update_dpp(0, __builtin_bit_cast(int, v), 0x141, 0xf, 0xf, true)); }
DI float red4(float v) { v += dpp_x1(v); v += dpp_x2(v); return v; }
DI float red8(float v) { v += dpp_x1(v); v += dpp_x2(v); v += dpp_hm(v); return v; }
DI float sigmoidf_(float x) { return 1.f / (1.f + __expf(-x)); }
DI float siluf_(float x) { return x / (1.f + __expf(-x)); }

DI bf16x8 frag_kc(const LAS bf16* base, int ld, int row0, int k0, int lane) {
    return *(const LAS bf16x8*)(base + (row0 + (lane & 15)) * ld + k0 + 8 * (lane >> 4));
}
DI bf16x8 frag_kr(const LAS bf16* base, int ld, int x0, int k0, int lane) {
    const int g = lane >> 4, q = (lane & 15) >> 2, p = lane & 3;
    const LAS bf16* a = base + (k0 + 8 * g + q) * ld + x0 + 4 * p;
    const s16x4 lo = __builtin_amdgcn_ds_read_tr16_b64_v4i16((LAS s16x4*)a);
    const s16x4 hi = __builtin_amdgcn_ds_read_tr16_b64_v4i16((LAS s16x4*)(a + 4 * ld));
    return __builtin_shufflevector(lo, hi, 0, 1, 2, 3, 4, 5, 6, 7);
}
DI f32x4 mma(f32x4 acc, bf16x8 bfrag, bf16x8 afrag) { return __builtin_amdgcn_mfma_f32_16x16x32_bf16(bfrag, afrag, acc, 0, 0, 0); }

#define XB_TMO      128
#define XB_XCNT(j)  (256  + 64 * (j))
#define XB_XSUB(j)  (1280 + 64 * (j))
#define XB_XGEN(j)  (2304 + 64 * (j))
#define XB_TOP      3328
#define XB_TOPGEN   3392
#define XCD_BAR_WORDS 3456
#define XB_SPIN_CAP (1u << 18)
DI unsigned xb_ld(unsigned* p)              { return __hip_atomic_load(p, __ATOMIC_RELAXED, __HIP_MEMORY_SCOPE_AGENT); }
DI unsigned xb_add(unsigned* p, unsigned v) { return __hip_atomic_fetch_add(p, v, __ATOMIC_RELAXED, __HIP_MEMORY_SCOPE_AGENT); }
DI unsigned xb_xcc_id() { return (unsigned)__builtin_amdgcn_s_getreg((3 << 11) | 20) & 0xFu; }
#define XB_SPIN(cond, bar) do { unsigned _sp = 0; while (cond) { __builtin_amdgcn_s_sleep(1); \
    if ((++_sp & 255u) == 0u) { if (xb_ld(&(bar)[XB_TMO])) break; if (_sp > XB_SPIN_CAP) { atomicAdd(&(bar)[XB_TMO], 1u); break; } } } } while (0)
struct XcdBarrier { unsigned* bar; unsigned x; volatile LAS unsigned* st; };
DI XcdBarrier xcd_barrier_post(unsigned* bar, volatile LAS unsigned* st) {
    XcdBarrier b; b.bar = bar; b.x = xb_xcc_id(); b.st = st;
    if (threadIdx.x == 0) (void)xb_add(&bar[XB_XCNT(b.x)], 1u);
    return b;
}
DI void xcd_barrier_complete(unsigned* bar, unsigned x, unsigned& nloc, unsigned& nx) {
    const unsigned G = gridDim.x * gridDim.y * gridDim.z;
    unsigned sum, cnt, mine, sp = 0u;
    for (;;) {
        sum = 0u; cnt = 0u; mine = 0u;
#pragma unroll
        for (unsigned j = 0; j < 16; ++j) { const unsigned c = xb_ld(&bar[XB_XCNT(j)]); sum += c; cnt += (c > 0u) ? 1u : 0u; mine = (j == x) ? c : mine; }
        if (sum == G) break;
        __builtin_amdgcn_s_sleep(1);
        if ((++sp & 255u) == 0u) { if (xb_ld(&bar[XB_TMO])) break; if (sp > XB_SPIN_CAP) { atomicAdd(&bar[XB_TMO], 1u); break; } }
    }
    nloc = mine > 0u ? mine : 1u; nx = cnt > 0u ? cnt : 1u;
}
DI void xcd_barrier(const XcdBarrier& b) {
    asm volatile("s_waitcnt vmcnt(0)" ::: "memory");
    __syncthreads();
    if (threadIdx.x == 0) {
        unsigned* bar = b.bar;
        __builtin_amdgcn_s_waitcnt(0);
        unsigned nloc = b.st[0], nx = b.st[1];
        if (nloc == 0u) { xcd_barrier_complete(bar, b.x, nloc, nx); b.st[0] = nloc; b.st[1] = nx; }
        const unsigned old = xb_add(&bar[XB_XSUB(b.x)], 1u);
        const unsigned gen = old / nloc;
        if (old + 1u == (gen + 1u) * nloc) {
            __builtin_amdgcn_fence(__ATOMIC_RELEASE, "agent");
            asm volatile("s_waitcnt vmcnt(0)" ::: "memory");
            const unsigned og = xb_add(&bar[XB_TOP], 1u);
            const unsigned tg = og / nx;
            if (og + 1u == (tg + 1u) * nx) xb_add(&bar[XB_TOPGEN], 1u);
            else XB_SPIN(xb_ld(&bar[XB_TOPGEN]) == tg, bar);
            __builtin_amdgcn_fence(__ATOMIC_ACQUIRE, "agent");
            xb_add(&bar[XB_XGEN(b.x)], 1u);
            asm volatile("s_waitcnt vmcnt(0)" ::: "memory");
        } else {
            XB_SPIN(xb_ld(&bar[XB_XGEN(b.x)]) == gen, bar);
            __builtin_amdgcn_fence(__ATOMIC_ACQUIRE, "agent");
            asm volatile("s_waitcnt vmcnt(0)" ::: "memory");
        }
    }
    __syncthreads();
}

struct Fr {
    LAS unsigned char* lds;
    unsigned char* ws;
    const float* const* in;
    float* out;
    int tid, lane, wave, bx, G, gw, NGW;
};

using pg8::Unit;
template <int ACT  > struct EpiStore {
    static constexpr bool PERM = true;
    bf16* O; int ldc; int nvalid;
    DI void operator()(const f32x4 (&acc)[2][2][4][2], const Unit& u, int wr, int wc, int fr, int fq) const {
        const int row0 = u.pm * 256 + wr * 64 + fr, col0 = u.pn * 256 + wc * 32 + 8 * fq;
#pragma unroll
        for (int ai = 0; ai < 2; ++ai)
#pragma unroll
            for (int m = 0; m < 4; ++m) { bf16* rowp = O + (size_t)(row0 + ai * 128 + m * 16) * ldc + col0;
#pragma unroll
                for (int bj = 0; bj < 2; ++bj) { if (u.pn * 256 + bj * 128 >= nvalid) continue;
                    f32x4 v0 = acc[ai][bj][m][0], v1 = acc[ai][bj][m][1];
                    if (ACT == 1) {
#pragma unroll
                        for (int j = 0; j < 4; ++j) { v0[j] = tanhf(v0[j]); v1[j] = tanhf(v1[j]); } }
                    if (ACT == 2) {
#pragma unroll
                        for (int j = 0; j < 4; ++j) { v0[j] = sigmoidf_(v0[j]); v1[j] = sigmoidf_(v1[j]); } }
                    u32x4 w; w.x = pg8::cvt_pk_bf16(v0[0], v0[1]); w.y = pg8::cvt_pk_bf16(v0[2], v0[3]); w.z = pg8::cvt_pk_bf16(v1[0], v1[1]); w.w = pg8::cvt_pk_bf16(v1[2], v1[3]);
                    *(u32x4*)(rowp + bj * 128) = w; } }
    }
};
struct EpiStoreHead {
    static constexpr bool PERM = true;
    bf16* O; int TL; int lat_off;
    DI void operator()(const f32x4 (&acc)[2][2][4][2], const Unit& u, int wr, int wc, int fr, int fq) const {
        const bool lat = u.pm < 64; const int b = lat ? (u.pm >> 3) : (u.pm - 64); const int sbase = lat ? lat_off + (u.pm & 7) * 256 : 0;
        const int rt0 = sbase + wr * 64 + fr, j = (wc & 1) * 32 + 8 * fq;
#pragma unroll
        for (int ai = 0; ai < 2; ++ai)
#pragma unroll
            for (int m = 0; m < 4; ++m)
#pragma unroll
                for (int bj = 0; bj < 2; ++bj) { const int h = 4 * u.pn + 2 * bj + (wc >> 1);
                    const f32x4 v0 = acc[ai][bj][m][0], v1 = acc[ai][bj][m][1];
                    u32x4 w; w.x = pg8::cvt_pk_bf16(v0[0], v0[1]); w.y = pg8::cvt_pk_bf16(v0[2], v0[3]); w.z = pg8::cvt_pk_bf16(v1[0], v1[1]); w.w = pg8::cvt_pk_bf16(v1[2], v1[3]);
                    *(u32x4*)(O + ((size_t)(b * 16 + h) * TL + rt0 + ai * 128 + m * 16) * 64 + j) = w; }
    }
};
struct EpiResid {
    static constexpr bool PERM = false;
    const float* baseL; float* outL; const float* baseC; float* outC; const float* modg;
    DI void operator()(const f32x4 (&acc)[2][2][4][2], const Unit& u, int wr, int wc, int fr, int fq) const {
        const bool lat = u.pm < 64; const int r = lat ? (u.pm >> 3) : 8;
        const float* base = lat ? baseL : baseC; float* out = lat ? outL : outC;
        const int row0 = (lat ? u.pm : u.pm - 64) * 256 + wr * 64 + fr, col0 = u.pn * 256 + wc * 32 + 4 * fq;
        const float* mg = modg + (size_t)r * 6144 + col0;
        f32x4 mv[2][2];
#pragma unroll
        for (int bj = 0; bj < 2; ++bj)
#pragma unroll
            for (int n = 0; n < 2; ++n) mv[bj][n] = *(const f32x4*)(mg + bj * 128 + n * 16);
#pragma unroll
        for (int ai = 0; ai < 2; ++ai)
#pragma unroll
            for (int m = 0; m < 4; ++m) { const size_t off = (size_t)(row0 + ai * 128 + m * 16) * D + col0;
#pragma unroll
                for (int bj = 0; bj < 2; ++bj)
#pragma unroll
                    for (int n = 0; n < 2; ++n) { const f32x4 bs = *(const f32x4*)(base + off + bj * 128 + n * 16);
                        *(f32x4*)(out + off + bj * 128 + n * 16) = bs + mv[bj][n] * acc[ai][bj][m][n]; } }
    }
};
struct EpiSwiglu {
    static constexpr bool PERM = true;
    bf16* Hd; int ldh;
    DI void operator()(const f32x4 (&acc)[2][2][4][2], const Unit& u, int wr, int wc, int fr, int fq) const {
        const int row0 = u.pm * 256 + wr * 64 + fr, col0 = u.pn * 128 + wc * 32 + 8 * fq;
#pragma unroll
        for (int ai = 0; ai < 2; ++ai)
#pragma unroll
            for (int m = 0; m < 4; ++m) { bf16* rowp = Hd + (size_t)(row0 + ai * 128 + m * 16) * ldh + col0;
                f32x4 v0, v1;
#pragma unroll
                for (int j = 0; j < 4; ++j) { v0[j] = siluf_(acc[ai][0][m][0][j]) * acc[ai][1][m][0][j]; v1[j] = siluf_(acc[ai][0][m][1][j]) * acc[ai][1][m][1][j]; }
                u32x4 w; w.x = pg8::cvt_pk_bf16(v0[0], v0[1]); w.y = pg8::cvt_pk_bf16(v0[2], v0[3]); w.z = pg8::cvt_pk_bf16(v1[0], v1[1]); w.w = pg8::cvt_pk_bf16(v1[2], v1[3]);
                *(u32x4*)rowp = w; }
    }
};
struct EpiLora2 {
    static constexpr bool PERM = true;
    bf16* DEC; bf16* AG; const float* w0; const float* a0;
    DI void operator()(const f32x4 (&acc)[2][2][4][2], const Unit& u, int wr, int wc, int fr, int fq) const {
        const int q = u.pn >> 2, z = q & 1; const int col0 = (u.pn & 3) * 256 + wc * 32 + 8 * fq;
        const bool lat = u.pm < 64; const int b = lat ? (u.pm >> 3) : (u.pm - 64); const int rt0 = (lat ? CTXL + (u.pm & 7) * 256 : 0) + wr * 64 + fr, j = (wc & 1) * 32 + 8 * fq;
        const float* bias = (q < 2 ? w0 : a0) + z * 1024 + col0;
        f32x4 bv[2][2];
#pragma unroll
        for (int bj = 0; bj < 2; ++bj)
#pragma unroll
            for (int n = 0; n < 2; ++n) bv[bj][n] = *(const f32x4*)(bias + bj * 128 + 4 * n);
#pragma unroll
        for (int ai = 0; ai < 2; ++ai)
#pragma unroll
            for (int m = 0; m < 4; ++m) {
#pragma unroll
                for (int bj = 0; bj < 2; ++bj) { f32x4 v0 = acc[ai][bj][m][0] + bv[bj][0], v1 = acc[ai][bj][m][1] + bv[bj][1];
                    const int h = 4 * (u.pn & 3) + 2 * bj + (wc >> 1);
                    const size_t off = ((size_t)(z * 128 + b * 16 + h) * (SEQ + CTXL) + rt0 + ai * 128 + m * 16) * 64 + j;
                    if (q < 2) {
#pragma unroll
                        for (int jj = 0; jj < 4; ++jj) {
                            v0[jj] = -0.6065306597126334f * sigmoidf_(v0[jj]); v1[jj] = -0.6065306597126334f * sigmoidf_(v1[jj]); }
                        u32x4 w; w.x = pg8::cvt_pk_bf16(v0[0], v0[1]); w.y = pg8::cvt_pk_bf16(v0[2], v0[3]); w.z = pg8::cvt_pk_bf16(v1[0], v1[1]); w.w = pg8::cvt_pk_bf16(v1[2], v1[3]);
                        *(u32x4*)(DEC + off) = w; __builtin_amdgcn_sched_barrier(0);
                    } else {
#pragma unroll
                        for (int jj = 0; jj < 4; ++jj) { v0[jj] = sigmoidf_(v0[jj]); v1[jj] = sigmoidf_(v1[jj]); }
                        u32x4 w; w.x = pg8::cvt_pk_bf16(v0[0], v0[1]); w.y = pg8::cvt_pk_bf16(v0[2], v0[3]); w.z = pg8::cvt_pk_bf16(v1[0], v1[1]); w.w = pg8::cvt_pk_bf16(v1[2], v1[3]);
                        *(u32x4*)(AG + off) = w; __builtin_amdgcn_sched_barrier(0); } } }
    }
};
struct EpiMoeOut {
    static constexpr bool PERM = true;
    bf16* YS; const int* RowTok; const float* RowW;
    DI void operator()(const f32x4 (&acc)[2][2][4][2], const Unit& u, int wr, int wc, int fr, int fq) const {
        const int row0 = u.pm * 256 + wr * 64 + fr, col0 = u.pn * 256 + wc * 32 + 8 * fq;
#pragma unroll
        for (int ai = 0; ai < 2; ++ai)
#pragma unroll
            for (int m = 0; m < 4; ++m) { const int row = row0 + ai * 128 + m * 16; const int t2 = RowTok[row]; if (t2 < 0) continue; const float w = RowW[row];
                bf16* rowp = YS + (size_t)t2 * D + col0;
#pragma unroll
                for (int bj = 0; bj < 2; ++bj) { const f32x4 v0 = acc[ai][bj][m][0] * w, v1 = acc[ai][bj][m][1] * w;
                    u32x4 o; o.x = pg8::cvt_pk_bf16(v0[0], v0[1]); o.y = pg8::cvt_pk_bf16(v0[2], v0[3]); o.z = pg8::cvt_pk_bf16(v1[0], v1[1]); o.w = pg8::cvt_pk_bf16(v1[2], v1[3]);
                    *(u32x4*)(rowp + bj * 128) = o; } }
    }
};

DI void tr_item(const float* src, int ldsrc, int Kreal, int k0, int n0, bf16* dst, int lddst, int drow0, int dcol0, LAS float* scr, int lane) {
#pragma unroll 8
    for (int i = 0; i < 32; ++i) { const int kk = 2 * i + (lane >> 5), k = k0 + kk; float v = 0.f; if (k < Kreal) v = src[(size_t)k * ldsrc + n0 + (lane & 31)]; scr[kk * 33 + (lane & 31)] = v; }
    LDS_WAIT();
    const int c = lane & 7;
#pragma unroll
    for (int j = 0; j < 4; ++j) { const int n = (lane >> 3) + 8 * j; const LAS float* s = scr + (8 * c) * 33 + n;
        u32x4 o; o.x = pk2(s[0 * 33], s[1 * 33]); o.y = pk2(s[2 * 33], s[3 * 33]); o.z = pk2(s[4 * 33], s[5 * 33]); o.w = pk2(s[6 * 33], s[7 * 33]);
        *(u32x4*)(dst + (size_t)(drow0 + n) * lddst + dcol0 + k0 + 8 * c) = o; }
    LDS_WAIT();
}
DI void tr_plain(const float* src, int K, int N, bf16* dst, int r, LAS float* scr, int lane) {
    const int nblk = N / 32, kb = r / nblk, nb = r % nblk; tr_item(src, N, K, 64 * kb, 32 * nb, dst, K, 32 * nb, 0, scr, lane);
}
DI void tr_gateup(const float* src, int K, int Hh, bf16* dst, int r, LAS float* scr, int lane) {
    const int nblk = 2 * Hh / 32, kb = r / nblk, nb = r % nblk, n0 = 32 * nb, half = n0 / Hh, j0 = n0 % Hh;
    tr_item(src, 2 * Hh, K, 64 * kb, n0, dst, K, (j0 / 128) * 256 + half * 128 + (j0 % 128), 0, scr, lane);
}
DI void tr16_item(const float* src, int ldsrc, int k0, int n0, bf16* dst, int lddst, int Hh, int lane) {
    f32x4 v[16];
#pragma unroll
    for (int kk = 0; kk < 16; ++kk) v[kk] = *(const f32x4*)(src + (size_t)(k0 + kk) * ldsrc + n0 + 4 * lane);
    const int n = n0 + 4 * lane; int drow = n;
    if (Hh) { const int half = n / Hh, j = n % Hh; drow = (j / 128) * 256 + half * 128 + (j % 128); }
#pragma unroll
    for (int q = 0; q < 4; ++q) { u32x4 o0, o1;
        o0.x = pk2(v[0][q], v[1][q]); o0.y = pk2(v[2][q], v[3][q]); o0.z = pk2(v[4][q], v[5][q]); o0.w = pk2(v[6][q], v[7][q]);
        o1.x = pk2(v[8][q], v[9][q]); o1.y = pk2(v[10][q], v[11][q]); o1.z = pk2(v[12][q], v[13][q]); o1.w = pk2(v[14][q], v[15][q]);
        bf16* d = dst + (size_t)(drow + q) * lddst + k0; *(u32x4*)d = o0; *(u32x4*)(d + 8) = o1; }
}
DI void tr64_item(const float* src, int ldsrc, int k0, int n0, bf16* dst, int lddst, int Hh, int lane) {
    float v[64];
    const float* sp = src + (size_t)k0 * ldsrc + n0 + lane;
#pragma unroll
    for (int kk = 0; kk < 64; ++kk) v[kk] = sp[(size_t)kk * ldsrc];
    const int n = n0 + lane; int drow = n;
    if (Hh) { const int half = n / Hh, j = n % Hh; drow = (j / 128) * 256 + half * 128 + (j % 128); }
    bf16* d = dst + (size_t)drow * lddst + k0;
#pragma unroll
    for (int c = 0; c < 8; ++c) { u32x4 o; o.x = pk2(v[8 * c], v[8 * c + 1]); o.y = pk2(v[8 * c + 2], v[8 * c + 3]); o.z = pk2(v[8 * c + 4], v[8 * c + 5]); o.w = pk2(v[8 * c + 6], v[8 * c + 7]);
        *(u32x4*)(d + 8 * c) = o; }
}
DI void tr16_mat(const float* src, int K, int N, bf16* dst, int Hh, int r, int lane) { const int nb = N / 64; tr64_item(src, N, 64 * (r / nb), 64 * (r % nb), dst, K, Hh, lane); }
constexpr int MOE_B13 = 16 * 112, MOE_B2 = 56 * 16, MOE_ITEMS = 8 * MOE_B13 + 8 * MOE_B2;
DI void moe_fill(Fr& F, int slot, int nslots, int i0, int i1) {
    if (slot < 0 || slot >= nslots) return;
    bf16* W_M13 = (bf16*)(F.ws + WS_W_M13); bf16* W_M2 = (bf16*)(F.ws + WS_W_M2);
    for (int r = i0 + slot * NWAVES + F.wave; r < i1; r += nslots * NWAVES) {
        if (r < 8 * MOE_B13) { const int e = r / MOE_B13; tr16_mat(F.in[35] + (size_t)e * 1024 * 7168, 1024, 7168, W_M13 + (size_t)e * 7168 * 1024, EXP_H, r % MOE_B13, F.lane); }
        else { const int r2 = r - 8 * MOE_B13, e = r2 / MOE_B2; tr16_mat(F.in[36] + (size_t)e * EXP_H * 1024, EXP_H, 1024, W_M2 + (size_t)e * 1024 * EXP_H, 0, r2 % MOE_B2, F.lane); }
    }
}
DI void p0_prologue(Fr& F) {
    LAS float* scr = (LAS float*)(F.lds + F.wave * 16384);
    const float* const* in = F.in;
    bf16* W_IN = (bf16*)(F.ws + WS_W_IN); bf16* W_OUT = (bf16*)(F.ws + WS_W_OUT); bf16* W_13 = (bf16*)(F.ws + WS_W_13); bf16* W_2 = (bf16*)(F.ws + WS_W_2);
    bf16* W_RKV = (bf16*)(F.ws + WS_W_RKV); bf16* W_L1 = (bf16*)(F.ws + WS_W_L1); bf16* W_L2 = (bf16*)(F.ws + WS_W_L2); bf16* W_G2 = (bf16*)(F.ws + WS_W_G2);
    bf16* W_O = (bf16*)(F.ws + WS_W_O);
    for (int prep_ = 0; prep_ < ((((PROBE_DUP) >> 21) & 1u) ? 2 : 1); ++prep_) {
        constexpr int B_IN = 16 * 56, B_OUT = 16 * 16, B_13 = 16 * 88, B_2 = 44 * 16, B_RKV = 256, B_O = 256;
        constexpr int NB_ITEMS = B_IN + B_OUT + B_13 + B_2 + 3 * B_RKV + B_O;
        for (int it = F.gw; it < NB_ITEMS; it += F.NGW) {
            int r = it;
            if (r < B_IN) { tr16_mat(in[8], 1024, INW, W_IN, 0, r, F.lane); continue; } r -= B_IN;
            if (r < B_OUT) { tr16_mat(in[15], 1024, 1024, W_OUT, 0, r, F.lane); continue; } r -= B_OUT;
            if (r < B_13) { tr16_mat(in[16], 1024, 2 * FFN_H, W_13, FFN_H, r, F.lane); continue; } r -= B_13;
            if (r < B_2) { tr16_mat(in[17], FFN_H, 1024, W_2, 0, r, F.lane); continue; } r -= B_2;
            if (r < 3 * B_RKV) { const int sx = r / B_RKV; tr16_mat(in[19] + (size_t)sx * 1024 * 1024, 1024, 1024, W_RKV + (size_t)sx * 1024 * 1024, 0, r % B_RKV, F.lane); continue; } r -= 3 * B_RKV;
            tr16_mat(in[33], 1024, 1024, W_O, 0, r, F.lane);
        }
    }
    constexpr int I_W1 = 2 * 32, I_A1 = 2 * 32, I_G1 = 16 * 5, I_L2 = 4 * 32, I_G2 = 4 * 32;
    constexpr int NITEMS = I_W1 + I_A1 + I_G1 + I_L2 + I_G2;
    for (int it = F.gw; it < NITEMS; it += F.NGW) {
        int r = it;
        if (r < I_W1) { const int z = r / 32, rr = r % 32; tr_item(in[21] + (size_t)z * 1024 * 64, 64, 1024, 64 * (rr / 2), 32 * (rr % 2), W_L1, 1024, z * 64 + 32 * (rr % 2), 0, scr, F.lane); continue; } r -= I_W1;
        if (r < I_A1) { const int z = r / 32, rr = r % 32; tr_item(in[24] + (size_t)z * 1024 * 64, 64, 1024, 64 * (rr / 2), 32 * (rr % 2), W_L1 + 256 * 1024, 1024, z * 64 + 32 * (rr % 2), 0, scr, F.lane); continue; } r -= I_A1;
        if (r < I_G1) { tr_item(in[26], 160, 1024, 64 * (r / 5), 32 * (r % 5), W_L1 + 2 * 256 * 1024, 1024, 32 * (r % 5), 0, scr, F.lane); continue; } r -= I_G1;
        if (r < I_L2) { const int q = r / 32, nb = r % 32; const float* src = (q < 2 ? in[22] : in[25]) + (size_t)(q & 1) * 64 * 1024;
            for (int i = F.lane; i < 32 * 24; i += 64) { const int row = i / 24, ch = i % 24; const int col = 8 * ch + (8 * ch >= q * 64 ? 64 : 0);
                *(u32x4*)(W_L2 + (size_t)(q * 1024 + 32 * nb + row) * 256 + col) = (u32x4){0u, 0u, 0u, 0u}; }
            tr_item(src, 1024, 64, 0, 32 * nb, W_L2, 256, q * 1024 + 32 * nb, q * 64, scr, F.lane); continue; } r -= I_L2;
        tr_item(in[27], 1024, 160, 64 * (r / 32), 32 * (r % 32), W_G2, 256, 32 * (r % 32), 0, scr, F.lane);
    }
    { const int gt = F.bx * NTHR + F.tid, NT = F.G * NTHR;
      for (int i = gt; i < (128 + 128 + 96) * 128; i += NT) { int row = i / 128; const int ch = i % 128; int mat = 0;
          if (row >= 256) { mat = 2; row = row - 256 + 160; } else if (row >= 128) { mat = 1; } else { row += 128; }
          *(u32x4*)(W_L1 + ((size_t)mat * 256 + row) * 1024 + 8 * ch) = (u32x4){0u, 0u, 0u, 0u}; }
      f32x2* rope = (f32x2*)(F.ws + WS_ROPE);
      for (int i = gt; i < 2048; i += NT) { const int pos = i >> 5, j = i & 31; const float fr = powf(10000.f, -(float)j / 32.f), ang = (float)pos * fr; rope[i] = (f32x2){cosf(ang), sinf(ang)}; }
    }
    WG_SYNC();
    for (int prep_ = 0; prep_ < ((((PROBE_DUP) >> 23) & 1u) ? 2 : 1); ++prep_)
    for (int u = F.bx; u < 192; u += F.G) {
        const int li = u / 96, n0 = (u % 96) * 64;
        LAS float* sm = (LAS float*)F.lds;
        for (int idx = F.tid; idx < 9 * 1024; idx += NTHR) { const int r = idx >> 10, k = idx & 1023; const float cv = (r < 8) ? in[1][r * 1024 + k] : in[3][k]; sm[idx] = cv / (1.f + expf(-cv)); }
        WG_SYNC();
        const int ks = F.tid >> 4, cg4 = F.tid & 15;
        f32x4 acc[9];
#pragma unroll
        for (int r = 0; r < 9; ++r) acc[r] = (f32x4){0.f, 0.f, 0.f, 0.f};
        const float* w = in[4] + (size_t)li * 1024 * 6144 + n0 + 4 * cg4;
#pragma unroll 8
        for (int k = ks * 32; k < ks * 32 + 32; ++k) { const f32x4 wv = *(const f32x4*)(w + (size_t)k * 6144);
#pragma unroll
            for (int r = 0; r < 9; ++r) acc[r] += wv * sm[r * 1024 + k]; }
        LAS float* red = sm + 9 * 1024;
#pragma unroll
        for (int r = 0; r < 9; ++r) *(LAS f32x4*)(red + (ks * 9 + r) * 64 + 4 * cg4) = acc[r];
        WG_SYNC();
        float* MOD = (float*)(F.ws + WS_MOD);
        for (int idx = F.tid; idx < 9 * 64; idx += NTHR) { const int r = idx / 64, n2 = idx % 64; float s = 0.f;
#pragma unroll
            for (int q = 0; q < 32; ++q) s += red[(q * 9 + r) * 64 + n2];
            MOD[((size_t)li * 9 + r) * 6144 + n0 + n2] = s + in[5][li * 6144 + n0 + n2]; }
        WG_SYNC();
    }
}

DI void mod_rows(Fr& F, const float* xl, const float* xc, int nrows, const float* normw, const float* modl, int off_shift, int off_scale, bf16* H) {
    for (int g = F.gw; g < nrows / 4; g += F.NGW) {
        const int row0 = 4 * g;
        const float* src = row0 < ML ? xl + (size_t)row0 * D : xc + (size_t)(row0 - ML) * D;
        const float* mrow = modl + (size_t)(row0 < ML ? row0 / SEQ : 8) * 6144;
        f32x4 v[4][4];
#pragma unroll
        for (int r = 0; r < 4; ++r)
#pragma unroll
            for (int j = 0; j < 4; ++j) v[r][j] = ((const f32x4*)(src + (size_t)r * D))[F.lane + 64 * j];
        f32x4 gsc[4], gsh[4];
#pragma unroll
        for (int j = 0; j < 4; ++j) { const int c4 = F.lane + 64 * j; gsc[j] = ((const f32x4*)normw)[c4] * (((const f32x4*)(mrow + off_scale))[c4] + 1.f); gsh[j] = ((const f32x4*)(mrow + off_shift))[c4]; }
#pragma unroll
        for (int r = 0; r < 4; ++r) { float ss = 0.f;
#pragma unroll
            for (int j = 0; j < 4; ++j) ss += (v[r][j].x * v[r][j].x + v[r][j].y * v[r][j].y) + (v[r][j].z * v[r][j].z + v[r][j].w * v[r][j].w);
            const float rstd = rsqrtf(wave_sum_fast(ss) * (1.f / D) + 1e-6f);
            u32x2* o = (u32x2*)(H + (size_t)(row0 + r) * D);
#pragma unroll
            for (int j = 0; j < 4; ++j) { const f32x4 y = v[r][j] * rstd * gsc[j] + gsh[j]; u32x2 p; p.x = pk2(y.x, y.y); p.y = pk2(y.z, y.w); o[F.lane + 64 * j] = p; } }
    }
}

DI void load_rope_pair(const bf16* rowp, int hh, int jj, bool lat, int rpos, int cpos, const f32x2* rope, float scl, float (&x1)[8], float (&x2)[8]) {
    const u32x4 a = *(const u32x4*)(rowp + hh * 64 + jj), b = *(const u32x4*)(rowp + hh * 64 + jj + 32);
    const unsigned aw[4] = {a.x, a.y, a.z, a.w}, bw[4] = {b.x, b.y, b.z, b.w};
#pragma unroll
    for (int i = 0; i < 4; ++i) { x1[2 * i] = bflo(aw[i]); x1[2 * i + 1] = bfhi(aw[i]); x2[2 * i] = bflo(bw[i]); x2[2 * i + 1] = bfhi(bw[i]); }
    if (lat) { const int pos = hh ? cpos : rpos;
#pragma unroll
        for (int i = 0; i < 8; ++i) { const f32x2 cs = rope[pos * 32 + jj + i]; const float y1 = x1[i] * cs.x - x2[i] * cs.y, y2 = x1[i] * cs.y + x2[i] * cs.x; x1[i] = y1; x2[i] = y2; } }
#pragma unroll
    for (int i = 0; i < 8; ++i) { x1[i] *= scl; x2[i] *= scl; }
}
DI u32x4 pack8(const float (&x)[8], float s) { u32x4 o; o.x = pk2(x[0] * s, x[1] * s); o.y = pk2(x[2] * s, x[3] * s); o.z = pk2(x[4] * s, x[5] * s); o.w = pk2(x[6] * s, x[7] * s); return o; }
constexpr int RLD = 136;
constexpr int RTILE = 128 * RLD * 2;
DI int ret_row0(int b, int id) { return id < 2 ? ML + b * CTXL + id * 128 : b * SEQ + (id - 2) * 128; }

DI void ret_kv_phase(Fr& F) {
    const bf16* QKV = (const bf16*)(F.ws + WS_QKV); float* KV = (float*)(F.ws + WS_KV); const f32x2* rope = (const f32x2*)(F.ws + WS_ROPE);
    LAS bf16* Vs = (LAS bf16*)F.lds; LAS bf16* Kf = (LAS bf16*)(F.lds + RTILE); LAS bf16* Kb = (LAS bf16*)(F.lds + 2 * RTILE);
    const int wr2 = F.wave >> 1, wc2 = F.wave & 1, fr = F.lane & 15, fq = F.lane >> 4;
    for (int u = F.bx; u < NB * 4 * NCH; u += F.G) {
        const int b = u / (4 * NCH), h = (u / NCH) % 4, id = u % NCH; const int grow0 = ret_row0(b, id); const bool lat = id >= 2;
        const float lgf = -expf(F.in[9][h]), lgb = -expf(F.in[10][h]);
        for (int it = F.tid; it < 128 * 16; it += NTHR) { const int c = it >> 4, ch = it & 15;
            *(LAS u32x4*)(Vs + c * RLD + 8 * ch) = *(const u32x4*)(QKV + (size_t)(grow0 + c) * INW + 1024 + h * 128 + 8 * ch); }
        for (int it = F.tid; it < 128 * 8; it += NTHR) { const int c = it >> 3, pi = it & 7, hh = pi >> 2, jj = (pi & 3) * 8; const int t = (id - 2) * 128 + c;
            float x1[8], x2[8]; load_rope_pair(QKV + (size_t)(grow0 + c) * INW + 512 + h * 128, hh, jj, lat, t >> 6, t & 63, rope, 0.08838834764831845f, x1, x2);
            const float wf = __expf(lgf * (float)(127 - c)), wb = __expf(lgb * (float)c);
            *(LAS u32x4*)(Kf + c * RLD + hh * 64 + jj) = pack8(x1, wf); *(LAS u32x4*)(Kf + c * RLD + hh * 64 + jj + 32) = pack8(x2, wf);
            *(LAS u32x4*)(Kb + c * RLD + hh * 64 + jj) = pack8(x1, wb); *(LAS u32x4*)(Kb + c * RLD + hh * 64 + jj + 32) = pack8(x2, wb); }
        LDS_BARRIER();
#pragma unroll
        for (int dir = 0; dir < 2; ++dir) {
            const LAS bf16* Kd = dir ? Kb : Kf;
            f32x4 acc[2][4];
#pragma unroll
            for (int i = 0; i < 2; ++i)
#pragma unroll
                for (int j = 0; j < 4; ++j) acc[i][j] = (f32x4){0.f, 0.f, 0.f, 0.f};
#pragma unroll 1
            for (int k0 = 0; k0 < 128; k0 += 32) { bf16x8 af[2], bfg[4];
#pragma unroll
                for (int i = 0; i < 2; ++i) af[i] = frag_kr(Vs, RLD, 32 * wr2 + 16 * i, k0, F.lane);
#pragma unroll
                for (int j = 0; j < 4; ++j) bfg[j] = frag_kr(Kd, RLD, 64 * wc2 + 16 * j, k0, F.lane);
#pragma unroll
                for (int i = 0; i < 2; ++i)
#pragma unroll
                    for (int j = 0; j < 4; ++j) acc[i][j] = mma(acc[i][j], bfg[j], af[i]); }
            float* o = KV + ((size_t)((b * 4 + h) * 2 + dir) * NCH + id) * 16384;
#pragma unroll
            for (int i = 0; i < 2; ++i)
#pragma unroll
                for (int j = 0; j < 4; ++j) *(f32x4*)(o + (32 * wr2 + 16 * i + fr) * 128 + 64 * wc2 + 16 * j + 4 * fq) = acc[i][j];
        }
        LDS_BARRIER();
    }
}
DI void ret_prefix_phase(Fr& F) {
    const float* KV = (const float*)(F.ws + WS_KV); bf16* SP = (bf16*)(F.ws + WS_SPREV);
    const int gt = F.bx * NTHR + F.tid, NT = F.G * NTHR;
    for (int i = gt; i < 64 * 4096; i += NT) { const int bhd = i >> 12, e4 = i & 4095, dir = bhd & 1, h = (bhd >> 1) & 3;
        const float lg = -expf(dir ? F.in[10][h] : F.in[9][h]), cd = expf(lg * 128.f);
        f32x4 s = (f32x4){0.f, 0.f, 0.f, 0.f};
        for (int st = 0; st < NCH; ++st) { const int id = dir ? (st == 0 ? 1 : (st == 1 ? 0 : 19 - st)) : st;
            const size_t off = ((size_t)bhd * NCH + id) * 16384 + 4 * e4;
            u32x2 p; p.x = pk2(s.x, s.y); p.y = pk2(s.z, s.w); *(u32x2*)(SP + off) = p;
            s = s * cd + *(const f32x4*)(KV + off); }
    }
}
DI void ret_out_phase(Fr& F) {
    const bf16* QKV = (const bf16*)(F.ws + WS_QKV); const bf16* SP = (const bf16*)(F.ws + WS_SPREV); bf16* MIX = (bf16*)(F.ws + WS_MIX); const f32x2* rope = (const f32x2*)(F.ws + WS_ROPE);
    LAS bf16* Qs = (LAS bf16*)F.lds; LAS bf16* KP = (LAS bf16*)(F.lds + RTILE); LAS bf16* Vs = (LAS bf16*)(F.lds + 2 * RTILE); LAS bf16* Sf = (LAS bf16*)(F.lds + 3 * RTILE);
    LAS float* red = (LAS float*)(F.lds + 4 * RTILE);
    const int wr2 = F.wave >> 1, wc2 = F.wave & 1, fr = F.lane & 15, fq = F.lane >> 4;
    for (int u = F.bx; u < NB * 4 * NCH; u += F.G) {
        const int b = u / (4 * NCH), h = (u / NCH) % 4, id = u % NCH; const int grow0 = ret_row0(b, id); const bool lat = id >= 2;
        const float lgf = -expf(F.in[9][h]), lgb = -expf(F.in[10][h]);
        const bf16* spf = SP + ((size_t)((b * 4 + h) * 2 + 0) * NCH + id) * 16384; const bf16* spb = SP + ((size_t)((b * 4 + h) * 2 + 1) * NCH + id) * 16384;
        for (int it = F.tid; it < 128 * 16; it += NTHR) { const int c = it >> 4, ch = it & 15;
            *(LAS u32x4*)(Vs + c * RLD + 8 * ch) = *(const u32x4*)(QKV + (size_t)(grow0 + c) * INW + 1024 + h * 128 + 8 * ch);
            *(LAS u32x4*)(Sf + c * RLD + 8 * ch) = *(const u32x4*)(spf + c * 128 + 8 * ch); }
        for (int it = F.tid; it < 128 * 8; it += NTHR) { const int c = it >> 3, pi = it & 7, hh = pi >> 2, jj = (pi & 3) * 8; const int t = (id - 2) * 128 + c;
            float x1[8], x2[8];
            load_rope_pair(QKV + (size_t)(grow0 + c) * INW + h * 128, hh, jj, lat, t >> 6, t & 63, rope, 1.f, x1, x2);
            *(LAS u32x4*)(Qs + c * RLD + hh * 64 + jj) = pack8(x1, 1.f); *(LAS u32x4*)(Qs + c * RLD + hh * 64 + jj + 32) = pack8(x2, 1.f);
            load_rope_pair(QKV + (size_t)(grow0 + c) * INW + 512 + h * 128, hh, jj, lat, t >> 6, t & 63, rope, 0.08838834764831845f, x1, x2);
            *(LAS u32x4*)(KP + c * RLD + hh * 64 + jj) = pack8(x1, 1.f); *(LAS u32x4*)(KP + c * RLD + hh * 64 + jj + 32) = pack8(x2, 1.f); }
        LDS_BARRIER();
        f32x4 sacc[2][4], facc[2][4];
#pragma unroll
        for (int i = 0; i < 2; ++i)
#pragma unroll
            for (int j = 0; j < 4; ++j) { sacc[i][j] = (f32x4){0.f, 0.f, 0.f, 0.f}; facc[i][j] = (f32x4){0.f, 0.f, 0.f, 0.f}; }
#pragma unroll 1
        for (int k0 = 0; k0 < 128; k0 += 32) { bf16x8 af[2], bk[4], bs[4];
#pragma unroll
            for (int i = 0; i < 2; ++i) af[i] = frag_kc(Qs, RLD, 32 * wr2 + 16 * i, k0, F.lane);
#pragma unroll
            for (int j = 0; j < 4; ++j) { bk[j] = frag_kc(KP, RLD, 64 * wc2 + 16 * j, k0, F.lane); bs[j] = frag_kc(Sf, RLD, 64 * wc2 + 16 * j, k0, F.lane); }
#pragma unroll
            for (int i = 0; i < 2; ++i)
#pragma unroll
                for (int j = 0; j < 4; ++j) { sacc[i][j] = mma(sacc[i][j], bk[j], af[i]); facc[i][j] = mma(facc[i][j], bs[j], af[i]); } }
        LDS_BARRIER();
        { const float lf2 = lgf * 1.4426950408889634f, lb2 = lgb * 1.4426950408889634f;
#pragma unroll
          for (int i = 0; i < 2; ++i)
#pragma unroll
            for (int j = 0; j < 4; ++j) { const int c = 32 * wr2 + 16 * i + fr, s0 = 64 * wc2 + 16 * j + 4 * fq; float pv[4];
#pragma unroll
                for (int r = 0; r < 4; ++r) { const int df = c - (s0 + r); const float wgt = df > 0 ? exp2f(lf2 * (float)df) : (df < 0 ? exp2f(lb2 * (float)(-df)) : 2.f); pv[r] = sacc[i][j][r] * wgt; }
                u32x2 p; p.x = pk2(pv[0], pv[1]); p.y = pk2(pv[2], pv[3]); *(LAS u32x2*)(KP + c * RLD + s0) = p; }
          for (int it = F.tid; it < 128 * 16; it += NTHR) { const int c = it >> 4, ch = it & 15; *(LAS u32x4*)(Sf + c * RLD + 8 * ch) = *(const u32x4*)(spb + c * 128 + 8 * ch); }
        }
        LDS_BARRIER();
        f32x4 oacc[2][4], bacc[2][4];
#pragma unroll
        for (int i = 0; i < 2; ++i) { const float qdf = __expf(lgf * (float)(32 * wr2 + 16 * i + fr + 1));
#pragma unroll
            for (int j = 0; j < 4; ++j) { oacc[i][j] = facc[i][j] * qdf; bacc[i][j] = (f32x4){0.f, 0.f, 0.f, 0.f}; } }
#pragma unroll 1
        for (int k0 = 0; k0 < 128; k0 += 32) { bf16x8 ap[2], aq[2], bv[4], bs[4];
#pragma unroll
            for (int i = 0; i < 2; ++i) { ap[i] = frag_kc(KP, RLD, 32 * wr2 + 16 * i, k0, F.lane); aq[i] = frag_kc(Qs, RLD, 32 * wr2 + 16 * i, k0, F.lane); }
#pragma unroll
            for (int j = 0; j < 4; ++j) { bv[j] = frag_kr(Vs, RLD, 64 * wc2 + 16 * j, k0, F.lane); bs[j] = frag_kc(Sf, RLD, 64 * wc2 + 16 * j, k0, F.lane); }
#pragma unroll
            for (int i = 0; i < 2; ++i)
#pragma unroll
                for (int j = 0; j < 4; ++j) { oacc[i][j] = mma(oacc[i][j], bv[j], ap[i]); bacc[i][j] = mma(bacc[i][j], bs[j], aq[i]); } }
        float rs[2], rq[2];
#pragma unroll
        for (int i = 0; i < 2; ++i) { const int c = 32 * wr2 + 16 * i + fr; const float qdb = __expf(lgb * (float)(128 - c)); float s = 0.f, q = 0.f;
#pragma unroll
            for (int j = 0; j < 4; ++j) { oacc[i][j] = oacc[i][j] + bacc[i][j] * qdb;
#pragma unroll
                for (int r = 0; r < 4; ++r) { s += oacc[i][j][r]; q += oacc[i][j][r] * oacc[i][j][r]; } }
            s += __shfl_xor(s, 16); s += __shfl_xor(s, 32); q += __shfl_xor(q, 16); q += __shfl_xor(q, 32);
            if (fq == 0) { red[(c * 2 + wc2) * 2 + 0] = s; red[(c * 2 + wc2) * 2 + 1] = q; }
            rs[i] = s; rq[i] = q; }
        LDS_BARRIER();
#pragma unroll
        for (int i = 0; i < 2; ++i) { const int c = 32 * wr2 + 16 * i + fr;
            const float s = red[(c * 2 + 0) * 2 + 0] + red[(c * 2 + 1) * 2 + 0], q = red[(c * 2 + 0) * 2 + 1] + red[(c * 2 + 1) * 2 + 1];
            const float mean = s * (1.f / 128.f), var = fmaxf(q * (1.f / 128.f) - mean * mean, 0.f), rstd = rsqrtf(var + 1e-5f);
            const size_t grow = (size_t)(grow0 + c);
#pragma unroll
            for (int j = 0; j < 4; ++j) { const int e0 = 64 * wc2 + 16 * j + 4 * fq;
                const f32x4 gw = *(const f32x4*)(F.in[11] + h * 128 + e0); const u32x2 gg = *(const u32x2*)(QKV + grow * INW + 1536 + h * 128 + e0);
                const float g0 = bflo(gg.x), g1 = bfhi(gg.x), g2 = bflo(gg.y), g3 = bfhi(gg.y);
                const f32x4 y = (oacc[i][j] - mean) * rstd * gw;
                u32x2 p; p.x = pk2(y.x * siluf_(g0), y.y * siluf_(g1)); p.y = pk2(y.z * siluf_(g2), y.w * siluf_(g3));
                *(u32x2*)(MIX + grow * D + h * 128 + e0) = p; } }
        (void)rs; (void)rq;
        LDS_BARRIER();
    }
}

DI void na_norm_rows(Fr& F) {
    const bf16* QKV = (const bf16*)(F.ws + WS_QKV); bf16* NQ = (bf16*)(F.ws + WS_NQ); bf16* NK = (bf16*)(F.ws + WS_NK); bf16* NV = (bf16*)(F.ws + WS_NV);
    const bool isk = F.lane >= 32; const float* wsrc = (isk ? F.in[13] : F.in[12]) + (F.lane & 3) * 16; const float scl = isk ? 1.f : 0.125f;
    const int head = (F.lane & 31) >> 2, j0 = (F.lane & 3) * 16;
    float wv[16];
#pragma unroll
    for (int i = 0; i < 16; ++i) wv[i] = wsrc[i] * scl;
    for (int row = F.gw; row < MA; row += F.NGW) {
        const bool lat = row < ML; const int b = lat ? row / SEQ : (row - ML) / CTXL, sr = lat ? CTXL + row % SEQ : (row - ML) % CTXL;
        const size_t ho = ((size_t)(b * 8 + head) * (SEQ + CTXL) + sr) * 64 + j0;
        const bf16* p = QKV + (size_t)row * INW + 2048 + 16 * F.lane;
        const u32x4 a = *(const u32x4*)p, b2 = *(const u32x4*)(p + 8); const unsigned w[8] = {a.x, a.y, a.z, a.w, b2.x, b2.y, b2.z, b2.w}; float x[16]; float ss = 0.f;
#pragma unroll
        for (int i = 0; i < 8; ++i) { x[2 * i] = bflo(w[i]); x[2 * i + 1] = bfhi(w[i]); ss += x[2 * i] * x[2 * i] + x[2 * i + 1] * x[2 * i + 1]; }
        const float rinv = rsqrtf(red4(ss) * (1.f / 64.f) + 1e-6f);
        u32x4 o0, o1;
        o0.x = pk2(x[0] * rinv * wv[0], x[1] * rinv * wv[1]); o0.y = pk2(x[2] * rinv * wv[2], x[3] * rinv * wv[3]); o0.z = pk2(x[4] * rinv * wv[4], x[5] * rinv * wv[5]); o0.w = pk2(x[6] * rinv * wv[6], x[7] * rinv * wv[7]);
        o1.x = pk2(x[8] * rinv * wv[8], x[9] * rinv * wv[9]); o1.y = pk2(x[10] * rinv * wv[10], x[11] * rinv * wv[11]); o1.z = pk2(x[12] * rinv * wv[12], x[13] * rinv * wv[13]); o1.w = pk2(x[14] * rinv * wv[14], x[15] * rinv * wv[15]);
        bf16* d = (isk ? NK : NQ) + ho; *(u32x4*)d = o0; *(u32x4*)(d + 8) = o1;
        if (!isk) { const bf16* pv = QKV + (size_t)row * INW + 3072 + 16 * F.lane; const u32x4 v0 = *(const u32x4*)pv, v1 = *(const u32x4*)(pv + 8); *(u32x4*)(NV + ho) = v0; *(u32x4*)(NV + ho + 8) = v1; }
    }
}
constexpr int NLD = 72;
DI void na_phase(Fr& F) {
    const bf16* NQ = (const bf16*)(F.ws + WS_NQ); const bf16* NK = (const bf16*)(F.ws + WS_NK); const bf16* NV = (const bf16*)(F.ws + WS_NV); bf16* MIX = (bf16*)(F.ws + WS_MIX);
    LAS bf16* Ks = (LAS bf16*)F.lds;
    LAS bf16* Vs = (LAS bf16*)(F.lds + 36864);
    LAS bf16* Pw = (LAS bf16*)(F.lds + 2 * 36864) + F.wave * (32 * NLD);
    LAS float* rpbs = (LAS float*)(F.lds + 2 * 36864 + 8 * 4608);
    const int fr = F.lane & 15, fq = F.lane >> 4;
    float bound;
    { float mqw = fabsf(F.in[12][F.lane]), mkw = fabsf(F.in[13][F.lane]), mb = 0.f;
      for (int i = F.lane; i < 8 * 15 * 31; i += 64) mb = fmaxf(mb, fabsf(F.in[14][i]));
      bound = 8.f * wave_max(mqw) * wave_max(mkw) + wave_max(mb); }
    for (int u = F.bx; u < 512 + 64; u += F.G) {
        int b, head, r = -1, cb = 0, qtok0, kb_lo = 0, nwin = 0;
        if (u < 512) { const int bh = ((u >> 6) << 3) + (u & 7), qb = (u >> 3) & 7; b = bh >> 3; head = bh & 7;
            r = 4 * qb + (F.wave >> 1); cb = 32 * (F.wave & 1); qtok0 = b * SEQ + r * 64 + cb;
            const int r0lo = min(max(4 * qb - 4, 0), 24), r0hi = min(max(4 * qb - 1, 0), 24); kb_lo = r0lo >> 2; nwin = ((r0hi + 7) >> 2) - kb_lo + 1; }
        else { const int cu = u - 512; b = cu >> 3; head = cu & 7; qtok0 = ML + b * CTXL + 32 * F.wave; }
        const int r0 = min(max(r - 4, 0), 24);
        const size_t hb = (size_t)(b * 8 + head) * (SEQ + CTXL); const int qseq = u < 512 ? CTXL + r * 64 + cb : 32 * F.wave;
        bf16x8 aq[2][2];
#pragma unroll
        for (int mt = 0; mt < 2; ++mt)
#pragma unroll
            for (int ks = 0; ks < 2; ++ks) aq[mt][ks] = *(const bf16x8*)(NQ + (hb + qseq + 16 * mt + fr) * 64 + 32 * ks + 8 * fq);
        if (u < 512) for (int i = F.tid; i < 15 * 32; i += NTHR) { const int ro = i >> 5, co = i & 31; rpbs[i] = co < 31 ? F.in[14][head * 465 + ro * 31 + co] - bound : -1.0e30f; }
        int boff[2][4][4]; int nlo[2], nhi[2];
#pragma unroll
        for (int mt = 0; mt < 2; ++mt) { const int cs = cb + 16 * mt, c = cs + fr, c0 = min(max(c - 8, 0), 48);
            nlo[mt] = max(cs - 8, 0) >> 4; nhi[mt] = (min(cs + 7, 48) + 15) >> 4;
#pragma unroll
            for (int nt = 0; nt < 4; ++nt)
#pragma unroll
                for (int i = 0; i < 4; ++i) { const int kc = 16 * nt + 4 * fq + i; boff[mt][nt][i] = ((kc >= c0) && (kc < c0 + 16)) ? (kc - c + 15) : 31; } }
        f32x4 oacc[2][4]; float lsum[2] = {0.f, 0.f};
#pragma unroll
        for (int mt = 0; mt < 2; ++mt)
#pragma unroll
            for (int j = 0; j < 4; ++j) oacc[mt][j] = (f32x4){0.f, 0.f, 0.f, 0.f};
        u32x4 kst[4], vst[4];
#define NA_LOAD(bi_) do { const int kbase_ = (bi_) < nwin ? CTXL + 256 * (kb_lo + (bi_)) : 0; _Pragma("unroll") for (int it_ = 0; it_ < 4; ++it_) { const size_t o_ = (hb + kbase_ + (F.tid >> 3) + 64 * it_) * 64 + 8 * (F.tid & 7); \
            kst[it_] = *(const u32x4*)(NK + o_); vst[it_] = *(const u32x4*)(NV + o_); } } while (0)
        NA_LOAD(0);
        for (int bi = 0; bi <= nwin; ++bi) {
            const bool is_ctx = bi == nwin;
#pragma unroll
            for (int it = 0; it < 4; ++it) { const int krow = (F.tid >> 3) + 64 * it, c8 = F.tid & 7;
                *(LAS u32x4*)(Ks + krow * NLD + 8 * c8) = kst[it]; *(LAS u32x4*)(Vs + krow * NLD + 8 * c8) = vst[it]; }
            LDS_BARRIER();
            if (bi < nwin) NA_LOAD(bi + 1);
            if ((((PROBE_DUP) >> 30) & 1u) && bi < nwin) { asm volatile("" ::: "memory"); NA_LOAD(bi + 1); }
            f32x4 osv[2][4]; float lsv[2];
#pragma unroll
            for (int mt = 0; mt < 2; ++mt) { lsv[mt] = lsum[mt];
#pragma unroll
                for (int j = 0; j < 4; ++j) osv[mt][j] = oacc[mt][j]; }
            for (int pdc_ = 0; pdc_ < ((((PROBE_DUP) >> 31) & 1u) ? 2 : 1); ++pdc_) {
            if (pdc_ == 1) {
#pragma unroll
                for (int mt = 0; mt < 2; ++mt) { lsum[mt] = lsv[mt];
#pragma unroll
                    for (int j = 0; j < 4; ++j) oacc[mt][j] = osv[mt][j]; } }
#pragma unroll 1
            for (int krl = 0; krl < 4; ++krl) {
                const int kr = 4 * (kb_lo + bi) + krl;
                if (!is_ctx && (kr < r0 || kr > r0 + 7)) continue;
                f32x4 sacc[2][4];
#pragma unroll
                for (int mt = 0; mt < 2; ++mt)
#pragma unroll
                    for (int nt = 0; nt < 4; ++nt) sacc[mt][nt] = (f32x4){0.f, 0.f, 0.f, 0.f};
                const int n0w = is_ctx ? 0 : nlo[0], n1w = is_ctx ? 3 : nhi[1];
#pragma unroll
                for (int nt = 0; nt < 4; ++nt) { if (nt < n0w || nt > n1w) continue;
                    const bool u0 = is_ctx || (nt >= nlo[0] && nt <= nhi[0]), u1 = is_ctx || (nt >= nlo[1] && nt <= nhi[1]);
#pragma unroll
                    for (int ks = 0; ks < 2; ++ks) { const bf16x8 bk = frag_kc(Ks, NLD, 64 * krl + 16 * nt, 32 * ks, F.lane);
                        if (u0) sacc[0][nt] = mma(sacc[0][nt], bk, aq[0][ks]); if (u1) sacc[1][nt] = mma(sacc[1][nt], bk, aq[1][ks]); } }
                const int rowb = is_ctx ? 0 : (kr - r + 7) * 32;
#pragma unroll
                for (int mt = 0; mt < 2; ++mt) {
#pragma unroll
                    for (int nt = 0; nt < 4; ++nt) { float pv[4] = {0.f, 0.f, 0.f, 0.f};
                        if (is_ctx) {
#pragma unroll
                            for (int i = 0; i < 4; ++i) { pv[i] = __expf(sacc[mt][nt][i] - bound); lsum[mt] += pv[i]; } }
                        else if (nt >= nlo[mt] && nt <= nhi[mt]) {
#pragma unroll
                            for (int i = 0; i < 4; ++i) { pv[i] = __expf(sacc[mt][nt][i] + rpbs[rowb + boff[mt][nt][i]]); lsum[mt] += pv[i]; } }
                        u32x2 pk; pk.x = pk2(pv[0], pv[1]); pk.y = pk2(pv[2], pv[3]); *(LAS u32x2*)(Pw + (16 * mt + fr) * NLD + 16 * nt + 4 * fq) = pk; } }
                LDS_WAIT();
#pragma unroll
                for (int ks2 = 0; ks2 < 2; ++ks2) {
                    const bool v0 = is_ctx || (2 * ks2 + 1 >= nlo[0] && 2 * ks2 <= nhi[0]), v1 = is_ctx || (2 * ks2 + 1 >= nlo[1] && 2 * ks2 <= nhi[1]);
                    if (!(v0 || v1)) continue;
                    const bf16x8 ap0 = frag_kc(Pw, NLD, 0, 32 * ks2, F.lane), ap1 = frag_kc(Pw, NLD, 16, 32 * ks2, F.lane);
#pragma unroll
                    for (int et = 0; et < 4; ++et) { const bf16x8 bv = frag_kr(Vs, NLD, 16 * et, 64 * krl + 32 * ks2, F.lane);
                        if (v0) oacc[0][et] = mma(oacc[0][et], bv, ap0); if (v1) oacc[1][et] = mma(oacc[1][et], bv, ap1); } }
            }
            }
            LDS_BARRIER();
        }
#undef NA_LOAD
#pragma unroll
        for (int mt = 0; mt < 2; ++mt) { float l = lsum[mt]; l += __shfl_xor(l, 16); l += __shfl_xor(l, 32); const float inv = 1.f / l;
#pragma unroll
            for (int et = 0; et < 4; ++et) { const f32x4 o = oacc[mt][et] * inv; u32x2 p; p.x = pk2(o.x, o.y); p.y = pk2(o.z, o.w);
                *(u32x2*)(MIX + (size_t)(qtok0 + 16 * mt + fr) * D + 512 + head * 64 + 16 * et + 4 * fq) = p; } }
    }
}

DI void xm_phase(Fr& F, const float* xl, const float* xc, const float* normw, const float* modl) {
    bf16* XM = (bf16*)(F.ws + WS_XM); const float* mu = F.in[18];
    for (int g = F.gw; g < MA / 4; g += F.NGW) {
        const int row0 = 4 * g; const bool lat = row0 < ML; const int rr0 = lat ? row0 : row0 - ML; const int L = lat ? SEQ : CTXL; const int t0 = rr0 % L;
        const float* src = (lat ? xl : xc) + (size_t)rr0 * D;
        const float* mrow = modl + (size_t)(lat ? row0 / SEQ : 8) * 6144;
        const bool hp = t0 > 0, hn = t0 + 4 < L;
        f32x4 v[6][4]; float rs[6];
#pragma unroll
        for (int r = 0; r < 6; ++r) { const bool ok = (r == 0) ? hp : (r == 5 ? hn : true);
#pragma unroll
            for (int j = 0; j < 4; ++j) v[r][j] = ok ? ((const f32x4*)(src + (size_t)(r - 1) * D))[F.lane + 64 * j] : (f32x4){0.f, 0.f, 0.f, 0.f}; }
#pragma unroll
        for (int r = 0; r < 6; ++r) { float ss = 0.f;
#pragma unroll
            for (int j = 0; j < 4; ++j) ss += (v[r][j].x * v[r][j].x + v[r][j].y * v[r][j].y) + (v[r][j].z * v[r][j].z + v[r][j].w * v[r][j].w);
            rs[r] = rsqrtf(wave_sum_fast(ss) * (1.f / D) + 1e-6f); }
#pragma unroll
        for (int j = 0; j < 4; ++j) { const int c4 = F.lane + 64 * j;
            const f32x4 gg = ((const f32x4*)normw)[c4] * (((const f32x4*)(mrow + 1024))[c4] + 1.f), sh = ((const f32x4*)mrow)[c4];
            f32x4 h[6];
#pragma unroll
            for (int r = 0; r < 6; ++r) { const bool ok = (r == 0) ? hp : (r == 5 ? hn : true); h[r] = ok ? v[r][j] * rs[r] * gg + sh : (f32x4){0.f, 0.f, 0.f, 0.f}; }
            f32x4 m[6];
#pragma unroll
            for (int sx = 0; sx < 6; ++sx) m[sx] = ((const f32x4*)(mu + sx * 1024))[c4];
#pragma unroll
            for (int r = 0; r < 4; ++r) { const f32x4 hc = h[r + 1], xx = (h[r] + h[r + 2]) * 0.5f - hc;
#pragma unroll
                for (int sx = 0; sx < 6; ++sx) { const f32x4 y = hc + xx * m[sx];
                    u32x2 p; p.x = pk2(y.x, y.y); p.y = pk2(y.z, y.w); ((u32x2*)(XM + ((size_t)sx * MA + row0 + r) * D))[c4] = p; } } }
    }
}

DI f32x4 mma16(f32x4 acc, s16x4 bfrag, s16x4 afrag) { return __builtin_amdgcn_mfma_f32_16x16x16bf16_1k(bfrag, afrag, acc, 0, 0, 0); }
DI s16x4 frag16_kc(const LAS bf16* base, int ld, int row0, int k0, int lane) { return *(const LAS s16x4*)(base + (row0 + (lane & 15)) * ld + k0 + 4 * (lane >> 4)); }
DI s16x4 frag16_kr(const LAS bf16* base, int ld, int x0, int k0, int lane) { const int g = lane >> 4, q = (lane & 15) >> 2, p = lane & 3;
    return __builtin_amdgcn_ds_read_tr16_b64_v4i16((LAS s16x4*)(base + (k0 + 4 * g + q) * ld + x0 + 4 * p)); }
DI s16x4 cvt4(f32x4 v) { u32x2 p; p.x = pk2(v.x, v.y); p.y = pk2(v.z, v.w); return __builtin_bit_cast(s16x4, p); }
constexpr int WLD = 72;
DI void rwkv_scan2_phase(Fr& F) {
    const bf16* KB = (const bf16*)(F.ws + WS_KB); const bf16* VB = (const bf16*)(F.ws + WS_VB); const bf16* RB = (const bf16*)(F.ws + WS_RB);
    const bf16* LW = (const bf16*)(F.ws + WS_DEC); const bf16* AG = (const bf16*)(F.ws + WS_AG);
    LAS bf16* AT = (LAS bf16*)F.lds; LAS bf16* BT = AT + 64 * WLD; LAS bf16* KT = BT + 64 * WLD; LAS bf16* RT = KT + 64 * WLD; LAS bf16* BH = RT + 64 * WLD; LAS bf16* KH = BH + 64 * WLD;
    LAS bf16* VN = KH + 64 * WLD; LAS bf16* W1s = VN + 64 * WLD;
    LAS bf16* PRB = W1s + 64 * WLD; LAS bf16* PRK = PRB + 1024;
    LAS f32x4* UVT = (LAS f32x4*)(PRK + 1024);
    LAS float* GC = (LAS float*)(UVT + 1024);
    LAS float* CSs = GC + 256;
    LAS float* YS = CSs + 4096;
    const int cq = F.wave >> 1, half = F.wave & 1, fr = F.lane & 15, fq = F.lane >> 4;
    for (int u = F.bx; u < 256; u += F.G) {
        const int z = u & 1, h = (u >> 1) & 15, b = u >> 5;
        bf16* Y = (bf16*)(F.ws + (z ? WS_YB : WS_YF));
        const int sx = F.lane >> 3, cg = F.lane & 7;
        float kkw[8], kaw[8], rkw[8];
#pragma unroll
        for (int i = 0; i < 8; ++i) { kkw[i] = F.in[28][h * 64 + 8 * cg + i]; kaw[i] = F.in[29][h * 64 + 8 * cg + i]; rkw[i] = F.in[30][h * 64 + 8 * cg + i]; }
        float* coef = (float*)(F.ws + WS_COEF) + ((size_t)z * 128 + b * 16 + h) * SEQ;
        const size_t bh = (size_t)(b * 16 + h);
        const bf16* kbh = KB + bh * (SEQ + CTXL) * 64 + 8 * cg; const bf16* vbh = VB + bh * (SEQ + CTXL) * 64 + 8 * cg; const bf16* rbh = RB + bh * SEQ * 64 + 8 * cg;
        const bf16* agh = AG + ((size_t)z * 128 + bh) * (SEQ + CTXL) * 64 + 8 * cg; const bf16* lwh = LW + ((size_t)z * 128 + bh) * (SEQ + CTXL) * 64 + 8 * cg;
        f32x4 S[4];
#pragma unroll
        for (int j = 0; j < 4; ++j) S[j] = (f32x4){0.f, 0.f, 0.f, 0.f};
        u32x4 kreg, vreg, rreg, areg, lreg;
        const int stl = 16 * cq + 8 * half + sx;
#define RW_LOAD(sc) do { const int g_ = (sc) * 64 + stl; const bool lat_ = g_ >= CTXL; const int row_ = z ? (lat_ ? (2 * CTXL + SEQ - 1 - g_) : (CTXL - 1 - g_)) : g_; \
            kreg = *(const u32x4*)(kbh + (size_t)row_ * 64); vreg = *(const u32x4*)(vbh + (size_t)row_ * 64); areg = *(const u32x4*)(agh + (size_t)row_ * 64); \
            rreg = lat_ ? *(const u32x4*)(rbh + (size_t)(row_ - CTXL) * 64) : (u32x4){0u, 0u, 0u, 0u}; \
            lreg = *(const u32x4*)(lwh + (size_t)row_ * 64); } while (0)
        RW_LOAD(0);
        for (int sc = 0; sc < (SEQ + CTXL) / 64; ++sc) {
            const bool lat = sc * 64 >= CTXL;
            *(LAS f32x4*)(CSs + stl * 64 + 8 * cg) = (f32x4){bflo(lreg.x), bfhi(lreg.x), bflo(lreg.y), bfhi(lreg.y)}; *(LAS f32x4*)(CSs + stl * 64 + 8 * cg + 4) = (f32x4){bflo(lreg.z), bfhi(lreg.z), bflo(lreg.w), bfhi(lreg.w)};
            LDS_BARRIER();
            if (F.tid < 256) { const int q = F.tid >> 6, c = F.tid & 63; float v[16];
#pragma unroll
                for (int t = 0; t < 16; ++t) v[t] = CSs[(16 * q + t) * 64 + c];
                float acc = 0.f;
#pragma unroll
                for (int t = 0; t < 16; ++t) { acc += v[t]; CSs[(16 * q + t) * 64 + c] = acc; } }
            LDS_BARRIER();
            { const int tau = 8 * half + sx;
              const f32x4 c0 = *(const LAS f32x4*)(CSs + stl * 64 + 8 * cg), c1 = *(const LAS f32x4*)(CSs + stl * 64 + 8 * cg + 4);
              f32x4 p0 = (f32x4){0.f, 0.f, 0.f, 0.f}, p1 = p0;
              if (tau > 0) { p0 = *(const LAS f32x4*)(CSs + (stl - 1) * 64 + 8 * cg); p1 = *(const LAS f32x4*)(CSs + (stl - 1) * 64 + 8 * cg + 4); }
              const f32x4 t0 = *(const LAS f32x4*)(CSs + (16 * cq + 15) * 64 + 8 * cg), t1 = *(const LAS f32x4*)(CSs + (16 * cq + 15) * 64 + 8 * cg + 4);
              const float cs[8] = {c0.x, c0.y, c0.z, c0.w, c1.x, c1.y, c1.z, c1.w}, cp[8] = {p0.x, p0.y, p0.z, p0.w, p1.x, p1.y, p1.z, p1.w}, ct[8] = {t0.x, t0.y, t0.z, t0.w, t1.x, t1.y, t1.z, t1.w};
              const unsigned kw[4] = {kreg.x, kreg.y, kreg.z, kreg.w}, aw[4] = {areg.x, areg.y, areg.z, areg.w}, rw[4] = {rreg.x, rreg.y, rreg.z, rreg.w};
              float kr[8], ag[8], rr[8], kk[8]; float ss = 0.f;
#pragma unroll
              for (int i = 0; i < 4; ++i) { kr[2 * i] = bflo(kw[i]); kr[2 * i + 1] = bfhi(kw[i]); ag[2 * i] = bflo(aw[i]); ag[2 * i + 1] = bfhi(aw[i]); rr[2 * i] = bflo(rw[i]); rr[2 * i + 1] = bfhi(rw[i]); }
#pragma unroll
              for (int i = 0; i < 8; ++i) { kk[i] = kr[i] * kkw[i]; ss += kk[i] * kk[i]; }
              const float rn = __builtin_amdgcn_rsqf(fmaxf(red8(ss), 1e-24f));
              float oa[8], ob[8], ok[8], orr[8], obh[8], okh[8], eCv[8]; float cfp = 0.f;
#pragma unroll
              for (int i = 0; i < 8; ++i) { const float e1 = __expf(cs[i]), ep = __expf(cp[i]), eC = __expf(ct[i]), inv = __builtin_amdgcn_rcpf(e1);
                  const float kki = kk[i] * rn, b_ = kki * ag[i], kd_ = kr[i] * (1.f + (ag[i] - 1.f) * kaw[i]);
                  cfp += rr[i] * kd_ * rkw[i];
                  oa[i] = -kki * ep; ob[i] = b_ * inv; ok[i] = kd_ * inv; orr[i] = rr[i] * e1; obh[i] = b_ * eC * inv; okh[i] = kd_ * eC * inv; eCv[i] = eC; }
              cfp = red8(cfp);
              if (lat && cg == 0) { const int g = sc * 64 + stl; coef[z ? (SEQ + CTXL - 1 - g) : (g - CTXL)] = cfp; }
              const int o = stl * WLD + 8 * cg;
              *(LAS u32x4*)(AT + o) = pack8(oa, 1.f); *(LAS u32x4*)(BT + o) = pack8(ob, 1.f); *(LAS u32x4*)(KT + o) = pack8(ok, 1.f); *(LAS u32x4*)(RT + o) = pack8(orr, 1.f);
              *(LAS u32x4*)(BH + o) = pack8(obh, 1.f); *(LAS u32x4*)(KH + o) = pack8(okh, 1.f); *(LAS u32x4*)(VN + o) = vreg;
              if (tau == 0) { *(LAS f32x4*)(GC + cq * 64 + 8 * cg) = (f32x4){eCv[0], eCv[1], eCv[2], eCv[3]}; *(LAS f32x4*)(GC + cq * 64 + 8 * cg + 4) = (f32x4){eCv[4], eCv[5], eCv[6], eCv[7]}; } }
            LDS_BARRIER();
            if (sc + 1 < (SEQ + CTXL) / 64) RW_LOAD(sc + 1);
            for (int pa2_ = 0; pa2_ < ((((PROBE_DUP) >> 25) & 1u) ? 2 : 1); ++pa2_)
            if (half) { f32x4 pb = (f32x4){0.f, 0.f, 0.f, 0.f}, pk = (f32x4){0.f, 0.f, 0.f, 0.f};
#pragma unroll
                for (int k0 = 0; k0 < 64; k0 += 32) { const bf16x8 af = frag_kc(RT, WLD, 16 * cq, k0, F.lane);
                    pb = mma(pb, frag_kc(BT, WLD, 16 * cq, k0, F.lane), af); pk = mma(pk, frag_kc(KT, WLD, 16 * cq, k0, F.lane), af); }
#pragma unroll
                for (int r = 0; r < 4; ++r) if (4 * fq + r > fr) { pb[r] = 0.f; pk[r] = 0.f; }
                const int o = cq * 256 + fr * 16 + 4 * fq;
                *(LAS s16x4*)(PRB + o) = cvt4(pb); *(LAS s16x4*)(PRK + o) = cvt4(pk); }
            else { f32x4 xa = (f32x4){0.f, 0.f, 0.f, 0.f}, xt = (f32x4){0.f, 0.f, 0.f, 0.f}, ak = (f32x4){0.f, 0.f, 0.f, 0.f};
#pragma unroll
                for (int k0 = 0; k0 < 64; k0 += 32) { const bf16x8 af = frag_kc(AT, WLD, 16 * cq, k0, F.lane), bfm = frag_kc(BT, WLD, 16 * cq, k0, F.lane);
                    xa = mma(xa, bfm, af);
                    xt = mma(xt, af, bfm);
                    ak = mma(ak, frag_kc(KT, WLD, 16 * cq, k0, F.lane), af); }
#pragma unroll
                for (int r = 0; r < 4; ++r) { if (4 * fq + r >= fr) { xa[r] = 0.f; ak[r] = 0.f; } if (4 * fq + r <= fr) xt[r] = 0.f; }
                f32x4 P = xa;
#pragma unroll
                for (int r = 0; r < 4; ++r) if (4 * fq + r == fr) P[r] += 1.f;
#pragma unroll
                for (int lvl = 0; lvl < 3; ++lvl) { const s16x4 xf = cvt4(xa), xtf = cvt4(xt);
                    const f32x4 x2 = mma16((f32x4){0.f, 0.f, 0.f, 0.f}, xtf, xf);
                    const f32x4 x2t = mma16((f32x4){0.f, 0.f, 0.f, 0.f}, xf, xtf);
                    xa = x2; xt = x2t;
                    P = mma16(P, cvt4(xt), cvt4(P)); }
                const s16x4 tf = cvt4(P), akf = cvt4(ak);
#pragma unroll
                for (int jt = 0; jt < 4; ++jt) { const f32x4 acc = mma16((f32x4){0.f, 0.f, 0.f, 0.f}, frag16_kr(AT, WLD, 16 * jt, 16 * cq, F.lane), tf);
                    *(LAS s16x4*)(W1s + (16 * cq + fr) * WLD + 16 * jt + 4 * fq) = cvt4(acc); }
#pragma unroll
                for (int it = 0; it < 4; ++it) { const f32x4 xvt = mma16((f32x4){0.f, 0.f, 0.f, 0.f}, akf, frag16_kr(VN, WLD, 16 * it, 16 * cq, F.lane));
                    UVT[(cq * 4 + it) * 64 + F.lane] = mma16((f32x4){0.f, 0.f, 0.f, 0.f}, tf, cvt4(xvt)); } }
            LDS_BARRIER();
            if (F.wave < 4) { const int it = F.wave;
                s16x4 w1f[2][4], bhf[2][4], khf[2][4], vfr[2]; f32x4 g4[2][4], uv0[2];
#define SB_LOAD(c_, b_) do { _Pragma("unroll") for (int jt = 0; jt < 4; ++jt) { w1f[b_][jt] = frag16_kc(W1s, WLD, 16 * (c_), 16 * jt, F.lane); \
                        bhf[b_][jt] = frag16_kr(BH, WLD, 16 * jt, 16 * (c_), F.lane); khf[b_][jt] = frag16_kr(KH, WLD, 16 * jt, 16 * (c_), F.lane); g4[b_][jt] = *(const LAS f32x4*)(GC + (c_) * 64 + 16 * jt + 4 * fq); } \
                    vfr[b_] = frag16_kr(VN, WLD, 16 * it, 16 * (c_), F.lane); uv0[b_] = UVT[((c_) * 4 + it) * 64 + F.lane]; } while (0)
                SB_LOAD(0, 0);
#pragma unroll
                for (int c = 0; c < 4; ++c) { const int cb_ = c & 1;
                    if (c < 3) SB_LOAD(c + 1, cb_ ^ 1);
                    s16x4 sfr[4];
#pragma unroll
                    for (int jt = 0; jt < 4; ++jt) sfr[jt] = cvt4(S[jt]);
#define CAT8(a_, b_) __builtin_shufflevector((a_), (b_), 0, 1, 2, 3, 4, 5, 6, 7)
                    const bf16x8 s01 = CAT8(sfr[0], sfr[1]), s23 = CAT8(sfr[2], sfr[3]);
                    f32x4 Ua = mma(uv0[cb_], CAT8(w1f[cb_][0], w1f[cb_][1]), s01); Ua = mma(Ua, CAT8(w1f[cb_][2], w1f[cb_][3]), s23);
                    const s16x4 ufr = cvt4(Ua); const bf16x8 uv8 = CAT8(ufr, vfr[cb_]);
#pragma unroll
                    for (int jt = 0; jt < 4; ++jt) S[jt] = mma(S[jt] * g4[cb_][jt], CAT8(bhf[cb_][jt], khf[cb_][jt]), uv8);
                    if (lat) { s16x4 rtf[4];
#pragma unroll
                        for (int jt = 0; jt < 4; ++jt) rtf[jt] = frag16_kc(RT, WLD, 16 * c, 16 * jt, F.lane);
                        const s16x4 pbf = frag16_kc(PRB + c * 256, 16, 0, 0, F.lane), pkf = frag16_kc(PRK + c * 256, 16, 0, 0, F.lane);
                        f32x4 Ya = mma((f32x4){0.f, 0.f, 0.f, 0.f}, CAT8(rtf[0], rtf[1]), s01); Ya = mma(Ya, CAT8(rtf[2], rtf[3]), s23);
                        const f32x4 Yb = mma((f32x4){0.f, 0.f, 0.f, 0.f}, CAT8(pbf, pkf), uv8);
                        const f32x4 Yt = Ya + Yb;
#pragma unroll
                        for (int r = 0; r < 4; ++r) YS[(16 * c + 4 * fq + r) * 68 + 16 * it + fr] = Yt[r]; }
                }
#undef SB_LOAD
            }
            LDS_BARRIER();
            if (lat) {
                const int g = sc * 64 + (F.tid >> 3); const int tl = z ? (SEQ + CTXL - 1 - g) : (g - CTXL);
                const f32x4 y0 = *(const LAS f32x4*)(YS + (F.tid >> 3) * 68 + 8 * (F.tid & 7)), y1 = *(const LAS f32x4*)(YS + (F.tid >> 3) * 68 + 8 * (F.tid & 7) + 4);
                u32x4 o; o.x = pk2(y0.x, y0.y); o.y = pk2(y0.z, y0.w); o.z = pk2(y1.x, y1.y); o.w = pk2(y1.z, y1.w);
                *(u32x4*)(Y + (size_t)(b * SEQ + tl) * D + h * 64 + 8 * (F.tid & 7)) = o; }
            LDS_BARRIER();
        }
#undef RW_LOAD
    }
}

DI void rwkv_readout_phase(Fr& F) {
    const bf16* VB = (const bf16*)(F.ws + WS_VB); const bf16* G = (const bf16*)(F.ws + WS_G); const float* COEF = (const float*)(F.ws + WS_COEF);
    const bf16* YF = (const bf16*)(F.ws + WS_YF); const bf16* YB = (const bf16*)(F.ws + WS_YB); bf16* Z = (bf16*)(F.ws + WS_H);
    const int c0 = 16 * F.lane, hh = F.lane >> 2, j0 = (F.lane & 3) * 16;
    float lnw[16], lnb[16];
#pragma unroll
    for (int q = 0; q < 16; ++q) { lnw[q] = F.in[31][c0 + q]; lnb[q] = F.in[32][c0 + q]; }
#define RD16(dst, ptr) do { const u32x4 t0_ = *(const u32x4*)(ptr), t1_ = *(const u32x4*)((ptr) + 8); const unsigned tw_[8] = {t0_.x, t0_.y, t0_.z, t0_.w, t1_.x, t1_.y, t1_.z, t1_.w}; \
        _Pragma("unroll") for (int q_ = 0; q_ < 8; ++q_) { dst[2 * q_] = bflo(tw_[q_]); dst[2 * q_ + 1] = bfhi(tw_[q_]); } } while (0)
    for (int row = F.gw; row < ML; row += F.NGW) {
        const size_t off = (size_t)row * D + c0; const int b = row / SEQ, t = row % SEQ;
        const size_t hoff = ((size_t)(b * 16 + hh) * (SEQ + CTXL) + CTXL + t) * 64 + j0;
        float y[16], yb[16], vv[16], gv[16];
        RD16(y, YF + off); RD16(yb, YB + off); RD16(vv, VB + hoff); RD16(gv, G + off);
        const float cf = COEF[(size_t)(b * 16 + hh) * SEQ + t] + COEF[(size_t)(128 + b * 16 + hh) * SEQ + t];
        float s = 0.f;
#pragma unroll
        for (int q = 0; q < 16; ++q) { y[q] += yb[q]; s += y[q]; }
        s = red4(s);
        const float mean = s * (1.f / 64.f); float q2 = 0.f;
#pragma unroll
        for (int q = 0; q < 16; ++q) { const float d = y[q] - mean; q2 += d * d; }
        q2 = red4(q2);
        const float rstd = rsqrtf(q2 * (1.f / 64.f) + 64e-5f);
        float o[16];
#pragma unroll
        for (int q = 0; q < 16; ++q) o[q] = ((y[q] - mean) * rstd * lnw[q] + lnb[q] + cf * vv[q]) * gv[q];
        u32x4 p0, p1; p0.x = pk2(o[0], o[1]); p0.y = pk2(o[2], o[3]); p0.z = pk2(o[4], o[5]); p0.w = pk2(o[6], o[7]); p1.x = pk2(o[8], o[9]); p1.y = pk2(o[10], o[11]); p1.z = pk2(o[12], o[13]); p1.w = pk2(o[14], o[15]);
        *(u32x4*)(Z + off) = p0; *(u32x4*)(Z + off + 8) = p1;
    }
#undef RD16
}

DI void moe_route_phase(Fr& F, const float* xl, const float* normw, const float* modl) {
    bf16* H2 = (bf16*)(F.ws + WS_MIX); int* TopE = (int*)(F.ws + WS_MISC + MISC_TOPE); f32x2* TopW = (f32x2*)(F.ws + WS_MISC + MISC_TOPW); int* Cnts = (int*)(F.ws + WS_MISC + MISC_CNTS);
    LAS int* lc = (LAS int*)F.lds;
    f32x4 rw[4][4][2];
#pragma unroll
    for (int j = 0; j < 4; ++j)
#pragma unroll
        for (int q = 0; q < 4; ++q) { const float* rp = F.in[34] + (size_t)(4 * (F.lane + 64 * j) + q) * 8; rw[j][q][0] = *(const f32x4*)rp; rw[j][q][1] = *(const f32x4*)(rp + 4); }
    for (int wg = F.bx; wg < 256; wg += F.G) {
        LDS_BARRIER();
#pragma unroll 2
        for (int it = 0; it < 8; ++it) { const int row = wg * 64 + F.wave * 8 + it;
            const float* src = xl + (size_t)row * D; const float* mrow = modl + (size_t)(row / SEQ) * 6144;
            f32x4 v[4]; float ss = 0.f;
#pragma unroll
            for (int j = 0; j < 4; ++j) { v[j] = ((const f32x4*)src)[F.lane + 64 * j]; ss += (v[j].x * v[j].x + v[j].y * v[j].y) + (v[j].z * v[j].z + v[j].w * v[j].w); }
            const float rstd = rsqrtf(wave_sum_fast(ss) * (1.f / D) + 1e-6f);
            f32x4 l0 = (f32x4){0.f, 0.f, 0.f, 0.f}, l1 = l0;
#pragma unroll
            for (int j = 0; j < 4; ++j) { const int c4 = F.lane + 64 * j;
                const f32x4 w = ((const f32x4*)normw)[c4], sc = ((const f32x4*)(mrow + 4096))[c4], sh = ((const f32x4*)(mrow + 3072))[c4];
                const f32x4 y = v[j] * rstd * w * (sc + 1.f) + sh;
                u32x2 p; p.x = pk2(y.x, y.y); p.y = pk2(y.z, y.w); ((u32x2*)(H2 + (size_t)row * D))[c4] = p;
                l0 += rw[j][0][0] * y.x + rw[j][1][0] * y.y + rw[j][2][0] * y.z + rw[j][3][0] * y.w;
                l1 += rw[j][0][1] * y.x + rw[j][1][1] * y.y + rw[j][2][1] * y.z + rw[j][3][1] * y.w; }
            float lg[8] = {l0.x, l0.y, l0.z, l0.w, l1.x, l1.y, l1.z, l1.w};
#pragma unroll
            for (int e = 0; e < 8; ++e) lg[e] = wave_sum_fast(lg[e]);
            int e0 = 0; float v0 = lg[0];
#pragma unroll
            for (int e = 1; e < 8; ++e) if (lg[e] > v0) { v0 = lg[e]; e0 = e; }
            int e1 = -1; float v1 = -3.0e38f;
#pragma unroll
            for (int e = 0; e < 8; ++e) if (e != e0 && lg[e] > v1) { v1 = lg[e]; e1 = e; }
            const float w0 = 1.f / (1.f + expf(v1 - v0)), w1 = 1.f - w0;
            if (F.lane == 0) { TopE[row] = e0 | (e1 << 8); TopW[row] = (f32x2){w0, w1}; lc[F.wave * 8 + it] = e0 | (e1 << 8); }
        }
        LDS_BARRIER();
        if (F.tid < 8) { int c = 0; for (int t = 0; t < 64; ++t) { const int code = lc[t]; c += ((code & 255) == F.tid ? 1 : 0) + ((code >> 8) == F.tid ? 1 : 0); } Cnts[wg * 8 + F.tid] = c; }
    }
}
DI void moe_gather_phase(Fr& F) {
    const bf16* H2 = (const bf16*)(F.ws + WS_MIX); const int* TopE = (const int*)(F.ws + WS_MISC + MISC_TOPE); const f32x2* TopW = (const f32x2*)(F.ws + WS_MISC + MISC_TOPW);
    const int* Cnts = (const int*)(F.ws + WS_MISC + MISC_CNTS); int* Exp = (int*)(F.ws + WS_MISC + MISC_EXP);
    bf16* XG = (bf16*)(F.ws + WS_XG); int* RowTok = (int*)(F.ws + WS_ROWS); float* RowW = (float*)(F.ws + WS_ROWS + 262144);
    LAS int* lc = (LAS int*)F.lds;
    LAS int* tot = lc + 2048;
    LAS int* rows = tot + 32;
    LAS int* te = rows + 128;
    for (int idx = F.tid; idx < 2048; idx += NTHR) lc[idx] = Cnts[idx];
    WG_SYNC();
    for (int wg = F.bx; wg < 256; wg += F.G) {
        if (F.tid < 64) te[F.tid] = TopE[wg * 64 + F.tid];
        if (F.tid < 8) { int t = 0, mb = 0; for (int w = 0; w < 256; ++w) { const int c = lc[w * 8 + F.tid]; t += c; mb += (w < wg) ? c : 0; } tot[F.tid] = t; tot[16 + F.tid] = mb; }
        WG_SYNC();
        if (F.tid == 0) { int sgs = 0; for (int e = 0; e < 8; ++e) { tot[8 + e] = sgs; sgs += (tot[e] + 255) & ~255; }
            if (wg == 0) { int acc = 0; for (int e = 0; e < 8; ++e) { Exp[e] = tot[e]; Exp[8 + e] = tot[8 + e]; acc += (tot[e] + 255) >> 8; Exp[16 + e] = acc; } } }
        WG_SYNC();
        if (F.tid < 64) { const int code = te[F.tid]; const int e0 = code & 255, e1 = code >> 8; int r0 = 0, r1 = 0;
            for (int t = 0; t < F.tid; ++t) { const int c2 = te[t]; const int a = c2 & 255, bq = c2 >> 8; r0 += (a == e0 ? 1 : 0) + (bq == e0 ? 1 : 0); r1 += (a == e1 ? 1 : 0) + (bq == e1 ? 1 : 0); }
            rows[2 * F.tid] = tot[8 + e0] + tot[16 + e0] + r0; rows[2 * F.tid + 1] = tot[8 + e1] + tot[16 + e1] + r1; }
        WG_SYNC();
        for (int it = F.wave; it < 128; it += NWAVES) { const int t = it >> 1, k = it & 1, tok = wg * 64 + t, row = rows[it];
            const u32x4* s = (const u32x4*)(H2 + (size_t)tok * D); u32x4* d = (u32x4*)(XG + (size_t)row * D);
            d[F.lane] = s[F.lane]; d[F.lane + 64] = s[F.lane + 64];
            if (F.lane == 0) { RowTok[row] = tok * 2 + k; const f32x2 w = TopW[tok]; RowW[row] = k ? w.y : w.x; } }
        if (wg == 0) {
            for (int e = 0; e < 8; ++e) { const int a = tot[8 + e] + tot[e], bnd = tot[8 + e] + ((tot[e] + 255) & ~255); for (int rr = a + F.tid; rr < bnd; rr += NTHR) RowTok[rr] = -1; } }
        WG_SYNC();
    }
}
DI void moe_combine_phase(Fr& F, float* xl, const float* modl) {
    const bf16* YS = (const bf16*)(F.ws + WS_YS);
    for (int row = F.gw; row < ML; row += F.NGW) {
        const float* mrow = modl + (size_t)(row / SEQ) * 6144 + 5120; float* xr = xl + (size_t)row * D;
        const u32x2* s0 = (const u32x2*)(YS + (size_t)(2 * row) * D); const u32x2* s1 = (const u32x2*)(YS + (size_t)(2 * row + 1) * D);
#pragma unroll
        for (int j = 0; j < 4; ++j) { const int c4 = F.lane + 64 * j; const f32x4 x = ((const f32x4*)xr)[c4], m = ((const f32x4*)mrow)[c4]; const u32x2 a = s0[c4], bq = s1[c4];
            f32x4 o; o.x = x.x + m.x * (bflo(a.x) + bflo(bq.x)); o.y = x.y + m.y * (bfhi(a.x) + bfhi(bq.x)); o.z = x.z + m.z * (bflo(a.y) + bflo(bq.y)); o.w = x.w + m.w * (bfhi(a.y) + bfhi(bq.y));
            ((f32x4*)xr)[c4] = o; }
    }
}

constexpr int N_PHASES = 20;
constexpr int FILL_A = 4000, FILL_B = 8200, FILL_C = 15700;
struct Args { const float* in[37]; float* out; unsigned char* ws; int ph_lo, ph_hi; };
template <class Epi> DI void run_gemm(Fr& F, const bf16* A, const bf16* Bt, int M, int N, int K, const Epi& E, int& rot) {
    int Kv = K; asm volatile("" : "+s"(Kv));
    pg8::Gemm g{A, Bt, M, N, Kv}; pg8::StaticOrder S; S.init(M, N, F.G, (F.bx + F.G - (rot % F.G)) % F.G); rot += (M / 256) * (N / 256);
    pg8::gemm_phase<Epi, pg8::StaticOrder>(F.lds, g, S, E);
}
__global__ void __launch_bounds__(NTHR, 2) fwd_kernel(Args args) {
    extern __shared__ __attribute__((aligned(16))) unsigned char lds_raw[];
    Fr F;
    F.lds = (LAS unsigned char*)lds_raw; F.ws = args.ws; F.in = args.in; F.out = args.out;
    F.tid = threadIdx.x; F.lane = F.tid & 63; F.wave = __builtin_amdgcn_readfirstlane(F.tid >> 6); F.bx = blockIdx.x; F.G = gridDim.x;
    F.gw = F.bx * NWAVES + F.wave; F.NGW = F.G * NWAVES;
    volatile LAS unsigned* MISC = (volatile LAS unsigned*)(F.lds + LDS_MISC_OFF);
    if (F.tid < 64) MISC[F.tid] = 0u;
    __syncthreads();
    const int lo = args.ph_lo, hi = args.ph_hi;
    const bool multi = (hi - lo) > 1;
    XcdBarrier bar; bar.bar = (unsigned*)(F.ws + WS_CTL) + CW_BAR; bar.x = 0; bar.st = nullptr;
    if (multi) bar = xcd_barrier_post((unsigned*)(F.ws + WS_CTL) + CW_BAR, MISC + 8);
#ifndef PH_MASK
#define PH_MASK 0xFFFFFFFFu
#endif
#define IN(k) ((((PH_MASK) >> (k)) & 1u) && lo <= (k) && (k) < hi)
#define REP(k) for (int rep_ = 0; rep_ < ((((PROBE_DUP) >> (k)) & 1u) ? 2 : 1); ++rep_)
#define SEAM(k) do { if (IN(k) && IN((k) + 1)) xcd_barrier(bar); } while (0)
    const float* const* in = args.in;
    float* MOD = (float*)(F.ws + WS_MOD);
    float* XL = F.out; float* XC = (float*)(F.ws + WS_XC);
    bf16* H = (bf16*)(F.ws + WS_H); bf16* MIX = (bf16*)(F.ws + WS_MIX);

    if (IN(0)) REP(0) { p0_prologue(F); } SEAM(0);
    if (IN(1)) REP(1) { mod_rows(F, in[0], in[2], MA, in[6], MOD, 0, 1024, H); } SEAM(1);
    if (IN(2)) REP(2) { int rot = 0; EpiStore<0> E{(bf16*)(F.ws + WS_QKV), INW, INW}; run_gemm(F, H, (const bf16*)(F.ws + WS_W_IN), MA, INW, 1024, E, rot); } SEAM(2);
    if (IN(3)) REP(3) { na_norm_rows(F); ret_kv_phase(F); } SEAM(3);
    if (IN(4)) REP(4) { ret_prefix_phase(F); } SEAM(4);
    #ifndef PH5_SEL
#define PH5_SEL 3
#endif
    if (IN(5)) REP(5) { for (int r5_ = 0; r5_ < ((((PROBE_DUP) >> 27) & 1u) ? 2 : 1); ++r5_) ret_out_phase(F); for (int r6_ = 0; r6_ < ((((PROBE_DUP) >> 28) & 1u) ? 2 : 1); ++r6_) na_phase(F); } SEAM(5);
    if (IN(6)) REP(6) { int rot = 0; EpiResid E{in[0], XL, in[2], XC, MOD + 2048}; run_gemm(F, MIX, (const bf16*)(F.ws + WS_W_OUT), MA, 1024, 1024, E, rot); moe_fill(F, F.bx - 32, F.G - 32, 0, FILL_A); } SEAM(6);
    if (IN(7)) REP(7) { mod_rows(F, XL, XC, MA, in[7], MOD, 3072, 4096, H); } SEAM(7);
    if (IN(8)) REP(8) { int rot = 0; EpiSwiglu E{(bf16*)(F.ws + WS_FFH), FFN_H}; run_gemm(F, H, (const bf16*)(F.ws + WS_W_13), MA, 2 * FFN_H, 1024, E, rot); moe_fill(F, F.bx - 48, F.G - 48, FILL_A, FILL_B); } SEAM(8);
    if (IN(9)) { int rot = 0; EpiResid E{XL, XL, XC, XC, MOD + 5120}; run_gemm(F, (const bf16*)(F.ws + WS_FFH), (const bf16*)(F.ws + WS_W_2), MA, 1024, FFN_H, E, rot); moe_fill(F, F.bx - 32, F.G - 32, FILL_B, FILL_C); } SEAM(9);
    const float* MOD1 = MOD + 9 * 6144;
    if (IN(10)) REP(10) { xm_phase(F, XL, XC, in[6] + 1024, MOD1); } SEAM(10);
    if (IN(11)) REP(11) { int rot = 0; const bf16* XM = (const bf16*)(F.ws + WS_XM); const bf16* WR = (const bf16*)(F.ws + WS_W_RKV); const bf16* WL1 = (const bf16*)(F.ws + WS_W_L1);
        { EpiStoreHead E{(bf16*)(F.ws + WS_RB), SEQ, 0}; run_gemm(F, XM, WR, ML, 1024, 1024, E, rot); }
        { EpiStoreHead E{(bf16*)(F.ws + WS_KB), SEQ + CTXL, CTXL}; run_gemm(F, XM + (size_t)1 * MA * D, WR + 1024 * 1024, MA, 1024, 1024, E, rot); }
        { EpiStoreHead E{(bf16*)(F.ws + WS_VB), SEQ + CTXL, CTXL}; run_gemm(F, XM + (size_t)2 * MA * D, WR + 2 * 1024 * 1024, MA, 1024, 1024, E, rot); }
        { EpiStore<1> E{(bf16*)(F.ws + WS_L1), 256, 128}; run_gemm(F, XM + (size_t)3 * MA * D, WL1, MA, 256, 1024, E, rot); }
        { EpiStore<0> E{(bf16*)(F.ws + WS_L1) + 128, 256, 128}; run_gemm(F, XM + (size_t)4 * MA * D, WL1 + 256 * 1024, MA, 256, 1024, E, rot); }
        { EpiStore<2> E{(bf16*)(F.ws + WS_LG), 256, 256}; run_gemm(F, XM + (size_t)5 * MA * D, WL1 + 2 * 256 * 1024, ML, 256, 1024, E, rot); }
        moe_fill(F, F.bx - 16, F.G - 16, FILL_C, MOE_ITEMS); } SEAM(11);
    if (IN(12)) REP(12) { int rot = 0;
        { EpiLora2 E{(bf16*)(F.ws + WS_DEC), (bf16*)(F.ws + WS_AG), in[20], in[23]}; run_gemm(F, (const bf16*)(F.ws + WS_L1), (const bf16*)(F.ws + WS_W_L2), MA, 4096, 256, E, rot); }
        { EpiStore<0> E{(bf16*)(F.ws + WS_G), D, D}; run_gemm(F, (const bf16*)(F.ws + WS_LG), (const bf16*)(F.ws + WS_W_G2), ML, 1024, 256, E, rot); } } SEAM(12);
    #ifndef SCAN_VER
#define SCAN_VER 2
#endif
    if (IN(13)) REP(13) { rwkv_scan2_phase(F); } SEAM(13);
    if (IN(14)) REP(14) { rwkv_readout_phase(F); } SEAM(14);
    if (IN(15)) { int rot = 0; EpiResid E{XL, XL, XC, XC, MOD1 + 2048}; run_gemm(F, H, (const bf16*)(F.ws + WS_W_O), ML, 1024, 1024, E, rot); } SEAM(15);
    if (IN(16)) REP(16) { moe_route_phase(F, XL, in[7] + 1024, MOD1); } SEAM(16);
    if (IN(17)) REP(17) { moe_gather_phase(F); } SEAM(17);
    if (IN(18) || IN(19)) {
        const int* Exp = (const int*)(F.ws + WS_MISC + MISC_EXP);
        pg8::MoeOrder S; S.G = F.G; S.c = F.bx;
#pragma unroll
        for (int e = 0; e < 8; ++e) S.tend[e] = Exp[16 + e];
        S.nM = S.tend[7];
        if (IN(18)) REP(18) { S.nN = 2 * EXP_H / 256; S.nwg = S.nM * S.nN; pg8::Gemm g{(const bf16*)(F.ws + WS_XG), (const bf16*)(F.ws + WS_W_M13), XG_ROWS, 2 * EXP_H, 1024};
            EpiSwiglu E{(bf16*)(F.ws + WS_HG), EXP_H}; pg8::gemm_phase<EpiSwiglu, pg8::MoeOrder>(F.lds, g, S, E); }
        SEAM(18);
        if (IN(19)) REP(19) { S.nN = 4; S.nwg = S.nM * S.nN; pg8::Gemm g{(const bf16*)(F.ws + WS_HG), (const bf16*)(F.ws + WS_W_M2), XG_ROWS, 1024, EXP_H};
            EpiMoeOut E{(bf16*)(F.ws + WS_YS), (const int*)(F.ws + WS_ROWS), (const float*)(F.ws + WS_ROWS + 262144)}; pg8::gemm_phase<EpiMoeOut, pg8::MoeOrder>(F.lds, g, S, E); }
    }
    if (IN(19) && IN(20)) xcd_barrier(bar);
    if (IN(19) && IN(20)) for (int xb_ = 0; xb_ < ((((PROBE_DUP) >> 29) & 1u) ? 20 : 0); ++xb_) xcd_barrier(bar);
    if (IN(20)) { moe_combine_phase(F, XL, MOD1); }
#undef IN
#undef SEAM
}

#ifndef MK_SPLIT
#define MK_SPLIT 0
#endif
extern "C" void kernel_launch(void* const* d_in, const int* in_sizes, int n_in, void* d_out, int out_size, void* d_ws, size_t ws_size, hipStream_t stream) {
    static int grid = 0;
    if (grid == 0) {
        if (n_in != 37 || out_size != ML * D || ws_size < WS_END) { fprintf(stderr, "kernel_launch: unexpected problem (n_in %d out %d ws %zu)\n", n_in, out_size, ws_size); grid = -1; return; }
        int dev = 0, cus = 0, per_cu = 0;
        if (hipGetDevice(&dev) != hipSuccess || hipDeviceGetAttribute(&cus, hipDeviceAttributeMultiprocessorCount, dev) != hipSuccess) { grid = -1; return; }
        if (hipFuncSetAttribute((const void*)fwd_kernel, hipFuncAttributeMaxDynamicSharedMemorySize, LDS_BYTES) != hipSuccess) { fprintf(stderr, "kernel_launch: hipFuncSetAttribute failed\n"); grid = -1; return; }
        if (hipOccupancyMaxActiveBlocksPerMultiprocessor(&per_cu, (const void*)fwd_kernel, NTHR, LDS_BYTES) != hipSuccess || per_cu < 1) { fprintf(stderr, "kernel_launch: occupancy query says %d\n", per_cu); }
        (void)hipGetLastError();
        grid = cus;
    }
    if (grid < 0) return;
    (void)hipMemsetAsync((char*)d_ws + WS_CTL, 0, CTL_ZERO_BYTES, stream);
    Args a{};
    for (int i = 0; i < 37; ++i) a.in[i] = (const float*)d_in[i];
    a.out = (float*)d_out; a.ws = (unsigned char*)d_ws;
#if MK_SPLIT
    for (int p = 0; p <= N_PHASES; ++p) { a.ph_lo = p; a.ph_hi = p + 1; hipLaunchKernelGGL(fwd_kernel, dim3(grid), dim3(NTHR), LDS_BYTES, stream, a); }
#elif defined(PROBE_RELAUNCH)
    a.ph_lo = 0; a.ph_hi = PROBE_RELAUNCH + 1; hipLaunchKernelGGL(fwd_kernel, dim3(grid), dim3(NTHR), LDS_BYTES, stream, a);
    (void)hipMemsetAsync((char*)d_ws + WS_CTL, 0, CTL_ZERO_BYTES, stream);
    a.ph_lo = PROBE_RELAUNCH; a.ph_hi = PROBE_RELAUNCH + 1; hipLaunchKernelGGL(fwd_kernel, dim3(grid), dim3(NTHR), LDS_BYTES, stream, a);
    a.ph_lo = PROBE_RELAUNCH + 1; a.ph_hi = N_PHASES + 1; hipLaunchKernelGGL(fwd_kernel, dim3(grid), dim3(NTHR), LDS_BYTES, stream, a);
#else
    a.ph_lo = 0; a.ph_hi = N_PHASES + 1; hipLaunchKernelGGL(fwd_kernel, dim3(grid), dim3(NTHR), LDS_BYTES, stream, a);
#endif
}
```

```cpp
#include <hip/hip_runtime.h>
#include <cstdio>
#include <cstdint>

#ifndef PROBE_DUP
#define PROBE_DUP 0u
#endif
#define DI __device__ __forceinline__
#define LAS __attribute__((address_space(3)))

namespace pg8 {
#define PG8_LAS __attribute__((address_space(3)))
typedef unsigned short bf16_t;
typedef short bf16x8 __attribute__((ext_vector_type(8)));
typedef float f32x4 __attribute__((ext_vector_type(4)));
typedef unsigned u32x4 __attribute__((ext_vector_type(4)));
constexpr int BM = 256, BK = 64, HALF = 128, HTB = HALF * BK * 2  , STAGE_BYTES = 8 * HTB, NXCD = 8, WGM = 8;

__host__ __device__ __forceinline__ int lds_byte(int r, int c) { const int st = (r >> 4) * 2 + (c >> 5), rr = r & 15, cc = c & 31, ob = rr * 64 + cc * 2; return st * 1024 + (ob ^ (((ob >> 9) & 1) << 5)); }
__host__ __device__ __forceinline__ void stage_rc(int b, int& R, int& C) { const int st = b / 1024, sb = b % 1024, swz = sb ^ (((sb >> 9) & 1) << 5); R = (st >> 1) * 16 + swz / 64; C = (st & 1) * 32 + (swz % 64) / 2; }
__host__ __device__ __forceinline__ int perm32(int rho) { const int n = rho >> 4, i = rho & 15; return 8 * (i >> 2) + 4 * n + (i & 3); }

struct Unit { int pm, pn, pb; };
struct Gemm { const bf16_t* A; const bf16_t* Bt; int M, N, K; };

struct StaticOrder {
    int nM, nN, nwg, G, c;
    __host__ __device__ void init(int M, int N, int G_, int c_) { nM = M / BM; nN = N / BM; nwg = nM * nN; G = G_; c = c_; }
    __host__ __device__ bool next(int i, Unit& u) const {
        const long L = (long)i * G + c; if (L >= nwg) return false;
        int wgid = (int)L; { const int q = nwg / NXCD, r = nwg % NXCD, xcd = wgid % NXCD, off = wgid / NXCD; wgid = (xcd < r ? xcd * (q + 1) : r * (q + 1) + (xcd - r) * q) + off; }
        const int nig = WGM * nN, gid = wgid / nig, fm = gid * WGM, gsz = (nM - fm) < WGM ? (nM - fm) : WGM;
        u.pm = fm + ((wgid % nig) % gsz); u.pn = (wgid % nig) / gsz; u.pb = u.pn; return true;
    }
    __device__ __forceinline__ void a_ready(const Unit&) const {}
    __device__ __forceinline__ void done(const Unit&) const {}
};
struct MoeOrder {
    int nM, nN, nwg, G, c; int tend[8];
    __device__ bool next(int i, Unit& u) const {
        const long L = (long)i * G + c; if (L >= nwg) return false;
        int wgid = (int)L; { const int q = nwg / NXCD, r = nwg % NXCD, xcd = wgid % NXCD, off = wgid / NXCD; wgid = (xcd < r ? xcd * (q + 1) : r * (q + 1) + (xcd - r) * q) + off; }
        const int nig = WGM * nN, gid = wgid / nig, fm = gid * WGM, gsz = (nM - fm) < WGM ? (nM - fm) : WGM;
        u.pm = fm + ((wgid % nig) % gsz); u.pn = (wgid % nig) / gsz;
        int e = 0;
#pragma unroll
        for (int j = 0; j < 7; ++j) e += (u.pm >= tend[j]) ? 1 : 0;
        u.pb = e * nN + u.pn; return true;
    }
    __device__ __forceinline__ void a_ready(const Unit&) const {}
    __device__ __forceinline__ void done(const Unit&) const {}
};

typedef float f32x2_t __attribute__((ext_vector_type(2))); typedef __bf16 bf16x2_t __attribute__((ext_vector_type(2)));
__device__ __forceinline__ unsigned cvt_pk_bf16(float lo, float hi) { const f32x2_t v = {lo, hi}; const bf16x2_t b = __builtin_convertvector(v, bf16x2_t); return __builtin_bit_cast(unsigned, b); }

template <class Epi, class Sched>
__device__ __forceinline__ void gemm_phase(PG8_LAS unsigned char* lds, const Gemm g, const Sched& S, const Epi& E) {
    const int tid = threadIdx.x, wid = __builtin_amdgcn_readfirstlane(tid >> 6), lane = tid & 63, wr = wid >> 2, wc = wid & 3, fr = lane & 15, fq = lane >> 4;
    const int K = g.K, nt = K / BK;
    unsigned voffA[2], voffB[2];
#pragma unroll
    for (int i = 0; i < 2; ++i) { int R, C; stage_rc(tid * 16 + i * 8192, R, C); const int Rb = Epi::PERM ? ((R & ~31) + perm32(R & 31)) : R;
        voffA[i] = (unsigned)(R * K + C) * 2u; voffB[i] = (unsigned)(Rb * K + C) * 2u; }
    const size_t kstep = (size_t)(BK * 2);
    const size_t hstep = (size_t)HALF * K * 2;
    const size_t tstep = 2 * hstep;
    const unsigned ldsw = (unsigned)wid * 1024u;
    const int aoff = lds_byte(wr * 64 + fr, fq * 8), boff = lds_byte(wc * 32 + fr, fq * 8);
#define PG8_SA(b, h) (((b) * 2 + (h)) * HTB)
#define PG8_SB(b, h) ((4 + (b) * 2 + (h)) * HTB)
#define PG8_STAGE(bufoff, gbase, voff) do { _Pragma("unroll") for (int _i = 0; _i < 2; ++_i) \
        __builtin_amdgcn_global_load_lds((const unsigned*)((const char*)(gbase) + (voff)[_i]), (PG8_LAS unsigned*)(lds + (bufoff) + ldsw + _i * 8192), 16, 0, 0); } while (0)
#define PG8_LDA(dst, b, h) do { _Pragma("unroll") for (int m = 0; m < 4; ++m) _Pragma("unroll") for (int k = 0; k < 2; ++k) dst[m][k] = *(const PG8_LAS bf16x8*)(lds + PG8_SA(b, h) + aoff + m * 2048 + k * 1024); } while (0)
#define PG8_LDB(dst, b, h) do { _Pragma("unroll") for (int n = 0; n < 2; ++n) _Pragma("unroll") for (int k = 0; k < 2; ++k) dst[n][k] = *(const PG8_LAS bf16x8*)(lds + PG8_SB(b, h) + boff + n * 2048 + k * 1024); } while (0)
#define PG8_MMA(ai, bj, At, Bt) do { __builtin_amdgcn_s_setprio(1); _Pragma("unroll") for (int m = 0; m < 4; ++m) _Pragma("unroll") for (int n = 0; n < 2; ++n) _Pragma("unroll") for (int k = 0; k < 2; ++k) \
        acc[ai][bj][m][n] = __builtin_amdgcn_mfma_f32_16x16x32_bf16(Bt[n][k], At[m][k], acc[ai][bj][m][n], 0, 0, 0); __builtin_amdgcn_s_setprio(0); } while (0)
#define PG8_WAIT_V(n) asm volatile("s_waitcnt vmcnt(" #n ")" ::: "memory")
#define PG8_WAIT_L(n) asm volatile("s_waitcnt lgkmcnt(" #n ")" ::: "memory")
#define PG8_BAR __builtin_amdgcn_s_barrier()
#define PG8_SCHED __builtin_amdgcn_sched_barrier(0)
    Unit cur, nxt; int ui = 0;
    if (!S.next(0, cur)) return;
    f32x4 acc[2][2][4][2];
#pragma unroll
    for (int a = 0; a < 2; ++a)
#pragma unroll
        for (int b = 0; b < 2; ++b)
#pragma unroll
            for (int m = 0; m < 4; ++m)
#pragma unroll
                for (int n = 0; n < 2; ++n) acc[a][b][m][n] = (f32x4){0.f, 0.f, 0.f, 0.f};
    bf16x8 At[4][2], B0[2][2], B1[2][2];
    const char* cA = (const char*)g.A + (size_t)cur.pm * tstep; const char* cB = (const char*)g.Bt + (size_t)cur.pb * tstep;
    S.a_ready(cur);
    PG8_STAGE(PG8_SB(0, 0), cB, voffB); PG8_STAGE(PG8_SB(0, 1), cB + hstep, voffB); PG8_STAGE(PG8_SA(0, 0), cA, voffA); PG8_STAGE(PG8_SA(0, 1), cA + hstep, voffA);
    if (wr == 1) PG8_BAR;
    PG8_WAIT_V(2); PG8_BAR;
    PG8_STAGE(PG8_SB(1, 0), cB + kstep, voffB); PG8_STAGE(PG8_SA(1, 0), cA + kstep, voffA); PG8_STAGE(PG8_SB(1, 1), cB + hstep + kstep, voffB);
    PG8_WAIT_V(6); PG8_BAR;
    for (;;) {
        const bool has_next = S.next(ui + 1, nxt);
        const char* nA = has_next ? (const char*)g.A + (size_t)nxt.pm * tstep : cA; const char* nB = has_next ? (const char*)g.Bt + (size_t)nxt.pb * tstep : cB;
        for (int t = 0; t < nt; t += 2) {
            const bool last = (t == nt - 2);
            const char* a1 = cA + (size_t)(t + 1) * kstep;
            const char* a2 = last ? nA : cA + (size_t)(t + 2) * kstep; const char* b2 = last ? nB : cB + (size_t)(t + 2) * kstep;
            const char* a3 = a2 + kstep; const char* b3 = b2 + kstep;
            if (last && has_next) S.a_ready(nxt);
            PG8_LDB(B0, 0, 0); PG8_LDB(B1, 0, 1); PG8_SCHED; PG8_LDA(At, 0, 0); PG8_STAGE(PG8_SA(1, 1), a1 + hstep, voffA);
            PG8_WAIT_V(8); PG8_WAIT_L(0); PG8_BAR; PG8_MMA(0, 0, At, B0); PG8_MMA(0, 1, At, B1); PG8_BAR; PG8_SCHED;
            PG8_LDA(At, 0, 1); PG8_STAGE(PG8_SB(0, 0), b2, voffB); PG8_STAGE(PG8_SB(0, 1), b2 + hstep, voffB); PG8_STAGE(PG8_SA(0, 0), a2, voffA);
            PG8_WAIT_V(8); PG8_WAIT_L(0); PG8_BAR; PG8_MMA(1, 0, At, B0); PG8_MMA(1, 1, At, B1); PG8_BAR; PG8_SCHED;
            PG8_LDB(B0, 1, 0); PG8_LDB(B1, 1, 1); PG8_SCHED; PG8_LDA(At, 1, 0); PG8_STAGE(PG8_SA(0, 1), a2 + hstep, voffA);
            PG8_WAIT_V(8); PG8_WAIT_L(0); PG8_BAR; PG8_MMA(0, 0, At, B0); PG8_MMA(0, 1, At, B1); PG8_BAR; PG8_SCHED;
            PG8_LDA(At, 1, 1); PG8_STAGE(PG8_SB(1, 0), b3, voffB); PG8_STAGE(PG8_SB(1, 1), b3 + hstep, voffB); PG8_STAGE(PG8_SA(1, 0), a3, voffA);
            PG8_WAIT_V(8); PG8_WAIT_L(0); PG8_BAR; PG8_MMA(1, 0, At, B0); PG8_MMA(1, 1, At, B1); PG8_BAR; PG8_SCHED;
        }
        if (wr == 0) PG8_BAR;
        E(acc, cur, wr, wc, fr, fq); S.done(cur);
        if (!has_next) break;
#pragma unroll
        for (int a = 0; a < 2; ++a)
#pragma unroll
            for (int b = 0; b < 2; ++b)
#pragma unroll
                for (int m = 0; m < 4; ++m)
#pragma unroll
                    for (int n = 0; n < 2; ++n) acc[a][b][m][n] = (f32x4){0.f, 0.f, 0.f, 0.f};
        cur = nxt; cA = nA; cB = nB; ++ui;
        if (wr == 1) PG8_BAR;
    }
    PG8_WAIT_V(0);
    PG8_BAR;
#undef PG8_SA
#undef PG8_SB
#undef PG8_STAGE
#undef PG8_LDA
#undef PG8_LDB
#undef PG8_MMA
#undef PG8_WAIT_V
#undef PG8_WAIT_L
#undef PG8_BAR
#undef PG8_SCHED
}
}

constexpr int D = 1024, NB = 8, SEQ = 2048, CTXL = 256;
constexpr int ML = NB * SEQ;
constexpr int MC = NB * CTXL;
constexpr int MA = ML + MC;
constexpr int INW = 3584, FFN_H = 2816, EXP_H = 3584, NEXP = 8;
constexpr int NCH = 18;
constexpr int XG_ROWS = 34816;
constexpr int NWAVES = 8, NTHR = 512;

constexpr size_t MiB = 1u << 20;
constexpr size_t WS_CTL = 0, CTL_ZERO_BYTES = 1 * MiB;
constexpr size_t WS_MOD = 1 * MiB;
constexpr size_t WS_ROPE = 2 * MiB;
constexpr size_t WS_MISC = 3 * MiB;
constexpr size_t WS_W_IN = 4 * MiB, WS_W_OUT = 11 * MiB, WS_W_13 = 13 * MiB, WS_W_2 = 24 * MiB, WS_W_RKV = 30 * MiB, WS_W_L1 = 36 * MiB,
                 WS_W_L2 = 38 * MiB, WS_W_G2 = 40 * MiB, WS_W_O = 41 * MiB, WS_W_M13 = 43 * MiB, WS_W_M2 = 155 * MiB;
constexpr size_t WS_XC = 211 * MiB, WS_H = 219 * MiB, WS_MIX = 255 * MiB, WS_R = 291 * MiB;
constexpr size_t WS_QKV = WS_R, WS_KV = WS_R + 126 * MiB, WS_SPREV = WS_R + 198 * MiB, WS_FFH = WS_R;
constexpr size_t WS_NQ = WS_R + 240 * MiB, WS_NK = WS_R + 260 * MiB, WS_NV = WS_R + 280 * MiB;
constexpr size_t WS_XM = WS_R, WS_DEC = WS_R, WS_AG = WS_R + 144 * MiB, WS_RB = WS_R + 216 * MiB, WS_KB = WS_R + 248 * MiB, WS_VB = WS_R + 284 * MiB,
                 WS_L1 = WS_R + 320 * MiB, WS_LG = WS_R + 329 * MiB, WS_G = WS_R + 337 * MiB, WS_YF = WS_R + 369 * MiB, WS_YB = WS_R + 433 * MiB;
constexpr size_t WS_COEF = WS_R + 401 * MiB;
constexpr size_t WS_XG = WS_R, WS_HG = WS_R + 68 * MiB, WS_YS = WS_R + 306 * MiB, WS_ROWS = WS_R + 370 * MiB;
constexpr size_t WS_END = WS_R + 497 * MiB;
static_assert(WS_END <= 896 * MiB, "workspace map");
constexpr int CW_BAR = 4096;
constexpr size_t MISC_TOPE = 0, MISC_TOPW = 65536, MISC_CNTS = 196608, MISC_EXP = 204800;

constexpr int LDS_MAIN = 147456;
constexpr int LDS_MISC_OFF = LDS_MAIN;
constexpr int LDS_BYTES = LDS_MAIN + 256;

typedef unsigned short bf16;
typedef short bf16x8 __attribute__((ext_vector_type(8)));
typedef short s16x4 __attribute__((ext_vector_type(4)));
typedef float f32x4 __attribute__((ext_vector_type(4)));
typedef float f32x2 __attribute__((ext_vector_type(2)));
typedef unsigned u32x4 __attribute__((ext_vector_type(4)));
typedef unsigned u32x2 __attribute__((ext_vector_type(2)));
#define LDS_WAIT() asm volatile("s_waitcnt lgkmcnt(0)" ::: "memory")
#define VM_WAIT() asm volatile("s_waitcnt vmcnt(0)" ::: "memory")
#define WG_SYNC() __syncthreads()
#define LDS_BARRIER() do { asm volatile("s_waitcnt lgkmcnt(0)" ::: "memory"); __builtin_amdgcn_s_barrier(); asm volatile("" ::: "memory"); } while (0)
DI unsigned f2bf(float f) { unsigned u = __builtin_bit_cast(unsigned, f); return (u + 0x7fffu + ((u >> 16) & 1u)) >> 16; }
typedef __bf16 bf16x2_t __attribute__((ext_vector_type(2)));
DI unsigned pk2(float lo, float hi) { const f32x2 v = {lo, hi}; const bf16x2_t b = __builtin_convertvector(v, bf16x2_t); return __builtin_bit_cast(unsigned, b); }
DI float bflo(unsigned w) { return __builtin_bit_cast(float, w << 16); }
DI float bfhi(unsigned w) { return __builtin_bit_cast(float, w & 0xffff0000u); }
DI float bf1(bf16 b) { return __builtin_bit_cast(float, (unsigned)b << 16); }
DI float wave_sum(float v) {
#pragma unroll
    for (int o = 1; o < 64; o <<= 1) v += __shfl_xor(v, o);
    return v;
}
DI float dpp_rm(float v) { return __builtin_bit_cast(float, __builtin_amdgcn_update_dpp(0, __builtin_bit_cast(int, v), 0x140, 0xf, 0xf, true)); }
DI float wave_sum_fast(float v) {
    v += __builtin_bit_cast(float, __builtin_amdgcn_update_dpp(0, __builtin_bit_cast(int, v), 0xB1, 0xf, 0xf, true));
    v += __builtin_bit_cast(float, __builtin_amdgcn_update_dpp(0, __builtin_bit_cast(int, v), 0x4E, 0xf, 0xf, true));
    v += __builtin_bit_cast(float, __builtin_amdgcn_update_dpp(0, __builtin_bit_cast(int, v), 0x141, 0xf, 0xf, true));
    v += dpp_rm(v);
    const int iv = __builtin_bit_cast(int, v);
    const float a = __builtin_bit_cast(float, __builtin_amdgcn_readlane(iv, 0)), b = __builtin_bit_cast(float, __builtin_amdgcn_readlane(iv, 16));
    const float c = __builtin_bit_cast(float, __builtin_amdgcn_readlane(iv, 32)), d = __builtin_bit_cast(float, __builtin_amdgcn_readlane(iv, 48));
    return (a + b) + (c + d);
}
DI float wave_max(float v) {
#pragma unroll
    for (int o = 1; o < 64; o <<= 1) v = fmaxf(v, __shfl_xor(v, o));
    return v;
}
DI float dpp_x1(float v) { return __builtin_bit_cast(float, __builtin_amdgcn_update_dpp(0, __builtin_bit_cast(int, v), 0xB1, 0xf, 0xf, true)); }
DI float dpp_x2(float v) { return __builtin_bit_cast(float, __builtin_amdgcn_update_dpp(0, __builtin_bit_cast(int, v), 0x4E, 0xf, 0xf, true)); }
DI float dpp_hm(float v) { return __builtin_bit_cast(float, __builtin_amdgcn_update_dpp(0, __builtin_bit_cast(int, v), 0x141, 0xf, 0xf, true)); }
DI float red4(float v) { v += dpp_x1(v); v += dpp_x2(v); return v; }
DI float red8(float v) { v += dpp_x1(v); v += dpp_x2(v); v += dpp_hm(v); return v; }
DI float sigmoidf_(float x) { return __builtin_amdgcn_rcpf(1.f + __expf(-x)); }
DI float siluf_(float x) { return x * __builtin_amdgcn_rcpf(1.f + __expf(-x)); }

DI bf16x8 frag_kc(const LAS bf16* base, int ld, int row0, int k0, int lane) {
    return *(const LAS bf16x8*)(base + (row0 + (lane & 15)) * ld + k0 + 8 * (lane >> 4));
}
DI bf16x8 frag_kr(const LAS bf16* base, int ld, int x0, int k0, int lane) {
    const int g = lane >> 4, q = (lane & 15) >> 2, p = lane & 3;
    const LAS bf16* a = base + (k0 + 8 * g + q) * ld + x0 + 4 * p;
    const s16x4 lo = __builtin_amdgcn_ds_read_tr16_b64_v4i16((LAS s16x4*)a);
    const s16x4 hi = __builtin_amdgcn_ds_read_tr16_b64_v4i16((LAS s16x4*)(a + 4 * ld));
    return __builtin_shufflevector(lo, hi, 0, 1, 2, 3, 4, 5, 6, 7);
}
DI f32x4 mma(f32x4 acc, bf16x8 bfrag, bf16x8 afrag) { return __builtin_amdgcn_mfma_f32_16x16x32_bf16(bfrag, afrag, acc, 0, 0, 0); }

#define XB_TMO      128
#define XB_XCNT(j)  (256  + 64 * (j))
#define XB_XSUB(j)  (1280 + 64 * (j))
#define XB_XGEN(j)  (2304 + 64 * (j))
#define XB_TOP      3328
#define XB_TOPGEN   3392
#define XCD_BAR_WORDS 3456
#define XB_SPIN_CAP (1u << 18)
DI unsigned xb_ld(unsigned* p)              { return __hip_atomic_load(p, __ATOMIC_RELAXED, __HIP_MEMORY_SCOPE_AGENT); }
DI unsigned xb_add(unsigned* p, unsigned v) { return __hip_atomic_fetch_add(p, v, __ATOMIC_RELAXED, __HIP_MEMORY_SCOPE_AGENT); }
DI unsigned xb_xcc_id() { return (unsigned)__builtin_amdgcn_s_getreg((3 << 11) | 20) & 0xFu; }
#define XB_SPIN(cond, bar) do { unsigned _sp = 0; while (cond) { __builtin_amdgcn_s_sleep(1); \
    if ((++_sp & 255u) == 0u) { if (xb_ld(&(bar)[XB_TMO])) break; if (_sp > XB_SPIN_CAP) { atomicAdd(&(bar)[XB_TMO], 1u); break; } } } } while (0)
struct XcdBarrier { unsigned* bar; unsigned x; volatile LAS unsigned* st; };
DI XcdBarrier xcd_barrier_post(unsigned* bar, volatile LAS unsigned* st) {
    XcdBarrier b; b.bar = bar; b.x = xb_xcc_id(); b.st = st;
    if (threadIdx.x == 0) (void)xb_add(&bar[XB_XCNT(b.x)], 1u);
    return b;
}
DI void xcd_barrier_complete(unsigned* bar, unsigned x, unsigned& nloc, unsigned& nx) {
    const unsigned G = gridDim.x * gridDim.y * gridDim.z;
    unsigned sum, cnt, mine, sp = 0u;
    for (;;) {
        sum = 0u; cnt = 0u; mine = 0u;
#pragma unroll
        for (unsigned j = 0; j < 16; ++j) { const unsigned c = xb_ld(&bar[XB_XCNT(j)]); sum += c; cnt += (c > 0u) ? 1u : 0u; mine = (j == x) ? c : mine; }
        if (sum == G) break;
        __builtin_amdgcn_s_sleep(1);
        if ((++sp & 255u) == 0u) { if (xb_ld(&bar[XB_TMO])) break; if (sp > XB_SPIN_CAP) { atomicAdd(&bar[XB_TMO], 1u); break; } }
    }
    nloc = mine > 0u ? mine : 1u; nx = cnt > 0u ? cnt : 1u;
}
DI void xcd_barrier(const XcdBarrier& b) {
    asm volatile("s_waitcnt vmcnt(0)" ::: "memory");
    __syncthreads();
    if (threadIdx.x == 0) {
        unsigned* bar = b.bar;
        __builtin_amdgcn_s_waitcnt(0);
        unsigned nloc = b.st[0], nx = b.st[1];
        if (nloc == 0u) { xcd_barrier_complete(bar, b.x, nloc, nx); b.st[0] = nloc; b.st[1] = nx; }
        const unsigned old = xb_add(&bar[XB_XSUB(b.x)], 1u);
        const unsigned gen = old / nloc;
        if (old + 1u == (gen + 1u) * nloc) {
            __builtin_amdgcn_fence(__ATOMIC_RELEASE, "agent");
            asm volatile("s_waitcnt vmcnt(0)" ::: "memory");
            const unsigned og = xb_add(&bar[XB_TOP], 1u);
            const unsigned tg = og / nx;
            if (og + 1u == (tg + 1u) * nx) xb_add(&bar[XB_TOPGEN], 1u);
            else XB_SPIN(xb_ld(&bar[XB_TOPGEN]) == tg, bar);
            __builtin_amdgcn_fence(__ATOMIC_ACQUIRE, "agent");
            xb_add(&bar[XB_XGEN(b.x)], 1u);
            asm volatile("s_waitcnt vmcnt(0)" ::: "memory");
        } else {
            XB_SPIN(xb_ld(&bar[XB_XGEN(b.x)]) == gen, bar);
            __builtin_amdgcn_fence(__ATOMIC_ACQUIRE, "agent");
            asm volatile("s_waitcnt vmcnt(0)" ::: "memory");
        }
    }
    __syncthreads();
}

struct Fr {
    LAS unsigned char* lds;
    unsigned char* ws;
    const float* const* in;
    float* out;
    int tid, lane, wave, bx, G, gw, NGW;
};

using pg8::Unit;
template <int ACT  > struct EpiStore {
    static constexpr bool PERM = true;
    bf16* O; int ldc; int nvalid;
    DI void operator()(const f32x4 (&acc)[2][2][4][2], const Unit& u, int wr, int wc, int fr, int fq) const {
        const int row0 = u.pm * 256 + wr * 64 + fr, col0 = u.pn * 256 + wc * 32 + 8 * fq;
#pragma unroll
        for (int ai = 0; ai < 2; ++ai)
#pragma unroll
            for (int m = 0; m < 4; ++m) { bf16* rowp = O + (size_t)(row0 + ai * 128 + m * 16) * ldc + col0;
#pragma unroll
                for (int bj = 0; bj < 2; ++bj) { if (u.pn * 256 + bj * 128 >= nvalid) continue;
                    f32x4 v0 = acc[ai][bj][m][0], v1 = acc[ai][bj][m][1];
                    if (ACT == 1) {
#pragma unroll
                        for (int j = 0; j < 4; ++j) { v0[j] = 1.f - 2.f * __builtin_amdgcn_rcpf(1.f + __expf(2.f * v0[j])); v1[j] = 1.f - 2.f * __builtin_amdgcn_rcpf(1.f + __expf(2.f * v1[j])); } }
                    if (ACT == 2) {
#pragma unroll
                        for (int j = 0; j < 4; ++j) { v0[j] = sigmoidf_(v0[j]); v1[j] = sigmoidf_(v1[j]); } }
                    u32x4 w; w.x = pg8::cvt_pk_bf16(v0[0], v0[1]); w.y = pg8::cvt_pk_bf16(v0[2], v0[3]); w.z = pg8::cvt_pk_bf16(v1[0], v1[1]); w.w = pg8::cvt_pk_bf16(v1[2], v1[3]);
                    *(u32x4*)(rowp + bj * 128) = w; } }
    }
};
struct EpiStoreHead {
    static constexpr bool PERM = true;
    bf16* O; int TL; int lat_off;
    DI void operator()(const f32x4 (&acc)[2][2][4][2], const Unit& u, int wr, int wc, int fr, int fq) const {
        const bool lat = u.pm < 64; const int b = lat ? (u.pm >> 3) : (u.pm - 64); const int sbase = lat ? lat_off + (u.pm & 7) * 256 : 0;
        const int rt0 = sbase + wr * 64 + fr, j = (wc & 1) * 32 + 8 * fq;
#pragma unroll
        for (int ai = 0; ai < 2; ++ai)
#pragma unroll
            for (int m = 0; m < 4; ++m)
#pragma unroll
                for (int bj = 0; bj < 2; ++bj) { const int h = 4 * u.pn + 2 * bj + (wc >> 1);
                    const f32x4 v0 = acc[ai][bj][m][0], v1 = acc[ai][bj][m][1];
                    u32x4 w; w.x = pg8::cvt_pk_bf16(v0[0], v0[1]); w.y = pg8::cvt_pk_bf16(v0[2], v0[3]); w.z = pg8::cvt_pk_bf16(v1[0], v1[1]); w.w = pg8::cvt_pk_bf16(v1[2], v1[3]);
                    *(u32x4*)(O + ((size_t)(b * 16 + h) * TL + rt0 + ai * 128 + m * 16) * 64 + j) = w; }
    }
};
struct EpiResid {
    static constexpr bool PERM = false;
    const float* baseL; float* outL; const float* baseC; float* outC; const float* modg;
    DI void operator()(const f32x4 (&acc)[2][2][4][2], const Unit& u, int wr, int wc, int fr, int fq) const {
        const bool lat = u.pm < 64; const int r = lat ? (u.pm >> 3) : 8;
        const float* base = lat ? baseL : baseC; float* out = lat ? outL : outC;
        const int row0 = (lat ? u.pm : u.pm - 64) * 256 + wr * 64 + fr, col0 = u.pn * 256 + wc * 32 + 4 * fq;
        const float* mg = modg + (size_t)r * 6144 + col0;
        f32x4 mv[2][2];
#pragma unroll
        for (int bj = 0; bj < 2; ++bj)
#pragma unroll
            for (int n = 0; n < 2; ++n) mv[bj][n] = *(const f32x4*)(mg + bj * 128 + n * 16);
#pragma unroll
        for (int ai = 0; ai < 2; ++ai)
#pragma unroll
            for (int m = 0; m < 4; ++m) { const size_t off = (size_t)(row0 + ai * 128 + m * 16) * D + col0;
#pragma unroll
                for (int bj = 0; bj < 2; ++bj)
#pragma unroll
                    for (int n = 0; n < 2; ++n) { const f32x4 bs = *(const f32x4*)(base + off + bj * 128 + n * 16);
                        *(f32x4*)(out + off + bj * 128 + n * 16) = bs + mv[bj][n] * acc[ai][bj][m][n]; } }
    }
};
struct EpiSwiglu {
    static constexpr bool PERM = true;
    bf16* Hd; int ldh;
    DI void operator()(const f32x4 (&acc)[2][2][4][2], const Unit& u, int wr, int wc, int fr, int fq) const {
        const int row0 = u.pm * 256 + wr * 64 + fr, col0 = u.pn * 128 + wc * 32 + 8 * fq;
#pragma unroll
        for (int ai = 0; ai < 2; ++ai)
#pragma unroll
            for (int m = 0; m < 4; ++m) { bf16* rowp = Hd + (size_t)(row0 + ai * 128 + m * 16) * ldh + col0;
                f32x4 v0, v1;
#pragma unroll
                for (int j = 0; j < 4; ++j) { v0[j] = siluf_(acc[ai][0][m][0][j]) * acc[ai][1][m][0][j]; v1[j] = siluf_(acc[ai][0][m][1][j]) * acc[ai][1][m][1][j]; }
                u32x4 w; w.x = pg8::cvt_pk_bf16(v0[0], v0[1]); w.y = pg8::cvt_pk_bf16(v0[2], v0[3]); w.z = pg8::cvt_pk_bf16(v1[0], v1[1]); w.w = pg8::cvt_pk_bf16(v1[2], v1[3]);
                *(u32x4*)rowp = w; }
    }
};
struct EpiLora2 {
    static constexpr bool PERM = true;
    bf16* DEC; bf16* AG; const float* w0; const float* a0;
    DI void operator()(const f32x4 (&acc)[2][2][4][2], const Unit& u, int wr, int wc, int fr, int fq) const {
        const int q = u.pn >> 2, z = q & 1; const int col0 = (u.pn & 3) * 256 + wc * 32 + 8 * fq;
        const bool lat = u.pm < 64; const int b = lat ? (u.pm >> 3) : (u.pm - 64); const int rt0 = (lat ? CTXL + (u.pm & 7) * 256 : 0) + wr * 64 + fr, j = (wc & 1) * 32 + 8 * fq;
        const float* bias = (q < 2 ? w0 : a0) + z * 1024 + col0;
        f32x4 bv[2][2];
#pragma unroll
        for (int bj = 0; bj < 2; ++bj)
#pragma unroll
            for (int n = 0; n < 2; ++n) bv[bj][n] = *(const f32x4*)(bias + bj * 128 + 4 * n);
#pragma unroll
        for (int ai = 0; ai < 2; ++ai)
#pragma unroll
            for (int m = 0; m < 4; ++m) {
#pragma unroll
                for (int bj = 0; bj < 2; ++bj) { f32x4 v0 = acc[ai][bj][m][0] + bv[bj][0], v1 = acc[ai][bj][m][1] + bv[bj][1];
                    const int h = 4 * (u.pn & 3) + 2 * bj + (wc >> 1);
                    const size_t off = ((size_t)(z * 128 + b * 16 + h) * (SEQ + CTXL) + rt0 + ai * 128 + m * 16) * 64 + j;
                    if (q < 2) {
#pragma unroll
                        for (int jj = 0; jj < 4; ++jj) {
                            v0[jj] = -0.6065306597126334f * sigmoidf_(v0[jj]); v1[jj] = -0.6065306597126334f * sigmoidf_(v1[jj]); }
                        u32x4 w; w.x = pg8::cvt_pk_bf16(v0[0], v0[1]); w.y = pg8::cvt_pk_bf16(v0[2], v0[3]); w.z = pg8::cvt_pk_bf16(v1[0], v1[1]); w.w = pg8::cvt_pk_bf16(v1[2], v1[3]);
                        *(u32x4*)(DEC + off) = w; __builtin_amdgcn_sched_barrier(0);
                    } else {
#pragma unroll
                        for (int jj = 0; jj < 4; ++jj) { v0[jj] = sigmoidf_(v0[jj]); v1[jj] = sigmoidf_(v1[jj]); }
                        u32x4 w; w.x = pg8::cvt_pk_bf16(v0[0], v0[1]); w.y = pg8::cvt_pk_bf16(v0[2], v0[3]); w.z = pg8::cvt_pk_bf16(v1[0], v1[1]); w.w = pg8::cvt_pk_bf16(v1[2], v1[3]);
                        *(u32x4*)(AG + off) = w; __builtin_amdgcn_sched_barrier(0); } } }
    }
};
struct EpiMoeOut {
    static constexpr bool PERM = true;
    bf16* YS; const int* RowTok; const float* RowW;
    DI void operator()(const f32x4 (&acc)[2][2][4][2], const Unit& u, int wr, int wc, int fr, int fq) const {
        const int row0 = u.pm * 256 + wr * 64 + fr, col0 = u.pn * 256 + wc * 32 + 8 * fq;
#pragma unroll
        for (int ai = 0; ai < 2; ++ai)
#pragma unroll
            for (int m = 0; m < 4; ++m) { const int row = row0 + ai * 128 + m * 16; const int t2 = RowTok[row]; if (t2 < 0) continue; const float w = RowW[row];
                bf16* rowp = YS + (size_t)t2 * D + col0;
#pragma unroll
                for (int bj = 0; bj < 2; ++bj) { const f32x4 v0 = acc[ai][bj][m][0] * w, v1 = acc[ai][bj][m][1] * w;
                    u32x4 o; o.x = pg8::cvt_pk_bf16(v0[0], v0[1]); o.y = pg8::cvt_pk_bf16(v0[2], v0[3]); o.z = pg8::cvt_pk_bf16(v1[0], v1[1]); o.w = pg8::cvt_pk_bf16(v1[2], v1[3]);
                    *(u32x4*)(rowp + bj * 128) = o; } }
    }
};

DI void tr_item(const float* src, int ldsrc, int Kreal, int k0, int n0, bf16* dst, int lddst, int drow0, int dcol0, LAS float* scr, int lane) {
#pragma unroll 8
    for (int i = 0; i < 32; ++i) { const int kk = 2 * i + (lane >> 5), k = k0 + kk; float v = 0.f; if (k < Kreal) v = src[(size_t)k * ldsrc + n0 + (lane & 31)]; scr[kk * 33 + (lane & 31)] = v; }
    LDS_WAIT();
    const int c = lane & 7;
#pragma unroll
    for (int j = 0; j < 4; ++j) { const int n = (lane >> 3) + 8 * j; const LAS float* s = scr + (8 * c) * 33 + n;
        u32x4 o; o.x = pk2(s[0 * 33], s[1 * 33]); o.y = pk2(s[2 * 33], s[3 * 33]); o.z = pk2(s[4 * 33], s[5 * 33]); o.w = pk2(s[6 * 33], s[7 * 33]);
        *(u32x4*)(dst + (size_t)(drow0 + n) * lddst + dcol0 + k0 + 8 * c) = o; }
    LDS_WAIT();
}
DI void tr_plain(const float* src, int K, int N, bf16* dst, int r, LAS float* scr, int lane) {
    const int nblk = N / 32, kb = r / nblk, nb = r % nblk; tr_item(src, N, K, 64 * kb, 32 * nb, dst, K, 32 * nb, 0, scr, lane);
}
DI void tr_gateup(const float* src, int K, int Hh, bf16* dst, int r, LAS float* scr, int lane) {
    const int nblk = 2 * Hh / 32, kb = r / nblk, nb = r % nblk, n0 = 32 * nb, half = n0 / Hh, j0 = n0 % Hh;
    tr_item(src, 2 * Hh, K, 64 * kb, n0, dst, K, (j0 / 128) * 256 + half * 128 + (j0 % 128), 0, scr, lane);
}
DI void tr16_item(const float* src, int ldsrc, int k0, int n0, bf16* dst, int lddst, int Hh, int lane) {
    f32x4 v[16];
#pragma unroll
    for (int kk = 0; kk < 16; ++kk) v[kk] = *(const f32x4*)(src + (size_t)(k0 + kk) * ldsrc + n0 + 4 * lane);
    const int n = n0 + 4 * lane; int drow = n;
    if (Hh) { const int half = n / Hh, j = n % Hh; drow = (j / 128) * 256 + half * 128 + (j % 128); }
#pragma unroll
    for (int q = 0; q < 4; ++q) { u32x4 o0, o1;
        o0.x = pk2(v[0][q], v[1][q]); o0.y = pk2(v[2][q], v[3][q]); o0.z = pk2(v[4][q], v[5][q]); o0.w = pk2(v[6][q], v[7][q]);
        o1.x = pk2(v[8][q], v[9][q]); o1.y = pk2(v[10][q], v[11][q]); o1.z = pk2(v[12][q], v[13][q]); o1.w = pk2(v[14][q], v[15][q]);
        bf16* d = dst + (size_t)(drow + q) * lddst + k0; *(u32x4*)d = o0; *(u32x4*)(d + 8) = o1; }
}
DI void tr64_item(const float* src, int ldsrc, int k0, int n0, bf16* dst, int lddst, int Hh, int lane) {
    float v[64];
    const float* sp = src + (size_t)k0 * ldsrc + n0 + lane;
#pragma unroll
    for (int kk = 0; kk < 64; ++kk) v[kk] = sp[(size_t)kk * ldsrc];
    const int n = n0 + lane; int drow = n;
    if (Hh) { const int half = n / Hh, j = n % Hh; drow = (j / 128) * 256 + half * 128 + (j % 128); }
    bf16* d = dst + (size_t)drow * lddst + k0;
#pragma unroll
    for (int c = 0; c < 8; ++c) { u32x4 o; o.x = pk2(v[8 * c], v[8 * c + 1]); o.y = pk2(v[8 * c + 2], v[8 * c + 3]); o.z = pk2(v[8 * c + 4], v[8 * c + 5]); o.w = pk2(v[8 * c + 6], v[8 * c + 7]);
        *(u32x4*)(d + 8 * c) = o; }
}
DI void tr16_mat(const float* src, int K, int N, bf16* dst, int Hh, int r, int lane) { const int nb = N / 64; tr64_item(src, N, 64 * (r / nb), 64 * (r % nb), dst, K, Hh, lane); }
constexpr int MOE_B13 = 16 * 112, MOE_B2 = 56 * 16, MOE_ITEMS = 8 * MOE_B13 + 8 * MOE_B2;
constexpr int FILL_A = 0, FILL_B = 0, FILL_C = 7500;
DI void moe_fill(Fr& F, int slot, int nslots, int i0, int i1) {
    if (slot < 0 || slot >= nslots) return;
    bf16* W_M13 = (bf16*)(F.ws + WS_W_M13); bf16* W_M2 = (bf16*)(F.ws + WS_W_M2);
    for (int r = i0 + slot * NWAVES + F.wave; r < i1; r += nslots * NWAVES) {
        if (r < 8 * MOE_B13) { const int e = r / MOE_B13; tr16_mat(F.in[35] + (size_t)e * 1024 * 7168, 1024, 7168, W_M13 + (size_t)e * 7168 * 1024, EXP_H, r % MOE_B13, F.lane); }
        else { const int r2 = r - 8 * MOE_B13, e = r2 / MOE_B2; tr16_mat(F.in[36] + (size_t)e * EXP_H * 1024, EXP_H, 1024, W_M2 + (size_t)e * 1024 * EXP_H, 0, r2 % MOE_B2, F.lane); }
    }
}
DI void p0_prologue(Fr& F) {
    LAS float* scr = (LAS float*)(F.lds + F.wave * 16384);
    const float* const* in = F.in;
    bf16* W_IN = (bf16*)(F.ws + WS_W_IN); bf16* W_OUT = (bf16*)(F.ws + WS_W_OUT); bf16* W_13 = (bf16*)(F.ws + WS_W_13); bf16* W_2 = (bf16*)(F.ws + WS_W_2);
    bf16* W_RKV = (bf16*)(F.ws + WS_W_RKV); bf16* W_L1 = (bf16*)(F.ws + WS_W_L1); bf16* W_L2 = (bf16*)(F.ws + WS_W_L2); bf16* W_G2 = (bf16*)(F.ws + WS_W_G2);
    bf16* W_O = (bf16*)(F.ws + WS_W_O);
    for (int prep_ = 0; prep_ < ((((PROBE_DUP) >> 21) & 1u) ? 2 : 1); ++prep_) {
        constexpr int B_IN = 16 * 56, B_OUT = 16 * 16, B_13 = 16 * 88, B_2 = 44 * 16, B_RKV = 256, B_O = 256;
        constexpr int NB_ITEMS = B_IN + B_OUT + B_13 + B_2 + 3 * B_RKV + B_O;
        for (int it = F.gw; it < NB_ITEMS; it += F.NGW) {
            int r = it;
            if (r < B_IN) { tr16_mat(in[8], 1024, INW, W_IN, 0, r, F.lane); continue; } r -= B_IN;
            if (r < B_OUT) { tr16_mat(in[15], 1024, 1024, W_OUT, 0, r, F.lane); continue; } r -= B_OUT;
            if (r < B_13) { tr16_mat(in[16], 1024, 2 * FFN_H, W_13, FFN_H, r, F.lane); continue; } r -= B_13;
            if (r < B_2) { tr16_mat(in[17], FFN_H, 1024, W_2, 0, r, F.lane); continue; } r -= B_2;
            if (r < 3 * B_RKV) { const int sx = r / B_RKV; tr16_mat(in[19] + (size_t)sx * 1024 * 1024, 1024, 1024, W_RKV + (size_t)sx * 1024 * 1024, 0, r % B_RKV, F.lane); continue; } r -= 3 * B_RKV;
            tr16_mat(in[33], 1024, 1024, W_O, 0, r, F.lane);
        }
    }
    moe_fill(F, F.bx, F.G, FILL_C, MOE_ITEMS);
    constexpr int I_W1 = 2 * 32, I_A1 = 2 * 32, I_G1 = 16 * 5, I_L2 = 4 * 32, I_G2 = 4 * 32;
    constexpr int NITEMS = I_W1 + I_A1 + I_G1 + I_L2 + I_G2;
    for (int it = F.gw; it < NITEMS; it += F.NGW) {
        int r = it;
        if (r < I_W1) { const int z = r / 32, rr = r % 32; tr_item(in[21] + (size_t)z * 1024 * 64, 64, 1024, 64 * (rr / 2), 32 * (rr % 2), W_L1, 1024, z * 64 + 32 * (rr % 2), 0, scr, F.lane); continue; } r -= I_W1;
        if (r < I_A1) { const int z = r / 32, rr = r % 32; tr_item(in[24] + (size_t)z * 1024 * 64, 64, 1024, 64 * (rr / 2), 32 * (rr % 2), W_L1 + 256 * 1024, 1024, z * 64 + 32 * (rr % 2), 0, scr, F.lane); continue; } r -= I_A1;
        if (r < I_G1) { tr_item(in[26], 160, 1024, 64 * (r / 5), 32 * (r % 5), W_L1 + 2 * 256 * 1024, 1024, 32 * (r % 5), 0, scr, F.lane); continue; } r -= I_G1;
        if (r < I_L2) { const int q = r / 32, nb = r % 32; const float* src = (q < 2 ? in[22] : in[25]) + (size_t)(q & 1) * 64 * 1024;
            for (int i = F.lane; i < 32 * 24; i += 64) { const int row = i / 24, ch = i % 24; const int col = 8 * ch + (8 * ch >= q * 64 ? 64 : 0);
                *(u32x4*)(W_L2 + (size_t)(q * 1024 + 32 * nb + row) * 256 + col) = (u32x4){0u, 0u, 0u, 0u}; }
            tr_item(src, 1024, 64, 0, 32 * nb, W_L2, 256, q * 1024 + 32 * nb, q * 64, scr, F.lane); continue; } r -= I_L2;
        tr_item(in[27], 1024, 160, 64 * (r / 32), 32 * (r % 32), W_G2, 256, 32 * (r % 32), 0, scr, F.lane);
    }
    { const int gt = F.bx * NTHR + F.tid, NT = F.G * NTHR;
      for (int i = gt; i < (128 + 128 + 96) * 128; i += NT) { int row = i / 128; const int ch = i % 128; int mat = 0;
          if (row >= 256) { mat = 2; row = row - 256 + 160; } else if (row >= 128) { mat = 1; } else { row += 128; }
          *(u32x4*)(W_L1 + ((size_t)mat * 256 + row) * 1024 + 8 * ch) = (u32x4){0u, 0u, 0u, 0u}; }
      f32x2* rope = (f32x2*)(F.ws + WS_ROPE);
      for (int i = gt; i < 2048; i += NT) { const int pos = i >> 5, j = i & 31; const float fr = powf(10000.f, -(float)j / 32.f), ang = (float)pos * fr; rope[i] = (f32x2){cosf(ang), sinf(ang)}; }
    }
    WG_SYNC();
    for (int prep_ = 0; prep_ < ((((PROBE_DUP) >> 23) & 1u) ? 2 : 1); ++prep_)
    for (int u = F.bx; u < 192; u += F.G) {
        const int li = u / 96, n0 = (u % 96) * 64;
        LAS float* sm = (LAS float*)F.lds;
        for (int idx = F.tid; idx < 9 * 1024; idx += NTHR) { const int r = idx >> 10, k = idx & 1023; const float cv = (r < 8) ? in[1][r * 1024 + k] : in[3][k]; sm[idx] = cv / (1.f + expf(-cv)); }
        WG_SYNC();
        const int ks = F.tid >> 4, cg4 = F.tid & 15;
        f32x4 acc[9];
#pragma unroll
        for (int r = 0; r < 9; ++r) acc[r] = (f32x4){0.f, 0.f, 0.f, 0.f};
        const float* w = in[4] + (size_t)li * 1024 * 6144 + n0 + 4 * cg4;
#pragma unroll 8
        for (int k = ks * 32; k < ks * 32 + 32; ++k) { const f32x4 wv = *(const f32x4*)(w + (size_t)k * 6144);
#pragma unroll
            for (int r = 0; r < 9; ++r) acc[r] += wv * sm[r * 1024 + k]; }
        LAS float* red = sm + 9 * 1024;
#pragma unroll
        for (int r = 0; r < 9; ++r) *(LAS f32x4*)(red + (ks * 9 + r) * 64 + 4 * cg4) = acc[r];
        WG_SYNC();
        float* MOD = (float*)(F.ws + WS_MOD);
        for (int idx = F.tid; idx < 9 * 64; idx += NTHR) { const int r = idx / 64, n2 = idx % 64; float s = 0.f;
#pragma unroll
            for (int q = 0; q < 32; ++q) s += red[(q * 9 + r) * 64 + n2];
            MOD[((size_t)li * 9 + r) * 6144 + n0 + n2] = s + in[5][li * 6144 + n0 + n2]; }
        WG_SYNC();
    }
}

DI void mod_rows(Fr& F, const float* xl, const float* xc, int nrows, const float* normw, const float* modl, int off_shift, int off_scale, bf16* H) {
    for (int g = F.gw; g < nrows / 4; g += F.NGW) {
        const int row0 = 4 * g;
        const float* src = row0 < ML ? xl + (size_t)row0 * D : xc + (size_t)(row0 - ML) * D;
        const float* mrow = modl + (size_t)(row0 < ML ? row0 / SEQ : 8) * 6144;
        f32x4 v[4][4];
#pragma unroll
        for (int r = 0; r < 4; ++r)
#pragma unroll
            for (int j = 0; j < 4; ++j) v[r][j] = ((const f32x4*)(src + (size_t)r * D))[F.lane + 64 * j];
        f32x4 gsc[4], gsh[4];
#pragma unroll
        for (int j = 0; j < 4; ++j) { const int c4 = F.lane + 64 * j; gsc[j] = ((const f32x4*)normw)[c4] * (((const f32x4*)(mrow + off_scale))[c4] + 1.f); gsh[j] = ((const f32x4*)(mrow + off_shift))[c4]; }
#pragma unroll
        for (int r = 0; r < 4; ++r) { float ss = 0.f;
#pragma unroll
            for (int j = 0; j < 4; ++j) ss += (v[r][j].x * v[r][j].x + v[r][j].y * v[r][j].y) + (v[r][j].z * v[r][j].z + v[r][j].w * v[r][j].w);
            const float rstd = rsqrtf(wave_sum_fast(ss) * (1.f / D) + 1e-6f);
            u32x2* o = (u32x2*)(H + (size_t)(row0 + r) * D);
#pragma unroll
            for (int j = 0; j < 4; ++j) { const f32x4 y = v[r][j] * rstd * gsc[j] + gsh[j]; u32x2 p; p.x = pk2(y.x, y.y); p.y = pk2(y.z, y.w); o[F.lane + 64 * j] = p; } }
    }
}

DI void load_rope_pair(const bf16* rowp, int hh, int jj, bool lat, int rpos, int cpos, const f32x2* rope, float scl, float (&x1)[8], float (&x2)[8]) {
    const u32x4 a = *(const u32x4*)(rowp + hh * 64 + jj), b = *(const u32x4*)(rowp + hh * 64 + jj + 32);
    const unsigned aw[4] = {a.x, a.y, a.z, a.w}, bw[4] = {b.x, b.y, b.z, b.w};
#pragma unroll
    for (int i = 0; i < 4; ++i) { x1[2 * i] = bflo(aw[i]); x1[2 * i + 1] = bfhi(aw[i]); x2[2 * i] = bflo(bw[i]); x2[2 * i + 1] = bfhi(bw[i]); }
    if (lat) { const int pos = hh ? cpos : rpos;
#pragma unroll
        for (int i = 0; i < 8; ++i) { const f32x2 cs = rope[pos * 32 + jj + i]; const float y1 = x1[i] * cs.x - x2[i] * cs.y, y2 = x1[i] * cs.y + x2[i] * cs.x; x1[i] = y1; x2[i] = y2; } }
#pragma unroll
    for (int i = 0; i < 8; ++i) { x1[i] *= scl; x2[i] *= scl; }
}
DI u32x4 pack8(const float (&x)[8], float s) { u32x4 o; o.x = pk2(x[0] * s, x[1] * s); o.y = pk2(x[2] * s, x[3] * s); o.z = pk2(x[4] * s, x[5] * s); o.w = pk2(x[6] * s, x[7] * s); return o; }
constexpr int RLD = 136;
constexpr int RTILE = 128 * RLD * 2;
DI int ret_row0(int b, int id) { return id < 2 ? ML + b * CTXL + id * 128 : b * SEQ + (id - 2) * 128; }

DI void ret_kv_phase(Fr& F) {
    const bf16* QKV = (const bf16*)(F.ws + WS_QKV); float* KV = (float*)(F.ws + WS_KV); const f32x2* rope = (const f32x2*)(F.ws + WS_ROPE);
    LAS bf16* Vs = (LAS bf16*)F.lds; LAS bf16* Kf = (LAS bf16*)(F.lds + RTILE); LAS bf16* Kb = (LAS bf16*)(F.lds + 2 * RTILE);
    const int wr2 = F.wave >> 1, wc2 = F.wave & 1, fr = F.lane & 15, fq = F.lane >> 4;
    for (int u = F.bx; u < NB * 4 * NCH; u += F.G) {
        const int b = u / (4 * NCH), h = (u / NCH) % 4, id = u % NCH; const int grow0 = ret_row0(b, id); const bool lat = id >= 2;
        const float lgf = -expf(F.in[9][h]), lgb = -expf(F.in[10][h]);
        for (int it = F.tid; it < 128 * 16; it += NTHR) { const int c = it >> 4, ch = it & 15;
            *(LAS u32x4*)(Vs + c * RLD + 8 * ch) = *(const u32x4*)(QKV + (size_t)(grow0 + c) * INW + 1024 + h * 128 + 8 * ch); }
        for (int it = F.tid; it < 128 * 8; it += NTHR) { const int c = it >> 3, pi = it & 7, hh = pi >> 2, jj = (pi & 3) * 8; const int t = (id - 2) * 128 + c;
            float x1[8], x2[8]; load_rope_pair(QKV + (size_t)(grow0 + c) * INW + 512 + h * 128, hh, jj, lat, t >> 6, t & 63, rope, 0.08838834764831845f, x1, x2);
            const float wf = __expf(lgf * (float)(127 - c)), wb = __expf(lgb * (float)c);
            *(LAS u32x4*)(Kf + c * RLD + hh * 64 + jj) = pack8(x1, wf); *(LAS u32x4*)(Kf + c * RLD + hh * 64 + jj + 32) = pack8(x2, wf);
            *(LAS u32x4*)(Kb + c * RLD + hh * 64 + jj) = pack8(x1, wb); *(LAS u32x4*)(Kb + c * RLD + hh * 64 + jj + 32) = pack8(x2, wb); }
        LDS_BARRIER();
#pragma unroll
        for (int dir = 0; dir < 2; ++dir) {
            const LAS bf16* Kd = dir ? Kb : Kf;
            f32x4 acc[2][4];
#pragma unroll
            for (int i = 0; i < 2; ++i)
#pragma unroll
                for (int j = 0; j < 4; ++j) acc[i][j] = (f32x4){0.f, 0.f, 0.f, 0.f};
#pragma unroll 1
            for (int k0 = 0; k0 < 128; k0 += 32) { bf16x8 af[2], bfg[4];
#pragma unroll
                for (int i = 0; i < 2; ++i) af[i] = frag_kr(Vs, RLD, 32 * wr2 + 16 * i, k0, F.lane);
#pragma unroll
                for (int j = 0; j < 4; ++j) bfg[j] = frag_kr(Kd, RLD, 64 * wc2 + 16 * j, k0, F.lane);
#pragma unroll
                for (int i = 0; i < 2; ++i)
#pragma unroll
                    for (int j = 0; j < 4; ++j) acc[i][j] = mma(acc[i][j], bfg[j], af[i]); }
            float* o = KV + ((size_t)((b * 4 + h) * 2 + dir) * NCH + id) * 16384;
#pragma unroll
            for (int i = 0; i < 2; ++i)
#pragma unroll
                for (int j = 0; j < 4; ++j) *(f32x4*)(o + (32 * wr2 + 16 * i + fr) * 128 + 64 * wc2 + 16 * j + 4 * fq) = acc[i][j];
        }
        LDS_BARRIER();
    }
}
DI void ret_prefix_phase(Fr& F) {
    const float* KV = (const float*)(F.ws + WS_KV); bf16* SP = (bf16*)(F.ws + WS_SPREV);
    const int gt = F.bx * NTHR + F.tid, NT = F.G * NTHR;
    for (int i = gt; i < 64 * 4096; i += NT) { const int bhd = i >> 12, e4 = i & 4095, dir = bhd & 1, h = (bhd >> 1) & 3;
        const float lg = -expf(dir ? F.in[10][h] : F.in[9][h]), cd = expf(lg * 128.f);
        f32x4 s = (f32x4){0.f, 0.f, 0.f, 0.f};
        for (int st = 0; st < NCH; ++st) { const int id = dir ? (st == 0 ? 1 : (st == 1 ? 0 : 19 - st)) : st;
            const size_t off = ((size_t)bhd * NCH + id) * 16384 + 4 * e4;
            u32x2 p; p.x = pk2(s.x, s.y); p.y = pk2(s.z, s.w); *(u32x2*)(SP + off) = p;
            s = s * cd + *(const f32x4*)(KV + off); }
    }
}
DI void ret_out_phase(Fr& F) {
    const bf16* QKV = (const bf16*)(F.ws + WS_QKV); const bf16* SP = (const bf16*)(F.ws + WS_SPREV); bf16* MIX = (bf16*)(F.ws + WS_MIX); const f32x2* rope = (const f32x2*)(F.ws + WS_ROPE);
    LAS bf16* Qs = (LAS bf16*)F.lds; LAS bf16* KP = (LAS bf16*)(F.lds + RTILE); LAS bf16* Vs = (LAS bf16*)(F.lds + 2 * RTILE); LAS bf16* Sf = (LAS bf16*)(F.lds + 3 * RTILE);
    LAS float* red = (LAS float*)(F.lds + 4 * RTILE);
    const int wr2 = F.wave >> 1, wc2 = F.wave & 1, fr = F.lane & 15, fq = F.lane >> 4;
    for (int u = F.bx; u < NB * 4 * NCH; u += F.G) {
        const int b = u / (4 * NCH), h = (u / NCH) % 4, id = u % NCH; const int grow0 = ret_row0(b, id); const bool lat = id >= 2;
        const float lgf = -expf(F.in[9][h]), lgb = -expf(F.in[10][h]);
        const bf16* spf = SP + ((size_t)((b * 4 + h) * 2 + 0) * NCH + id) * 16384; const bf16* spb = SP + ((size_t)((b * 4 + h) * 2 + 1) * NCH + id) * 16384;
        for (int it = F.tid; it < 128 * 16; it += NTHR) { const int c = it >> 4, ch = it & 15;
            *(LAS u32x4*)(Vs + c * RLD + 8 * ch) = *(const u32x4*)(QKV + (size_t)(grow0 + c) * INW + 1024 + h * 128 + 8 * ch);
            *(LAS u32x4*)(Sf + c * RLD + 8 * ch) = *(const u32x4*)(spf + c * 128 + 8 * ch); }
        for (int it = F.tid; it < 128 * 8; it += NTHR) { const int c = it >> 3, pi = it & 7, hh = pi >> 2, jj = (pi & 3) * 8; const int t = (id - 2) * 128 + c;
            float x1[8], x2[8];
            load_rope_pair(QKV + (size_t)(grow0 + c) * INW + h * 128, hh, jj, lat, t >> 6, t & 63, rope, 1.f, x1, x2);
            *(LAS u32x4*)(Qs + c * RLD + hh * 64 + jj) = pack8(x1, 1.f); *(LAS u32x4*)(Qs + c * RLD + hh * 64 + jj + 32) = pack8(x2, 1.f);
            load_rope_pair(QKV + (size_t)(grow0 + c) * INW + 512 + h * 128, hh, jj, lat, t >> 6, t & 63, rope, 0.08838834764831845f, x1, x2);
            *(LAS u32x4*)(KP + c * RLD + hh * 64 + jj) = pack8(x1, 1.f); *(LAS u32x4*)(KP + c * RLD + hh * 64 + jj + 32) = pack8(x2, 1.f); }
        LDS_BARRIER();
        f32x4 sacc[2][4], facc[2][4];
#pragma unroll
        for (int i = 0; i < 2; ++i)
#pragma unroll
            for (int j = 0; j < 4; ++j) { sacc[i][j] = (f32x4){0.f, 0.f, 0.f, 0.f}; facc[i][j] = (f32x4){0.f, 0.f, 0.f, 0.f}; }
#pragma unroll 1
        for (int k0 = 0; k0 < 128; k0 += 32) { bf16x8 af[2], bk[4], bs[4];
#pragma unroll
            for (int i = 0; i < 2; ++i) af[i] = frag_kc(Qs, RLD, 32 * wr2 + 16 * i, k0, F.lane);
#pragma unroll
            for (int j = 0; j < 4; ++j) { bk[j] = frag_kc(KP, RLD, 64 * wc2 + 16 * j, k0, F.lane); bs[j] = frag_kc(Sf, RLD, 64 * wc2 + 16 * j, k0, F.lane); }
#pragma unroll
            for (int i = 0; i < 2; ++i)
#pragma unroll
                for (int j = 0; j < 4; ++j) { sacc[i][j] = mma(sacc[i][j], bk[j], af[i]); facc[i][j] = mma(facc[i][j], bs[j], af[i]); } }
        LDS_BARRIER();
        { const float lf2 = lgf * 1.4426950408889634f, lb2 = lgb * 1.4426950408889634f;
#pragma unroll
          for (int i = 0; i < 2; ++i)
#pragma unroll
            for (int j = 0; j < 4; ++j) { const int c = 32 * wr2 + 16 * i + fr, s0 = 64 * wc2 + 16 * j + 4 * fq; float pv[4];
#pragma unroll
                for (int r = 0; r < 4; ++r) { const int df = c - (s0 + r); const float wgt = df > 0 ? exp2f(lf2 * (float)df) : (df < 0 ? exp2f(lb2 * (float)(-df)) : 2.f); pv[r] = sacc[i][j][r] * wgt; }
                u32x2 p; p.x = pk2(pv[0], pv[1]); p.y = pk2(pv[2], pv[3]); *(LAS u32x2*)(KP + c * RLD + s0) = p; }
          for (int it = F.tid; it < 128 * 16; it += NTHR) { const int c = it >> 4, ch = it & 15; *(LAS u32x4*)(Sf + c * RLD + 8 * ch) = *(const u32x4*)(spb + c * 128 + 8 * ch); }
        }
        LDS_BARRIER();
        f32x4 oacc[2][4], bacc[2][4];
#pragma unroll
        for (int i = 0; i < 2; ++i) { const float qdf = __expf(lgf * (float)(32 * wr2 + 16 * i + fr + 1));
#pragma unroll
            for (int j = 0; j < 4; ++j) { oacc[i][j] = facc[i][j] * qdf; bacc[i][j] = (f32x4){0.f, 0.f, 0.f, 0.f}; } }
#pragma unroll 1
        for (int k0 = 0; k0 < 128; k0 += 32) { bf16x8 ap[2], aq[2], bv[4], bs[4];
#pragma unroll
            for (int i = 0; i < 2; ++i) { ap[i] = frag_kc(KP, RLD, 32 * wr2 + 16 * i, k0, F.lane); aq[i] = frag_kc(Qs, RLD, 32 * wr2 + 16 * i, k0, F.lane); }
#pragma unroll
            for (int j = 0; j < 4; ++j) { bv[j] = frag_kr(Vs, RLD, 64 * wc2 + 16 * j, k0, F.lane); bs[j] = frag_kc(Sf, RLD, 64 * wc2 + 16 * j, k0, F.lane); }
#pragma unroll
            for (int i = 0; i < 2; ++i)
#pragma unroll
                for (int j = 0; j < 4; ++j) { oacc[i][j] = mma(oacc[i][j], bv[j], ap[i]); bacc[i][j] = mma(bacc[i][j], bs[j], aq[i]); } }
        float rs[2], rq[2];
#pragma unroll
        for (int i = 0; i < 2; ++i) { const int c = 32 * wr2 + 16 * i + fr; const float qdb = __expf(lgb * (float)(128 - c)); float s = 0.f, q = 0.f;
#pragma unroll
            for (int j = 0; j < 4; ++j) { oacc[i][j] = oacc[i][j] + bacc[i][j] * qdb;
#pragma unroll
                for (int r = 0; r < 4; ++r) { s += oacc[i][j][r]; q += oacc[i][j][r] * oacc[i][j][r]; } }
            s += __shfl_xor(s, 16); s += __shfl_xor(s, 32); q += __shfl_xor(q, 16); q += __shfl_xor(q, 32);
            if (fq == 0) { red[(c * 2 + wc2) * 2 + 0] = s; red[(c * 2 + wc2) * 2 + 1] = q; }
            rs[i] = s; rq[i] = q; }
        LDS_BARRIER();
#pragma unroll
        for (int i = 0; i < 2; ++i) { const int c = 32 * wr2 + 16 * i + fr;
            const float s = red[(c * 2 + 0) * 2 + 0] + red[(c * 2 + 1) * 2 + 0], q = red[(c * 2 + 0) * 2 + 1] + red[(c * 2 + 1) * 2 + 1];
            const float mean = s * (1.f / 128.f), var = fmaxf(q * (1.f / 128.f) - mean * mean, 0.f), rstd = rsqrtf(var + 1e-5f);
            const size_t grow = (size_t)(grow0 + c);
#pragma unroll
            for (int j = 0; j < 4; ++j) { const int e0 = 64 * wc2 + 16 * j + 4 * fq;
                const f32x4 gw = *(const f32x4*)(F.in[11] + h * 128 + e0); const u32x2 gg = *(const u32x2*)(QKV + grow * INW + 1536 + h * 128 + e0);
                const float g0 = bflo(gg.x), g1 = bfhi(gg.x), g2 = bflo(gg.y), g3 = bfhi(gg.y);
                const f32x4 y = (oacc[i][j] - mean) * rstd * gw;
                u32x2 p; p.x = pk2(y.x * siluf_(g0), y.y * siluf_(g1)); p.y = pk2(y.z * siluf_(g2), y.w * siluf_(g3));
                *(u32x2*)(MIX + grow * D + h * 128 + e0) = p; } }
        (void)rs; (void)rq;
        LDS_BARRIER();
    }
}

DI void na_norm_rows(Fr& F) {
    const bf16* QKV = (const bf16*)(F.ws + WS_QKV); bf16* NQ = (bf16*)(F.ws + WS_NQ); bf16* NK = (bf16*)(F.ws + WS_NK); bf16* NV = (bf16*)(F.ws + WS_NV);
    const bool isk = F.lane >= 32; const float* wsrc = (isk ? F.in[13] : F.in[12]) + (F.lane & 3) * 16; const float scl = isk ? 1.f : 0.125f;
    const int head = (F.lane & 31) >> 2, j0 = (F.lane & 3) * 16;
    float wv[16];
#pragma unroll
    for (int i = 0; i < 16; ++i) wv[i] = wsrc[i] * scl;
    for (int row = F.gw; row < MA; row += F.NGW) {
        const bool lat = row < ML; const int b = lat ? row / SEQ : (row - ML) / CTXL, sr = lat ? CTXL + row % SEQ : (row - ML) % CTXL;
        const size_t ho = ((size_t)(b * 8 + head) * (SEQ + CTXL) + sr) * 64 + j0;
        const bf16* p = QKV + (size_t)row * INW + 2048 + 16 * F.lane;
        const u32x4 a = *(const u32x4*)p, b2 = *(const u32x4*)(p + 8); const unsigned w[8] = {a.x, a.y, a.z, a.w, b2.x, b2.y, b2.z, b2.w}; float x[16]; float ss = 0.f;
#pragma unroll
        for (int i = 0; i < 8; ++i) { x[2 * i] = bflo(w[i]); x[2 * i + 1] = bfhi(w[i]); ss += x[2 * i] * x[2 * i] + x[2 * i + 1] * x[2 * i + 1]; }
        const float rinv = rsqrtf(red4(ss) * (1.f / 64.f) + 1e-6f);
        u32x4 o0, o1;
        o0.x = pk2(x[0] * rinv * wv[0], x[1] * rinv * wv[1]); o0.y = pk2(x[2] * rinv * wv[2], x[3] * rinv * wv[3]); o0.z = pk2(x[4] * rinv * wv[4], x[5] * rinv * wv[5]); o0.w = pk2(x[6] * rinv * wv[6], x[7] * rinv * wv[7]);
        o1.x = pk2(x[8] * rinv * wv[8], x[9] * rinv * wv[9]); o1.y = pk2(x[10] * rinv * wv[10], x[11] * rinv * wv[11]); o1.z = pk2(x[12] * rinv * wv[12], x[13] * rinv * wv[13]); o1.w = pk2(x[14] * rinv * wv[14], x[15] * rinv * wv[15]);
        bf16* d = (isk ? NK : NQ) + ho; *(u32x4*)d = o0; *(u32x4*)(d + 8) = o1;
        if (!isk) { const bf16* pv = QKV + (size_t)row * INW + 3072 + 16 * F.lane; const u32x4 v0 = *(const u32x4*)pv, v1 = *(const u32x4*)(pv + 8); *(u32x4*)(NV + ho) = v0; *(u32x4*)(NV + ho + 8) = v1; }
    }
}
constexpr int NLD = 72;
DI void na_phase(Fr& F) {
    const bf16* NQ = (const bf16*)(F.ws + WS_NQ); const bf16* NK = (const bf16*)(F.ws + WS_NK); const bf16* NV = (const bf16*)(F.ws + WS_NV); bf16* MIX = (bf16*)(F.ws + WS_MIX);
    LAS bf16* Ks = (LAS bf16*)F.lds;
    LAS bf16* Vs = (LAS bf16*)(F.lds + 36864);
    LAS bf16* Pw = (LAS bf16*)(F.lds + 2 * 36864) + F.wave * (32 * NLD);
    LAS float* rpbs = (LAS float*)(F.lds + 2 * 36864 + 8 * 4608);
    const int fr = F.lane & 15, fq = F.lane >> 4;
    float bound;
    { float mqw = fabsf(F.in[12][F.lane]), mkw = fabsf(F.in[13][F.lane]), mb = 0.f;
      for (int i = F.lane; i < 8 * 15 * 31; i += 64) mb = fmaxf(mb, fabsf(F.in[14][i]));
      bound = 8.f * wave_max(mqw) * wave_max(mkw) + wave_max(mb); }
    for (int u = F.bx; u < 512 + 64; u += F.G) {
        int b, head, r = -1, cb = 0, qtok0, kb_lo = 0, nwin = 0;
        if (u < 512) { const int bh = ((u >> 6) << 3) + (u & 7), qb = (u >> 3) & 7; b = bh >> 3; head = bh & 7;
            r = 4 * qb + (F.wave >> 1); cb = 32 * (F.wave & 1); qtok0 = b * SEQ + r * 64 + cb;
            const int r0lo = min(max(4 * qb - 4, 0), 24), r0hi = min(max(4 * qb - 1, 0), 24); kb_lo = r0lo >> 2; nwin = ((r0hi + 7) >> 2) - kb_lo + 1; }
        else { const int cu = u - 512; b = cu >> 3; head = cu & 7; qtok0 = ML + b * CTXL + 32 * F.wave; }
        const int r0 = min(max(r - 4, 0), 24);
        const size_t hb = (size_t)(b * 8 + head) * (SEQ + CTXL); const int qseq = u < 512 ? CTXL + r * 64 + cb : 32 * F.wave;
        bf16x8 aq[2][2];
#pragma unroll
        for (int mt = 0; mt < 2; ++mt)
#pragma unroll
            for (int ks = 0; ks < 2; ++ks) aq[mt][ks] = *(const bf16x8*)(NQ + (hb + qseq + 16 * mt + fr) * 64 + 32 * ks + 8 * fq);
        if (u < 512) for (int i = F.tid; i < 15 * 32; i += NTHR) { const int ro = i >> 5, co = i & 31; rpbs[i] = co < 31 ? F.in[14][head * 465 + ro * 31 + co] - bound : -1.0e30f; }
        int boff[2][4][4]; int nlo[2], nhi[2];
#pragma unroll
        for (int mt = 0; mt < 2; ++mt) { const int cs = cb + 16 * mt, c = cs + fr, c0 = min(max(c - 8, 0), 48);
            nlo[mt] = max(cs - 8, 0) >> 4; nhi[mt] = (min(cs + 7, 48) + 15) >> 4;
#pragma unroll
            for (int nt = 0; nt < 4; ++nt)
#pragma unroll
                for (int i = 0; i < 4; ++i) { const int kc = 16 * nt + 4 * fq + i; boff[mt][nt][i] = ((kc >= c0) && (kc < c0 + 16)) ? (kc - c + 15) : 31; } }
        f32x4 oacc[2][4]; float lsum[2] = {0.f, 0.f};
#pragma unroll
        for (int mt = 0; mt < 2; ++mt)
#pragma unroll
            for (int j = 0; j < 4; ++j) oacc[mt][j] = (f32x4){0.f, 0.f, 0.f, 0.f};
        u32x4 kst[4], vst[4];
#define NA_LOAD(bi_) do { const int kbase_ = (bi_) < nwin ? CTXL + 256 * (kb_lo + (bi_)) : 0; _Pragma("unroll") for (int it_ = 0; it_ < 4; ++it_) { const size_t o_ = (hb + kbase_ + (F.tid >> 3) + 64 * it_) * 64 + 8 * (F.tid & 7); \
            kst[it_] = *(const u32x4*)(NK + o_); vst[it_] = *(const u32x4*)(NV + o_); } } while (0)
        NA_LOAD(0);
        for (int bi = 0; bi <= nwin; ++bi) {
            const bool is_ctx = bi == nwin;
#pragma unroll
            for (int it = 0; it < 4; ++it) { const int krow = (F.tid >> 3) + 64 * it, c8 = F.tid & 7;
                *(LAS u32x4*)(Ks + krow * NLD + 8 * c8) = kst[it]; *(LAS u32x4*)(Vs + krow * NLD + 8 * c8) = vst[it]; }
            LDS_BARRIER();
            if (bi < nwin) NA_LOAD(bi + 1);
            if ((((PROBE_DUP) >> 30) & 1u) && bi < nwin) { asm volatile("" ::: "memory"); NA_LOAD(bi + 1); }
            f32x4 osv[2][4]; float lsv[2];
#pragma unroll
            for (int mt = 0; mt < 2; ++mt) { lsv[mt] = lsum[mt];
#pragma unroll
                for (int j = 0; j < 4; ++j) osv[mt][j] = oacc[mt][j]; }
            for (int pdc_ = 0; pdc_ < ((((PROBE_DUP) >> 31) & 1u) ? 2 : 1); ++pdc_) {
            if (pdc_ == 1) {
#pragma unroll
                for (int mt = 0; mt < 2; ++mt) { lsum[mt] = lsv[mt];
#pragma unroll
                    for (int j = 0; j < 4; ++j) oacc[mt][j] = osv[mt][j]; } }
#pragma unroll 1
            for (int krl = 0; krl < 4; ++krl) {
                const int kr = 4 * (kb_lo + bi) + krl;
                if (!is_ctx && (kr < r0 || kr > r0 + 7)) continue;
                f32x4 sacc[2][4];
#pragma unroll
                for (int mt = 0; mt < 2; ++mt)
#pragma unroll
                    for (int nt = 0; nt < 4; ++nt) sacc[mt][nt] = (f32x4){0.f, 0.f, 0.f, 0.f};
                const int n0w = is_ctx ? 0 : nlo[0], n1w = is_ctx ? 3 : nhi[1];
#pragma unroll
                for (int nt = 0; nt < 4; ++nt) { if (nt < n0w || nt > n1w) continue;
                    const bool u0 = is_ctx || (nt >= nlo[0] && nt <= nhi[0]), u1 = is_ctx || (nt >= nlo[1] && nt <= nhi[1]);
#pragma unroll
                    for (int ks = 0; ks < 2; ++ks) { const bf16x8 bk = frag_kc(Ks, NLD, 64 * krl + 16 * nt, 32 * ks, F.lane);
                        if (u0) sacc[0][nt] = mma(sacc[0][nt], bk, aq[0][ks]); if (u1) sacc[1][nt] = mma(sacc[1][nt], bk, aq[1][ks]); } }
                const int rowb = is_ctx ? 0 : (kr - r + 7) * 32;
#pragma unroll
                for (int mt = 0; mt < 2; ++mt) {
#pragma unroll
                    for (int nt = 0; nt < 4; ++nt) { float pv[4] = {0.f, 0.f, 0.f, 0.f};
                        if (is_ctx) {
#pragma unroll
                            for (int i = 0; i < 4; ++i) { pv[i] = __expf(sacc[mt][nt][i] - bound); lsum[mt] += pv[i]; } }
                        else if (nt >= nlo[mt] && nt <= nhi[mt]) {
#pragma unroll
                            for (int i = 0; i < 4; ++i) { pv[i] = __expf(sacc[mt][nt][i] + rpbs[rowb + boff[mt][nt][i]]); lsum[mt] += pv[i]; } }
                        u32x2 pk; pk.x = pk2(pv[0], pv[1]); pk.y = pk2(pv[2], pv[3]); *(LAS u32x2*)(Pw + (16 * mt + fr) * NLD + 16 * nt + 4 * fq) = pk; } }
                LDS_WAIT();
#pragma unroll
                for (int ks2 = 0; ks2 < 2; ++ks2) {
                    const bool v0 = is_ctx || (2 * ks2 + 1 >= nlo[0] && 2 * ks2 <= nhi[0]), v1 = is_ctx || (2 * ks2 + 1 >= nlo[1] && 2 * ks2 <= nhi[1]);
                    if (!(v0 || v1)) continue;
                    const bf16x8 ap0 = frag_kc(Pw, NLD, 0, 32 * ks2, F.lane), ap1 = frag_kc(Pw, NLD, 16, 32 * ks2, F.lane);
#pragma unroll
                    for (int et = 0; et < 4; ++et) { const bf16x8 bv = frag_kr(Vs, NLD, 16 * et, 64 * krl + 32 * ks2, F.lane);
                        if (v0) oacc[0][et] = mma(oacc[0][et], bv, ap0); if (v1) oacc[1][et] = mma(oacc[1][et], bv, ap1); } }
            }
            }
            LDS_BARRIER();
        }
#undef NA_LOAD
#pragma unroll
        for (int mt = 0; mt < 2; ++mt) { float l = lsum[mt]; l += __shfl_xor(l, 16); l += __shfl_xor(l, 32); const float inv = 1.f / l;
#pragma unroll
            for (int et = 0; et < 4; ++et) { const f32x4 o = oacc[mt][et] * inv; u32x2 p; p.x = pk2(o.x, o.y); p.y = pk2(o.z, o.w);
                *(u32x2*)(MIX + (size_t)(qtok0 + 16 * mt + fr) * D + 512 + head * 64 + 16 * et + 4 * fq) = p; } }
    }
}

DI void xm_phase(Fr& F, const float* xl, const float* xc, const float* normw, const float* modl) {
    bf16* XM = (bf16*)(F.ws + WS_XM); const float* mu = F.in[18];
    for (int g = F.gw; g < MA / 4; g += F.NGW) {
        const int row0 = 4 * g; const bool lat = row0 < ML; const int rr0 = lat ? row0 : row0 - ML; const int L = lat ? SEQ : CTXL; const int t0 = rr0 % L;
        const float* src = (lat ? xl : xc) + (size_t)rr0 * D;
        const float* mrow = modl + (size_t)(lat ? row0 / SEQ : 8) * 6144;
        const bool hp = t0 > 0, hn = t0 + 4 < L;
        f32x4 v[6][4]; float rs[6];
#pragma unroll
        for (int r = 0; r < 6; ++r) { const bool ok = (r == 0) ? hp : (r == 5 ? hn : true);
#pragma unroll
            for (int j = 0; j < 4; ++j) v[r][j] = ok ? ((const f32x4*)(src + (size_t)(r - 1) * D))[F.lane + 64 * j] : (f32x4){0.f, 0.f, 0.f, 0.f}; }
#pragma unroll
        for (int r = 0; r < 6; ++r) { float ss = 0.f;
#pragma unroll
            for (int j = 0; j < 4; ++j) ss += (v[r][j].x * v[r][j].x + v[r][j].y * v[r][j].y) + (v[r][j].z * v[r][j].z + v[r][j].w * v[r][j].w);
            rs[r] = rsqrtf(wave_sum_fast(ss) * (1.f / D) + 1e-6f); }
#pragma unroll
        for (int j = 0; j < 4; ++j) { const int c4 = F.lane + 64 * j;
            const f32x4 gg = ((const f32x4*)normw)[c4] * (((const f32x4*)(mrow + 1024))[c4] + 1.f), sh = ((const f32x4*)mrow)[c4];
            f32x4 h[6];
#pragma unroll
            for (int r = 0; r < 6; ++r) { const bool ok = (r == 0) ? hp : (r == 5 ? hn : true); h[r] = ok ? v[r][j] * rs[r] * gg + sh : (f32x4){0.f, 0.f, 0.f, 0.f}; }
            f32x4 m[6];
#pragma unroll
            for (int sx = 0; sx < 6; ++sx) m[sx] = ((const f32x4*)(mu + sx * 1024))[c4];
#pragma unroll
            for (int r = 0; r < 4; ++r) { const f32x4 hc = h[r + 1], xx = (h[r] + h[r + 2]) * 0.5f - hc;
#pragma unroll
                for (int sx = 0; sx < 6; ++sx) { const f32x4 y = hc + xx * m[sx];
                    u32x2 p; p.x = pk2(y.x, y.y); p.y = pk2(y.z, y.w); ((u32x2*)(XM + ((size_t)sx * MA + row0 + r) * D))[c4] = p; } } }
    }
}

DI f32x4 mma16(f32x4 acc, s16x4 bfrag, s16x4 afrag) { return __builtin_amdgcn_mfma_f32_16x16x16bf16_1k(bfrag, afrag, acc, 0, 0, 0); }
DI s16x4 frag16_kc(const LAS bf16* base, int ld, int row0, int k0, int lane) { return *(const LAS s16x4*)(base + (row0 + (lane & 15)) * ld + k0 + 4 * (lane >> 4)); }
DI s16x4 frag16_kr(const LAS bf16* base, int ld, int x0, int k0, int lane) { const int g = lane >> 4, q = (lane & 15) >> 2, p = lane & 3;
    return __builtin_amdgcn_ds_read_tr16_b64_v4i16((LAS s16x4*)(base + (k0 + 4 * g + q) * ld + x0 + 4 * p)); }
DI s16x4 cvt4(f32x4 v) { u32x2 p; p.x = pk2(v.x, v.y); p.y = pk2(v.z, v.w); return __builtin_bit_cast(s16x4, p); }
constexpr int WLD = 72;
DI void rwkv_scan2_phase(Fr& F) {
    const bf16* KB = (const bf16*)(F.ws + WS_KB); const bf16* VB = (const bf16*)(F.ws + WS_VB); const bf16* RB = (const bf16*)(F.ws + WS_RB);
    const bf16* LW = (const bf16*)(F.ws + WS_DEC); const bf16* AG = (const bf16*)(F.ws + WS_AG);
    LAS bf16* AT = (LAS bf16*)F.lds; LAS bf16* BT = AT + 64 * WLD; LAS bf16* KT = BT + 64 * WLD; LAS bf16* RT = KT + 64 * WLD; LAS bf16* BH = RT + 64 * WLD; LAS bf16* KH = BH + 64 * WLD;
    LAS bf16* VN = KH + 64 * WLD; LAS bf16* W1s = VN + 64 * WLD;
    LAS bf16* PRB = W1s + 64 * WLD; LAS bf16* PRK = PRB + 1024;
    LAS f32x4* UVT = (LAS f32x4*)(PRK + 1024);
    LAS float* GC = (LAS float*)(UVT + 1024);
    LAS float* CSs = GC + 256;
    LAS float* YS = CSs + 4096;
    const int cq = F.wave >> 1, half = F.wave & 1, fr = F.lane & 15, fq = F.lane >> 4;
    for (int u = F.bx; u < 256; u += F.G) {
        const int z = u & 1, h = (u >> 1) & 15, b = u >> 5;
        bf16* Y = (bf16*)(F.ws + (z ? WS_YB : WS_YF));
        const int sx = F.lane >> 3, cg = F.lane & 7;
        float kkw[8], kaw[8], rkw[8];
#pragma unroll
        for (int i = 0; i < 8; ++i) { kkw[i] = F.in[28][h * 64 + 8 * cg + i]; kaw[i] = F.in[29][h * 64 + 8 * cg + i]; rkw[i] = F.in[30][h * 64 + 8 * cg + i]; }
        float* coef = (float*)(F.ws + WS_COEF) + ((size_t)z * 128 + b * 16 + h) * SEQ;
        const size_t bh = (size_t)(b * 16 + h);
        const bf16* kbh = KB + bh * (SEQ + CTXL) * 64 + 8 * cg; const bf16* vbh = VB + bh * (SEQ + CTXL) * 64 + 8 * cg; const bf16* rbh = RB + bh * SEQ * 64 + 8 * cg;
        const bf16* agh = AG + ((size_t)z * 128 + bh) * (SEQ + CTXL) * 64 + 8 * cg; const bf16* lwh = LW + ((size_t)z * 128 + bh) * (SEQ + CTXL) * 64 + 8 * cg;
        f32x4 S[4];
#pragma unroll
        for (int j = 0; j < 4; ++j) S[j] = (f32x4){0.f, 0.f, 0.f, 0.f};
        u32x4 kreg, vreg, rreg, areg, lreg;
        const int stl = 16 * cq + 8 * half + sx;
#define RW_LOAD(sc) do { const int g_ = (sc) * 64 + stl; const bool lat_ = g_ >= CTXL; const int row_ = z ? (lat_ ? (2 * CTXL + SEQ - 1 - g_) : (CTXL - 1 - g_)) : g_; \
            kreg = *(const u32x4*)(kbh + (size_t)row_ * 64); vreg = *(const u32x4*)(vbh + (size_t)row_ * 64); areg = *(const u32x4*)(agh + (size_t)row_ * 64); \
            rreg = lat_ ? *(const u32x4*)(rbh + (size_t)(row_ - CTXL) * 64) : (u32x4){0u, 0u, 0u, 0u}; \
            lreg = *(const u32x4*)(lwh + (size_t)row_ * 64); } while (0)
        RW_LOAD(0);
        for (int sc = 0; sc < (SEQ + CTXL) / 64; ++sc) {
            const bool lat = sc * 64 >= CTXL;
            *(LAS f32x4*)(CSs + stl * 64 + 8 * cg) = (f32x4){bflo(lreg.x), bfhi(lreg.x), bflo(lreg.y), bfhi(lreg.y)}; *(LAS f32x4*)(CSs + stl * 64 + 8 * cg + 4) = (f32x4){bflo(lreg.z), bfhi(lreg.z), bflo(lreg.w), bfhi(lreg.w)};
            LDS_BARRIER();
            if (F.tid < 256) { const int q = F.tid >> 6, c = F.tid & 63; float v[16];
#pragma unroll
                for (int t = 0; t < 16; ++t) v[t] = CSs[(16 * q + t) * 64 + c];
                float acc = 0.f;
#pragma unroll
                for (int t = 0; t < 16; ++t) { acc += v[t]; CSs[(16 * q + t) * 64 + c] = acc; } }
            LDS_BARRIER();
            { const int tau = 8 * half + sx;
              const f32x4 c0 = *(const LAS f32x4*)(CSs + stl * 64 + 8 * cg), c1 = *(const LAS f32x4*)(CSs + stl * 64 + 8 * cg + 4);
              f32x4 p0 = (f32x4){0.f, 0.f, 0.f, 0.f}, p1 = p0;
              if (tau > 0) { p0 = *(const LAS f32x4*)(CSs + (stl - 1) * 64 + 8 * cg); p1 = *(const LAS f32x4*)(CSs + (stl - 1) * 64 + 8 * cg + 4); }
              const f32x4 t0 = *(const LAS f32x4*)(CSs + (16 * cq + 15) * 64 + 8 * cg), t1 = *(const LAS f32x4*)(CSs + (16 * cq + 15) * 64 + 8 * cg + 4);
              const float cs[8] = {c0.x, c0.y, c0.z, c0.w, c1.x, c1.y, c1.z, c1.w}, cp[8] = {p0.x, p0.y, p0.z, p0.w, p1.x, p1.y, p1.z, p1.w}, ct[8] = {t0.x, t0.y, t0.z, t0.w, t1.x, t1.y, t1.z, t1.w};
              const unsigned kw[4] = {kreg.x, kreg.y, kreg.z, kreg.w}, aw[4] = {areg.x, areg.y, areg.z, areg.w}, rw[4] = {rreg.x, rreg.y, rreg.z, rreg.w};
              float kr[8], ag[8], rr[8], kk[8]; float ss = 0.f;
#pragma unroll
              for (int i = 0; i < 4; ++i) { kr[2 * i] = bflo(kw[i]); kr[2 * i + 1] = bfhi(kw[i]); ag[2 * i] = bflo(aw[i]); ag[2 * i + 1] = bfhi(aw[i]); rr[2 * i] = bflo(rw[i]); rr[2 * i + 1] = bfhi(rw[i]); }
#pragma unroll
              for (int i = 0; i < 8; ++i) { kk[i] = kr[i] * kkw[i]; ss += kk[i] * kk[i]; }
              const float rn = __builtin_amdgcn_rsqf(fmaxf(red8(ss), 1e-24f));
              float oa[8], ob[8], ok[8], orr[8], obh[8], okh[8], eCv[8]; float cfp = 0.f;
#pragma unroll
              for (int i = 0; i < 8; ++i) { const float e1 = __expf(cs[i]), ep = __expf(cp[i]), eC = __expf(ct[i]), inv = __builtin_amdgcn_rcpf(e1);
                  const float kki = kk[i] * rn, b_ = kki * ag[i], kd_ = kr[i] * (1.f + (ag[i] - 1.f) * kaw[i]);
                  cfp += rr[i] * kd_ * rkw[i];
                  oa[i] = -kki * ep; ob[i] = b_ * inv; ok[i] = kd_ * inv; orr[i] = rr[i] * e1; obh[i] = b_ * eC * inv; okh[i] = kd_ * eC * inv; eCv[i] = eC; }
              cfp = red8(cfp);
              if (lat && cg == 0) { const int g = sc * 64 + stl; coef[z ? (SEQ + CTXL - 1 - g) : (g - CTXL)] = cfp; }
              const int o = stl * WLD + 8 * cg;
              *(LAS u32x4*)(AT + o) = pack8(oa, 1.f); *(LAS u32x4*)(BT + o) = pack8(ob, 1.f); *(LAS u32x4*)(KT + o) = pack8(ok, 1.f); *(LAS u32x4*)(RT + o) = pack8(orr, 1.f);
              *(LAS u32x4*)(BH + o) = pack8(obh, 1.f); *(LAS u32x4*)(KH + o) = pack8(okh, 1.f); *(LAS u32x4*)(VN + o) = vreg;
              if (tau == 0) { *(LAS f32x4*)(GC + cq * 64 + 8 * cg) = (f32x4){eCv[0], eCv[1], eCv[2], eCv[3]}; *(LAS f32x4*)(GC + cq * 64 + 8 * cg + 4) = (f32x4){eCv[4], eCv[5], eCv[6], eCv[7]}; } }
            LDS_BARRIER();
            if (sc + 1 < (SEQ + CTXL) / 64) RW_LOAD(sc + 1);
            for (int pa2_ = 0; pa2_ < ((((PROBE_DUP) >> 25) & 1u) ? 2 : 1); ++pa2_)
            if (half) { f32x4 pb = (f32x4){0.f, 0.f, 0.f, 0.f}, pk = (f32x4){0.f, 0.f, 0.f, 0.f};
#pragma unroll
                for (int k0 = 0; k0 < 64; k0 += 32) { const bf16x8 af = frag_kc(RT, WLD, 16 * cq, k0, F.lane);
                    pb = mma(pb, frag_kc(BT, WLD, 16 * cq, k0, F.lane), af); pk = mma(pk, frag_kc(KT, WLD, 16 * cq, k0, F.lane), af); }
#pragma unroll
                for (int r = 0; r < 4; ++r) if (4 * fq + r > fr) { pb[r] = 0.f; pk[r] = 0.f; }
                const int o = cq * 256 + fr * 16 + 4 * fq;
                *(LAS s16x4*)(PRB + o) = cvt4(pb); *(LAS s16x4*)(PRK + o) = cvt4(pk); }
            else { f32x4 xa = (f32x4){0.f, 0.f, 0.f, 0.f}, xt = (f32x4){0.f, 0.f, 0.f, 0.f}, ak = (f32x4){0.f, 0.f, 0.f, 0.f};
#pragma unroll
                for (int k0 = 0; k0 < 64; k0 += 32) { const bf16x8 af = frag_kc(AT, WLD, 16 * cq, k0, F.lane), bfm = frag_kc(BT, WLD, 16 * cq, k0, F.lane);
                    xa = mma(xa, bfm, af);
                    xt = mma(xt, af, bfm);
                    ak = mma(ak, frag_kc(KT, WLD, 16 * cq, k0, F.lane), af); }
#pragma unroll
                for (int r = 0; r < 4; ++r) { if (4 * fq + r >= fr) { xa[r] = 0.f; ak[r] = 0.f; } if (4 * fq + r <= fr) xt[r] = 0.f; }
                f32x4 P = xa;
#pragma unroll
                for (int r = 0; r < 4; ++r) if (4 * fq + r == fr) P[r] += 1.f;
#pragma unroll
                for (int lvl = 0; lvl < 3; ++lvl) { const s16x4 xf = cvt4(xa), xtf = cvt4(xt);
                    const f32x4 x2 = mma16((f32x4){0.f, 0.f, 0.f, 0.f}, xtf, xf);
                    const f32x4 x2t = mma16((f32x4){0.f, 0.f, 0.f, 0.f}, xf, xtf);
                    xa = x2; xt = x2t;
                    P = mma16(P, cvt4(xt), cvt4(P)); }
                const s16x4 tf = cvt4(P), akf = cvt4(ak);
#pragma unroll
                for (int jt = 0; jt < 4; ++jt) { const f32x4 acc = mma16((f32x4){0.f, 0.f, 0.f, 0.f}, frag16_kr(AT, WLD, 16 * jt, 16 * cq, F.lane), tf);
                    *(LAS s16x4*)(W1s + (16 * cq + fr) * WLD + 16 * jt + 4 * fq) = cvt4(acc); }
#pragma unroll
                for (int it = 0; it < 4; ++it) { const f32x4 xvt = mma16((f32x4){0.f, 0.f, 0.f, 0.f}, akf, frag16_kr(VN, WLD, 16 * it, 16 * cq, F.lane));
                    UVT[(cq * 4 + it) * 64 + F.lane] = mma16((f32x4){0.f, 0.f, 0.f, 0.f}, tf, cvt4(xvt)); } }
            LDS_BARRIER();
            if (F.wave < 4) { const int it = F.wave;
                s16x4 w1f[2][4], bhf[2][4], khf[2][4], vfr[2]; f32x4 g4[2][4], uv0[2];
#define SB_LOAD(c_, b_) do { _Pragma("unroll") for (int jt = 0; jt < 4; ++jt) { w1f[b_][jt] = frag16_kc(W1s, WLD, 16 * (c_), 16 * jt, F.lane); \
                        bhf[b_][jt] = frag16_kr(BH, WLD, 16 * jt, 16 * (c_), F.lane); khf[b_][jt] = frag16_kr(KH, WLD, 16 * jt, 16 * (c_), F.lane); g4[b_][jt] = *(const LAS f32x4*)(GC + (c_) * 64 + 16 * jt + 4 * fq); } \
                    vfr[b_] = frag16_kr(VN, WLD, 16 * it, 16 * (c_), F.lane); uv0[b_] = UVT[((c_) * 4 + it) * 64 + F.lane]; } while (0)
                SB_LOAD(0, 0);
#pragma unroll
                for (int c = 0; c < 4; ++c) { const int cb_ = c & 1;
                    if (c < 3) SB_LOAD(c + 1, cb_ ^ 1);
                    s16x4 sfr[4];
#pragma unroll
                    for (int jt = 0; jt < 4; ++jt) sfr[jt] = cvt4(S[jt]);
#define CAT8(a_, b_) __builtin_shufflevector((a_), (b_), 0, 1, 2, 3, 4, 5, 6, 7)
                    const bf16x8 s01 = CAT8(sfr[0], sfr[1]), s23 = CAT8(sfr[2], sfr[3]);
                    f32x4 Ua = mma(uv0[cb_], CAT8(w1f[cb_][0], w1f[cb_][1]), s01); Ua = mma(Ua, CAT8(w1f[cb_][2], w1f[cb_][3]), s23);
                    const s16x4 ufr = cvt4(Ua); const bf16x8 uv8 = CAT8(ufr, vfr[cb_]);
#pragma unroll
                    for (int jt = 0; jt < 4; ++jt) S[jt] = mma(S[jt] * g4[cb_][jt], CAT8(bhf[cb_][jt], khf[cb_][jt]), uv8);
                    if (lat) { s16x4 rtf[4];
#pragma unroll
                        for (int jt = 0; jt < 4; ++jt) rtf[jt] = frag16_kc(RT, WLD, 16 * c, 16 * jt, F.lane);
                        const s16x4 pbf = frag16_kc(PRB + c * 256, 16, 0, 0, F.lane), pkf = frag16_kc(PRK + c * 256, 16, 0, 0, F.lane);
                        f32x4 Ya = mma((f32x4){0.f, 0.f, 0.f, 0.f}, CAT8(rtf[0], rtf[1]), s01); Ya = mma(Ya, CAT8(rtf[2], rtf[3]), s23);
                        const f32x4 Yb = mma((f32x4){0.f, 0.f, 0.f, 0.f}, CAT8(pbf, pkf), uv8);
                        const f32x4 Yt = Ya + Yb;
#pragma unroll
                        for (int r = 0; r < 4; ++r) YS[(16 * c + 4 * fq + r) * 68 + 16 * it + fr] = Yt[r]; }
                }
#undef SB_LOAD
            }
            LDS_BARRIER();
            if (lat) {
                const int g = sc * 64 + (F.tid >> 3); const int tl = z ? (SEQ + CTXL - 1 - g) : (g - CTXL);
                const f32x4 y0 = *(const LAS f32x4*)(YS + (F.tid >> 3) * 68 + 8 * (F.tid & 7)), y1 = *(const LAS f32x4*)(YS + (F.tid >> 3) * 68 + 8 * (F.tid & 7) + 4);
                u32x4 o; o.x = pk2(y0.x, y0.y); o.y = pk2(y0.z, y0.w); o.z = pk2(y1.x, y1.y); o.w = pk2(y1.z, y1.w);
                *(u32x4*)(Y + (size_t)(b * SEQ + tl) * D + h * 64 + 8 * (F.tid & 7)) = o; }
            LDS_BARRIER();
        }
#undef RW_LOAD
    }
}

DI void rwkv_readout_phase(Fr& F) {
    const bf16* VB = (const bf16*)(F.ws + WS_VB); const bf16* G = (const bf16*)(F.ws + WS_G); const float* COEF = (const float*)(F.ws + WS_COEF);
    const bf16* YF = (const bf16*)(F.ws + WS_YF); const bf16* YB = (const bf16*)(F.ws + WS_YB); bf16* Z = (bf16*)(F.ws + WS_H);
    const int c0 = 16 * F.lane, hh = F.lane >> 2, j0 = (F.lane & 3) * 16;
    float lnw[16], lnb[16];
#pragma unroll
    for (int q = 0; q < 16; ++q) { lnw[q] = F.in[31][c0 + q]; lnb[q] = F.in[32][c0 + q]; }
#define RD16(dst, ptr) do { const u32x4 t0_ = *(const u32x4*)(ptr), t1_ = *(const u32x4*)((ptr) + 8); const unsigned tw_[8] = {t0_.x, t0_.y, t0_.z, t0_.w, t1_.x, t1_.y, t1_.z, t1_.w}; \
        _Pragma("unroll") for (int q_ = 0; q_ < 8; ++q_) { dst[2 * q_] = bflo(tw_[q_]); dst[2 * q_ + 1] = bfhi(tw_[q_]); } } while (0)
    for (int row = F.gw; row < ML; row += F.NGW) {
        const size_t off = (size_t)row * D + c0; const int b = row / SEQ, t = row % SEQ;
        const size_t hoff = ((size_t)(b * 16 + hh) * (SEQ + CTXL) + CTXL + t) * 64 + j0;
        float y[16], yb[16], vv[16], gv[16];
        RD16(y, YF + off); RD16(yb, YB + off); RD16(vv, VB + hoff); RD16(gv, G + off);
        const float cf = COEF[(size_t)(b * 16 + hh) * SEQ + t] + COEF[(size_t)(128 + b * 16 + hh) * SEQ + t];
        float s = 0.f;
#pragma unroll
        for (int q = 0; q < 16; ++q) { y[q] += yb[q]; s += y[q]; }
        s = red4(s);
        const float mean = s * (1.f / 64.f); float q2 = 0.f;
#pragma unroll
        for (int q = 0; q < 16; ++q) { const float d = y[q] - mean; q2 += d * d; }
        q2 = red4(q2);
        const float rstd = rsqrtf(q2 * (1.f / 64.f) + 64e-5f);
        float o[16];
#pragma unroll
        for (int q = 0; q < 16; ++q) o[q] = ((y[q] - mean) * rstd * lnw[q] + lnb[q] + cf * vv[q]) * gv[q];
        u32x4 p0, p1; p0.x = pk2(o[0], o[1]); p0.y = pk2(o[2], o[3]); p0.z = pk2(o[4], o[5]); p0.w = pk2(o[6], o[7]); p1.x = pk2(o[8], o[9]); p1.y = pk2(o[10], o[11]); p1.z = pk2(o[12], o[13]); p1.w = pk2(o[14], o[15]);
        *(u32x4*)(Z + off) = p0; *(u32x4*)(Z + off + 8) = p1;
    }
#undef RD16
}

DI void moe_route_phase(Fr& F, const float* xl, const float* normw, const float* modl) {
    bf16* H2 = (bf16*)(F.ws + WS_MIX); int* TopE = (int*)(F.ws + WS_MISC + MISC_TOPE); f32x2* TopW = (f32x2*)(F.ws + WS_MISC + MISC_TOPW); int* Cnts = (int*)(F.ws + WS_MISC + MISC_CNTS);
    LAS int* lc = (LAS int*)F.lds;
    f32x4 rw[4][4][2];
#pragma unroll
    for (int j = 0; j < 4; ++j)
#pragma unroll
        for (int q = 0; q < 4; ++q) { const float* rp = F.in[34] + (size_t)(4 * (F.lane + 64 * j) + q) * 8; rw[j][q][0] = *(const f32x4*)rp; rw[j][q][1] = *(const f32x4*)(rp + 4); }
    for (int wg = F.bx; wg < 256; wg += F.G) {
        LDS_BARRIER();
#pragma unroll 2
        for (int it = 0; it < 8; ++it) { const int row = wg * 64 + F.wave * 8 + it;
            const float* src = xl + (size_t)row * D; const float* mrow = modl + (size_t)(row / SEQ) * 6144;
            f32x4 v[4]; float ss = 0.f;
#pragma unroll
            for (int j = 0; j < 4; ++j) { v[j] = ((const f32x4*)src)[F.lane + 64 * j]; ss += (v[j].x * v[j].x + v[j].y * v[j].y) + (v[j].z * v[j].z + v[j].w * v[j].w); }
            const float rstd = rsqrtf(wave_sum_fast(ss) * (1.f / D) + 1e-6f);
            f32x4 l0 = (f32x4){0.f, 0.f, 0.f, 0.f}, l1 = l0;
#pragma unroll
            for (int j = 0; j < 4; ++j) { const int c4 = F.lane + 64 * j;
                const f32x4 w = ((const f32x4*)normw)[c4], sc = ((const f32x4*)(mrow + 4096))[c4], sh = ((const f32x4*)(mrow + 3072))[c4];
                const f32x4 y = v[j] * rstd * w * (sc + 1.f) + sh;
                u32x2 p; p.x = pk2(y.x, y.y); p.y = pk2(y.z, y.w); ((u32x2*)(H2 + (size_t)row * D))[c4] = p;
                l0 += rw[j][0][0] * y.x + rw[j][1][0] * y.y + rw[j][2][0] * y.z + rw[j][3][0] * y.w;
                l1 += rw[j][0][1] * y.x + rw[j][1][1] * y.y + rw[j][2][1] * y.z + rw[j][3][1] * y.w; }
            float lg[8] = {l0.x, l0.y, l0.z, l0.w, l1.x, l1.y, l1.z, l1.w};
#pragma unroll
            for (int e = 0; e < 8; ++e) lg[e] = wave_sum_fast(lg[e]);
            int e0 = 0; float v0 = lg[0];
#pragma unroll
            for (int e = 1; e < 8; ++e) if (lg[e] > v0) { v0 = lg[e]; e0 = e; }
            int e1 = -1; float v1 = -3.0e38f;
#pragma unroll
            for (int e = 0; e < 8; ++e) if (e != e0 && lg[e] > v1) { v1 = lg[e]; e1 = e; }
            const float w0 = 1.f / (1.f + expf(v1 - v0)), w1 = 1.f - w0;
            if (F.lane == 0) { TopE[row] = e0 | (e1 << 8); TopW[row] = (f32x2){w0, w1}; lc[F.wave * 8 + it] = e0 | (e1 << 8); }
        }
        LDS_BARRIER();
        if (F.tid < 8) { int c = 0; for (int t = 0; t < 64; ++t) { const int code = lc[t]; c += ((code & 255) == F.tid ? 1 : 0) + ((code >> 8) == F.tid ? 1 : 0); } Cnts[wg * 8 + F.tid] = c; }
    }
}
DI void moe_gather_phase(Fr& F) {
    const bf16* H2 = (const bf16*)(F.ws + WS_MIX); const int* TopE = (const int*)(F.ws + WS_MISC + MISC_TOPE); const f32x2* TopW = (const f32x2*)(F.ws + WS_MISC + MISC_TOPW);
    const int* Cnts = (const int*)(F.ws + WS_MISC + MISC_CNTS); int* Exp = (int*)(F.ws + WS_MISC + MISC_EXP);
    bf16* XG = (bf16*)(F.ws + WS_XG); int* RowTok = (int*)(F.ws + WS_ROWS); float* RowW = (float*)(F.ws + WS_ROWS + 262144);
    LAS int* lc = (LAS int*)F.lds;
    LAS int* tot = lc + 2048;
    LAS int* rows = tot + 32;
    LAS int* te = rows + 128;
    for (int idx = F.tid; idx < 2048; idx += NTHR) lc[idx] = Cnts[idx];
    WG_SYNC();
    for (int wg = F.bx; wg < 256; wg += F.G) {
        if (F.tid < 64) te[F.tid] = TopE[wg * 64 + F.tid];
        if (F.tid < 8) { int t = 0, mb = 0; for (int w = 0; w < 256; ++w) { const int c = lc[w * 8 + F.tid]; t += c; mb += (w < wg) ? c : 0; } tot[F.tid] = t; tot[16 + F.tid] = mb; }
        WG_SYNC();
        if (F.tid == 0) { int sgs = 0; for (int e = 0; e < 8; ++e) { tot[8 + e] = sgs; sgs += (tot[e] + 255) & ~255; }
            if (wg == 0) { int acc = 0; for (int e = 0; e < 8; ++e) { Exp[e] = tot[e]; Exp[8 + e] = tot[8 + e]; acc += (tot[e] + 255) >> 8; Exp[16 + e] = acc; } } }
        WG_SYNC();
        if (F.tid < 64) { const int code = te[F.tid]; const int e0 = code & 255, e1 = code >> 8; int r0 = 0, r1 = 0;
            for (int t = 0; t < F.tid; ++t) { const int c2 = te[t]; const int a = c2 & 255, bq = c2 >> 8; r0 += (a == e0 ? 1 : 0) + (bq == e0 ? 1 : 0); r1 += (a == e1 ? 1 : 0) + (bq == e1 ? 1 : 0); }
            rows[2 * F.tid] = tot[8 + e0] + tot[16 + e0] + r0; rows[2 * F.tid + 1] = tot[8 + e1] + tot[16 + e1] + r1; }
        WG_SYNC();
        for (int it = F.wave; it < 128; it += NWAVES) { const int t = it >> 1, k = it & 1, tok = wg * 64 + t, row = rows[it];
            const u32x4* s = (const u32x4*)(H2 + (size_t)tok * D); u32x4* d = (u32x4*)(XG + (size_t)row * D);
            d[F.lane] = s[F.lane]; d[F.lane + 64] = s[F.lane + 64];
            if (F.lane == 0) { RowTok[row] = tok * 2 + k; const f32x2 w = TopW[tok]; RowW[row] = k ? w.y : w.x; } }
        if (wg == 0) {
            for (int e = 0; e < 8; ++e) { const int a = tot[8 + e] + tot[e], bnd = tot[8 + e] + ((tot[e] + 255) & ~255); for (int rr = a + F.tid; rr < bnd; rr += NTHR) RowTok[rr] = -1; } }
        WG_SYNC();
    }
}
DI void moe_combine_phase(Fr& F, float* xl, const float* modl) {
    const bf16* YS = (const bf16*)(F.ws + WS_YS);
    for (int row = F.gw; row < ML; row += F.NGW) {
        const float* mrow = modl + (size_t)(row / SEQ) * 6144 + 5120; float* xr = xl + (size_t)row * D;
        const u32x2* s0 = (const u32x2*)(YS + (size_t)(2 * row) * D); const u32x2* s1 = (const u32x2*)(YS + (size_t)(2 * row + 1) * D);
#pragma unroll
        for (int j = 0; j < 4; ++j) { const int c4 = F.lane + 64 * j; const f32x4 x = ((const f32x4*)xr)[c4], m = ((const f32x4*)mrow)[c4]; const u32x2 a = s0[c4], bq = s1[c4];
            f32x4 o; o.x = x.x + m.x * (bflo(a.x) + bflo(bq.x)); o.y = x.y + m.y * (bfhi(a.x) + bfhi(bq.x)); o.z = x.z + m.z * (bflo(a.y) + bflo(bq.y)); o.w = x.w + m.w * (bfhi(a.y) + bfhi(bq.y));
            ((f32x4*)xr)[c4] = o; }
    }
}

constexpr int N_PHASES = 20;

struct Args { const float* in[37]; float* out; unsigned char* ws; int ph_lo, ph_hi; };
template <class Epi> DI void run_gemm(Fr& F, const bf16* A, const bf16* Bt, int M, int N, int K, const Epi& E, int& rot) {
    int Kv = K; asm volatile("" : "+s"(Kv));
    pg8::Gemm g{A, Bt, M, N, Kv}; pg8::StaticOrder S; S.init(M, N, F.G, (F.bx + F.G - (rot % F.G)) % F.G); rot += (M / 256) * (N / 256);
    pg8::gemm_phase<Epi, pg8::StaticOrder>(F.lds, g, S, E);
}
__global__ void __launch_bounds__(NTHR, 2) fwd_kernel(Args args) {
    extern __shared__ __attribute__((aligned(16))) unsigned char lds_raw[];
    Fr F;
    F.lds = (LAS unsigned char*)lds_raw; F.ws = args.ws; F.in = args.in; F.out = args.out;
    F.tid = threadIdx.x; F.lane = F.tid & 63; F.wave = __builtin_amdgcn_readfirstlane(F.tid >> 6); F.bx = blockIdx.x; F.G = gridDim.x;
    F.gw = F.bx * NWAVES + F.wave; F.NGW = F.G * NWAVES;
    volatile LAS unsigned* MISC = (volatile LAS unsigned*)(F.lds + LDS_MISC_OFF);
    if (F.tid < 64) MISC[F.tid] = 0u;
    __syncthreads();
    const int lo = args.ph_lo, hi = args.ph_hi;
    const bool multi = (hi - lo) > 1;
    XcdBarrier bar; bar.bar = (unsigned*)(F.ws + WS_CTL) + CW_BAR; bar.x = 0; bar.st = nullptr;
    if (multi) bar = xcd_barrier_post((unsigned*)(F.ws + WS_CTL) + CW_BAR, MISC + 8);
#ifndef PH_MASK
#define PH_MASK 0xFFFFFFFFu
#endif
#define IN(k) ((((PH_MASK) >> (k)) & 1u) && lo <= (k) && (k) < hi)
#define REP(k) for (int rep_ = 0; rep_ < ((((PROBE_DUP) >> (k)) & 1u) ? 2 : 1); ++rep_)
#define SEAM(k) do { if (IN(k) && IN((k) + 1)) xcd_barrier(bar); } while (0)
    const float* const* in = args.in;
    float* MOD = (float*)(F.ws + WS_MOD);
    float* XL = F.out; float* XC = (float*)(F.ws + WS_XC);
    bf16* H = (bf16*)(F.ws + WS_H); bf16* MIX = (bf16*)(F.ws + WS_MIX);

    if (IN(0)) REP(0) { p0_prologue(F); } SEAM(0);
    if (IN(1)) REP(1) { mod_rows(F, in[0], in[2], MA, in[6], MOD, 0, 1024, H); } SEAM(1);
    if (IN(2)) REP(2) { int rot = 0; EpiStore<0> E{(bf16*)(F.ws + WS_QKV), INW, INW}; run_gemm(F, H, (const bf16*)(F.ws + WS_W_IN), MA, INW, 1024, E, rot); } SEAM(2);
    if (IN(3)) REP(3) { na_norm_rows(F); ret_kv_phase(F); } SEAM(3);
    if (IN(4)) REP(4) { ret_prefix_phase(F); } SEAM(4);
    #ifndef PH5_SEL
#define PH5_SEL 3
#endif
    if (IN(5)) REP(5) { for (int r5_ = 0; r5_ < ((((PROBE_DUP) >> 27) & 1u) ? 2 : 1); ++r5_) ret_out_phase(F); for (int r6_ = 0; r6_ < ((((PROBE_DUP) >> 28) & 1u) ? 2 : 1); ++r6_) na_phase(F); } SEAM(5);
    if (IN(6)) REP(6) { int rot = 0; EpiResid E{in[0], XL, in[2], XC, MOD + 2048}; run_gemm(F, MIX, (const bf16*)(F.ws + WS_W_OUT), MA, 1024, 1024, E, rot); moe_fill(F, F.bx - 32, F.G - 32, 0, FILL_A); } SEAM(6);
    if (IN(7)) REP(7) { mod_rows(F, XL, XC, MA, in[7], MOD, 3072, 4096, H); } SEAM(7);
    if (IN(8)) REP(8) { int rot = 0; EpiSwiglu E{(bf16*)(F.ws + WS_FFH), FFN_H}; run_gemm(F, H, (const bf16*)(F.ws + WS_W_13), MA, 2 * FFN_H, 1024, E, rot); moe_fill(F, F.bx - 48, F.G - 48, FILL_A, FILL_B); } SEAM(8);
    if (IN(9)) { int rot = 0; EpiResid E{XL, XL, XC, XC, MOD + 5120}; run_gemm(F, (const bf16*)(F.ws + WS_FFH), (const bf16*)(F.ws + WS_W_2), MA, 1024, FFN_H, E, rot); moe_fill(F, F.bx - 32, F.G - 32, FILL_B, FILL_C); } SEAM(9);
    const float* MOD1 = MOD + 9 * 6144;
    if (IN(10)) REP(10) { xm_phase(F, XL, XC, in[6] + 1024, MOD1); } SEAM(10);
    if (IN(11)) REP(11) { int rot = 0; const bf16* XM = (const bf16*)(F.ws + WS_XM); const bf16* WR = (const bf16*)(F.ws + WS_W_RKV); const bf16* WL1 = (const bf16*)(F.ws + WS_W_L1);
        { EpiStoreHead E{(bf16*)(F.ws + WS_RB), SEQ, 0}; run_gemm(F, XM, WR, ML, 1024, 1024, E, rot); }
        { EpiStoreHead E{(bf16*)(F.ws + WS_KB), SEQ + CTXL, CTXL}; run_gemm(F, XM + (size_t)1 * MA * D, WR + 1024 * 1024, MA, 1024, 1024, E, rot); }
        { EpiStoreHead E{(bf16*)(F.ws + WS_VB), SEQ + CTXL, CTXL}; run_gemm(F, XM + (size_t)2 * MA * D, WR + 2 * 1024 * 1024, MA, 1024, 1024, E, rot); }
        { EpiStore<1> E{(bf16*)(F.ws + WS_L1), 256, 128}; run_gemm(F, XM + (size_t)3 * MA * D, WL1, MA, 256, 1024, E, rot); }
        { EpiStore<0> E{(bf16*)(F.ws + WS_L1) + 128, 256, 128}; run_gemm(F, XM + (size_t)4 * MA * D, WL1 + 256 * 1024, MA, 256, 1024, E, rot); }
        { EpiStore<2> E{(bf16*)(F.ws + WS_LG), 256, 256}; run_gemm(F, XM + (size_t)5 * MA * D, WL1 + 2 * 256 * 1024, ML, 256, 1024, E, rot); }
        } SEAM(11);
    if (IN(12)) REP(12) { int rot = 0;
        { EpiLora2 E{(bf16*)(F.ws + WS_DEC), (bf16*)(F.ws + WS_AG), in[20], in[23]}; run_gemm(F, (const bf16*)(F.ws + WS_L1), (const bf16*)(F.ws + WS_W_L2), MA, 4096, 256, E, rot); }
        { EpiStore<0> E{(bf16*)(F.ws + WS_G), D, D}; run_gemm(F, (const bf16*)(F.ws + WS_LG), (const bf16*)(F.ws + WS_W_G2), ML, 1024, 256, E, rot); } } SEAM(12);
    #ifndef SCAN_VER
#define SCAN_VER 2
#endif
    if (IN(13)) REP(13) { rwkv_scan2_phase(F); } SEAM(13);
    if (IN(14)) REP(14) { rwkv_readout_phase(F); } SEAM(14);
    if (IN(15)) { int rot = 0; EpiResid E{XL, XL, XC, XC, MOD1 + 2048}; run_gemm(F, H, (const bf16*)(F.ws + WS_W_O), ML, 1024, 1024, E, rot); } SEAM(15);
    if (IN(16)) REP(16) { moe_route_phase(F, XL, in[7] + 1024, MOD1); } SEAM(16);
    if (IN(17)) REP(17) { moe_gather_phase(F); } SEAM(17);
    if (IN(18) || IN(19)) {
        const int* Exp = (const int*)(F.ws + WS_MISC + MISC_EXP);
        pg8::MoeOrder S; S.G = F.G; S.c = F.bx;
#pragma unroll
        for (int e = 0; e < 8; ++e) S.tend[e] = Exp[16 + e];
        S.nM = S.tend[7];
        if (IN(18)) REP(18) { S.nN = 2 * EXP_H / 256; S.nwg = S.nM * S.nN; pg8::Gemm g{(const bf16*)(F.ws + WS_XG), (const bf16*)(F.ws + WS_W_M13), XG_ROWS, 2 * EXP_H, 1024};
            EpiSwiglu E{(bf16*)(F.ws + WS_HG), EXP_H}; pg8::gemm_phase<EpiSwiglu, pg8::MoeOrder>(F.lds, g, S, E); }
        SEAM(18);
        if (IN(19)) REP(19) { S.nN = 4; S.nwg = S.nM * S.nN; pg8::Gemm g{(const bf16*)(F.ws + WS_HG), (const bf16*)(F.ws + WS_W_M2), XG_ROWS, 1024, EXP_H};
            EpiMoeOut E{(bf16*)(F.ws + WS_YS), (const int*)(F.ws + WS_ROWS), (const float*)(F.ws + WS_ROWS + 262144)}; pg8::gemm_phase<EpiMoeOut, pg8::MoeOrder>(F.lds, g, S, E); }
    }
    if (IN(19) && IN(20)) xcd_barrier(bar);
    if (IN(19) && IN(20)) for (int xb_ = 0; xb_ < ((((PROBE_DUP) >> 29) & 1u) ? 20 : 0); ++xb_) xcd_barrier(bar);
    if (IN(20)) { moe_combine_phase(F, XL, MOD1); }
#undef IN
#undef SEAM
}

#ifndef MK_SPLIT
#define MK_SPLIT 0
#endif
extern "C" void kernel_launch(void* const* d_in, const int* in_sizes, int n_in, void* d_out, int out_size, void* d_ws, size_t ws_size, hipStream_t stream) {
    static int grid = 0;
    if (grid == 0) {
        if (n_in != 37 || out_size != ML * D || ws_size < WS_END) { fprintf(stderr, "kernel_launch: unexpected problem (n_in %d out %d ws %zu)\n", n_in, out_size, ws_size); grid = -1; return; }
        int dev = 0, cus = 0, per_cu = 0;
        if (hipGetDevice(&dev) != hipSuccess || hipDeviceGetAttribute(&cus, hipDeviceAttributeMultiprocessorCount, dev) != hipSuccess) { grid = -1; return; }
        if (hipFuncSetAttribute((const void*)fwd_kernel, hipFuncAttributeMaxDynamicSharedMemorySize, LDS_BYTES) != hipSuccess) { fprintf(stderr, "kernel_launch: hipFuncSetAttribute failed\n"); grid = -1; return; }
        if (hipOccupancyMaxActiveBlocksPerMultiprocessor(&per_cu, (const void*)fwd_kernel, NTHR, LDS_BYTES) != hipSuccess || per_cu < 1) { fprintf(stderr, "kernel_launch: occupancy query says %d\n", per_cu); }
        (void)hipGetLastError();
        grid = cus;
    }
    if (grid < 0) return;
    (void)hipMemsetAsync((char*)d_ws + WS_CTL, 0, CTL_ZERO_BYTES, stream);
    Args a{};
    for (int i = 0; i < 37; ++i) a.in[i] = (const float*)d_in[i];
    a.out = (float*)d_out; a.ws = (unsigned char*)d_ws;
#if MK_SPLIT
    for (int p = 0; p <= N_PHASES; ++p) { a.ph_lo = p; a.ph_hi = p + 1; hipLaunchKernelGGL(fwd_kernel, dim3(grid), dim3(NTHR), LDS_BYTES, stream, a); }
#elif defined(PROBE_RELAUNCH)
    a.ph_lo = 0; a.ph_hi = PROBE_RELAUNCH + 1; hipLaunchKernelGGL(fwd_kernel, dim3(grid), dim3(NTHR), LDS_BYTES, stream, a);
    (void)hipMemsetAsync((char*)d_ws + WS_CTL, 0, CTL_ZERO_BYTES, stream);
    a.ph_lo = PROBE_RELAUNCH; a.ph_hi = PROBE_RELAUNCH + 1; hipLaunchKernelGGL(fwd_kernel, dim3(grid), dim3(NTHR), LDS_BYTES, stream, a);
    a.ph_lo = PROBE_RELAUNCH + 1; a.ph_hi = N_PHASES + 1; hipLaunchKernelGGL(fwd_kernel, dim3(grid), dim3(NTHR), LDS_BYTES, stream, a);
#else
    a.ph_lo = 0; a.ph_hi = N_PHASES + 1; hipLaunchKernelGGL(fwd_kernel, dim3(grid), dim3(NTHR), LDS_BYTES, stream, a);
#endif
}
```

```cpp
#include <hip/hip_runtime.h>
#include <cstdio>
#include <cstdint>

#ifndef PROBE_DUP
#define PROBE_DUP 0u
#endif
#define DI __device__ __forceinline__
#define LAS __attribute__((address_space(3)))

namespace pg8 {
#define PG8_LAS __attribute__((address_space(3)))
typedef unsigned short bf16_t;
typedef short bf16x8 __attribute__((ext_vector_type(8)));
typedef float f32x4 __attribute__((ext_vector_type(4)));
typedef unsigned u32x4 __attribute__((ext_vector_type(4)));
constexpr int BM = 256, BK = 64, HALF = 128, HTB = HALF * BK * 2  , STAGE_BYTES = 8 * HTB, NXCD = 8, WGM = 8;

__host__ __device__ __forceinline__ int lds_byte(int r, int c) { const int st = (r >> 4) * 2 + (c >> 5), rr = r & 15, cc = c & 31, ob = rr * 64 + cc * 2; return st * 1024 + (ob ^ (((ob >> 9) & 1) << 5)); }
__host__ __device__ __forceinline__ void stage_rc(int b, int& R, int& C) { const int st = b / 1024, sb = b % 1024, swz = sb ^ (((sb >> 9) & 1) << 5); R = (st >> 1) * 16 + swz / 64; C = (st & 1) * 32 + (swz % 64) / 2; }
__host__ __device__ __forceinline__ int perm32(int rho) { const int n = rho >> 4, i = rho & 15; return 8 * (i >> 2) + 4 * n + (i & 3); }

struct Unit { int pm, pn, pb; };
struct Gemm { const bf16_t* A; const bf16_t* Bt; int M, N, K; };

struct StaticOrder {
    int nM, nN, nwg, G, c;
    __host__ __device__ void init(int M, int N, int G_, int c_) { nM = M / BM; nN = N / BM; nwg = nM * nN; G = G_; c = c_; }
    __host__ __device__ bool next(int i, Unit& u) const {
        const long L = (long)i * G + c; if (L >= nwg) return false;
        int wgid = (int)L; { const int q = nwg / NXCD, r = nwg % NXCD, xcd = wgid % NXCD, off = wgid / NXCD; wgid = (xcd < r ? xcd * (q + 1) : r * (q + 1) + (xcd - r) * q) + off; }
        const int nig = WGM * nN, gid = wgid / nig, fm = gid * WGM, gsz = (nM - fm) < WGM ? (nM - fm) : WGM;
        u.pm = fm + ((wgid % nig) % gsz); u.pn = (wgid % nig) / gsz; u.pb = u.pn; return true;
    }
    __device__ __forceinline__ void a_ready(const Unit&) const {}
    __device__ __forceinline__ void done(const Unit&) const {}
};
struct MoeOrder {
    int nM, nN, nwg, G, c; int tend[8];
    __device__ bool next(int i, Unit& u) const {
        const long L = (long)i * G + c; if (L >= nwg) return false;
        int wgid = (int)L; { const int q = nwg / NXCD, r = nwg % NXCD, xcd = wgid % NXCD, off = wgid / NXCD; wgid = (xcd < r ? xcd * (q + 1) : r * (q + 1) + (xcd - r) * q) + off; }
        const int nig = WGM * nN, gid = wgid / nig, fm = gid * WGM, gsz = (nM - fm) < WGM ? (nM - fm) : WGM;
        u.pm = fm + ((wgid % nig) % gsz); u.pn = (wgid % nig) / gsz;
        int e = 0;
#pragma unroll
        for (int j = 0; j < 7; ++j) e += (u.pm >= tend[j]) ? 1 : 0;
        u.pb = e * nN + u.pn; return true;
    }
    __device__ __forceinline__ void a_ready(const Unit&) const {}
    __device__ __forceinline__ void done(const Unit&) const {}
};

typedef float f32x2_t __attribute__((ext_vector_type(2))); typedef __bf16 bf16x2_t __attribute__((ext_vector_type(2)));
__device__ __forceinline__ unsigned cvt_pk_bf16(float lo, float hi) { const f32x2_t v = {lo, hi}; const bf16x2_t b = __builtin_convertvector(v, bf16x2_t); return __builtin_bit_cast(unsigned, b); }

template <class Epi, class Sched>
__device__ __forceinline__ void gemm_phase(PG8_LAS unsigned char* lds, const Gemm g, const Sched& S, const Epi& E) {
    const int tid = threadIdx.x, wid = __builtin_amdgcn_readfirstlane(tid >> 6), lane = tid & 63, wr = wid >> 2, wc = wid & 3, fr = lane & 15, fq = lane >> 4;
    const int K = g.K, nt = K / BK;
    unsigned voffA[2], voffB[2];
#pragma unroll
    for (int i = 0; i < 2; ++i) { int R, C; stage_rc(tid * 16 + i * 8192, R, C); const int Rb = Epi::PERM ? ((R & ~31) + perm32(R & 31)) : R;
        voffA[i] = (unsigned)(R * K + C) * 2u; voffB[i] = (unsigned)(Rb * K + C) * 2u; }
    const size_t kstep = (size_t)(BK * 2);
    const size_t hstep = (size_t)HALF * K * 2;
    const size_t tstep = 2 * hstep;
    const unsigned ldsw = (unsigned)wid * 1024u;
    const int aoff = lds_byte(wr * 64 + fr, fq * 8), boff = lds_byte(wc * 32 + fr, fq * 8);
#define PG8_SA(b, h) (((b) * 2 + (h)) * HTB)
#define PG8_SB(b, h) ((4 + (b) * 2 + (h)) * HTB)
#define PG8_STAGE(bufoff, gbase, voff) do { _Pragma("unroll") for (int _i = 0; _i < 2; ++_i) \
        __builtin_amdgcn_global_load_lds((const unsigned*)((const char*)(gbase) + (voff)[_i]), (PG8_LAS unsigned*)(lds + (bufoff) + ldsw + _i * 8192), 16, 0, 0); } while (0)
#define PG8_LDA(dst, b, h) do { _Pragma("unroll") for (int m = 0; m < 4; ++m) _Pragma("unroll") for (int k = 0; k < 2; ++k) dst[m][k] = *(const PG8_LAS bf16x8*)(lds + PG8_SA(b, h) + aoff + m * 2048 + k * 1024); } while (0)
#define PG8_LDB(dst, b, h) do { _Pragma("unroll") for (int n = 0; n < 2; ++n) _Pragma("unroll") for (int k = 0; k < 2; ++k) dst[n][k] = *(const PG8_LAS bf16x8*)(lds + PG8_SB(b, h) + boff + n * 2048 + k * 1024); } while (0)
#define PG8_MMA(ai, bj, At, Bt) do { __builtin_amdgcn_s_setprio(1); _Pragma("unroll") for (int m = 0; m < 4; ++m) _Pragma("unroll") for (int n = 0; n < 2; ++n) _Pragma("unroll") for (int k = 0; k < 2; ++k) \
        acc[ai][bj][m][n] = __builtin_amdgcn_mfma_f32_16x16x32_bf16(Bt[n][k], At[m][k], acc[ai][bj][m][n], 0, 0, 0); __builtin_amdgcn_s_setprio(0); } while (0)
#define PG8_WAIT_V(n) asm volatile("s_waitcnt vmcnt(" #n ")" ::: "memory")
#define PG8_WAIT_L(n) asm volatile("s_waitcnt lgkmcnt(" #n ")" ::: "memory")
#define PG8_BAR __builtin_amdgcn_s_barrier()
#define PG8_SCHED __builtin_amdgcn_sched_barrier(0)
    Unit cur, nxt; int ui = 0;
    if (!S.next(0, cur)) return;
    f32x4 acc[2][2][4][2];
#pragma unroll
    for (int a = 0; a < 2; ++a)
#pragma unroll
        for (int b = 0; b < 2; ++b)
#pragma unroll
            for (int m = 0; m < 4; ++m)
#pragma unroll
                for (int n = 0; n < 2; ++n) acc[a][b][m][n] = (f32x4){0.f, 0.f, 0.f, 0.f};
    bf16x8 At[4][2], B0[2][2], B1[2][2];
    const char* cA = (const char*)g.A + (size_t)cur.pm * tstep; const char* cB = (const char*)g.Bt + (size_t)cur.pb * tstep;
    S.a_ready(cur);
    PG8_STAGE(PG8_SB(0, 0), cB, voffB); PG8_STAGE(PG8_SB(0, 1), cB + hstep, voffB); PG8_STAGE(PG8_SA(0, 0), cA, voffA); PG8_STAGE(PG8_SA(0, 1), cA + hstep, voffA);
    if (wr == 1) PG8_BAR;
    PG8_WAIT_V(2); PG8_BAR;
    PG8_STAGE(PG8_SB(1, 0), cB + kstep, voffB); PG8_STAGE(PG8_SA(1, 0), cA + kstep, voffA); PG8_STAGE(PG8_SB(1, 1), cB + hstep + kstep, voffB);
    PG8_WAIT_V(6); PG8_BAR;
    for (;;) {
        const bool has_next = S.next(ui + 1, nxt);
        const char* nA = has_next ? (const char*)g.A + (size_t)nxt.pm * tstep : cA; const char* nB = has_next ? (const char*)g.Bt + (size_t)nxt.pb * tstep : cB;
        for (int t = 0; t < nt; t += 2) {
            const bool last = (t == nt - 2);
            const char* a1 = cA + (size_t)(t + 1) * kstep;
            const char* a2 = last ? nA : cA + (size_t)(t + 2) * kstep; const char* b2 = last ? nB : cB + (size_t)(t + 2) * kstep;
            const char* a3 = a2 + kstep; const char* b3 = b2 + kstep;
            if (last && has_next) S.a_ready(nxt);
            PG8_LDB(B0, 0, 0); PG8_LDB(B1, 0, 1); PG8_SCHED; PG8_LDA(At, 0, 0); PG8_STAGE(PG8_SA(1, 1), a1 + hstep, voffA);
            PG8_WAIT_V(8); PG8_WAIT_L(0); PG8_BAR; PG8_MMA(0, 0, At, B0); PG8_MMA(0, 1, At, B1); PG8_BAR; PG8_SCHED;
            PG8_LDA(At, 0, 1); PG8_STAGE(PG8_SB(0, 0), b2, voffB); PG8_STAGE(PG8_SB(0, 1), b2 + hstep, voffB); PG8_STAGE(PG8_SA(0, 0), a2, voffA);
            PG8_WAIT_V(8); PG8_WAIT_L(0); PG8_BAR; PG8_MMA(1, 0, At, B0); PG8_MMA(1, 1, At, B1); PG8_BAR; PG8_SCHED;
            PG8_LDB(B0, 1, 0); PG8_LDB(B1, 1, 1); PG8_SCHED; PG8_LDA(At, 1, 0); PG8_STAGE(PG8_SA(0, 1), a2 + hstep, voffA);
            PG8_WAIT_V(8); PG8_WAIT_L(0); PG8_BAR; PG8_MMA(0, 0, At, B0); PG8_MMA(0, 1, At, B1); PG8_BAR; PG8_SCHED;
            PG8_LDA(At, 1, 1); PG8_STAGE(PG8_SB(1, 0), b3, voffB); PG8_STAGE(PG8_SB(1, 1), b3 + hstep, voffB); PG8_STAGE(PG8_SA(1, 0), a3, voffA);
            PG8_WAIT_V(8); PG8_WAIT_L(0); PG8_BAR; PG8_MMA(1, 0, At, B0); PG8_MMA(1, 1, At, B1); PG8_BAR; PG8_SCHED;
        }
        if (wr == 0) PG8_BAR;
        E(acc, cur, wr, wc, fr, fq); S.done(cur);
        if (!has_next) break;
#pragma unroll
        for (int a = 0; a < 2; ++a)
#pragma unroll
            for (int b = 0; b < 2; ++b)
#pragma unroll
                for (int m = 0; m < 4; ++m)
#pragma unroll
                    for (int n = 0; n < 2; ++n) acc[a][b][m][n] = (f32x4){0.f, 0.f, 0.f, 0.f};
        cur = nxt; cA = nA; cB = nB; ++ui;
        if (wr == 1) PG8_BAR;
    }
    PG8_WAIT_V(0);
    PG8_BAR;
#undef PG8_SA
#undef PG8_SB
#undef PG8_STAGE
#undef PG8_LDA
#undef PG8_LDB
#undef PG8_MMA
#undef PG8_WAIT_V
#undef PG8_WAIT_L
#undef PG8_BAR
#undef PG8_SCHED
}
}

constexpr int D = 1024, NB = 8, SEQ = 2048, CTXL = 256;
constexpr int ML = NB * SEQ;
constexpr int MC = NB * CTXL;
constexpr int MA = ML + MC;
constexpr int INW = 3584, FFN_H = 2816, EXP_H = 3584, NEXP = 8;
constexpr int NCH = 18;
constexpr int XG_ROWS = 34816;
constexpr int NWAVES = 8, NTHR = 512;

constexpr size_t MiB = 1u << 20;
constexpr size_t WS_CTL = 0, CTL_ZERO_BYTES = 1 * MiB;
constexpr size_t WS_MOD = 1 * MiB;
constexpr size_t WS_ROPE = 2 * MiB;
constexpr size_t WS_MISC = 3 * MiB;
constexpr size_t WS_W_IN = 4 * MiB, WS_W_OUT = 11 * MiB, WS_W_13 = 13 * MiB, WS_W_2 = 24 * MiB, WS_W_RKV = 30 * MiB, WS_W_L1 = 36 * MiB,
                 WS_W_L2 = 38 * MiB, WS_W_G2 = 40 * MiB, WS_W_O = 41 * MiB, WS_W_M13 = 43 * MiB, WS_W_M2 = 155 * MiB;
constexpr size_t WS_XC = 211 * MiB, WS_H = 219 * MiB, WS_MIX = 255 * MiB, WS_R = 291 * MiB;
constexpr size_t WS_QKV = WS_R, WS_KV = WS_R + 126 * MiB, WS_SPREV = WS_R + 198 * MiB, WS_FFH = WS_R;
constexpr size_t WS_NQ = WS_R + 240 * MiB, WS_NK = WS_R + 260 * MiB, WS_NV = WS_R + 280 * MiB;
constexpr size_t WS_XM = WS_R, WS_DEC = WS_R, WS_AG = WS_R + 144 * MiB, WS_RB = WS_R + 216 * MiB, WS_KB = WS_R + 248 * MiB, WS_VB = WS_R + 284 * MiB,
                 WS_L1 = WS_R + 320 * MiB, WS_LG = WS_R + 329 * MiB, WS_G = WS_R + 337 * MiB, WS_YF = WS_R + 369 * MiB, WS_YB = WS_R + 433 * MiB;
constexpr size_t WS_COEF = WS_R + 401 * MiB;
constexpr size_t WS_XG = WS_R, WS_HG = WS_R + 68 * MiB, WS_YS = WS_R + 306 * MiB, WS_ROWS = WS_R + 370 * MiB;
constexpr size_t WS_END = WS_R + 497 * MiB;
static_assert(WS_END <= 896 * MiB, "workspace map");
constexpr int CW_BAR = 4096;
constexpr size_t MISC_TOPE = 0, MISC_TOPW = 65536, MISC_CNTS = 196608, MISC_EXP = 204800;

constexpr int LDS_MAIN = 147456;
constexpr int LDS_MISC_OFF = LDS_MAIN;
constexpr int LDS_BYTES = LDS_MAIN + 256;

typedef unsigned short bf16;
typedef short bf16x8 __attribute__((ext_vector_type(8)));
typedef short s16x4 __attribute__((ext_vector_type(4)));
typedef float f32x4 __attribute__((ext_vector_type(4)));
typedef float f32x2 __attribute__((ext_vector_type(2)));
typedef unsigned u32x4 __attribute__((ext_vector_type(4)));
typedef unsigned u32x2 __attribute__((ext_vector_type(2)));
#define LDS_WAIT() asm volatile("s_waitcnt lgkmcnt(0)" ::: "memory")
#define VM_WAIT() asm volatile("s_waitcnt vmcnt(0)" ::: "memory")
#define WG_SYNC() __syncthreads()
#define LDS_BARRIER() do { asm volatile("s_waitcnt lgkmcnt(0)" ::: "memory"); __builtin_amdgcn_s_barrier(); asm volatile("" ::: "memory"); } while (0)
DI unsigned f2bf(float f) { unsigned u = __builtin_bit_cast(unsigned, f); return (u + 0x7fffu + ((u >> 16) & 1u)) >> 16; }
typedef __bf16 bf16x2_t __attribute__((ext_vector_type(2)));
DI unsigned pk2(float lo, float hi) { const f32x2 v = {lo, hi}; const bf16x2_t b = __builtin_convertvector(v, bf16x2_t); return __builtin_bit_cast(unsigned, b); }
DI float bflo(unsigned w) { return __builtin_bit_cast(float, w << 16); }
DI float bfhi(unsigned w) { return __builtin_bit_cast(float, w & 0xffff0000u); }
DI float bf1(bf16 b) { return __builtin_bit_cast(float, (unsigned)b << 16); }
DI float wave_sum(float v) {
#pragma unroll
    for (int o = 1; o < 64; o <<= 1) v += __shfl_xor(v, o);
    return v;
}
DI float dpp_rm(float v) { return __builtin_bit_cast(float, __builtin_amdgcn_update_dpp(0, __builtin_bit_cast(int, v), 0x140, 0xf, 0xf, true)); }
DI float wave_sum_fast(float v) {
    v += __builtin_bit_cast(float, __builtin_amdgcn_update_dpp(0, __builtin_bit_cast(int, v), 0xB1, 0xf, 0xf, true));
    v += __builtin_bit_cast(float, __builtin_amdgcn_update_dpp(0, __builtin_bit_cast(int, v), 0x4E, 0xf, 0xf, true));
    v += __builtin_bit_cast(float, __builtin_amdgcn_update_dpp(0, __builtin_bit_cast(int, v), 0x141, 0xf, 0xf, true));
    v += dpp_rm(v);
    const int iv = __builtin_bit_cast(int, v);
    const float a = __builtin_bit_cast(float, __builtin_amdgcn_readlane(iv, 0)), b = __builtin_bit_cast(float, __builtin_amdgcn_readlane(iv, 16));
    const float c = __builtin_bit_cast(float, __builtin_amdgcn_readlane(iv, 32)), d = __builtin_bit_cast(float, __builtin_amdgcn_readlane(iv, 48));
    return (a + b) + (c + d);
}
DI float wave_max(float v) {
#pragma unroll
    for (int o = 1; o < 64; o <<= 1) v = fmaxf(v, __shfl_xor(v, o));
    return v;
}
DI float dpp_x1(float v) { return __builtin_bit_cast(float, __builtin_amdgcn_update_dpp(0, __builtin_bit_cast(int, v), 0xB1, 0xf, 0xf, true)); }
DI float dpp_x2(float v) { return __builtin_bit_cast(float, __builtin_amdgcn_update_dpp(0, __builtin_bit_cast(int, v), 0x4E, 0xf, 0xf, true)); }
DI float dpp_hm(float v) { return __builtin_bit_cast(float, __builtin_amdgcn_update_dpp(0, __builtin_bit_cast(int, v), 0x141, 0xf, 0xf, true)); }
DI float red4(float v) { v += dpp_x1(v); v += dpp_x2(v); return v; }
DI float red8(float v) { v += dpp_x1(v); v += dpp_x2(v); v += dpp_hm(v); return v; }
DI float sigmoidf_(float x) { return __builtin_amdgcn_rcpf(1.f + __expf(-x)); }
DI float siluf_(float x) { return x * __builtin_amdgcn_rcpf(1.f + __expf(-x)); }

DI bf16x8 frag_kc(const LAS bf16* base, int ld, int row0, int k0, int lane) {
    return *(const LAS bf16x8*)(base + (row0 + (lane & 15)) * ld + k0 + 8 * (lane >> 4));
}
DI bf16x8 frag_kr(const LAS bf16* base, int ld, int x0, int k0, int lane) {
    const int g = lane >> 4, q = (lane & 15) >> 2, p = lane & 3;
    const LAS bf16* a = base + (k0 + 8 * g + q) * ld + x0 + 4 * p;
    const s16x4 lo = __builtin_amdgcn_ds_read_tr16_b64_v4i16((LAS s16x4*)a);
    const s16x4 hi = __builtin_amdgcn_ds_read_tr16_b64_v4i16((LAS s16x4*)(a + 4 * ld));
    return __builtin_shufflevector(lo, hi, 0, 1, 2, 3, 4, 5, 6, 7);
}
DI f32x4 mma(f32x4 acc, bf16x8 bfrag, bf16x8 afrag) { return __builtin_amdgcn_mfma_f32_16x16x32_bf16(bfrag, afrag, acc, 0, 0, 0); }

#define XB_TMO      128
#define XB_XCNT(j)  (256  + 64 * (j))
#define XB_XSUB(j)  (1280 + 64 * (j))
#define XB_XGEN(j)  (2304 + 64 * (j))
#define XB_TOP      3328
#define XB_TOPGEN   3392
#define XCD_BAR_WORDS 3456
#define XB_SPIN_CAP (1u << 18)
DI unsigned xb_ld(unsigned* p)              { return __hip_atomic_load(p, __ATOMIC_RELAXED, __HIP_MEMORY_SCOPE_AGENT); }
DI unsigned xb_add(unsigned* p, unsigned v) { return __hip_atomic_fetch_add(p, v, __ATOMIC_RELAXED, __HIP_MEMORY_SCOPE_AGENT); }
DI unsigned xb_xcc_id() { return (unsigned)__builtin_amdgcn_s_getreg((3 << 11) | 20) & 0xFu; }
#define XB_SPIN(cond, bar) do { unsigned _sp = 0; while (cond) { __builtin_amdgcn_s_sleep(1); \
    if ((++_sp & 255u) == 0u) { if (xb_ld(&(bar)[XB_TMO])) break; if (_sp > XB_SPIN_CAP) { atomicAdd(&(bar)[XB_TMO], 1u); break; } } } } while (0)
struct XcdBarrier { unsigned* bar; unsigned x; volatile LAS unsigned* st; };
DI XcdBarrier xcd_barrier_post(unsigned* bar, volatile LAS unsigned* st) {
    XcdBarrier b; b.bar = bar; b.x = xb_xcc_id(); b.st = st;
    if (threadIdx.x == 0) (void)xb_add(&bar[XB_XCNT(b.x)], 1u);
    return b;
}
DI void xcd_barrier_complete(unsigned* bar, unsigned x, unsigned& nloc, unsigned& nx) {
    const unsigned G = gridDim.x * gridDim.y * gridDim.z;
    unsigned sum, cnt, mine, sp = 0u;
    for (;;) {
        sum = 0u; cnt = 0u; mine = 0u;
#pragma unroll
        for (unsigned j = 0; j < 16; ++j) { const unsigned c = xb_ld(&bar[XB_XCNT(j)]); sum += c; cnt += (c > 0u) ? 1u : 0u; mine = (j == x) ? c : mine; }
        if (sum == G) break;
        __builtin_amdgcn_s_sleep(1);
        if ((++sp & 255u) == 0u) { if (xb_ld(&bar[XB_TMO])) break; if (sp > XB_SPIN_CAP) { atomicAdd(&bar[XB_TMO], 1u); break; } }
    }
    nloc = mine > 0u ? mine : 1u; nx = cnt > 0u ? cnt : 1u;
}
DI void xcd_barrier(const XcdBarrier& b) {
    asm volatile("s_waitcnt vmcnt(0)" ::: "memory");
    __syncthreads();
    if (threadIdx.x == 0) {
        unsigned* bar = b.bar;
        __builtin_amdgcn_s_waitcnt(0);
        unsigned nloc = b.st[0], nx = b.st[1];
        if (nloc == 0u) { xcd_barrier_complete(bar, b.x, nloc, nx); b.st[0] = nloc; b.st[1] = nx; }
        const unsigned old = xb_add(&bar[XB_XSUB(b.x)], 1u);
        const unsigned gen = old / nloc;
        if (old + 1u == (gen + 1u) * nloc) {
            __builtin_amdgcn_fence(__ATOMIC_RELEASE, "agent");
            asm volatile("s_waitcnt vmcnt(0)" ::: "memory");
            const unsigned og = xb_add(&bar[XB_TOP], 1u);
            const unsigned tg = og / nx;
            if (og + 1u == (tg + 1u) * nx) xb_add(&bar[XB_TOPGEN], 1u);
            else XB_SPIN(xb_ld(&bar[XB_TOPGEN]) == tg, bar);
            __builtin_amdgcn_fence(__ATOMIC_ACQUIRE, "agent");
            xb_add(&bar[XB_XGEN(b.x)], 1u);
            asm volatile("s_waitcnt vmcnt(0)" ::: "memory");
        } else {
            XB_SPIN(xb_ld(&bar[XB_XGEN(b.x)]) == gen, bar);
            __builtin_amdgcn_fence(__ATOMIC_ACQUIRE, "agent");
            asm volatile("s_waitcnt vmcnt(0)" ::: "memory");
        }
    }
    __syncthreads();
}

struct Fr {
    LAS unsigned char* lds;
    unsigned char* ws;
    const float* const* in;
    float* out;
    int tid, lane, wave, bx, G, gw, NGW;
};

using pg8::Unit;
template <int ACT  > struct EpiStore {
    static constexpr bool PERM = true;
    bf16* O; int ldc; int nvalid;
    DI void operator()(const f32x4 (&acc)[2][2][4][2], const Unit& u, int wr, int wc, int fr, int fq) const {
        const int row0 = u.pm * 256 + wr * 64 + fr, col0 = u.pn * 256 + wc * 32 + 8 * fq;
#pragma unroll
        for (int ai = 0; ai < 2; ++ai)
#pragma unroll
            for (int m = 0; m < 4; ++m) { bf16* rowp = O + (size_t)(row0 + ai * 128 + m * 16) * ldc + col0;
#pragma unroll
                for (int bj = 0; bj < 2; ++bj) { if (u.pn * 256 + bj * 128 >= nvalid) continue;
                    f32x4 v0 = acc[ai][bj][m][0], v1 = acc[ai][bj][m][1];
                    if (ACT == 1) {
#pragma unroll
                        for (int j = 0; j < 4; ++j) { v0[j] = 1.f - 2.f * __builtin_amdgcn_rcpf(1.f + __expf(2.f * v0[j])); v1[j] = 1.f - 2.f * __builtin_amdgcn_rcpf(1.f + __expf(2.f * v1[j])); } }
                    if (ACT == 2) {
#pragma unroll
                        for (int j = 0; j < 4; ++j) { v0[j] = sigmoidf_(v0[j]); v1[j] = sigmoidf_(v1[j]); } }
                    u32x4 w; w.x = pg8::cvt_pk_bf16(v0[0], v0[1]); w.y = pg8::cvt_pk_bf16(v0[2], v0[3]); w.z = pg8::cvt_pk_bf16(v1[0], v1[1]); w.w = pg8::cvt_pk_bf16(v1[2], v1[3]);
                    *(u32x4*)(rowp + bj * 128) = w; } }
    }
};
struct EpiStoreHead {
    static constexpr bool PERM = true;
    bf16* O; int TL; int lat_off;
    DI void operator()(const f32x4 (&acc)[2][2][4][2], const Unit& u, int wr, int wc, int fr, int fq) const {
        const bool lat = u.pm < 64; const int b = lat ? (u.pm >> 3) : (u.pm - 64); const int sbase = lat ? lat_off + (u.pm & 7) * 256 : 0;
        const int rt0 = sbase + wr * 64 + fr, j = (wc & 1) * 32 + 8 * fq;
#pragma unroll
        for (int ai = 0; ai < 2; ++ai)
#pragma unroll
            for (int m = 0; m < 4; ++m)
#pragma unroll
                for (int bj = 0; bj < 2; ++bj) { const int h = 4 * u.pn + 2 * bj + (wc >> 1);
                    const f32x4 v0 = acc[ai][bj][m][0], v1 = acc[ai][bj][m][1];
                    u32x4 w; w.x = pg8::cvt_pk_bf16(v0[0], v0[1]); w.y = pg8::cvt_pk_bf16(v0[2], v0[3]); w.z = pg8::cvt_pk_bf16(v1[0], v1[1]); w.w = pg8::cvt_pk_bf16(v1[2], v1[3]);
                    *(u32x4*)(O + ((size_t)(b * 16 + h) * TL + rt0 + ai * 128 + m * 16) * 64 + j) = w; }
    }
};
struct EpiResid {
    static constexpr bool PERM = false;
    const float* baseL; float* outL; const float* baseC; float* outC; const float* modg;
    DI void operator()(const f32x4 (&acc)[2][2][4][2], const Unit& u, int wr, int wc, int fr, int fq) const {
        const bool lat = u.pm < 64; const int r = lat ? (u.pm >> 3) : 8;
        const float* base = lat ? baseL : baseC; float* out = lat ? outL : outC;
        const int row0 = (lat ? u.pm : u.pm - 64) * 256 + wr * 64 + fr, col0 = u.pn * 256 + wc * 32 + 4 * fq;
        const float* mg = modg + (size_t)r * 6144 + col0;
        f32x4 mv[2][2];
#pragma unroll
        for (int bj = 0; bj < 2; ++bj)
#pragma unroll
            for (int n = 0; n < 2; ++n) mv[bj][n] = *(const f32x4*)(mg + bj * 128 + n * 16);
#pragma unroll
        for (int ai = 0; ai < 2; ++ai)
#pragma unroll
            for (int m = 0; m < 4; ++m) { const size_t off = (size_t)(row0 + ai * 128 + m * 16) * D + col0;
#pragma unroll
                for (int bj = 0; bj < 2; ++bj)
#pragma unroll
                    for (int n = 0; n < 2; ++n) { const f32x4 bs = *(const f32x4*)(base + off + bj * 128 + n * 16);
                        *(f32x4*)(out + off + bj * 128 + n * 16) = bs + mv[bj][n] * acc[ai][bj][m][n]; } }
    }
};
struct EpiSwiglu {
    static constexpr bool PERM = true;
    bf16* Hd; int ldh;
    DI void operator()(const f32x4 (&acc)[2][2][4][2], const Unit& u, int wr, int wc, int fr, int fq) const {
        const int row0 = u.pm * 256 + wr * 64 + fr, col0 = u.pn * 128 + wc * 32 + 8 * fq;
#pragma unroll
        for (int ai = 0; ai < 2; ++ai)
#pragma unroll
            for (int m = 0; m < 4; ++m) { bf16* rowp = Hd + (size_t)(row0 + ai * 128 + m * 16) * ldh + col0;
                f32x4 v0, v1;
#pragma unroll
                for (int j = 0; j < 4; ++j) { v0[j] = siluf_(acc[ai][0][m][0][j]) * acc[ai][1][m][0][j]; v1[j] = siluf_(acc[ai][0][m][1][j]) * acc[ai][1][m][1][j]; }
                u32x4 w; w.x = pg8::cvt_pk_bf16(v0[0], v0[1]); w.y = pg8::cvt_pk_bf16(v0[2], v0[3]); w.z = pg8::cvt_pk_bf16(v1[0], v1[1]); w.w = pg8::cvt_pk_bf16(v1[2], v1[3]);
                *(u32x4*)rowp = w; }
    }
};
struct EpiLora2 {
    static constexpr bool PERM = true;
    bf16* DEC; bf16* AG; const float* w0; const float* a0;
    DI void operator()(const f32x4 (&acc)[2][2][4][2], const Unit& u, int wr, int wc, int fr, int fq) const {
        const int q = u.pn >> 2, z = q & 1; const int col0 = (u.pn & 3) * 256 + wc * 32 + 8 * fq;
        const bool lat = u.pm < 64; const int b = lat ? (u.pm >> 3) : (u.pm - 64); const int rt0 = (lat ? CTXL + (u.pm & 7) * 256 : 0) + wr * 64 + fr, j = (wc & 1) * 32 + 8 * fq;
        const float* bias = (q < 2 ? w0 : a0) + z * 1024 + col0;
        f32x4 bv[2][2];
#pragma unroll
        for (int bj = 0; bj < 2; ++bj)
#pragma unroll
            for (int n = 0; n < 2; ++n) bv[bj][n] = *(const f32x4*)(bias + bj * 128 + 4 * n);
#pragma unroll
        for (int ai = 0; ai < 2; ++ai)
#pragma unroll
            for (int m = 0; m < 4; ++m) {
#pragma unroll
                for (int bj = 0; bj < 2; ++bj) { f32x4 v0 = acc[ai][bj][m][0] + bv[bj][0], v1 = acc[ai][bj][m][1] + bv[bj][1];
                    const int h = 4 * (u.pn & 3) + 2 * bj + (wc >> 1);
                    const size_t off = ((size_t)(z * 128 + b * 16 + h) * (SEQ + CTXL) + rt0 + ai * 128 + m * 16) * 64 + j;
                    if (q < 2) {
#pragma unroll
                        for (int jj = 0; jj < 4; ++jj) {
                            v0[jj] = -0.6065306597126334f * sigmoidf_(v0[jj]); v1[jj] = -0.6065306597126334f * sigmoidf_(v1[jj]); }
                        u32x4 w; w.x = pg8::cvt_pk_bf16(v0[0], v0[1]); w.y = pg8::cvt_pk_bf16(v0[2], v0[3]); w.z = pg8::cvt_pk_bf16(v1[0], v1[1]); w.w = pg8::cvt_pk_bf16(v1[2], v1[3]);
                        *(u32x4*)(DEC + off) = w; __builtin_amdgcn_sched_barrier(0);
                    } else {
#pragma unroll
                        for (int jj = 0; jj < 4; ++jj) { v0[jj] = sigmoidf_(v0[jj]); v1[jj] = sigmoidf_(v1[jj]); }
                        u32x4 w; w.x = pg8::cvt_pk_bf16(v0[0], v0[1]); w.y = pg8::cvt_pk_bf16(v0[2], v0[3]); w.z = pg8::cvt_pk_bf16(v1[0], v1[1]); w.w = pg8::cvt_pk_bf16(v1[2], v1[3]);
                        *(u32x4*)(AG + off) = w; __builtin_amdgcn_sched_barrier(0); } } }
    }
};
struct EpiMoeOut {
    static constexpr bool PERM = true;
    bf16* YS; const int* RowTok; const float* RowW;
    DI void operator()(const f32x4 (&acc)[2][2][4][2], const Unit& u, int wr, int wc, int fr, int fq) const {
        const int row0 = u.pm * 256 + wr * 64 + fr, col0 = u.pn * 256 + wc * 32 + 8 * fq;
#pragma unroll
        for (int ai = 0; ai < 2; ++ai)
#pragma unroll
            for (int m = 0; m < 4; ++m) { const int row = row0 + ai * 128 + m * 16; const int t2 = RowTok[row]; if (t2 < 0) continue; const float w = RowW[row];
                bf16* rowp = YS + (size_t)t2 * D + col0;
#pragma unroll
                for (int bj = 0; bj < 2; ++bj) { const f32x4 v0 = acc[ai][bj][m][0] * w, v1 = acc[ai][bj][m][1] * w;
                    u32x4 o; o.x = pg8::cvt_pk_bf16(v0[0], v0[1]); o.y = pg8::cvt_pk_bf16(v0[2], v0[3]); o.z = pg8::cvt_pk_bf16(v1[0], v1[1]); o.w = pg8::cvt_pk_bf16(v1[2], v1[3]);
                    *(u32x4*)(rowp + bj * 128) = o; } }
    }
};

DI void tr_item(const float* src, int ldsrc, int Kreal, int k0, int n0, bf16* dst, int lddst, int drow0, int dcol0, LAS float* scr, int lane) {
#pragma unroll 8
    for (int i = 0; i < 32; ++i) { const int kk = 2 * i + (lane >> 5), k = k0 + kk; float v = 0.f; if (k < Kreal) v = src[(size_t)k * ldsrc + n0 + (lane & 31)]; scr[kk * 33 + (lane & 31)] = v; }
    LDS_WAIT();
    const int c = lane & 7;
#pragma unroll
    for (int j = 0; j < 4; ++j) { const int n = (lane >> 3) + 8 * j; const LAS float* s = scr + (8 * c) * 33 + n;
        u32x4 o; o.x = pk2(s[0 * 33], s[1 * 33]); o.y = pk2(s[2 * 33], s[3 * 33]); o.z = pk2(s[4 * 33], s[5 * 33]); o.w = pk2(s[6 * 33], s[7 * 33]);
        *(u32x4*)(dst + (size_t)(drow0 + n) * lddst + dcol0 + k0 + 8 * c) = o; }
    LDS_WAIT();
}
DI void tr_plain(const float* src, int K, int N, bf16* dst, int r, LAS float* scr, int lane) {
    const int nblk = N / 32, kb = r / nblk, nb = r % nblk; tr_item(src, N, K, 64 * kb, 32 * nb, dst, K, 32 * nb, 0, scr, lane);
}
DI void tr_gateup(const float* src, int K, int Hh, bf16* dst, int r, LAS float* scr, int lane) {
    const int nblk = 2 * Hh / 32, kb = r / nblk, nb = r % nblk, n0 = 32 * nb, half = n0 / Hh, j0 = n0 % Hh;
    tr_item(src, 2 * Hh, K, 64 * kb, n0, dst, K, (j0 / 128) * 256 + half * 128 + (j0 % 128), 0, scr, lane);
}
DI void tr16_item(const float* src, int ldsrc, int k0, int n0, bf16* dst, int lddst, int Hh, int lane) {
    f32x4 v[16];
#pragma unroll
    for (int kk = 0; kk < 16; ++kk) v[kk] = *(const f32x4*)(src + (size_t)(k0 + kk) * ldsrc + n0 + 4 * lane);
    const int n = n0 + 4 * lane; int drow = n;
    if (Hh) { const int half = n / Hh, j = n % Hh; drow = (j / 128) * 256 + half * 128 + (j % 128); }
#pragma unroll
    for (int q = 0; q < 4; ++q) { u32x4 o0, o1;
        o0.x = pk2(v[0][q], v[1][q]); o0.y = pk2(v[2][q], v[3][q]); o0.z = pk2(v[4][q], v[5][q]); o0.w = pk2(v[6][q], v[7][q]);
        o1.x = pk2(v[8][q], v[9][q]); o1.y = pk2(v[10][q], v[11][q]); o1.z = pk2(v[12][q], v[13][q]); o1.w = pk2(v[14][q], v[15][q]);
        bf16* d = dst + (size_t)(drow + q) * lddst + k0; *(u32x4*)d = o0; *(u32x4*)(d + 8) = o1; }
}
DI void tr64_item(const float* src, int ldsrc, int k0, int n0, bf16* dst, int lddst, int Hh, int lane) {
    float v[64];
    const float* sp = src + (size_t)k0 * ldsrc + n0 + lane;
#pragma unroll
    for (int kk = 0; kk < 64; ++kk) v[kk] = sp[(size_t)kk * ldsrc];
    const int n = n0 + lane; int drow = n;
    if (Hh) { const int half = n / Hh, j = n % Hh; drow = (j / 128) * 256 + half * 128 + (j % 128); }
    bf16* d = dst + (size_t)drow * lddst + k0;
#pragma unroll
    for (int c = 0; c < 8; ++c) { u32x4 o; o.x = pk2(v[8 * c], v[8 * c + 1]); o.y = pk2(v[8 * c + 2], v[8 * c + 3]); o.z = pk2(v[8 * c + 4], v[8 * c + 5]); o.w = pk2(v[8 * c + 6], v[8 * c + 7]);
        *(u32x4*)(d + 8 * c) = o; }
}
DI void tr16_mat(const float* src, int K, int N, bf16* dst, int Hh, int r, int lane) { const int nb = N / 64; tr64_item(src, N, 64 * (r / nb), 64 * (r % nb), dst, K, Hh, lane); }
struct TrItem { const float* src; bf16* dst; int ldsrc, lddst, k0, n0, Hh; };
DI void tr_wg_load(const TrItem& t, f32x4 (&v)[8], int wave, int lane) {
    const float* sp = t.src + (size_t)(t.k0 + 8 * wave) * t.ldsrc + t.n0 + 4 * lane;
#pragma unroll
    for (int kk = 0; kk < 8; ++kk) v[kk] = *(const f32x4*)(sp + (size_t)kk * t.ldsrc);
}
DI void tr_wg_to_lds(const f32x4 (&v)[8], LAS bf16* img, int wave, int lane) {
#pragma unroll
    for (int q = 0; q < 4; ++q) { u32x4 o; o.x = pk2(v[0][q], v[1][q]); o.y = pk2(v[2][q], v[3][q]); o.z = pk2(v[4][q], v[5][q]); o.w = pk2(v[6][q], v[7][q]);
        *(LAS u32x4*)(img + (4 * lane + q) * 72 + 8 * wave) = o; }
}
DI void tr_wg_store(const TrItem& t, const LAS bf16* img, int wave, int lane) {
    const int row = 32 * wave + (lane >> 1), half = lane & 1, n = t.n0 + row; int drow = n;
    if (t.Hh) { const int hf = n / t.Hh, j = n % t.Hh; drow = (j / 128) * 256 + hf * 128 + (j % 128); }
    bf16* d = t.dst + (size_t)drow * t.lddst + t.k0 + 32 * half;
#pragma unroll
    for (int i = 0; i < 4; ++i) *(u32x4*)(d + 8 * i) = *(const LAS u32x4*)(img + row * 72 + 32 * half + 8 * i);
}
constexpr int WG_M13 = 16 * 28, WG_M2 = 56 * 4, WG_MOE = 8 * WG_M13 + 8 * WG_M2;
constexpr int WG_IN = 16 * 14, WG_OUT = 16 * 4, WG_13 = 16 * 22, WG_2 = 44 * 4, WG_RKV = 64, WG_O = 64, WG_DENSE = WG_IN + WG_OUT + WG_13 + WG_2 + 3 * WG_RKV + WG_O;
DI TrItem tr_mat_item(const float* src, int K, int N, bf16* dst, int Hh, int r) { const int nb = N / 256; return TrItem{src, dst, N, K, 64 * (r / nb), 256 * (r % nb), Hh}; }
DI TrItem moe_item(Fr& F, int r) {
    bf16* W_M13 = (bf16*)(F.ws + WS_W_M13); bf16* W_M2 = (bf16*)(F.ws + WS_W_M2);
    if (r < 8 * WG_M13) { const int e = r / WG_M13; return tr_mat_item(F.in[35] + (size_t)e * 1024 * 7168, 1024, 7168, W_M13 + (size_t)e * 7168 * 1024, EXP_H, r % WG_M13); }
    const int r2 = r - 8 * WG_M13, e = r2 / WG_M2; return tr_mat_item(F.in[36] + (size_t)e * EXP_H * 1024, EXP_H, 1024, W_M2 + (size_t)e * 1024 * EXP_H, 0, r2 % WG_M2);
}
DI TrItem dense_item(Fr& F, int r) {
    const float* const* in = F.in;
    if (r < WG_IN) return tr_mat_item(in[8], 1024, INW, (bf16*)(F.ws + WS_W_IN), 0, r); r -= WG_IN;
    if (r < WG_OUT) return tr_mat_item(in[15], 1024, 1024, (bf16*)(F.ws + WS_W_OUT), 0, r); r -= WG_OUT;
    if (r < WG_13) return tr_mat_item(in[16], 1024, 2 * FFN_H, (bf16*)(F.ws + WS_W_13), FFN_H, r); r -= WG_13;
    if (r < WG_2) return tr_mat_item(in[17], FFN_H, 1024, (bf16*)(F.ws + WS_W_2), 0, r); r -= WG_2;
    if (r < 3 * WG_RKV) { const int sx = r / WG_RKV; return tr_mat_item(in[19] + (size_t)sx * 1024 * 1024, 1024, 1024, (bf16*)(F.ws + WS_W_RKV) + (size_t)sx * 1024 * 1024, 0, r % WG_RKV); } r -= 3 * WG_RKV;
    return tr_mat_item(in[33], 1024, 1024, (bf16*)(F.ws + WS_W_O), 0, r);
}
template <int L> DI void tr_wg_run(Fr& F, int first, int stride, int end) {
    if (first >= end) return;
    LAS bf16* img0 = (LAS bf16*)F.lds; LAS bf16* img1 = img0 + 256 * 72;
    f32x4 v[8]; TrItem cur = L ? moe_item(F, first) : dense_item(F, first);
    tr_wg_load(cur, v, F.wave, F.lane);
    int par = 0;
    for (int r = first; r < end; r += stride, par ^= 1) {
        LAS bf16* img = par ? img1 : img0;
        tr_wg_to_lds(v, img, F.wave, F.lane);
        TrItem nxt = cur; const bool more = r + stride < end;
        if (more) { nxt = L ? moe_item(F, r + stride) : dense_item(F, r + stride); tr_wg_load(nxt, v, F.wave, F.lane); }
        LDS_BARRIER();
        tr_wg_store(cur, img, F.wave, F.lane);
        cur = nxt;
    }
    LDS_BARRIER();
}
constexpr int MOE_ITEMS = WG_MOE;
constexpr int FILL_A = 0, FILL_B = 0, FILL_C = 0;
DI void moe_fill(Fr& F, int slot, int nslots, int i0, int i1) {
    if (slot < 0 || slot >= nslots) return;
    tr_wg_run<1>(F, i0 + slot, nslots, i1);
}
DI void p0_prologue(Fr& F) {
    LAS float* scr = (LAS float*)(F.lds + F.wave * 16384);
    const float* const* in = F.in;
    bf16* W_IN = (bf16*)(F.ws + WS_W_IN); bf16* W_OUT = (bf16*)(F.ws + WS_W_OUT); bf16* W_13 = (bf16*)(F.ws + WS_W_13); bf16* W_2 = (bf16*)(F.ws + WS_W_2);
    bf16* W_RKV = (bf16*)(F.ws + WS_W_RKV); bf16* W_L1 = (bf16*)(F.ws + WS_W_L1); bf16* W_L2 = (bf16*)(F.ws + WS_W_L2); bf16* W_G2 = (bf16*)(F.ws + WS_W_G2);
    bf16* W_O = (bf16*)(F.ws + WS_W_O);
    tr_wg_run<0>(F, F.bx, F.G, WG_DENSE);
    moe_fill(F, F.bx, F.G, FILL_C, MOE_ITEMS);
    constexpr int I_W1 = 2 * 32, I_A1 = 2 * 32, I_G1 = 16 * 5, I_L2 = 4 * 32, I_G2 = 4 * 32;
    constexpr int NITEMS = I_W1 + I_A1 + I_G1 + I_L2 + I_G2;
    for (int it = F.gw; it < NITEMS; it += F.NGW) {
        int r = it;
        if (r < I_W1) { const int z = r / 32, rr = r % 32; tr_item(in[21] + (size_t)z * 1024 * 64, 64, 1024, 64 * (rr / 2), 32 * (rr % 2), W_L1, 1024, z * 64 + 32 * (rr % 2), 0, scr, F.lane); continue; } r -= I_W1;
        if (r < I_A1) { const int z = r / 32, rr = r % 32; tr_item(in[24] + (size_t)z * 1024 * 64, 64, 1024, 64 * (rr / 2), 32 * (rr % 2), W_L1 + 256 * 1024, 1024, z * 64 + 32 * (rr % 2), 0, scr, F.lane); continue; } r -= I_A1;
        if (r < I_G1) { tr_item(in[26], 160, 1024, 64 * (r / 5), 32 * (r % 5), W_L1 + 2 * 256 * 1024, 1024, 32 * (r % 5), 0, scr, F.lane); continue; } r -= I_G1;
        if (r < I_L2) { const int q = r / 32, nb = r % 32; const float* src = (q < 2 ? in[22] : in[25]) + (size_t)(q & 1) * 64 * 1024;
            for (int i = F.lane; i < 32 * 24; i += 64) { const int row = i / 24, ch = i % 24; const int col = 8 * ch + (8 * ch >= q * 64 ? 64 : 0);
                *(u32x4*)(W_L2 + (size_t)(q * 1024 + 32 * nb + row) * 256 + col) = (u32x4){0u, 0u, 0u, 0u}; }
            tr_item(src, 1024, 64, 0, 32 * nb, W_L2, 256, q * 1024 + 32 * nb, q * 64, scr, F.lane); continue; } r -= I_L2;
        tr_item(in[27], 1024, 160, 64 * (r / 32), 32 * (r % 32), W_G2, 256, 32 * (r % 32), 0, scr, F.lane);
    }
    { const int gt = F.bx * NTHR + F.tid, NT = F.G * NTHR;
      for (int i = gt; i < (128 + 128 + 96) * 128; i += NT) { int row = i / 128; const int ch = i % 128; int mat = 0;
          if (row >= 256) { mat = 2; row = row - 256 + 160; } else if (row >= 128) { mat = 1; } else { row += 128; }
          *(u32x4*)(W_L1 + ((size_t)mat * 256 + row) * 1024 + 8 * ch) = (u32x4){0u, 0u, 0u, 0u}; }
      f32x2* rope = (f32x2*)(F.ws + WS_ROPE);
      for (int i = gt; i < 2048; i += NT) { const int pos = i >> 5, j = i & 31; const float fr = powf(10000.f, -(float)j / 32.f), ang = (float)pos * fr; rope[i] = (f32x2){cosf(ang), sinf(ang)}; }
    }
    WG_SYNC();
    for (int prep_ = 0; prep_ < ((((PROBE_DUP) >> 23) & 1u) ? 2 : 1); ++prep_)
    for (int u = F.bx; u < 192; u += F.G) {
        const int li = u / 96, n0 = (u % 96) * 64;
        LAS float* sm = (LAS float*)F.lds;
        for (int idx = F.tid; idx < 9 * 1024; idx += NTHR) { const int r = idx >> 10, k = idx & 1023; const float cv = (r < 8) ? in[1][r * 1024 + k] : in[3][k]; sm[idx] = cv / (1.f + expf(-cv)); }
        WG_SYNC();
        const int ks = F.tid >> 4, cg4 = F.tid & 15;
        f32x4 acc[9];
#pragma unroll
        for (int r = 0; r < 9; ++r) acc[r] = (f32x4){0.f, 0.f, 0.f, 0.f};
        const float* w = in[4] + (size_t)li * 1024 * 6144 + n0 + 4 * cg4;
#pragma unroll 8
        for (int k = ks * 32; k < ks * 32 + 32; ++k) { const f32x4 wv = *(const f32x4*)(w + (size_t)k * 6144);
#pragma unroll
            for (int r = 0; r < 9; ++r) acc[r] += wv * sm[r * 1024 + k]; }
        LAS float* red = sm + 9 * 1024;
#pragma unroll
        for (int r = 0; r < 9; ++r) *(LAS f32x4*)(red + (ks * 9 + r) * 64 + 4 * cg4) = acc[r];
        WG_SYNC();
        float* MOD = (float*)(F.ws + WS_MOD);
        for (int idx = F.tid; idx < 9 * 64; idx += NTHR) { const int r = idx / 64, n2 = idx % 64; float s = 0.f;
#pragma unroll
            for (int q = 0; q < 32; ++q) s += red[(q * 9 + r) * 64 + n2];
            MOD[((size_t)li * 9 + r) * 6144 + n0 + n2] = s + in[5][li * 6144 + n0 + n2]; }
        WG_SYNC();
    }
}

DI void mod_rows(Fr& F, const float* xl, const float* xc, int nrows, const float* normw, const float* modl, int off_shift, int off_scale, bf16* H) {
    for (int g = F.gw; g < nrows / 4; g += F.NGW) {
        const int row0 = 4 * g;
        const float* src = row0 < ML ? xl + (size_t)row0 * D : xc + (size_t)(row0 - ML) * D;
        const float* mrow = modl + (size_t)(row0 < ML ? row0 / SEQ : 8) * 6144;
        f32x4 v[4][4];
#pragma unroll
        for (int r = 0; r < 4; ++r)
#pragma unroll
            for (int j = 0; j < 4; ++j) v[r][j] = ((const f32x4*)(src + (size_t)r * D))[F.lane + 64 * j];
        f32x4 gsc[4], gsh[4];
#pragma unroll
        for (int j = 0; j < 4; ++j) { const int c4 = F.lane + 64 * j; gsc[j] = ((const f32x4*)normw)[c4] * (((const f32x4*)(mrow + off_scale))[c4] + 1.f); gsh[j] = ((const f32x4*)(mrow + off_shift))[c4]; }
#pragma unroll
        for (int r = 0; r < 4; ++r) { float ss = 0.f;
#pragma unroll
            for (int j = 0; j < 4; ++j) ss += (v[r][j].x * v[r][j].x + v[r][j].y * v[r][j].y) + (v[r][j].z * v[r][j].z + v[r][j].w * v[r][j].w);
            const float rstd = rsqrtf(wave_sum_fast(ss) * (1.f / D) + 1e-6f);
            u32x2* o = (u32x2*)(H + (size_t)(row0 + r) * D);
#pragma unroll
            for (int j = 0; j < 4; ++j) { const f32x4 y = v[r][j] * rstd * gsc[j] + gsh[j]; u32x2 p; p.x = pk2(y.x, y.y); p.y = pk2(y.z, y.w); o[F.lane + 64 * j] = p; } }
    }
}

DI void load_rope_pair(const bf16* rowp, int hh, int jj, bool lat, int rpos, int cpos, const f32x2* rope, float scl, float (&x1)[8], float (&x2)[8]) {
    const u32x4 a = *(const u32x4*)(rowp + hh * 64 + jj), b = *(const u32x4*)(rowp + hh * 64 + jj + 32);
    const unsigned aw[4] = {a.x, a.y, a.z, a.w}, bw[4] = {b.x, b.y, b.z, b.w};
#pragma unroll
    for (int i = 0; i < 4; ++i) { x1[2 * i] = bflo(aw[i]); x1[2 * i + 1] = bfhi(aw[i]); x2[2 * i] = bflo(bw[i]); x2[2 * i + 1] = bfhi(bw[i]); }
    if (lat) { const int pos = hh ? cpos : rpos;
#pragma unroll
        for (int i = 0; i < 8; ++i) { const f32x2 cs = rope[pos * 32 + jj + i]; const float y1 = x1[i] * cs.x - x2[i] * cs.y, y2 = x1[i] * cs.y + x2[i] * cs.x; x1[i] = y1; x2[i] = y2; } }
#pragma unroll
    for (int i = 0; i < 8; ++i) { x1[i] *= scl; x2[i] *= scl; }
}
DI u32x4 pack8(const float (&x)[8], float s) { u32x4 o; o.x = pk2(x[0] * s, x[1] * s); o.y = pk2(x[2] * s, x[3] * s); o.z = pk2(x[4] * s, x[5] * s); o.w = pk2(x[6] * s, x[7] * s); return o; }
constexpr int RLD = 136;
constexpr int RTILE = 128 * RLD * 2;
DI int ret_row0(int b, int id) { return id < 2 ? ML + b * CTXL + id * 128 : b * SEQ + (id - 2) * 128; }

DI void ret_kv_phase(Fr& F) {
    const bf16* QKV = (const bf16*)(F.ws + WS_QKV); float* KV = (float*)(F.ws + WS_KV); const f32x2* rope = (const f32x2*)(F.ws + WS_ROPE);
    LAS bf16* Vs = (LAS bf16*)F.lds; LAS bf16* Kf = (LAS bf16*)(F.lds + RTILE); LAS bf16* Kb = (LAS bf16*)(F.lds + 2 * RTILE);
    const int wr2 = F.wave >> 1, wc2 = F.wave & 1, fr = F.lane & 15, fq = F.lane >> 4;
    for (int u = F.bx; u < NB * 4 * NCH; u += F.G) {
        const int b = u / (4 * NCH), h = (u / NCH) % 4, id = u % NCH; const int grow0 = ret_row0(b, id); const bool lat = id >= 2;
        const float lgf = -expf(F.in[9][h]), lgb = -expf(F.in[10][h]);
        for (int it = F.tid; it < 128 * 16; it += NTHR) { const int c = it >> 4, ch = it & 15;
            *(LAS u32x4*)(Vs + c * RLD + 8 * ch) = *(const u32x4*)(QKV + (size_t)(grow0 + c) * INW + 1024 + h * 128 + 8 * ch); }
        for (int it = F.tid; it < 128 * 8; it += NTHR) { const int c = it >> 3, pi = it & 7, hh = pi >> 2, jj = (pi & 3) * 8; const int t = (id - 2) * 128 + c;
            float x1[8], x2[8]; load_rope_pair(QKV + (size_t)(grow0 + c) * INW + 512 + h * 128, hh, jj, lat, t >> 6, t & 63, rope, 0.08838834764831845f, x1, x2);
            const float wf = __expf(lgf * (float)(127 - c)), wb = __expf(lgb * (float)c);
            *(LAS u32x4*)(Kf + c * RLD + hh * 64 + jj) = pack8(x1, wf); *(LAS u32x4*)(Kf + c * RLD + hh * 64 + jj + 32) = pack8(x2, wf);
            *(LAS u32x4*)(Kb + c * RLD + hh * 64 + jj) = pack8(x1, wb); *(LAS u32x4*)(Kb + c * RLD + hh * 64 + jj + 32) = pack8(x2, wb); }
        LDS_BARRIER();
#pragma unroll
        for (int dir = 0; dir < 2; ++dir) {
            const LAS bf16* Kd = dir ? Kb : Kf;
            f32x4 acc[2][4];
#pragma unroll
            for (int i = 0; i < 2; ++i)
#pragma unroll
                for (int j = 0; j < 4; ++j) acc[i][j] = (f32x4){0.f, 0.f, 0.f, 0.f};
#pragma unroll 1
            for (int k0 = 0; k0 < 128; k0 += 32) { bf16x8 af[2], bfg[4];
#pragma unroll
                for (int i = 0; i < 2; ++i) af[i] = frag_kr(Vs, RLD, 32 * wr2 + 16 * i, k0, F.lane);
#pragma unroll
                for (int j = 0; j < 4; ++j) bfg[j] = frag_kr(Kd, RLD, 64 * wc2 + 16 * j, k0, F.lane);
#pragma unroll
                for (int i = 0; i < 2; ++i)
#pragma unroll
                    for (int j = 0; j < 4; ++j) acc[i][j] = mma(acc[i][j], bfg[j], af[i]); }
            float* o = KV + ((size_t)((b * 4 + h) * 2 + dir) * NCH + id) * 16384;
#pragma unroll
            for (int i = 0; i < 2; ++i)
#pragma unroll
                for (int j = 0; j < 4; ++j) *(f32x4*)(o + (32 * wr2 + 16 * i + fr) * 128 + 64 * wc2 + 16 * j + 4 * fq) = acc[i][j];
        }
        LDS_BARRIER();
    }
}
DI void ret_prefix_phase(Fr& F) {
    const float* KV = (const float*)(F.ws + WS_KV); bf16* SP = (bf16*)(F.ws + WS_SPREV);
    const int gt = F.bx * NTHR + F.tid, NT = F.G * NTHR;
    for (int i = gt; i < 64 * 4096; i += NT) { const int bhd = i >> 12, e4 = i & 4095, dir = bhd & 1, h = (bhd >> 1) & 3;
        const float lg = -expf(dir ? F.in[10][h] : F.in[9][h]), cd = expf(lg * 128.f);
        f32x4 s = (f32x4){0.f, 0.f, 0.f, 0.f};
        for (int st = 0; st < NCH; ++st) { const int id = dir ? (st == 0 ? 1 : (st == 1 ? 0 : 19 - st)) : st;
            const size_t off = ((size_t)bhd * NCH + id) * 16384 + 4 * e4;
            u32x2 p; p.x = pk2(s.x, s.y); p.y = pk2(s.z, s.w); *(u32x2*)(SP + off) = p;
            s = s * cd + *(const f32x4*)(KV + off); }
    }
}
DI void ret_out_phase(Fr& F) {
    const bf16* QKV = (const bf16*)(F.ws + WS_QKV); const bf16* SP = (const bf16*)(F.ws + WS_SPREV); bf16* MIX = (bf16*)(F.ws + WS_MIX); const f32x2* rope = (const f32x2*)(F.ws + WS_ROPE);
    LAS bf16* Qs = (LAS bf16*)F.lds; LAS bf16* KP = (LAS bf16*)(F.lds + RTILE); LAS bf16* Vs = (LAS bf16*)(F.lds + 2 * RTILE); LAS bf16* Sf = (LAS bf16*)(F.lds + 3 * RTILE);
    LAS float* red = (LAS float*)(F.lds + 4 * RTILE);
    const int wr2 = F.wave >> 1, wc2 = F.wave & 1, fr = F.lane & 15, fq = F.lane >> 4;
    for (int u = F.bx; u < NB * 4 * NCH; u += F.G) {
        const int b = u / (4 * NCH), h = (u / NCH) % 4, id = u % NCH; const int grow0 = ret_row0(b, id); const bool lat = id >= 2;
        const float lgf = -expf(F.in[9][h]), lgb = -expf(F.in[10][h]);
        const bf16* spf = SP + ((size_t)((b * 4 + h) * 2 + 0) * NCH + id) * 16384; const bf16* spb = SP + ((size_t)((b * 4 + h) * 2 + 1) * NCH + id) * 16384;
        for (int it = F.tid; it < 128 * 16; it += NTHR) { const int c = it >> 4, ch = it & 15;
            *(LAS u32x4*)(Vs + c * RLD + 8 * ch) = *(const u32x4*)(QKV + (size_t)(grow0 + c) * INW + 1024 + h * 128 + 8 * ch);
            *(LAS u32x4*)(Sf + c * RLD + 8 * ch) = *(const u32x4*)(spf + c * 128 + 8 * ch); }
        for (int it = F.tid; it < 128 * 8; it += NTHR) { const int c = it >> 3, pi = it & 7, hh = pi >> 2, jj = (pi & 3) * 8; const int t = (id - 2) * 128 + c;
            float x1[8], x2[8];
            load_rope_pair(QKV + (size_t)(grow0 + c) * INW + h * 128, hh, jj, lat, t >> 6, t & 63, rope, 1.f, x1, x2);
            *(LAS u32x4*)(Qs + c * RLD + hh * 64 + jj) = pack8(x1, 1.f); *(LAS u32x4*)(Qs + c * RLD + hh * 64 + jj + 32) = pack8(x2, 1.f);
            load_rope_pair(QKV + (size_t)(grow0 + c) * INW + 512 + h * 128, hh, jj, lat, t >> 6, t & 63, rope, 0.08838834764831845f, x1, x2);
            *(LAS u32x4*)(KP + c * RLD + hh * 64 + jj) = pack8(x1, 1.f); *(LAS u32x4*)(KP + c * RLD + hh * 64 + jj + 32) = pack8(x2, 1.f); }
        LDS_BARRIER();
        f32x4 sacc[2][4], facc[2][4];
#pragma unroll
        for (int i = 0; i < 2; ++i)
#pragma unroll
            for (int j = 0; j < 4; ++j) { sacc[i][j] = (f32x4){0.f, 0.f, 0.f, 0.f}; facc[i][j] = (f32x4){0.f, 0.f, 0.f, 0.f}; }
#pragma unroll 1
        for (int k0 = 0; k0 < 128; k0 += 32) { bf16x8 af[2], bk[4], bs[4];
#pragma unroll
            for (int i = 0; i < 2; ++i) af[i] = frag_kc(Qs, RLD, 32 * wr2 + 16 * i, k0, F.lane);
#pragma unroll
            for (int j = 0; j < 4; ++j) { bk[j] = frag_kc(KP, RLD, 64 * wc2 + 16 * j, k0, F.lane); bs[j] = frag_kc(Sf, RLD, 64 * wc2 + 16 * j, k0, F.lane); }
#pragma unroll
            for (int i = 0; i < 2; ++i)
#pragma unroll
                for (int j = 0; j < 4; ++j) { sacc[i][j] = mma(sacc[i][j], bk[j], af[i]); facc[i][j] = mma(facc[i][j], bs[j], af[i]); } }
        LDS_BARRIER();
        { const float lf2 = lgf * 1.4426950408889634f, lb2 = lgb * 1.4426950408889634f;
#pragma unroll
          for (int i = 0; i < 2; ++i)
#pragma unroll
            for (int j = 0; j < 4; ++j) { const int c = 32 * wr2 + 16 * i + fr, s0 = 64 * wc2 + 16 * j + 4 * fq; float pv[4];
#pragma unroll
                for (int r = 0; r < 4; ++r) { const int df = c - (s0 + r); const float wgt = df > 0 ? exp2f(lf2 * (float)df) : (df < 0 ? exp2f(lb2 * (float)(-df)) : 2.f); pv[r] = sacc[i][j][r] * wgt; }
                u32x2 p; p.x = pk2(pv[0], pv[1]); p.y = pk2(pv[2], pv[3]); *(LAS u32x2*)(KP + c * RLD + s0) = p; }
          for (int it = F.tid; it < 128 * 16; it += NTHR) { const int c = it >> 4, ch = it & 15; *(LAS u32x4*)(Sf + c * RLD + 8 * ch) = *(const u32x4*)(spb + c * 128 + 8 * ch); }
        }
        LDS_BARRIER();
        f32x4 oacc[2][4], bacc[2][4];
#pragma unroll
        for (int i = 0; i < 2; ++i) { const float qdf = __expf(lgf * (float)(32 * wr2 + 16 * i + fr + 1));
#pragma unroll
            for (int j = 0; j < 4; ++j) { oacc[i][j] = facc[i][j] * qdf; bacc[i][j] = (f32x4){0.f, 0.f, 0.f, 0.f}; } }
#pragma unroll 1
        for (int k0 = 0; k0 < 128; k0 += 32) { bf16x8 ap[2], aq[2], bv[4], bs[4];
#pragma unroll
            for (int i = 0; i < 2; ++i) { ap[i] = frag_kc(KP, RLD, 32 * wr2 + 16 * i, k0, F.lane); aq[i] = frag_kc(Qs, RLD, 32 * wr2 + 16 * i, k0, F.lane); }
#pragma unroll
            for (int j = 0; j < 4; ++j) { bv[j] = frag_kr(Vs, RLD, 64 * wc2 + 16 * j, k0, F.lane); bs[j] = frag_kc(Sf, RLD, 64 * wc2 + 16 * j, k0, F.lane); }
#pragma unroll
            for (int i = 0; i < 2; ++i)
#pragma unroll
                for (int j = 0; j < 4; ++j) { oacc[i][j] = mma(oacc[i][j], bv[j], ap[i]); bacc[i][j] = mma(bacc[i][j], bs[j], aq[i]); } }
        float rs[2], rq[2];
#pragma unroll
        for (int i = 0; i < 2; ++i) { const int c = 32 * wr2 + 16 * i + fr; const float qdb = __expf(lgb * (float)(128 - c)); float s = 0.f, q = 0.f;
#pragma unroll
            for (int j = 0; j < 4; ++j) { oacc[i][j] = oacc[i][j] + bacc[i][j] * qdb;
#pragma unroll
                for (int r = 0; r < 4; ++r) { s += oacc[i][j][r]; q += oacc[i][j][r] * oacc[i][j][r]; } }
            s += __shfl_xor(s, 16); s += __shfl_xor(s, 32); q += __shfl_xor(q, 16); q += __shfl_xor(q, 32);
            if (fq == 0) { red[(c * 2 + wc2) * 2 + 0] = s; red[(c * 2 + wc2) * 2 + 1] = q; }
            rs[i] = s; rq[i] = q; }
        LDS_BARRIER();
#pragma unroll
        for (int i = 0; i < 2; ++i) { const int c = 32 * wr2 + 16 * i + fr;
            const float s = red[(c * 2 + 0) * 2 + 0] + red[(c * 2 + 1) * 2 + 0], q = red[(c * 2 + 0) * 2 + 1] + red[(c * 2 + 1) * 2 + 1];
            const float mean = s * (1.f / 128.f), var = fmaxf(q * (1.f / 128.f) - mean * mean, 0.f), rstd = rsqrtf(var + 1e-5f);
            const size_t grow = (size_t)(grow0 + c);
#pragma unroll
            for (int j = 0; j < 4; ++j) { const int e0 = 64 * wc2 + 16 * j + 4 * fq;
                const f32x4 gw = *(const f32x4*)(F.in[11] + h * 128 + e0); const u32x2 gg = *(const u32x2*)(QKV + grow * INW + 1536 + h * 128 + e0);
                const float g0 = bflo(gg.x), g1 = bfhi(gg.x), g2 = bflo(gg.y), g3 = bfhi(gg.y);
                const f32x4 y = (oacc[i][j] - mean) * rstd * gw;
                u32x2 p; p.x = pk2(y.x * siluf_(g0), y.y * siluf_(g1)); p.y = pk2(y.z * siluf_(g2), y.w * siluf_(g3));
                *(u32x2*)(MIX + grow * D + h * 128 + e0) = p; } }
        (void)rs; (void)rq;
        LDS_BARRIER();
    }
}

DI void na_norm_rows(Fr& F) {
    const bf16* QKV = (const bf16*)(F.ws + WS_QKV); bf16* NQ = (bf16*)(F.ws + WS_NQ); bf16* NK = (bf16*)(F.ws + WS_NK); bf16* NV = (bf16*)(F.ws + WS_NV);
    const bool isk = F.lane >= 32; const float* wsrc = (isk ? F.in[13] : F.in[12]) + (F.lane & 3) * 16; const float scl = isk ? 1.f : 0.125f;
    const int head = (F.lane & 31) >> 2, j0 = (F.lane & 3) * 16;
    float wv[16];
#pragma unroll
    for (int i = 0; i < 16; ++i) wv[i] = wsrc[i] * scl;
    for (int row = F.gw; row < MA; row += F.NGW) {
        const bool lat = row < ML; const int b = lat ? row / SEQ : (row - ML) / CTXL, sr = lat ? CTXL + row % SEQ : (row - ML) % CTXL;
        const size_t ho = ((size_t)(b * 8 + head) * (SEQ + CTXL) + sr) * 64 + j0;
        const bf16* p = QKV + (size_t)row * INW + 2048 + 16 * F.lane;
        const u32x4 a = *(const u32x4*)p, b2 = *(const u32x4*)(p + 8); const unsigned w[8] = {a.x, a.y, a.z, a.w, b2.x, b2.y, b2.z, b2.w}; float x[16]; float ss = 0.f;
#pragma unroll
        for (int i = 0; i < 8; ++i) { x[2 * i] = bflo(w[i]); x[2 * i + 1] = bfhi(w[i]); ss += x[2 * i] * x[2 * i] + x[2 * i + 1] * x[2 * i + 1]; }
        const float rinv = rsqrtf(red4(ss) * (1.f / 64.f) + 1e-6f);
        u32x4 o0, o1;
        o0.x = pk2(x[0] * rinv * wv[0], x[1] * rinv * wv[1]); o0.y = pk2(x[2] * rinv * wv[2], x[3] * rinv * wv[3]); o0.z = pk2(x[4] * rinv * wv[4], x[5] * rinv * wv[5]); o0.w = pk2(x[6] * rinv * wv[6], x[7] * rinv * wv[7]);
        o1.x = pk2(x[8] * rinv * wv[8], x[9] * rinv * wv[9]); o1.y = pk2(x[10] * rinv * wv[10], x[11] * rinv * wv[11]); o1.z = pk2(x[12] * rinv * wv[12], x[13] * rinv * wv[13]); o1.w = pk2(x[14] * rinv * wv[14], x[15] * rinv * wv[15]);
        bf16* d = (isk ? NK : NQ) + ho; *(u32x4*)d = o0; *(u32x4*)(d + 8) = o1;
        if (!isk) { const bf16* pv = QKV + (size_t)row * INW + 3072 + 16 * F.lane; const u32x4 v0 = *(const u32x4*)pv, v1 = *(const u32x4*)(pv + 8); *(u32x4*)(NV + ho) = v0; *(u32x4*)(NV + ho + 8) = v1; }
    }
}
constexpr int NLD = 72;
DI void na_phase(Fr& F) {
    const bf16* NQ = (const bf16*)(F.ws + WS_NQ); const bf16* NK = (const bf16*)(F.ws + WS_NK); const bf16* NV = (const bf16*)(F.ws + WS_NV); bf16* MIX = (bf16*)(F.ws + WS_MIX);
    LAS bf16* Ks = (LAS bf16*)F.lds;
    LAS bf16* Vs = (LAS bf16*)(F.lds + 36864);
    LAS bf16* Pw = (LAS bf16*)(F.lds + 2 * 36864) + F.wave * (32 * NLD);
    LAS float* rpbs = (LAS float*)(F.lds + 2 * 36864 + 8 * 4608);
    const int fr = F.lane & 15, fq = F.lane >> 4;
    float bound;
    { float mqw = fabsf(F.in[12][F.lane]), mkw = fabsf(F.in[13][F.lane]), mb = 0.f;
      for (int i = F.lane; i < 8 * 15 * 31; i += 64) mb = fmaxf(mb, fabsf(F.in[14][i]));
      bound = 8.f * wave_max(mqw) * wave_max(mkw) + wave_max(mb); }
    for (int u = F.bx; u < 512 + 64; u += F.G) {
        int b, head, r = -1, cb = 0, qtok0, kb_lo = 0, nwin = 0;
        if (u < 512) { const int bh = ((u >> 6) << 3) + (u & 7), qb = (u >> 3) & 7; b = bh >> 3; head = bh & 7;
            r = 4 * qb + (F.wave >> 1); cb = 32 * (F.wave & 1); qtok0 = b * SEQ + r * 64 + cb;
            const int r0lo = min(max(4 * qb - 4, 0), 24), r0hi = min(max(4 * qb - 1, 0), 24); kb_lo = r0lo >> 2; nwin = ((r0hi + 7) >> 2) - kb_lo + 1; }
        else { const int cu = u - 512; b = cu >> 3; head = cu & 7; qtok0 = ML + b * CTXL + 32 * F.wave; }
        const int r0 = min(max(r - 4, 0), 24);
        const size_t hb = (size_t)(b * 8 + head) * (SEQ + CTXL); const int qseq = u < 512 ? CTXL + r * 64 + cb : 32 * F.wave;
        bf16x8 aq[2][2];
#pragma unroll
        for (int mt = 0; mt < 2; ++mt)
#pragma unroll
            for (int ks = 0; ks < 2; ++ks) aq[mt][ks] = *(const bf16x8*)(NQ + (hb + qseq + 16 * mt + fr) * 64 + 32 * ks + 8 * fq);
        if (u < 512) for (int i = F.tid; i < 15 * 32; i += NTHR) { const int ro = i >> 5, co = i & 31; rpbs[i] = co < 31 ? F.in[14][head * 465 + ro * 31 + co] - bound : -1.0e30f; }
        int boff[2][4][4]; int nlo[2], nhi[2];
#pragma unroll
        for (int mt = 0; mt < 2; ++mt) { const int cs = cb + 16 * mt, c = cs + fr, c0 = min(max(c - 8, 0), 48);
            nlo[mt] = max(cs - 8, 0) >> 4; nhi[mt] = (min(cs + 7, 48) + 15) >> 4;
#pragma unroll
            for (int nt = 0; nt < 4; ++nt)
#pragma unroll
                for (int i = 0; i < 4; ++i) { const int kc = 16 * nt + 4 * fq + i; boff[mt][nt][i] = ((kc >= c0) && (kc < c0 + 16)) ? (kc - c + 15) : 31; } }
        f32x4 oacc[2][4]; float lsum[2] = {0.f, 0.f};
#pragma unroll
        for (int mt = 0; mt < 2; ++mt)
#pragma unroll
            for (int j = 0; j < 4; ++j) oacc[mt][j] = (f32x4){0.f, 0.f, 0.f, 0.f};
        u32x4 kst[4], vst[4];
#define NA_LOAD(bi_) do { const int kbase_ = (bi_) < nwin ? CTXL + 256 * (kb_lo + (bi_)) : 0; _Pragma("unroll") for (int it_ = 0; it_ < 4; ++it_) { const size_t o_ = (hb + kbase_ + (F.tid >> 3) + 64 * it_) * 64 + 8 * (F.tid & 7); \
            kst[it_] = *(const u32x4*)(NK + o_); vst[it_] = *(const u32x4*)(NV + o_); } } while (0)
        NA_LOAD(0);
        for (int bi = 0; bi <= nwin; ++bi) {
            const bool is_ctx = bi == nwin;
#pragma unroll
            for (int it = 0; it < 4; ++it) { const int krow = (F.tid >> 3) + 64 * it, c8 = F.tid & 7;
                *(LAS u32x4*)(Ks + krow * NLD + 8 * c8) = kst[it]; *(LAS u32x4*)(Vs + krow * NLD + 8 * c8) = vst[it]; }
            LDS_BARRIER();
            if (bi < nwin) NA_LOAD(bi + 1);
            if ((((PROBE_DUP) >> 30) & 1u) && bi < nwin) { asm volatile("" ::: "memory"); NA_LOAD(bi + 1); }
            f32x4 osv[2][4]; float lsv[2];
#pragma unroll
            for (int mt = 0; mt < 2; ++mt) { lsv[mt] = lsum[mt];
#pragma unroll
                for (int j = 0; j < 4; ++j) osv[mt][j] = oacc[mt][j]; }
            for (int pdc_ = 0; pdc_ < ((((PROBE_DUP) >> 31) & 1u) ? 2 : 1); ++pdc_) {
            if (pdc_ == 1) {
#pragma unroll
                for (int mt = 0; mt < 2; ++mt) { lsum[mt] = lsv[mt];
#pragma unroll
                    for (int j = 0; j < 4; ++j) oacc[mt][j] = osv[mt][j]; } }
#pragma unroll 1
            for (int krl = 0; krl < 4; ++krl) {
                const int kr = 4 * (kb_lo + bi) + krl;
                if (!is_ctx && (kr < r0 || kr > r0 + 7)) continue;
                f32x4 sacc[2][4];
#pragma unroll
                for (int mt = 0; mt < 2; ++mt)
#pragma unroll
                    for (int nt = 0; nt < 4; ++nt) sacc[mt][nt] = (f32x4){0.f, 0.f, 0.f, 0.f};
                const int n0w = is_ctx ? 0 : nlo[0], n1w = is_ctx ? 3 : nhi[1];
#pragma unroll
                for (int nt = 0; nt < 4; ++nt) { if (nt < n0w || nt > n1w) continue;
                    const bool u0 = is_ctx || (nt >= nlo[0] && nt <= nhi[0]), u1 = is_ctx || (nt >= nlo[1] && nt <= nhi[1]);
#pragma unroll
                    for (int ks = 0; ks < 2; ++ks) { const bf16x8 bk = frag_kc(Ks, NLD, 64 * krl + 16 * nt, 32 * ks, F.lane);
                        if (u0) sacc[0][nt] = mma(sacc[0][nt], bk, aq[0][ks]); if (u1) sacc[1][nt] = mma(sacc[1][nt], bk, aq[1][ks]); } }
                const int rowb = is_ctx ? 0 : (kr - r + 7) * 32;
#pragma unroll
                for (int mt = 0; mt < 2; ++mt) {
#pragma unroll
                    for (int nt = 0; nt < 4; ++nt) { float pv[4] = {0.f, 0.f, 0.f, 0.f};
                        if (is_ctx) {
#pragma unroll
                            for (int i = 0; i < 4; ++i) { pv[i] = __expf(sacc[mt][nt][i] - bound); lsum[mt] += pv[i]; } }
                        else if (nt >= nlo[mt] && nt <= nhi[mt]) {
#pragma unroll
                            for (int i = 0; i < 4; ++i) { pv[i] = __expf(sacc[mt][nt][i] + rpbs[rowb + boff[mt][nt][i]]); lsum[mt] += pv[i]; } }
                        u32x2 pk; pk.x = pk2(pv[0], pv[1]); pk.y = pk2(pv[2], pv[3]); *(LAS u32x2*)(Pw + (16 * mt + fr) * NLD + 16 * nt + 4 * fq) = pk; } }
                LDS_WAIT();
#pragma unroll
                for (int ks2 = 0; ks2 < 2; ++ks2) {
                    const bool v0 = is_ctx || (2 * ks2 + 1 >= nlo[0] && 2 * ks2 <= nhi[0]), v1 = is_ctx || (2 * ks2 + 1 >= nlo[1] && 2 * ks2 <= nhi[1]);
                    if (!(v0 || v1)) continue;
                    const bf16x8 ap0 = frag_kc(Pw, NLD, 0, 32 * ks2, F.lane), ap1 = frag_kc(Pw, NLD, 16, 32 * ks2, F.lane);
#pragma unroll
                    for (int et = 0; et < 4; ++et) { const bf16x8 bv = frag_kr(Vs, NLD, 16 * et, 64 * krl + 32 * ks2, F.lane);
                        if (v0) oacc[0][et] = mma(oacc[0][et], bv, ap0); if (v1) oacc[1][et] = mma(oacc[1][et], bv, ap1); } }
            }
            }
            LDS_BARRIER();
        }
#undef NA_LOAD
#pragma unroll
        for (int mt = 0; mt < 2; ++mt) { float l = lsum[mt]; l += __shfl_xor(l, 16); l += __shfl_xor(l, 32); const float inv = 1.f / l;
#pragma unroll
            for (int et = 0; et < 4; ++et) { const f32x4 o = oacc[mt][et] * inv; u32x2 p; p.x = pk2(o.x, o.y); p.y = pk2(o.z, o.w);
                *(u32x2*)(MIX + (size_t)(qtok0 + 16 * mt + fr) * D + 512 + head * 64 + 16 * et + 4 * fq) = p; } }
    }
}

DI void xm_phase(Fr& F, const float* xl, const float* xc, const float* normw, const float* modl) {
    bf16* XM = (bf16*)(F.ws + WS_XM); const float* mu = F.in[18];
    for (int g = F.gw; g < MA / 4; g += F.NGW) {
        const int row0 = 4 * g; const bool lat = row0 < ML; const int rr0 = lat ? row0 : row0 - ML; const int L = lat ? SEQ : CTXL; const int t0 = rr0 % L;
        const float* src = (lat ? xl : xc) + (size_t)rr0 * D;
        const float* mrow = modl + (size_t)(lat ? row0 / SEQ : 8) * 6144;
        const bool hp = t0 > 0, hn = t0 + 4 < L;
        f32x4 v[6][4]; float rs[6];
#pragma unroll
        for (int r = 0; r < 6; ++r) { const bool ok = (r == 0) ? hp : (r == 5 ? hn : true);
#pragma unroll
            for (int j = 0; j < 4; ++j) v[r][j] = ok ? ((const f32x4*)(src + (size_t)(r - 1) * D))[F.lane + 64 * j] : (f32x4){0.f, 0.f, 0.f, 0.f}; }
#pragma unroll
        for (int r = 0; r < 6; ++r) { float ss = 0.f;
#pragma unroll
            for (int j = 0; j < 4; ++j) ss += (v[r][j].x * v[r][j].x + v[r][j].y * v[r][j].y) + (v[r][j].z * v[r][j].z + v[r][j].w * v[r][j].w);
            rs[r] = rsqrtf(wave_sum_fast(ss) * (1.f / D) + 1e-6f); }
#pragma unroll
        for (int j = 0; j < 4; ++j) { const int c4 = F.lane + 64 * j;
            const f32x4 gg = ((const f32x4*)normw)[c4] * (((const f32x4*)(mrow + 1024))[c4] + 1.f), sh = ((const f32x4*)mrow)[c4];
            f32x4 h[6];
#pragma unroll
            for (int r = 0; r < 6; ++r) { const bool ok = (r == 0) ? hp : (r == 5 ? hn : true); h[r] = ok ? v[r][j] * rs[r] * gg + sh : (f32x4){0.f, 0.f, 0.f, 0.f}; }
            f32x4 m[6];
#pragma unroll
            for (int sx = 0; sx < 6; ++sx) m[sx] = ((const f32x4*)(mu + sx * 1024))[c4];
#pragma unroll
            for (int r = 0; r < 4; ++r) { const f32x4 hc = h[r + 1], xx = (h[r] + h[r + 2]) * 0.5f - hc;
#pragma unroll
                for (int sx = 0; sx < 6; ++sx) { const f32x4 y = hc + xx * m[sx];
                    u32x2 p; p.x = pk2(y.x, y.y); p.y = pk2(y.z, y.w); ((u32x2*)(XM + ((size_t)sx * MA + row0 + r) * D))[c4] = p; } } }
    }
}

DI f32x4 mma16(f32x4 acc, s16x4 bfrag, s16x4 afrag) { return __builtin_amdgcn_mfma_f32_16x16x16bf16_1k(bfrag, afrag, acc, 0, 0, 0); }
DI s16x4 frag16_kc(const LAS bf16* base, int ld, int row0, int k0, int lane) { return *(const LAS s16x4*)(base + (row0 + (lane & 15)) * ld + k0 + 4 * (lane >> 4)); }
DI s16x4 frag16_kr(const LAS bf16* base, int ld, int x0, int k0, int lane) { const int g = lane >> 4, q = (lane & 15) >> 2, p = lane & 3;
    return __builtin_amdgcn_ds_read_tr16_b64_v4i16((LAS s16x4*)(base + (k0 + 4 * g + q) * ld + x0 + 4 * p)); }
DI s16x4 cvt4(f32x4 v) { u32x2 p; p.x = pk2(v.x, v.y); p.y = pk2(v.z, v.w); return __builtin_bit_cast(s16x4, p); }
constexpr int WLD = 72;
DI void rwkv_scan2_phase(Fr& F) {
    const bf16* KB = (const bf16*)(F.ws + WS_KB); const bf16* VB = (const bf16*)(F.ws + WS_VB); const bf16* RB = (const bf16*)(F.ws + WS_RB);
    const bf16* LW = (const bf16*)(F.ws + WS_DEC); const bf16* AG = (const bf16*)(F.ws + WS_AG);
    LAS bf16* AT = (LAS bf16*)F.lds; LAS bf16* BT = AT + 64 * WLD; LAS bf16* KT = BT + 64 * WLD; LAS bf16* RT = KT + 64 * WLD; LAS bf16* BH = RT + 64 * WLD; LAS bf16* KH = BH + 64 * WLD;
    LAS bf16* VN = KH + 64 * WLD; LAS bf16* W1s = VN + 64 * WLD;
    LAS bf16* PRB = W1s + 64 * WLD; LAS bf16* PRK = PRB + 1024;
    LAS f32x4* UVT = (LAS f32x4*)(PRK + 1024);
    LAS float* GC = (LAS float*)(UVT + 1024);
    LAS float* CSs = GC + 256;
    LAS float* YS = CSs + 4096;
    const int cq = F.wave >> 1, half = F.wave & 1, fr = F.lane & 15, fq = F.lane >> 4;
    for (int u = F.bx; u < 256; u += F.G) {
        const int z = u & 1, h = (u >> 1) & 15, b = u >> 5;
        bf16* Y = (bf16*)(F.ws + (z ? WS_YB : WS_YF));
        const int sx = F.lane >> 3, cg = F.lane & 7;
        float kkw[8], kaw[8], rkw[8];
#pragma unroll
        for (int i = 0; i < 8; ++i) { kkw[i] = F.in[28][h * 64 + 8 * cg + i]; kaw[i] = F.in[29][h * 64 + 8 * cg + i]; rkw[i] = F.in[30][h * 64 + 8 * cg + i]; }
        float* coef = (float*)(F.ws + WS_COEF) + ((size_t)z * 128 + b * 16 + h) * SEQ;
        const size_t bh = (size_t)(b * 16 + h);
        const bf16* kbh = KB + bh * (SEQ + CTXL) * 64 + 8 * cg; const bf16* vbh = VB + bh * (SEQ + CTXL) * 64 + 8 * cg; const bf16* rbh = RB + bh * SEQ * 64 + 8 * cg;
        const bf16* agh = AG + ((size_t)z * 128 + bh) * (SEQ + CTXL) * 64 + 8 * cg; const bf16* lwh = LW + ((size_t)z * 128 + bh) * (SEQ + CTXL) * 64 + 8 * cg;
        f32x4 S[4];
#pragma unroll
        for (int j = 0; j < 4; ++j) S[j] = (f32x4){0.f, 0.f, 0.f, 0.f};
        u32x4 kreg, vreg, rreg, areg, lreg;
        const int stl = 16 * cq + 8 * half + sx;
#define RW_LOAD(sc) do { const int g_ = (sc) * 64 + stl; const bool lat_ = g_ >= CTXL; const int row_ = z ? (lat_ ? (2 * CTXL + SEQ - 1 - g_) : (CTXL - 1 - g_)) : g_; \
            kreg = *(const u32x4*)(kbh + (size_t)row_ * 64); vreg = *(const u32x4*)(vbh + (size_t)row_ * 64); areg = *(const u32x4*)(agh + (size_t)row_ * 64); \
            rreg = lat_ ? *(const u32x4*)(rbh + (size_t)(row_ - CTXL) * 64) : (u32x4){0u, 0u, 0u, 0u}; \
            lreg = *(const u32x4*)(lwh + (size_t)row_ * 64); } while (0)
        RW_LOAD(0);
        for (int sc = 0; sc < (SEQ + CTXL) / 64; ++sc) {
            const bool lat = sc * 64 >= CTXL;
            *(LAS f32x4*)(CSs + stl * 64 + 8 * cg) = (f32x4){bflo(lreg.x), bfhi(lreg.x), bflo(lreg.y), bfhi(lreg.y)}; *(LAS f32x4*)(CSs + stl * 64 + 8 * cg + 4) = (f32x4){bflo(lreg.z), bfhi(lreg.z), bflo(lreg.w), bfhi(lreg.w)};
            LDS_BARRIER();
            if (F.tid < 256) { const int q = F.tid >> 6, c = F.tid & 63; float v[16];
#pragma unroll
                for (int t = 0; t < 16; ++t) v[t] = CSs[(16 * q + t) * 64 + c];
                float acc = 0.f;
#pragma unroll
                for (int t = 0; t < 16; ++t) { acc += v[t]; CSs[(16 * q + t) * 64 + c] = acc; } }
            LDS_BARRIER();
            { const int tau = 8 * half + sx;
              const f32x4 c0 = *(const LAS f32x4*)(CSs + stl * 64 + 8 * cg), c1 = *(const LAS f32x4*)(CSs + stl * 64 + 8 * cg + 4);
              f32x4 p0 = (f32x4){0.f, 0.f, 0.f, 0.f}, p1 = p0;
              if (tau > 0) { p0 = *(const LAS f32x4*)(CSs + (stl - 1) * 64 + 8 * cg); p1 = *(const LAS f32x4*)(CSs + (stl - 1) * 64 + 8 * cg + 4); }
              const f32x4 t0 = *(const LAS f32x4*)(CSs + (16 * cq + 15) * 64 + 8 * cg), t1 = *(const LAS f32x4*)(CSs + (16 * cq + 15) * 64 + 8 * cg + 4);
              const float cs[8] = {c0.x, c0.y, c0.z, c0.w, c1.x, c1.y, c1.z, c1.w}, cp[8] = {p0.x, p0.y, p0.z, p0.w, p1.x, p1.y, p1.z, p1.w}, ct[8] = {t0.x, t0.y, t0.z, t0.w, t1.x, t1.y, t1.z, t1.w};
              const unsigned kw[4] = {kreg.x, kreg.y, kreg.z, kreg.w}, aw[4] = {areg.x, areg.y, areg.z, areg.w}, rw[4] = {rreg.x, rreg.y, rreg.z, rreg.w};
              float kr[8], ag[8], rr[8], kk[8]; float ss = 0.f;
#pragma unroll
              for (int i = 0; i < 4; ++i) { kr[2 * i] = bflo(kw[i]); kr[2 * i + 1] = bfhi(kw[i]); ag[2 * i] = bflo(aw[i]); ag[2 * i + 1] = bfhi(aw[i]); rr[2 * i] = bflo(rw[i]); rr[2 * i + 1] = bfhi(rw[i]); }
#pragma unroll
              for (int i = 0; i < 8; ++i) { kk[i] = kr[i] * kkw[i]; ss += kk[i] * kk[i]; }
              const float rn = __builtin_amdgcn_rsqf(fmaxf(red8(ss), 1e-24f));
              float oa[8], ob[8], ok[8], orr[8], obh[8], okh[8], eCv[8]; float cfp = 0.f;
#pragma unroll
              for (int i = 0; i < 8; ++i) { const float e1 = __expf(cs[i]), ep = __expf(cp[i]), eC = __expf(ct[i]), inv = __builtin_amdgcn_rcpf(e1);
                  const float kki = kk[i] * rn, b_ = kki * ag[i], kd_ = kr[i] * (1.f + (ag[i] - 1.f) * kaw[i]);
                  cfp += rr[i] * kd_ * rkw[i];
                  oa[i] = -kki * ep; ob[i] = b_ * inv; ok[i] = kd_ * inv; orr[i] = rr[i] * e1; obh[i] = b_ * eC * inv; okh[i] = kd_ * eC * inv; eCv[i] = eC; }
              cfp = red8(cfp);
              if (lat && cg == 0) { const int g = sc * 64 + stl; coef[z ? (SEQ + CTXL - 1 - g) : (g - CTXL)] = cfp; }
              const int o = stl * WLD + 8 * cg;
              *(LAS u32x4*)(AT + o) = pack8(oa, 1.f); *(LAS u32x4*)(BT + o) = pack8(ob, 1.f); *(LAS u32x4*)(KT + o) = pack8(ok, 1.f); *(LAS u32x4*)(RT + o) = pack8(orr, 1.f);
              *(LAS u32x4*)(BH + o) = pack8(obh, 1.f); *(LAS u32x4*)(KH + o) = pack8(okh, 1.f); *(LAS u32x4*)(VN + o) = vreg;
              if (tau == 0) { *(LAS f32x4*)(GC + cq * 64 + 8 * cg) = (f32x4){eCv[0], eCv[1], eCv[2], eCv[3]}; *(LAS f32x4*)(GC + cq * 64 + 8 * cg + 4) = (f32x4){eCv[4], eCv[5], eCv[6], eCv[7]}; } }
            LDS_BARRIER();
            if (sc + 1 < (SEQ + CTXL) / 64) RW_LOAD(sc + 1);
            for (int pa2_ = 0; pa2_ < ((((PROBE_DUP) >> 25) & 1u) ? 2 : 1); ++pa2_)
            if (half) { f32x4 pb = (f32x4){0.f, 0.f, 0.f, 0.f}, pk = (f32x4){0.f, 0.f, 0.f, 0.f};
#pragma unroll
                for (int k0 = 0; k0 < 64; k0 += 32) { const bf16x8 af = frag_kc(RT, WLD, 16 * cq, k0, F.lane);
                    pb = mma(pb, frag_kc(BT, WLD, 16 * cq, k0, F.lane), af); pk = mma(pk, frag_kc(KT, WLD, 16 * cq, k0, F.lane), af); }
#pragma unroll
                for (int r = 0; r < 4; ++r) if (4 * fq + r > fr) { pb[r] = 0.f; pk[r] = 0.f; }
                const int o = cq * 256 + fr * 16 + 4 * fq;
                *(LAS s16x4*)(PRB + o) = cvt4(pb); *(LAS s16x4*)(PRK + o) = cvt4(pk); }
            else { f32x4 xa = (f32x4){0.f, 0.f, 0.f, 0.f}, xt = (f32x4){0.f, 0.f, 0.f, 0.f}, ak = (f32x4){0.f, 0.f, 0.f, 0.f};
#pragma unroll
                for (int k0 = 0; k0 < 64; k0 += 32) { const bf16x8 af = frag_kc(AT, WLD, 16 * cq, k0, F.lane), bfm = frag_kc(BT, WLD, 16 * cq, k0, F.lane);
                    xa = mma(xa, bfm, af);
                    xt = mma(xt, af, bfm);
                    ak = mma(ak, frag_kc(KT, WLD, 16 * cq, k0, F.lane), af); }
#pragma unroll
                for (int r = 0; r < 4; ++r) { if (4 * fq + r >= fr) { xa[r] = 0.f; ak[r] = 0.f; } if (4 * fq + r <= fr) xt[r] = 0.f; }
                f32x4 P = xa;
#pragma unroll
                for (int r = 0; r < 4; ++r) if (4 * fq + r == fr) P[r] += 1.f;
#pragma unroll
                for (int lvl = 0; lvl < 3; ++lvl) { const s16x4 xf = cvt4(xa), xtf = cvt4(xt);
                    const f32x4 x2 = mma16((f32x4){0.f, 0.f, 0.f, 0.f}, xtf, xf);
                    const f32x4 x2t = mma16((f32x4){0.f, 0.f, 0.f, 0.f}, xf, xtf);
                    xa = x2; xt = x2t;
                    P = mma16(P, cvt4(xt), cvt4(P)); }
                const s16x4 tf = cvt4(P), akf = cvt4(ak);
#pragma unroll
                for (int jt = 0; jt < 4; ++jt) { const f32x4 acc = mma16((f32x4){0.f, 0.f, 0.f, 0.f}, frag16_kr(AT, WLD, 16 * jt, 16 * cq, F.lane), tf);
                    *(LAS s16x4*)(W1s + (16 * cq + fr) * WLD + 16 * jt + 4 * fq) = cvt4(acc); }
#pragma unroll
                for (int it = 0; it < 4; ++it) { const f32x4 xvt = mma16((f32x4){0.f, 0.f, 0.f, 0.f}, akf, frag16_kr(VN, WLD, 16 * it, 16 * cq, F.lane));
                    UVT[(cq * 4 + it) * 64 + F.lane] = mma16((f32x4){0.f, 0.f, 0.f, 0.f}, tf, cvt4(xvt)); } }
            LDS_BARRIER();
            if (F.wave < 4) { const int it = F.wave;
                s16x4 w1f[2][4], bhf[2][4], khf[2][4], vfr[2]; f32x4 g4[2][4], uv0[2];
#define SB_LOAD(c_, b_) do { _Pragma("unroll") for (int jt = 0; jt < 4; ++jt) { w1f[b_][jt] = frag16_kc(W1s, WLD, 16 * (c_), 16 * jt, F.lane); \
                        bhf[b_][jt] = frag16_kr(BH, WLD, 16 * jt, 16 * (c_), F.lane); khf[b_][jt] = frag16_kr(KH, WLD, 16 * jt, 16 * (c_), F.lane); g4[b_][jt] = *(const LAS f32x4*)(GC + (c_) * 64 + 16 * jt + 4 * fq); } \
                    vfr[b_] = frag16_kr(VN, WLD, 16 * it, 16 * (c_), F.lane); uv0[b_] = UVT[((c_) * 4 + it) * 64 + F.lane]; } while (0)
                SB_LOAD(0, 0);
#pragma unroll
                for (int c = 0; c < 4; ++c) { const int cb_ = c & 1;
                    if (c < 3) SB_LOAD(c + 1, cb_ ^ 1);
                    s16x4 sfr[4];
#pragma unroll
                    for (int jt = 0; jt < 4; ++jt) sfr[jt] = cvt4(S[jt]);
#define CAT8(a_, b_) __builtin_shufflevector((a_), (b_), 0, 1, 2, 3, 4, 5, 6, 7)
                    const bf16x8 s01 = CAT8(sfr[0], sfr[1]), s23 = CAT8(sfr[2], sfr[3]);
                    f32x4 Ua = mma(uv0[cb_], CAT8(w1f[cb_][0], w1f[cb_][1]), s01); Ua = mma(Ua, CAT8(w1f[cb_][2], w1f[cb_][3]), s23);
                    const s16x4 ufr = cvt4(Ua); const bf16x8 uv8 = CAT8(ufr, vfr[cb_]);
#pragma unroll
                    for (int jt = 0; jt < 4; ++jt) S[jt] = mma(S[jt] * g4[cb_][jt], CAT8(bhf[cb_][jt], khf[cb_][jt]), uv8);
                    if (lat) { s16x4 rtf[4];
#pragma unroll
                        for (int jt = 0; jt < 4; ++jt) rtf[jt] = frag16_kc(RT, WLD, 16 * c, 16 * jt, F.lane);
                        const s16x4 pbf = frag16_kc(PRB + c * 256, 16, 0, 0, F.lane), pkf = frag16_kc(PRK + c * 256, 16, 0, 0, F.lane);
                        f32x4 Ya = mma((f32x4){0.f, 0.f, 0.f, 0.f}, CAT8(rtf[0], rtf[1]), s01); Ya = mma(Ya, CAT8(rtf[2], rtf[3]), s23);
                        const f32x4 Yb = mma((f32x4){0.f, 0.f, 0.f, 0.f}, CAT8(pbf, pkf), uv8);
                        const f32x4 Yt = Ya + Yb;
#pragma unroll
                        for (int r = 0; r < 4; ++r) YS[(16 * c + 4 * fq + r) * 68 + 16 * it + fr] = Yt[r]; }
                }
#undef SB_LOAD
            }
            LDS_BARRIER();
            if (lat) {
                const int g = sc * 64 + (F.tid >> 3); const int tl = z ? (SEQ + CTXL - 1 - g) : (g - CTXL);
                const f32x4 y0 = *(const LAS f32x4*)(YS + (F.tid >> 3) * 68 + 8 * (F.tid & 7)), y1 = *(const LAS f32x4*)(YS + (F.tid >> 3) * 68 + 8 * (F.tid & 7) + 4);
                u32x4 o; o.x = pk2(y0.x, y0.y); o.y = pk2(y0.z, y0.w); o.z = pk2(y1.x, y1.y); o.w = pk2(y1.z, y1.w);
                *(u32x4*)(Y + (size_t)(b * SEQ + tl) * D + h * 64 + 8 * (F.tid & 7)) = o; }
            LDS_BARRIER();
        }
#undef RW_LOAD
    }
}

DI void rwkv_readout_phase(Fr& F) {
    const bf16* VB = (const bf16*)(F.ws + WS_VB); const bf16* G = (const bf16*)(F.ws + WS_G); const float* COEF = (const float*)(F.ws + WS_COEF);
    const bf16* YF = (const bf16*)(F.ws + WS_YF); const bf16* YB = (const bf16*)(F.ws + WS_YB); bf16* Z = (bf16*)(F.ws + WS_H);
    const int c0 = 16 * F.lane, hh = F.lane >> 2, j0 = (F.lane & 3) * 16;
    float lnw[16], lnb[16];
#pragma unroll
    for (int q = 0; q < 16; ++q) { lnw[q] = F.in[31][c0 + q]; lnb[q] = F.in[32][c0 + q]; }
#define RD16(dst, ptr) do { const u32x4 t0_ = *(const u32x4*)(ptr), t1_ = *(const u32x4*)((ptr) + 8); const unsigned tw_[8] = {t0_.x, t0_.y, t0_.z, t0_.w, t1_.x, t1_.y, t1_.z, t1_.w}; \
        _Pragma("unroll") for (int q_ = 0; q_ < 8; ++q_) { dst[2 * q_] = bflo(tw_[q_]); dst[2 * q_ + 1] = bfhi(tw_[q_]); } } while (0)
    for (int row = F.gw; row < ML; row += F.NGW) {
        const size_t off = (size_t)row * D + c0; const int b = row / SEQ, t = row % SEQ;
        const size_t hoff = ((size_t)(b * 16 + hh) * (SEQ + CTXL) + CTXL + t) * 64 + j0;
        float y[16], yb[16], vv[16], gv[16];
        RD16(y, YF + off); RD16(yb, YB + off); RD16(vv, VB + hoff); RD16(gv, G + off);
        const float cf = COEF[(size_t)(b * 16 + hh) * SEQ + t] + COEF[(size_t)(128 + b * 16 + hh) * SEQ + t];
        float s = 0.f;
#pragma unroll
        for (int q = 0; q < 16; ++q) { y[q] += yb[q]; s += y[q]; }
        s = red4(s);
        const float mean = s * (1.f / 64.f); float q2 = 0.f;
#pragma unroll
        for (int q = 0; q < 16; ++q) { const float d = y[q] - mean; q2 += d * d; }
        q2 = red4(q2);
        const float rstd = rsqrtf(q2 * (1.f / 64.f) + 64e-5f);
        float o[16];
#pragma unroll
        for (int q = 0; q < 16; ++q) o[q] = ((y[q] - mean) * rstd * lnw[q] + lnb[q] + cf * vv[q]) * gv[q];
        u32x4 p0, p1; p0.x = pk2(o[0], o[1]); p0.y = pk2(o[2], o[3]); p0.z = pk2(o[4], o[5]); p0.w = pk2(o[6], o[7]); p1.x = pk2(o[8], o[9]); p1.y = pk2(o[10], o[11]); p1.z = pk2(o[12], o[13]); p1.w = pk2(o[14], o[15]);
        *(u32x4*)(Z + off) = p0; *(u32x4*)(Z + off + 8) = p1;
    }
#undef RD16
}

DI void moe_route_phase(Fr& F, const float* xl, const float* normw, const float* modl) {
    bf16* H2 = (bf16*)(F.ws + WS_MIX); int* TopE = (int*)(F.ws + WS_MISC + MISC_TOPE); f32x2* TopW = (f32x2*)(F.ws + WS_MISC + MISC_TOPW); int* Cnts = (int*)(F.ws + WS_MISC + MISC_CNTS);
    LAS int* lc = (LAS int*)F.lds;
    f32x4 rw[4][4][2];
#pragma unroll
    for (int j = 0; j < 4; ++j)
#pragma unroll
        for (int q = 0; q < 4; ++q) { const float* rp = F.in[34] + (size_t)(4 * (F.lane + 64 * j) + q) * 8; rw[j][q][0] = *(const f32x4*)rp; rw[j][q][1] = *(const f32x4*)(rp + 4); }
    for (int wg = F.bx; wg < 256; wg += F.G) {
        LDS_BARRIER();
#pragma unroll 2
        for (int it = 0; it < 8; ++it) { const int row = wg * 64 + F.wave * 8 + it;
            const float* src = xl + (size_t)row * D; const float* mrow = modl + (size_t)(row / SEQ) * 6144;
            f32x4 v[4]; float ss = 0.f;
#pragma unroll
            for (int j = 0; j < 4; ++j) { v[j] = ((const f32x4*)src)[F.lane + 64 * j]; ss += (v[j].x * v[j].x + v[j].y * v[j].y) + (v[j].z * v[j].z + v[j].w * v[j].w); }
            const float rstd = rsqrtf(wave_sum_fast(ss) * (1.f / D) + 1e-6f);
            f32x4 l0 = (f32x4){0.f, 0.f, 0.f, 0.f}, l1 = l0;
#pragma unroll
            for (int j = 0; j < 4; ++j) { const int c4 = F.lane + 64 * j;
                const f32x4 w = ((const f32x4*)normw)[c4], sc = ((const f32x4*)(mrow + 4096))[c4], sh = ((const f32x4*)(mrow + 3072))[c4];
                const f32x4 y = v[j] * rstd * w * (sc + 1.f) + sh;
                u32x2 p; p.x = pk2(y.x, y.y); p.y = pk2(y.z, y.w); ((u32x2*)(H2 + (size_t)row * D))[c4] = p;
                l0 += rw[j][0][0] * y.x + rw[j][1][0] * y.y + rw[j][2][0] * y.z + rw[j][3][0] * y.w;
                l1 += rw[j][0][1] * y.x + rw[j][1][1] * y.y + rw[j][2][1] * y.z + rw[j][3][1] * y.w; }
            float lg[8] = {l0.x, l0.y, l0.z, l0.w, l1.x, l1.y, l1.z, l1.w};
#pragma unroll
            for (int e = 0; e < 8; ++e) lg[e] = wave_sum_fast(lg[e]);
            int e0 = 0; float v0 = lg[0];
#pragma unroll
            for (int e = 1; e < 8; ++e) if (lg[e] > v0) { v0 = lg[e]; e0 = e; }
            int e1 = -1; float v1 = -3.0e38f;
#pragma unroll
            for (int e = 0; e < 8; ++e) if (e != e0 && lg[e] > v1) { v1 = lg[e]; e1 = e; }
            const float w0 = 1.f / (1.f + expf(v1 - v0)), w1 = 1.f - w0;
            if (F.lane == 0) { TopE[row] = e0 | (e1 << 8); TopW[row] = (f32x2){w0, w1}; lc[F.wave * 8 + it] = e0 | (e1 << 8); }
        }
        LDS_BARRIER();
        if (F.tid < 8) { int c = 0; for (int t = 0; t < 64; ++t) { const int code = lc[t]; c += ((code & 255) == F.tid ? 1 : 0) + ((code >> 8) == F.tid ? 1 : 0); } Cnts[wg * 8 + F.tid] = c; }
    }
}
DI void moe_gather_phase(Fr& F) {
    const bf16* H2 = (const bf16*)(F.ws + WS_MIX); const int* TopE = (const int*)(F.ws + WS_MISC + MISC_TOPE); const f32x2* TopW = (const f32x2*)(F.ws + WS_MISC + MISC_TOPW);
    const int* Cnts = (const int*)(F.ws + WS_MISC + MISC_CNTS); int* Exp = (int*)(F.ws + WS_MISC + MISC_EXP);
    bf16* XG = (bf16*)(F.ws + WS_XG); int* RowTok = (int*)(F.ws + WS_ROWS); float* RowW = (float*)(F.ws + WS_ROWS + 262144);
    LAS int* lc = (LAS int*)F.lds;
    LAS int* tot = lc + 2048;
    LAS int* rows = tot + 32;
    LAS int* te = rows + 128;
    for (int idx = F.tid; idx < 2048; idx += NTHR) lc[idx] = Cnts[idx];
    WG_SYNC();
    for (int wg = F.bx; wg < 256; wg += F.G) {
        if (F.tid < 64) te[F.tid] = TopE[wg * 64 + F.tid];
        if (F.tid < 8) { int t = 0, mb = 0; for (int w = 0; w < 256; ++w) { const int c = lc[w * 8 + F.tid]; t += c; mb += (w < wg) ? c : 0; } tot[F.tid] = t; tot[16 + F.tid] = mb; }
        WG_SYNC();
        if (F.tid == 0) { int sgs = 0; for (int e = 0; e < 8; ++e) { tot[8 + e] = sgs; sgs += (tot[e] + 255) & ~255; }
            if (wg == 0) { int acc = 0; for (int e = 0; e < 8; ++e) { Exp[e] = tot[e]; Exp[8 + e] = tot[8 + e]; acc += (tot[e] + 255) >> 8; Exp[16 + e] = acc; } } }
        WG_SYNC();
        if (F.tid < 64) { const int code = te[F.tid]; const int e0 = code & 255, e1 = code >> 8; int r0 = 0, r1 = 0;
            for (int t = 0; t < F.tid; ++t) { const int c2 = te[t]; const int a = c2 & 255, bq = c2 >> 8; r0 += (a == e0 ? 1 : 0) + (bq == e0 ? 1 : 0); r1 += (a == e1 ? 1 : 0) + (bq == e1 ? 1 : 0); }
            rows[2 * F.tid] = tot[8 + e0] + tot[16 + e0] + r0; rows[2 * F.tid + 1] = tot[8 + e1] + tot[16 + e1] + r1; }
        WG_SYNC();
        for (int it = F.wave; it < 128; it += NWAVES) { const int t = it >> 1, k = it & 1, tok = wg * 64 + t, row = rows[it];
            const u32x4* s = (const u32x4*)(H2 + (size_t)tok * D); u32x4* d = (u32x4*)(XG + (size_t)row * D);
            d[F.lane] = s[F.lane]; d[F.lane + 64] = s[F.lane + 64];
            if (F.lane == 0) { RowTok[row] = tok * 2 + k; const f32x2 w = TopW[tok]; RowW[row] = k ? w.y : w.x; } }
        if (wg == 0) {
            for (int e = 0; e < 8; ++e) { const int a = tot[8 + e] + tot[e], bnd = tot[8 + e] + ((tot[e] + 255) & ~255); for (int rr = a + F.tid; rr < bnd; rr += NTHR) RowTok[rr] = -1; } }
        WG_SYNC();
    }
}
DI void moe_combine_phase(Fr& F, float* xl, const float* modl) {
    const bf16* YS = (const bf16*)(F.ws + WS_YS);
    for (int row = F.gw; row < ML; row += F.NGW) {
        const float* mrow = modl + (size_t)(row / SEQ) * 6144 + 5120; float* xr = xl + (size_t)row * D;
        const u32x2* s0 = (const u32x2*)(YS + (size_t)(2 * row) * D); const u32x2* s1 = (const u32x2*)(YS + (size_t)(2 * row + 1) * D);
#pragma unroll
        for (int j = 0; j < 4; ++j) { const int c4 = F.lane + 64 * j; const f32x4 x = ((const f32x4*)xr)[c4], m = ((const f32x4*)mrow)[c4]; const u32x2 a = s0[c4], bq = s1[c4];
            f32x4 o; o.x = x.x + m.x * (bflo(a.x) + bflo(bq.x)); o.y = x.y + m.y * (bfhi(a.x) + bfhi(bq.x)); o.z = x.z + m.z * (bflo(a.y) + bflo(bq.y)); o.w = x.w + m.w * (bfhi(a.y) + bfhi(bq.y));
            ((f32x4*)xr)[c4] = o; }
    }
}

constexpr int N_PHASES = 20;

struct Args { const float* in[37]; float* out; unsigned char* ws; int ph_lo, ph_hi; };
template <class Epi> DI void run_gemm(Fr& F, const bf16* A, const bf16* Bt, int M, int N, int K, const Epi& E, int& rot) {
    int Kv = K; asm volatile("" : "+s"(Kv));
    pg8::Gemm g{A, Bt, M, N, Kv}; pg8::StaticOrder S; S.init(M, N, F.G, (F.bx + F.G - (rot % F.G)) % F.G); rot += (M / 256) * (N / 256);
    pg8::gemm_phase<Epi, pg8::StaticOrder>(F.lds, g, S, E);
}
__global__ void __launch_bounds__(NTHR, 2) fwd_kernel(Args args) {
    extern __shared__ __attribute__((aligned(16))) unsigned char lds_raw[];
    Fr F;
    F.lds = (LAS unsigned char*)lds_raw; F.ws = args.ws; F.in = args.in; F.out = args.out;
    F.tid = threadIdx.x; F.lane = F.tid & 63; F.wave = __builtin_amdgcn_readfirstlane(F.tid >> 6); F.bx = blockIdx.x; F.G = gridDim.x;
    F.gw = F.bx * NWAVES + F.wave; F.NGW = F.G * NWAVES;
    volatile LAS unsigned* MISC = (volatile LAS unsigned*)(F.lds + LDS_MISC_OFF);
    if (F.tid < 64) MISC[F.tid] = 0u;
    __syncthreads();
    const int lo = args.ph_lo, hi = args.ph_hi;
    const bool multi = (hi - lo) > 1;
    XcdBarrier bar; bar.bar = (unsigned*)(F.ws + WS_CTL) + CW_BAR; bar.x = 0; bar.st = nullptr;
    if (multi) bar = xcd_barrier_post((unsigned*)(F.ws + WS_CTL) + CW_BAR, MISC + 8);
#ifndef PH_MASK
#define PH_MASK 0xFFFFFFFFu
#endif
#define IN(k) ((((PH_MASK) >> (k)) & 1u) && lo <= (k) && (k) < hi)
#define REP(k) for (int rep_ = 0; rep_ < ((((PROBE_DUP) >> (k)) & 1u) ? 2 : 1); ++rep_)
#define SEAM(k) do { if (IN(k) && IN((k) + 1)) xcd_barrier(bar); } while (0)
    const float* const* in = args.in;
    float* MOD = (float*)(F.ws + WS_MOD);
    float* XL = F.out; float* XC = (float*)(F.ws + WS_XC);
    bf16* H = (bf16*)(F.ws + WS_H); bf16* MIX = (bf16*)(F.ws + WS_MIX);

    if (IN(0)) REP(0) { p0_prologue(F); } SEAM(0);
    if (IN(1)) REP(1) { mod_rows(F, in[0], in[2], MA, in[6], MOD, 0, 1024, H); } SEAM(1);
    if (IN(2)) REP(2) { int rot = 0; EpiStore<0> E{(bf16*)(F.ws + WS_QKV), INW, INW}; run_gemm(F, H, (const bf16*)(F.ws + WS_W_IN), MA, INW, 1024, E, rot); } SEAM(2);
    if (IN(3)) REP(3) { na_norm_rows(F); ret_kv_phase(F); } SEAM(3);
    if (IN(4)) REP(4) { ret_prefix_phase(F); } SEAM(4);
    #ifndef PH5_SEL
#define PH5_SEL 3
#endif
    if (IN(5)) REP(5) { for (int r5_ = 0; r5_ < ((((PROBE_DUP) >> 27) & 1u) ? 2 : 1); ++r5_) ret_out_phase(F); for (int r6_ = 0; r6_ < ((((PROBE_DUP) >> 28) & 1u) ? 2 : 1); ++r6_) na_phase(F); } SEAM(5);
    if (IN(6)) REP(6) { int rot = 0; EpiResid E{in[0], XL, in[2], XC, MOD + 2048}; run_gemm(F, MIX, (const bf16*)(F.ws + WS_W_OUT), MA, 1024, 1024, E, rot); moe_fill(F, F.bx - 32, F.G - 32, 0, FILL_A); } SEAM(6);
    if (IN(7)) REP(7) { mod_rows(F, XL, XC, MA, in[7], MOD, 3072, 4096, H); } SEAM(7);
    if (IN(8)) REP(8) { int rot = 0; EpiSwiglu E{(bf16*)(F.ws + WS_FFH), FFN_H}; run_gemm(F, H, (const bf16*)(F.ws + WS_W_13), MA, 2 * FFN_H, 1024, E, rot); moe_fill(F, F.bx - 48, F.G - 48, FILL_A, FILL_B); } SEAM(8);
    if (IN(9)) { int rot = 0; EpiResid E{XL, XL, XC, XC, MOD + 5120}; run_gemm(F, (const bf16*)(F.ws + WS_FFH), (const bf16*)(F.ws + WS_W_2), MA, 1024, FFN_H, E, rot); moe_fill(F, F.bx - 32, F.G - 32, FILL_B, FILL_C); } SEAM(9);
    const float* MOD1 = MOD + 9 * 6144;
    if (IN(10)) REP(10) { xm_phase(F, XL, XC, in[6] + 1024, MOD1); } SEAM(10);
    if (IN(11)) REP(11) { int rot = 0; const bf16* XM = (const bf16*)(F.ws + WS_XM); const bf16* WR = (const bf16*)(F.ws + WS_W_RKV); const bf16* WL1 = (const bf16*)(F.ws + WS_W_L1);
        { EpiStoreHead E{(bf16*)(F.ws + WS_RB), SEQ, 0}; run_gemm(F, XM, WR, ML, 1024, 1024, E, rot); }
        { EpiStoreHead E{(bf16*)(F.ws + WS_KB), SEQ + CTXL, CTXL}; run_gemm(F, XM + (size_t)1 * MA * D, WR + 1024 * 1024, MA, 1024, 1024, E, rot); }
        { EpiStoreHead E{(bf16*)(F.ws + WS_VB), SEQ + CTXL, CTXL}; run_gemm(F, XM + (size_t)2 * MA * D, WR + 2 * 1024 * 1024, MA, 1024, 1024, E, rot); }
        { EpiStore<1> E{(bf16*)(F.ws + WS_L1), 256, 128}; run_gemm(F, XM + (size_t)3 * MA * D, WL1, MA, 256, 1024, E, rot); }
        { EpiStore<0> E{(bf16*)(F.ws + WS_L1) + 128, 256, 128}; run_gemm(F, XM + (size_t)4 * MA * D, WL1 + 256 * 1024, MA, 256, 1024, E, rot); }
        { EpiStore<2> E{(bf16*)(F.ws + WS_LG), 256, 256}; run_gemm(F, XM + (size_t)5 * MA * D, WL1 + 2 * 256 * 1024, ML, 256, 1024, E, rot); }
        } SEAM(11);
    if (IN(12)) REP(12) { int rot = 0;
        { EpiLora2 E{(bf16*)(F.ws + WS_DEC), (bf16*)(F.ws + WS_AG), in[20], in[23]}; run_gemm(F, (const bf16*)(F.ws + WS_L1), (const bf16*)(F.ws + WS_W_L2), MA, 4096, 256, E, rot); }
        { EpiStore<0> E{(bf16*)(F.ws + WS_G), D, D}; run_gemm(F, (const bf16*)(F.ws + WS_LG), (const bf16*)(F.ws + WS_W_G2), ML, 1024, 256, E, rot); } } SEAM(12);
    #ifndef SCAN_VER
#define SCAN_VER 2
#endif
    if (IN(13)) REP(13) { rwkv_scan2_phase(F); } SEAM(13);
    if (IN(14)) REP(14) { rwkv_readout_phase(F); } SEAM(14);
    if (IN(15)) { int rot = 0; EpiResid E{XL, XL, XC, XC, MOD1 + 2048}; run_gemm(F, H, (const bf16*)(F.ws + WS_W_O), ML, 1024, 1024, E, rot); } SEAM(15);
    if (IN(16)) REP(16) { moe_route_phase(F, XL, in[7] + 1024, MOD1); } SEAM(16);
    if (IN(17)) REP(17) { moe_gather_phase(F); } SEAM(17);
    if (IN(18) || IN(19)) {
        const int* Exp = (const int*)(F.ws + WS_MISC + MISC_EXP);
        pg8::MoeOrder S; S.G = F.G; S.c = F.bx;
#pragma unroll
        for (int e = 0; e < 8; ++e) S.tend[e] = Exp[16 + e];
        S.nM = S.tend[7];
        if (IN(18)) REP(18) { S.nN = 2 * EXP_H / 256; S.nwg = S.nM * S.nN; pg8::Gemm g{(const bf16*)(F.ws + WS_XG), (const bf16*)(F.ws + WS_W_M13), XG_ROWS, 2 * EXP_H, 1024};
            EpiSwiglu E{(bf16*)(F.ws + WS_HG), EXP_H}; pg8::gemm_phase<EpiSwiglu, pg8::MoeOrder>(F.lds, g, S, E); }
        SEAM(18);
        if (IN(19)) REP(19) { S.nN = 4; S.nwg = S.nM * S.nN; pg8::Gemm g{(const bf16*)(F.ws + WS_HG), (const bf16*)(F.ws + WS_W_M2), XG_ROWS, 1024, EXP_H};
            EpiMoeOut E{(bf16*)(F.ws + WS_YS), (const int*)(F.ws + WS_ROWS), (const float*)(F.ws + WS_ROWS + 262144)}; pg8::gemm_phase<EpiMoeOut, pg8::MoeOrder>(F.lds, g, S, E); }
    }
    if (IN(19) && IN(20)) xcd_barrier(bar);
    if (IN(19) && IN(20)) for (int xb_ = 0; xb_ < ((((PROBE_DUP) >> 29) & 1u) ? 20 : 0); ++xb_) xcd_barrier(bar);
    if (IN(20)) { moe_combine_phase(F, XL, MOD1); }
#undef IN
#undef SEAM
}

#ifndef MK_SPLIT
#define MK_SPLIT 0
#endif
extern "C" void kernel_launch(void* const* d_in, const int* in_sizes, int n_in, void* d_out, int out_size, void* d_ws, size_t ws_size, hipStream_t stream) {
    static int grid = 0;
    if (grid == 0) {
        if (n_in != 37 || out_size != ML * D || ws_size < WS_END) { fprintf(stderr, "kernel_launch: unexpected problem (n_in %d out %d ws %zu)\n", n_in, out_size, ws_size); grid = -1; return; }
        int dev = 0, cus = 0, per_cu = 0;
        if (hipGetDevice(&dev) != hipSuccess || hipDeviceGetAttribute(&cus, hipDeviceAttributeMultiprocessorCount, dev) != hipSuccess) { grid = -1; return; }
        if (hipFuncSetAttribute((const void*)fwd_kernel, hipFuncAttributeMaxDynamicSharedMemorySize, LDS_BYTES) != hipSuccess) { fprintf(stderr, "kernel_launch: hipFuncSetAttribute failed\n"); grid = -1; return; }
        if (hipOccupancyMaxActiveBlocksPerMultiprocessor(&per_cu, (const void*)fwd_kernel, NTHR, LDS_BYTES) != hipSuccess || per_cu < 1) { fprintf(stderr, "kernel_launch: occupancy query says %d\n", per_cu); }
        (void)hipGetLastError();
        grid = cus;
    }
    if (grid < 0) return;
    (void)hipMemsetAsync((char*)d_ws + WS_CTL, 0, CTL_ZERO_BYTES, stream);
    Args a{};
    for (int i = 0; i < 37; ++i) a.in[i] = (const float*)d_in[i];
    a.out = (float*)d_out; a.ws = (unsigned char*)d_ws;
#if MK_SPLIT
    for (int p = 0; p <= N_PHASES; ++p) { a.ph_lo = p; a.ph_hi = p + 1; hipLaunchKernelGGL(fwd_kernel, dim3(grid), dim3(NTHR), LDS_BYTES, stream, a); }
#elif defined(PROBE_RELAUNCH)
    a.ph_lo = 0; a.ph_hi = PROBE_RELAUNCH + 1; hipLaunchKernelGGL(fwd_kernel, dim3(grid), dim3(NTHR), LDS_BYTES, stream, a);
    (void)hipMemsetAsync((char*)d_ws + WS_CTL, 0, CTL_ZERO_BYTES, stream);
    a.ph_lo = PROBE_RELAUNCH; a.ph_hi = PROBE_RELAUNCH + 1; hipLaunchKernelGGL(fwd_kernel, dim3(grid), dim3(NTHR), LDS_BYTES, stream, a);
    a.ph_lo = PROBE_RELAUNCH + 1; a.ph_hi = N_PHASES + 1; hipLaunchKernelGGL(fwd_kernel, dim3(grid), dim3(NTHR), LDS_BYTES, stream, a);
#else
    a.ph_lo = 0; a.ph_hi = N_PHASES + 1; hipLaunchKernelGGL(fwd_kernel, dim3(grid), dim3(NTHR), LDS_BYTES, stream, a);
#endif
}
```

```cpp
#include <hip/hip_runtime.h>
#include <cstdio>
#include <cstdint>

#ifndef PROBE_DUP
#define PROBE_DUP 0u
#endif
#define DI __device__ __forceinline__
#define LAS __attribute__((address_space(3)))

namespace pg8 {
#define PG8_LAS __attribute__((address_space(3)))
typedef unsigned short bf16_t;
typedef short bf16x8 __attribute__((ext_vector_type(8)));
typedef float f32x4 __attribute__((ext_vector_type(4)));
typedef unsigned u32x4 __attribute__((ext_vector_type(4)));
constexpr int BM = 256, BK = 64, HALF = 128, HTB = HALF * BK * 2  , STAGE_BYTES = 8 * HTB, NXCD = 8, WGM = 8;

__host__ __device__ __forceinline__ int lds_byte(int r, int c) { const int st = (r >> 4) * 2 + (c >> 5), rr = r & 15, cc = c & 31, ob = rr * 64 + cc * 2; return st * 1024 + (ob ^ (((ob >> 9) & 1) << 5)); }
__host__ __device__ __forceinline__ void stage_rc(int b, int& R, int& C) { const int st = b / 1024, sb = b % 1024, swz = sb ^ (((sb >> 9) & 1) << 5); R = (st >> 1) * 16 + swz / 64; C = (st & 1) * 32 + (swz % 64) / 2; }
__host__ __device__ __forceinline__ int perm32(int rho) { const int n = rho >> 4, i = rho & 15; return 8 * (i >> 2) + 4 * n + (i & 3); }

struct Unit { int pm, pn, pb; };
struct Gemm { const bf16_t* A; const bf16_t* Bt; int M, N, K; };

struct StaticOrder {
    int nM, nN, nwg, G, c;
    __host__ __device__ void init(int M, int N, int G_, int c_) { nM = M / BM; nN = N / BM; nwg = nM * nN; G = G_; c = c_; }
    __host__ __device__ bool next(int i, Unit& u) const {
        const long L = (long)i * G + c; if (L >= nwg) return false;
        int wgid = (int)L; { const int q = nwg / NXCD, r = nwg % NXCD, xcd = wgid % NXCD, off = wgid / NXCD; wgid = (xcd < r ? xcd * (q + 1) : r * (q + 1) + (xcd - r) * q) + off; }
        const int nig = WGM * nN, gid = wgid / nig, fm = gid * WGM, gsz = (nM - fm) < WGM ? (nM - fm) : WGM;
        u.pm = fm + ((wgid % nig) % gsz); u.pn = (wgid % nig) / gsz; u.pb = u.pn; return true;
    }
    __device__ __forceinline__ void a_ready(const Unit&) const {}
    __device__ __forceinline__ void done(const Unit&) const {}
};
struct MoeOrder {
    int nM, nN, nwg, G, c; int tend[8];
    __device__ bool next(int i, Unit& u) const {
        const long L = (long)i * G + c; if (L >= nwg) return false;
        int wgid = (int)L; { const int q = nwg / NXCD, r = nwg % NXCD, xcd = wgid % NXCD, off = wgid / NXCD; wgid = (xcd < r ? xcd * (q + 1) : r * (q + 1) + (xcd - r) * q) + off; }
        const int nig = WGM * nN, gid = wgid / nig, fm = gid * WGM, gsz = (nM - fm) < WGM ? (nM - fm) : WGM;
        u.pm = fm + ((wgid % nig) % gsz); u.pn = (wgid % nig) / gsz;
        int e = 0;
#pragma unroll
        for (int j = 0; j < 7; ++j) e += (u.pm >= tend[j]) ? 1 : 0;
        u.pb = e * nN + u.pn; return true;
    }
    __device__ __forceinline__ void a_ready(const Unit&) const {}
    __device__ __forceinline__ void done(const Unit&) const {}
};

typedef float f32x2_t __attribute__((ext_vector_type(2))); typedef __bf16 bf16x2_t __attribute__((ext_vector_type(2)));
__device__ __forceinline__ unsigned cvt_pk_bf16(float lo, float hi) { const f32x2_t v = {lo, hi}; const bf16x2_t b = __builtin_convertvector(v, bf16x2_t); return __builtin_bit_cast(unsigned, b); }

template <class Epi, class Sched>
__device__ __forceinline__ void gemm_phase(PG8_LAS unsigned char* lds, const Gemm g, const Sched& S, const Epi& E) {
    const int tid = threadIdx.x, wid = __builtin_amdgcn_readfirstlane(tid >> 6), lane = tid & 63, wr = wid >> 2, wc = wid & 3, fr = lane & 15, fq = lane >> 4;
    const int K = g.K, nt = K / BK;
    unsigned voffA[2], voffB[2];
#pragma unroll
    for (int i = 0; i < 2; ++i) { int R, C; stage_rc(tid * 16 + i * 8192, R, C); const int Rb = Epi::PERM ? ((R & ~31) + perm32(R & 31)) : R;
        voffA[i] = (unsigned)(R * K + C) * 2u; voffB[i] = (unsigned)(Rb * K + C) * 2u; }
    const size_t kstep = (size_t)(BK * 2);
    const size_t hstep = (size_t)HALF * K * 2;
    const size_t tstep = 2 * hstep;
    const unsigned ldsw = (unsigned)wid * 1024u;
    const int aoff = lds_byte(wr * 64 + fr, fq * 8), boff = lds_byte(wc * 32 + fr, fq * 8);
#define PG8_SA(b, h) (((b) * 2 + (h)) * HTB)
#define PG8_SB(b, h) ((4 + (b) * 2 + (h)) * HTB)
#define PG8_STAGE(bufoff, gbase, voff) do { _Pragma("unroll") for (int _i = 0; _i < 2; ++_i) \
        __builtin_amdgcn_global_load_lds((const unsigned*)((const char*)(gbase) + (voff)[_i]), (PG8_LAS unsigned*)(lds + (bufoff) + ldsw + _i * 8192), 16, 0, 0); } while (0)
#define PG8_LDA(dst, b, h) do { _Pragma("unroll") for (int m = 0; m < 4; ++m) _Pragma("unroll") for (int k = 0; k < 2; ++k) dst[m][k] = *(const PG8_LAS bf16x8*)(lds + PG8_SA(b, h) + aoff + m * 2048 + k * 1024); } while (0)
#define PG8_LDB(dst, b, h) do { _Pragma("unroll") for (int n = 0; n < 2; ++n) _Pragma("unroll") for (int k = 0; k < 2; ++k) dst[n][k] = *(const PG8_LAS bf16x8*)(lds + PG8_SB(b, h) + boff + n * 2048 + k * 1024); } while (0)
#define PG8_MMA(ai, bj, At, Bt) do { __builtin_amdgcn_s_setprio(1); _Pragma("unroll") for (int m = 0; m < 4; ++m) _Pragma("unroll") for (int n = 0; n < 2; ++n) _Pragma("unroll") for (int k = 0; k < 2; ++k) \
        acc[ai][bj][m][n] = __builtin_amdgcn_mfma_f32_16x16x32_bf16(Bt[n][k], At[m][k], acc[ai][bj][m][n], 0, 0, 0); __builtin_amdgcn_s_setprio(0); } while (0)
#define PG8_WAIT_V(n) asm volatile("s_waitcnt vmcnt(" #n ")" ::: "memory")
#define PG8_WAIT_L(n) asm volatile("s_waitcnt lgkmcnt(" #n ")" ::: "memory")
#define PG8_BAR __builtin_amdgcn_s_barrier()
#define PG8_SCHED __builtin_amdgcn_sched_barrier(0)
    Unit cur, nxt; int ui = 0;
    if (!S.next(0, cur)) return;
    f32x4 acc[2][2][4][2];
#pragma unroll
    for (int a = 0; a < 2; ++a)
#pragma unroll
        for (int b = 0; b < 2; ++b)
#pragma unroll
            for (int m = 0; m < 4; ++m)
#pragma unroll
                for (int n = 0; n < 2; ++n) acc[a][b][m][n] = (f32x4){0.f, 0.f, 0.f, 0.f};
    bf16x8 At[4][2], B0[2][2], B1[2][2];
    const char* cA = (const char*)g.A + (size_t)cur.pm * tstep; const char* cB = (const char*)g.Bt + (size_t)cur.pb * tstep;
    S.a_ready(cur);
    PG8_STAGE(PG8_SB(0, 0), cB, voffB); PG8_STAGE(PG8_SB(0, 1), cB + hstep, voffB); PG8_STAGE(PG8_SA(0, 0), cA, voffA); PG8_STAGE(PG8_SA(0, 1), cA + hstep, voffA);
    if (wr == 1) PG8_BAR;
    PG8_WAIT_V(2); PG8_BAR;
    PG8_STAGE(PG8_SB(1, 0), cB + kstep, voffB); PG8_STAGE(PG8_SA(1, 0), cA + kstep, voffA); PG8_STAGE(PG8_SB(1, 1), cB + hstep + kstep, voffB);
    PG8_WAIT_V(6); PG8_BAR;
    for (;;) {
        const bool has_next = S.next(ui + 1, nxt);
        const char* nA = has_next ? (const char*)g.A + (size_t)nxt.pm * tstep : cA; const char* nB = has_next ? (const char*)g.Bt + (size_t)nxt.pb * tstep : cB;
        for (int t = 0; t < nt; t += 2) {
            const bool last = (t == nt - 2);
            const char* a1 = cA + (size_t)(t + 1) * kstep;
            const char* a2 = last ? nA : cA + (size_t)(t + 2) * kstep; const char* b2 = last ? nB : cB + (size_t)(t + 2) * kstep;
            const char* a3 = a2 + kstep; const char* b3 = b2 + kstep;
            if (last && has_next) S.a_ready(nxt);
            PG8_LDB(B0, 0, 0); PG8_LDB(B1, 0, 1); PG8_SCHED; PG8_LDA(At, 0, 0); PG8_STAGE(PG8_SA(1, 1), a1 + hstep, voffA);
            PG8_WAIT_V(8); PG8_WAIT_L(0); PG8_BAR; PG8_MMA(0, 0, At, B0); PG8_MMA(0, 1, At, B1); PG8_BAR; PG8_SCHED;
            PG8_LDA(At, 0, 1); PG8_STAGE(PG8_SB(0, 0), b2, voffB); PG8_STAGE(PG8_SB(0, 1), b2 + hstep, voffB); PG8_STAGE(PG8_SA(0, 0), a2, voffA);
            PG8_WAIT_V(8); PG8_WAIT_L(0); PG8_BAR; PG8_MMA(1, 0, At, B0); PG8_MMA(1, 1, At, B1); PG8_BAR; PG8_SCHED;
            PG8_LDB(B0, 1, 0); PG8_LDB(B1, 1, 1); PG8_SCHED; PG8_LDA(At, 1, 0); PG8_STAGE(PG8_SA(0, 1), a2 + hstep, voffA);
            PG8_WAIT_V(8); PG8_WAIT_L(0); PG8_BAR; PG8_MMA(0, 0, At, B0); PG8_MMA(0, 1, At, B1); PG8_BAR; PG8_SCHED;
            PG8_LDA(At, 1, 1); PG8_STAGE(PG8_SB(1, 0), b3, voffB); PG8_STAGE(PG8_SB(1, 1), b3 + hstep, voffB); PG8_STAGE(PG8_SA(1, 0), a3, voffA);
            PG8_WAIT_V(8); PG8_WAIT_L(0); PG8_BAR; PG8_MMA(1, 0, At, B0); PG8_MMA(1, 1, At, B1); PG8_BAR; PG8_SCHED;
        }
        if (wr == 0) PG8_BAR;
        E(acc, cur, wr, wc, fr, fq); S.done(cur);
        if (!has_next) break;
#pragma unroll
        for (int a = 0; a < 2; ++a)
#pragma unroll
            for (int b = 0; b < 2; ++b)
#pragma unroll
                for (int m = 0; m < 4; ++m)
#pragma unroll
                    for (int n = 0; n < 2; ++n) acc[a][b][m][n] = (f32x4){0.f, 0.f, 0.f, 0.f};
        cur = nxt; cA = nA; cB = nB; ++ui;
        if (wr == 1) PG8_BAR;
    }
    PG8_WAIT_V(0);
    PG8_BAR;
#undef PG8_SA
#undef PG8_SB
#undef PG8_STAGE
#undef PG8_LDA
#undef PG8_LDB
#undef PG8_MMA
#undef PG8_WAIT_V
#undef PG8_WAIT_L
#undef PG8_BAR
#undef PG8_SCHED
}
}

constexpr int D = 1024, NB = 8, SEQ = 2048, CTXL = 256;
constexpr int ML = NB * SEQ;
constexpr int MC = NB * CTXL;
constexpr int MA = ML + MC;
constexpr int INW = 3584, FFN_H = 2816, EXP_H = 3584, NEXP = 8;
constexpr int NCH = 18;
constexpr int XG_ROWS = 34816;
constexpr int NWAVES = 8, NTHR = 512;

constexpr size_t MiB = 1u << 20;
constexpr size_t WS_CTL = 0, CTL_ZERO_BYTES = 1 * MiB;
constexpr size_t WS_MOD = 1 * MiB;
constexpr size_t WS_ROPE = 2 * MiB;
constexpr size_t WS_MISC = 3 * MiB;
constexpr size_t WS_W_IN = 4 * MiB, WS_W_OUT = 11 * MiB, WS_W_13 = 13 * MiB, WS_W_2 = 24 * MiB, WS_W_RKV = 30 * MiB, WS_W_L1 = 36 * MiB,
                 WS_W_L2 = 38 * MiB, WS_W_G2 = 40 * MiB, WS_W_O = 41 * MiB, WS_W_M13 = 43 * MiB, WS_W_M2 = 155 * MiB;
constexpr size_t WS_XC = 211 * MiB, WS_H = 219 * MiB, WS_MIX = 255 * MiB, WS_R = 291 * MiB;
constexpr size_t WS_QKV = WS_R, WS_KV = WS_R + 126 * MiB, WS_SPREV = WS_R + 198 * MiB, WS_FFH = WS_R;
constexpr size_t WS_NQ = WS_R + 240 * MiB, WS_NK = WS_R + 260 * MiB, WS_NV = WS_R + 280 * MiB;
constexpr size_t WS_XM = WS_R, WS_DEC = WS_R, WS_AG = WS_R + 144 * MiB, WS_RB = WS_R + 216 * MiB, WS_KB = WS_R + 248 * MiB, WS_VB = WS_R + 284 * MiB,
                 WS_L1 = WS_R + 320 * MiB, WS_LG = WS_R + 329 * MiB, WS_G = WS_R + 337 * MiB, WS_YF = WS_R + 369 * MiB, WS_YB = WS_R + 433 * MiB;
constexpr size_t WS_COEF = WS_R + 401 * MiB;
constexpr size_t WS_XG = WS_R, WS_HG = WS_R + 68 * MiB, WS_YS = WS_R + 306 * MiB, WS_ROWS = WS_R + 370 * MiB;
constexpr size_t WS_END = WS_R + 497 * MiB;
static_assert(WS_END <= 896 * MiB, "workspace map");
constexpr int CW_BAR = 4096;
constexpr size_t MISC_TOPE = 0, MISC_TOPW = 65536, MISC_CNTS = 196608, MISC_EXP = 204800;

constexpr int LDS_MAIN = 147456;
constexpr int LDS_MISC_OFF = LDS_MAIN;
constexpr int LDS_BYTES = LDS_MAIN + 256;

typedef unsigned short bf16;
typedef short bf16x8 __attribute__((ext_vector_type(8)));
typedef short s16x4 __attribute__((ext_vector_type(4)));
typedef float f32x4 __attribute__((ext_vector_type(4)));
typedef float f32x2 __attribute__((ext_vector_type(2)));
typedef unsigned u32x4 __attribute__((ext_vector_type(4)));
typedef unsigned u32x2 __attribute__((ext_vector_type(2)));
#define LDS_WAIT() asm volatile("s_waitcnt lgkmcnt(0)" ::: "memory")
#define VM_WAIT() asm volatile("s_waitcnt vmcnt(0)" ::: "memory")
#define WG_SYNC() __syncthreads()
#define LDS_BARRIER() do { asm volatile("s_waitcnt lgkmcnt(0)" ::: "memory"); __builtin_amdgcn_s_barrier(); asm volatile("" ::: "memory"); } while (0)
DI unsigned f2bf(float f) { unsigned u = __builtin_bit_cast(unsigned, f); return (u + 0x7fffu + ((u >> 16) & 1u)) >> 16; }
typedef __bf16 bf16x2_t __attribute__((ext_vector_type(2)));
DI unsigned pk2(float lo, float hi) { const f32x2 v = {lo, hi}; const bf16x2_t b = __builtin_convertvector(v, bf16x2_t); return __builtin_bit_cast(unsigned, b); }
DI float bflo(unsigned w) { return __builtin_bit_cast(float, w << 16); }
DI float bfhi(unsigned w) { return __builtin_bit_cast(float, w & 0xffff0000u); }
DI float bf1(bf16 b) { return __builtin_bit_cast(float, (unsigned)b << 16); }
DI float wave_sum(float v) {
#pragma unroll
    for (int o = 1; o < 64; o <<= 1) v += __shfl_xor(v, o);
    return v;
}
DI float dpp_rm(float v) { return __builtin_bit_cast(float, __builtin_amdgcn_update_dpp(0, __builtin_bit_cast(int, v), 0x140, 0xf, 0xf, true)); }
DI float wave_sum_fast(float v) {
    v += __builtin_bit_cast(float, __builtin_amdgcn_update_dpp(0, __builtin_bit_cast(int, v), 0xB1, 0xf, 0xf, true));
    v += __builtin_bit_cast(float, __builtin_amdgcn_update_dpp(0, __builtin_bit_cast(int, v), 0x4E, 0xf, 0xf, true));
    v += __builtin_bit_cast(float, __builtin_amdgcn_update_dpp(0, __builtin_bit_cast(int, v), 0x141, 0xf, 0xf, true));
    v += dpp_rm(v);
    const int iv = __builtin_bit_cast(int, v);
    const float a = __builtin_bit_cast(float, __builtin_amdgcn_readlane(iv, 0)), b = __builtin_bit_cast(float, __builtin_amdgcn_readlane(iv, 16));
    const float c = __builtin_bit_cast(float, __builtin_amdgcn_readlane(iv, 32)), d = __builtin_bit_cast(float, __builtin_amdgcn_readlane(iv, 48));
    return (a + b) + (c + d);
}
DI float wave_max(float v) {
#pragma unroll
    for (int o = 1; o < 64; o <<= 1) v = fmaxf(v, __shfl_xor(v, o));
    return v;
}
DI float dpp_x1(float v) { return __builtin_bit_cast(float, __builtin_amdgcn_update_dpp(0, __builtin_bit_cast(int, v), 0xB1, 0xf, 0xf, true)); }
DI float dpp_x2(float v) { return __builtin_bit_cast(float, __builtin_amdgcn_update_dpp(0, __builtin_bit_cast(int, v), 0x4E, 0xf, 0xf, true)); }
DI float dpp_hm(float v) { return __builtin_bit_cast(float, __builtin_amdgcn_update_dpp(0, __builtin_bit_cast(int, v), 0x141, 0xf, 0xf, true)); }
DI float red4(float v) { v += dpp_x1(v); v += dpp_x2(v); return v; }
DI float red8(float v) { v += dpp_x1(v); v += dpp_x2(v); v += dpp_hm(v); return v; }
DI float sigmoidf_(float x) { return __builtin_amdgcn_rcpf(1.f + __expf(-x)); }
DI float siluf_(float x) { return x * __builtin_amdgcn_rcpf(1.f + __expf(-x)); }

DI bf16x8 frag_kc(const LAS bf16* base, int ld, int row0, int k0, int lane) {
    return *(const LAS bf16x8*)(base + (row0 + (lane & 15)) * ld + k0 + 8 * (lane >> 4));
}
DI bf16x8 frag_kr(const LAS bf16* base, int ld, int x0, int k0, int lane) {
    const int g = lane >> 4, q = (lane & 15) >> 2, p = lane & 3;
    const LAS bf16* a = base + (k0 + 8 * g + q) * ld + x0 + 4 * p;
    const s16x4 lo = __builtin_amdgcn_ds_read_tr16_b64_v4i16((LAS s16x4*)a);
    const s16x4 hi = __builtin_amdgcn_ds_read_tr16_b64_v4i16((LAS s16x4*)(a + 4 * ld));
    return __builtin_shufflevector(lo, hi, 0, 1, 2, 3, 4, 5, 6, 7);
}
DI f32x4 mma(f32x4 acc, bf16x8 bfrag, bf16x8 afrag) { return __builtin_amdgcn_mfma_f32_16x16x32_bf16(bfrag, afrag, acc, 0, 0, 0); }

#define XB_TMO      128
#define XB_XCNT(j)  (256  + 64 * (j))
#define XB_XSUB(j)  (1280 + 64 * (j))
#define XB_XGEN(j)  (2304 + 64 * (j))
#define XB_TOP      3328
#define XB_TOPGEN   3392
#define XCD_BAR_WORDS 3456
#define XB_SPIN_CAP (1u << 18)
DI unsigned xb_ld(unsigned* p)              { return __hip_atomic_load(p, __ATOMIC_RELAXED, __HIP_MEMORY_SCOPE_AGENT); }
DI unsigned xb_add(unsigned* p, unsigned v) { return __hip_atomic_fetch_add(p, v, __ATOMIC_RELAXED, __HIP_MEMORY_SCOPE_AGENT); }
DI unsigned xb_xcc_id() { return (unsigned)__builtin_amdgcn_s_getreg((3 << 11) | 20) & 0xFu; }
#define XB_SPIN(cond, bar) do { unsigned _sp = 0; while (cond) { __builtin_amdgcn_s_sleep(1); \
    if ((++_sp & 255u) == 0u) { if (xb_ld(&(bar)[XB_TMO])) break; if (_sp > XB_SPIN_CAP) { atomicAdd(&(bar)[XB_TMO], 1u); break; } } } } while (0)
struct XcdBarrier { unsigned* bar; unsigned x; volatile LAS unsigned* st; };
DI XcdBarrier xcd_barrier_post(unsigned* bar, volatile LAS unsigned* st) {
    XcdBarrier b; b.bar = bar; b.x = xb_xcc_id(); b.st = st;
    if (threadIdx.x == 0) (void)xb_add(&bar[XB_XCNT(b.x)], 1u);
    return b;
}
DI void xcd_barrier_complete(unsigned* bar, unsigned x, unsigned& nloc, unsigned& nx) {
    const unsigned G = gridDim.x * gridDim.y * gridDim.z;
    unsigned sum, cnt, mine, sp = 0u;
    for (;;) {
        sum = 0u; cnt = 0u; mine = 0u;
#pragma unroll
        for (unsigned j = 0; j < 16; ++j) { const unsigned c = xb_ld(&bar[XB_XCNT(j)]); sum += c; cnt += (c > 0u) ? 1u : 0u; mine = (j == x) ? c : mine; }
        if (sum == G) break;
        __builtin_amdgcn_s_sleep(1);
        if ((++sp & 255u) == 0u) { if (xb_ld(&bar[XB_TMO])) break; if (sp > XB_SPIN_CAP) { atomicAdd(&bar[XB_TMO], 1u); break; } }
    }
    nloc = mine > 0u ? mine : 1u; nx = cnt > 0u ? cnt : 1u;
}
DI void xcd_barrier(const XcdBarrier& b) {
    asm volatile("s_waitcnt vmcnt(0)" ::: "memory");
    __syncthreads();
    if (threadIdx.x == 0) {
        unsigned* bar = b.bar;
        __builtin_amdgcn_s_waitcnt(0);
        unsigned nloc = b.st[0], nx = b.st[1];
        if (nloc == 0u) { xcd_barrier_complete(bar, b.x, nloc, nx); b.st[0] = nloc; b.st[1] = nx; }
        const unsigned old = xb_add(&bar[XB_XSUB(b.x)], 1u);
        const unsigned gen = old / nloc;
        if (old + 1u == (gen + 1u) * nloc) {
            __builtin_amdgcn_fence(__ATOMIC_RELEASE, "agent");
            asm volatile("s_waitcnt vmcnt(0)" ::: "memory");
            const unsigned og = xb_add(&bar[XB_TOP], 1u);
            const unsigned tg = og / nx;
            if (og + 1u == (tg + 1u) * nx) xb_add(&bar[XB_TOPGEN], 1u);
            else XB_SPIN(xb_ld(&bar[XB_TOPGEN]) == tg, bar);
            __builtin_amdgcn_fence(__ATOMIC_ACQUIRE, "agent");
            xb_add(&bar[XB_XGEN(b.x)], 1u);
            asm volatile("s_waitcnt vmcnt(0)" ::: "memory");
        } else {
            XB_SPIN(xb_ld(&bar[XB_XGEN(b.x)]) == gen, bar);
            __builtin_amdgcn_fence(__ATOMIC_ACQUIRE, "agent");
            asm volatile("s_waitcnt vmcnt(0)" ::: "memory");
        }
    }
    __syncthreads();
}

struct Fr {
    LAS unsigned char* lds;
    unsigned char* ws;
    const float* const* in;
    float* out;
    int tid, lane, wave, bx, G, gw, NGW;
};

using pg8::Unit;
template <int ACT  > struct EpiStore {
    static constexpr bool PERM = true;
    bf16* O; int ldc; int nvalid;
    DI void operator()(const f32x4 (&acc)[2][2][4][2], const Unit& u, int wr, int wc, int fr, int fq) const {
        const int row0 = u.pm * 256 + wr * 64 + fr, col0 = u.pn * 256 + wc * 32 + 8 * fq;
#pragma unroll
        for (int ai = 0; ai < 2; ++ai)
#pragma unroll
            for (int m = 0; m < 4; ++m) { bf16* rowp = O + (size_t)(row0 + ai * 128 + m * 16) * ldc + col0;
#pragma unroll
                for (int bj = 0; bj < 2; ++bj) { if (u.pn * 256 + bj * 128 >= nvalid) continue;
                    f32x4 v0 = acc[ai][bj][m][0], v1 = acc[ai][bj][m][1];
                    if (ACT == 1) {
#pragma unroll
                        for (int j = 0; j < 4; ++j) { v0[j] = 1.f - 2.f * __builtin_amdgcn_rcpf(1.f + __expf(2.f * v0[j])); v1[j] = 1.f - 2.f * __builtin_amdgcn_rcpf(1.f + __expf(2.f * v1[j])); } }
                    if (ACT == 2) {
#pragma unroll
                        for (int j = 0; j < 4; ++j) { v0[j] = sigmoidf_(v0[j]); v1[j] = sigmoidf_(v1[j]); } }
                    u32x4 w; w.x = pg8::cvt_pk_bf16(v0[0], v0[1]); w.y = pg8::cvt_pk_bf16(v0[2], v0[3]); w.z = pg8::cvt_pk_bf16(v1[0], v1[1]); w.w = pg8::cvt_pk_bf16(v1[2], v1[3]);
                    *(u32x4*)(rowp + bj * 128) = w; } }
    }
};
struct EpiStoreHead {
    static constexpr bool PERM = true;
    bf16* O; int TL; int lat_off;
    DI void operator()(const f32x4 (&acc)[2][2][4][2], const Unit& u, int wr, int wc, int fr, int fq) const {
        const bool lat = u.pm < 64; const int b = lat ? (u.pm >> 3) : (u.pm - 64); const int sbase = lat ? lat_off + (u.pm & 7) * 256 : 0;
        const int rt0 = sbase + wr * 64 + fr, j = (wc & 1) * 32 + 8 * fq;
#pragma unroll
        for (int ai = 0; ai < 2; ++ai)
#pragma unroll
            for (int m = 0; m < 4; ++m)
#pragma unroll
                for (int bj = 0; bj < 2; ++bj) { const int h = 4 * u.pn + 2 * bj + (wc >> 1);
                    const f32x4 v0 = acc[ai][bj][m][0], v1 = acc[ai][bj][m][1];
                    u32x4 w; w.x = pg8::cvt_pk_bf16(v0[0], v0[1]); w.y = pg8::cvt_pk_bf16(v0[2], v0[3]); w.z = pg8::cvt_pk_bf16(v1[0], v1[1]); w.w = pg8::cvt_pk_bf16(v1[2], v1[3]);
                    *(u32x4*)(O + ((size_t)(b * 16 + h) * TL + rt0 + ai * 128 + m * 16) * 64 + j) = w; }
    }
};
struct EpiResid {
    static constexpr bool PERM = false;
    const float* baseL; float* outL; const float* baseC; float* outC; const float* modg;
    DI void operator()(const f32x4 (&acc)[2][2][4][2], const Unit& u, int wr, int wc, int fr, int fq) const {
        const bool lat = u.pm < 64; const int r = lat ? (u.pm >> 3) : 8;
        const float* base = lat ? baseL : baseC; float* out = lat ? outL : outC;
        const int row0 = (lat ? u.pm : u.pm - 64) * 256 + wr * 64 + fr, col0 = u.pn * 256 + wc * 32 + 4 * fq;
        const float* mg = modg + (size_t)r * 6144 + col0;
        f32x4 mv[2][2];
#pragma unroll
        for (int bj = 0; bj < 2; ++bj)
#pragma unroll
            for (int n = 0; n < 2; ++n) mv[bj][n] = *(const f32x4*)(mg + bj * 128 + n * 16);
#pragma unroll
        for (int ai = 0; ai < 2; ++ai)
#pragma unroll
            for (int m = 0; m < 4; ++m) { const size_t off = (size_t)(row0 + ai * 128 + m * 16) * D + col0;
#pragma unroll
                for (int bj = 0; bj < 2; ++bj)
#pragma unroll
                    for (int n = 0; n < 2; ++n) { const f32x4 bs = *(const f32x4*)(base + off + bj * 128 + n * 16);
                        *(f32x4*)(out + off + bj * 128 + n * 16) = bs + mv[bj][n] * acc[ai][bj][m][n]; } }
    }
};
struct EpiSwiglu {
    static constexpr bool PERM = true;
    bf16* Hd; int ldh;
    DI void operator()(const f32x4 (&acc)[2][2][4][2], const Unit& u, int wr, int wc, int fr, int fq) const {
        const int row0 = u.pm * 256 + wr * 64 + fr, col0 = u.pn * 128 + wc * 32 + 8 * fq;
#pragma unroll
        for (int ai = 0; ai < 2; ++ai)
#pragma unroll
            for (int m = 0; m < 4; ++m) { bf16* rowp = Hd + (size_t)(row0 + ai * 128 + m * 16) * ldh + col0;
                f32x4 v0, v1;
#pragma unroll
                for (int j = 0; j < 4; ++j) { v0[j] = siluf_(acc[ai][0][m][0][j]) * acc[ai][1][m][0][j]; v1[j] = siluf_(acc[ai][0][m][1][j]) * acc[ai][1][m][1][j]; }
                u32x4 w; w.x = pg8::cvt_pk_bf16(v0[0], v0[1]); w.y = pg8::cvt_pk_bf16(v0[2], v0[3]); w.z = pg8::cvt_pk_bf16(v1[0], v1[1]); w.w = pg8::cvt_pk_bf16(v1[2], v1[3]);
                *(u32x4*)rowp = w; }
    }
};
struct EpiLora2 {
    static constexpr bool PERM = true;
    bf16* DEC; bf16* AG; const float* w0; const float* a0;
    DI void operator()(const f32x4 (&acc)[2][2][4][2], const Unit& u, int wr, int wc, int fr, int fq) const {
        const int q = u.pn >> 2, z = q & 1; const int col0 = (u.pn & 3) * 256 + wc * 32 + 8 * fq;
        const bool lat = u.pm < 64; const int b = lat ? (u.pm >> 3) : (u.pm - 64); const int rt0 = (lat ? CTXL + (u.pm & 7) * 256 : 0) + wr * 64 + fr, j = (wc & 1) * 32 + 8 * fq;
        const float* bias = (q < 2 ? w0 : a0) + z * 1024 + col0;
        f32x4 bv[2][2];
#pragma unroll
        for (int bj = 0; bj < 2; ++bj)
#pragma unroll
            for (int n = 0; n < 2; ++n) bv[bj][n] = *(const f32x4*)(bias + bj * 128 + 4 * n);
#pragma unroll
        for (int ai = 0; ai < 2; ++ai)
#pragma unroll
            for (int m = 0; m < 4; ++m) {
#pragma unroll
                for (int bj = 0; bj < 2; ++bj) { f32x4 v0 = acc[ai][bj][m][0] + bv[bj][0], v1 = acc[ai][bj][m][1] + bv[bj][1];
                    const int h = 4 * (u.pn & 3) + 2 * bj + (wc >> 1);
                    const size_t off = ((size_t)(z * 128 + b * 16 + h) * (SEQ + CTXL) + rt0 + ai * 128 + m * 16) * 64 + j;
                    if (q < 2) {
#pragma unroll
                        for (int jj = 0; jj < 4; ++jj) {
                            v0[jj] = -0.6065306597126334f * sigmoidf_(v0[jj]); v1[jj] = -0.6065306597126334f * sigmoidf_(v1[jj]); }
                        u32x4 w; w.x = pg8::cvt_pk_bf16(v0[0], v0[1]); w.y = pg8::cvt_pk_bf16(v0[2], v0[3]); w.z = pg8::cvt_pk_bf16(v1[0], v1[1]); w.w = pg8::cvt_pk_bf16(v1[2], v1[3]);
                        *(u32x4*)(DEC + off) = w; __builtin_amdgcn_sched_barrier(0);
                    } else {
#pragma unroll
                        for (int jj = 0; jj < 4; ++jj) { v0[jj] = sigmoidf_(v0[jj]); v1[jj] = sigmoidf_(v1[jj]); }
                        u32x4 w; w.x = pg8::cvt_pk_bf16(v0[0], v0[1]); w.y = pg8::cvt_pk_bf16(v0[2], v0[3]); w.z = pg8::cvt_pk_bf16(v1[0], v1[1]); w.w = pg8::cvt_pk_bf16(v1[2], v1[3]);
                        *(u32x4*)(AG + off) = w; __builtin_amdgcn_sched_barrier(0); } } }
    }
};
struct EpiMoeOut {
    static constexpr bool PERM = true;
    bf16* YS; const int* RowTok; const float* RowW;
    DI void operator()(const f32x4 (&acc)[2][2][4][2], const Unit& u, int wr, int wc, int fr, int fq) const {
        const int row0 = u.pm * 256 + wr * 64 + fr, col0 = u.pn * 256 + wc * 32 + 8 * fq;
#pragma unroll
        for (int ai = 0; ai < 2; ++ai)
#pragma unroll
            for (int m = 0; m < 4; ++m) { const int row = row0 + ai * 128 + m * 16; const int t2 = RowTok[row]; if (t2 < 0) continue; const float w = RowW[row];
                bf16* rowp = YS + (size_t)t2 * D + col0;
#pragma unroll
                for (int bj = 0; bj < 2; ++bj) { const f32x4 v0 = acc[ai][bj][m][0] * w, v1 = acc[ai][bj][m][1] * w;
                    u32x4 o; o.x = pg8::cvt_pk_bf16(v0[0], v0[1]); o.y = pg8::cvt_pk_bf16(v0[2], v0[3]); o.z = pg8::cvt_pk_bf16(v1[0], v1[1]); o.w = pg8::cvt_pk_bf16(v1[2], v1[3]);
                    *(u32x4*)(rowp + bj * 128) = o; } }
    }
};

DI void tr_item(const float* src, int ldsrc, int Kreal, int k0, int n0, bf16* dst, int lddst, int drow0, int dcol0, LAS float* scr, int lane) {
#pragma unroll 8
    for (int i = 0; i < 32; ++i) { const int kk = 2 * i + (lane >> 5), k = k0 + kk; float v = 0.f; if (k < Kreal) v = src[(size_t)k * ldsrc + n0 + (lane & 31)]; scr[kk * 33 + (lane & 31)] = v; }
    LDS_WAIT();
    const int c = lane & 7;
#pragma unroll
    for (int j = 0; j < 4; ++j) { const int n = (lane >> 3) + 8 * j; const LAS float* s = scr + (8 * c) * 33 + n;
        u32x4 o; o.x = pk2(s[0 * 33], s[1 * 33]); o.y = pk2(s[2 * 33], s[3 * 33]); o.z = pk2(s[4 * 33], s[5 * 33]); o.w = pk2(s[6 * 33], s[7 * 33]);
        *(u32x4*)(dst + (size_t)(drow0 + n) * lddst + dcol0 + k0 + 8 * c) = o; }
    LDS_WAIT();
}
DI void tr_plain(const float* src, int K, int N, bf16* dst, int r, LAS float* scr, int lane) {
    const int nblk = N / 32, kb = r / nblk, nb = r % nblk; tr_item(src, N, K, 64 * kb, 32 * nb, dst, K, 32 * nb, 0, scr, lane);
}
DI void tr_gateup(const float* src, int K, int Hh, bf16* dst, int r, LAS float* scr, int lane) {
    const int nblk = 2 * Hh / 32, kb = r / nblk, nb = r % nblk, n0 = 32 * nb, half = n0 / Hh, j0 = n0 % Hh;
    tr_item(src, 2 * Hh, K, 64 * kb, n0, dst, K, (j0 / 128) * 256 + half * 128 + (j0 % 128), 0, scr, lane);
}
DI void tr16_item(const float* src, int ldsrc, int k0, int n0, bf16* dst, int lddst, int Hh, int lane) {
    f32x4 v[16];
#pragma unroll
    for (int kk = 0; kk < 16; ++kk) v[kk] = *(const f32x4*)(src + (size_t)(k0 + kk) * ldsrc + n0 + 4 * lane);
    const int n = n0 + 4 * lane; int drow = n;
    if (Hh) { const int half = n / Hh, j = n % Hh; drow = (j / 128) * 256 + half * 128 + (j % 128); }
#pragma unroll
    for (int q = 0; q < 4; ++q) { u32x4 o0, o1;
        o0.x = pk2(v[0][q], v[1][q]); o0.y = pk2(v[2][q], v[3][q]); o0.z = pk2(v[4][q], v[5][q]); o0.w = pk2(v[6][q], v[7][q]);
        o1.x = pk2(v[8][q], v[9][q]); o1.y = pk2(v[10][q], v[11][q]); o1.z = pk2(v[12][q], v[13][q]); o1.w = pk2(v[14][q], v[15][q]);
        bf16* d = dst + (size_t)(drow + q) * lddst + k0; *(u32x4*)d = o0; *(u32x4*)(d + 8) = o1; }
}
DI void tr64_item(const float* src, int ldsrc, int k0, int n0, bf16* dst, int lddst, int Hh, int lane) {
    float v[64];
    const float* sp = src + (size_t)k0 * ldsrc + n0 + lane;
#pragma unroll
    for (int kk = 0; kk < 64; ++kk) v[kk] = sp[(size_t)kk * ldsrc];
    const int n = n0 + lane; int drow = n;
    if (Hh) { const int half = n / Hh, j = n % Hh; drow = (j / 128) * 256 + half * 128 + (j % 128); }
    bf16* d = dst + (size_t)drow * lddst + k0;
#pragma unroll
    for (int c = 0; c < 8; ++c) { u32x4 o; o.x = pk2(v[8 * c], v[8 * c + 1]); o.y = pk2(v[8 * c + 2], v[8 * c + 3]); o.z = pk2(v[8 * c + 4], v[8 * c + 5]); o.w = pk2(v[8 * c + 6], v[8 * c + 7]);
        *(u32x4*)(d + 8 * c) = o; }
}
DI void tr16_mat(const float* src, int K, int N, bf16* dst, int Hh, int r, int lane) { const int nb = N / 64; tr64_item(src, N, 64 * (r / nb), 64 * (r % nb), dst, K, Hh, lane); }
struct TrItem { const float* src; bf16* dst; int ldsrc, lddst, k0, n0, Hh; };
DI void tr_wg_load(const TrItem& t, f32x4 (&v)[8], int wave, int lane) {
    const float* sp = t.src + (size_t)(t.k0 + 8 * wave) * t.ldsrc + t.n0 + 4 * lane;
#pragma unroll
    for (int kk = 0; kk < 8; ++kk) v[kk] = *(const f32x4*)(sp + (size_t)kk * t.ldsrc);
}
DI void tr_wg_to_lds(const f32x4 (&v)[8], LAS bf16* img, int wave, int lane) {
#pragma unroll
    for (int q = 0; q < 4; ++q) { u32x4 o; o.x = pk2(v[0][q], v[1][q]); o.y = pk2(v[2][q], v[3][q]); o.z = pk2(v[4][q], v[5][q]); o.w = pk2(v[6][q], v[7][q]);
        *(LAS u32x4*)(img + (4 * lane + q) * 72 + 8 * wave) = o; }
}
DI void tr_wg_store(const TrItem& t, const LAS bf16* img, int wave, int lane) {
    const int row = 32 * wave + (lane >> 1), half = lane & 1, n = t.n0 + row; int drow = n;
    if (t.Hh) { const int hf = n / t.Hh, j = n % t.Hh; drow = (j / 128) * 256 + hf * 128 + (j % 128); }
    bf16* d = t.dst + (size_t)drow * t.lddst + t.k0 + 32 * half;
#pragma unroll
    for (int i = 0; i < 4; ++i) *(u32x4*)(d + 8 * i) = *(const LAS u32x4*)(img + row * 72 + 32 * half + 8 * i);
}
constexpr int WG_M13 = 16 * 28, WG_M2 = 56 * 4, WG_MOE = 8 * WG_M13 + 8 * WG_M2;
constexpr int WG_IN = 16 * 14, WG_OUT = 16 * 4, WG_13 = 16 * 22, WG_2 = 44 * 4, WG_RKV = 64, WG_O = 64, WG_DENSE = WG_IN + WG_OUT + WG_13 + WG_2 + 3 * WG_RKV + WG_O;
DI TrItem tr_mat_item(const float* src, int K, int N, bf16* dst, int Hh, int r) { const int nb = N / 256; return TrItem{src, dst, N, K, 64 * (r / nb), 256 * (r % nb), Hh}; }
DI TrItem moe_item(Fr& F, int r) {
    bf16* W_M13 = (bf16*)(F.ws + WS_W_M13); bf16* W_M2 = (bf16*)(F.ws + WS_W_M2);
    if (r < 8 * WG_M13) { const int e = r / WG_M13; return tr_mat_item(F.in[35] + (size_t)e * 1024 * 7168, 1024, 7168, W_M13 + (size_t)e * 7168 * 1024, EXP_H, r % WG_M13); }
    const int r2 = r - 8 * WG_M13, e = r2 / WG_M2; return tr_mat_item(F.in[36] + (size_t)e * EXP_H * 1024, EXP_H, 1024, W_M2 + (size_t)e * 1024 * EXP_H, 0, r2 % WG_M2);
}
DI TrItem dense_item(Fr& F, int r) {
    const float* const* in = F.in;
    if (r < WG_IN) return tr_mat_item(in[8], 1024, INW, (bf16*)(F.ws + WS_W_IN), 0, r); r -= WG_IN;
    if (r < WG_OUT) return tr_mat_item(in[15], 1024, 1024, (bf16*)(F.ws + WS_W_OUT), 0, r); r -= WG_OUT;
    if (r < WG_13) return tr_mat_item(in[16], 1024, 2 * FFN_H, (bf16*)(F.ws + WS_W_13), FFN_H, r); r -= WG_13;
    if (r < WG_2) return tr_mat_item(in[17], FFN_H, 1024, (bf16*)(F.ws + WS_W_2), 0, r); r -= WG_2;
    if (r < 3 * WG_RKV) { const int sx = r / WG_RKV; return tr_mat_item(in[19] + (size_t)sx * 1024 * 1024, 1024, 1024, (bf16*)(F.ws + WS_W_RKV) + (size_t)sx * 1024 * 1024, 0, r % WG_RKV); } r -= 3 * WG_RKV;
    return tr_mat_item(in[33], 1024, 1024, (bf16*)(F.ws + WS_W_O), 0, r);
}
template <int L> DI void tr_wg_run(Fr& F, int first, int stride, int end) {
    if (first >= end) return;
    LAS bf16* img0 = (LAS bf16*)F.lds; LAS bf16* img1 = img0 + 256 * 72;
    f32x4 v[8]; TrItem cur = L ? moe_item(F, first) : dense_item(F, first);
    tr_wg_load(cur, v, F.wave, F.lane);
    int par = 0;
    for (int r = first; r < end; r += stride, par ^= 1) {
        LAS bf16* img = par ? img1 : img0;
        tr_wg_to_lds(v, img, F.wave, F.lane);
        TrItem nxt = cur; const bool more = r + stride < end;
        if (more) { nxt = L ? moe_item(F, r + stride) : dense_item(F, r + stride); tr_wg_load(nxt, v, F.wave, F.lane); }
        LDS_BARRIER();
        tr_wg_store(cur, img, F.wave, F.lane);
        cur = nxt;
    }
    LDS_BARRIER();
}
constexpr int MOE_ITEMS = WG_MOE;
constexpr int CV_SCAN_ITEMS = 4608;
constexpr int FILL_A = 0, FILL_B = 0, FILL_C = 0;
DI void moe_fill(Fr& F, int slot, int nslots, int i0, int i1) {
    if (slot < 0 || slot >= nslots) return;
    tr_wg_run<1>(F, i0 + slot, nslots, i1);
}
DI void p0_prologue(Fr& F) {
    LAS float* scr = (LAS float*)(F.lds + F.wave * 16384);
    const float* const* in = F.in;
    bf16* W_IN = (bf16*)(F.ws + WS_W_IN); bf16* W_OUT = (bf16*)(F.ws + WS_W_OUT); bf16* W_13 = (bf16*)(F.ws + WS_W_13); bf16* W_2 = (bf16*)(F.ws + WS_W_2);
    bf16* W_RKV = (bf16*)(F.ws + WS_W_RKV); bf16* W_L1 = (bf16*)(F.ws + WS_W_L1); bf16* W_L2 = (bf16*)(F.ws + WS_W_L2); bf16* W_G2 = (bf16*)(F.ws + WS_W_G2);
    bf16* W_O = (bf16*)(F.ws + WS_W_O);
    tr_wg_run<0>(F, F.bx, F.G, WG_DENSE);
    tr_wg_run<1>(F, CV_SCAN_ITEMS + F.bx, F.G, WG_MOE);
    constexpr int I_W1 = 2 * 32, I_A1 = 2 * 32, I_G1 = 16 * 5, I_L2 = 4 * 32, I_G2 = 4 * 32;
    constexpr int NITEMS = I_W1 + I_A1 + I_G1 + I_L2 + I_G2;
    for (int it = F.gw; it < NITEMS; it += F.NGW) {
        int r = it;
        if (r < I_W1) { const int z = r / 32, rr = r % 32; tr_item(in[21] + (size_t)z * 1024 * 64, 64, 1024, 64 * (rr / 2), 32 * (rr % 2), W_L1, 1024, z * 64 + 32 * (rr % 2), 0, scr, F.lane); continue; } r -= I_W1;
        if (r < I_A1) { const int z = r / 32, rr = r % 32; tr_item(in[24] + (size_t)z * 1024 * 64, 64, 1024, 64 * (rr / 2), 32 * (rr % 2), W_L1 + 256 * 1024, 1024, z * 64 + 32 * (rr % 2), 0, scr, F.lane); continue; } r -= I_A1;
        if (r < I_G1) { tr_item(in[26], 160, 1024, 64 * (r / 5), 32 * (r % 5), W_L1 + 2 * 256 * 1024, 1024, 32 * (r % 5), 0, scr, F.lane); continue; } r -= I_G1;
        if (r < I_L2) { const int q = r / 32, nb = r % 32; const float* src = (q < 2 ? in[22] : in[25]) + (size_t)(q & 1) * 64 * 1024;
            for (int i = F.lane; i < 32 * 24; i += 64) { const int row = i / 24, ch = i % 24; const int col = 8 * ch + (8 * ch >= q * 64 ? 64 : 0);
                *(u32x4*)(W_L2 + (size_t)(q * 1024 + 32 * nb + row) * 256 + col) = (u32x4){0u, 0u, 0u, 0u}; }
            tr_item(src, 1024, 64, 0, 32 * nb, W_L2, 256, q * 1024 + 32 * nb, q * 64, scr, F.lane); continue; } r -= I_L2;
        tr_item(in[27], 1024, 160, 64 * (r / 32), 32 * (r % 32), W_G2, 256, 32 * (r % 32), 0, scr, F.lane);
    }
    { const int gt = F.bx * NTHR + F.tid, NT = F.G * NTHR;
      for (int i = gt; i < (128 + 128 + 96) * 128; i += NT) { int row = i / 128; const int ch = i % 128; int mat = 0;
          if (row >= 256) { mat = 2; row = row - 256 + 160; } else if (row >= 128) { mat = 1; } else { row += 128; }
          *(u32x4*)(W_L1 + ((size_t)mat * 256 + row) * 1024 + 8 * ch) = (u32x4){0u, 0u, 0u, 0u}; }
      f32x2* rope = (f32x2*)(F.ws + WS_ROPE);
      for (int i = gt; i < 2048; i += NT) { const int pos = i >> 5, j = i & 31; const float fr = powf(10000.f, -(float)j / 32.f), ang = (float)pos * fr; rope[i] = (f32x2){cosf(ang), sinf(ang)}; }
    }
    WG_SYNC();
    for (int prep_ = 0; prep_ < ((((PROBE_DUP) >> 23) & 1u) ? 2 : 1); ++prep_)
    for (int u = F.bx; u < 192; u += F.G) {
        const int li = u / 96, n0 = (u % 96) * 64;
        LAS float* sm = (LAS float*)F.lds;
        for (int idx = F.tid; idx < 9 * 1024; idx += NTHR) { const int r = idx >> 10, k = idx & 1023; const float cv = (r < 8) ? in[1][r * 1024 + k] : in[3][k]; sm[idx] = cv / (1.f + expf(-cv)); }
        WG_SYNC();
        const int ks = F.tid >> 4, cg4 = F.tid & 15;
        f32x4 acc[9];
#pragma unroll
        for (int r = 0; r < 9; ++r) acc[r] = (f32x4){0.f, 0.f, 0.f, 0.f};
        const float* w = in[4] + (size_t)li * 1024 * 6144 + n0 + 4 * cg4;
#pragma unroll 8
        for (int k = ks * 32; k < ks * 32 + 32; ++k) { const f32x4 wv = *(const f32x4*)(w + (size_t)k * 6144);
#pragma unroll
            for (int r = 0; r < 9; ++r) acc[r] += wv * sm[r * 1024 + k]; }
        LAS float* red = sm + 9 * 1024;
#pragma unroll
        for (int r = 0; r < 9; ++r) *(LAS f32x4*)(red + (ks * 9 + r) * 64 + 4 * cg4) = acc[r];
        WG_SYNC();
        float* MOD = (float*)(F.ws + WS_MOD);
        for (int idx = F.tid; idx < 9 * 64; idx += NTHR) { const int r = idx / 64, n2 = idx % 64; float s = 0.f;
#pragma unroll
            for (int q = 0; q < 32; ++q) s += red[(q * 9 + r) * 64 + n2];
            MOD[((size_t)li * 9 + r) * 6144 + n0 + n2] = s + in[5][li * 6144 + n0 + n2]; }
        WG_SYNC();
    }
}

DI void mod_rows(Fr& F, const float* xl, const float* xc, int nrows, const float* normw, const float* modl, int off_shift, int off_scale, bf16* H) {
    for (int g = F.gw; g < nrows / 4; g += F.NGW) {
        const int row0 = 4 * g;
        const float* src = row0 < ML ? xl + (size_t)row0 * D : xc + (size_t)(row0 - ML) * D;
        const float* mrow = modl + (size_t)(row0 < ML ? row0 / SEQ : 8) * 6144;
        f32x4 v[4][4];
#pragma unroll
        for (int r = 0; r < 4; ++r)
#pragma unroll
            for (int j = 0; j < 4; ++j) v[r][j] = ((const f32x4*)(src + (size_t)r * D))[F.lane + 64 * j];
        f32x4 gsc[4], gsh[4];
#pragma unroll
        for (int j = 0; j < 4; ++j) { const int c4 = F.lane + 64 * j; gsc[j] = ((const f32x4*)normw)[c4] * (((const f32x4*)(mrow + off_scale))[c4] + 1.f); gsh[j] = ((const f32x4*)(mrow + off_shift))[c4]; }
#pragma unroll
        for (int r = 0; r < 4; ++r) { float ss = 0.f;
#pragma unroll
            for (int j = 0; j < 4; ++j) ss += (v[r][j].x * v[r][j].x + v[r][j].y * v[r][j].y) + (v[r][j].z * v[r][j].z + v[r][j].w * v[r][j].w);
            const float rstd = rsqrtf(wave_sum_fast(ss) * (1.f / D) + 1e-6f);
            u32x2* o = (u32x2*)(H + (size_t)(row0 + r) * D);
#pragma unroll
            for (int j = 0; j < 4; ++j) { const f32x4 y = v[r][j] * rstd * gsc[j] + gsh[j]; u32x2 p; p.x = pk2(y.x, y.y); p.y = pk2(y.z, y.w); o[F.lane + 64 * j] = p; } }
    }
}

DI void load_rope_pair(const bf16* rowp, int hh, int jj, bool lat, int rpos, int cpos, const f32x2* rope, float scl, float (&x1)[8], float (&x2)[8]) {
    const u32x4 a = *(const u32x4*)(rowp + hh * 64 + jj), b = *(const u32x4*)(rowp + hh * 64 + jj + 32);
    const unsigned aw[4] = {a.x, a.y, a.z, a.w}, bw[4] = {b.x, b.y, b.z, b.w};
#pragma unroll
    for (int i = 0; i < 4; ++i) { x1[2 * i] = bflo(aw[i]); x1[2 * i + 1] = bfhi(aw[i]); x2[2 * i] = bflo(bw[i]); x2[2 * i + 1] = bfhi(bw[i]); }
    if (lat) { const int pos = hh ? cpos : rpos;
#pragma unroll
        for (int i = 0; i < 8; ++i) { const f32x2 cs = rope[pos * 32 + jj + i]; const float y1 = x1[i] * cs.x - x2[i] * cs.y, y2 = x1[i] * cs.y + x2[i] * cs.x; x1[i] = y1; x2[i] = y2; } }
#pragma unroll
    for (int i = 0; i < 8; ++i) { x1[i] *= scl; x2[i] *= scl; }
}
DI u32x4 pack8(const float (&x)[8], float s) { u32x4 o; o.x = pk2(x[0] * s, x[1] * s); o.y = pk2(x[2] * s, x[3] * s); o.z = pk2(x[4] * s, x[5] * s); o.w = pk2(x[6] * s, x[7] * s); return o; }
constexpr int RLD = 136;
constexpr int RTILE = 128 * RLD * 2;
DI int ret_row0(int b, int id) { return id < 2 ? ML + b * CTXL + id * 128 : b * SEQ + (id - 2) * 128; }

DI void ret_kv_phase(Fr& F) {
    const bf16* QKV = (const bf16*)(F.ws + WS_QKV); float* KV = (float*)(F.ws + WS_KV); const f32x2* rope = (const f32x2*)(F.ws + WS_ROPE);
    LAS bf16* Vs = (LAS bf16*)F.lds; LAS bf16* Kf = (LAS bf16*)(F.lds + RTILE); LAS bf16* Kb = (LAS bf16*)(F.lds + 2 * RTILE);
    const int wr2 = F.wave >> 1, wc2 = F.wave & 1, fr = F.lane & 15, fq = F.lane >> 4;
    for (int u = F.bx; u < NB * 4 * NCH; u += F.G) {
        const int b = u / (4 * NCH), h = (u / NCH) % 4, id = u % NCH; const int grow0 = ret_row0(b, id); const bool lat = id >= 2;
        const float lgf = -expf(F.in[9][h]), lgb = -expf(F.in[10][h]);
        for (int it = F.tid; it < 128 * 16; it += NTHR) { const int c = it >> 4, ch = it & 15;
            *(LAS u32x4*)(Vs + c * RLD + 8 * ch) = *(const u32x4*)(QKV + (size_t)(grow0 + c) * INW + 1024 + h * 128 + 8 * ch); }
        for (int it = F.tid; it < 128 * 8; it += NTHR) { const int c = it >> 3, pi = it & 7, hh = pi >> 2, jj = (pi & 3) * 8; const int t = (id - 2) * 128 + c;
            float x1[8], x2[8]; load_rope_pair(QKV + (size_t)(grow0 + c) * INW + 512 + h * 128, hh, jj, lat, t >> 6, t & 63, rope, 0.08838834764831845f, x1, x2);
            const float wf = __expf(lgf * (float)(127 - c)), wb = __expf(lgb * (float)c);
            *(LAS u32x4*)(Kf + c * RLD + hh * 64 + jj) = pack8(x1, wf); *(LAS u32x4*)(Kf + c * RLD + hh * 64 + jj + 32) = pack8(x2, wf);
            *(LAS u32x4*)(Kb + c * RLD + hh * 64 + jj) = pack8(x1, wb); *(LAS u32x4*)(Kb + c * RLD + hh * 64 + jj + 32) = pack8(x2, wb); }
        LDS_BARRIER();
#pragma unroll
        for (int dir = 0; dir < 2; ++dir) {
            const LAS bf16* Kd = dir ? Kb : Kf;
            f32x4 acc[2][4];
#pragma unroll
            for (int i = 0; i < 2; ++i)
#pragma unroll
                for (int j = 0; j < 4; ++j) acc[i][j] = (f32x4){0.f, 0.f, 0.f, 0.f};
#pragma unroll 1
            for (int k0 = 0; k0 < 128; k0 += 32) { bf16x8 af[2], bfg[4];
#pragma unroll
                for (int i = 0; i < 2; ++i) af[i] = frag_kr(Vs, RLD, 32 * wr2 + 16 * i, k0, F.lane);
#pragma unroll
                for (int j = 0; j < 4; ++j) bfg[j] = frag_kr(Kd, RLD, 64 * wc2 + 16 * j, k0, F.lane);
#pragma unroll
                for (int i = 0; i < 2; ++i)
#pragma unroll
                    for (int j = 0; j < 4; ++j) acc[i][j] = mma(acc[i][j], bfg[j], af[i]); }
            float* o = KV + ((size_t)((b * 4 + h) * 2 + dir) * NCH + id) * 16384;
#pragma unroll
            for (int i = 0; i < 2; ++i)
#pragma unroll
                for (int j = 0; j < 4; ++j) *(f32x4*)(o + (32 * wr2 + 16 * i + fr) * 128 + 64 * wc2 + 16 * j + 4 * fq) = acc[i][j];
        }
        LDS_BARRIER();
    }
}
DI void ret_prefix_phase(Fr& F) {
    const float* KV = (const float*)(F.ws + WS_KV); bf16* SP = (bf16*)(F.ws + WS_SPREV);
    const int gt = F.bx * NTHR + F.tid, NT = F.G * NTHR;
    for (int i = gt; i < 64 * 4096; i += NT) { const int bhd = i >> 12, e4 = i & 4095, dir = bhd & 1, h = (bhd >> 1) & 3;
        const float lg = -expf(dir ? F.in[10][h] : F.in[9][h]), cd = expf(lg * 128.f);
        f32x4 s = (f32x4){0.f, 0.f, 0.f, 0.f};
        for (int st = 0; st < NCH; ++st) { const int id = dir ? (st == 0 ? 1 : (st == 1 ? 0 : 19 - st)) : st;
            const size_t off = ((size_t)bhd * NCH + id) * 16384 + 4 * e4;
            u32x2 p; p.x = pk2(s.x, s.y); p.y = pk2(s.z, s.w); *(u32x2*)(SP + off) = p;
            s = s * cd + *(const f32x4*)(KV + off); }
    }
}
DI void ret_out_phase(Fr& F) {
    const bf16* QKV = (const bf16*)(F.ws + WS_QKV); const bf16* SP = (const bf16*)(F.ws + WS_SPREV); bf16* MIX = (bf16*)(F.ws + WS_MIX); const f32x2* rope = (const f32x2*)(F.ws + WS_ROPE);
    LAS bf16* Qs = (LAS bf16*)F.lds; LAS bf16* KP = (LAS bf16*)(F.lds + RTILE); LAS bf16* Vs = (LAS bf16*)(F.lds + 2 * RTILE); LAS bf16* Sf = (LAS bf16*)(F.lds + 3 * RTILE);
    LAS float* red = (LAS float*)(F.lds + 4 * RTILE);
    const int wr2 = F.wave >> 1, wc2 = F.wave & 1, fr = F.lane & 15, fq = F.lane >> 4;
    for (int u = F.bx; u < NB * 4 * NCH; u += F.G) {
        const int b = u / (4 * NCH), h = (u / NCH) % 4, id = u % NCH; const int grow0 = ret_row0(b, id); const bool lat = id >= 2;
        const float lgf = -expf(F.in[9][h]), lgb = -expf(F.in[10][h]);
        const bf16* spf = SP + ((size_t)((b * 4 + h) * 2 + 0) * NCH + id) * 16384; const bf16* spb = SP + ((size_t)((b * 4 + h) * 2 + 1) * NCH + id) * 16384;
        for (int it = F.tid; it < 128 * 16; it += NTHR) { const int c = it >> 4, ch = it & 15;
            *(LAS u32x4*)(Vs + c * RLD + 8 * ch) = *(const u32x4*)(QKV + (size_t)(grow0 + c) * INW + 1024 + h * 128 + 8 * ch);
            *(LAS u32x4*)(Sf + c * RLD + 8 * ch) = *(const u32x4*)(spf + c * 128 + 8 * ch); }
        for (int it = F.tid; it < 128 * 8; it += NTHR) { const int c = it >> 3, pi = it & 7, hh = pi >> 2, jj = (pi & 3) * 8; const int t = (id - 2) * 128 + c;
            float x1[8], x2[8];
            load_rope_pair(QKV + (size_t)(grow0 + c) * INW + h * 128, hh, jj, lat, t >> 6, t & 63, rope, 1.f, x1, x2);
            *(LAS u32x4*)(Qs + c * RLD + hh * 64 + jj) = pack8(x1, 1.f); *(LAS u32x4*)(Qs + c * RLD + hh * 64 + jj + 32) = pack8(x2, 1.f);
            load_rope_pair(QKV + (size_t)(grow0 + c) * INW + 512 + h * 128, hh, jj, lat, t >> 6, t & 63, rope, 0.08838834764831845f, x1, x2);
            *(LAS u32x4*)(KP + c * RLD + hh * 64 + jj) = pack8(x1, 1.f); *(LAS u32x4*)(KP + c * RLD + hh * 64 + jj + 32) = pack8(x2, 1.f); }
        LDS_BARRIER();
        f32x4 sacc[2][4], facc[2][4];
#pragma unroll
        for (int i = 0; i < 2; ++i)
#pragma unroll
            for (int j = 0; j < 4; ++j) { sacc[i][j] = (f32x4){0.f, 0.f, 0.f, 0.f}; facc[i][j] = (f32x4){0.f, 0.f, 0.f, 0.f}; }
#pragma unroll 1
        for (int k0 = 0; k0 < 128; k0 += 32) { bf16x8 af[2], bk[4], bs[4];
#pragma unroll
            for (int i = 0; i < 2; ++i) af[i] = frag_kc(Qs, RLD, 32 * wr2 + 16 * i, k0, F.lane);
#pragma unroll
            for (int j = 0; j < 4; ++j) { bk[j] = frag_kc(KP, RLD, 64 * wc2 + 16 * j, k0, F.lane); bs[j] = frag_kc(Sf, RLD, 64 * wc2 + 16 * j, k0, F.lane); }
#pragma unroll
            for (int i = 0; i < 2; ++i)
#pragma unroll
                for (int j = 0; j < 4; ++j) { sacc[i][j] = mma(sacc[i][j], bk[j], af[i]); facc[i][j] = mma(facc[i][j], bs[j], af[i]); } }
        LDS_BARRIER();
        { const float lf2 = lgf * 1.4426950408889634f, lb2 = lgb * 1.4426950408889634f;
#pragma unroll
          for (int i = 0; i < 2; ++i)
#pragma unroll
            for (int j = 0; j < 4; ++j) { const int c = 32 * wr2 + 16 * i + fr, s0 = 64 * wc2 + 16 * j + 4 * fq; float pv[4];
#pragma unroll
                for (int r = 0; r < 4; ++r) { const int df = c - (s0 + r); const float wgt = df > 0 ? exp2f(lf2 * (float)df) : (df < 0 ? exp2f(lb2 * (float)(-df)) : 2.f); pv[r] = sacc[i][j][r] * wgt; }
                u32x2 p; p.x = pk2(pv[0], pv[1]); p.y = pk2(pv[2], pv[3]); *(LAS u32x2*)(KP + c * RLD + s0) = p; }
          for (int it = F.tid; it < 128 * 16; it += NTHR) { const int c = it >> 4, ch = it & 15; *(LAS u32x4*)(Sf + c * RLD + 8 * ch) = *(const u32x4*)(spb + c * 128 + 8 * ch); }
        }
        LDS_BARRIER();
        f32x4 oacc[2][4], bacc[2][4];
#pragma unroll
        for (int i = 0; i < 2; ++i) { const float qdf = __expf(lgf * (float)(32 * wr2 + 16 * i + fr + 1));
#pragma unroll
            for (int j = 0; j < 4; ++j) { oacc[i][j] = facc[i][j] * qdf; bacc[i][j] = (f32x4){0.f, 0.f, 0.f, 0.f}; } }
#pragma unroll 1
        for (int k0 = 0; k0 < 128; k0 += 32) { bf16x8 ap[2], aq[2], bv[4], bs[4];
#pragma unroll
            for (int i = 0; i < 2; ++i) { ap[i] = frag_kc(KP, RLD, 32 * wr2 + 16 * i, k0, F.lane); aq[i] = frag_kc(Qs, RLD, 32 * wr2 + 16 * i, k0, F.lane); }
#pragma unroll
            for (int j = 0; j < 4; ++j) { bv[j] = frag_kr(Vs, RLD, 64 * wc2 + 16 * j, k0, F.lane); bs[j] = frag_kc(Sf, RLD, 64 * wc2 + 16 * j, k0, F.lane); }
#pragma unroll
            for (int i = 0; i < 2; ++i)
#pragma unroll
                for (int j = 0; j < 4; ++j) { oacc[i][j] = mma(oacc[i][j], bv[j], ap[i]); bacc[i][j] = mma(bacc[i][j], bs[j], aq[i]); } }
        float rs[2], rq[2];
#pragma unroll
        for (int i = 0; i < 2; ++i) { const int c = 32 * wr2 + 16 * i + fr; const float qdb = __expf(lgb * (float)(128 - c)); float s = 0.f, q = 0.f;
#pragma unroll
            for (int j = 0; j < 4; ++j) { oacc[i][j] = oacc[i][j] + bacc[i][j] * qdb;
#pragma unroll
                for (int r = 0; r < 4; ++r) { s += oacc[i][j][r]; q += oacc[i][j][r] * oacc[i][j][r]; } }
            s += __shfl_xor(s, 16); s += __shfl_xor(s, 32); q += __shfl_xor(q, 16); q += __shfl_xor(q, 32);
            if (fq == 0) { red[(c * 2 + wc2) * 2 + 0] = s; red[(c * 2 + wc2) * 2 + 1] = q; }
            rs[i] = s; rq[i] = q; }
        LDS_BARRIER();
#pragma unroll
        for (int i = 0; i < 2; ++i) { const int c = 32 * wr2 + 16 * i + fr;
            const float s = red[(c * 2 + 0) * 2 + 0] + red[(c * 2 + 1) * 2 + 0], q = red[(c * 2 + 0) * 2 + 1] + red[(c * 2 + 1) * 2 + 1];
            const float mean = s * (1.f / 128.f), var = fmaxf(q * (1.f / 128.f) - mean * mean, 0.f), rstd = rsqrtf(var + 1e-5f);
            const size_t grow = (size_t)(grow0 + c);
#pragma unroll
            for (int j = 0; j < 4; ++j) { const int e0 = 64 * wc2 + 16 * j + 4 * fq;
                const f32x4 gw = *(const f32x4*)(F.in[11] + h * 128 + e0); const u32x2 gg = *(const u32x2*)(QKV + grow * INW + 1536 + h * 128 + e0);
                const float g0 = bflo(gg.x), g1 = bfhi(gg.x), g2 = bflo(gg.y), g3 = bfhi(gg.y);
                const f32x4 y = (oacc[i][j] - mean) * rstd * gw;
                u32x2 p; p.x = pk2(y.x * siluf_(g0), y.y * siluf_(g1)); p.y = pk2(y.z * siluf_(g2), y.w * siluf_(g3));
                *(u32x2*)(MIX + grow * D + h * 128 + e0) = p; } }
        (void)rs; (void)rq;
        LDS_BARRIER();
    }
}

DI void na_norm_rows(Fr& F) {
    const bf16* QKV = (const bf16*)(F.ws + WS_QKV); bf16* NQ = (bf16*)(F.ws + WS_NQ); bf16* NK = (bf16*)(F.ws + WS_NK); bf16* NV = (bf16*)(F.ws + WS_NV);
    const bool isk = F.lane >= 32; const float* wsrc = (isk ? F.in[13] : F.in[12]) + (F.lane & 3) * 16; const float scl = isk ? 1.f : 0.125f;
    const int head = (F.lane & 31) >> 2, j0 = (F.lane & 3) * 16;
    float wv[16];
#pragma unroll
    for (int i = 0; i < 16; ++i) wv[i] = wsrc[i] * scl;
    for (int row = F.gw; row < MA; row += F.NGW) {
        const bool lat = row < ML; const int b = lat ? row / SEQ : (row - ML) / CTXL, sr = lat ? CTXL + row % SEQ : (row - ML) % CTXL;
        const size_t ho = ((size_t)(b * 8 + head) * (SEQ + CTXL) + sr) * 64 + j0;
        const bf16* p = QKV + (size_t)row * INW + 2048 + 16 * F.lane;
        const u32x4 a = *(const u32x4*)p, b2 = *(const u32x4*)(p + 8); const unsigned w[8] = {a.x, a.y, a.z, a.w, b2.x, b2.y, b2.z, b2.w}; float x[16]; float ss = 0.f;
#pragma unroll
        for (int i = 0; i < 8; ++i) { x[2 * i] = bflo(w[i]); x[2 * i + 1] = bfhi(w[i]); ss += x[2 * i] * x[2 * i] + x[2 * i + 1] * x[2 * i + 1]; }
        const float rinv = rsqrtf(red4(ss) * (1.f / 64.f) + 1e-6f);
        u32x4 o0, o1;
        o0.x = pk2(x[0] * rinv * wv[0], x[1] * rinv * wv[1]); o0.y = pk2(x[2] * rinv * wv[2], x[3] * rinv * wv[3]); o0.z = pk2(x[4] * rinv * wv[4], x[5] * rinv * wv[5]); o0.w = pk2(x[6] * rinv * wv[6], x[7] * rinv * wv[7]);
        o1.x = pk2(x[8] * rinv * wv[8], x[9] * rinv * wv[9]); o1.y = pk2(x[10] * rinv * wv[10], x[11] * rinv * wv[11]); o1.z = pk2(x[12] * rinv * wv[12], x[13] * rinv * wv[13]); o1.w = pk2(x[14] * rinv * wv[14], x[15] * rinv * wv[15]);
        bf16* d = (isk ? NK : NQ) + ho; *(u32x4*)d = o0; *(u32x4*)(d + 8) = o1;
        if (!isk) { const bf16* pv = QKV + (size_t)row * INW + 3072 + 16 * F.lane; const u32x4 v0 = *(const u32x4*)pv, v1 = *(const u32x4*)(pv + 8); *(u32x4*)(NV + ho) = v0; *(u32x4*)(NV + ho + 8) = v1; }
    }
}
constexpr int NLD = 72;
DI void na_phase(Fr& F) {
    const bf16* NQ = (const bf16*)(F.ws + WS_NQ); const bf16* NK = (const bf16*)(F.ws + WS_NK); const bf16* NV = (const bf16*)(F.ws + WS_NV); bf16* MIX = (bf16*)(F.ws + WS_MIX);
    LAS bf16* Ks = (LAS bf16*)F.lds;
    LAS bf16* Vs = (LAS bf16*)(F.lds + 36864);
    LAS bf16* Pw = (LAS bf16*)(F.lds + 2 * 36864) + F.wave * (32 * NLD);
    LAS float* rpbs = (LAS float*)(F.lds + 2 * 36864 + 8 * 4608);
    const int fr = F.lane & 15, fq = F.lane >> 4;
    float bound;
    { float mqw = fabsf(F.in[12][F.lane]), mkw = fabsf(F.in[13][F.lane]), mb = 0.f;
      for (int i = F.lane; i < 8 * 15 * 31; i += 64) mb = fmaxf(mb, fabsf(F.in[14][i]));
      bound = 8.f * wave_max(mqw) * wave_max(mkw) + wave_max(mb); }
    for (int u = F.bx; u < 512 + 64; u += F.G) {
        int b, head, r = -1, cb = 0, qtok0, kb_lo = 0, nwin = 0;
        if (u < 512) { const int bh = ((u >> 6) << 3) + (u & 7), qb = (u >> 3) & 7; b = bh >> 3; head = bh & 7;
            r = 4 * qb + (F.wave >> 1); cb = 32 * (F.wave & 1); qtok0 = b * SEQ + r * 64 + cb;
            const int r0lo = min(max(4 * qb - 4, 0), 24), r0hi = min(max(4 * qb - 1, 0), 24); kb_lo = r0lo >> 2; nwin = ((r0hi + 7) >> 2) - kb_lo + 1; }
        else { const int cu = u - 512; b = cu >> 3; head = cu & 7; qtok0 = ML + b * CTXL + 32 * F.wave; }
        const int r0 = min(max(r - 4, 0), 24);
        const size_t hb = (size_t)(b * 8 + head) * (SEQ + CTXL); const int qseq = u < 512 ? CTXL + r * 64 + cb : 32 * F.wave;
        bf16x8 aq[2][2];
#pragma unroll
        for (int mt = 0; mt < 2; ++mt)
#pragma unroll
            for (int ks = 0; ks < 2; ++ks) aq[mt][ks] = *(const bf16x8*)(NQ + (hb + qseq + 16 * mt + fr) * 64 + 32 * ks + 8 * fq);
        if (u < 512) for (int i = F.tid; i < 15 * 32; i += NTHR) { const int ro = i >> 5, co = i & 31; rpbs[i] = co < 31 ? F.in[14][head * 465 + ro * 31 + co] - bound : -1.0e30f; }
        int boff[2][4][4]; int nlo[2], nhi[2];
#pragma unroll
        for (int mt = 0; mt < 2; ++mt) { const int cs = cb + 16 * mt, c = cs + fr, c0 = min(max(c - 8, 0), 48);
            nlo[mt] = max(cs - 8, 0) >> 4; nhi[mt] = (min(cs + 7, 48) + 15) >> 4;
#pragma unroll
            for (int nt = 0; nt < 4; ++nt)
#pragma unroll
                for (int i = 0; i < 4; ++i) { const int kc = 16 * nt + 4 * fq + i; boff[mt][nt][i] = ((kc >= c0) && (kc < c0 + 16)) ? (kc - c + 15) : 31; } }
        f32x4 oacc[2][4]; float lsum[2] = {0.f, 0.f};
#pragma unroll
        for (int mt = 0; mt < 2; ++mt)
#pragma unroll
            for (int j = 0; j < 4; ++j) oacc[mt][j] = (f32x4){0.f, 0.f, 0.f, 0.f};
        u32x4 kst[4], vst[4];
#define NA_LOAD(bi_) do { const int kbase_ = (bi_) < nwin ? CTXL + 256 * (kb_lo + (bi_)) : 0; _Pragma("unroll") for (int it_ = 0; it_ < 4; ++it_) { const size_t o_ = (hb + kbase_ + (F.tid >> 3) + 64 * it_) * 64 + 8 * (F.tid & 7); \
            kst[it_] = *(const u32x4*)(NK + o_); vst[it_] = *(const u32x4*)(NV + o_); } } while (0)
        NA_LOAD(0);
        for (int bi = 0; bi <= nwin; ++bi) {
            const bool is_ctx = bi == nwin;
#pragma unroll
            for (int it = 0; it < 4; ++it) { const int krow = (F.tid >> 3) + 64 * it, c8 = F.tid & 7;
                *(LAS u32x4*)(Ks + krow * NLD + 8 * c8) = kst[it]; *(LAS u32x4*)(Vs + krow * NLD + 8 * c8) = vst[it]; }
            LDS_BARRIER();
            if (bi < nwin) NA_LOAD(bi + 1);
            if ((((PROBE_DUP) >> 30) & 1u) && bi < nwin) { asm volatile("" ::: "memory"); NA_LOAD(bi + 1); }
            f32x4 osv[2][4]; float lsv[2];
#pragma unroll
            for (int mt = 0; mt < 2; ++mt) { lsv[mt] = lsum[mt];
#pragma unroll
                for (int j = 0; j < 4; ++j) osv[mt][j] = oacc[mt][j]; }
            for (int pdc_ = 0; pdc_ < ((((PROBE_DUP) >> 31) & 1u) ? 2 : 1); ++pdc_) {
            if (pdc_ == 1) {
#pragma unroll
                for (int mt = 0; mt < 2; ++mt) { lsum[mt] = lsv[mt];
#pragma unroll
                    for (int j = 0; j < 4; ++j) oacc[mt][j] = osv[mt][j]; } }
#pragma unroll 1
            for (int krl = 0; krl < 4; ++krl) {
                const int kr = 4 * (kb_lo + bi) + krl;
                if (!is_ctx && (kr < r0 || kr > r0 + 7)) continue;
                f32x4 sacc[2][4];
#pragma unroll
                for (int mt = 0; mt < 2; ++mt)
#pragma unroll
                    for (int nt = 0; nt < 4; ++nt) sacc[mt][nt] = (f32x4){0.f, 0.f, 0.f, 0.f};
                const int n0w = is_ctx ? 0 : nlo[0], n1w = is_ctx ? 3 : nhi[1];
#pragma unroll
                for (int nt = 0; nt < 4; ++nt) { if (nt < n0w || nt > n1w) continue;
                    const bool u0 = is_ctx || (nt >= nlo[0] && nt <= nhi[0]), u1 = is_ctx || (nt >= nlo[1] && nt <= nhi[1]);
#pragma unroll
                    for (int ks = 0; ks < 2; ++ks) { const bf16x8 bk = frag_kc(Ks, NLD, 64 * krl + 16 * nt, 32 * ks, F.lane);
                        if (u0) sacc[0][nt] = mma(sacc[0][nt], bk, aq[0][ks]); if (u1) sacc[1][nt] = mma(sacc[1][nt], bk, aq[1][ks]); } }
                const int rowb = is_ctx ? 0 : (kr - r + 7) * 32;
#pragma unroll
                for (int mt = 0; mt < 2; ++mt) {
#pragma unroll
                    for (int nt = 0; nt < 4; ++nt) { float pv[4] = {0.f, 0.f, 0.f, 0.f};
                        if (is_ctx) {
#pragma unroll
                            for (int i = 0; i < 4; ++i) { pv[i] = __expf(sacc[mt][nt][i] - bound); lsum[mt] += pv[i]; } }
                        else if (nt >= nlo[mt] && nt <= nhi[mt]) {
#pragma unroll
                            for (int i = 0; i < 4; ++i) { pv[i] = __expf(sacc[mt][nt][i] + rpbs[rowb + boff[mt][nt][i]]); lsum[mt] += pv[i]; } }
                        u32x2 pk; pk.x = pk2(pv[0], pv[1]); pk.y = pk2(pv[2], pv[3]); *(LAS u32x2*)(Pw + (16 * mt + fr) * NLD + 16 * nt + 4 * fq) = pk; } }
                LDS_WAIT();
#pragma unroll
                for (int ks2 = 0; ks2 < 2; ++ks2) {
                    const bool v0 = is_ctx || (2 * ks2 + 1 >= nlo[0] && 2 * ks2 <= nhi[0]), v1 = is_ctx || (2 * ks2 + 1 >= nlo[1] && 2 * ks2 <= nhi[1]);
                    if (!(v0 || v1)) continue;
                    const bf16x8 ap0 = frag_kc(Pw, NLD, 0, 32 * ks2, F.lane), ap1 = frag_kc(Pw, NLD, 16, 32 * ks2, F.lane);
#pragma unroll
                    for (int et = 0; et < 4; ++et) { const bf16x8 bv = frag_kr(Vs, NLD, 16 * et, 64 * krl + 32 * ks2, F.lane);
                        if (v0) oacc[0][et] = mma(oacc[0][et], bv, ap0); if (v1) oacc[1][et] = mma(oacc[1][et], bv, ap1); } }
            }
            }
            LDS_BARRIER();
        }
#undef NA_LOAD
#pragma unroll
        for (int mt = 0; mt < 2; ++mt) { float l = lsum[mt]; l += __shfl_xor(l, 16); l += __shfl_xor(l, 32); const float inv = 1.f / l;
#pragma unroll
            for (int et = 0; et < 4; ++et) { const f32x4 o = oacc[mt][et] * inv; u32x2 p; p.x = pk2(o.x, o.y); p.y = pk2(o.z, o.w);
                *(u32x2*)(MIX + (size_t)(qtok0 + 16 * mt + fr) * D + 512 + head * 64 + 16 * et + 4 * fq) = p; } }
    }
}

DI void xm_phase(Fr& F, const float* xl, const float* xc, const float* normw, const float* modl) {
    bf16* XM = (bf16*)(F.ws + WS_XM); const float* mu = F.in[18];
    for (int g = F.gw; g < MA / 4; g += F.NGW) {
        const int row0 = 4 * g; const bool lat = row0 < ML; const int rr0 = lat ? row0 : row0 - ML; const int L = lat ? SEQ : CTXL; const int t0 = rr0 % L;
        const float* src = (lat ? xl : xc) + (size_t)rr0 * D;
        const float* mrow = modl + (size_t)(lat ? row0 / SEQ : 8) * 6144;
        const bool hp = t0 > 0, hn = t0 + 4 < L;
        f32x4 v[6][4]; float rs[6];
#pragma unroll
        for (int r = 0; r < 6; ++r) { const bool ok = (r == 0) ? hp : (r == 5 ? hn : true);
#pragma unroll
            for (int j = 0; j < 4; ++j) v[r][j] = ok ? ((const f32x4*)(src + (size_t)(r - 1) * D))[F.lane + 64 * j] : (f32x4){0.f, 0.f, 0.f, 0.f}; }
#pragma unroll
        for (int r = 0; r < 6; ++r) { float ss = 0.f;
#pragma unroll
            for (int j = 0; j < 4; ++j) ss += (v[r][j].x * v[r][j].x + v[r][j].y * v[r][j].y) + (v[r][j].z * v[r][j].z + v[r][j].w * v[r][j].w);
            rs[r] = rsqrtf(wave_sum_fast(ss) * (1.f / D) + 1e-6f); }
#pragma unroll
        for (int j = 0; j < 4; ++j) { const int c4 = F.lane + 64 * j;
            const f32x4 gg = ((const f32x4*)normw)[c4] * (((const f32x4*)(mrow + 1024))[c4] + 1.f), sh = ((const f32x4*)mrow)[c4];
            f32x4 h[6];
#pragma unroll
            for (int r = 0; r < 6; ++r) { const bool ok = (r == 0) ? hp : (r == 5 ? hn : true); h[r] = ok ? v[r][j] * rs[r] * gg + sh : (f32x4){0.f, 0.f, 0.f, 0.f}; }
            f32x4 m[6];
#pragma unroll
            for (int sx = 0; sx < 6; ++sx) m[sx] = ((const f32x4*)(mu + sx * 1024))[c4];
#pragma unroll
            for (int r = 0; r < 4; ++r) { const f32x4 hc = h[r + 1], xx = (h[r] + h[r + 2]) * 0.5f - hc;
#pragma unroll
                for (int sx = 0; sx < 6; ++sx) { const f32x4 y = hc + xx * m[sx];
                    u32x2 p; p.x = pk2(y.x, y.y); p.y = pk2(y.z, y.w); ((u32x2*)(XM + ((size_t)sx * MA + row0 + r) * D))[c4] = p; } } }
    }
}

struct CvDesc { const float* src; bf16* dst; int ldsrc; };
DI CvDesc cv_desc(Fr& F, int t, int lane) {
    const TrItem it = moe_item(F, t >> 3); const int sub = t & 7, k0 = it.k0 + 32 * (sub >> 2), n = it.n0 + 64 * (sub & 3) + lane; int drow = n;
    if (it.Hh) { const int hf = n / it.Hh, j = n % it.Hh; drow = (j / 128) * 256 + hf * 128 + (j % 128); }
    CvDesc d; d.src = it.src + (size_t)k0 * it.ldsrc + n; d.ldsrc = it.ldsrc; d.dst = it.dst + (size_t)drow * it.lddst + k0; return d;
}
DI void cv_load(const CvDesc& d, float (&v)[32]) {
#pragma unroll
    for (int kk = 0; kk < 32; ++kk) v[kk] = d.src[(size_t)kk * d.ldsrc];
}
DI void cv_store(bf16* dst, const float (&v)[32]) {
#pragma unroll
    for (int c = 0; c < 4; ++c) { u32x4 o; o.x = pk2(v[8 * c], v[8 * c + 1]); o.y = pk2(v[8 * c + 2], v[8 * c + 3]); o.z = pk2(v[8 * c + 4], v[8 * c + 5]); o.w = pk2(v[8 * c + 6], v[8 * c + 7]);
        *(u32x4*)(dst + 8 * c) = o; }
}
DI f32x4 mma16(f32x4 acc, s16x4 bfrag, s16x4 afrag) { return __builtin_amdgcn_mfma_f32_16x16x16bf16_1k(bfrag, afrag, acc, 0, 0, 0); }
DI s16x4 frag16_kc(const LAS bf16* base, int ld, int row0, int k0, int lane) { return *(const LAS s16x4*)(base + (row0 + (lane & 15)) * ld + k0 + 4 * (lane >> 4)); }
DI s16x4 frag16_kr(const LAS bf16* base, int ld, int x0, int k0, int lane) { const int g = lane >> 4, q = (lane & 15) >> 2, p = lane & 3;
    return __builtin_amdgcn_ds_read_tr16_b64_v4i16((LAS s16x4*)(base + (k0 + 4 * g + q) * ld + x0 + 4 * p)); }
DI s16x4 cvt4(f32x4 v) { u32x2 p; p.x = pk2(v.x, v.y); p.y = pk2(v.z, v.w); return __builtin_bit_cast(s16x4, p); }
constexpr int WLD = 72;
DI void rwkv_scan2_phase(Fr& F) {
    const bf16* KB = (const bf16*)(F.ws + WS_KB); const bf16* VB = (const bf16*)(F.ws + WS_VB); const bf16* RB = (const bf16*)(F.ws + WS_RB);
    const bf16* LW = (const bf16*)(F.ws + WS_DEC); const bf16* AG = (const bf16*)(F.ws + WS_AG);
    LAS bf16* AT = (LAS bf16*)F.lds; LAS bf16* BT = AT + 64 * WLD; LAS bf16* KT = BT + 64 * WLD; LAS bf16* RT = KT + 64 * WLD; LAS bf16* BH = RT + 64 * WLD; LAS bf16* KH = BH + 64 * WLD;
    LAS bf16* VN = KH + 64 * WLD; LAS bf16* W1s = VN + 64 * WLD;
    LAS bf16* PRB = W1s + 64 * WLD; LAS bf16* PRK = PRB + 1024;
    LAS f32x4* UVT = (LAS f32x4*)(PRK + 1024);
    LAS float* GC = (LAS float*)(UVT + 1024);
    LAS float* CSs = GC + 256;
    LAS float* YS = CSs + 4096;
    const int cq = F.wave >> 1, half = F.wave & 1, fr = F.lane & 15, fq = F.lane >> 4;
    float cvv[32]; bf16* cv_dst = nullptr; int cv_next = F.bx * 4 + (F.wave - 4); const int cv_stride = F.G * 4;
    for (int u = F.bx; u < 256; u += F.G) {
        const int z = u & 1, h = (u >> 1) & 15, b = u >> 5;
        bf16* Y = (bf16*)(F.ws + (z ? WS_YB : WS_YF));
        const int sx = F.lane >> 3, cg = F.lane & 7;
        float kkw[8], kaw[8], rkw[8];
#pragma unroll
        for (int i = 0; i < 8; ++i) { kkw[i] = F.in[28][h * 64 + 8 * cg + i]; kaw[i] = F.in[29][h * 64 + 8 * cg + i]; rkw[i] = F.in[30][h * 64 + 8 * cg + i]; }
        float* coef = (float*)(F.ws + WS_COEF) + ((size_t)z * 128 + b * 16 + h) * SEQ;
        const size_t bh = (size_t)(b * 16 + h);
        const bf16* kbh = KB + bh * (SEQ + CTXL) * 64 + 8 * cg; const bf16* vbh = VB + bh * (SEQ + CTXL) * 64 + 8 * cg; const bf16* rbh = RB + bh * SEQ * 64 + 8 * cg;
        const bf16* agh = AG + ((size_t)z * 128 + bh) * (SEQ + CTXL) * 64 + 8 * cg; const bf16* lwh = LW + ((size_t)z * 128 + bh) * (SEQ + CTXL) * 64 + 8 * cg;
        f32x4 S[4];
#pragma unroll
        for (int j = 0; j < 4; ++j) S[j] = (f32x4){0.f, 0.f, 0.f, 0.f};
        u32x4 kreg, vreg, rreg, areg, lreg;
        const int stl = 16 * cq + 8 * half + sx;
#define RW_LOAD(sc) do { const int g_ = (sc) * 64 + stl; const bool lat_ = g_ >= CTXL; const int row_ = z ? (lat_ ? (2 * CTXL + SEQ - 1 - g_) : (CTXL - 1 - g_)) : g_; \
            kreg = *(const u32x4*)(kbh + (size_t)row_ * 64); vreg = *(const u32x4*)(vbh + (size_t)row_ * 64); areg = *(const u32x4*)(agh + (size_t)row_ * 64); \
            rreg = lat_ ? *(const u32x4*)(rbh + (size_t)(row_ - CTXL) * 64) : (u32x4){0u, 0u, 0u, 0u}; \
            lreg = *(const u32x4*)(lwh + (size_t)row_ * 64); } while (0)
        RW_LOAD(0);
        for (int sc = 0; sc < (SEQ + CTXL) / 64; ++sc) {
            const bool lat = sc * 64 >= CTXL;
            *(LAS f32x4*)(CSs + stl * 64 + 8 * cg) = (f32x4){bflo(lreg.x), bfhi(lreg.x), bflo(lreg.y), bfhi(lreg.y)}; *(LAS f32x4*)(CSs + stl * 64 + 8 * cg + 4) = (f32x4){bflo(lreg.z), bfhi(lreg.z), bflo(lreg.w), bfhi(lreg.w)};
            LDS_BARRIER();
            if (F.tid < 256) { const int q = F.tid >> 6, c = F.tid & 63; float v[16];
#pragma unroll
                for (int t = 0; t < 16; ++t) v[t] = CSs[(16 * q + t) * 64 + c];
                float acc = 0.f;
#pragma unroll
                for (int t = 0; t < 16; ++t) { acc += v[t]; CSs[(16 * q + t) * 64 + c] = acc; } }
            LDS_BARRIER();
            { const int tau = 8 * half + sx;
              const f32x4 c0 = *(const LAS f32x4*)(CSs + stl * 64 + 8 * cg), c1 = *(const LAS f32x4*)(CSs + stl * 64 + 8 * cg + 4);
              f32x4 p0 = (f32x4){0.f, 0.f, 0.f, 0.f}, p1 = p0;
              if (tau > 0) { p0 = *(const LAS f32x4*)(CSs + (stl - 1) * 64 + 8 * cg); p1 = *(const LAS f32x4*)(CSs + (stl - 1) * 64 + 8 * cg + 4); }
              const f32x4 t0 = *(const LAS f32x4*)(CSs + (16 * cq + 15) * 64 + 8 * cg), t1 = *(const LAS f32x4*)(CSs + (16 * cq + 15) * 64 + 8 * cg + 4);
              const float cs[8] = {c0.x, c0.y, c0.z, c0.w, c1.x, c1.y, c1.z, c1.w}, cp[8] = {p0.x, p0.y, p0.z, p0.w, p1.x, p1.y, p1.z, p1.w}, ct[8] = {t0.x, t0.y, t0.z, t0.w, t1.x, t1.y, t1.z, t1.w};
              const unsigned kw[4] = {kreg.x, kreg.y, kreg.z, kreg.w}, aw[4] = {areg.x, areg.y, areg.z, areg.w}, rw[4] = {rreg.x, rreg.y, rreg.z, rreg.w};
              float kr[8], ag[8], rr[8], kk[8]; float ss = 0.f;
#pragma unroll
              for (int i = 0; i < 4; ++i) { kr[2 * i] = bflo(kw[i]); kr[2 * i + 1] = bfhi(kw[i]); ag[2 * i] = bflo(aw[i]); ag[2 * i + 1] = bfhi(aw[i]); rr[2 * i] = bflo(rw[i]); rr[2 * i + 1] = bfhi(rw[i]); }
#pragma unroll
              for (int i = 0; i < 8; ++i) { kk[i] = kr[i] * kkw[i]; ss += kk[i] * kk[i]; }
              const float rn = __builtin_amdgcn_rsqf(fmaxf(red8(ss), 1e-24f));
              float oa[8], ob[8], ok[8], orr[8], obh[8], okh[8], eCv[8]; float cfp = 0.f;
#pragma unroll
              for (int i = 0; i < 8; ++i) { const float e1 = __expf(cs[i]), ep = __expf(cp[i]), eC = __expf(ct[i]), inv = __builtin_amdgcn_rcpf(e1);
                  const float kki = kk[i] * rn, b_ = kki * ag[i], kd_ = kr[i] * (1.f + (ag[i] - 1.f) * kaw[i]);
                  cfp += rr[i] * kd_ * rkw[i];
                  oa[i] = -kki * ep; ob[i] = b_ * inv; ok[i] = kd_ * inv; orr[i] = rr[i] * e1; obh[i] = b_ * eC * inv; okh[i] = kd_ * eC * inv; eCv[i] = eC; }
              cfp = red8(cfp);
              if (lat && cg == 0) { const int g = sc * 64 + stl; coef[z ? (SEQ + CTXL - 1 - g) : (g - CTXL)] = cfp; }
              const int o = stl * WLD + 8 * cg;
              *(LAS u32x4*)(AT + o) = pack8(oa, 1.f); *(LAS u32x4*)(BT + o) = pack8(ob, 1.f); *(LAS u32x4*)(KT + o) = pack8(ok, 1.f); *(LAS u32x4*)(RT + o) = pack8(orr, 1.f);
              *(LAS u32x4*)(BH + o) = pack8(obh, 1.f); *(LAS u32x4*)(KH + o) = pack8(okh, 1.f); *(LAS u32x4*)(VN + o) = vreg;
              if (tau == 0) { *(LAS f32x4*)(GC + cq * 64 + 8 * cg) = (f32x4){eCv[0], eCv[1], eCv[2], eCv[3]}; *(LAS f32x4*)(GC + cq * 64 + 8 * cg + 4) = (f32x4){eCv[4], eCv[5], eCv[6], eCv[7]}; } }
            LDS_BARRIER();
            if (sc + 1 < (SEQ + CTXL) / 64) RW_LOAD(sc + 1);
            for (int pa2_ = 0; pa2_ < ((((PROBE_DUP) >> 25) & 1u) ? 2 : 1); ++pa2_)
            if (half) { f32x4 pb = (f32x4){0.f, 0.f, 0.f, 0.f}, pk = (f32x4){0.f, 0.f, 0.f, 0.f};
#pragma unroll
                for (int k0 = 0; k0 < 64; k0 += 32) { const bf16x8 af = frag_kc(RT, WLD, 16 * cq, k0, F.lane);
                    pb = mma(pb, frag_kc(BT, WLD, 16 * cq, k0, F.lane), af); pk = mma(pk, frag_kc(KT, WLD, 16 * cq, k0, F.lane), af); }
#pragma unroll
                for (int r = 0; r < 4; ++r) if (4 * fq + r > fr) { pb[r] = 0.f; pk[r] = 0.f; }
                const int o = cq * 256 + fr * 16 + 4 * fq;
                *(LAS s16x4*)(PRB + o) = cvt4(pb); *(LAS s16x4*)(PRK + o) = cvt4(pk); }
            else { f32x4 xa = (f32x4){0.f, 0.f, 0.f, 0.f}, xt = (f32x4){0.f, 0.f, 0.f, 0.f}, ak = (f32x4){0.f, 0.f, 0.f, 0.f};
#pragma unroll
                for (int k0 = 0; k0 < 64; k0 += 32) { const bf16x8 af = frag_kc(AT, WLD, 16 * cq, k0, F.lane), bfm = frag_kc(BT, WLD, 16 * cq, k0, F.lane);
                    xa = mma(xa, bfm, af);
                    xt = mma(xt, af, bfm);
                    ak = mma(ak, frag_kc(KT, WLD, 16 * cq, k0, F.lane), af); }
#pragma unroll
                for (int r = 0; r < 4; ++r) { if (4 * fq + r >= fr) { xa[r] = 0.f; ak[r] = 0.f; } if (4 * fq + r <= fr) xt[r] = 0.f; }
                f32x4 P = xa;
#pragma unroll
                for (int r = 0; r < 4; ++r) if (4 * fq + r == fr) P[r] += 1.f;
#pragma unroll
                for (int lvl = 0; lvl < 3; ++lvl) { const s16x4 xf = cvt4(xa), xtf = cvt4(xt);
                    const f32x4 x2 = mma16((f32x4){0.f, 0.f, 0.f, 0.f}, xtf, xf);
                    const f32x4 x2t = mma16((f32x4){0.f, 0.f, 0.f, 0.f}, xf, xtf);
                    xa = x2; xt = x2t;
                    P = mma16(P, cvt4(xt), cvt4(P)); }
                const s16x4 tf = cvt4(P), akf = cvt4(ak);
#pragma unroll
                for (int jt = 0; jt < 4; ++jt) { const f32x4 acc = mma16((f32x4){0.f, 0.f, 0.f, 0.f}, frag16_kr(AT, WLD, 16 * jt, 16 * cq, F.lane), tf);
                    *(LAS s16x4*)(W1s + (16 * cq + fr) * WLD + 16 * jt + 4 * fq) = cvt4(acc); }
#pragma unroll
                for (int it = 0; it < 4; ++it) { const f32x4 xvt = mma16((f32x4){0.f, 0.f, 0.f, 0.f}, akf, frag16_kr(VN, WLD, 16 * it, 16 * cq, F.lane));
                    UVT[(cq * 4 + it) * 64 + F.lane] = mma16((f32x4){0.f, 0.f, 0.f, 0.f}, tf, cvt4(xvt)); } }
            LDS_BARRIER();
            if (F.wave >= 4) {
                if (cv_dst) cv_store(cv_dst, cvv);
                cv_dst = nullptr;
                if (cv_next < 8 * CV_SCAN_ITEMS) { const CvDesc d = cv_desc(F, cv_next, F.lane); cv_load(d, cvv); cv_dst = d.dst; cv_next += cv_stride; } }
            if (F.wave < 4) { const int it = F.wave;
                s16x4 w1f[2][4], bhf[2][4], khf[2][4], vfr[2]; f32x4 uv0[2];
#define SB_LOAD(c_, b_) do { _Pragma("unroll") for (int jt = 0; jt < 4; ++jt) { w1f[b_][jt] = frag16_kc(W1s, WLD, 16 * (c_), 16 * jt, F.lane); \
                        bhf[b_][jt] = frag16_kr(BH, WLD, 16 * jt, 16 * (c_), F.lane); khf[b_][jt] = frag16_kr(KH, WLD, 16 * jt, 16 * (c_), F.lane); } \
                    vfr[b_] = frag16_kr(VN, WLD, 16 * it, 16 * (c_), F.lane); uv0[b_] = UVT[((c_) * 4 + it) * 64 + F.lane]; } while (0)
                SB_LOAD(0, 0);
#pragma unroll
                for (int c = 0; c < 4; ++c) { const int cb_ = c & 1;
                    if (c < 3) SB_LOAD(c + 1, cb_ ^ 1);
                    s16x4 sfr[4];
#pragma unroll
                    for (int jt = 0; jt < 4; ++jt) sfr[jt] = cvt4(S[jt]);
#define CAT8(a_, b_) __builtin_shufflevector((a_), (b_), 0, 1, 2, 3, 4, 5, 6, 7)
                    const bf16x8 s01 = CAT8(sfr[0], sfr[1]), s23 = CAT8(sfr[2], sfr[3]);
                    f32x4 Ua = mma(uv0[cb_], CAT8(w1f[cb_][0], w1f[cb_][1]), s01); Ua = mma(Ua, CAT8(w1f[cb_][2], w1f[cb_][3]), s23);
                    const s16x4 ufr = cvt4(Ua); const bf16x8 uv8 = CAT8(ufr, vfr[cb_]);
#pragma unroll
                    for (int jt = 0; jt < 4; ++jt) S[jt] = mma(S[jt] * *(const LAS f32x4*)(GC + c * 64 + 16 * jt + 4 * fq), CAT8(bhf[cb_][jt], khf[cb_][jt]), uv8);
                    if (lat) { s16x4 rtf[4];
#pragma unroll
                        for (int jt = 0; jt < 4; ++jt) rtf[jt] = frag16_kc(RT, WLD, 16 * c, 16 * jt, F.lane);
                        const s16x4 pbf = frag16_kc(PRB + c * 256, 16, 0, 0, F.lane), pkf = frag16_kc(PRK + c * 256, 16, 0, 0, F.lane);
                        f32x4 Ya = mma((f32x4){0.f, 0.f, 0.f, 0.f}, CAT8(rtf[0], rtf[1]), s01); Ya = mma(Ya, CAT8(rtf[2], rtf[3]), s23);
                        const f32x4 Yb = mma((f32x4){0.f, 0.f, 0.f, 0.f}, CAT8(pbf, pkf), uv8);
                        const f32x4 Yt = Ya + Yb;
#pragma unroll
                        for (int r = 0; r < 4; ++r) YS[(16 * c + 4 * fq + r) * 68 + 16 * it + fr] = Yt[r]; }
                }
#undef SB_LOAD
            }
            LDS_BARRIER();
            if (lat) {
                const int g = sc * 64 + (F.tid >> 3); const int tl = z ? (SEQ + CTXL - 1 - g) : (g - CTXL);
                const f32x4 y0 = *(const LAS f32x4*)(YS + (F.tid >> 3) * 68 + 8 * (F.tid & 7)), y1 = *(const LAS f32x4*)(YS + (F.tid >> 3) * 68 + 8 * (F.tid & 7) + 4);
                u32x4 o; o.x = pk2(y0.x, y0.y); o.y = pk2(y0.z, y0.w); o.z = pk2(y1.x, y1.y); o.w = pk2(y1.z, y1.w);
                *(u32x4*)(Y + (size_t)(b * SEQ + tl) * D + h * 64 + 8 * (F.tid & 7)) = o; }
            LDS_BARRIER();
        }
#undef RW_LOAD
    }
    if (F.wave >= 4) {
        if (cv_dst) cv_store(cv_dst, cvv);
        for (; cv_next < 8 * CV_SCAN_ITEMS; cv_next += cv_stride) { const CvDesc d = cv_desc(F, cv_next, F.lane); cv_load(d, cvv); cv_store(d.dst, cvv); } }
}

DI void rwkv_readout_phase(Fr& F) {
    const bf16* VB = (const bf16*)(F.ws + WS_VB); const bf16* G = (const bf16*)(F.ws + WS_G); const float* COEF = (const float*)(F.ws + WS_COEF);
    const bf16* YF = (const bf16*)(F.ws + WS_YF); const bf16* YB = (const bf16*)(F.ws + WS_YB); bf16* Z = (bf16*)(F.ws + WS_H);
    const int c0 = 16 * F.lane, hh = F.lane >> 2, j0 = (F.lane & 3) * 16;
    float lnw[16], lnb[16];
#pragma unroll
    for (int q = 0; q < 16; ++q) { lnw[q] = F.in[31][c0 + q]; lnb[q] = F.in[32][c0 + q]; }
#define RD16(dst, ptr) do { const u32x4 t0_ = *(const u32x4*)(ptr), t1_ = *(const u32x4*)((ptr) + 8); const unsigned tw_[8] = {t0_.x, t0_.y, t0_.z, t0_.w, t1_.x, t1_.y, t1_.z, t1_.w}; \
        _Pragma("unroll") for (int q_ = 0; q_ < 8; ++q_) { dst[2 * q_] = bflo(tw_[q_]); dst[2 * q_ + 1] = bfhi(tw_[q_]); } } while (0)
    for (int row = F.gw; row < ML; row += F.NGW) {
        const size_t off = (size_t)row * D + c0; const int b = row / SEQ, t = row % SEQ;
        const size_t hoff = ((size_t)(b * 16 + hh) * (SEQ + CTXL) + CTXL + t) * 64 + j0;
        float y[16], yb[16], vv[16], gv[16];
        RD16(y, YF + off); RD16(yb, YB + off); RD16(vv, VB + hoff); RD16(gv, G + off);
        const float cf = COEF[(size_t)(b * 16 + hh) * SEQ + t] + COEF[(size_t)(128 + b * 16 + hh) * SEQ + t];
        float s = 0.f;
#pragma unroll
        for (int q = 0; q < 16; ++q) { y[q] += yb[q]; s += y[q]; }
        s = red4(s);
        const float mean = s * (1.f / 64.f); float q2 = 0.f;
#pragma unroll
        for (int q = 0; q < 16; ++q) { const float d = y[q] - mean; q2 += d * d; }
        q2 = red4(q2);
        const float rstd = rsqrtf(q2 * (1.f / 64.f) + 64e-5f);
        float o[16];
#pragma unroll
        for (int q = 0; q < 16; ++q) o[q] = ((y[q] - mean) * rstd * lnw[q] + lnb[q] + cf * vv[q]) * gv[q];
        u32x4 p0, p1; p0.x = pk2(o[0], o[1]); p0.y = pk2(o[2], o[3]); p0.z = pk2(o[4], o[5]); p0.w = pk2(o[6], o[7]); p1.x = pk2(o[8], o[9]); p1.y = pk2(o[10], o[11]); p1.z = pk2(o[12], o[13]); p1.w = pk2(o[14], o[15]);
        *(u32x4*)(Z + off) = p0; *(u32x4*)(Z + off + 8) = p1;
    }
#undef RD16
}

DI void moe_route_phase(Fr& F, const float* xl, const float* normw, const float* modl) {
    bf16* H2 = (bf16*)(F.ws + WS_MIX); int* TopE = (int*)(F.ws + WS_MISC + MISC_TOPE); f32x2* TopW = (f32x2*)(F.ws + WS_MISC + MISC_TOPW); int* Cnts = (int*)(F.ws + WS_MISC + MISC_CNTS);
    LAS int* lc = (LAS int*)F.lds;
    f32x4 rw[4][4][2];
#pragma unroll
    for (int j = 0; j < 4; ++j)
#pragma unroll
        for (int q = 0; q < 4; ++q) { const float* rp = F.in[34] + (size_t)(4 * (F.lane + 64 * j) + q) * 8; rw[j][q][0] = *(const f32x4*)rp; rw[j][q][1] = *(const f32x4*)(rp + 4); }
    for (int wg = F.bx; wg < 256; wg += F.G) {
        LDS_BARRIER();
#pragma unroll 2
        for (int it = 0; it < 8; ++it) { const int row = wg * 64 + F.wave * 8 + it;
            const float* src = xl + (size_t)row * D; const float* mrow = modl + (size_t)(row / SEQ) * 6144;
            f32x4 v[4]; float ss = 0.f;
#pragma unroll
            for (int j = 0; j < 4; ++j) { v[j] = ((const f32x4*)src)[F.lane + 64 * j]; ss += (v[j].x * v[j].x + v[j].y * v[j].y) + (v[j].z * v[j].z + v[j].w * v[j].w); }
            const float rstd = rsqrtf(wave_sum_fast(ss) * (1.f / D) + 1e-6f);
            f32x4 l0 = (f32x4){0.f, 0.f, 0.f, 0.f}, l1 = l0;
#pragma unroll
            for (int j = 0; j < 4; ++j) { const int c4 = F.lane + 64 * j;
                const f32x4 w = ((const f32x4*)normw)[c4], sc = ((const f32x4*)(mrow + 4096))[c4], sh = ((const f32x4*)(mrow + 3072))[c4];
                const f32x4 y = v[j] * rstd * w * (sc + 1.f) + sh;
                u32x2 p; p.x = pk2(y.x, y.y); p.y = pk2(y.z, y.w); ((u32x2*)(H2 + (size_t)row * D))[c4] = p;
                l0 += rw[j][0][0] * y.x + rw[j][1][0] * y.y + rw[j][2][0] * y.z + rw[j][3][0] * y.w;
                l1 += rw[j][0][1] * y.x + rw[j][1][1] * y.y + rw[j][2][1] * y.z + rw[j][3][1] * y.w; }
            float lg[8] = {l0.x, l0.y, l0.z, l0.w, l1.x, l1.y, l1.z, l1.w};
#pragma unroll
            for (int e = 0; e < 8; ++e) lg[e] = wave_sum_fast(lg[e]);
            int e0 = 0; float v0 = lg[0];
#pragma unroll
            for (int e = 1; e < 8; ++e) if (lg[e] > v0) { v0 = lg[e]; e0 = e; }
            int e1 = -1; float v1 = -3.0e38f;
#pragma unroll
            for (int e = 0; e < 8; ++e) if (e != e0 && lg[e] > v1) { v1 = lg[e]; e1 = e; }
            const float w0 = 1.f / (1.f + expf(v1 - v0)), w1 = 1.f - w0;
            if (F.lane == 0) { TopE[row] = e0 | (e1 << 8); TopW[row] = (f32x2){w0, w1}; lc[F.wave * 8 + it] = e0 | (e1 << 8); }
        }
        LDS_BARRIER();
        if (F.tid < 8) { int c = 0; for (int t = 0; t < 64; ++t) { const int code = lc[t]; c += ((code & 255) == F.tid ? 1 : 0) + ((code >> 8) == F.tid ? 1 : 0); } Cnts[wg * 8 + F.tid] = c; }
    }
}
DI void moe_gather_phase(Fr& F) {
    const bf16* H2 = (const bf16*)(F.ws + WS_MIX); const int* TopE = (const int*)(F.ws + WS_MISC + MISC_TOPE); const f32x2* TopW = (const f32x2*)(F.ws + WS_MISC + MISC_TOPW);
    const int* Cnts = (const int*)(F.ws + WS_MISC + MISC_CNTS); int* Exp = (int*)(F.ws + WS_MISC + MISC_EXP);
    bf16* XG = (bf16*)(F.ws + WS_XG); int* RowTok = (int*)(F.ws + WS_ROWS); float* RowW = (float*)(F.ws + WS_ROWS + 262144);
    LAS int* lc = (LAS int*)F.lds;
    LAS int* tot = lc + 2048;
    LAS int* rows = tot + 32;
    LAS int* te = rows + 128;
    for (int idx = F.tid; idx < 2048; idx += NTHR) lc[idx] = Cnts[idx];
    WG_SYNC();
    for (int wg = F.bx; wg < 256; wg += F.G) {
        if (F.tid < 64) te[F.tid] = TopE[wg * 64 + F.tid];
        if (F.tid < 8) { int t = 0, mb = 0; for (int w = 0; w < 256; ++w) { const int c = lc[w * 8 + F.tid]; t += c; mb += (w < wg) ? c : 0; } tot[F.tid] = t; tot[16 + F.tid] = mb; }
        WG_SYNC();
        if (F.tid == 0) { int sgs = 0; for (int e = 0; e < 8; ++e) { tot[8 + e] = sgs; sgs += (tot[e] + 255) & ~255; }
            if (wg == 0) { int acc = 0; for (int e = 0; e < 8; ++e) { Exp[e] = tot[e]; Exp[8 + e] = tot[8 + e]; acc += (tot[e] + 255) >> 8; Exp[16 + e] = acc; } } }
        WG_SYNC();
        if (F.tid < 64) { const int code = te[F.tid]; const int e0 = code & 255, e1 = code >> 8; int r0 = 0, r1 = 0;
            for (int t = 0; t < F.tid; ++t) { const int c2 = te[t]; const int a = c2 & 255, bq = c2 >> 8; r0 += (a == e0 ? 1 : 0) + (bq == e0 ? 1 : 0); r1 += (a == e1 ? 1 : 0) + (bq == e1 ? 1 : 0); }
            rows[2 * F.tid] = tot[8 + e0] + tot[16 + e0] + r0; rows[2 * F.tid + 1] = tot[8 + e1] + tot[16 + e1] + r1; }
        WG_SYNC();
        for (int it = F.wave; it < 128; it += NWAVES) { const int t = it >> 1, k = it & 1, tok = wg * 64 + t, row = rows[it];
            const u32x4* s = (const u32x4*)(H2 + (size_t)tok * D); u32x4* d = (u32x4*)(XG + (size_t)row * D);
            d[F.lane] = s[F.lane]; d[F.lane + 64] = s[F.lane + 64];
            if (F.lane == 0) { RowTok[row] = tok * 2 + k; const f32x2 w = TopW[tok]; RowW[row] = k ? w.y : w.x; } }
        if (wg == 0) {
            for (int e = 0; e < 8; ++e) { const int a = tot[8 + e] + tot[e], bnd = tot[8 + e] + ((tot[e] + 255) & ~255); for (int rr = a + F.tid; rr < bnd; rr += NTHR) RowTok[rr] = -1; } }
        WG_SYNC();
    }
}
DI void moe_combine_phase(Fr& F, float* xl, const float* modl) {
    const bf16* YS = (const bf16*)(F.ws + WS_YS);
    for (int row = F.gw; row < ML; row += F.NGW) {
        const float* mrow = modl + (size_t)(row / SEQ) * 6144 + 5120; float* xr = xl + (size_t)row * D;
        const u32x2* s0 = (const u32x2*)(YS + (size_t)(2 * row) * D); const u32x2* s1 = (const u32x2*)(YS + (size_t)(2 * row + 1) * D);
#pragma unroll
        for (int j = 0; j < 4; ++j) { const int c4 = F.lane + 64 * j; const f32x4 x = ((const f32x4*)xr)[c4], m = ((const f32x4*)mrow)[c4]; const u32x2 a = s0[c4], bq = s1[c4];
            f32x4 o; o.x = x.x + m.x * (bflo(a.x) + bflo(bq.x)); o.y = x.y + m.y * (bfhi(a.x) + bfhi(bq.x)); o.z = x.z + m.z * (bflo(a.y) + bflo(bq.y)); o.w = x.w + m.w * (bfhi(a.y) + bfhi(bq.y));
            ((f32x4*)xr)[c4] = o; }
    }
}

constexpr int N_PHASES = 20;

struct Args { const float* in[37]; float* out; unsigned char* ws; int ph_lo, ph_hi; };
template <class Epi> DI void run_gemm(Fr& F, const bf16* A, const bf16* Bt, int M, int N, int K, const Epi& E, int& rot) {
    int Kv = K; asm volatile("" : "+s"(Kv));
    pg8::Gemm g{A, Bt, M, N, Kv}; pg8::StaticOrder S; S.init(M, N, F.G, (F.bx + F.G - (rot % F.G)) % F.G); rot += (M / 256) * (N / 256);
    pg8::gemm_phase<Epi, pg8::StaticOrder>(F.lds, g, S, E);
}
__global__ void __launch_bounds__(NTHR, 2) fwd_kernel(Args args) {
    extern __shared__ __attribute__((aligned(16))) unsigned char lds_raw[];
    Fr F;
    F.lds = (LAS unsigned char*)lds_raw; F.ws = args.ws; F.in = args.in; F.out = args.out;
    F.tid = threadIdx.x; F.lane = F.tid & 63; F.wave = __builtin_amdgcn_readfirstlane(F.tid >> 6); F.bx = blockIdx.x; F.G = gridDim.x;
    F.gw = F.bx * NWAVES + F.wave; F.NGW = F.G * NWAVES;
    volatile LAS unsigned* MISC = (volatile LAS unsigned*)(F.lds + LDS_MISC_OFF);
    if (F.tid < 64) MISC[F.tid] = 0u;
    __syncthreads();
    const int lo = args.ph_lo, hi = args.ph_hi;
    const bool multi = (hi - lo) > 1;
    XcdBarrier bar; bar.bar = (unsigned*)(F.ws + WS_CTL) + CW_BAR; bar.x = 0; bar.st = nullptr;
    if (multi) bar = xcd_barrier_post((unsigned*)(F.ws + WS_CTL) + CW_BAR, MISC + 8);
#ifndef PH_MASK
#define PH_MASK 0xFFFFFFFFu
#endif
#define IN(k) ((((PH_MASK) >> (k)) & 1u) && lo <= (k) && (k) < hi)
#define REP(k) for (int rep_ = 0; rep_ < ((((PROBE_DUP) >> (k)) & 1u) ? 2 : 1); ++rep_)
#define SEAM(k) do { if (IN(k) && IN((k) + 1)) xcd_barrier(bar); } while (0)
    const float* const* in = args.in;
    float* MOD = (float*)(F.ws + WS_MOD);
    float* XL = F.out; float* XC = (float*)(F.ws + WS_XC);
    bf16* H = (bf16*)(F.ws + WS_H); bf16* MIX = (bf16*)(F.ws + WS_MIX);

    if (IN(0)) REP(0) { p0_prologue(F); } SEAM(0);
    if (IN(1)) REP(1) { mod_rows(F, in[0], in[2], MA, in[6], MOD, 0, 1024, H); } SEAM(1);
    if (IN(2)) REP(2) { int rot = 0; EpiStore<0> E{(bf16*)(F.ws + WS_QKV), INW, INW}; run_gemm(F, H, (const bf16*)(F.ws + WS_W_IN), MA, INW, 1024, E, rot); } SEAM(2);
    if (IN(3)) REP(3) { na_norm_rows(F); ret_kv_phase(F); } SEAM(3);
    if (IN(4)) REP(4) { ret_prefix_phase(F); } SEAM(4);
    #ifndef PH5_SEL
#define PH5_SEL 3
#endif
    if (IN(5)) REP(5) { for (int r5_ = 0; r5_ < ((((PROBE_DUP) >> 27) & 1u) ? 2 : 1); ++r5_) ret_out_phase(F); for (int r6_ = 0; r6_ < ((((PROBE_DUP) >> 28) & 1u) ? 2 : 1); ++r6_) na_phase(F); } SEAM(5);
    if (IN(6)) REP(6) { int rot = 0; EpiResid E{in[0], XL, in[2], XC, MOD + 2048}; run_gemm(F, MIX, (const bf16*)(F.ws + WS_W_OUT), MA, 1024, 1024, E, rot); moe_fill(F, F.bx - 32, F.G - 32, 0, FILL_A); } SEAM(6);
    if (IN(7)) REP(7) { mod_rows(F, XL, XC, MA, in[7], MOD, 3072, 4096, H); } SEAM(7);
    if (IN(8)) REP(8) { int rot = 0; EpiSwiglu E{(bf16*)(F.ws + WS_FFH), FFN_H}; run_gemm(F, H, (const bf16*)(F.ws + WS_W_13), MA, 2 * FFN_H, 1024, E, rot); moe_fill(F, F.bx - 48, F.G - 48, FILL_A, FILL_B); } SEAM(8);
    if (IN(9)) { int rot = 0; EpiResid E{XL, XL, XC, XC, MOD + 5120}; run_gemm(F, (const bf16*)(F.ws + WS_FFH), (const bf16*)(F.ws + WS_W_2), MA, 1024, FFN_H, E, rot); moe_fill(F, F.bx - 32, F.G - 32, FILL_B, FILL_C); } SEAM(9);
    const float* MOD1 = MOD + 9 * 6144;
    if (IN(10)) REP(10) { xm_phase(F, XL, XC, in[6] + 1024, MOD1); } SEAM(10);
    if (IN(11)) REP(11) { int rot = 0; const bf16* XM = (const bf16*)(F.ws + WS_XM); const bf16* WR = (const bf16*)(F.ws + WS_W_RKV); const bf16* WL1 = (const bf16*)(F.ws + WS_W_L1);
        { EpiStoreHead E{(bf16*)(F.ws + WS_RB), SEQ, 0}; run_gemm(F, XM, WR, ML, 1024, 1024, E, rot); }
        { EpiStoreHead E{(bf16*)(F.ws + WS_KB), SEQ + CTXL, CTXL}; run_gemm(F, XM + (size_t)1 * MA * D, WR + 1024 * 1024, MA, 1024, 1024, E, rot); }
        { EpiStoreHead E{(bf16*)(F.ws + WS_VB), SEQ + CTXL, CTXL}; run_gemm(F, XM + (size_t)2 * MA * D, WR + 2 * 1024 * 1024, MA, 1024, 1024, E, rot); }
        { EpiStore<1> E{(bf16*)(F.ws + WS_L1), 256, 128}; run_gemm(F, XM + (size_t)3 * MA * D, WL1, MA, 256, 1024, E, rot); }
        { EpiStore<0> E{(bf16*)(F.ws + WS_L1) + 128, 256, 128}; run_gemm(F, XM + (size_t)4 * MA * D, WL1 + 256 * 1024, MA, 256, 1024, E, rot); }
        { EpiStore<2> E{(bf16*)(F.ws + WS_LG), 256, 256}; run_gemm(F, XM + (size_t)5 * MA * D, WL1 + 2 * 256 * 1024, ML, 256, 1024, E, rot); }
        } SEAM(11);
    if (IN(12)) REP(12) { int rot = 0;
        { EpiLora2 E{(bf16*)(F.ws + WS_DEC), (bf16*)(F.ws + WS_AG), in[20], in[23]}; run_gemm(F, (const bf16*)(F.ws + WS_L1), (const bf16*)(F.ws + WS_W_L2), MA, 4096, 256, E, rot); }
        { EpiStore<0> E{(bf16*)(F.ws + WS_G), D, D}; run_gemm(F, (const bf16*)(F.ws + WS_LG), (const bf16*)(F.ws + WS_W_G2), ML, 1024, 256, E, rot); } } SEAM(12);
    #ifndef SCAN_VER
#define SCAN_VER 2
#endif
    if (IN(13)) REP(13) { rwkv_scan2_phase(F); } SEAM(13);
    if (IN(14)) REP(14) { rwkv_readout_phase(F); } SEAM(14);
    if (IN(15)) { int rot = 0; EpiResid E{XL, XL, XC, XC, MOD1 + 2048}; run_gemm(F, H, (const bf16*)(F.ws + WS_W_O), ML, 1024, 1024, E, rot); } SEAM(15);
    if (IN(16)) REP(16) { moe_route_phase(F, XL, in[7] + 1024, MOD1); } SEAM(16);
    if (IN(17)) REP(17) { moe_gather_phase(F); } SEAM(17);
    if (IN(18) || IN(19)) {
        const int* Exp = (const int*)(F.ws + WS_MISC + MISC_EXP);
        pg8::MoeOrder S; S.G = F.G; S.c = F.bx;
#pragma unroll
        for (int e = 0; e < 8; ++e) S.tend[e] = Exp[16 + e];
        S.nM = S.tend[7];
        if (IN(18)) REP(18) { S.nN = 2 * EXP_H / 256; S.nwg = S.nM * S.nN; pg8::Gemm g{(const bf16*)(F.ws + WS_XG), (const bf16*)(F.ws + WS_W_M13), XG_ROWS, 2 * EXP_H, 1024};
            EpiSwiglu E{(bf16*)(F.ws + WS_HG), EXP_H}; pg8::gemm_phase<EpiSwiglu, pg8::MoeOrder>(F.lds, g, S, E); }
        SEAM(18);
        if (IN(19)) REP(19) { S.nN = 4; S.nwg = S.nM * S.nN; pg8::Gemm g{(const bf16*)(F.ws + WS_HG), (const bf16*)(F.ws + WS_W_M2), XG_ROWS, 1024, EXP_H};
            EpiMoeOut E{(bf16*)(F.ws + WS_YS), (const int*)(F.ws + WS_ROWS), (const float*)(F.ws + WS_ROWS + 262144)}; pg8::gemm_phase<EpiMoeOut, pg8::MoeOrder>(F.lds, g, S, E); }
    }
    if (IN(19) && IN(20)) xcd_barrier(bar);
    if (IN(19) && IN(20)) for (int xb_ = 0; xb_ < ((((PROBE_DUP) >> 29) & 1u) ? 20 : 0); ++xb_) xcd_barrier(bar);
    if (IN(20)) { moe_combine_phase(F, XL, MOD1); }
#undef IN
#undef SEAM
}

#ifndef MK_SPLIT
#define MK_SPLIT 0
#endif
extern "C" void kernel_launch(void* const* d_in, const int* in_sizes, int n_in, void* d_out, int out_size, void* d_ws, size_t ws_size, hipStream_t stream) {
    static int grid = 0;
    if (grid == 0) {
        if (n_in != 37 || out_size != ML * D || ws_size < WS_END) { fprintf(stderr, "kernel_launch: unexpected problem (n_in %d out %d ws %zu)\n", n_in, out_size, ws_size); grid = -1; return; }
        int dev = 0, cus = 0, per_cu = 0;
        if (hipGetDevice(&dev) != hipSuccess || hipDeviceGetAttribute(&cus, hipDeviceAttributeMultiprocessorCount, dev) != hipSuccess) { grid = -1; return; }
        if (hipFuncSetAttribute((const void*)fwd_kernel, hipFuncAttributeMaxDynamicSharedMemorySize, LDS_BYTES) != hipSuccess) { fprintf(stderr, "kernel_launch: hipFuncSetAttribute failed\n"); grid = -1; return; }
        if (hipOccupancyMaxActiveBlocksPerMultiprocessor(&per_cu, (const void*)fwd_kernel, NTHR, LDS_BYTES) != hipSuccess || per_cu < 1) { fprintf(stderr, "kernel_launch: occupancy query says %d\n", per_cu); }
        (void)hipGetLastError();
        grid = cus;
    }
    if (grid < 0) return;
    (void)hipMemsetAsync((char*)d_ws + WS_CTL, 0, CTL_ZERO_BYTES, stream);
    Args a{};
    for (int i = 0; i < 37; ++i) a.in[i] = (const float*)d_in[i];
    a.out = (float*)d_out; a.ws = (unsigned char*)d_ws;
#if MK_SPLIT
    for (int p = 0; p <= N_PHASES; ++p) { a.ph_lo = p; a.ph_hi = p + 1; hipLaunchKernelGGL(fwd_kernel, dim3(grid), dim3(NTHR), LDS_BYTES, stream, a); }
#elif defined(PROBE_RELAUNCH)
    a.ph_lo = 0; a.ph_hi = PROBE_RELAUNCH + 1; hipLaunchKernelGGL(fwd_kernel, dim3(grid), dim3(NTHR), LDS_BYTES, stream, a);
    (void)hipMemsetAsync((char*)d_ws + WS_CTL, 0, CTL_ZERO_BYTES, stream);
    a.ph_lo = PROBE_RELAUNCH; a.ph_hi = PROBE_RELAUNCH + 1; hipLaunchKernelGGL(fwd_kernel, dim3(grid), dim3(NTHR), LDS_BYTES, stream, a);
    a.ph_lo = PROBE_RELAUNCH + 1; a.ph_hi = N_PHASES + 1; hipLaunchKernelGGL(fwd_kernel, dim3(grid), dim3(NTHR), LDS_BYTES, stream, a);
#else
    a.ph_lo = 0; a.ph_hi = N_PHASES + 1; hipLaunchKernelGGL(fwd_kernel, dim3(grid), dim3(NTHR), LDS_BYTES, stream, a);
#endif
}
```

```cpp
#include <hip/hip_runtime.h>
#include <cstdio>
#include <cstdint>

#ifndef PROBE_DUP
#define PROBE_DUP 0u
#endif
#define DI __device__ __forceinline__
#define LAS __attribute__((address_space(3)))

namespace pg8 {
#define PG8_LAS __attribute__((address_space(3)))
typedef unsigned short bf16_t;
typedef short bf16x8 __attribute__((ext_vector_type(8)));
typedef float f32x4 __attribute__((ext_vector_type(4)));
typedef unsigned u32x4 __attribute__((ext_vector_type(4)));
constexpr int BM = 256, BK = 64, HALF = 128, HTB = HALF * BK * 2  , STAGE_BYTES = 8 * HTB, NXCD = 8, WGM = 8;

__host__ __device__ __forceinline__ int lds_byte(int r, int c) { const int st = (r >> 4) * 2 + (c >> 5), rr = r & 15, cc = c & 31, ob = rr * 64 + cc * 2; return st * 1024 + (ob ^ (((ob >> 9) & 1) << 5)); }
__host__ __device__ __forceinline__ void stage_rc(int b, int& R, int& C) { const int st = b / 1024, sb = b % 1024, swz = sb ^ (((sb >> 9) & 1) << 5); R = (st >> 1) * 16 + swz / 64; C = (st & 1) * 32 + (swz % 64) / 2; }
__host__ __device__ __forceinline__ int perm32(int rho) { const int n = rho >> 4, i = rho & 15; return 8 * (i >> 2) + 4 * n + (i & 3); }

struct Unit { int pm, pn, pb, kofs, aux; };
struct Gemm { const bf16_t* A; const bf16_t* Bt; int M, N, K; int ld = 0; };

struct StaticOrder {
    int nM, nN, nwg, G, c;
    __host__ __device__ void init(int M, int N, int G_, int c_) { nM = M / BM; nN = N / BM; nwg = nM * nN; G = G_; c = c_; }
    __host__ __device__ bool next(int i, Unit& u) const {
        const long L = (long)i * G + c; if (L >= nwg) return false;
        int wgid = (int)L; { const int q = nwg / NXCD, r = nwg % NXCD, xcd = wgid % NXCD, off = wgid / NXCD; wgid = (xcd < r ? xcd * (q + 1) : r * (q + 1) + (xcd - r) * q) + off; }
        const int nig = WGM * nN, gid = wgid / nig, fm = gid * WGM, gsz = (nM - fm) < WGM ? (nM - fm) : WGM;
        u.pm = fm + ((wgid % nig) % gsz); u.pn = (wgid % nig) / gsz; u.pb = u.pn; return true;
    }
    static constexpr bool DEFER = false;
    __device__ __forceinline__ void a_ready(const Unit&) const {}
    __device__ __forceinline__ void done(const Unit&) const {}
};
struct MoeOrder {
    int nM, nN, nwg, G, c; int tend[8]; int pm0;
    __device__ bool next(int i, Unit& u) const {
        const long L = (long)i * G + c; if (L >= nwg) return false;
        int wgid = (int)L; { const int q = nwg / NXCD, r = nwg % NXCD, xcd = wgid % NXCD, off = wgid / NXCD; wgid = (xcd < r ? xcd * (q + 1) : r * (q + 1) + (xcd - r) * q) + off; }
        const int nig = WGM * nN, gid = wgid / nig, fm = gid * WGM, gsz = (nM - fm) < WGM ? (nM - fm) : WGM;
        u.pm = pm0 + fm + ((wgid % nig) % gsz); u.pn = (wgid % nig) / gsz;
        int e = 0;
#pragma unroll
        for (int j = 0; j < 7; ++j) e += (u.pm >= tend[j]) ? 1 : 0;
        u.pb = e * nN + u.pn; return true;
    }
    static constexpr bool DEFER = false;
    __device__ __forceinline__ void a_ready(const Unit&) const {}
    __device__ __forceinline__ void done(const Unit&) const {}
};

typedef float f32x2_t __attribute__((ext_vector_type(2))); typedef __bf16 bf16x2_t __attribute__((ext_vector_type(2)));
struct TailSplitOrder {
    int nsub, G, c; int tend[8];
    __device__ bool next(int i, Unit& u) const {
        const int s = i * G + c; if (s >= nsub) return false;
        const int t = s / 7, part = s % 7; u.pm = 128 + (t >> 2); u.pn = t & 3; u.kofs = part * 512; u.aux = part;
        int e = 0;
#pragma unroll
        for (int j = 0; j < 7; ++j) e += (u.pm >= tend[j]) ? 1 : 0;
        u.pb = e * 4 + u.pn; return true;
    }
    static constexpr bool DEFER = false;
    __device__ __forceinline__ void a_ready(const Unit&) const {}
    __device__ __forceinline__ void done(const Unit&) const {}
};
struct FlowProdOrder {
    static constexpr bool DEFER = true;
    int G, c; unsigned* cnt;
    __device__ bool next(int i, Unit& u) const {
        int p;
        if (G == 256) { const int xcd = c & 7, slot = c >> 3;
            if (i < 4) p = 256 * i + 32 * xcd + slot;
            else if (i < 6) { if (slot < 4) return false; p = 1024 + 224 * (i - 4) + 28 * xcd + (slot - 4); }
            else if (i == 6) { if (slot < 4 || slot >= 18) return false; p = 1472 + 14 * xcd + (slot - 4); }
            else return false; }
        else { const long L = (long)i * G + c; if (L >= 1584) return false; p = (int)L; }
        const int g = p / 176, r = p % 176; u.pm = 8 * g + (r & 7); u.pn = r >> 3; u.pb = u.pn; return true;
    }
    __device__ __forceinline__ void a_ready(const Unit&) const {}
    __device__ __forceinline__ void done(const Unit& u) const {
        if ((threadIdx.x & 63) == 0) __hip_atomic_fetch_add(cnt + 64 * u.pm, 1u, __ATOMIC_RELAXED, __HIP_MEMORY_SCOPE_AGENT); }
};
struct FlowConsOrder {
    static constexpr bool DEFER = false;
    int G, c; const unsigned* cnt;
    __device__ bool next(int i, Unit& u) const {
        if (G == 256) { const int xcd = c & 7, slot = c >> 3;
            if (slot < 4) { if (i > 1) return false; u.pm = (i ? 64 : 0) + xcd; u.pn = slot; }
            else { if (i > 0) return false; const int q = slot >= 18 ? slot - 18 : 14 + (slot - 4); u.pm = 8 + xcd + 8 * (q >> 2); u.pn = q & 3; } }
        else { const long L = (long)i * G + c; if (L >= 288) return false; u.pm = (int)(L >> 2); u.pn = (int)(L & 3); }
        u.pb = u.pn; return true;
    }
    __device__ __forceinline__ void a_ready(const Unit& u) const {
        const unsigned* w = cnt + 64 * u.pm;
        for (unsigned spins = 0; spins < (1u << 21); ++spins) {
            if ((unsigned)__builtin_amdgcn_readfirstlane((int)__hip_atomic_load(w, __ATOMIC_RELAXED, __HIP_MEMORY_SCOPE_AGENT)) >= 176u) break;
            __builtin_amdgcn_s_sleep(2); }
        __builtin_amdgcn_fence(__ATOMIC_ACQUIRE, "agent");
    }
    __device__ __forceinline__ void done(const Unit&) const {}
};
__device__ __forceinline__ unsigned cvt_pk_bf16(float lo, float hi) { const f32x2_t v = {lo, hi}; const bf16x2_t b = __builtin_convertvector(v, bf16x2_t); return __builtin_bit_cast(unsigned, b); }

template <class Epi, class Sched>
__device__ __forceinline__ void gemm_phase(PG8_LAS unsigned char* lds, const Gemm g, const Sched& S, const Epi& E) {
    const int tid = threadIdx.x, wid = __builtin_amdgcn_readfirstlane(tid >> 6), lane = tid & 63, wr = wid >> 2, wc = wid & 3, fr = lane & 15, fq = lane >> 4;
    const int K = g.K, nt = K / BK, ld = g.ld ? g.ld : g.K;
    unsigned voffA[2], voffB[2];
#pragma unroll
    for (int i = 0; i < 2; ++i) { int R, C; stage_rc(tid * 16 + i * 8192, R, C); const int Rb = Epi::PERM ? ((R & ~31) + perm32(R & 31)) : R;
        voffA[i] = (unsigned)(R * ld + C) * 2u; voffB[i] = (unsigned)(Rb * ld + C) * 2u; }
    const size_t kstep = (size_t)(BK * 2);
    const size_t hstep = (size_t)HALF * ld * 2;
    const size_t tstep = 2 * hstep;
    const unsigned ldsw = (unsigned)wid * 1024u;
    const int aoff = lds_byte(wr * 64 + fr, fq * 8), boff = lds_byte(wc * 32 + fr, fq * 8);
#define PG8_SA(b, h) (((b) * 2 + (h)) * HTB)
#define PG8_SB(b, h) ((4 + (b) * 2 + (h)) * HTB)
#define PG8_STAGE(bufoff, gbase, voff) do { _Pragma("unroll") for (int _i = 0; _i < 2; ++_i) \
        __builtin_amdgcn_global_load_lds((const unsigned*)((const char*)(gbase) + (voff)[_i]), (PG8_LAS unsigned*)(lds + (bufoff) + ldsw + _i * 8192), 16, 0, 0); } while (0)
#define PG8_LDA(dst, b, h) do { _Pragma("unroll") for (int m = 0; m < 4; ++m) _Pragma("unroll") for (int k = 0; k < 2; ++k) dst[m][k] = *(const PG8_LAS bf16x8*)(lds + PG8_SA(b, h) + aoff + m * 2048 + k * 1024); } while (0)
#define PG8_LDB(dst, b, h) do { _Pragma("unroll") for (int n = 0; n < 2; ++n) _Pragma("unroll") for (int k = 0; k < 2; ++k) dst[n][k] = *(const PG8_LAS bf16x8*)(lds + PG8_SB(b, h) + boff + n * 2048 + k * 1024); } while (0)
#define PG8_MMA(ai, bj, At, Bt) do { __builtin_amdgcn_s_setprio(1); _Pragma("unroll") for (int m = 0; m < 4; ++m) _Pragma("unroll") for (int n = 0; n < 2; ++n) _Pragma("unroll") for (int k = 0; k < 2; ++k) \
        acc[ai][bj][m][n] = __builtin_amdgcn_mfma_f32_16x16x32_bf16(Bt[n][k], At[m][k], acc[ai][bj][m][n], 0, 0, 0); __builtin_amdgcn_s_setprio(0); } while (0)
#define PG8_WAIT_V(n) asm volatile("s_waitcnt vmcnt(" #n ")" ::: "memory")
#define PG8_WAIT_L(n) asm volatile("s_waitcnt lgkmcnt(" #n ")" ::: "memory")
#define PG8_BAR __builtin_amdgcn_s_barrier()
#define PG8_SCHED __builtin_amdgcn_sched_barrier(0)
    Unit cur, nxt; int ui = 0; cur.kofs = 0; cur.aux = 0; nxt.kofs = 0; nxt.aux = 0; int pend_pm = -1;
    if (!S.next(0, cur)) return;
    f32x4 acc[2][2][4][2];
    bf16x8 At[4][2], B0[2][2], B1[2][2];
    const char* cA = (const char*)g.A + (size_t)cur.pm * tstep + (size_t)cur.kofs * 2; const char* cB = (const char*)g.Bt + (size_t)cur.pb * tstep + (size_t)cur.kofs * 2;
    S.a_ready(cur);
    PG8_STAGE(PG8_SB(0, 0), cB, voffB); PG8_STAGE(PG8_SB(0, 1), cB + hstep, voffB); PG8_STAGE(PG8_SA(0, 0), cA, voffA); PG8_STAGE(PG8_SA(0, 1), cA + hstep, voffA);
    if (wr == 1) PG8_BAR;
    PG8_WAIT_V(2); PG8_BAR;
    PG8_STAGE(PG8_SB(1, 0), cB + kstep, voffB); PG8_STAGE(PG8_SA(1, 0), cA + kstep, voffA); PG8_STAGE(PG8_SB(1, 1), cB + hstep + kstep, voffB);
    PG8_WAIT_V(6); PG8_BAR;
    for (;;) {
        const bool has_next = S.next(ui + 1, nxt);
        const char* nA = has_next ? (const char*)g.A + (size_t)nxt.pm * tstep + (size_t)nxt.kofs * 2 : cA; const char* nB = has_next ? (const char*)g.Bt + (size_t)nxt.pb * tstep + (size_t)nxt.kofs * 2 : cB;
#pragma unroll
        for (int a = 0; a < 2; ++a)
#pragma unroll
            for (int b = 0; b < 2; ++b)
#pragma unroll
                for (int m = 0; m < 4; ++m)
#pragma unroll
                    for (int n = 0; n < 2; ++n) acc[a][b][m][n] = (f32x4){0.f, 0.f, 0.f, 0.f};
        int t = 0;
        do {
            const bool last = (t == nt - 2);
            const char* a1 = cA + (size_t)(t + 1) * kstep;
            const char* a2 = last ? nA : cA + (size_t)(t + 2) * kstep; const char* b2 = last ? nB : cB + (size_t)(t + 2) * kstep;
            const char* a3 = a2 + kstep; const char* b3 = b2 + kstep;
            if (last && has_next) S.a_ready(nxt);
            PG8_LDB(B0, 0, 0); PG8_LDB(B1, 0, 1); PG8_SCHED; PG8_LDA(At, 0, 0); PG8_STAGE(PG8_SA(1, 1), a1 + hstep, voffA);
            PG8_WAIT_V(8); PG8_WAIT_L(0); PG8_BAR; PG8_MMA(0, 0, At, B0); PG8_MMA(0, 1, At, B1); PG8_BAR; PG8_SCHED;
            PG8_LDA(At, 0, 1); PG8_STAGE(PG8_SB(0, 0), b2, voffB); PG8_STAGE(PG8_SB(0, 1), b2 + hstep, voffB); PG8_STAGE(PG8_SA(0, 0), a2, voffA);
            PG8_WAIT_V(8);
            if (Sched::DEFER && pend_pm >= 0) { Unit pu; pu.pm = pend_pm; S.done(pu); pend_pm = -1; }
            PG8_WAIT_L(0); PG8_BAR; PG8_MMA(1, 0, At, B0); PG8_MMA(1, 1, At, B1); PG8_BAR; PG8_SCHED;
            PG8_LDB(B0, 1, 0); PG8_LDB(B1, 1, 1); PG8_SCHED; PG8_LDA(At, 1, 0); PG8_STAGE(PG8_SA(0, 1), a2 + hstep, voffA);
            PG8_WAIT_V(8); PG8_WAIT_L(0); PG8_BAR; PG8_MMA(0, 0, At, B0); PG8_MMA(0, 1, At, B1); PG8_BAR; PG8_SCHED;
            PG8_LDA(At, 1, 1); PG8_STAGE(PG8_SB(1, 0), b3, voffB); PG8_STAGE(PG8_SB(1, 1), b3 + hstep, voffB); PG8_STAGE(PG8_SA(1, 0), a3, voffA);
            PG8_WAIT_V(8); PG8_WAIT_L(0); PG8_BAR; PG8_MMA(1, 0, At, B0); PG8_MMA(1, 1, At, B1); PG8_BAR; PG8_SCHED;
        } while ((t += 2) < nt);
        if (wr == 0) PG8_BAR;
        E(acc, cur, wr, wc, fr, fq); if (Sched::DEFER) pend_pm = cur.pm; else S.done(cur);
        if (!has_next) break;
        cur = nxt; cA = nA; cB = nB; ++ui;
        if (wr == 1) PG8_BAR;
    }
    PG8_WAIT_V(0);
    PG8_BAR;
    if (Sched::DEFER && pend_pm >= 0) { Unit pu; pu.pm = pend_pm; S.done(pu); }
#undef PG8_SA
#undef PG8_SB
#undef PG8_STAGE
#undef PG8_LDA
#undef PG8_LDB
#undef PG8_MMA
#undef PG8_WAIT_V
#undef PG8_WAIT_L
#undef PG8_BAR
#undef PG8_SCHED
}
}

constexpr int D = 1024, NB = 8, SEQ = 2048, CTXL = 256;
constexpr int ML = NB * SEQ;
constexpr int MC = NB * CTXL;
constexpr int MA = ML + MC;
constexpr int INW = 3584, FFN_H = 2816, EXP_H = 3584, NEXP = 8;
constexpr int NCH = 18;
constexpr int XG_ROWS = 34816;
constexpr int NWAVES = 8, NTHR = 512;

constexpr size_t MiB = 1u << 20;
constexpr size_t WS_CTL = 0, CTL_ZERO_BYTES = 1 * MiB;
constexpr size_t WS_MOD = 1 * MiB;
constexpr size_t WS_ROPE = 2 * MiB;
constexpr size_t WS_MISC = 3 * MiB;
constexpr size_t WS_W_IN = 4 * MiB, WS_W_OUT = 11 * MiB, WS_W_13 = 13 * MiB, WS_W_2 = 24 * MiB, WS_W_RKV = 30 * MiB, WS_W_L1 = 36 * MiB,
                 WS_W_L2 = 38 * MiB, WS_W_G2 = 40 * MiB, WS_W_O = 41 * MiB, WS_W_M13 = 43 * MiB, WS_W_M2 = 155 * MiB;
constexpr size_t WS_XC = 211 * MiB, WS_H = 219 * MiB, WS_MIX = 255 * MiB, WS_R = 291 * MiB;
constexpr size_t WS_QKV = WS_R, WS_KV = WS_R + 126 * MiB, WS_SPREV = WS_R + 198 * MiB, WS_FFH = WS_R;
constexpr size_t WS_NQ = WS_R + 240 * MiB, WS_NK = WS_R + 260 * MiB, WS_NV = WS_R + 280 * MiB;
constexpr size_t WS_XM = WS_R, WS_DEC = WS_R, WS_AG = WS_R + 144 * MiB, WS_RB = WS_R + 216 * MiB, WS_KB = WS_R + 248 * MiB, WS_VB = WS_R + 284 * MiB,
                 WS_L1 = WS_R + 320 * MiB, WS_LG = WS_R + 329 * MiB, WS_G = WS_R + 337 * MiB, WS_YF = WS_R + 369 * MiB, WS_YB = WS_R + 433 * MiB;
constexpr size_t WS_COEF = WS_R + 401 * MiB;
constexpr size_t WS_XG = WS_R, WS_HG = WS_R + 68 * MiB, WS_YS = WS_R + 306 * MiB, WS_ROWS = WS_R + 370 * MiB;
constexpr size_t WS_XLB = WS_R + 497 * MiB;
constexpr size_t WS_END = WS_XLB + 32 * MiB;
static_assert(WS_END <= 896 * MiB, "workspace map");
constexpr int CW_BAR = 4096, CW_FLOW = 65536;
constexpr size_t MISC_TOPE = 0, MISC_TOPW = 65536, MISC_CNTS = 196608, MISC_EXP = 204800, MISC_TAIL = 212992  , MISC_SROW = 327680  ;

constexpr int LDS_MAIN = 159744;
constexpr int LDS_MISC_OFF = LDS_MAIN;
constexpr int LDS_BYTES = LDS_MAIN + 256;

typedef unsigned short bf16;
typedef short bf16x8 __attribute__((ext_vector_type(8)));
typedef short s16x4 __attribute__((ext_vector_type(4)));
typedef float f32x4 __attribute__((ext_vector_type(4)));
typedef float f32x2 __attribute__((ext_vector_type(2)));
typedef unsigned u32x4 __attribute__((ext_vector_type(4)));
typedef unsigned u32x2 __attribute__((ext_vector_type(2)));
#define LDS_WAIT() asm volatile("s_waitcnt lgkmcnt(0)" ::: "memory")
#define VM_WAIT() asm volatile("s_waitcnt vmcnt(0)" ::: "memory")
#define WG_SYNC() __syncthreads()
#define LDS_BARRIER() do { asm volatile("s_waitcnt lgkmcnt(0)" ::: "memory"); __builtin_amdgcn_s_barrier(); asm volatile("" ::: "memory"); } while (0)
DI unsigned f2bf(float f) { unsigned u = __builtin_bit_cast(unsigned, f); return (u + 0x7fffu + ((u >> 16) & 1u)) >> 16; }
typedef __bf16 bf16x2_t __attribute__((ext_vector_type(2)));
DI unsigned pk2(float lo, float hi) { const f32x2 v = {lo, hi}; const bf16x2_t b = __builtin_convertvector(v, bf16x2_t); return __builtin_bit_cast(unsigned, b); }
DI float bflo(unsigned w) { return __builtin_bit_cast(float, w << 16); }
DI float bfhi(unsigned w) { return __builtin_bit_cast(float, w & 0xffff0000u); }
DI float bf1(bf16 b) { return __builtin_bit_cast(float, (unsigned)b << 16); }
DI float wave_sum(float v) {
#pragma unroll
    for (int o = 1; o < 64; o <<= 1) v += __shfl_xor(v, o);
    return v;
}
DI float dpp_rm(float v) { return __builtin_bit_cast(float, __builtin_amdgcn_update_dpp(0, __builtin_bit_cast(int, v), 0x140, 0xf, 0xf, true)); }
DI float wave_sum_fast(float v) {
    v += __builtin_bit_cast(float, __builtin_amdgcn_update_dpp(0, __builtin_bit_cast(int, v), 0xB1, 0xf, 0xf, true));
    v += __builtin_bit_cast(float, __builtin_amdgcn_update_dpp(0, __builtin_bit_cast(int, v), 0x4E, 0xf, 0xf, true));
    v += __builtin_bit_cast(float, __builtin_amdgcn_update_dpp(0, __builtin_bit_cast(int, v), 0x141, 0xf, 0xf, true));
    v += dpp_rm(v);
    const int iv = __builtin_bit_cast(int, v);
    const float a = __builtin_bit_cast(float, __builtin_amdgcn_readlane(iv, 0)), b = __builtin_bit_cast(float, __builtin_amdgcn_readlane(iv, 16));
    const float c = __builtin_bit_cast(float, __builtin_amdgcn_readlane(iv, 32)), d = __builtin_bit_cast(float, __builtin_amdgcn_readlane(iv, 48));
    return (a + b) + (c + d);
}
DI float wave_max(float v) {
#pragma unroll
    for (int o = 1; o < 64; o <<= 1) v = fmaxf(v, __shfl_xor(v, o));
    return v;
}
DI float dpp_x1(float v) { return __builtin_bit_cast(float, __builtin_amdgcn_update_dpp(0, __builtin_bit_cast(int, v), 0xB1, 0xf, 0xf, true)); }
DI float dpp_x2(float v) { return __builtin_bit_cast(float, __builtin_amdgcn_update_dpp(0, __builtin_bit_cast(int, v), 0x4E, 0xf, 0xf, true)); }
DI float dpp_hm(float v) { return __builtin_bit_cast(float, __builtin_amdgcn_update_dpp(0, __builtin_bit_cast(int, v), 0x141, 0xf, 0xf, true)); }
DI float red4(float v) { v += dpp_x1(v); v += dpp_x2(v); return v; }
DI float red8(float v) { v += dpp_x1(v); v += dpp_x2(v); v += dpp_hm(v); return v; }
DI float sigmoidf_(float x) { return __builtin_amdgcn_rcpf(1.f + __expf(-x)); }
DI float siluf_(float x) { return x * __builtin_amdgcn_rcpf(1.f + __expf(-x)); }

DI bf16x8 frag_kc(const LAS bf16* base, int ld, int row0, int k0, int lane) {
    return *(const LAS bf16x8*)(base + (row0 + (lane & 15)) * ld + k0 + 8 * (lane >> 4));
}
DI bf16x8 frag_kr(const LAS bf16* base, int ld, int x0, int k0, int lane) {
    const int g = lane >> 4, q = (lane & 15) >> 2, p = lane & 3;
    const LAS bf16* a = base + (k0 + 8 * g + q) * ld + x0 + 4 * p;
    const s16x4 lo = __builtin_amdgcn_ds_read_tr16_b64_v4i16((LAS s16x4*)a);
    const s16x4 hi = __builtin_amdgcn_ds_read_tr16_b64_v4i16((LAS s16x4*)(a + 4 * ld));
    return __builtin_shufflevector(lo, hi, 0, 1, 2, 3, 4, 5, 6, 7);
}
DI f32x4 mma(f32x4 acc, bf16x8 bfrag, bf16x8 afrag) { return __builtin_amdgcn_mfma_f32_16x16x32_bf16(bfrag, afrag, acc, 0, 0, 0); }

#define XB_TMO      128
#define XB_XCNT(j)  (256  + 64 * (j))
#define XB_XSUB(j)  (1280 + 64 * (j))
#define XB_XGEN(j)  (2304 + 64 * (j))
#define XB_TOP      3328
#define XB_TOPGEN   3392
#define XCD_BAR_WORDS 3456
#define XB_SPIN_CAP (1u << 18)
DI unsigned xb_ld(unsigned* p)              { return __hip_atomic_load(p, __ATOMIC_RELAXED, __HIP_MEMORY_SCOPE_AGENT); }
DI unsigned xb_add(unsigned* p, unsigned v) { return __hip_atomic_fetch_add(p, v, __ATOMIC_RELAXED, __HIP_MEMORY_SCOPE_AGENT); }
DI unsigned xb_xcc_id() { return (unsigned)__builtin_amdgcn_s_getreg((3 << 11) | 20) & 0xFu; }
#define XB_SPIN(cond, bar) do { unsigned _sp = 0; while (cond) { __builtin_amdgcn_s_sleep(1); \
    if ((++_sp & 255u) == 0u) { if (xb_ld(&(bar)[XB_TMO])) break; if (_sp > XB_SPIN_CAP) { atomicAdd(&(bar)[XB_TMO], 1u); break; } } } } while (0)
struct XcdBarrier { unsigned* bar; unsigned x; volatile LAS unsigned* st; };
DI XcdBarrier xcd_barrier_post(unsigned* bar, volatile LAS unsigned* st) {
    XcdBarrier b; b.bar = bar; b.x = xb_xcc_id(); b.st = st;
    if (threadIdx.x == 0) (void)xb_add(&bar[XB_XCNT(b.x)], 1u);
    return b;
}
DI void xcd_barrier_complete(unsigned* bar, unsigned x, unsigned& nloc, unsigned& nx) {
    const unsigned G = gridDim.x * gridDim.y * gridDim.z;
    unsigned sum, cnt, mine, sp = 0u;
    for (;;) {
        sum = 0u; cnt = 0u; mine = 0u;
#pragma unroll
        for (unsigned j = 0; j < 16; ++j) { const unsigned c = xb_ld(&bar[XB_XCNT(j)]); sum += c; cnt += (c > 0u) ? 1u : 0u; mine = (j == x) ? c : mine; }
        if (sum == G) break;
        __builtin_amdgcn_s_sleep(1);
        if ((++sp & 255u) == 0u) { if (xb_ld(&bar[XB_TMO])) break; if (sp > XB_SPIN_CAP) { atomicAdd(&bar[XB_TMO], 1u); break; } }
    }
    nloc = mine > 0u ? mine : 1u; nx = cnt > 0u ? cnt : 1u;
}
DI void xcd_barrier(const XcdBarrier& b) {
    asm volatile("s_waitcnt vmcnt(0)" ::: "memory");
    __syncthreads();
    if (threadIdx.x == 0) {
        unsigned* bar = b.bar;
        __builtin_amdgcn_s_waitcnt(0);
        unsigned nloc = b.st[0], nx = b.st[1];
        if (nloc == 0u) { xcd_barrier_complete(bar, b.x, nloc, nx); b.st[0] = nloc; b.st[1] = nx; }
        const unsigned old = xb_add(&bar[XB_XSUB(b.x)], 1u);
        const unsigned gen = old / nloc;
        if (old + 1u == (gen + 1u) * nloc) {
            __builtin_amdgcn_fence(__ATOMIC_RELEASE, "agent");
            asm volatile("s_waitcnt vmcnt(0)" ::: "memory");
            const unsigned og = xb_add(&bar[XB_TOP], 1u);
            const unsigned tg = og / nx;
            if (og + 1u == (tg + 1u) * nx) xb_add(&bar[XB_TOPGEN], 1u);
            else XB_SPIN(xb_ld(&bar[XB_TOPGEN]) == tg, bar);
            __builtin_amdgcn_fence(__ATOMIC_ACQUIRE, "agent");
            xb_add(&bar[XB_XGEN(b.x)], 1u);
            asm volatile("s_waitcnt vmcnt(0)" ::: "memory");
        } else {
            XB_SPIN(xb_ld(&bar[XB_XGEN(b.x)]) == gen, bar);
            __builtin_amdgcn_fence(__ATOMIC_ACQUIRE, "agent");
            asm volatile("s_waitcnt vmcnt(0)" ::: "memory");
        }
    }
    __syncthreads();
}

struct Fr {
    LAS unsigned char* lds;
    unsigned char* ws;
    const float* const* in;
    float* out;
    int tid, lane, wave, bx, G, gw, NGW;
};

using pg8::Unit;
template <int ACT  , bool HALF = false  > struct EpiStore {
    static constexpr bool PERM = true;
    bf16* O; int ldc; int nvalid;
    DI void operator()(const f32x4 (&acc)[2][2][4][2], const Unit& u, int wr, int wc, int fr, int fq) const {
        const int row0 = u.pm * 256 + wr * 64 + fr, col0 = u.pn * 256 + wc * 32 + 8 * fq;
#pragma unroll
        for (int ai = 0; ai < 2; ++ai)
#pragma unroll
            for (int m = 0; m < 4; ++m) { bf16* rowp = O + (size_t)(row0 + ai * 128 + m * 16) * ldc + col0;
#pragma unroll
                for (int bj = 0; bj < (HALF ? 1 : 2); ++bj) {
                    f32x4 v0 = acc[ai][bj][m][0], v1 = acc[ai][bj][m][1];
                    if (ACT == 1) {
#pragma unroll
                        for (int j = 0; j < 4; ++j) { v0[j] = 1.f - 2.f * __builtin_amdgcn_rcpf(1.f + __expf(2.f * v0[j])); v1[j] = 1.f - 2.f * __builtin_amdgcn_rcpf(1.f + __expf(2.f * v1[j])); } }
                    if (ACT == 2) {
#pragma unroll
                        for (int j = 0; j < 4; ++j) { v0[j] = sigmoidf_(v0[j]); v1[j] = sigmoidf_(v1[j]); } }
                    u32x4 w; w.x = pg8::cvt_pk_bf16(v0[0], v0[1]); w.y = pg8::cvt_pk_bf16(v0[2], v0[3]); w.z = pg8::cvt_pk_bf16(v1[0], v1[1]); w.w = pg8::cvt_pk_bf16(v1[2], v1[3]);
                    *(u32x4*)(rowp + bj * 128) = w; } }
    }
};
struct EpiStoreHead {
    static constexpr bool PERM = true;
    bf16* O; int TL; int lat_off;
    DI void operator()(const f32x4 (&acc)[2][2][4][2], const Unit& u, int wr, int wc, int fr, int fq) const {
        const bool lat = u.pm < 64; const int b = lat ? (u.pm >> 3) : (u.pm - 64); const int sbase = lat ? lat_off + (u.pm & 7) * 256 : 0;
        const int rt0 = sbase + wr * 64 + fr, j = (wc & 1) * 32 + 8 * fq;
#pragma unroll
        for (int ai = 0; ai < 2; ++ai)
#pragma unroll
            for (int m = 0; m < 4; ++m)
#pragma unroll
                for (int bj = 0; bj < 2; ++bj) { const int h = 4 * u.pn + 2 * bj + (wc >> 1);
                    const f32x4 v0 = acc[ai][bj][m][0], v1 = acc[ai][bj][m][1];
                    u32x4 w; w.x = pg8::cvt_pk_bf16(v0[0], v0[1]); w.y = pg8::cvt_pk_bf16(v0[2], v0[3]); w.z = pg8::cvt_pk_bf16(v1[0], v1[1]); w.w = pg8::cvt_pk_bf16(v1[2], v1[3]);
                    *(u32x4*)(O + ((size_t)(b * 16 + h) * TL + rt0 + ai * 128 + m * 16) * 64 + j) = w; }
    }
};
DI f32x4 ldx4(const float* rowp, int c4) { return ((const f32x4*)rowp)[c4]; }
DI f32x4 ldx4(const bf16* rowp, int c4) { const u32x2 t = ((const u32x2*)rowp)[c4]; return (f32x4){bflo(t.x), bfhi(t.x), bflo(t.y), bfhi(t.y)}; }
DI void ldx8(const float* p, f32x4& a, f32x4& b) { a = *(const f32x4*)p; b = *(const f32x4*)(p + 4); }
DI void ldx8(const bf16* p, f32x4& a, f32x4& b) { const u32x4 t = *(const u32x4*)p; a = (f32x4){bflo(t.x), bfhi(t.x), bflo(t.y), bfhi(t.y)}; b = (f32x4){bflo(t.z), bfhi(t.z), bflo(t.w), bfhi(t.w)}; }
template <class TI> struct EpiResidB {
    static constexpr bool PERM = true;
    const TI* baseL; bf16* outL; const TI* baseC; bf16* outC; const float* modg;
    DI void operator()(const f32x4 (&acc)[2][2][4][2], const Unit& u, int wr, int wc, int fr, int fq) const {
        const bool lat = u.pm < 64; const int r = lat ? (u.pm >> 3) : 8;
        const TI* base = lat ? baseL : baseC; bf16* out = lat ? outL : outC;
        const int row0 = (lat ? u.pm : u.pm - 64) * 256 + wr * 64 + fr, col0 = u.pn * 256 + wc * 32 + 8 * fq;
        const float* mg = modg + (size_t)r * 6144 + col0;
        f32x4 mv[2][2];
#pragma unroll
        for (int bj = 0; bj < 2; ++bj)
#pragma unroll
            for (int n = 0; n < 2; ++n) mv[bj][n] = *(const f32x4*)(mg + bj * 128 + 4 * n);
#pragma unroll
        for (int ai = 0; ai < 2; ++ai)
#pragma unroll
            for (int m = 0; m < 4; ++m) { const size_t off = (size_t)(row0 + ai * 128 + m * 16) * D + col0;
#pragma unroll
                for (int bj = 0; bj < 2; ++bj) { f32x4 b0, b1; ldx8(base + off + bj * 128, b0, b1);
                    const f32x4 v0 = b0 + mv[bj][0] * acc[ai][bj][m][0], v1 = b1 + mv[bj][1] * acc[ai][bj][m][1];
                    u32x4 w; w.x = pg8::cvt_pk_bf16(v0[0], v0[1]); w.y = pg8::cvt_pk_bf16(v0[2], v0[3]); w.z = pg8::cvt_pk_bf16(v1[0], v1[1]); w.w = pg8::cvt_pk_bf16(v1[2], v1[3]);
                    *(u32x4*)(out + off + bj * 128) = w; } }
    }
};
struct EpiResid {
    static constexpr bool PERM = false;
    const float* baseL; float* outL; const float* baseC; float* outC; const float* modg;
    DI void operator()(const f32x4 (&acc)[2][2][4][2], const Unit& u, int wr, int wc, int fr, int fq) const {
        const bool lat = u.pm < 64; const int r = lat ? (u.pm >> 3) : 8;
        const float* base = lat ? baseL : baseC; float* out = lat ? outL : outC;
        const int row0 = (lat ? u.pm : u.pm - 64) * 256 + wr * 64 + fr, col0 = u.pn * 256 + wc * 32 + 4 * fq;
        const float* mg = modg + (size_t)r * 6144 + col0;
        f32x4 mv[2][2];
#pragma unroll
        for (int bj = 0; bj < 2; ++bj)
#pragma unroll
            for (int n = 0; n < 2; ++n) mv[bj][n] = *(const f32x4*)(mg + bj * 128 + n * 16);
#pragma unroll
        for (int ai = 0; ai < 2; ++ai)
#pragma unroll
            for (int m = 0; m < 4; ++m) { const size_t off = (size_t)(row0 + ai * 128 + m * 16) * D + col0;
#pragma unroll
                for (int bj = 0; bj < 2; ++bj)
#pragma unroll
                    for (int n = 0; n < 2; ++n) { const f32x4 bs = *(const f32x4*)(base + off + bj * 128 + n * 16);
                        *(f32x4*)(out + off + bj * 128 + n * 16) = bs + mv[bj][n] * acc[ai][bj][m][n]; } }
    }
};
template <bool WT> struct EpiSwigluT {
    static constexpr bool PERM = true;
    bf16* Hd; int ldh;
    DI void operator()(const f32x4 (&acc)[2][2][4][2], const Unit& u, int wr, int wc, int fr, int fq) const {
        const int row0 = u.pm * 256 + wr * 64 + fr, col0 = u.pn * 128 + wc * 32 + 8 * fq;
        f32x4 kml2 = (f32x4){-1.4426950408889634f, -1.4426950408889634f, -1.4426950408889634f, -1.4426950408889634f}, kone = (f32x4){1.f, 1.f, 1.f, 1.f};
        asm volatile("" : "+v"(kml2), "+v"(kone));
#pragma unroll
        for (int ai = 0; ai < 2; ++ai)
#pragma unroll
            for (int m = 0; m < 4; ++m) { bf16* rowp = Hd + (size_t)(row0 + ai * 128 + m * 16) * ldh + col0;
                f32x4 v0, v1;
#pragma unroll
                for (int n = 0; n < 2; ++n) { const f32x4 g = acc[ai][0][m][n], up = acc[ai][1][m][n];
                    const f32x4 t = g * kml2; f32x4 e;
#pragma unroll
                    for (int j = 0; j < 4; ++j) e[j] = __builtin_amdgcn_exp2f(t[j]);
                    const f32x4 d = e + kone; f32x4 r;
#pragma unroll
                    for (int j = 0; j < 4; ++j) r[j] = __builtin_amdgcn_rcpf(d[j]);
                    const f32x4 y = (g * r) * up; if (n == 0) v0 = y; else v1 = y; }
                u32x4 w; w.x = pg8::cvt_pk_bf16(v0[0], v0[1]); w.y = pg8::cvt_pk_bf16(v0[2], v0[3]); w.z = pg8::cvt_pk_bf16(v1[0], v1[1]); w.w = pg8::cvt_pk_bf16(v1[2], v1[3]);
                if (WT) __builtin_amdgcn_raw_buffer_store_b128(w, __builtin_amdgcn_make_buffer_rsrc(Hd, 0, 0x7fffffff, 0x00020000), (unsigned)((const char*)rowp - (const char*)Hd), 0, 16);
                else *(u32x4*)rowp = w; }
    }
};
typedef EpiSwigluT<false> EpiSwiglu;
struct EpiLora2 {
    static constexpr bool PERM = true;
    bf16* DEC; bf16* AG; const float* w0; const float* a0;
    DI void operator()(const f32x4 (&acc)[2][2][4][2], const Unit& u, int wr, int wc, int fr, int fq) const {
        const int q = u.pn >> 2, z = q & 1; const int col0 = (u.pn & 3) * 256 + wc * 32 + 8 * fq;
        const bool lat = u.pm < 64; const int b = lat ? (u.pm >> 3) : (u.pm - 64); const int rt0 = (lat ? CTXL + (u.pm & 7) * 256 : 0) + wr * 64 + fr, j = (wc & 1) * 32 + 8 * fq;
        const float* bias = (q < 2 ? w0 : a0) + z * 1024 + col0;
        f32x4 bv[2][2];
#pragma unroll
        for (int bj = 0; bj < 2; ++bj)
#pragma unroll
            for (int n = 0; n < 2; ++n) bv[bj][n] = *(const f32x4*)(bias + bj * 128 + 4 * n);
#pragma unroll
        for (int ai = 0; ai < 2; ++ai)
#pragma unroll
            for (int m = 0; m < 4; ++m) {
#pragma unroll
                for (int bj = 0; bj < 2; ++bj) { f32x4 v0 = acc[ai][bj][m][0] + bv[bj][0], v1 = acc[ai][bj][m][1] + bv[bj][1];
                    const int h = 4 * (u.pn & 3) + 2 * bj + (wc >> 1);
                    const size_t off = ((size_t)(z * 128 + b * 16 + h) * (SEQ + CTXL) + rt0 + ai * 128 + m * 16) * 64 + j;
                    if (q < 2) {
#pragma unroll
                        for (int jj = 0; jj < 4; ++jj) {
                            v0[jj] = -0.6065306597126334f * sigmoidf_(v0[jj]); v1[jj] = -0.6065306597126334f * sigmoidf_(v1[jj]); }
                        u32x4 w; w.x = pg8::cvt_pk_bf16(v0[0], v0[1]); w.y = pg8::cvt_pk_bf16(v0[2], v0[3]); w.z = pg8::cvt_pk_bf16(v1[0], v1[1]); w.w = pg8::cvt_pk_bf16(v1[2], v1[3]);
                        *(u32x4*)(DEC + off) = w; __builtin_amdgcn_sched_barrier(0);
                    } else {
#pragma unroll
                        for (int jj = 0; jj < 4; ++jj) { v0[jj] = sigmoidf_(v0[jj]); v1[jj] = sigmoidf_(v1[jj]); }
                        u32x4 w; w.x = pg8::cvt_pk_bf16(v0[0], v0[1]); w.y = pg8::cvt_pk_bf16(v0[2], v0[3]); w.z = pg8::cvt_pk_bf16(v1[0], v1[1]); w.w = pg8::cvt_pk_bf16(v1[2], v1[3]);
                        *(u32x4*)(AG + off) = w; __builtin_amdgcn_sched_barrier(0); } } }
    }
};
struct EpiMoePart {
    static constexpr bool PERM = true;
    float* PART;
    DI void operator()(const f32x4 (&acc)[2][2][4][2], const Unit& u, int wr, int wc, int fr, int fq) const {
        const int row0 = (u.pm - 128) * 256 + wr * 64 + fr, col0 = u.pn * 256 + wc * 32 + 8 * fq;
#pragma unroll
        for (int ai = 0; ai < 2; ++ai)
#pragma unroll
            for (int m = 0; m < 4; ++m) { float* rowp = PART + ((size_t)u.aux * 2048 + row0 + ai * 128 + m * 16) * D + col0;
#pragma unroll
                for (int bj = 0; bj < 2; ++bj) { *(f32x4*)(rowp + bj * 128) = acc[ai][bj][m][0]; *(f32x4*)(rowp + bj * 128 + 4) = acc[ai][bj][m][1]; } }
    }
};
struct EpiMoeOut {
    static constexpr bool PERM = true;
    bf16* YS; const int* RowTok; const float* RowW;
    DI void operator()(const f32x4 (&acc)[2][2][4][2], const Unit& u, int wr, int wc, int fr, int fq) const {
        const int row0 = u.pm * 256 + wr * 64 + fr, col0 = u.pn * 256 + wc * 32 + 8 * fq;
        int t2v[2][4]; float wv[2][4];
#pragma unroll
        for (int ai = 0; ai < 2; ++ai)
#pragma unroll
            for (int m = 0; m < 4; ++m) { const int row = row0 + ai * 128 + m * 16; t2v[ai][m] = RowTok[row]; wv[ai][m] = RowW[row]; }
#pragma unroll
        for (int ai = 0; ai < 2; ++ai)
#pragma unroll
            for (int m = 0; m < 4; ++m) { const int t2 = t2v[ai][m]; if (t2 < 0) continue; const float w = wv[ai][m];
                bf16* rowp = YS + (size_t)t2 * D + col0;
#pragma unroll
                for (int bj = 0; bj < 2; ++bj) { const f32x4 v0 = acc[ai][bj][m][0] * w, v1 = acc[ai][bj][m][1] * w;
                    u32x4 o; o.x = pg8::cvt_pk_bf16(v0[0], v0[1]); o.y = pg8::cvt_pk_bf16(v0[2], v0[3]); o.z = pg8::cvt_pk_bf16(v1[0], v1[1]); o.w = pg8::cvt_pk_bf16(v1[2], v1[3]);
                    *(u32x4*)(rowp + bj * 128) = o; } }
    }
};

DI void tr_item(const float* src, int ldsrc, int Kreal, int k0, int n0, bf16* dst, int lddst, int drow0, int dcol0, LAS float* scr, int lane) {
#pragma unroll 8
    for (int i = 0; i < 32; ++i) { const int kk = 2 * i + (lane >> 5), k = k0 + kk; float v = 0.f; if (k < Kreal) v = src[(size_t)k * ldsrc + n0 + (lane & 31)]; scr[kk * 33 + (lane & 31)] = v; }
    LDS_WAIT();
    const int c = lane & 7;
#pragma unroll
    for (int j = 0; j < 4; ++j) { const int n = (lane >> 3) + 8 * j; const LAS float* s = scr + (8 * c) * 33 + n;
        u32x4 o; o.x = pk2(s[0 * 33], s[1 * 33]); o.y = pk2(s[2 * 33], s[3 * 33]); o.z = pk2(s[4 * 33], s[5 * 33]); o.w = pk2(s[6 * 33], s[7 * 33]);
        *(u32x4*)(dst + (size_t)(drow0 + n) * lddst + dcol0 + k0 + 8 * c) = o; }
    LDS_WAIT();
}
DI void tr_plain(const float* src, int K, int N, bf16* dst, int r, LAS float* scr, int lane) {
    const int nblk = N / 32, kb = r / nblk, nb = r % nblk; tr_item(src, N, K, 64 * kb, 32 * nb, dst, K, 32 * nb, 0, scr, lane);
}
DI void tr_gateup(const float* src, int K, int Hh, bf16* dst, int r, LAS float* scr, int lane) {
    const int nblk = 2 * Hh / 32, kb = r / nblk, nb = r % nblk, n0 = 32 * nb, half = n0 / Hh, j0 = n0 % Hh;
    tr_item(src, 2 * Hh, K, 64 * kb, n0, dst, K, (j0 / 128) * 256 + half * 128 + (j0 % 128), 0, scr, lane);
}
DI void tr16_item(const float* src, int ldsrc, int k0, int n0, bf16* dst, int lddst, int Hh, int lane) {
    f32x4 v[16];
#pragma unroll
    for (int kk = 0; kk < 16; ++kk) v[kk] = *(const f32x4*)(src + (size_t)(k0 + kk) * ldsrc + n0 + 4 * lane);
    const int n = n0 + 4 * lane; int drow = n;
    if (Hh) { const int half = n / Hh, j = n % Hh; drow = (j / 128) * 256 + half * 128 + (j % 128); }
#pragma unroll
    for (int q = 0; q < 4; ++q) { u32x4 o0, o1;
        o0.x = pk2(v[0][q], v[1][q]); o0.y = pk2(v[2][q], v[3][q]); o0.z = pk2(v[4][q], v[5][q]); o0.w = pk2(v[6][q], v[7][q]);
        o1.x = pk2(v[8][q], v[9][q]); o1.y = pk2(v[10][q], v[11][q]); o1.z = pk2(v[12][q], v[13][q]); o1.w = pk2(v[14][q], v[15][q]);
        bf16* d = dst + (size_t)(drow + q) * lddst + k0; *(u32x4*)d = o0; *(u32x4*)(d + 8) = o1; }
}
DI void tr64_item(const float* src, int ldsrc, int k0, int n0, bf16* dst, int lddst, int Hh, int lane) {
    float v[64];
    const float* sp = src + (size_t)k0 * ldsrc + n0 + lane;
#pragma unroll
    for (int kk = 0; kk < 64; ++kk) v[kk] = sp[(size_t)kk * ldsrc];
    const int n = n0 + lane; int drow = n;
    if (Hh) { const int half = n / Hh, j = n % Hh; drow = (j / 128) * 256 + half * 128 + (j % 128); }
    bf16* d = dst + (size_t)drow * lddst + k0;
#pragma unroll
    for (int c = 0; c < 8; ++c) { u32x4 o; o.x = pk2(v[8 * c], v[8 * c + 1]); o.y = pk2(v[8 * c + 2], v[8 * c + 3]); o.z = pk2(v[8 * c + 4], v[8 * c + 5]); o.w = pk2(v[8 * c + 6], v[8 * c + 7]);
        *(u32x4*)(d + 8 * c) = o; }
}
DI void tr16_mat(const float* src, int K, int N, bf16* dst, int Hh, int r, int lane) { const int nb = N / 64; tr64_item(src, N, 64 * (r / nb), 64 * (r % nb), dst, K, Hh, lane); }
struct TrItem { const float* src; bf16* dst; int ldsrc, lddst, k0, n0, Hh; };
DI void tr_wg_load(const TrItem& t, f32x4 (&v)[8], int wave, int lane) {
    const float* sp = t.src + (size_t)(t.k0 + 8 * wave) * t.ldsrc + t.n0 + 4 * lane;
#pragma unroll
    for (int kk = 0; kk < 8; ++kk) v[kk] = *(const f32x4*)(sp + (size_t)kk * t.ldsrc);
}
DI void tr_wg_to_lds(const f32x4 (&v)[8], LAS bf16* img, int wave, int lane) {
#pragma unroll
    for (int q = 0; q < 4; ++q) { u32x4 o; o.x = pk2(v[0][q], v[1][q]); o.y = pk2(v[2][q], v[3][q]); o.z = pk2(v[4][q], v[5][q]); o.w = pk2(v[6][q], v[7][q]);
        *(LAS u32x4*)(img + (4 * lane + q) * 72 + 8 * wave) = o; }
}
DI void tr_wg_store(const TrItem& t, const LAS bf16* img, int wave, int lane) {
    const int row = 32 * wave + (lane >> 1), half = lane & 1, n = t.n0 + row; int drow = n;
    if (t.Hh) { const int hf = n / t.Hh, j = n % t.Hh; drow = (j / 128) * 256 + hf * 128 + (j % 128); }
    bf16* d = t.dst + (size_t)drow * t.lddst + t.k0 + 32 * half;
#pragma unroll
    for (int i = 0; i < 4; ++i) *(u32x4*)(d + 8 * i) = *(const LAS u32x4*)(img + row * 72 + 32 * half + 8 * i);
}
constexpr int WG_M13 = 16 * 28, WG_M2 = 56 * 4, WG_MOE = 8 * WG_M13 + 8 * WG_M2;
constexpr int WG_IN = 16 * 14, WG_OUT = 16 * 4, WG_13 = 16 * 22, WG_2 = 44 * 4, WG_RKV = 64, WG_O = 64, WG_DENSE = WG_IN + WG_OUT + WG_13 + WG_2 + 3 * WG_RKV + WG_O;
DI TrItem tr_mat_item(const float* src, int K, int N, bf16* dst, int Hh, int r) { const int nb = N / 256; return TrItem{src, dst, N, K, 64 * (r / nb), 256 * (r % nb), Hh}; }
DI TrItem moe_item(Fr& F, int r) {
    bf16* W_M13 = (bf16*)(F.ws + WS_W_M13); bf16* W_M2 = (bf16*)(F.ws + WS_W_M2);
    if (r < 8 * WG_M13) { const int e = r / WG_M13; return tr_mat_item(F.in[35] + (size_t)e * 1024 * 7168, 1024, 7168, W_M13 + (size_t)e * 7168 * 1024, EXP_H, r % WG_M13); }
    const int r2 = r - 8 * WG_M13, e = r2 / WG_M2; return tr_mat_item(F.in[36] + (size_t)e * EXP_H * 1024, EXP_H, 1024, W_M2 + (size_t)e * 1024 * EXP_H, 0, r2 % WG_M2);
}
DI TrItem dense_item(Fr& F, int r) {
    const float* const* in = F.in;
    if (r < WG_IN) return tr_mat_item(in[8], 1024, INW, (bf16*)(F.ws + WS_W_IN), 0, r); r -= WG_IN;
    if (r < WG_OUT) return tr_mat_item(in[15], 1024, 1024, (bf16*)(F.ws + WS_W_OUT), 0, r); r -= WG_OUT;
    if (r < WG_13) return tr_mat_item(in[16], 1024, 2 * FFN_H, (bf16*)(F.ws + WS_W_13), FFN_H, r); r -= WG_13;
    if (r < WG_2) return tr_mat_item(in[17], FFN_H, 1024, (bf16*)(F.ws + WS_W_2), 0, r); r -= WG_2;
    if (r < 3 * WG_RKV) { const int sx = r / WG_RKV; return tr_mat_item(in[19] + (size_t)sx * 1024 * 1024, 1024, 1024, (bf16*)(F.ws + WS_W_RKV) + (size_t)sx * 1024 * 1024, 0, r % WG_RKV); } r -= 3 * WG_RKV;
    return tr_mat_item(in[33], 1024, 1024, (bf16*)(F.ws + WS_W_O), 0, r);
}
template <int L> DI void tr_wg_run(Fr& F, int first, int stride, int end) {
    if (first >= end) return;
    LAS bf16* img0 = (LAS bf16*)F.lds; LAS bf16* img1 = img0 + 256 * 72;
    f32x4 va[8], vb[8];
    TrItem ta = L ? moe_item(F, first) : dense_item(F, first), tb = ta;
    tr_wg_load(ta, va, F.wave, F.lane);
    if (first + stride < end) { tb = L ? moe_item(F, first + stride) : dense_item(F, first + stride); tr_wg_load(tb, vb, F.wave, F.lane); }
    for (int r = first; r < end; r += 2 * stride) {
        tr_wg_to_lds(va, img0, F.wave, F.lane);
        TrItem na = ta; if (r + 2 * stride < end) { na = L ? moe_item(F, r + 2 * stride) : dense_item(F, r + 2 * stride); tr_wg_load(na, va, F.wave, F.lane); }
        LDS_BARRIER();
        tr_wg_store(ta, img0, F.wave, F.lane); ta = na;
        if (r + stride >= end) break;
        tr_wg_to_lds(vb, img1, F.wave, F.lane);
        TrItem nb = tb; if (r + 3 * stride < end) { nb = L ? moe_item(F, r + 3 * stride) : dense_item(F, r + 3 * stride); tr_wg_load(nb, vb, F.wave, F.lane); }
        LDS_BARRIER();
        tr_wg_store(tb, img1, F.wave, F.lane); tb = nb;
    }
    LDS_BARRIER();
}
constexpr int MOE_ITEMS = WG_MOE;
constexpr int CV_SCAN_ITEMS = 4608;
constexpr int P0_FILL = 32;
constexpr int P5_FILL = 256;
constexpr int FILL_A = 0, FILL_B = 0, FILL_C = 0;
DI void moe_fill(Fr& F, int slot, int nslots, int i0, int i1) {
    if (slot < 0 || slot >= nslots) return;
    tr_wg_run<1>(F, i0 + slot, nslots, i1);
}
DI void dense_fill(Fr& F, int slot, int nslots, int i0, int i1) {
    if (slot < 0 || slot >= nslots) return;
    tr_wg_run<0>(F, i0 + slot, nslots, i1);
}
constexpr int DENSE_P0 = WG_IN + WG_OUT, DENSE_P6 = DENSE_P0 + WG_13 + WG_2, DENSE_P9 = DENSE_P6 + 3 * WG_RKV;
DI void p0_small(Fr& F, int gw0, int ngw, int gt, int NT) {
    LAS float* scr = (LAS float*)(F.lds + F.wave * 16384);
    const float* const* in = F.in;
    bf16* W_L1 = (bf16*)(F.ws + WS_W_L1); bf16* W_L2 = (bf16*)(F.ws + WS_W_L2); bf16* W_G2 = (bf16*)(F.ws + WS_W_G2);
    constexpr int I_W1 = 2 * 32, I_A1 = 2 * 32, I_G1 = 16 * 5, I_L2 = 4 * 32, I_G2 = 4 * 32;
    constexpr int NITEMS = I_W1 + I_A1 + I_G1 + I_L2 + I_G2;
    for (int it = gw0; it < NITEMS; it += ngw) {
        int r = it;
        if (r < I_W1) { const int z = r / 32, rr = r % 32; tr_item(in[21] + (size_t)z * 1024 * 64, 64, 1024, 64 * (rr / 2), 32 * (rr % 2), W_L1, 1024, z * 64 + 32 * (rr % 2), 0, scr, F.lane); continue; } r -= I_W1;
        if (r < I_A1) { const int z = r / 32, rr = r % 32; tr_item(in[24] + (size_t)z * 1024 * 64, 64, 1024, 64 * (rr / 2), 32 * (rr % 2), W_L1 + 256 * 1024, 1024, z * 64 + 32 * (rr % 2), 0, scr, F.lane); continue; } r -= I_A1;
        if (r < I_G1) { tr_item(in[26], 160, 1024, 64 * (r / 5), 32 * (r % 5), W_L1 + 2 * 256 * 1024, 1024, 32 * (r % 5), 0, scr, F.lane); continue; } r -= I_G1;
        if (r < I_L2) { const int q = r / 32, nb = r % 32; const float* src = (q < 2 ? in[22] : in[25]) + (size_t)(q & 1) * 64 * 1024;
            for (int i = F.lane; i < 32 * 24; i += 64) { const int row = i / 24, ch = i % 24; const int col = 8 * ch + (8 * ch >= q * 64 ? 64 : 0);
                *(u32x4*)(W_L2 + (size_t)(q * 1024 + 32 * nb + row) * 256 + col) = (u32x4){0u, 0u, 0u, 0u}; }
            tr_item(src, 1024, 64, 0, 32 * nb, W_L2, 256, q * 1024 + 32 * nb, q * 64, scr, F.lane); continue; } r -= I_L2;
        tr_item(in[27], 1024, 160, 64 * (r / 32), 32 * (r % 32), W_G2, 256, 32 * (r % 32), 0, scr, F.lane);
    }
    for (int i = gt; i < (128 + 128 + 96) * 128; i += NT) { int row = i / 128; const int ch = i % 128; int mat = 0;
        if (row >= 256) { mat = 2; row = row - 256 + 160; } else if (row >= 128) { mat = 1; } else { row += 128; }
        *(u32x4*)(W_L1 + ((size_t)mat * 256 + row) * 1024 + 8 * ch) = (u32x4){0u, 0u, 0u, 0u}; }
}
DI void mod_gemv(Fr& F, int u0, int u1, int slot, int nslots) {
    const float* const* in = F.in;
    if (slot < 0 || slot >= nslots) return;
    for (int u = u0 + slot; u < u1; u += nslots) {
        const int li = u / 96, n0 = (u % 96) * 64;
        LAS float* sm = (LAS float*)F.lds;
        for (int idx = F.tid; idx < 9 * 1024; idx += NTHR) { const int r = idx >> 10, k = idx & 1023; const float cv = (r < 8) ? in[1][r * 1024 + k] : in[3][k]; sm[idx] = cv / (1.f + expf(-cv)); }
        WG_SYNC();
        const int ks = F.tid >> 4, cg4 = F.tid & 15;
        f32x4 acc[9];
#pragma unroll
        for (int r = 0; r < 9; ++r) acc[r] = (f32x4){0.f, 0.f, 0.f, 0.f};
        const float* w = in[4] + (size_t)li * 1024 * 6144 + n0 + 4 * cg4;
#pragma unroll 8
        for (int k = ks * 32; k < ks * 32 + 32; ++k) { const f32x4 wv = *(const f32x4*)(w + (size_t)k * 6144);
#pragma unroll
            for (int r = 0; r < 9; ++r) acc[r] += wv * sm[r * 1024 + k]; }
        LAS float* red = sm + 9 * 1024;
#pragma unroll
        for (int r = 0; r < 9; ++r) *(LAS f32x4*)(red + (ks * 9 + r) * 64 + 4 * cg4) = acc[r];
        WG_SYNC();
        float* MOD = (float*)(F.ws + WS_MOD);
        for (int idx = F.tid; idx < 9 * 64; idx += NTHR) { const int r = idx / 64, n2 = idx % 64; float s = 0.f;
#pragma unroll
            for (int q = 0; q < 32; ++q) s += red[(q * 9 + r) * 64 + n2];
            MOD[((size_t)li * 9 + r) * 6144 + n0 + n2] = s + in[5][li * 6144 + n0 + n2]; }
        WG_SYNC();
    }
}
DI void p0_prologue(Fr& F) {
    const int gt = F.bx * NTHR + F.tid, NT = F.G * NTHR;
    f32x2* rope = (f32x2*)(F.ws + WS_ROPE);
    for (int i = gt; i < 2048; i += NT) { const int pos = i >> 5, j = i & 31; const float fr = powf(10000.f, -(float)j / 32.f), ang = (float)pos * fr; rope[i] = (f32x2){cosf(ang), sinf(ang)}; }
    if (F.G == 256) {
        if (F.bx < 96) mod_gemv(F, 0, 96, F.bx, 96); else { tr_wg_run<0>(F, F.bx - 96, 160, DENSE_P0); moe_fill(F, F.bx - 96 - 128, 32, CV_SCAN_ITEMS + P5_FILL, CV_SCAN_ITEMS + P5_FILL + P0_FILL); }
        return; }
    tr_wg_run<0>(F, F.bx, F.G, WG_DENSE);
    tr_wg_run<1>(F, CV_SCAN_ITEMS + F.bx, F.G, WG_MOE);
    p0_small(F, F.gw, F.NGW, gt, NT);
    WG_SYNC();
    mod_gemv(F, 0, 192, F.bx, F.G);
}

template <class T> DI void mod_rows(Fr& F, const T* xl, const T* xc, int nrows, const float* normw, const float* modl, int off_shift, int off_scale, bf16* H) {
    for (int g = F.gw; g < nrows / 4; g += F.NGW) {
        const int row0 = 4 * g;
        const T* src = row0 < ML ? xl + (size_t)row0 * D : xc + (size_t)(row0 - ML) * D;
        const float* mrow = modl + (size_t)(row0 < ML ? row0 / SEQ : 8) * 6144;
        f32x4 v[4][4];
#pragma unroll
        for (int r = 0; r < 4; ++r)
#pragma unroll
            for (int j = 0; j < 4; ++j) v[r][j] = ldx4(src + (size_t)r * D, F.lane + 64 * j);
        f32x4 gsc[4], gsh[4];
#pragma unroll
        for (int j = 0; j < 4; ++j) { const int c4 = F.lane + 64 * j; gsc[j] = ((const f32x4*)normw)[c4] * (((const f32x4*)(mrow + off_scale))[c4] + 1.f); gsh[j] = ((const f32x4*)(mrow + off_shift))[c4]; }
#pragma unroll
        for (int r = 0; r < 4; ++r) { float ss = 0.f;
#pragma unroll
            for (int j = 0; j < 4; ++j) ss += (v[r][j].x * v[r][j].x + v[r][j].y * v[r][j].y) + (v[r][j].z * v[r][j].z + v[r][j].w * v[r][j].w);
            const float rstd = rsqrtf(wave_sum_fast(ss) * (1.f / D) + 1e-6f);
            u32x2* o = (u32x2*)(H + (size_t)(row0 + r) * D);
#pragma unroll
            for (int j = 0; j < 4; ++j) { const f32x4 y = v[r][j] * rstd * gsc[j] + gsh[j]; u32x2 p; p.x = pk2(y.x, y.y); p.y = pk2(y.z, y.w); o[F.lane + 64 * j] = p; } }
    }
}

DI void load_rope_pair(const bf16* rowp, int hh, int jj, bool lat, int rpos, int cpos, const f32x2* rope, float scl, float (&x1)[8], float (&x2)[8]) {
    const u32x4 a = *(const u32x4*)(rowp + hh * 64 + jj), b = *(const u32x4*)(rowp + hh * 64 + jj + 32);
    const unsigned aw[4] = {a.x, a.y, a.z, a.w}, bw[4] = {b.x, b.y, b.z, b.w};
#pragma unroll
    for (int i = 0; i < 4; ++i) { x1[2 * i] = bflo(aw[i]); x1[2 * i + 1] = bfhi(aw[i]); x2[2 * i] = bflo(bw[i]); x2[2 * i + 1] = bfhi(bw[i]); }
    if (lat) { const int pos = hh ? cpos : rpos;
#pragma unroll
        for (int i = 0; i < 8; ++i) { const f32x2 cs = rope[pos * 32 + jj + i]; const float y1 = x1[i] * cs.x - x2[i] * cs.y, y2 = x1[i] * cs.y + x2[i] * cs.x; x1[i] = y1; x2[i] = y2; } }
#pragma unroll
    for (int i = 0; i < 8; ++i) { x1[i] *= scl; x2[i] *= scl; }
}
DI u32x4 pack8(const float (&x)[8], float s) { u32x4 o; o.x = pk2(x[0] * s, x[1] * s); o.y = pk2(x[2] * s, x[3] * s); o.z = pk2(x[4] * s, x[5] * s); o.w = pk2(x[6] * s, x[7] * s); return o; }
constexpr int RLD = 136;
constexpr int RTILE = 128 * RLD * 2;
DI int ret_row0(int b, int id) { return id < 2 ? ML + b * CTXL + id * 128 : b * SEQ + (id - 2) * 128; }

DI void rope_apply(u32x4 a, u32x4 b, int hh, int jj, bool lat, int rpos, int cpos, const LAS f32x2* ropeL, float scl, float (&x1)[8], float (&x2)[8]) {
    const unsigned aw[4] = {a.x, a.y, a.z, a.w}, bw[4] = {b.x, b.y, b.z, b.w};
#pragma unroll
    for (int i = 0; i < 4; ++i) { x1[2 * i] = bflo(aw[i]); x1[2 * i + 1] = bfhi(aw[i]); x2[2 * i] = bflo(bw[i]); x2[2 * i + 1] = bfhi(bw[i]); }
    if (lat) { const int pos = hh ? cpos : rpos; const LAS f32x4* rp = (const LAS f32x4*)(ropeL + pos * 32 + jj);
#pragma unroll
        for (int i2 = 0; i2 < 4; ++i2) { const f32x4 cs = rp[i2];
            { const int i = 2 * i2; const float y1 = x1[i] * cs.x - x2[i] * cs.y, y2 = x1[i] * cs.y + x2[i] * cs.x; x1[i] = y1; x2[i] = y2; }
            { const int i = 2 * i2 + 1; const float y1 = x1[i] * cs.z - x2[i] * cs.w, y2 = x1[i] * cs.w + x2[i] * cs.z; x1[i] = y1; x2[i] = y2; } } }
#pragma unroll
    for (int i = 0; i < 8; ++i) { x1[i] *= scl; x2[i] *= scl; }
}
DI void rope_to_lds(Fr& F, LAS f32x2* ropeL) { const f32x4* g = (const f32x4*)(F.ws + WS_ROPE);
    for (int i = F.tid; i < 1024; i += NTHR) ((LAS f32x4*)ropeL)[i] = g[i]; }
DI void ret_kv_phase(Fr& F) {
    const bf16* QKV = (const bf16*)(F.ws + WS_QKV); bf16* KV = (bf16*)(F.ws + WS_KV); const f32x2* rope = (const f32x2*)(F.ws + WS_ROPE);
    LAS bf16* Vs = (LAS bf16*)F.lds; LAS bf16* Kf = (LAS bf16*)(F.lds + RTILE); LAS bf16* Kb = (LAS bf16*)(F.lds + 2 * RTILE);
    LAS f32x2* ropeL = (LAS f32x2*)(F.lds + 4 * RTILE + 2048); rope_to_lds(F, ropeL); LDS_BARRIER();
    const int wr2 = F.wave >> 1, wc2 = F.wave & 1, fr = F.lane & 15, fq = F.lane >> 4;
    for (int u = F.bx; u < NB * 4 * NCH; u += F.G) {
        const int b = u / (4 * NCH), h = (u / NCH) % 4, id = u % NCH; const int grow0 = ret_row0(b, id); const bool lat = id >= 2;
        const float lgf = -expf(F.in[9][h]), lgb = -expf(F.in[10][h]);
        u32x4 vq[4], ka[2], kb[2];
#pragma unroll
        for (int k = 0; k < 4; ++k) { const int it = F.tid + NTHR * k; vq[k] = *(const u32x4*)(QKV + (size_t)(grow0 + (it >> 4)) * INW + 1024 + h * 128 + 8 * (it & 15)); }
#pragma unroll
        for (int k = 0; k < 2; ++k) { const int it = F.tid + NTHR * k, c = it >> 3, pi = it & 7; const bf16* rowp = QKV + (size_t)(grow0 + c) * INW + 512 + h * 128 + (pi >> 2) * 64 + (pi & 3) * 8;
            ka[k] = *(const u32x4*)rowp; kb[k] = *(const u32x4*)(rowp + 32); }
#pragma unroll
        for (int k = 0; k < 4; ++k) { const int it = F.tid + NTHR * k; *(LAS u32x4*)(Vs + (it >> 4) * RLD + 8 * (it & 15)) = vq[k]; }
#pragma unroll
        for (int k = 0; k < 2; ++k) { const int it = F.tid + NTHR * k; const int c = it >> 3, pi = it & 7, hh = pi >> 2, jj = (pi & 3) * 8; const int t = (id - 2) * 128 + c;
            float x1[8], x2[8]; rope_apply(ka[k], kb[k], hh, jj, lat, t >> 6, t & 63, ropeL, 0.08838834764831845f, x1, x2);
            const float wf = __expf(lgf * (float)(127 - c)), wb = __expf(lgb * (float)c);
            *(LAS u32x4*)(Kf + c * RLD + hh * 64 + jj) = pack8(x1, wf); *(LAS u32x4*)(Kf + c * RLD + hh * 64 + jj + 32) = pack8(x2, wf);
            *(LAS u32x4*)(Kb + c * RLD + hh * 64 + jj) = pack8(x1, wb); *(LAS u32x4*)(Kb + c * RLD + hh * 64 + jj + 32) = pack8(x2, wb); }
        LDS_BARRIER();
#pragma unroll
        for (int dir = 0; dir < 2; ++dir) {
            const LAS bf16* Kd = dir ? Kb : Kf;
            f32x4 acc[2][4];
#pragma unroll
            for (int i = 0; i < 2; ++i)
#pragma unroll
                for (int j = 0; j < 4; ++j) acc[i][j] = (f32x4){0.f, 0.f, 0.f, 0.f};
#pragma unroll 2
            for (int k0 = 0; k0 < 128; k0 += 32) { bf16x8 af[2], bfg[4];
#pragma unroll
                for (int i = 0; i < 2; ++i) af[i] = frag_kr(Vs, RLD, 32 * wr2 + 16 * i, k0, F.lane);
#pragma unroll
                for (int j = 0; j < 4; ++j) bfg[j] = frag_kr(Kd, RLD, 64 * wc2 + 16 * j, k0, F.lane);
#pragma unroll
                for (int i = 0; i < 2; ++i)
#pragma unroll
                    for (int j = 0; j < 4; ++j) acc[i][j] = mma(acc[i][j], bfg[j], af[i]); }
            bf16* o = KV + ((size_t)((b * 4 + h) * 2 + dir) * NCH + id) * 16384;
#pragma unroll
            for (int i = 0; i < 2; ++i)
#pragma unroll
                for (int j = 0; j < 4; ++j) { u32x2 pv; pv.x = pk2(acc[i][j].x, acc[i][j].y); pv.y = pk2(acc[i][j].z, acc[i][j].w); *(u32x2*)(o + (32 * wr2 + 16 * i + fr) * 128 + 64 * wc2 + 16 * j + 4 * fq) = pv; }
        }
        LDS_BARRIER();
    }
}
DI void ret_prefix_phase(Fr& F) {
    const bf16* KV = (const bf16*)(F.ws + WS_KV); bf16* SP = (bf16*)(F.ws + WS_SPREV);
    const int gt = F.bx * NTHR + F.tid, NT = F.G * NTHR;
    for (int i = gt; i < 64 * 4096; i += NT) { const int bhd = i >> 12, e4 = i & 4095, dir = bhd & 1, h = (bhd >> 1) & 3;
        const float lg = -expf(dir ? F.in[10][h] : F.in[9][h]), cd = expf(lg * 128.f);
        f32x4 s = (f32x4){0.f, 0.f, 0.f, 0.f};
        for (int st = 0; st < NCH; ++st) { const int id = dir ? (st == 0 ? 1 : (st == 1 ? 0 : 19 - st)) : st;
            const size_t off = ((size_t)bhd * NCH + id) * 16384 + 4 * e4;
            u32x2 p; p.x = pk2(s.x, s.y); p.y = pk2(s.z, s.w); *(u32x2*)(SP + off) = p;
            const u32x2 kv = *(const u32x2*)(KV + off); s = s * cd + (f32x4){bflo(kv.x), bfhi(kv.x), bflo(kv.y), bfhi(kv.y)}; }
    }
}
DI void ret_out_phase(Fr& F) {
    const bf16* QKV = (const bf16*)(F.ws + WS_QKV); const bf16* SP = (const bf16*)(F.ws + WS_SPREV); bf16* MIX = (bf16*)(F.ws + WS_MIX); const f32x2* rope = (const f32x2*)(F.ws + WS_ROPE);
    LAS bf16* Qs = (LAS bf16*)F.lds; LAS bf16* KP = (LAS bf16*)(F.lds + RTILE); LAS bf16* Vs = (LAS bf16*)(F.lds + 2 * RTILE); LAS bf16* Sf = (LAS bf16*)(F.lds + 3 * RTILE);
    LAS float* red = (LAS float*)(F.lds + 4 * RTILE);
    LAS f32x2* ropeL = (LAS f32x2*)(F.lds + 4 * RTILE + 2048); rope_to_lds(F, ropeL); LDS_BARRIER();
    const int wr2 = F.wave >> 1, wc2 = F.wave & 1, fr = F.lane & 15, fq = F.lane >> 4;
    for (int u = F.bx; u < NB * 4 * NCH; u += F.G) {
        const int b = u / (4 * NCH), h = (u / NCH) % 4, id = u % NCH; const int grow0 = ret_row0(b, id); const bool lat = id >= 2;
        const float lgf = -expf(F.in[9][h]), lgb = -expf(F.in[10][h]);
        const bf16* spf = SP + ((size_t)((b * 4 + h) * 2 + 0) * NCH + id) * 16384; const bf16* spb = SP + ((size_t)((b * 4 + h) * 2 + 1) * NCH + id) * 16384;
        u32x4 vq[4], sq[4], sbreg[4], qa[2], qb[2], ka[2], kb[2];
#pragma unroll
        for (int k = 0; k < 4; ++k) { const int it = F.tid + NTHR * k, c = it >> 4, ch = it & 15;
            vq[k] = *(const u32x4*)(QKV + (size_t)(grow0 + c) * INW + 1024 + h * 128 + 8 * ch); sq[k] = *(const u32x4*)(spf + c * 128 + 8 * ch); }
#pragma unroll
        for (int k = 0; k < 2; ++k) { const int it = F.tid + NTHR * k, c = it >> 3, pi = it & 7; const bf16* rowp = QKV + (size_t)(grow0 + c) * INW + h * 128 + (pi >> 2) * 64 + (pi & 3) * 8;
            qa[k] = *(const u32x4*)rowp; qb[k] = *(const u32x4*)(rowp + 32); ka[k] = *(const u32x4*)(rowp + 512); kb[k] = *(const u32x4*)(rowp + 512 + 32); }
#pragma unroll
        for (int k = 0; k < 4; ++k) { const int it = F.tid + NTHR * k; sbreg[k] = *(const u32x4*)(spb + (it >> 4) * 128 + 8 * (it & 15)); }
#pragma unroll
        for (int k = 0; k < 4; ++k) { const int it = F.tid + NTHR * k, c = it >> 4, ch = it & 15; *(LAS u32x4*)(Vs + c * RLD + 8 * ch) = vq[k]; *(LAS u32x4*)(Sf + c * RLD + 8 * ch) = sq[k]; }
#pragma unroll
        for (int k = 0; k < 2; ++k) { const int it = F.tid + NTHR * k; const int c = it >> 3, pi = it & 7, hh = pi >> 2, jj = (pi & 3) * 8; const int t = (id - 2) * 128 + c;
            float x1[8], x2[8];
            rope_apply(qa[k], qb[k], hh, jj, lat, t >> 6, t & 63, ropeL, 1.f, x1, x2);
            *(LAS u32x4*)(Qs + c * RLD + hh * 64 + jj) = pack8(x1, 1.f); *(LAS u32x4*)(Qs + c * RLD + hh * 64 + jj + 32) = pack8(x2, 1.f);
            rope_apply(ka[k], kb[k], hh, jj, lat, t >> 6, t & 63, ropeL, 0.08838834764831845f, x1, x2);
            *(LAS u32x4*)(KP + c * RLD + hh * 64 + jj) = pack8(x1, 1.f); *(LAS u32x4*)(KP + c * RLD + hh * 64 + jj + 32) = pack8(x2, 1.f); }
        LDS_BARRIER();
        f32x4 sacc[2][4], facc[2][4];
#pragma unroll
        for (int i = 0; i < 2; ++i)
#pragma unroll
            for (int j = 0; j < 4; ++j) { sacc[i][j] = (f32x4){0.f, 0.f, 0.f, 0.f}; facc[i][j] = (f32x4){0.f, 0.f, 0.f, 0.f}; }
#pragma unroll 1
        for (int k0 = 0; k0 < 128; k0 += 32) { bf16x8 af[2], bk[4], bs[4];
#pragma unroll
            for (int i = 0; i < 2; ++i) af[i] = frag_kc(Qs, RLD, 32 * wr2 + 16 * i, k0, F.lane);
#pragma unroll
            for (int j = 0; j < 4; ++j) { bk[j] = frag_kc(KP, RLD, 64 * wc2 + 16 * j, k0, F.lane); bs[j] = frag_kc(Sf, RLD, 64 * wc2 + 16 * j, k0, F.lane); }
#pragma unroll
            for (int i = 0; i < 2; ++i)
#pragma unroll
                for (int j = 0; j < 4; ++j) { sacc[i][j] = mma(sacc[i][j], bk[j], af[i]); facc[i][j] = mma(facc[i][j], bs[j], af[i]); } }
        LDS_BARRIER();
        { const float lf2 = lgf * 1.4426950408889634f, lb2 = lgb * 1.4426950408889634f;
#pragma unroll
          for (int i = 0; i < 2; ++i)
#pragma unroll
            for (int j = 0; j < 4; ++j) { const int c = 32 * wr2 + 16 * i + fr, s0 = 64 * wc2 + 16 * j + 4 * fq; float pv[4];
#pragma unroll
                for (int r = 0; r < 4; ++r) { const int df = c - (s0 + r); const float wgt = df > 0 ? exp2f(lf2 * (float)df) : (df < 0 ? exp2f(lb2 * (float)(-df)) : 2.f); pv[r] = sacc[i][j][r] * wgt; }
                u32x2 p; p.x = pk2(pv[0], pv[1]); p.y = pk2(pv[2], pv[3]); *(LAS u32x2*)(KP + c * RLD + s0) = p; }
#pragma unroll
          for (int k = 0; k < 4; ++k) { const int it = F.tid + NTHR * k; *(LAS u32x4*)(Sf + (it >> 4) * RLD + 8 * (it & 15)) = sbreg[k]; }
        }
        LDS_BARRIER();
        u32x2 ggr[2][4];
#pragma unroll
        for (int i = 0; i < 2; ++i)
#pragma unroll
            for (int j = 0; j < 4; ++j) ggr[i][j] = *(const u32x2*)(QKV + (size_t)(grow0 + 32 * wr2 + 16 * i + fr) * INW + 1536 + h * 128 + 64 * wc2 + 16 * j + 4 * fq);
        f32x4 oacc[2][4], bacc[2][4];
#pragma unroll
        for (int i = 0; i < 2; ++i) { const float qdf = __expf(lgf * (float)(32 * wr2 + 16 * i + fr + 1));
#pragma unroll
            for (int j = 0; j < 4; ++j) { oacc[i][j] = facc[i][j] * qdf; bacc[i][j] = (f32x4){0.f, 0.f, 0.f, 0.f}; } }
#pragma unroll 1
        for (int k0 = 0; k0 < 128; k0 += 32) { bf16x8 ap[2], aq[2], bv[4], bs[4];
#pragma unroll
            for (int i = 0; i < 2; ++i) { ap[i] = frag_kc(KP, RLD, 32 * wr2 + 16 * i, k0, F.lane); aq[i] = frag_kc(Qs, RLD, 32 * wr2 + 16 * i, k0, F.lane); }
#pragma unroll
            for (int j = 0; j < 4; ++j) { bv[j] = frag_kr(Vs, RLD, 64 * wc2 + 16 * j, k0, F.lane); bs[j] = frag_kc(Sf, RLD, 64 * wc2 + 16 * j, k0, F.lane); }
#pragma unroll
            for (int i = 0; i < 2; ++i)
#pragma unroll
                for (int j = 0; j < 4; ++j) { oacc[i][j] = mma(oacc[i][j], bv[j], ap[i]); bacc[i][j] = mma(bacc[i][j], bs[j], aq[i]); } }
        float rs[2], rq[2];
#pragma unroll
        for (int i = 0; i < 2; ++i) { const int c = 32 * wr2 + 16 * i + fr; const float qdb = __expf(lgb * (float)(128 - c)); float s = 0.f, q = 0.f;
#pragma unroll
            for (int j = 0; j < 4; ++j) { oacc[i][j] = oacc[i][j] + bacc[i][j] * qdb;
#pragma unroll
                for (int r = 0; r < 4; ++r) { s += oacc[i][j][r]; q += oacc[i][j][r] * oacc[i][j][r]; } }
            s += __shfl_xor(s, 16); s += __shfl_xor(s, 32); q += __shfl_xor(q, 16); q += __shfl_xor(q, 32);
            if (fq == 0) { red[(c * 2 + wc2) * 2 + 0] = s; red[(c * 2 + wc2) * 2 + 1] = q; }
            rs[i] = s; rq[i] = q; }
        LDS_BARRIER();
#pragma unroll
        for (int i = 0; i < 2; ++i) { const int c = 32 * wr2 + 16 * i + fr;
            const float s = red[(c * 2 + 0) * 2 + 0] + red[(c * 2 + 1) * 2 + 0], q = red[(c * 2 + 0) * 2 + 1] + red[(c * 2 + 1) * 2 + 1];
            const float mean = s * (1.f / 128.f), var = fmaxf(q * (1.f / 128.f) - mean * mean, 0.f), rstd = rsqrtf(var + 1e-5f);
            const size_t grow = (size_t)(grow0 + c);
#pragma unroll
            for (int j = 0; j < 4; ++j) { const int e0 = 64 * wc2 + 16 * j + 4 * fq;
                const f32x4 gw = *(const f32x4*)(F.in[11] + h * 128 + e0); const u32x2 gg = ggr[i][j];
                const float g0 = bflo(gg.x), g1 = bfhi(gg.x), g2 = bflo(gg.y), g3 = bfhi(gg.y);
                const f32x4 y = (oacc[i][j] - mean) * rstd * gw;
                u32x2 p; p.x = pk2(y.x * siluf_(g0), y.y * siluf_(g1)); p.y = pk2(y.z * siluf_(g2), y.w * siluf_(g3));
                *(u32x2*)(MIX + grow * D + h * 128 + e0) = p; } }
        (void)rs; (void)rq;
        LDS_BARRIER();
    }
}

DI void na_norm_rows(Fr& F) {
    const bf16* QKV = (const bf16*)(F.ws + WS_QKV); bf16* NQ = (bf16*)(F.ws + WS_NQ); bf16* NK = (bf16*)(F.ws + WS_NK); bf16* NV = (bf16*)(F.ws + WS_NV);
    const bool isk = F.lane >= 32; const float* wsrc = (isk ? F.in[13] : F.in[12]) + (F.lane & 3) * 16; const float scl = isk ? 1.f : 0.125f * 1.4426950408889634f;
    const int head = (F.lane & 31) >> 2, j0 = (F.lane & 3) * 16;
    float wv[16];
#pragma unroll
    for (int i = 0; i < 16; ++i) wv[i] = wsrc[i] * scl;
    const bool skip64 = (F.G == 256); if (skip64 && F.bx < 64) return;
    const int gw0 = skip64 ? F.gw - 64 * NWAVES : F.gw, ngw = skip64 ? F.NGW - 64 * NWAVES : F.NGW;
    for (int row = gw0; row < MA; row += ngw) {
        const bool lat = row < ML; const int b = lat ? row / SEQ : (row - ML) / CTXL, sr = lat ? CTXL + row % SEQ : (row - ML) % CTXL;
        const size_t ho = ((size_t)(b * 8 + head) * (SEQ + CTXL) + sr) * 64 + j0;
        const bf16* p = QKV + (size_t)row * INW + 2048 + 16 * F.lane;
        const u32x4 a = *(const u32x4*)p, b2 = *(const u32x4*)(p + 8); const unsigned w[8] = {a.x, a.y, a.z, a.w, b2.x, b2.y, b2.z, b2.w}; float x[16]; float ss = 0.f;
#pragma unroll
        for (int i = 0; i < 8; ++i) { x[2 * i] = bflo(w[i]); x[2 * i + 1] = bfhi(w[i]); ss += x[2 * i] * x[2 * i] + x[2 * i + 1] * x[2 * i + 1]; }
        const float rinv = rsqrtf(red4(ss) * (1.f / 64.f) + 1e-6f);
        u32x4 o0, o1;
        o0.x = pk2(x[0] * rinv * wv[0], x[1] * rinv * wv[1]); o0.y = pk2(x[2] * rinv * wv[2], x[3] * rinv * wv[3]); o0.z = pk2(x[4] * rinv * wv[4], x[5] * rinv * wv[5]); o0.w = pk2(x[6] * rinv * wv[6], x[7] * rinv * wv[7]);
        o1.x = pk2(x[8] * rinv * wv[8], x[9] * rinv * wv[9]); o1.y = pk2(x[10] * rinv * wv[10], x[11] * rinv * wv[11]); o1.z = pk2(x[12] * rinv * wv[12], x[13] * rinv * wv[13]); o1.w = pk2(x[14] * rinv * wv[14], x[15] * rinv * wv[15]);
        bf16* d = (isk ? NK : NQ) + ho; *(u32x4*)d = o0; *(u32x4*)(d + 8) = o1;
        if (!isk) { const bf16* pv = QKV + (size_t)row * INW + 3072 + 16 * F.lane; const u32x4 v0 = *(const u32x4*)pv, v1 = *(const u32x4*)(pv + 8); *(u32x4*)(NV + ho) = v0; *(u32x4*)(NV + ho + 8) = v1; }
    }
}
constexpr int NLD = 72;
DI void na_phase(Fr& F) {
    const bf16* NQ = (const bf16*)(F.ws + WS_NQ); const bf16* NK = (const bf16*)(F.ws + WS_NK); const bf16* NV = (const bf16*)(F.ws + WS_NV); bf16* MIX = (bf16*)(F.ws + WS_MIX);
    LAS bf16* Ks = (LAS bf16*)F.lds;
    LAS bf16* Vs = (LAS bf16*)(F.lds + 36864);
    LAS bf16* Pw = (LAS bf16*)(F.lds + 2 * 36864) + F.wave * (32 * NLD);
    LAS float* rpbs = (LAS float*)(F.lds + 2 * 36864 + 8 * 4608);
    const int fr = F.lane & 15, fq = F.lane >> 4;
    float bound;
    { float mqw = fabsf(F.in[12][F.lane]), mkw = fabsf(F.in[13][F.lane]), mb = 0.f;
      for (int i = F.lane; i < 8 * 15 * 31; i += 64) mb = fmaxf(mb, fabsf(F.in[14][i]));
      bound = (8.f * wave_max(mqw) * wave_max(mkw) + wave_max(mb)) * 1.4426950408889634f; }
    const bool deal256 = (F.G == 256);
    for (int ui = 0;; ++ui) {
        int u;
        if (deal256) { const int x = F.bx & 7;
            if (F.bx < 64) { if (ui > 1) break; u = 64 * (F.bx >> 3) + 8 * (ui ? 7 : 0) + x; }
            else { const int t = (F.bx - 64) >> 3;
                if (ui < 2) u = 64 * (t / 3) + 8 * (1 + 2 * (t % 3) + ui) + x; else if (ui == 2 && F.bx < 128) u = 448 + F.bx; else break; } }
        else { u = F.bx + F.G * ui; if (u >= 512 + 64) break; }
        int b, head, r = -1, cb = 0, qtok0, kb_lo = 0, nwin = 0;
        if (u < 512) { const int bh = ((u >> 6) << 3) + (u & 7), qb = (u >> 3) & 7; b = bh >> 3; head = bh & 7;
            r = 4 * qb + (F.wave >> 1); cb = 32 * (F.wave & 1); qtok0 = b * SEQ + r * 64 + cb;
            const int r0lo = min(max(4 * qb - 4, 0), 24), r0hi = min(max(4 * qb - 1, 0), 24); kb_lo = r0lo >> 2; nwin = ((r0hi + 7) >> 2) - kb_lo + 1; }
        else { const int cu = u - 512; b = cu >> 3; head = cu & 7; qtok0 = ML + b * CTXL + 32 * F.wave; }
        const int r0 = min(max(r - 4, 0), 24);
        const size_t hb = (size_t)(b * 8 + head) * (SEQ + CTXL); const int qseq = u < 512 ? CTXL + r * 64 + cb : 32 * F.wave;
        bf16x8 aq[2][2];
#pragma unroll
        for (int mt = 0; mt < 2; ++mt)
#pragma unroll
            for (int ks = 0; ks < 2; ++ks) aq[mt][ks] = *(const bf16x8*)(NQ + (hb + qseq + 16 * mt + fr) * 64 + 32 * ks + 8 * fq);
        if (u < 512) for (int i = F.tid; i < 15 * 32; i += NTHR) { const int ro = i >> 5, co = i & 31; rpbs[i] = co < 31 ? F.in[14][head * 465 + ro * 31 + co] * 1.4426950408889634f - bound : -1.0e30f; }
        int boff[2][4][4]; int nlo[2], nhi[2];
#pragma unroll
        for (int mt = 0; mt < 2; ++mt) { const int cs = cb + 16 * mt, c = cs + fr, c0 = min(max(c - 8, 0), 48);
            nlo[mt] = max(cs - 8, 0) >> 4; nhi[mt] = (min(cs + 7, 48) + 15) >> 4;
#pragma unroll
            for (int nt = 0; nt < 4; ++nt)
#pragma unroll
                for (int i = 0; i < 4; ++i) { const int kc = 16 * nt + 4 * fq + i; boff[mt][nt][i] = ((kc >= c0) && (kc < c0 + 16)) ? (kc - c + 15) : 31; } }
        f32x4 oacc[2][4]; float lsum[2] = {0.f, 0.f};
#pragma unroll
        for (int mt = 0; mt < 2; ++mt)
#pragma unroll
            for (int j = 0; j < 4; ++j) oacc[mt][j] = (f32x4){0.f, 0.f, 0.f, 0.f};
        u32x4 kst[4], vst[4];
#define NA_LOAD(bi_) do { const int kbase_ = (bi_) < nwin ? CTXL + 256 * (kb_lo + (bi_)) : 0; _Pragma("unroll") for (int it_ = 0; it_ < 4; ++it_) { const size_t o_ = (hb + kbase_ + (F.tid >> 3) + 64 * it_) * 64 + 8 * (F.tid & 7); \
            kst[it_] = *(const u32x4*)(NK + o_); vst[it_] = *(const u32x4*)(NV + o_); } } while (0)
        NA_LOAD(0);
        for (int bi = 0; bi <= nwin; ++bi) {
            const bool is_ctx = bi == nwin;
#pragma unroll
            for (int it = 0; it < 4; ++it) { const int krow = (F.tid >> 3) + 64 * it, c8 = F.tid & 7;
                *(LAS u32x4*)(Ks + krow * NLD + 8 * c8) = kst[it]; *(LAS u32x4*)(Vs + krow * NLD + 8 * c8) = vst[it]; }
            LDS_BARRIER();
            if (bi < nwin) NA_LOAD(bi + 1);
#define NA_ROW(M0, M1, CTX) do { \
                float bia[2][4][4]; \
                if (!(CTX)) { const int rowb0 = (kr - r + 7) * 32; \
                    _Pragma("unroll") for (int mt = 0; mt < 2; ++mt) _Pragma("unroll") for (int nt = 0; nt < 4; ++nt) { if (!((((mt) ? (M1) : (M0)) >> nt) & 1)) continue; \
                        _Pragma("unroll") for (int i = 0; i < 4; ++i) bia[mt][nt][i] = rpbs[rowb0 + boff[mt][nt][i]]; } } \
                f32x4 sacc[2][4]; \
                _Pragma("unroll") for (int nt = 0; nt < 4; ++nt) { const bool u0 = ((M0) >> nt) & 1, u1 = ((M1) >> nt) & 1; if (!(u0 || u1)) continue; \
                    sacc[0][nt] = (f32x4){0.f, 0.f, 0.f, 0.f}; sacc[1][nt] = (f32x4){0.f, 0.f, 0.f, 0.f}; \
                    _Pragma("unroll") for (int ks = 0; ks < 2; ++ks) { const bf16x8 bk = frag_kc(Ks, NLD, 64 * krl + 16 * nt, 32 * ks, F.lane); \
                        if (u0) sacc[0][nt] = mma(sacc[0][nt], bk, aq[0][ks]); if (u1) sacc[1][nt] = mma(sacc[1][nt], bk, aq[1][ks]); } } \
                _Pragma("unroll") for (int mt = 0; mt < 2; ++mt) { \
                    _Pragma("unroll") for (int nt = 0; nt < 4; ++nt) { const int mm = (mt) ? (M1) : (M0); const bool act = (mm >> nt) & 1, pair = (mm >> (nt ^ 1)) & 1; \
                        if (!(act || pair)) continue;                       \
                        float pv[4] = {0.f, 0.f, 0.f, 0.f}; \
                        if (act) { \
                            _Pragma("unroll") for (int i = 0; i < 4; ++i) { pv[i] = (CTX) ? __builtin_amdgcn_exp2f(sacc[mt][nt][i] - bound) : __builtin_amdgcn_exp2f(sacc[mt][nt][i] + bia[mt][nt][i]); lsum[mt] += pv[i]; } } \
                        u32x2 pk; pk.x = pk2(pv[0], pv[1]); pk.y = pk2(pv[2], pv[3]); *(LAS u32x2*)(Pw + (16 * mt + fr) * NLD + 16 * nt + 4 * fq) = pk; } } \
                LDS_WAIT(); \
                _Pragma("unroll") for (int ks2 = 0; ks2 < 2; ++ks2) { const bool v0 = (((M0) >> (2 * ks2)) & 3) != 0, v1 = (((M1) >> (2 * ks2)) & 3) != 0; \
                    if (!(v0 || v1)) continue; \
                    bf16x8 ap0, ap1; if (v0) ap0 = frag_kc(Pw, NLD, 0, 32 * ks2, F.lane); if (v1) ap1 = frag_kc(Pw, NLD, 16, 32 * ks2, F.lane); \
                    _Pragma("unroll") for (int et = 0; et < 4; ++et) { const bf16x8 bv = frag_kr(Vs, NLD, 16 * et, 64 * krl + 32 * ks2, F.lane); \
                        if (v0) oacc[0][et] = mma(oacc[0][et], bv, ap0); if (v1) oacc[1][et] = mma(oacc[1][et], bv, ap1); } } } while (0)
#pragma unroll 1
            for (int krl = 0; krl < 4; ++krl) {
                const int kr = 4 * (kb_lo + bi) + krl;
                if (!is_ctx && (kr < r0 || kr > r0 + 7)) continue;
                if (is_ctx) NA_ROW(15, 15, 1); else if (cb == 0) NA_ROW(3, 7, 0); else NA_ROW(14, 12, 0);
            }
#undef NA_ROW
            LDS_BARRIER();
        }
#undef NA_LOAD
#pragma unroll
        for (int mt = 0; mt < 2; ++mt) { float l = lsum[mt]; l += __shfl_xor(l, 16); l += __shfl_xor(l, 32); const float inv = 1.f / l;
#pragma unroll
            for (int et = 0; et < 4; ++et) { const f32x4 o = oacc[mt][et] * inv; u32x2 p; p.x = pk2(o.x, o.y); p.y = pk2(o.z, o.w);
                *(u32x2*)(MIX + (size_t)(qtok0 + 16 * mt + fr) * D + 512 + head * 64 + 16 * et + 4 * fq) = p; } }
    }
}

DI void xm_phase(Fr& F, const bf16* xl, const bf16* xc, const float* normw, const float* modl) {
    bf16* XM = (bf16*)(F.ws + WS_XM); const float* mu = F.in[18];
    for (int g = F.gw; g < MA / 4; g += F.NGW) {
        const int row0 = 4 * g; const bool lat = row0 < ML; const int rr0 = lat ? row0 : row0 - ML; const int L = lat ? SEQ : CTXL; const int t0 = rr0 % L;
        const bf16* src = (lat ? xl : xc) + (size_t)rr0 * D;
        const float* mrow = modl + (size_t)(lat ? row0 / SEQ : 8) * 6144;
        const bool hp = t0 > 0, hn = t0 + 4 < L;
        f32x4 v[6][4]; float rs[6];
#pragma unroll
        for (int r = 0; r < 6; ++r) { const bool ok = (r == 0) ? hp : (r == 5 ? hn : true);
#pragma unroll
            for (int j = 0; j < 4; ++j) v[r][j] = ok ? ldx4(src + (ptrdiff_t)(r - 1) * D, F.lane + 64 * j) : (f32x4){0.f, 0.f, 0.f, 0.f}; }
#pragma unroll
        for (int r = 0; r < 6; ++r) { float ss = 0.f;
#pragma unroll
            for (int j = 0; j < 4; ++j) ss += (v[r][j].x * v[r][j].x + v[r][j].y * v[r][j].y) + (v[r][j].z * v[r][j].z + v[r][j].w * v[r][j].w);
            rs[r] = rsqrtf(wave_sum_fast(ss) * (1.f / D) + 1e-6f); }
#pragma unroll
        for (int j = 0; j < 4; ++j) { const int c4 = F.lane + 64 * j;
            const f32x4 gg = ((const f32x4*)normw)[c4] * (((const f32x4*)(mrow + 1024))[c4] + 1.f), sh = ((const f32x4*)mrow)[c4];
            f32x4 h[6];
#pragma unroll
            for (int r = 0; r < 6; ++r) { const bool ok = (r == 0) ? hp : (r == 5 ? hn : true); h[r] = ok ? v[r][j] * rs[r] * gg + sh : (f32x4){0.f, 0.f, 0.f, 0.f}; }
            f32x4 m[6];
#pragma unroll
            for (int sx = 0; sx < 6; ++sx) m[sx] = ((const f32x4*)(mu + sx * 1024))[c4];
#pragma unroll
            for (int r = 0; r < 4; ++r) { const f32x4 hc = h[r + 1], xx = (h[r] + h[r + 2]) * 0.5f - hc;
#pragma unroll
                for (int sx = 0; sx < 6; ++sx) { if (!lat && (sx == 0 || sx == 5)) continue;
                    const f32x4 y = hc + xx * m[sx];
                    u32x2 p; p.x = pk2(y.x, y.y); p.y = pk2(y.z, y.w); ((u32x2*)(XM + ((size_t)sx * MA + row0 + r) * D))[c4] = p; } } }
    }
}

struct CvDesc { const float* src; bf16* dst; int ldsrc; };
DI CvDesc cv_desc(Fr& F, int t, int lane) {
    const TrItem it = moe_item(F, t >> 3); const int sub = t & 7, k0 = it.k0 + 32 * (sub >> 2), n = it.n0 + 64 * (sub & 3) + lane; int drow = n;
    if (it.Hh) { const int hf = n / it.Hh, j = n % it.Hh; drow = (j / 128) * 256 + hf * 128 + (j % 128); }
    CvDesc d; d.src = it.src + (size_t)k0 * it.ldsrc + n; d.ldsrc = it.ldsrc; d.dst = it.dst + (size_t)drow * it.lddst + k0; return d;
}
DI void cv_load(const CvDesc& d, float (&v)[32]) {
#pragma unroll
    for (int kk = 0; kk < 32; ++kk) v[kk] = d.src[(size_t)kk * d.ldsrc];
}
DI void cv_store(bf16* dst, const float (&v)[32]) {
#pragma unroll
    for (int c = 0; c < 4; ++c) { u32x4 o; o.x = pk2(v[8 * c], v[8 * c + 1]); o.y = pk2(v[8 * c + 2], v[8 * c + 3]); o.z = pk2(v[8 * c + 4], v[8 * c + 5]); o.w = pk2(v[8 * c + 6], v[8 * c + 7]);
        *(u32x4*)(dst + 8 * c) = o; }
}
DI f32x4 mma16(f32x4 acc, s16x4 bfrag, s16x4 afrag) { return __builtin_amdgcn_mfma_f32_16x16x16bf16_1k(bfrag, afrag, acc, 0, 0, 0); }
DI s16x4 frag16_kc(const LAS bf16* base, int ld, int row0, int k0, int lane) { return *(const LAS s16x4*)(base + (row0 + (lane & 15)) * ld + k0 + 4 * (lane >> 4)); }
DI s16x4 frag16_kr(const LAS bf16* base, int ld, int x0, int k0, int lane) { const int g = lane >> 4, q = (lane & 15) >> 2, p = lane & 3;
    return __builtin_amdgcn_ds_read_tr16_b64_v4i16((LAS s16x4*)(base + (k0 + 4 * g + q) * ld + x0 + 4 * p)); }
DI s16x4 cvt4(f32x4 v) { u32x2 p; p.x = pk2(v.x, v.y); p.y = pk2(v.z, v.w); return __builtin_bit_cast(s16x4, p); }
constexpr int WLD = 72;
DI void rwkv_scan2_phase(Fr& F) {
    const bf16* KB = (const bf16*)(F.ws + WS_KB); const bf16* VB = (const bf16*)(F.ws + WS_VB); const bf16* RB = (const bf16*)(F.ws + WS_RB);
    const bf16* L1 = (const bf16*)(F.ws + WS_L1); const bf16* WL2 = (const bf16*)(F.ws + WS_W_L2);
    LAS bf16* AT = (LAS bf16*)F.lds; LAS bf16* BT = AT + 64 * WLD; LAS bf16* KT = BT + 64 * WLD; LAS bf16* RT = KT + 64 * WLD; LAS bf16* BH = RT + 64 * WLD; LAS bf16* KH = BH + 64 * WLD;
    LAS bf16* VN = KH + 64 * WLD; LAS bf16* W1s = VN + 64 * WLD;
    LAS bf16* PRB = W1s + 64 * WLD; LAS bf16* PRK = PRB + 1024;
    LAS f32x4* UVT = (LAS f32x4*)(PRK + 1024);
    LAS float* GC = (LAS float*)(UVT + 1024);
    LAS float* CSs = GC + 256;
    LAS float* YS = CSs + 4096;
    LAS bf16* W2s = (LAS bf16*)(YS + 64 * 68); LAS bf16* A2s = W2s + 64 * WLD;
    LAS float* LBs = (LAS float*)(A2s + 64 * WLD);
    LAS bf16* AGs = W1s;
    const int cq = F.wave >> 1, half = F.wave & 1, fr = F.lane & 15, fq = F.lane >> 4;
    float cvv[32]; bf16* cv_dst = nullptr; int cv_next = F.bx * 4 + (F.wave - 4); const int cv_stride = F.G * 4;
    for (int u = F.bx; u < 256; u += F.G) {
        const int z = u & 1, h = (u >> 1) & 15, b = u >> 5;
        bf16* Y = (bf16*)(F.ws + (z ? WS_YB : WS_YF));
        const int sx = F.lane >> 3, cg = F.lane & 7;
        float kkw[8], kaw[8], rkw[8];
#pragma unroll
        for (int i = 0; i < 8; ++i) { kkw[i] = F.in[28][h * 64 + 8 * cg + i]; kaw[i] = F.in[29][h * 64 + 8 * cg + i]; rkw[i] = F.in[30][h * 64 + 8 * cg + i]; }
        float* coef = (float*)(F.ws + WS_COEF) + ((size_t)z * 128 + b * 16 + h) * SEQ;
        const size_t bh = (size_t)(b * 16 + h);
        const bf16* kbh = KB + bh * (SEQ + CTXL) * 64 + 8 * cg; const bf16* vbh = VB + bh * (SEQ + CTXL) * 64 + 8 * cg; const bf16* rbh = RB + bh * SEQ * 64 + 8 * cg;
        { const int c = F.tid >> 3, ch8 = F.tid & 7;
          *(LAS u32x4*)(W2s + c * WLD + 8 * ch8) = *(const u32x4*)(WL2 + (size_t)(z * 1024 + h * 64 + c) * 256 + z * 64 + 8 * ch8);
          *(LAS u32x4*)(A2s + c * WLD + 8 * ch8) = *(const u32x4*)(WL2 + (size_t)((2 + z) * 1024 + h * 64 + c) * 256 + (2 + z) * 64 + 8 * ch8); }
        if (F.tid < 128) LBs[F.tid] = ((F.tid & 64) ? F.in[23] : F.in[20])[z * 1024 + h * 64 + (F.tid & 63)];
        LDS_BARRIER();
        const int pa = F.wave & 1, mt = F.wave >> 1;
        const bf16* l1f = L1 + pa * 128 + z * 64 + 8 * fq;
        f32x4 S[4];
#pragma unroll
        for (int j = 0; j < 4; ++j) S[j] = (f32x4){0.f, 0.f, 0.f, 0.f};
        u32x4 kreg, vreg, rreg, fa0, fa1;
        const int stl = 16 * cq + 8 * half + sx;
#define RW_LOAD(sc) do { const int g_ = (sc) * 64 + stl; const bool lat_ = g_ >= CTXL; const int row_ = z ? (lat_ ? (2 * CTXL + SEQ - 1 - g_) : (CTXL - 1 - g_)) : g_; \
            kreg = *(const u32x4*)(kbh + (size_t)row_ * 64); vreg = *(const u32x4*)(vbh + (size_t)row_ * 64); \
            rreg = lat_ ? *(const u32x4*)(rbh + (size_t)(row_ - CTXL) * 64) : (u32x4){0u, 0u, 0u, 0u}; \
            const int gf_ = (sc) * 64 + 16 * mt + fr; const bool latf_ = gf_ >= CTXL; const int rowf_ = z ? (latf_ ? (2 * CTXL + SEQ - 1 - gf_) : (CTXL - 1 - gf_)) : gf_; \
            const size_t trow_ = latf_ ? (size_t)b * SEQ + (rowf_ - CTXL) : (size_t)ML + b * CTXL + rowf_;        \
            fa0 = *(const u32x4*)(l1f + trow_ * 256); fa1 = *(const u32x4*)(l1f + trow_ * 256 + 32); } while (0)
        RW_LOAD(0);
        for (int sc = 0; sc < (SEQ + CTXL) / 64; ++sc) {
            const bool lat = sc * 64 >= CTXL;
            { const LAS bf16* Wt = pa ? A2s : W2s;
              f32x4 la[4];
#pragma unroll
              for (int nt = 0; nt < 4; ++nt) la[nt] = *(const LAS f32x4*)(LBs + 64 * pa + 16 * nt + 4 * fq);
#pragma unroll
              for (int nt = 0; nt < 4; ++nt) { la[nt] = mma(la[nt], frag_kc(Wt, WLD, 16 * nt, 0, F.lane), __builtin_bit_cast(bf16x8, fa0)); la[nt] = mma(la[nt], frag_kc(Wt, WLD, 16 * nt, 32, F.lane), __builtin_bit_cast(bf16x8, fa1)); }
              if (pa == 0) {
#pragma unroll
                  for (int nt = 0; nt < 4; ++nt) { f32x4 v;
#pragma unroll
                      for (int r = 0; r < 4; ++r) { float x = sigmoidf_(la[nt][r]) * -0.8750387749596068f;
                          x += __builtin_bit_cast(float, __builtin_amdgcn_update_dpp(0, __builtin_bit_cast(int, x), 0x111, 0xf, 0xf, true));
                          x += __builtin_bit_cast(float, __builtin_amdgcn_update_dpp(0, __builtin_bit_cast(int, x), 0x112, 0xf, 0xf, true));
                          x += __builtin_bit_cast(float, __builtin_amdgcn_update_dpp(0, __builtin_bit_cast(int, x), 0x114, 0xf, 0xf, true));
                          x += __builtin_bit_cast(float, __builtin_amdgcn_update_dpp(0, __builtin_bit_cast(int, x), 0x118, 0xf, 0xf, true));
                          v[r] = x; }
                      *(LAS f32x4*)(CSs + (16 * mt + fr) * 64 + 16 * nt + 4 * fq) = v; } }
              else {
#pragma unroll
                  for (int nt = 0; nt < 4; ++nt) { f32x4 v;
#pragma unroll
                      for (int r = 0; r < 4; ++r) v[r] = sigmoidf_(la[nt][r]);
                      *(LAS s16x4*)(AGs + (16 * mt + fr) * WLD + 16 * nt + 4 * fq) = cvt4(v); } } }
            LDS_BARRIER();
            { const int tau = 8 * half + sx;
              const f32x4 c0 = *(const LAS f32x4*)(CSs + stl * 64 + 8 * cg), c1 = *(const LAS f32x4*)(CSs + stl * 64 + 8 * cg + 4);
              f32x4 p0 = (f32x4){0.f, 0.f, 0.f, 0.f}, p1 = p0;
              if (tau > 0) { p0 = *(const LAS f32x4*)(CSs + (stl - 1) * 64 + 8 * cg); p1 = *(const LAS f32x4*)(CSs + (stl - 1) * 64 + 8 * cg + 4); }
              const f32x4 t0 = *(const LAS f32x4*)(CSs + (16 * cq + 15) * 64 + 8 * cg), t1 = *(const LAS f32x4*)(CSs + (16 * cq + 15) * 64 + 8 * cg + 4);
              const float cs[8] = {c0.x, c0.y, c0.z, c0.w, c1.x, c1.y, c1.z, c1.w}, cp[8] = {p0.x, p0.y, p0.z, p0.w, p1.x, p1.y, p1.z, p1.w}, ct[8] = {t0.x, t0.y, t0.z, t0.w, t1.x, t1.y, t1.z, t1.w};
              const u32x4 agw = *(const LAS u32x4*)(AGs + stl * WLD + 8 * cg);
              const unsigned kw[4] = {kreg.x, kreg.y, kreg.z, kreg.w}, aw[4] = {agw.x, agw.y, agw.z, agw.w}, rw[4] = {rreg.x, rreg.y, rreg.z, rreg.w};
              float kr[8], ag[8], rr[8], kk[8]; float ss = 0.f;
#pragma unroll
              for (int i = 0; i < 4; ++i) { kr[2 * i] = bflo(kw[i]); kr[2 * i + 1] = bfhi(kw[i]); ag[2 * i] = bflo(aw[i]); ag[2 * i + 1] = bfhi(aw[i]); rr[2 * i] = bflo(rw[i]); rr[2 * i + 1] = bfhi(rw[i]); }
#pragma unroll
              for (int i = 0; i < 8; ++i) { kk[i] = kr[i] * kkw[i]; ss += kk[i] * kk[i]; }
              const float rn = __builtin_amdgcn_rsqf(fmaxf(red8(ss), 1e-24f));
              float oa[8], ob[8], ok[8], orr[8], obh[8], okh[8], eCv[8]; float cfp = 0.f;
#pragma unroll
              for (int i = 0; i < 8; ++i) { const float e1 = __builtin_amdgcn_exp2f(cs[i]), ep = __builtin_amdgcn_exp2f(cp[i]), eC = __builtin_amdgcn_exp2f(ct[i]), inv = __builtin_amdgcn_rcpf(e1);
                  const float kki = kk[i] * rn, b_ = kki * ag[i], kd_ = kr[i] * (1.f + (ag[i] - 1.f) * kaw[i]);
                  cfp += rr[i] * kd_ * rkw[i];
                  oa[i] = -kki * ep; ob[i] = b_ * inv; ok[i] = kd_ * inv; orr[i] = rr[i] * e1; obh[i] = b_ * eC * inv; okh[i] = kd_ * eC * inv; eCv[i] = eC; }
              cfp = red8(cfp);
              if (lat && cg == 0) { const int g = sc * 64 + stl; coef[z ? (SEQ + CTXL - 1 - g) : (g - CTXL)] = cfp; }
              const int o = stl * WLD + 8 * cg;
              *(LAS u32x4*)(AT + o) = pack8(oa, 1.f); *(LAS u32x4*)(BT + o) = pack8(ob, 1.f); *(LAS u32x4*)(KT + o) = pack8(ok, 1.f); *(LAS u32x4*)(RT + o) = pack8(orr, 1.f);
              *(LAS u32x4*)(BH + o) = pack8(obh, 1.f); *(LAS u32x4*)(KH + o) = pack8(okh, 1.f); *(LAS u32x4*)(VN + o) = vreg;
              if (tau == 0) { *(LAS f32x4*)(GC + cq * 64 + 8 * cg) = (f32x4){eCv[0], eCv[1], eCv[2], eCv[3]}; *(LAS f32x4*)(GC + cq * 64 + 8 * cg + 4) = (f32x4){eCv[4], eCv[5], eCv[6], eCv[7]}; } }
            LDS_BARRIER();
            if (sc + 1 < (SEQ + CTXL) / 64) RW_LOAD(sc + 1);
            for (int pa2_ = 0; pa2_ < ((((PROBE_DUP) >> 25) & 1u) ? 2 : 1); ++pa2_)
            if (half) { f32x4 pb = (f32x4){0.f, 0.f, 0.f, 0.f}, pk = (f32x4){0.f, 0.f, 0.f, 0.f};
#pragma unroll
                for (int k0 = 0; k0 < 64; k0 += 32) { const bf16x8 af = frag_kc(RT, WLD, 16 * cq, k0, F.lane);
                    pb = mma(pb, frag_kc(BT, WLD, 16 * cq, k0, F.lane), af); pk = mma(pk, frag_kc(KT, WLD, 16 * cq, k0, F.lane), af); }
#pragma unroll
                for (int r = 0; r < 4; ++r) if (4 * fq + r > fr) { pb[r] = 0.f; pk[r] = 0.f; }
                const int o = cq * 256 + fr * 16 + 4 * fq;
                *(LAS s16x4*)(PRB + o) = cvt4(pb); *(LAS s16x4*)(PRK + o) = cvt4(pk); }
            else { f32x4 xa = (f32x4){0.f, 0.f, 0.f, 0.f}, xt = (f32x4){0.f, 0.f, 0.f, 0.f}, ak = (f32x4){0.f, 0.f, 0.f, 0.f};
#pragma unroll
                for (int k0 = 0; k0 < 64; k0 += 32) { const bf16x8 af = frag_kc(AT, WLD, 16 * cq, k0, F.lane), bfm = frag_kc(BT, WLD, 16 * cq, k0, F.lane);
                    xa = mma(xa, bfm, af);
                    xt = mma(xt, af, bfm);
                    ak = mma(ak, frag_kc(KT, WLD, 16 * cq, k0, F.lane), af); }
#pragma unroll
                for (int r = 0; r < 4; ++r) { if (4 * fq + r >= fr) { xa[r] = 0.f; ak[r] = 0.f; } if (4 * fq + r <= fr) xt[r] = 0.f; }
                f32x4 P = xa;
#pragma unroll
                for (int r = 0; r < 4; ++r) if (4 * fq + r == fr) P[r] += 1.f;
#pragma unroll
                for (int lvl = 0; lvl < 3; ++lvl) { const s16x4 xf = cvt4(xa), xtf = cvt4(xt);
                    const f32x4 x2 = mma16((f32x4){0.f, 0.f, 0.f, 0.f}, xtf, xf);
                    const f32x4 x2t = mma16((f32x4){0.f, 0.f, 0.f, 0.f}, xf, xtf);
                    xa = x2; xt = x2t;
                    P = mma16(P, cvt4(xt), cvt4(P)); }
                const s16x4 tf = cvt4(P), akf = cvt4(ak);
#pragma unroll
                for (int jt = 0; jt < 4; ++jt) { const f32x4 acc = mma16((f32x4){0.f, 0.f, 0.f, 0.f}, frag16_kr(AT, WLD, 16 * jt, 16 * cq, F.lane), tf);
                    *(LAS s16x4*)(W1s + (16 * cq + fr) * WLD + 16 * jt + 4 * fq) = cvt4(acc); }
#pragma unroll
                for (int it = 0; it < 4; ++it) { const f32x4 xvt = mma16((f32x4){0.f, 0.f, 0.f, 0.f}, akf, frag16_kr(VN, WLD, 16 * it, 16 * cq, F.lane));
                    UVT[(cq * 4 + it) * 64 + F.lane] = mma16((f32x4){0.f, 0.f, 0.f, 0.f}, tf, cvt4(xvt)); } }
            LDS_BARRIER();
            if (F.wave >= 4) {
                if (cv_dst) cv_store(cv_dst, cvv);
                cv_dst = nullptr;
                if (cv_next < 8 * CV_SCAN_ITEMS) { const CvDesc d = cv_desc(F, cv_next, F.lane); cv_load(d, cvv); cv_dst = d.dst; cv_next += cv_stride; } }
            if (F.wave < 4) { const int it = F.wave;
                s16x4 w1f[2][4], bhf[2][4], khf[2][4], vfr[2]; f32x4 uv0[2];
#define SB_LOAD(c_, b_) do { _Pragma("unroll") for (int jt = 0; jt < 4; ++jt) { w1f[b_][jt] = frag16_kc(W1s, WLD, 16 * (c_), 16 * jt, F.lane); \
                        bhf[b_][jt] = frag16_kr(BH, WLD, 16 * jt, 16 * (c_), F.lane); khf[b_][jt] = frag16_kr(KH, WLD, 16 * jt, 16 * (c_), F.lane); } \
                    vfr[b_] = frag16_kr(VN, WLD, 16 * it, 16 * (c_), F.lane); uv0[b_] = UVT[((c_) * 4 + it) * 64 + F.lane]; } while (0)
                SB_LOAD(0, 0);
#pragma unroll
                for (int c = 0; c < 4; ++c) { const int cb_ = c & 1;
                    if (c < 3) SB_LOAD(c + 1, cb_ ^ 1);
                    f32x4 gcf[4];
#pragma unroll
                    for (int jt = 0; jt < 4; ++jt) gcf[jt] = *(const LAS f32x4*)(GC + c * 64 + 16 * jt + 4 * fq);
                    s16x4 sfr[4];
#pragma unroll
                    for (int jt = 0; jt < 4; ++jt) sfr[jt] = cvt4(S[jt]);
#define CAT8(a_, b_) __builtin_shufflevector((a_), (b_), 0, 1, 2, 3, 4, 5, 6, 7)
                    const bf16x8 s01 = CAT8(sfr[0], sfr[1]), s23 = CAT8(sfr[2], sfr[3]);
                    f32x4 Ua = mma(uv0[cb_], CAT8(w1f[cb_][0], w1f[cb_][1]), s01); Ua = mma(Ua, CAT8(w1f[cb_][2], w1f[cb_][3]), s23);
                    const s16x4 ufr = cvt4(Ua); const bf16x8 uv8 = CAT8(ufr, vfr[cb_]);
#pragma unroll
                    for (int jt = 0; jt < 4; ++jt) S[jt] = mma(S[jt] * gcf[jt], CAT8(bhf[cb_][jt], khf[cb_][jt]), uv8);
                    if (lat) { s16x4 rtf[4];
#pragma unroll
                        for (int jt = 0; jt < 4; ++jt) rtf[jt] = frag16_kc(RT, WLD, 16 * c, 16 * jt, F.lane);
                        const s16x4 pbf = frag16_kc(PRB + c * 256, 16, 0, 0, F.lane), pkf = frag16_kc(PRK + c * 256, 16, 0, 0, F.lane);
                        f32x4 Ya = mma((f32x4){0.f, 0.f, 0.f, 0.f}, CAT8(rtf[0], rtf[1]), s01); Ya = mma(Ya, CAT8(rtf[2], rtf[3]), s23);
                        const f32x4 Yb = mma((f32x4){0.f, 0.f, 0.f, 0.f}, CAT8(pbf, pkf), uv8);
                        const f32x4 Yt = Ya + Yb;
#pragma unroll
                        for (int r = 0; r < 4; ++r) YS[(16 * c + 4 * fq + r) * 68 + 16 * it + fr] = Yt[r]; }
                }
#undef SB_LOAD
            }
            LDS_BARRIER();
            if (lat) {
                const int g = sc * 64 + (F.tid >> 3); const int tl = z ? (SEQ + CTXL - 1 - g) : (g - CTXL);
                const f32x4 y0 = *(const LAS f32x4*)(YS + (F.tid >> 3) * 68 + 8 * (F.tid & 7)), y1 = *(const LAS f32x4*)(YS + (F.tid >> 3) * 68 + 8 * (F.tid & 7) + 4);
                u32x4 o; o.x = pk2(y0.x, y0.y); o.y = pk2(y0.z, y0.w); o.z = pk2(y1.x, y1.y); o.w = pk2(y1.z, y1.w);
                *(u32x4*)(Y + (size_t)(b * SEQ + tl) * D + h * 64 + 8 * (F.tid & 7)) = o; }
        }
        LDS_BARRIER();
#undef RW_LOAD
    }
    if (F.wave >= 4) {
        if (cv_dst) cv_store(cv_dst, cvv);
        for (; cv_next < 8 * CV_SCAN_ITEMS; cv_next += cv_stride) { const CvDesc d = cv_desc(F, cv_next, F.lane); cv_load(d, cvv); cv_store(d.dst, cvv); } }
}

DI void rwkv_readout_phase(Fr& F) {
    const bf16* VB = (const bf16*)(F.ws + WS_VB); const bf16* G = (const bf16*)(F.ws + WS_G); const float* COEF = (const float*)(F.ws + WS_COEF);
    const bf16* YF = (const bf16*)(F.ws + WS_YF); const bf16* YB = (const bf16*)(F.ws + WS_YB); bf16* Z = (bf16*)(F.ws + WS_H);
    const int c0 = 16 * F.lane, hh = F.lane >> 2, j0 = (F.lane & 3) * 16;
    float lnw[16], lnb[16];
#pragma unroll
    for (int q = 0; q < 16; ++q) { lnw[q] = F.in[31][c0 + q]; lnb[q] = F.in[32][c0 + q]; }
#define RD16(dst, ptr) do { const u32x4 t0_ = *(const u32x4*)(ptr), t1_ = *(const u32x4*)((ptr) + 8); const unsigned tw_[8] = {t0_.x, t0_.y, t0_.z, t0_.w, t1_.x, t1_.y, t1_.z, t1_.w}; \
        _Pragma("unroll") for (int q_ = 0; q_ < 8; ++q_) { dst[2 * q_] = bflo(tw_[q_]); dst[2 * q_ + 1] = bfhi(tw_[q_]); } } while (0)
    for (int row = F.gw; row < ML; row += F.NGW) {
        const size_t off = (size_t)row * D + c0; const int b = row / SEQ, t = row % SEQ;
        const size_t hoff = ((size_t)(b * 16 + hh) * (SEQ + CTXL) + CTXL + t) * 64 + j0;
        float y[16], yb[16], vv[16], gv[16];
        RD16(y, YF + off); RD16(yb, YB + off); RD16(vv, VB + hoff); RD16(gv, G + off);
        const float cf = COEF[(size_t)(b * 16 + hh) * SEQ + t] + COEF[(size_t)(128 + b * 16 + hh) * SEQ + t];
        float s = 0.f;
#pragma unroll
        for (int q = 0; q < 16; ++q) { y[q] += yb[q]; s += y[q]; }
        s = red4(s);
        const float mean = s * (1.f / 64.f); float q2 = 0.f;
#pragma unroll
        for (int q = 0; q < 16; ++q) { const float d = y[q] - mean; q2 += d * d; }
        q2 = red4(q2);
        const float rstd = rsqrtf(q2 * (1.f / 64.f) + 64e-5f);
        float o[16];
#pragma unroll
        for (int q = 0; q < 16; ++q) o[q] = ((y[q] - mean) * rstd * lnw[q] + lnb[q] + cf * vv[q]) * gv[q];
        u32x4 p0, p1; p0.x = pk2(o[0], o[1]); p0.y = pk2(o[2], o[3]); p0.z = pk2(o[4], o[5]); p0.w = pk2(o[6], o[7]); p1.x = pk2(o[8], o[9]); p1.y = pk2(o[10], o[11]); p1.z = pk2(o[12], o[13]); p1.w = pk2(o[14], o[15]);
        *(u32x4*)(Z + off) = p0; *(u32x4*)(Z + off + 8) = p1;
    }
#undef RD16
}

DI void moe_route_phase(Fr& F, const bf16* xl, const float* normw, const float* modl) {
    int* TopE = (int*)(F.ws + WS_MISC + MISC_TOPE); f32x2* TopW = (f32x2*)(F.ws + WS_MISC + MISC_TOPW); int* Cnts = (int*)(F.ws + WS_MISC + MISC_CNTS);
    LAS int* lc = (LAS int*)F.lds;
    f32x4 rw[4][4][2];
#pragma unroll
    for (int j = 0; j < 4; ++j)
#pragma unroll
        for (int q = 0; q < 4; ++q) { const float* rp = F.in[34] + (size_t)(4 * (F.lane + 64 * j) + q) * 8; rw[j][q][0] = *(const f32x4*)rp; rw[j][q][1] = *(const f32x4*)(rp + 4); }
    for (int wg = F.bx; wg < 256; wg += F.G) {
        LDS_BARRIER();
        f32x4 nw[4], nsc[4], nsh[4];
        { const float* mrow0 = modl + (size_t)((wg * 64) / SEQ) * 6144;
#pragma unroll
          for (int j = 0; j < 4; ++j) { const int c4 = F.lane + 64 * j; nw[j] = ((const f32x4*)normw)[c4]; nsc[j] = ((const f32x4*)(mrow0 + 4096))[c4] + 1.f; nsh[j] = ((const f32x4*)(mrow0 + 3072))[c4]; } }
#pragma unroll 4
        for (int it = 0; it < 8; ++it) { const int row = wg * 64 + F.wave * 8 + it;
            const bf16* src = xl + (size_t)row * D;
            f32x4 v[4]; float ss = 0.f;
#pragma unroll
            for (int j = 0; j < 4; ++j) { v[j] = ldx4(src, F.lane + 64 * j); ss += (v[j].x * v[j].x + v[j].y * v[j].y) + (v[j].z * v[j].z + v[j].w * v[j].w); }
            const float rstd = rsqrtf(wave_sum_fast(ss) * (1.f / D) + 1e-6f);
            f32x4 l0 = (f32x4){0.f, 0.f, 0.f, 0.f}, l1 = l0;
#pragma unroll
            for (int j = 0; j < 4; ++j) {
                const f32x4 y = v[j] * rstd * nw[j] * nsc[j] + nsh[j];
                l0 += rw[j][0][0] * y.x + rw[j][1][0] * y.y + rw[j][2][0] * y.z + rw[j][3][0] * y.w;
                l1 += rw[j][0][1] * y.x + rw[j][1][1] * y.y + rw[j][2][1] * y.z + rw[j][3][1] * y.w; }
            float lg[8] = {l0.x, l0.y, l0.z, l0.w, l1.x, l1.y, l1.z, l1.w};
#pragma unroll
            for (int e = 0; e < 8; ++e) lg[e] = wave_sum_fast(lg[e]);
            int e0 = 0; float v0 = lg[0];
#pragma unroll
            for (int e = 1; e < 8; ++e) if (lg[e] > v0) { v0 = lg[e]; e0 = e; }
            int e1 = -1; float v1 = -3.0e38f;
#pragma unroll
            for (int e = 0; e < 8; ++e) if (e != e0 && lg[e] > v1) { v1 = lg[e]; e1 = e; }
            const float w0 = 1.f / (1.f + expf(v1 - v0)), w1 = 1.f - w0;
            if (F.lane == 0) { TopE[row] = e0 | (e1 << 8); TopW[row] = (f32x2){w0, w1}; lc[F.wave * 8 + it] = e0 | (e1 << 8); ((int*)(F.ws + WS_MISC + MISC_TAIL))[row] = 0; }
        }
        LDS_BARRIER();
        if (F.tid < 8) { int c = 0; for (int t = 0; t < 64; ++t) { const int code = lc[t]; c += ((code & 255) == F.tid ? 1 : 0) + ((code >> 8) == F.tid ? 1 : 0); } Cnts[wg * 8 + F.tid] = c; }
    }
}
DI void moe_gather_phase(Fr& F, const bf16* xl, const float* normw, const float* modl) {
    const int* TopE = (const int*)(F.ws + WS_MISC + MISC_TOPE); const f32x2* TopW = (const f32x2*)(F.ws + WS_MISC + MISC_TOPW);
    const int* Cnts = (const int*)(F.ws + WS_MISC + MISC_CNTS); int* Exp = (int*)(F.ws + WS_MISC + MISC_EXP);
    bf16* XG = (bf16*)(F.ws + WS_XG); int* RowTok = (int*)(F.ws + WS_ROWS); float* RowW = (float*)(F.ws + WS_ROWS + 262144);
    LAS int* lc = (LAS int*)F.lds;
    LAS int* tot = lc + 2048;
    LAS int* rows = tot + 32;
    LAS int* te = rows + 128;
    for (int idx = F.tid; idx < 2048; idx += NTHR) lc[idx] = Cnts[idx];
    WG_SYNC();
    for (int wg = F.bx; wg < 256; wg += F.G) {
        if (F.tid < 64) te[F.tid] = TopE[wg * 64 + F.tid];
        if (F.tid < 8) { int t = 0, mb = 0; for (int w = 0; w < 256; ++w) { const int c = lc[w * 8 + F.tid]; t += c; mb += (w < wg) ? c : 0; } tot[F.tid] = t; tot[16 + F.tid] = mb; }
        WG_SYNC();
        if (F.tid == 0) { int sgs = 0; for (int e = 0; e < 8; ++e) { tot[8 + e] = sgs; sgs += (tot[e] + 255) & ~255; }
            if (wg == 0) { int acc = 0; for (int e = 0; e < 8; ++e) { Exp[e] = tot[e]; Exp[8 + e] = tot[8 + e]; acc += (tot[e] + 255) >> 8; Exp[16 + e] = acc; } } }
        WG_SYNC();
        if (F.tid < 64) { const int code = te[F.tid]; const int e0 = code & 255, e1 = code >> 8; int r0 = 0, r1 = 0;
            for (int t = 0; t < F.tid; ++t) { const int c2 = te[t]; const int a = c2 & 255, bq = c2 >> 8; r0 += (a == e0 ? 1 : 0) + (bq == e0 ? 1 : 0); r1 += (a == e1 ? 1 : 0) + (bq == e1 ? 1 : 0); }
            rows[2 * F.tid] = tot[8 + e0] + tot[16 + e0] + r0; rows[2 * F.tid + 1] = tot[8 + e1] + tot[16 + e1] + r1; }
        WG_SYNC();
        for (int t = F.wave; t < 64; t += NWAVES) { const int tok = wg * 64 + t;
            const bf16* src = xl + (size_t)tok * D; const float* mrow = modl + (size_t)(tok / SEQ) * 6144;
            f32x4 v[4]; float ss = 0.f;
#pragma unroll
            for (int j = 0; j < 4; ++j) { v[j] = ldx4(src, F.lane + 64 * j); ss += (v[j].x * v[j].x + v[j].y * v[j].y) + (v[j].z * v[j].z + v[j].w * v[j].w); }
            const float rstd = rsqrtf(wave_sum_fast(ss) * (1.f / D) + 1e-6f);
            const int row0 = rows[2 * t], row1 = rows[2 * t + 1];
#pragma unroll
            for (int j = 0; j < 4; ++j) { const int c4 = F.lane + 64 * j;
                const f32x4 w = ((const f32x4*)normw)[c4], sc = ((const f32x4*)(mrow + 4096))[c4], sh = ((const f32x4*)(mrow + 3072))[c4];
                const f32x4 y = v[j] * rstd * w * (sc + 1.f) + sh;
                u32x2 p; p.x = pk2(y.x, y.y); p.y = pk2(y.z, y.w); ((u32x2*)(XG + (size_t)row0 * D))[c4] = p; ((u32x2*)(XG + (size_t)row1 * D))[c4] = p; }
            if (F.lane < 2) { const int k = F.lane, row = k ? row1 : row0; RowTok[row] = tok * 2 + k; const f32x2 w = TopW[tok]; RowW[row] = k ? w.y : w.x; ((int*)(F.ws + WS_MISC + MISC_SROW))[tok * 2 + k] = row; if (row >= 32768) ((int*)(F.ws + WS_MISC + MISC_TAIL))[tok] = 1; } }
        if (wg == 0) {
            for (int e = 0; e < 8; ++e) { const int a = tot[8 + e] + tot[e], bnd = tot[8 + e] + ((tot[e] + 255) & ~255); for (int rr = a + F.tid; rr < bnd; rr += NTHR) RowTok[rr] = -1; } }
        WG_SYNC();
    }
}
DI void moe_combine_phase(Fr& F, const bf16* xin, float* xl, const float* modl, int slot, int nslots, int flagval) {
    const bf16* YS = (const bf16*)(F.ws + WS_YS); const int* tailf = (const int*)(F.ws + WS_MISC + MISC_TAIL); const int* srow = (const int*)(F.ws + WS_MISC + MISC_SROW);
    const float* PART = (const float*)(F.ws + WS_XG); const float* RowW = (const float*)(F.ws + WS_ROWS + 262144);
    if (slot < 0 || slot >= nslots) return;
    for (int row = slot * NWAVES + F.wave; row < ML; row += nslots * NWAVES) {
        if (tailf[row] != flagval) continue;
        const float* mrow = modl + (size_t)(row / SEQ) * 6144 + 5120; float* xr = xl + (size_t)row * D;
        int r0 = 0, r1 = 0; float w0 = 0.f, w1 = 0.f;
        if (flagval) { r0 = srow[2 * row]; r1 = srow[2 * row + 1]; w0 = RowW[r0]; w1 = RowW[r1]; }
        const u32x2* s0 = (const u32x2*)(YS + (size_t)(2 * row) * D); const u32x2* s1 = (const u32x2*)(YS + (size_t)(2 * row + 1) * D);
#pragma unroll
        for (int j = 0; j < 4; ++j) { const int c4 = F.lane + 64 * j; const f32x4 x = ldx4(xin + (size_t)row * D, c4), m = ((const f32x4*)mrow)[c4];
            f32x4 a, bq;
            if (flagval && r0 >= 32768) { a = (f32x4){0.f, 0.f, 0.f, 0.f};
#pragma unroll
                for (int pp = 0; pp < 7; ++pp) a += ((const f32x4*)(PART + ((size_t)pp * 2048 + (r0 - 32768)) * D))[c4];
                a = a * w0; }
            else { const u32x2 t = s0[c4]; a = (f32x4){bflo(t.x), bfhi(t.x), bflo(t.y), bfhi(t.y)}; }
            if (flagval && r1 >= 32768) { bq = (f32x4){0.f, 0.f, 0.f, 0.f};
#pragma unroll
                for (int pp = 0; pp < 7; ++pp) bq += ((const f32x4*)(PART + ((size_t)pp * 2048 + (r1 - 32768)) * D))[c4];
                bq = bq * w1; }
            else { const u32x2 t = s1[c4]; bq = (f32x4){bflo(t.x), bfhi(t.x), bflo(t.y), bfhi(t.y)}; }
            ((f32x4*)xr)[c4] = x + m * (a + bq); }
    }
}

constexpr int N_PHASES = 20;

struct Args { const float* in[37]; float* out; unsigned char* ws; int ph_lo, ph_hi; };
template <class Epi> DI void run_gemm(Fr& F, const bf16* A, const bf16* Bt, int M, int N, int K, const Epi& E, int& rot) {
    int Kv = K; asm volatile("" : "+s"(Kv));
    pg8::Gemm g{A, Bt, M, N, Kv}; pg8::StaticOrder S; S.init(M, N, F.G, (F.bx + F.G - (rot % F.G)) % F.G); rot += (M / 256) * (N / 256);
    pg8::gemm_phase<Epi, pg8::StaticOrder>(F.lds, g, S, E);
}
__global__ void __launch_bounds__(NTHR, 2) fwd_kernel(Args args) {
    extern __shared__ __attribute__((aligned(16))) unsigned char lds_raw[];
    Fr F;
    F.lds = (LAS unsigned char*)lds_raw; F.ws = args.ws; F.in = args.in; F.out = args.out;
    F.tid = threadIdx.x; F.lane = F.tid & 63; F.wave = __builtin_amdgcn_readfirstlane(F.tid >> 6); F.bx = blockIdx.x; F.G = gridDim.x;
    F.gw = F.bx * NWAVES + F.wave; F.NGW = F.G * NWAVES;
    volatile LAS unsigned* MISC = (volatile LAS unsigned*)(F.lds + LDS_MISC_OFF);
    if (F.tid < 64) MISC[F.tid] = 0u;
    __syncthreads();
    const int lo = args.ph_lo, hi = args.ph_hi;
    const bool multi = (hi - lo) > 1;
    XcdBarrier bar; bar.bar = (unsigned*)(F.ws + WS_CTL) + CW_BAR; bar.x = 0; bar.st = nullptr;
    if (multi) bar = xcd_barrier_post((unsigned*)(F.ws + WS_CTL) + CW_BAR, MISC + 8);
#ifndef PH_MASK
#define PH_MASK 0xFFFFFFFFu
#endif
#define IN(k) ((((PH_MASK) >> (k)) & 1u) && lo <= (k) && (k) < hi)
#define REP(k) for (int rep_ = 0; rep_ < ((((PROBE_DUP) >> (k)) & 1u) ? 2 : 1); ++rep_)
#define SEAM(k) do { if (IN(k) && IN((k) + 1)) xcd_barrier(bar); } while (0)
    const float* const* in = args.in;
    float* MOD = (float*)(F.ws + WS_MOD);
    bf16* XL = (bf16*)(F.ws + WS_XLB); bf16* XC = (bf16*)(F.ws + WS_XC);
    bf16* H = (bf16*)(F.ws + WS_H); bf16* MIX = (bf16*)(F.ws + WS_MIX);

    if (IN(0)) REP(0) { p0_prologue(F); } SEAM(0);
    if (IN(1)) REP(1) { mod_rows(F, in[0], in[2], MA, in[6], MOD, 0, 1024, H); } SEAM(1);
    if (IN(2)) REP(2) { int rot = 0; EpiStore<0> E{(bf16*)(F.ws + WS_QKV), INW, INW}; run_gemm(F, H, (const bf16*)(F.ws + WS_W_IN), MA, INW, 1024, E, rot); } SEAM(2);
    if (IN(3)) REP(3) { na_norm_rows(F); ret_kv_phase(F); } SEAM(3);
    if (IN(4)) REP(4) { ret_prefix_phase(F); } SEAM(4);
    #ifndef PH5_SEL
#define PH5_SEL 3
#endif
    if (IN(5)) REP(5) { for (int r5_ = 0; r5_ < ((((PROBE_DUP) >> 27) & 1u) ? 2 : 1); ++r5_) ret_out_phase(F); for (int r6_ = 0; r6_ < ((((PROBE_DUP) >> 28) & 1u) ? 2 : 1); ++r6_) na_phase(F);
        if (F.G == 256) { LDS_BARRIER(); moe_fill(F, F.bx - 128, 128, CV_SCAN_ITEMS, CV_SCAN_ITEMS + P5_FILL); } } SEAM(5);
    if (IN(6)) REP(6) { int rot = 0; EpiResidB<float> E{in[0], XL, in[2], XC, MOD + 2048}; run_gemm(F, MIX, (const bf16*)(F.ws + WS_W_OUT), MA, 1024, 1024, E, rot); if (F.G == 256 && F.bx >= 32) { dense_fill(F, F.bx - 32, 224, DENSE_P0, DENSE_P6); WG_SYNC(); p0_small(F, (F.bx - 32) * NWAVES + F.wave, 224 * NWAVES, (F.bx - 32) * NTHR + F.tid, 224 * NTHR); } } SEAM(6);
    if (IN(7)) REP(7) { mod_rows(F, XL, XC, MA, in[7], MOD, 3072, 4096, H); } SEAM(7);
    unsigned* flow_cnt = (unsigned*)(F.ws + WS_CTL) + CW_FLOW;
    if (IN(8)) { int Kv = 1024; asm volatile("" : "+s"(Kv)); pg8::Gemm g{H, (const bf16*)(F.ws + WS_W_13), MA, 2 * FFN_H, Kv}; pg8::FlowProdOrder S{F.G, F.bx, flow_cnt};
        EpiSwigluT<true> E{(bf16*)(F.ws + WS_FFH), FFN_H}; pg8::gemm_phase<EpiSwigluT<true>, pg8::FlowProdOrder>(F.lds, g, S, E); }
    if (IN(9)) { int Kv = FFN_H; asm volatile("" : "+s"(Kv)); pg8::Gemm g{(const bf16*)(F.ws + WS_FFH), (const bf16*)(F.ws + WS_W_2), MA, 1024, Kv}; pg8::FlowConsOrder S{F.G, F.bx, flow_cnt};
        EpiResidB<bf16> E{XL, XL, XC, XC, MOD + 5120}; pg8::gemm_phase<EpiResidB<bf16>, pg8::FlowConsOrder>(F.lds, g, S, E);
        if (F.G == 256 && (F.bx >> 3) >= 18) { const int sl = ((F.bx >> 3) - 18) * 8 + (F.bx & 7); dense_fill(F, sl, 112, DENSE_P6, WG_DENSE);        WG_SYNC(); mod_gemv(F, 96, 192, sl, 112); } } SEAM(9);
    const float* MOD1 = MOD + 9 * 6144;
    if (IN(10)) REP(10) { xm_phase(F, XL, XC, in[6] + 1024, MOD1); } SEAM(10);
    if (IN(11)) REP(11) { int rot = 0; const bf16* XM = (const bf16*)(F.ws + WS_XM); const bf16* WR = (const bf16*)(F.ws + WS_W_RKV); const bf16* WL1 = (const bf16*)(F.ws + WS_W_L1);
        { EpiStoreHead E{(bf16*)(F.ws + WS_RB), SEQ, 0}; run_gemm(F, XM, WR, ML, 1024, 1024, E, rot); }
        { EpiStoreHead E{(bf16*)(F.ws + WS_KB), SEQ + CTXL, CTXL}; run_gemm(F, XM + (size_t)1 * MA * D, WR + 1024 * 1024, MA, 1024, 1024, E, rot); }
        { EpiStoreHead E{(bf16*)(F.ws + WS_VB), SEQ + CTXL, CTXL}; run_gemm(F, XM + (size_t)2 * MA * D, WR + 2 * 1024 * 1024, MA, 1024, 1024, E, rot); }
        { EpiStore<1, true> E{(bf16*)(F.ws + WS_L1), 256, 128}; run_gemm(F, XM + (size_t)3 * MA * D, WL1, MA, 256, 1024, E, rot); }
        { EpiStore<0, true> E{(bf16*)(F.ws + WS_L1) + 128, 256, 128}; run_gemm(F, XM + (size_t)4 * MA * D, WL1 + 256 * 1024, MA, 256, 1024, E, rot); }
        { EpiStore<2> E{(bf16*)(F.ws + WS_LG), 256, 256}; run_gemm(F, XM + (size_t)5 * MA * D, WL1 + 2 * 256 * 1024, ML, 256, 1024, E, rot); }
        if (F.G == 256) moe_fill(F, F.bx - 16, 240, CV_SCAN_ITEMS + P5_FILL + P0_FILL, WG_MOE);
        }
    if (IN(11) && (IN(12) || IN(13))) xcd_barrier(bar);
    if (IN(13)) REP(13) { { int rot = 0; EpiStore<0> E{(bf16*)(F.ws + WS_G), D, D}; run_gemm(F, (const bf16*)(F.ws + WS_LG), (const bf16*)(F.ws + WS_W_G2), ML, 1024, 256, E, rot); }
        rwkv_scan2_phase(F); } SEAM(13);
    if (IN(14)) REP(14) { rwkv_readout_phase(F); } SEAM(14);
    if (IN(15)) { int rot = 0; EpiResidB<bf16> E{XL, XL, XC, XC, MOD1 + 2048}; run_gemm(F, H, (const bf16*)(F.ws + WS_W_O), ML, 1024, 1024, E, rot); } SEAM(15);
    if (IN(16)) REP(16) { moe_route_phase(F, XL, in[7] + 1024, MOD1); } SEAM(16);
    if (IN(17)) REP(17) { moe_gather_phase(F, XL, in[7] + 1024, MOD1); } SEAM(17);
    if (IN(18) || IN(19)) {
        const int* Exp = (const int*)(F.ws + WS_MISC + MISC_EXP);
        pg8::MoeOrder S; S.G = F.G; S.c = F.bx; S.pm0 = 0;
#pragma unroll
        for (int e = 0; e < 8; ++e) S.tend[e] = Exp[16 + e];
        S.nM = S.tend[7];
        if (IN(18)) REP(18) { S.nN = 2 * EXP_H / 256; S.nwg = S.nM * S.nN; pg8::Gemm g{(const bf16*)(F.ws + WS_XG), (const bf16*)(F.ws + WS_W_M13), XG_ROWS, 2 * EXP_H, 1024};
            EpiSwiglu E{(bf16*)(F.ws + WS_HG), EXP_H}; pg8::gemm_phase<EpiSwiglu, pg8::MoeOrder>(F.lds, g, S, E); }
        SEAM(18);
        if (IN(19)) { S.nN = 4; S.nM = S.tend[7] < 128 ? S.tend[7] : 128; S.nwg = S.nM * S.nN;
            pg8::Gemm g{(const bf16*)(F.ws + WS_HG), (const bf16*)(F.ws + WS_W_M2), XG_ROWS, 1024, EXP_H};
            EpiMoeOut E{(bf16*)(F.ws + WS_YS), (const int*)(F.ws + WS_ROWS), (const float*)(F.ws + WS_ROWS + 262144)}; pg8::gemm_phase<EpiMoeOut, pg8::MoeOrder>(F.lds, g, S, E); }
    }
    if (IN(19) && IN(20)) xcd_barrier(bar);
    if (IN(20)) {
        const int* Exp = (const int*)(F.ws + WS_MISC + MISC_EXP); const int ntile = Exp[16 + 7], nsub = ntile > 128 ? (ntile - 128) * 4 * 7 : 0;
        if (nsub > 0) { pg8::TailSplitOrder S; S.nsub = nsub; S.G = F.G; S.c = F.bx;
#pragma unroll
            for (int e = 0; e < 8; ++e) S.tend[e] = Exp[16 + e];
            pg8::Gemm g{(const bf16*)(F.ws + WS_HG), (const bf16*)(F.ws + WS_W_M2), XG_ROWS, 1024, 512, EXP_H};
            EpiMoePart E{(float*)(F.ws + WS_XG)}; pg8::gemm_phase<EpiMoePart, pg8::TailSplitOrder>(F.lds, g, S, E); }
        moe_combine_phase(F, XL, F.out, MOD1, F.bx, F.G, 0);
        if (multi) xcd_barrier(bar);
        moe_combine_phase(F, XL, F.out, MOD1, F.bx, F.G, 1);
    }
#undef IN
#undef SEAM
}

#ifndef MK_SPLIT
#define MK_SPLIT 0
#endif
extern "C" void kernel_launch(void* const* d_in, const int* in_sizes, int n_in, void* d_out, int out_size, void* d_ws, size_t ws_size, hipStream_t stream) {
    static int grid = 0;
    if (grid == 0) {
        if (n_in != 37 || out_size != ML * D || ws_size < WS_END) { fprintf(stderr, "kernel_launch: unexpected problem (n_in %d out %d ws %zu)\n", n_in, out_size, ws_size); grid = -1; return; }
        int dev = 0, cus = 0, per_cu = 0;
        if (hipGetDevice(&dev) != hipSuccess || hipDeviceGetAttribute(&cus, hipDeviceAttributeMultiprocessorCount, dev) != hipSuccess) { grid = -1; return; }
        if (hipFuncSetAttribute((const void*)fwd_kernel, hipFuncAttributeMaxDynamicSharedMemorySize, LDS_BYTES) != hipSuccess) { fprintf(stderr, "kernel_launch: hipFuncSetAttribute failed\n"); grid = -1; return; }
        if (hipOccupancyMaxActiveBlocksPerMultiprocessor(&per_cu, (const void*)fwd_kernel, NTHR, LDS_BYTES) != hipSuccess || per_cu < 1) { fprintf(stderr, "kernel_launch: occupancy query says %d\n", per_cu); }
        (void)hipGetLastError();
        grid = cus;
    }
    if (grid < 0) return;
    (void)hipMemsetAsync((char*)d_ws + WS_CTL, 0, CTL_ZERO_BYTES, stream);
    Args a{};
    for (int i = 0; i < 37; ++i) a.in[i] = (const float*)d_in[i];
    a.out = (float*)d_out; a.ws = (unsigned char*)d_ws;
#if MK_SPLIT
    for (int p = 0; p <= N_PHASES; ++p) { a.ph_lo = p; a.ph_hi = p + 1; hipLaunchKernelGGL(fwd_kernel, dim3(grid), dim3(NTHR), LDS_BYTES, stream, a); }
#elif defined(PROBE_RELAUNCH)
    a.ph_lo = 0; a.ph_hi = PROBE_RELAUNCH + 1; hipLaunchKernelGGL(fwd_kernel, dim3(grid), dim3(NTHR), LDS_BYTES, stream, a);
    (void)hipMemsetAsync((char*)d_ws + WS_CTL, 0, CTL_ZERO_BYTES, stream);
    a.ph_lo = PROBE_RELAUNCH; a.ph_hi = PROBE_RELAUNCH + 1; hipLaunchKernelGGL(fwd_kernel, dim3(grid), dim3(NTHR), LDS_BYTES, stream, a);
    a.ph_lo = PROBE_RELAUNCH + 1; a.ph_hi = N_PHASES + 1; hipLaunchKernelGGL(fwd_kernel, dim3(grid), dim3(NTHR), LDS_BYTES, stream, a);
#else
    a.ph_lo = 0; a.ph_hi = N_PHASES + 1; hipLaunchKernelGGL(fwd_kernel, dim3(grid), dim3(NTHR), LDS_BYTES, stream, a);
#endif
}
```
